# Optimizing an MI355X kernel written in HIP

```python
import jax, jax.numpy as jnp
from jax import lax
import numpy as np

D_MODEL = 1024
BATCH = 16
SEQ = 2048
DEPTH = 2

CHUNK = 64
N_A_LAYERS = DEPTH // 2
N_B_LAYERS = DEPTH - N_A_LAYERS
EPS = 1e-6

MA_HEADS = 8
MA_QK = 64
MA_V = D_MODEL // MA_HEADS
MA_CONV = 4
MA_QK_COLS = 2 * MA_HEADS * MA_QK
MA_PROJ = MA_QK_COLS + 2 * D_MODEL + 2 * MA_HEADS

SB_HEADS = 16
SB_DIM = D_MODEL // SB_HEADS
SB_BLOCK = 128

PEER_HEADS = 8
PEER_NKEYS = 128
PEER_EXPERTS = PEER_NKEYS * PEER_NKEYS
PEER_QDIM = 256
PEER_TOPK = 16
PEER_BLOCK = 128

kernel_name = 'hybrid_mlstm_stickbreaking_peer'


def rmsnorm(x, g):
    xf = x.astype(jnp.float32)
    y = xf * lax.rsqrt(jnp.mean(xf * xf, axis=-1, keepdims=True) + EPS)
    return (y * g.astype(jnp.float32)).astype(x.dtype)


def ada_mod(c, w, b):
    return jnp.einsum('bd,de->be', jax.nn.silu(c), w) + b


def modulate(h, shift, scale):
    return h * (1.0 + scale[:, None, :]) + shift[:, None, :]


def causal_conv(x, w):
    width, ch = w.shape
    return lax.conv_general_dilated(x, w[:, None, :], window_strides=(1,), padding=[(width - 1, 0)],
                                    dimension_numbers=('NWC', 'WIO', 'NWC'), feature_group_count=ch)


def mlstm_mixer(h, w_in, conv_w, b_if, hnorm_g, w_out):
    bsz, seq, _ = h.shape
    nc = seq // CHUNK
    proj = jnp.einsum('bsd,de->bse', h, w_in)
    qk, v, o, gates = jnp.split(proj, [MA_QK_COLS, MA_QK_COLS + D_MODEL, MA_QK_COLS + 2 * D_MODEL], axis=-1)
    qk = jax.nn.silu(causal_conv(qk, conv_w))
    q, k = jnp.split(qk, 2, axis=-1)
    gates = (gates + b_if).astype(jnp.float32)
    i_pre, f_pre = jnp.split(gates, 2, axis=-1)

    def to_chunks(t, d):
        return t.reshape(bsz, nc, CHUNK, MA_HEADS, d).transpose(0, 3, 1, 2, 4)

    q = to_chunks(q, MA_QK).astype(jnp.float32) * (MA_QK ** -0.5)
    k = to_chunks(k, MA_QK).astype(jnp.float32)
    v = to_chunks(v, MA_V).astype(jnp.float32)
    i_pre = i_pre.reshape(bsz, nc, CHUNK, MA_HEADS).transpose(0, 3, 1, 2)
    log_f = jax.nn.log_sigmoid(f_pre).reshape(bsz, nc, CHUNK, MA_HEADS).transpose(0, 3, 1, 2)
    b = jnp.cumsum(log_f, axis=-1)
    b_last = b[..., -1]

    w_state = b_last[..., None] - b + i_pre
    m_loc = jnp.max(w_state, axis=-1)
    e_state = jnp.exp(w_state - m_loc[..., None])
    c_loc = jnp.einsum('bhcl,bhclv,bhclk->bhcvk', e_state, v, k)
    n_loc = jnp.einsum('bhcl,bhclk->bhck', e_state, k)

    def step(carry, inp):
        c_st, n_st, m_st = carry
        cl, nl, ml, bl = inp
        m_new = jnp.maximum(bl + m_st, ml)
        a = jnp.exp(bl + m_st - m_new)
        r = jnp.exp(ml - m_new)
        c_new = a[..., None, None] * c_st + r[..., None, None] * cl
        n_new = a[..., None] * n_st + r[..., None] * nl
        return (c_new, n_new, m_new), (c_st, n_st, m_st)

    init = (jnp.zeros((bsz, MA_HEADS, MA_V, MA_QK), jnp.float32),
            jnp.zeros((bsz, MA_HEADS, MA_QK), jnp.float32),
            jnp.zeros((bsz, MA_HEADS), jnp.float32))
    xs = (c_loc.transpose(2, 0, 1, 3, 4), n_loc.transpose(2, 0, 1, 3),
          m_loc.transpose(2, 0, 1), b_last.transpose(2, 0, 1))
    _, (c_prev, n_prev, m_prev) = lax.scan(step, init, xs)
    c_prev = c_prev.transpose(1, 2, 0, 3, 4)
    n_prev = n_prev.transpose(1, 2, 0, 3)
    m_prev = m_prev.transpose(1, 2, 0)

    causal = jnp.tril(jnp.ones((CHUNK, CHUNK), dtype=bool))
    log_d = jnp.where(causal, b[..., :, None] - b[..., None, :] + i_pre[..., None, :], -jnp.inf)
    inter_log = b + m_prev[..., None]
    m_t = jnp.maximum(inter_log, jnp.max(log_d, axis=-1))
    inter_w = jnp.exp(inter_log - m_t)
    s_qk = jnp.einsum('bhcld,bhcsd->bhcls', q, k) * jnp.exp(log_d - m_t[..., None])
    num = jnp.einsum('bhcls,bhcsv->bhclv', s_qk, v) + inter_w[..., None] * jnp.einsum('bhcvk,bhclk->bhclv', c_prev, q)
    den = jnp.sum(s_qk, axis=-1) + inter_w * jnp.einsum('bhck,bhclk->bhcl', n_prev, q)
    hh = num / jnp.maximum(jnp.abs(den), jnp.exp(-m_t))[..., None]
    hh = hh.transpose(0, 2, 3, 1, 4).reshape(bsz, seq, MA_HEADS, MA_V)
    hh = rmsnorm(hh, hnorm_g) * jax.nn.sigmoid(o.astype(jnp.float32)).reshape(bsz, seq, MA_HEADS, MA_V)
    return jnp.einsum('bse,ed->bsd', hh.reshape(bsz, seq, D_MODEL).astype(h.dtype), w_out)


def shared_kv(x, c, kv_ada_w, kv_ada_b, kv_norm_g, kv_w, k_norm_g):
    bsz, seq, _ = x.shape
    shift, scale = jnp.split(ada_mod(c, kv_ada_w, kv_ada_b), 2, axis=-1)
    h = modulate(rmsnorm(x, kv_norm_g), shift, scale)
    kv = jnp.einsum('bsd,de->bse', h, kv_w)
    k, v = jnp.split(kv, 2, axis=-1)
    k = rmsnorm(k.reshape(bsz, seq, SB_HEADS, SB_DIM), k_norm_g).transpose(0, 2, 1, 3)
    v = v.reshape(bsz, seq, SB_HEADS, SB_DIM).transpose(0, 2, 1, 3)
    return k, v


def stick_breaking_mixer(h, k, v, w_q, q_norm_g, w_out):
    bsz, seq, _ = h.shape
    q = jnp.einsum('bsd,de->bse', h, w_q).reshape(bsz, seq, SB_HEADS, SB_DIM)
    q = (rmsnorm(q, q_norm_g) * (SB_DIM ** -0.5)).transpose(0, 2, 1, 3)
    outs = []
    for blk in range(seq // SB_BLOCK):
        t0 = blk * SB_BLOCK
        end = t0 + SB_BLOCK
        z = jnp.einsum('bhtd,bhsd->bhts', q[:, :, t0:end], k[:, :, :end]).astype(jnp.float32)
        strict = jnp.arange(end)[None, :] < (t0 + jnp.arange(SB_BLOCK))[:, None]
        log1m = jnp.where(strict, -jax.nn.softplus(z), 0.0)
        between = lax.cumsum(log1m, axis=3, reverse=True) - log1m
        a = jnp.where(strict, jnp.exp(jax.nn.log_sigmoid(z) + between), 0.0)
        outs.append(jnp.einsum('bhts,bhsd->bhtd', a, v[:, :, :end].astype(jnp.float32)))
    o = jnp.concatenate(outs, axis=2).transpose(0, 2, 1, 3).reshape(bsz, seq, D_MODEL)
    return jnp.einsum('bse,ed->bsd', o.astype(h.dtype), w_out)


def peer_ffn(h, w_q, sub_keys, peer_u, peer_v):
    bsz, seq, d = h.shape
    xt = h.reshape(bsz * seq // PEER_BLOCK, PEER_BLOCK, d)

    def block(xb):
        q = jnp.einsum('td,de->te', xb, w_q).reshape(PEER_BLOCK, PEER_HEADS, 2, PEER_QDIM // 2)
        s = jnp.einsum('thpk,pnk->thpn', q, sub_keys).astype(jnp.float32)
        s_top, i_top = lax.top_k(s, PEER_TOPK)
        cand = (s_top[:, :, 0, :, None] + s_top[:, :, 1, None, :]).reshape(PEER_BLOCK, PEER_HEADS, PEER_TOPK * PEER_TOPK)
        cand_idx = (i_top[:, :, 0, :, None] * PEER_NKEYS + i_top[:, :, 1, None, :]).reshape(PEER_BLOCK, PEER_HEADS, PEER_TOPK * PEER_TOPK)
        g_top, pos = lax.top_k(cand, PEER_TOPK)
        expert = jnp.take_along_axis(cand_idx, pos, axis=-1)
        g = jax.nn.softmax(g_top, axis=-1)
        u = jnp.take(peer_u, expert, axis=0)
        act = jax.nn.gelu(jnp.einsum('thkd,td->thk', u, xb).astype(jnp.float32), approximate=False)
        vv = jnp.take(peer_v, expert, axis=0)
        return jnp.einsum('thk,thkd->td', (g * act).astype(xb.dtype), vv)

    return lax.map(block, xt).reshape(bsz, seq, d)


def setup_inputs(seed: int = 0) -> dict:
    key = jax.random.key(seed)
    ks = jax.random.split(key, 24)
    f32 = jnp.float32
    d = D_MODEL

    def nrm(k, shape, scale):
        return jax.random.normal(k, shape, f32) * scale

    def gain(k, shape):
        return 1.0 + 0.02 * jax.random.normal(k, shape, f32)

    if_base = jnp.concatenate([jnp.zeros((MA_HEADS,), f32), jnp.linspace(3.0, 6.0, MA_HEADS, dtype=f32)])
    return {
        'x': nrm(ks[0], (BATCH, SEQ, d), 1.0),
        'c': nrm(ks[1], (BATCH, d), 1.0),
        'ada_w': nrm(ks[2], (DEPTH, d, 6 * d), 0.5 * d ** -0.5),
        'ada_b': nrm(ks[3], (DEPTH, 6 * d), 0.01),
        'norm_mix_g': gain(ks[4], (DEPTH, d)),
        'norm_ffn_g': gain(ks[5], (DEPTH, d)),
        'ma_w_in': nrm(ks[6], (N_A_LAYERS, d, MA_PROJ), d ** -0.5),
        'ma_conv_w': nrm(ks[7], (N_A_LAYERS, MA_CONV, MA_QK_COLS), MA_CONV ** -0.5),
        'ma_b_if': if_base + nrm(ks[8], (N_A_LAYERS, 2 * MA_HEADS), 0.1),
        'ma_hnorm_g': gain(ks[9], (N_A_LAYERS, MA_HEADS, MA_V)),
        'ma_w_out': nrm(ks[10], (N_A_LAYERS, d, d), d ** -0.5),
        'kv_ada_w': nrm(ks[11], (d, 2 * d), 0.5 * d ** -0.5),
        'kv_ada_b': nrm(ks[12], (2 * d,), 0.01),
        'kv_norm_g': gain(ks[13], (d,)),
        'kv_w': nrm(ks[14], (d, 2 * d), d ** -0.5),
        'k_norm_g': gain(ks[15], (SB_DIM,)),
        'sb_w_q': nrm(ks[16], (N_B_LAYERS, d, d), d ** -0.5),
        'sb_q_norm_g': gain(ks[17], (N_B_LAYERS, SB_DIM)),
        'sb_w_out': nrm(ks[18], (N_B_LAYERS, d, d), d ** -0.5),
        'peer_w_q': nrm(ks[19], (DEPTH, d, PEER_HEADS * PEER_QDIM), d ** -0.5),
        'peer_sub_keys': nrm(ks[20], (DEPTH, 2, PEER_NKEYS, PEER_QDIM // 2), (PEER_QDIM // 2) ** -0.5),
        'peer_u': nrm(ks[21], (DEPTH, PEER_EXPERTS, d), d ** -0.5),
        'peer_v': nrm(ks[22], (DEPTH, PEER_EXPERTS, d), PEER_HEADS ** -0.5),
    }


def reference(x, c, ada_w, ada_b, norm_mix_g, norm_ffn_g, ma_w_in, ma_conv_w, ma_b_if, ma_hnorm_g, ma_w_out,
              kv_ada_w, kv_ada_b, kv_norm_g, kv_w, k_norm_g, sb_w_q, sb_q_norm_g, sb_w_out,
              peer_w_q, peer_sub_keys, peer_u, peer_v):
    k_sh = None
    v_sh = None
    for layer in range(DEPTH):
        sh1, sc1, g1, sh2, sc2, g2 = jnp.split(ada_mod(c, ada_w[layer], ada_b[layer]), 6, axis=-1)
        h = modulate(rmsnorm(x, norm_mix_g[layer]), sh1, sc1)
        if layer < N_A_LAYERS:
            y = mlstm_mixer(h, ma_w_in[layer], ma_conv_w[layer], ma_b_if[layer], ma_hnorm_g[layer], ma_w_out[layer])
        else:
            if layer == N_A_LAYERS:
                k_sh, v_sh = shared_kv(x, c, kv_ada_w, kv_ada_b, kv_norm_g, kv_w, k_norm_g)
            j = layer - N_A_LAYERS
            y = stick_breaking_mixer(h, k_sh, v_sh, sb_w_q[j], sb_q_norm_g[j], sb_w_out[j])
        x = x + g1[:, None, :] * y
        h = modulate(rmsnorm(x, norm_ffn_g[layer]), sh2, sc2)
        x = x + g2[:, None, :] * peer_ffn(h, peer_w_q[layer], peer_sub_keys[layer], peer_u[layer], peer_v[layer])
    return x
```

```cpp
#include <hip/hip_runtime.h>
#include <hip/hip_cooperative_groups.h>
#include <cstdio>
#include <cstdint>
namespace cg = cooperative_groups;
#define N_LAUNCH_MODE 1
namespace pg8 {
#define PG8_LAS __attribute__((address_space(3)))
typedef unsigned short bf16_t;
typedef short bf16x8 __attribute__((ext_vector_type(8)));
typedef float f32x4 __attribute__((ext_vector_type(4)));
typedef unsigned u32x4 __attribute__((ext_vector_type(4)));
constexpr int BM = 256, BK = 64, HALF = 128, HTB = HALF * BK * 2  , STAGE_BYTES = 8 * HTB, NXCD = 8, WGM = 8;

__host__ __device__ __forceinline__ int lds_byte(int r, int c) { const int st = (r >> 4) * 2 + (c >> 5), rr = r & 15, cc = c & 31, ob = rr * 64 + cc * 2; return st * 1024 + (ob ^ (((ob >> 9) & 1) << 5)); }
__host__ __device__ __forceinline__ void stage_rc(int b, int& R, int& C) { const int st = b / 1024, sb = b % 1024, swz = sb ^ (((sb >> 9) & 1) << 5); R = (st >> 1) * 16 + swz / 64; C = (st & 1) * 32 + (swz % 64) / 2; }
__host__ __device__ __forceinline__ int perm32(int rho) { const int n = rho >> 4, i = rho & 15; return 8 * (i >> 2) + 4 * n + (i & 3); }

struct Unit { int pm, pn; };
struct Gemm { const bf16_t* A; const bf16_t* Bt; int M, N, K; };

struct StaticOrder {
    int nM, nN, nwg, G, c;
    __host__ __device__ void init(int M, int N, int G_, int c_) { nM = M / BM; nN = N / BM; nwg = nM * nN; G = G_; c = c_; }
    __host__ __device__ bool next(int i, Unit& u) const {
        const long L = (long)i * G + c; if (L >= nwg) return false;
        int wgid = (int)L; { const int q = nwg / NXCD, r = nwg % NXCD, xcd = wgid % NXCD, off = wgid / NXCD; wgid = (xcd < r ? xcd * (q + 1) : r * (q + 1) + (xcd - r) * q) + off; }
        const int nig = WGM * nN, gid = wgid / nig, fm = gid * WGM, gsz = (nM - fm) < WGM ? (nM - fm) : WGM;
        u.pm = fm + ((wgid % nig) % gsz); u.pn = (wgid % nig) / gsz; return true;
    }
    __device__ __forceinline__ void a_ready(const Unit&) const {}
    __device__ __forceinline__ void done(const Unit&) const {}
};

__device__ __forceinline__ unsigned cvt_pk_bf16(float lo, float hi) { unsigned r; asm volatile("v_cvt_pk_bf16_f32 %0, %1, %2" : "=v"(r) : "v"(lo), "v"(hi)); return r; }
typedef float f32x2 __attribute__((ext_vector_type(2)));
__device__ __forceinline__ f32x2 gelu_pk(f32x2 v) {
    const f32x2 av = __builtin_elementwise_abs(v), d = av * 0.2316418882f + 1.0f;
    f32x2 t; t.x = __builtin_amdgcn_rcpf(d.x); t.y = __builtin_amdgcn_rcpf(d.y);
    f32x2 q = t * 0.5307027145f + (-0.7265760135f); q = q * t + 0.7107068705f; q = q * t + (-0.142248368f); q = q * t + 0.127414796f; q = q * t;
    const f32x2 s = (v * v) * (-0.72134752044f);
    f32x2 e; e.x = __builtin_amdgcn_exp2f(s.x); e.y = __builtin_amdgcn_exp2f(s.y);
    const f32x2 m = v * (q * e), r = v - m;
    f32x2 o; o.x = v.x < 0.f ? m.x : r.x; o.y = v.y < 0.f ? m.y : r.y; return o;
}

template <int ACT  > struct EpiBf16 {
    static constexpr bool PERM = true, AFTER_DRAIN = false; static_assert(ACT == 0 || ACT == 1, "EpiBf16: ACT is 0 (none) or 1 (gelu_pk)");
    bf16_t* O; int ldc; const float* bias; int split_cols; size_t split_stride; float scale0;
    __device__ __forceinline__ void operator()(const f32x4 (&acc)[2][2][4][2], const Unit& u, int wr, int wc, int fr, int fq) const {
        const int row0 = u.pm * BM + wr * 64 + fr; int colt = u.pn * BM; bf16_t* base = O;
        float sc = 1.f; if (split_cols) { const int t = colt / split_cols; base += (size_t)t * split_stride; colt -= t * split_cols; if (t == 0) sc = scale0; }
        const int col0 = colt + wc * 32 + 8 * fq, bcol0 = u.pn * BM + wc * 32 + 8 * fq;
        f32x4 bv[2][2];
#pragma unroll
        for (int bj = 0; bj < 2; ++bj)
#pragma unroll
            for (int n = 0; n < 2; ++n) bv[bj][n] = bias ? *(const f32x4*)(bias + bcol0 + bj * HALF + 4 * n) : (f32x4){0.f, 0.f, 0.f, 0.f};
#pragma unroll
        for (int ai = 0; ai < 2; ++ai)
#pragma unroll
            for (int m = 0; m < 4; ++m) { bf16_t* rowp = base + (size_t)(row0 + ai * HALF + m * 16) * ldc + col0;
#pragma unroll
                for (int bj = 0; bj < 2; ++bj) { f32x4 v0 = acc[ai][bj][m][0] + bv[bj][0], v1 = acc[ai][bj][m][1] + bv[bj][1];
                    if (ACT == 1) { f32x2 a = gelu_pk((f32x2){v0[0], v0[1]}), b = gelu_pk((f32x2){v0[2], v0[3]}), c = gelu_pk((f32x2){v1[0], v1[1]}), d = gelu_pk((f32x2){v1[2], v1[3]});
                        v0 = (f32x4){a.x, a.y, b.x, b.y}; v1 = (f32x4){c.x, c.y, d.x, d.y}; }
                    v0 = v0 * sc; v1 = v1 * sc; u32x4 w; w.x = cvt_pk_bf16(v0[0], v0[1]); w.y = cvt_pk_bf16(v0[2], v0[3]); w.z = cvt_pk_bf16(v1[0], v1[1]); w.w = cvt_pk_bf16(v1[2], v1[3]);
                    *(u32x4*)(rowp + bj * HALF) = w; } }
    }
};
struct EpiResid {
    static constexpr bool PERM = false, AFTER_DRAIN = false;
    const float* base; float* out; const float* gate; int gstride;
    __device__ __forceinline__ void operator()(const f32x4 (&acc)[2][2][4][2], const Unit& u, int wr, int wc, int fr, int fq) const {
        const int col0 = u.pn * BM + wc * 32 + 4 * fq;
        const int b = (u.pm * BM) >> 11;
        f32x4 gv[2][2];
#pragma unroll
        for (int bj = 0; bj < 2; ++bj)
#pragma unroll
            for (int n = 0; n < 2; ++n) gv[bj][n] = *(const f32x4*)(gate + (size_t)b * gstride + col0 + bj * HALF + n * 16);
#pragma unroll
        for (int ai = 0; ai < 2; ++ai)
#pragma unroll
            for (int m = 0; m < 4; ++m) { const size_t off = (size_t)(u.pm * BM + ai * HALF + wr * 64 + m * 16 + fr) * 1024 + col0;
#pragma unroll
                for (int bj = 0; bj < 2; ++bj)
#pragma unroll
                    for (int n = 0; n < 2; ++n) { const f32x4 bs = *(const f32x4*)(base + off + bj * HALF + n * 16);
                        *(f32x4*)(out + off + bj * HALF + n * 16) = bs + gv[bj][n] * acc[ai][bj][m][n]; }
                if (m & 1) asm volatile("" ::: "memory"); }
    }
};
struct EpiHeadNorm {
    static constexpr bool PERM = true, AFTER_DRAIN = false;
    bf16_t* O0; bf16_t* O1; int ntile_norm; const float* g; float scale; float eps;
    __device__ __forceinline__ void operator()(const f32x4 (&acc)[2][2][4][2], const Unit& u, int wr, int wc, int fr, int fq) const {
        const bool nrm = u.pn < ntile_norm; bf16_t* O = nrm ? O0 : O1; const int pnl = nrm ? u.pn : u.pn - ntile_norm;
        f32x4 gv[2][2];
#pragma unroll
        for (int bj = 0; bj < 2; ++bj)
#pragma unroll
            for (int n = 0; n < 2; ++n) { const f32x4 t = *(const f32x4*)(g + 32 * bj + 8 * fq + 4 * n); gv[bj][n] = nrm ? t * scale : (f32x4){1.f, 1.f, 1.f, 1.f}; }
#pragma unroll
        for (int ai = 0; ai < 2; ++ai)
#pragma unroll
            for (int m = 0; m < 4; ++m) {
                float ss = 0.f;
#pragma unroll
                for (int bj = 0; bj < 2; ++bj)
#pragma unroll
                    for (int n = 0; n < 2; ++n) { const f32x4 x = acc[ai][bj][m][n]; ss += (x[0] * x[0] + x[1] * x[1]) + (x[2] * x[2] + x[3] * x[3]); }
                ss += __shfl_xor(ss, 16); ss += __shfl_xor(ss, 32);
                const float rs = nrm ? 1.0f / sqrtf(ss * (1.0f / 64.0f) + eps) : 1.0f;
                bf16_t* rowp = O + (size_t)(u.pm * BM + ai * HALF + wr * 64 + m * 16 + fr) * 1024 + pnl * BM + wc * 64 + 8 * fq;
#pragma unroll
                for (int bj = 0; bj < 2; ++bj) { const f32x4 v0 = acc[ai][bj][m][0] * rs * gv[bj][0], v1 = acc[ai][bj][m][1] * rs * gv[bj][1];
                    u32x4 w; w.x = cvt_pk_bf16(v0[0], v0[1]); w.y = cvt_pk_bf16(v0[2], v0[3]); w.z = cvt_pk_bf16(v1[0], v1[1]); w.w = cvt_pk_bf16(v1[2], v1[3]);
                    *(u32x4*)(rowp + bj * 32) = w; }
            }
    }
};
template <class Epi, class Sched, bool ALIGN_EPI = false, bool SP2 = false>
__device__ __forceinline__ void gemm_phase(PG8_LAS unsigned char* lds, const Gemm g, const Sched& S, const Epi& E) {
    const int tid = threadIdx.x, wid = __builtin_amdgcn_readfirstlane(tid >> 6), lane = tid & 63, wr = wid >> 2, wc = wid & 3, fr = lane & 15, fq = lane >> 4;
    const int K = g.K, nt = K / BK;
    unsigned voffA[2], voffB[2];
#pragma unroll
    for (int i = 0; i < 2; ++i) { int R, C; stage_rc(tid * 16 + i * 8192, R, C); const int Rb = Epi::PERM ? ((R & ~31) + perm32(R & 31)) : R;
        voffA[i] = (unsigned)(R * K + C) * 2u; voffB[i] = (unsigned)(Rb * K + C) * 2u; }
    const size_t kstep = (size_t)(BK * 2);
    const size_t hstep = (size_t)HALF * K * 2;
    const size_t tstep = 2 * hstep;
    const unsigned ldsw = (unsigned)wid * 1024u;
    const int aoff = lds_byte(wr * 64 + fr, fq * 8), boff = lds_byte(wc * 32 + fr, fq * 8);
#define PG8_SA(b, h) (((b) * 2 + (h)) * HTB)
#define PG8_SB(b, h) ((4 + (b) * 2 + (h)) * HTB)
#define PG8_STAGE(bufoff, gbase, voff) do { _Pragma("unroll") for (int _i = 0; _i < 2; ++_i) \
        __builtin_amdgcn_global_load_lds((const unsigned*)((const char*)(gbase) + (voff)[_i]), (PG8_LAS unsigned*)(lds + (bufoff) + ldsw + _i * 8192), 16, 0, 0); } while (0)
#define PG8_LDA(dst, b, h) do { _Pragma("unroll") for (int m = 0; m < 4; ++m) _Pragma("unroll") for (int k = 0; k < 2; ++k) dst[m][k] = *(const PG8_LAS bf16x8*)(lds + PG8_SA(b, h) + aoff + m * 2048 + k * 1024); } while (0)
#define PG8_LDB(dst, b, h) do { _Pragma("unroll") for (int n = 0; n < 2; ++n) _Pragma("unroll") for (int k = 0; k < 2; ++k) dst[n][k] = *(const PG8_LAS bf16x8*)(lds + PG8_SB(b, h) + boff + n * 2048 + k * 1024); } while (0)
#define PG8_MMA(ai, bj, At, Bt) do { __builtin_amdgcn_s_setprio(1); _Pragma("unroll") for (int m = 0; m < 4; ++m) _Pragma("unroll") for (int n = 0; n < 2; ++n) _Pragma("unroll") for (int k = 0; k < 2; ++k) \
        acc[ai][bj][m][n] = __builtin_amdgcn_mfma_f32_16x16x32_bf16(Bt[n][k], At[m][k], acc[ai][bj][m][n], 0, 0, 0); __builtin_amdgcn_s_setprio(0); } while (0)
#define PG8_WAIT_V(n) asm volatile("s_waitcnt vmcnt(" #n ")" ::: "memory")
#define PG8_WAIT_L(n) asm volatile("s_waitcnt lgkmcnt(" #n ")" ::: "memory")
#define PG8_BAR __builtin_amdgcn_s_barrier()
#define PG8_SCHED __builtin_amdgcn_sched_barrier(0)
    Unit cur, nxt; int ui = 0;
    if (!S.next(0, cur)) return;
    f32x4 acc[2][2][4][2];
#pragma unroll
    for (int a = 0; a < 2; ++a)
#pragma unroll
        for (int b = 0; b < 2; ++b)
#pragma unroll
            for (int m = 0; m < 4; ++m)
#pragma unroll
                for (int n = 0; n < 2; ++n) acc[a][b][m][n] = (f32x4){0.f, 0.f, 0.f, 0.f};
    bf16x8 At[4][2], B0[2][2], B1[2][2];
    const char* cA = (const char*)g.A + (size_t)cur.pm * tstep; const char* cB = (const char*)g.Bt + (size_t)cur.pn * tstep;
    S.a_ready(cur);
    if constexpr (SP2) {
        PG8_STAGE(PG8_SB(0, 0), cB, voffB); PG8_STAGE(PG8_SB(0, 1), cB + hstep, voffB); PG8_STAGE(PG8_SA(0, 0), cA, voffA); PG8_STAGE(PG8_SA(0, 1), cA + hstep, voffA);
        if (wr == 1) PG8_BAR;
        PG8_WAIT_V(2); PG8_BAR;
        PG8_STAGE(PG8_SB(1, 0), cB + kstep, voffB); PG8_STAGE(PG8_SA(1, 0), cA + kstep, voffA); PG8_STAGE(PG8_SB(1, 1), cB + hstep + kstep, voffB);
        PG8_WAIT_V(6); PG8_BAR;
    } else {
        PG8_STAGE(PG8_SB(0, 0), cB, voffB); PG8_STAGE(PG8_SA(0, 0), cA, voffA); PG8_STAGE(PG8_SB(0, 1), cB + hstep, voffB); PG8_STAGE(PG8_SA(0, 1), cA + hstep, voffA);
        if (wr == 1) PG8_BAR;
        PG8_WAIT_V(4); PG8_BAR;
        PG8_STAGE(PG8_SB(1, 0), cB + kstep, voffB); PG8_STAGE(PG8_SA(1, 0), cA + kstep, voffA); PG8_STAGE(PG8_SB(1, 1), cB + hstep + kstep, voffB);
        PG8_WAIT_V(6); PG8_BAR;
    }
    for (;;) {
        const bool has_next = S.next(ui + 1, nxt);
        const char* nA = has_next ? (const char*)g.A + (size_t)nxt.pm * tstep : cA; const char* nB = has_next ? (const char*)g.Bt + (size_t)nxt.pn * tstep : cB;
        for (int t = 0; t < nt; t += 2) {
            const bool last = (t == nt - 2);
            const char* a1 = cA + (size_t)(t + 1) * kstep;
            const char* a2 = last ? nA : cA + (size_t)(t + 2) * kstep; const char* b2 = last ? nB : cB + (size_t)(t + 2) * kstep;
            const char* a3 = a2 + kstep; const char* b3 = b2 + kstep;
            if (last && has_next) S.a_ready(nxt);
            if constexpr (SP2) {
            PG8_LDB(B0, 0, 0); PG8_LDB(B1, 0, 1); PG8_SCHED; PG8_LDA(At, 0, 0); PG8_STAGE(PG8_SA(1, 1), a1 + hstep, voffA);
            PG8_WAIT_V(8); PG8_WAIT_L(0); PG8_BAR; PG8_MMA(0, 0, At, B0); PG8_MMA(0, 1, At, B1); PG8_BAR; PG8_SCHED;
            PG8_LDA(At, 0, 1); PG8_STAGE(PG8_SB(0, 0), b2, voffB); PG8_STAGE(PG8_SB(0, 1), b2 + hstep, voffB); PG8_STAGE(PG8_SA(0, 0), a2, voffA);
            PG8_WAIT_V(8); PG8_WAIT_L(0); PG8_BAR; PG8_MMA(1, 0, At, B0); PG8_MMA(1, 1, At, B1); PG8_BAR; PG8_SCHED;
            PG8_LDB(B0, 1, 0); PG8_LDB(B1, 1, 1); PG8_SCHED; PG8_LDA(At, 1, 0); PG8_STAGE(PG8_SA(0, 1), a2 + hstep, voffA);
            PG8_WAIT_V(8); PG8_WAIT_L(0); PG8_BAR; PG8_MMA(0, 0, At, B0); PG8_MMA(0, 1, At, B1); PG8_BAR; PG8_SCHED;
            PG8_LDA(At, 1, 1); PG8_STAGE(PG8_SB(1, 0), b3, voffB); PG8_STAGE(PG8_SB(1, 1), b3 + hstep, voffB); PG8_STAGE(PG8_SA(1, 0), a3, voffA);
            PG8_WAIT_V(8); PG8_WAIT_L(0); PG8_BAR; PG8_MMA(1, 0, At, B0); PG8_MMA(1, 1, At, B1); PG8_BAR; PG8_SCHED;
            } else {
            PG8_LDB(B0, 0, 0); PG8_SCHED; PG8_LDA(At, 0, 0); PG8_STAGE(PG8_SA(1, 1), a1 + hstep, voffA);
            PG8_WAIT_L(8); PG8_BAR; PG8_WAIT_L(0); PG8_MMA(0, 0, At, B0); PG8_BAR; PG8_SCHED;
            PG8_LDB(B1, 0, 1); PG8_STAGE(PG8_SB(0, 0), b2, voffB);
            PG8_BAR; PG8_WAIT_L(0); PG8_MMA(0, 1, At, B1); PG8_BAR;
            PG8_LDA(At, 0, 1); PG8_STAGE(PG8_SA(0, 0), a2, voffA);
            PG8_BAR; PG8_WAIT_L(0); PG8_MMA(1, 0, At, B0); PG8_BAR; PG8_SCHED;
            PG8_STAGE(PG8_SB(0, 1), b2 + hstep, voffB);
            PG8_WAIT_V(6); PG8_BAR; PG8_MMA(1, 1, At, B1); PG8_BAR;
            PG8_LDB(B0, 1, 0); PG8_SCHED; PG8_LDA(At, 1, 0); PG8_STAGE(PG8_SA(0, 1), a2 + hstep, voffA);
            PG8_WAIT_L(8); PG8_BAR; PG8_WAIT_L(0); PG8_MMA(0, 0, At, B0); PG8_BAR; PG8_SCHED;
            PG8_LDB(B1, 1, 1); PG8_STAGE(PG8_SB(1, 0), b3, voffB);
            PG8_BAR; PG8_WAIT_L(0); PG8_MMA(0, 1, At, B1); PG8_BAR;
            PG8_LDA(At, 1, 1); PG8_STAGE(PG8_SA(1, 0), a3, voffA);
            PG8_BAR; PG8_WAIT_L(0); PG8_MMA(1, 0, At, B0); PG8_BAR; PG8_SCHED;
            PG8_STAGE(PG8_SB(1, 1), b3 + hstep, voffB);
            PG8_WAIT_V(6); PG8_BAR; PG8_MMA(1, 1, At, B1); PG8_BAR;
            }
        }
        if constexpr (ALIGN_EPI) { if (wr == 0) PG8_BAR; }
        if constexpr (!Epi::AFTER_DRAIN) { E(acc, cur, wr, wc, fr, fq); S.done(cur); }
        if (!has_next) break;
#pragma unroll
        for (int a = 0; a < 2; ++a)
#pragma unroll
            for (int b = 0; b < 2; ++b)
#pragma unroll
                for (int m = 0; m < 4; ++m)
#pragma unroll
                    for (int n = 0; n < 2; ++n) acc[a][b][m][n] = (f32x4){0.f, 0.f, 0.f, 0.f};
        cur = nxt; cA = nA; cB = nB; ++ui;
        if constexpr (ALIGN_EPI) { if (wr == 1) PG8_BAR; }
    }
    PG8_WAIT_V(0);
    if constexpr (!ALIGN_EPI) { if (wr == 0) PG8_BAR; }
    PG8_BAR;
    if constexpr (Epi::AFTER_DRAIN) { E.fused(acc, cur, wr, wc, fr, fq, lds, wid, lane); S.done(cur); }
#undef PG8_SA
#undef PG8_SB
#undef PG8_STAGE
#undef PG8_LDA
#undef PG8_LDB
#undef PG8_MMA
#undef PG8_WAIT_V
#undef PG8_WAIT_L
#undef PG8_BAR
#undef PG8_SCHED
}
}

#define DI __device__ __forceinline__
#define LAS __attribute__((address_space(3)))
typedef unsigned short bf16;
typedef __bf16 bf16x2_t __attribute__((ext_vector_type(2)));
typedef float f32x2_t __attribute__((ext_vector_type(2)));
typedef float f32x4 __attribute__((ext_vector_type(4)));
typedef float f32x16 __attribute__((ext_vector_type(16)));
typedef short bf16x8 __attribute__((ext_vector_type(8)));
typedef short s16x4 __attribute__((ext_vector_type(4)));
typedef unsigned u32x4 __attribute__((ext_vector_type(4)));
typedef unsigned u32x2 __attribute__((ext_vector_type(2)));

constexpr int NT = 512, NWAVES = 8;
constexpr int LDS_BYTES = 147456;
constexpr int T_TOK = 32768, DM = 1024, SEQ = 2048, NB = 16;
constexpr float EPS = 1e-6f;
constexpr size_t MiB = 1u << 20;
constexpr size_t WS_MODS = 1 * MiB, WS_KVMODS = WS_MODS + (size_t)2 * 16 * 6144 * 4;
constexpr size_t WS_GATES = 2 * MiB, WS_BLAST = 4 * MiB, WS_MLOC = 4 * MiB + 65536, WS_MPREV = 4 * MiB + 131072, WS_NLOC = 5 * MiB;
constexpr size_t WS_WG = 6 * MiB, WS_SUBK = 7 * MiB;
constexpr size_t WS_WIN = 8 * MiB, WS_WOUT = 14 * MiB, WS_WKV = 16 * MiB, WS_WSQ = 20 * MiB, WS_WSO = 22 * MiB, WS_WPQ = 24 * MiB;
constexpr size_t WS_IDX = 36 * MiB, WS_GATE = 44 * MiB;
constexpr size_t WS_U = 64 * MiB, WS_V = 128 * MiB, WS_H = 192 * MiB, WS_HB = 256 * MiB, WS_PROJ = 320 * MiB, WS_END = 512 * MiB;
constexpr size_t WS_CST = WS_HB;
constexpr size_t WS_Q = WS_PROJ, WS_K = WS_PROJ + 64 * MiB, WS_VV = WS_PROJ + 128 * MiB, WS_PQ = WS_PROJ;

struct Args { const float* in[23]; float* out; unsigned char* ws; int ph_lo, ph_hi; };
struct Frame {
    LAS unsigned char* lds;
    const float* in[23]; float* out; unsigned char* ws;
    int tid, lane, wave, bid, G;
};

DI unsigned cvtpk(float lo, float hi) { f32x2_t v = {lo, hi}; bf16x2_t b = __builtin_convertvector(v, bf16x2_t); return __builtin_bit_cast(unsigned, b); }
DI float bflo(unsigned u) { return __uint_as_float(u << 16); }
DI float bfhi(unsigned u) { return __uint_as_float(u & 0xffff0000u); }
DI float wave_sum(float v) {
#pragma unroll
    for (int o = 1; o < 64; o <<= 1) v += __shfl_xor(v, o);
    return v;
}
DI float wave_max(float v) {
#pragma unroll
    for (int o = 1; o < 64; o <<= 1) v = fmaxf(v, __shfl_xor(v, o));
    return v;
}
DI int crow(int r, int hi) { return (r & 3) + 8 * (r >> 2) + 4 * hi; }
#define MFMA32(a, b, c) __builtin_amdgcn_mfma_f32_32x32x16_bf16((a), (b), (c), 0, 0, 0)
typedef short v4i16_t __attribute__((ext_vector_type(4)));
DI s16x4 tr16(const LAS unsigned char* p) { return __builtin_bit_cast(s16x4, __builtin_amdgcn_ds_read_tr16_b64_v4i16((LAS v4i16_t*)p)); }
DI int tr_off(int tok, int ch) { return (ch >> 2) * 4096 + (tok >> 4) * 1024 + (tok & 15) * 64 + (ch & 3) * 16; }
DI bf16x8 tr_frag(const LAS unsigned char* img, int dh, int ks, int lane) {
    const int hi = lane >> 5; const int vb = ((lane >> 4) & 1) * 32 + (lane & 3) * 8 + (4 * hi + ((lane & 15) >> 2)) * 64;
    const s16x4 lo = tr16(img + vb + dh * 4096 + ks * 1024), h2 = tr16(img + vb + dh * 4096 + ks * 1024 + 512);
    return __builtin_shufflevector(lo, h2, 0, 1, 2, 3, 4, 5, 6, 7);
}
template <int NTOK> DI bf16x8 row_frag(const LAS unsigned char* img, int tt, int ks, int lane) {
    const int hi = lane >> 5, r32 = lane & 31;
    return *(const LAS bf16x8*)(img + (2 * ks + hi) * (NTOK * 16) + (32 * tt + r32) * 16);
}
DI bf16x8 pack8(const f32x16& x, int s) {
    u32x4 p; p.x = cvtpk(x[8 * s], x[8 * s + 1]); p.y = cvtpk(x[8 * s + 2], x[8 * s + 3]); p.z = cvtpk(x[8 * s + 4], x[8 * s + 5]); p.w = cvtpk(x[8 * s + 6], x[8 * s + 7]);
    return __builtin_bit_cast(bf16x8, p);
}

DI void p0_ada(Frame& F) {
    LAS float* sil = (LAS float*)F.lds;
    LAS float* red = (LAS float*)(F.lds + 65536);
    const float* c = F.in[1];
    for (int i = F.tid; i < 16 * 1024; i += NT) { const int b = i >> 10, d = i & 1023; const float v = c[i]; sil[d * 16 + b] = v / (1.f + expf(-v)); }
    __syncthreads();
    for (int item = F.bid; item < 224; item += F.G) {
        const float* W; const float* bias; float* out; int N, col0;
        if (item < 192) { const int layer = item / 96, it = item % 96; W = F.in[2] + (size_t)layer * 1024 * 6144; bias = F.in[3] + layer * 6144; N = 6144; col0 = it * 64; out = (float*)(F.ws + WS_MODS) + (size_t)layer * 16 * 6144; }
        else { const int it = item - 192; W = F.in[11]; bias = F.in[12]; N = 2048; col0 = it * 64; out = (float*)(F.ws + WS_KVMODS); }
        float acc[16];
#pragma unroll
        for (int b = 0; b < 16; ++b) acc[b] = 0.f;
        const int d0 = F.wave * 128;
        const float* wp = W + (size_t)d0 * N + col0 + F.lane;
#pragma unroll 4
        for (int d = 0; d < 128; ++d) {
            const float w = wp[(size_t)d * N];
            const LAS f32x4* s4 = (const LAS f32x4*)(sil + (d0 + d) * 16);
            const f32x4 s0 = s4[0], s1 = s4[1], s2 = s4[2], s3 = s4[3];
            acc[0] += w * s0[0]; acc[1] += w * s0[1]; acc[2] += w * s0[2]; acc[3] += w * s0[3];
            acc[4] += w * s1[0]; acc[5] += w * s1[1]; acc[6] += w * s1[2]; acc[7] += w * s1[3];
            acc[8] += w * s2[0]; acc[9] += w * s2[1]; acc[10] += w * s2[2]; acc[11] += w * s2[3];
            acc[12] += w * s3[0]; acc[13] += w * s3[1]; acc[14] += w * s3[2]; acc[15] += w * s3[3];
        }
#pragma unroll
        for (int b = 0; b < 16; ++b) red[(F.wave * 16 + b) * 64 + F.lane] = acc[b];
        __syncthreads();
        for (int i = F.tid; i < 1024; i += NT) { const int b = i >> 6, l = i & 63; float s = 0.f;
#pragma unroll
            for (int w = 0; w < 8; ++w) s += red[(w * 16 + b) * 64 + l];
            out[(size_t)b * N + col0 + l] = s + bias[col0 + l]; }
        __syncthreads();
    }
}
DI void transpose_item(const float* W, int ldw, bf16* WT, int dst_row0, LAS float* scr, int k0, int n0, int lane) {
#pragma unroll 8
    for (int i = 0; i < 32; ++i) { const int kk = 2 * i + (lane >> 5); scr[kk * 33 + (lane & 31)] = W[(size_t)(k0 + kk) * ldw + n0 + (lane & 31)]; }
    asm volatile("s_waitcnt lgkmcnt(0)" ::: "memory");
    const int c = lane & 7;
#pragma unroll
    for (int j = 0; j < 4; ++j) { const int n = (lane >> 3) + 8 * j; const LAS float* s = scr + (8 * c) * 33 + n;
        u32x4 o; o.x = cvtpk(s[0 * 33], s[1 * 33]); o.y = cvtpk(s[2 * 33], s[3 * 33]); o.z = cvtpk(s[4 * 33], s[5 * 33]); o.w = cvtpk(s[6 * 33], s[7 * 33]);
        *(u32x4*)(WT + (size_t)(dst_row0 + n) * 1024 + k0 + 8 * c) = o; }
    asm volatile("s_waitcnt lgkmcnt(0)" ::: "memory");
}
DI int permrow(int c) { return (c & ~255) + 32 * (4 * ((c >> 5) & 1) + ((c >> 6) & 3)) + (c & 31); }
DI void p0_prologue(Frame& F) {
    p0_ada(F);
    LAS float* scr = (LAS float*)(F.lds + F.wave * 16384);
    const int gw = F.bid * NWAVES + F.wave, NGW = F.G * NWAVES;
    for (int it = gw; it < 6144; it += NGW) {
        int r = it; const float* W; int ldw, ncols; bf16* dst; bool perm;
        if (r < 1536) { W = F.in[6]; ldw = 3088; ncols = 3072; dst = (bf16*)(F.ws + WS_WIN); perm = false; }
        else if ((r -= 1536) < 512) { W = F.in[10]; ldw = 1024; ncols = 1024; dst = (bf16*)(F.ws + WS_WOUT); perm = false; }
        else if ((r -= 512) < 1024) { W = F.in[14]; ldw = 2048; ncols = 2048; dst = (bf16*)(F.ws + WS_WKV); perm = true; }
        else if ((r -= 1024) < 512) { W = F.in[16]; ldw = 1024; ncols = 1024; dst = (bf16*)(F.ws + WS_WSQ); perm = true; }
        else if ((r -= 512) < 512) { W = F.in[18]; ldw = 1024; ncols = 1024; dst = (bf16*)(F.ws + WS_WSO); perm = false; }
        else if ((r -= 512) < 1024) { W = F.in[19]; ldw = 2048; ncols = 2048; dst = (bf16*)(F.ws + WS_WPQ); perm = false; }
        else { r -= 1024; W = F.in[19] + (size_t)1024 * 2048; ldw = 2048; ncols = 2048; dst = (bf16*)(F.ws + WS_WPQ) + (size_t)2048 * 1024; perm = false; }
        const int nblk = ncols / 32, kb = r / nblk, nb = r % nblk, n0 = 32 * nb;
        transpose_item(W, ldw, dst, perm ? permrow(n0) : n0, scr, 64 * kb, n0, F.lane);
    }
    const size_t gt = (size_t)F.bid * NT + F.tid, NGT = (size_t)F.G * NT;
    constexpr size_t TBL8 = (size_t)2 * 16384 * 1024 / 8;
    for (size_t i = gt; i < 2 * TBL8; i += NGT) {
        const bool isv = i >= TBL8; const size_t j = isv ? i - TBL8 : i;
        const f32x4* src = (const f32x4*)(isv ? F.in[22] : F.in[21]) + 2 * j;
        const f32x4 a = src[0], b = src[1];
        u32x4 o; o.x = cvtpk(a[0], a[1]); o.y = cvtpk(a[2], a[3]); o.z = cvtpk(b[0], b[1]); o.w = cvtpk(b[2], b[3]);
        ((u32x4*)(F.ws + (isv ? WS_V : WS_U)))[j] = o;
    }
    for (size_t i = gt; i < 65536 / 2; i += NGT) { const float a = F.in[20][2 * i], b = F.in[20][2 * i + 1]; ((unsigned*)(F.ws + WS_SUBK))[i] = cvtpk(a, b); }
    for (size_t i = gt; i < 16 * 1024; i += NGT) { const int g = (int)(i >> 10), k = (int)(i & 1023); ((float*)(F.ws + WS_WG))[i] = F.in[6][(size_t)k * 3088 + 3072 + g]; }
}

template <bool GATES> DI void norm_phase(Frame& F, const float* xin, const float* g, const float* shp, const float* scp, int bstride, bf16* hout) {
    const int gw = F.bid * NWAVES + F.wave, NGW = F.G * NWAVES;
    LAS float* wg = (LAS float*)F.lds;
    if (GATES) { const float* src = (const float*)(F.ws + WS_WG); for (int i = F.tid; i < 16 * 1024 / 4; i += NT) ((LAS f32x4*)wg)[i] = ((const f32x4*)src)[i]; __syncthreads(); }
    for (int chunk = gw; chunk < T_TOK / 16; chunk += NGW) {
        const int row0 = chunk * 16, b = row0 >> 11;
        f32x4 A[4], Bv[4];
#pragma unroll
        for (int j = 0; j < 4; ++j) { const int c = 4 * F.lane + 256 * j; const f32x4 gg = *(const f32x4*)(g + c), sc = *(const f32x4*)(scp + (size_t)b * bstride + c);
            A[j] = gg * (sc + 1.0f); Bv[j] = *(const f32x4*)(shp + (size_t)b * bstride + c); }
        for (int r = 0; r < 16; ++r) {
            const int row = row0 + r;
            const f32x4* xr = (const f32x4*)(xin + (size_t)row * DM) + F.lane;
            f32x4 v[4]; float ss = 0.f;
#pragma unroll
            for (int j = 0; j < 4; ++j) { v[j] = xr[64 * j]; ss += (v[j][0] * v[j][0] + v[j][1] * v[j][1]) + (v[j][2] * v[j][2] + v[j][3] * v[j][3]); }
            const float rstd = 1.0f / sqrtf(wave_sum(ss) * (1.0f / DM) + EPS);
            unsigned long long* o8 = (unsigned long long*)(hout + (size_t)row * DM) + F.lane;
#pragma unroll
            for (int j = 0; j < 4; ++j) { v[j] = v[j] * rstd * A[j] + Bv[j]; o8[64 * j] = (unsigned long long)cvtpk(v[j][0], v[j][1]) | ((unsigned long long)cvtpk(v[j][2], v[j][3]) << 32); }
            if (GATES) {
                float p[16];
#pragma unroll
                for (int q = 0; q < 16; ++q) { float s = 0.f;
#pragma unroll
                    for (int j = 0; j < 4; ++j) { const f32x4 w = *(const LAS f32x4*)(wg + q * 1024 + 4 * F.lane + 256 * j); s += (v[j][0] * w[0] + v[j][1] * w[1]) + (v[j][2] * w[2] + v[j][3] * w[3]); }
                    p[q] = s; if ((q & 3) == 3) { asm volatile("" ::: "memory"); __builtin_amdgcn_sched_barrier(0); } }
#pragma unroll
                for (int i = 0; i < 8; ++i) { const bool up = (F.lane & 32) != 0; const float send = up ? p[i] : p[i + 8], keep = up ? p[i + 8] : p[i]; p[i] = keep + __shfl_xor(send, 32); }
#pragma unroll
                for (int i = 0; i < 4; ++i) { const bool up = (F.lane & 16) != 0; const float send = up ? p[i] : p[i + 4], keep = up ? p[i + 4] : p[i]; p[i] = keep + __shfl_xor(send, 16); }
#pragma unroll
                for (int i = 0; i < 2; ++i) { const bool up = (F.lane & 8) != 0; const float send = up ? p[i] : p[i + 2], keep = up ? p[i + 2] : p[i]; p[i] = keep + __shfl_xor(send, 8); }
                { const bool up = (F.lane & 4) != 0; const float send = up ? p[0] : p[1], keep = up ? p[1] : p[0]; p[0] = keep + __shfl_xor(send, 4); }
                p[0] += __shfl_xor(p[0], 2); p[0] += __shfl_xor(p[0], 1);
                const int gi = ((F.lane >> 5) & 1) * 8 + ((F.lane >> 4) & 1) * 4 + ((F.lane >> 3) & 1) * 2 + ((F.lane >> 2) & 1);
                if ((F.lane & 3) == 0) ((float*)(F.ws + WS_GATES))[(size_t)row * 16 + gi] = p[0];
            }
        }
    }
}

DI void mlstm_gates(Frame& F, size_t trow0, int h, float& ipre, float& bcum, float& blast) {
    const float* gates = (const float*)(F.ws + WS_GATES); const float* bif = F.in[8];
    const float iv = gates[(trow0 + F.lane) * 16 + h] + bif[h];
    const float fv = gates[(trow0 + F.lane) * 16 + 8 + h] + bif[8 + h];
    float b = -(fmaxf(-fv, 0.f) + log1pf(expf(-fabsf(fv))));
#pragma unroll
    for (int d = 1; d < 64; d <<= 1) { const float t = __shfl_up(b, d); if (F.lane >= d) b += t; }
    ipre = iv; bcum = b; blast = __shfl(b, 63);
}
template <int MODE> DI void stage_qk(LAS unsigned char* dst, const LAS float* e_s, const bf16* proj, const float* convw, int tseq0, size_t trow0, int col0, int lane) {
    const int g8 = lane >> 3, ch = lane & 7, col = col0 + 8 * ch;
    float cw[4][8];
#pragma unroll
    for (int tap = 0; tap < 4; ++tap) { const f32x4 a = *(const f32x4*)(convw + tap * 1024 + col), b = *(const f32x4*)(convw + tap * 1024 + col + 4);
        cw[tap][0] = a[0]; cw[tap][1] = a[1]; cw[tap][2] = a[2]; cw[tap][3] = a[3]; cw[tap][4] = b[0]; cw[tap][5] = b[1]; cw[tap][6] = b[2]; cw[tap][7] = b[3]; }
#pragma unroll 1
    for (int ph = 0; ph < 2; ++ph) {
        float x[7][8];
#pragma unroll
        for (int i = 0; i < 7; ++i) {
            const int rel = 8 * g8 + 4 * ph + i - 3; const bool valid = (tseq0 + rel) >= 0; const long rr = valid ? (long)rel : 0;
            u32x4 raw = *(const u32x4*)(proj + (size_t)((long)trow0 + rr) * 3072 + col);
            if (!valid) raw = (u32x4){0u, 0u, 0u, 0u};
            x[i][0] = bflo(raw.x); x[i][1] = bfhi(raw.x); x[i][2] = bflo(raw.y); x[i][3] = bfhi(raw.y); x[i][4] = bflo(raw.z); x[i][5] = bfhi(raw.z); x[i][6] = bflo(raw.w); x[i][7] = bfhi(raw.w);
        }
#pragma unroll
        for (int o = 0; o < 4; ++o) {
            const int tok = 8 * g8 + 4 * ph + o;
            float y[8];
#pragma unroll
            for (int e = 0; e < 8; ++e) { float a = cw[0][e] * x[o][e] + cw[1][e] * x[o + 1][e] + cw[2][e] * x[o + 2][e] + cw[3][e] * x[o + 3][e]; y[e] = a / (1.f + __expf(-a)); }
            float sc = 1.f; if (MODE == 0) sc = e_s[tok]; if (MODE == 1) sc = 0.125f;
            u32x4 w; w.x = cvtpk(y[0] * sc, y[1] * sc); w.y = cvtpk(y[2] * sc, y[3] * sc); w.z = cvtpk(y[4] * sc, y[5] * sc); w.w = cvtpk(y[6] * sc, y[7] * sc);
            const int off = (MODE == 0) ? tr_off(tok, ch) : ch * 1024 + tok * 16;
            *(LAS u32x4*)(dst + off) = w;
        }
    }
}
DI void stage_v_half(LAS unsigned char* dst, const bf16* proj, size_t trow0, int col0, int lane) {
    const int g8 = lane >> 3, ch = lane & 7;
#pragma unroll
    for (int o = 0; o < 8; ++o) { const int tok = 8 * g8 + o; const u32x4 raw = *(const u32x4*)(proj + (trow0 + tok) * 3072 + col0 + 8 * ch); *(LAS u32x4*)(dst + tr_off(tok, ch)) = raw; }
}
constexpr int MW_LDS = 17408;

DI void p3_mlstm_local(Frame& F) {
    LAS unsigned char* wl = F.lds + F.wave * MW_LDS;
    LAS unsigned char* kimg = wl; LAS unsigned char* vimg = wl + 8192; LAS float* e_s = (LAS float*)(wl + 16384);
    const bf16* proj = (const bf16*)(F.ws + WS_PROJ);
    bf16* cst = (bf16*)(F.ws + WS_CST);
    const int lane = F.lane, r32 = lane & 31, hi = lane >> 5;
    for (int bu = F.bid; bu < 512; bu += F.G) {
        int h = F.wave; asm volatile("" : "+s"(h));
        const int b = bu >> 5, c = bu & 31; const int unit = bu * 8 + h; const size_t trow0 = (size_t)b * SEQ + c * 64;
        float ipre, bcum, blast; mlstm_gates(F, trow0, h, ipre, bcum, blast);
        const float w = blast - bcum + ipre; const float mloc = wave_max(w); const float e = expf(w - mloc);
        e_s[lane] = e;
        if (lane == 0) { ((float*)(F.ws + WS_BLAST))[unit] = blast; ((float*)(F.ws + WS_MLOC))[unit] = mloc; }
        stage_qk<0>(kimg, e_s, proj, F.in[7], c * 64, trow0, 512 + h * 64, lane);
        bf16x8 kef[2][4];
#pragma unroll
        for (int kt = 0; kt < 2; ++kt)
#pragma unroll
            for (int ks = 0; ks < 4; ++ks) kef[kt][ks] = tr_frag(kimg, kt, ks, lane);
        const bf16x8 ones = {0x3F80, 0x3F80, 0x3F80, 0x3F80, 0x3F80, 0x3F80, 0x3F80, 0x3F80};
#pragma unroll
        for (int kt = 0; kt < 2; ++kt) { f32x16 an = {};
#pragma unroll
            for (int ks = 0; ks < 4; ++ks) an = MFMA32(kef[kt][ks], ones, an);
            if (r32 == 0) {
#pragma unroll
                for (int r = 0; r < 16; ++r) ((float*)(F.ws + WS_NLOC))[(size_t)unit * 64 + 32 * kt + crow(r, hi)] = an[r]; } }
#pragma unroll 1
        for (int vh = 0; vh < 2; ++vh) {
            stage_v_half(vimg, proj, trow0, 1024 + h * 128 + 64 * vh, lane);
#pragma unroll
            for (int vt = 0; vt < 2; ++vt) {
                bf16x8 vf[4];
#pragma unroll
                for (int ks = 0; ks < 4; ++ks) vf[ks] = tr_frag(vimg, vt, ks, lane);
#pragma unroll
                for (int kt = 0; kt < 2; ++kt) { f32x16 acc = {};
#pragma unroll
                    for (int ks = 0; ks < 4; ++ks) acc = MFMA32(kef[kt][ks], vf[ks], acc);
                    bf16* dstp = cst + ((size_t)unit * 128 + 64 * vh + 32 * vt + r32) * 64 + 32 * kt + 4 * hi;
#pragma unroll
                    for (int rg = 0; rg < 4; ++rg) { u32x2 pk; pk.x = cvtpk(acc[4 * rg], acc[4 * rg + 1]); pk.y = cvtpk(acc[4 * rg + 2], acc[4 * rg + 3]); *(u32x2*)(dstp + 8 * rg) = pk; }
                }
            }
        }
    }
}
DI void p4_scan(Frame& F) {
    const int gt = F.bid * NT + F.tid, NGT = F.G * NT;
    const float* mlocp = (const float*)(F.ws + WS_MLOC); const float* blastp = (const float*)(F.ws + WS_BLAST);
    for (int item = gt; item < 128 * 1024; item += NGT) {
        const int bh = item >> 10, e8 = item & 1023, b = bh >> 3, h = bh & 7;
        float st[8]; float m = 0.f;
#pragma unroll
        for (int i = 0; i < 8; ++i) st[i] = 0.f;
#pragma unroll 4
        for (int c = 0; c < 32; ++c) {
            const int unit = (b * 32 + c) * 8 + h;
            u32x4* p = (u32x4*)((bf16*)(F.ws + WS_CST) + (size_t)unit * 8192) + e8;
            const u32x4 raw = *p; const float ml = mlocp[unit], bl = blastp[unit];
            u32x4 o; o.x = cvtpk(st[0], st[1]); o.y = cvtpk(st[2], st[3]); o.z = cvtpk(st[4], st[5]); o.w = cvtpk(st[6], st[7]); *p = o;
            const float mn = fmaxf(bl + m, ml), a = expf(bl + m - mn), r = expf(ml - mn);
            st[0] = a * st[0] + r * bflo(raw.x); st[1] = a * st[1] + r * bfhi(raw.x); st[2] = a * st[2] + r * bflo(raw.y); st[3] = a * st[3] + r * bfhi(raw.y);
            st[4] = a * st[4] + r * bflo(raw.z); st[5] = a * st[5] + r * bfhi(raw.z); st[6] = a * st[6] + r * bflo(raw.w); st[7] = a * st[7] + r * bfhi(raw.w);
            m = mn;
        }
    }
    for (int item = gt; item < 128 * 64; item += NGT) {
        const int bh = item >> 6, k = item & 63, b = bh >> 3, h = bh & 7;
        float ns = 0.f, m = 0.f;
        for (int c = 0; c < 32; ++c) {
            const int unit = (b * 32 + c) * 8 + h;
            float* np = (float*)(F.ws + WS_NLOC) + (size_t)unit * 64 + k;
            const float nl = *np, ml = mlocp[unit], bl = blastp[unit];
            *np = ns; if (k == 0) ((float*)(F.ws + WS_MPREV))[unit] = m;
            const float mn = fmaxf(bl + m, ml), a = expf(bl + m - mn), r = expf(ml - mn);
            ns = a * ns + r * nl; m = mn;
        }
    }
}
DI void p5_mlstm_out(Frame& F) {
    LAS unsigned char* wl = F.lds + F.wave * MW_LDS;
    LAS unsigned char* qimg = wl; LAS unsigned char* kimg = wl + 8192; LAS float* sc = (LAS float*)(wl + 16384);
    const bf16* proj = (const bf16*)(F.ws + WS_PROJ);
    const bf16* cst = (const bf16*)(F.ws + WS_CST);
    bf16* hh = (bf16*)(F.ws + WS_H);
    for (int bu = F.bid; bu < 512; bu += F.G) {
        int lane = F.lane; asm volatile("" : "+v"(lane)); const int r32 = lane & 31, hi = lane >> 5;
        int h = F.wave; asm volatile("" : "+s"(h));
        const int b = bu >> 5, c = bu & 31; const int unit = bu * 8 + h; const size_t trow0 = (size_t)b * SEQ + c * 64;
        {
            float ipre, bcum, blast; mlstm_gates(F, trow0, h, ipre, bcum, blast);
            const float mprev = ((const float*)(F.ws + WS_MPREV))[unit];
            const float gg = ipre - bcum; float pm = gg;
#pragma unroll
            for (int d = 1; d < 64; d <<= 1) { const float t = __shfl_up(pm, d); if (lane >= d) pm = fmaxf(pm, t); }
            const float Mx = fmaxf(mprev, pm), mt = bcum + Mx;
            sc[lane] = gg; sc[64 + lane] = Mx; sc[128 + lane] = expf(mprev - Mx); sc[192 + lane] = expf(-mt);
        }
#pragma unroll 1
        for (int lt = 0; lt < 2; ++lt) {
            stage_qk<1>(qimg, nullptr, proj, F.in[7], c * 64, trow0, h * 64, lane); asm volatile("" ::: "memory"); __builtin_amdgcn_sched_barrier(0);
            stage_qk<2>(kimg, nullptr, proj, F.in[7], c * 64, trow0, 512 + h * 64, lane);
            bf16x8 qf[4];
#pragma unroll
            for (int ks = 0; ks < 4; ++ks) qf[ks] = row_frag<64>(qimg, lt, ks, lane);
            const int l = 32 * lt + r32;
            const float Mxl = sc[64 + l];
            bf16x8 P[2][2]; float dsum = 0.f;
#pragma unroll
            for (int st = 0; st < 2; ++st) {
                P[st][0] = (bf16x8){0, 0, 0, 0, 0, 0, 0, 0}; P[st][1] = P[st][0];
                if (st <= lt) {
                    f32x16 acc = {};
#pragma unroll
                    for (int ks = 0; ks < 4; ++ks) acc = MFMA32(row_frag<64>(kimg, st, ks, lane), qf[ks], acc);
#pragma unroll
                    for (int r = 0; r < 16; ++r) { const int srow = crow(r, hi); float val = acc[r] * __expf(sc[32 * st + srow] - Mxl); if (st == lt && srow > r32) val = 0.f; acc[r] = val; dsum += val; }
                    P[st][0] = pack8(acc, 0); P[st][1] = pack8(acc, 1);
                }
            }
            float nq;
            { const float* np = (const float*)(F.ws + WS_NLOC) + (size_t)unit * 64; float s = 0.f;
#pragma unroll
              for (int ks = 0; ks < 4; ++ks) { const f32x4 n0 = *(const f32x4*)(np + 16 * ks + 8 * hi), n1 = *(const f32x4*)(np + 16 * ks + 8 * hi + 4); const u32x4 q = __builtin_bit_cast(u32x4, qf[ks]);
                  s += bflo(q.x) * n0[0] + bfhi(q.x) * n0[1] + bflo(q.y) * n0[2] + bfhi(q.y) * n0[3] + bflo(q.z) * n1[0] + bfhi(q.z) * n1[1] + bflo(q.w) * n1[2] + bfhi(q.w) * n1[3]; }
              nq = s + __shfl_xor(s, 32); }
            asm volatile("s_waitcnt lgkmcnt(0)" ::: "memory");
            stage_v_half(wl, proj, trow0, 1024 + h * 128, lane); asm volatile("" ::: "memory"); __builtin_amdgcn_sched_barrier(0);
            stage_v_half(wl + 8192, proj, trow0, 1024 + h * 128 + 64, lane); asm volatile("" ::: "memory"); __builtin_amdgcn_sched_barrier(0);
            f32x16 acc[4];
#pragma unroll
            for (int vt = 0; vt < 4; ++vt) { acc[vt] = (f32x16){};
#pragma unroll
                for (int ks = 0; ks < 4; ++ks) { const bf16x8 cf = *(const bf16x8*)(cst + ((size_t)unit * 128 + 32 * vt + r32) * 64 + 16 * ks + 8 * hi); acc[vt] = MFMA32(cf, qf[ks], acc[vt]); }
                asm volatile("" ::: "memory"); __builtin_amdgcn_sched_barrier(0); }
            const float iwl = sc[128 + l];
#pragma unroll
            for (int vt = 0; vt < 4; ++vt) acc[vt] = acc[vt] * iwl;
#pragma unroll
            for (int st = 0; st < 2; ++st) if (st <= lt) {
#pragma unroll
                for (int k2 = 0; k2 < 2; ++k2) {
#pragma unroll
                    for (int vt = 0; vt < 4; ++vt) acc[vt] = MFMA32(tr_frag(wl + (vt >> 1) * 8192, vt & 1, 2 * st + k2, lane), P[st][k2], acc[vt]);
                    asm volatile("" ::: "memory"); __builtin_amdgcn_sched_barrier(0); } }
            const float den = dsum + __shfl_xor(dsum, 32) + iwl * nq;
            const float inv = 1.0f / fmaxf(fabsf(den), sc[192 + l]);
            float ss = 0.f;
#pragma unroll
            for (int vt = 0; vt < 4; ++vt)
#pragma unroll
                for (int r = 0; r < 16; ++r) { const float v = acc[vt][r] * inv; acc[vt][r] = v; ss += v * v; }
            ss += __shfl_xor(ss, 32);
            const float rstd = 1.0f / sqrtf(ss * (1.0f / 128.0f) + EPS);
            const size_t t = trow0 + l;
#pragma unroll
            for (int vt = 0; vt < 4; ++vt)
#pragma unroll
                for (int rg = 0; rg < 4; ++rg) { const int v = 32 * vt + 8 * rg + 4 * hi;
                    const u32x2 o4 = *(const u32x2*)(proj + t * 3072 + 2048 + h * 128 + v); const f32x4 g4 = *(const f32x4*)(F.in[9] + h * 128 + v);
                    const float o0 = bflo(o4.x), o1 = bfhi(o4.x), o2 = bflo(o4.y), o3 = bfhi(o4.y);
                    const float y0 = acc[vt][4 * rg] * rstd * g4[0] / (1.f + __expf(-o0)), y1 = acc[vt][4 * rg + 1] * rstd * g4[1] / (1.f + __expf(-o1));
                    const float y2 = acc[vt][4 * rg + 2] * rstd * g4[2] / (1.f + __expf(-o2)), y3 = acc[vt][4 * rg + 3] * rstd * g4[3] / (1.f + __expf(-o3));
                    u32x2 pk; pk.x = cvtpk(y0, y1); pk.y = cvtpk(y2, y3); *(u32x2*)(hh + t * 1024 + h * 128 + v) = pk;
                    if ((rg & 1) == 1) { asm volatile("" ::: "memory"); __builtin_amdgcn_sched_barrier(0); } }
            asm volatile("s_waitcnt lgkmcnt(0)" ::: "memory");
        }
    }
}

DI float softplus_f(float z) { return fmaxf(z, 0.f) + __logf(1.f + __expf(-fabsf(z))); }
DI void p12_attn(Frame& F) {
    LAS unsigned char* kimg = F.lds; LAS unsigned char* vimg = F.lds + 8192;
    const bf16* Q = (const bf16*)(F.ws + WS_Q); const bf16* K = (const bf16*)(F.ws + WS_K); const bf16* V = (const bf16*)(F.ws + WS_VV);
    bf16* O = (bf16*)(F.ws + WS_H);
    const int lane = F.lane, r32 = lane & 31, hi = lane >> 5, wave = F.wave;
    const int skey = F.tid >> 3, schk = F.tid & 7;
    for (int bh = F.bid; bh < 256; bh += F.G) {
        const int b = bh >> 4, h = bh & 15;
        for (int qb = 7; qb >= 0; --qb) {
            const int qlo = qb * 256 + 32 * wave;
            const size_t tq0 = (size_t)b * SEQ + qlo;
            bf16x8 qr[4];
#pragma unroll
            for (int ks = 0; ks < 4; ++ks) qr[ks] = *(const bf16x8*)(Q + (tq0 + r32) * 1024 + h * 64 + 16 * ks + 8 * hi);
            f32x16 o0 = {}, o1 = {}; float R = 0.f;
            const int ntile = 4 * qb + 4;
            u32x4 kraw, vraw;
            { const size_t src = ((size_t)b * SEQ + 64 * (ntile - 1) + skey) * 1024 + h * 64 + 8 * schk; kraw = *(const u32x4*)(K + src); vraw = *(const u32x4*)(V + src); }
            for (int kt = ntile - 1; kt >= 0; --kt) {
                __syncthreads();
                *(LAS u32x4*)(kimg + schk * 1024 + skey * 16) = kraw;
                *(LAS u32x4*)(vimg + tr_off(skey, schk)) = vraw;
                if (kt > 0) { const size_t src = ((size_t)b * SEQ + 64 * (kt - 1) + skey) * 1024 + h * 64 + 8 * schk; kraw = *(const u32x4*)(K + src); vraw = *(const u32x4*)(V + src); }
                __syncthreads();
                if (64 * kt <= qlo + 30) {
                    f32x16 p0 = {}, p1 = {};
#pragma unroll
                    for (int ks = 0; ks < 4; ++ks) { p0 = MFMA32(row_frag<64>(kimg, 0, ks, lane), qr[ks], p0); p1 = MFMA32(row_frag<64>(kimg, 1, ks, lane), qr[ks], p1); }
                    const bool diag = (64 * kt + 63 >= qlo);
                    const int qrel = qlo + r32 - 64 * kt;
                    float s0[16], s1[16];
#pragma unroll
                    for (int r = 0; r < 16; ++r) { const int kr = crow(r, hi);
                        const bool v0 = !diag || kr < qrel, v1 = !diag || (kr + 32) < qrel;
                        s0[r] = v0 ? softplus_f(p0[r]) : 0.f; s1[r] = v1 ? softplus_f(p1[r]) : 0.f; }
#pragma unroll
                    for (int g = 0; g < 4; ++g) { s0[4 * g + 2] += s0[4 * g + 3]; s0[4 * g + 1] += s0[4 * g + 2]; s0[4 * g] += s0[4 * g + 1];
                                                  s1[4 * g + 2] += s1[4 * g + 3]; s1[4 * g + 1] += s1[4 * g + 2]; s1[4 * g] += s1[4 * g + 1]; }
                    float off0[4], off1[4]; float tot0, tot1;
                    { float og[4], T[4];
#pragma unroll
                      for (int g = 0; g < 4; ++g) og[g] = __shfl_xor(s1[4 * g], 32);
                      T[3] = 0.f; T[2] = s1[12] + og[3]; T[1] = T[2] + s1[8] + og[2]; T[0] = T[1] + s1[4] + og[1]; tot1 = T[0] + s1[0] + og[0];
#pragma unroll
                      for (int g = 0; g < 4; ++g) off1[g] = T[g] + (hi == 0 ? og[g] : 0.f) + R; }
                    { float og[4], T[4];
#pragma unroll
                      for (int g = 0; g < 4; ++g) og[g] = __shfl_xor(s0[4 * g], 32);
                      T[3] = 0.f; T[2] = s0[12] + og[3]; T[1] = T[2] + s0[8] + og[2]; T[0] = T[1] + s0[4] + og[1]; tot0 = T[0] + s0[0] + og[0];
#pragma unroll
                      for (int g = 0; g < 4; ++g) off0[g] = T[g] + (hi == 0 ? og[g] : 0.f) + R + tot1; }
#pragma unroll
                    for (int r = 0; r < 16; ++r) { const int kr = crow(r, hi);
                        const bool v0 = !diag || kr < qrel, v1 = !diag || (kr + 32) < qrel;
                        const float a0 = __expf(p0[r] - s0[r] - off0[r >> 2]), a1 = __expf(p1[r] - s1[r] - off1[r >> 2]);
                        p0[r] = v0 ? a0 : 0.f; p1[r] = v1 ? a1 : 0.f; }
                    R += tot0 + tot1;
                    const bf16x8 pa0 = pack8(p0, 0), pa1 = pack8(p0, 1), pa2 = pack8(p1, 0), pa3 = pack8(p1, 1);
                    o0 = MFMA32(pa0, tr_frag(vimg, 0, 0, lane), o0); o1 = MFMA32(pa0, tr_frag(vimg, 1, 0, lane), o1);
                    o0 = MFMA32(pa1, tr_frag(vimg, 0, 1, lane), o0); o1 = MFMA32(pa1, tr_frag(vimg, 1, 1, lane), o1);
                    o0 = MFMA32(pa2, tr_frag(vimg, 0, 2, lane), o0); o1 = MFMA32(pa2, tr_frag(vimg, 1, 2, lane), o1);
                    o0 = MFMA32(pa3, tr_frag(vimg, 0, 3, lane), o0); o1 = MFMA32(pa3, tr_frag(vimg, 1, 3, lane), o1);
                }
            }
#pragma unroll
            for (int r = 0; r < 16; ++r) { bf16* op = O + (tq0 + crow(r, hi)) * 1024 + h * 64 + r32;
                op[0] = (bf16)(cvtpk(o0[r], 0.f) & 0xffffu); op[32] = (bf16)(cvtpk(o1[r], 0.f) & 0xffffu); }
        }
    }
}

__device__ constexpr int NET16_A[63] = {0,2,0,1,1,4,6,4,5,5,0,2,2,1,3,3,1,3,5,8,10,8,9,9,12,14,12,13,13,8,10,10,9,11,11,9,11,13,0,4,4,2,6,6,2,6,10,1,5,5,3,7,7,3,7,11,1,3,5,7,9,11,13};
__device__ constexpr int NET16_B[63] = {1,3,2,3,2,5,7,6,7,6,4,6,4,5,7,5,2,4,6,9,11,10,11,10,13,15,14,15,14,12,14,12,13,15,13,10,12,14,8,12,8,10,14,10,4,8,12,9,13,9,11,15,11,5,9,13,2,4,6,8,10,12,14};
__device__ constexpr int BIT16_A[32] = {0,1,2,3,4,5,6,7,0,1,2,3,8,9,10,11,0,1,4,5,8,9,12,13,0,2,4,6,8,10,12,14};
__device__ constexpr int BIT16_B[32] = {8,9,10,11,12,13,14,15,4,5,6,7,12,13,14,15,2,3,6,7,10,11,14,15,1,3,5,7,9,11,13,15};
DI unsigned umax_(unsigned a, unsigned b) { return a > b ? a : b; }
DI unsigned umin_(unsigned a, unsigned b) { return a < b ? a : b; }
DI void sort16(unsigned (&k)[16]) {
#pragma unroll
    for (int c = 0; c < 63; ++c) { const unsigned a = k[NET16_A[c]], b = k[NET16_B[c]]; k[NET16_A[c]] = umax_(a, b); k[NET16_B[c]] = umin_(a, b); }
}
DI void bitonic16(unsigned (&k)[16]) {
#pragma unroll
    for (int c = 0; c < 32; ++c) { const unsigned a = k[BIT16_A[c]], b = k[BIT16_B[c]]; k[BIT16_A[c]] = umax_(a, b); k[BIT16_B[c]] = umin_(a, b); }
}
DI void merge16(unsigned (&x)[16], const unsigned (&y)[16]) {
#pragma unroll
    for (int i = 0; i < 16; ++i) x[i] = umax_(x[i], y[15 - i]);
    bitonic16(x);
}
DI unsigned f2key(float x) { const unsigned b = __float_as_uint(x); return b ^ ((unsigned)((int)b >> 31) | 0x80000000u); }
DI float key2f(unsigned k) { return __uint_as_float(k ^ (~(unsigned)((int)k >> 31) | 0x80000000u)); }

DI void p_route(Frame& F, int layer) {
    LAS unsigned char* simg = F.lds;
    LAS unsigned char* dec = F.lds + 65536 + F.wave * 1024;
    { const u32x4* src = (const u32x4*)((const bf16*)(F.ws + WS_SUBK) + (size_t)layer * 2 * 128 * 128);
      for (int i = F.tid; i < 2 * 128 * 16; i += NT) { const int p = i >> 11, n = (i >> 4) & 127, ch = i & 15; *(LAS u32x4*)(simg + p * 32768 + ch * 2048 + n * 16) = src[i]; } }
    __syncthreads();
    const bf16* PQ = (const bf16*)(F.ws + WS_PQ);
    const int lane = F.lane, r32 = lane & 31, hi = lane >> 5;
    const int gw = F.bid * NWAVES + F.wave, NGW = F.G * NWAVES;
    for (int wu = gw; wu < T_TOK * 8 / 32; wu += NGW) {
        const int row = wu * 32 + r32, t = row >> 3, hd = row & 7;
        unsigned top[2][16];
#pragma unroll
        for (int p = 0; p < 2; ++p) {
            bf16x8 qf[8];
#pragma unroll
            for (int ks = 0; ks < 8; ++ks) qf[ks] = *(const bf16x8*)(PQ + (size_t)t * 2048 + hd * 256 + p * 128 + 16 * ks + 8 * hi);
            unsigned keys[4][16];
#pragma unroll
            for (int nt = 0; nt < 4; ++nt) {
                f32x16 acc = {};
#pragma unroll
                for (int ks = 0; ks < 8; ++ks) acc = MFMA32(*(const LAS bf16x8*)(simg + p * 32768 + (2 * ks + hi) * 2048 + (32 * nt + r32) * 16), qf[ks], acc);
#pragma unroll
                for (int r = 0; r < 16; ++r) keys[nt][r] = (f2key(acc[r]) & 0xFFFFFF80u) | (unsigned)(32 * nt + crow(r, 0)) | (unsigned)(4 * hi);
                sort16(keys[nt]);
            }
            merge16(keys[0], keys[1]); merge16(keys[2], keys[3]); merge16(keys[0], keys[2]);
            unsigned lo[16], up[16];
#pragma unroll
            for (int i = 0; i < 16; ++i) { auto rr = __builtin_amdgcn_permlane32_swap(keys[0][i], keys[0][i], false, false); lo[i] = rr[0]; up[i] = rr[1]; }
#pragma unroll
            for (int i = 0; i < 16; ++i) top[p][i] = umax_(lo[i], up[15 - i]);
            bitonic16(top[p]);
        }
        if (hi == 0) {
            u32x4 w0, w1, w2, w3;
            w0.x = (top[0][0] & 127u) | ((top[0][1] & 127u) << 8) | ((top[0][2] & 127u) << 16) | ((top[0][3] & 127u) << 24);
            w0.y = (top[0][4] & 127u) | ((top[0][5] & 127u) << 8) | ((top[0][6] & 127u) << 16) | ((top[0][7] & 127u) << 24);
            w0.z = (top[0][8] & 127u) | ((top[0][9] & 127u) << 8) | ((top[0][10] & 127u) << 16) | ((top[0][11] & 127u) << 24);
            w0.w = (top[0][12] & 127u) | ((top[0][13] & 127u) << 8) | ((top[0][14] & 127u) << 16) | ((top[0][15] & 127u) << 24);
            w1.x = (top[1][0] & 127u) | ((top[1][1] & 127u) << 8) | ((top[1][2] & 127u) << 16) | ((top[1][3] & 127u) << 24);
            w1.y = (top[1][4] & 127u) | ((top[1][5] & 127u) << 8) | ((top[1][6] & 127u) << 16) | ((top[1][7] & 127u) << 24);
            w1.z = (top[1][8] & 127u) | ((top[1][9] & 127u) << 8) | ((top[1][10] & 127u) << 16) | ((top[1][11] & 127u) << 24);
            w1.w = (top[1][12] & 127u) | ((top[1][13] & 127u) << 8) | ((top[1][14] & 127u) << 16) | ((top[1][15] & 127u) << 24);
            *(LAS u32x4*)(dec + r32 * 32) = w0; *(LAS u32x4*)(dec + r32 * 32 + 16) = w1;
        }
        float av[16], bv[16];
#pragma unroll
        for (int i = 0; i < 16; ++i) { av[i] = key2f(top[0][i] & 0xFFFFFF80u); bv[i] = key2f(top[1][i] & 0xFFFFFF80u); }
        unsigned c0[16], c1[16], c2[16], c3[16];
#pragma unroll
        for (int j = 0; j < 16; ++j) c0[j] = (f2key(av[0] + bv[j]) & 0xFFFFFF00u) | (unsigned)j;
        {
            int n = 0;
#pragma unroll
            for (int i = 1; i < 16; ++i)
#pragma unroll
                for (int j = 0; j < 16; ++j) if ((i + 1) * (j + 1) <= 16) {
                    const unsigned k = (f2key(av[i] + bv[j]) & 0xFFFFFF00u) | (unsigned)(i * 16 + j);
                    if (n < 16) c1[n] = k; else if (n < 32) c2[n - 16] = k; else c3[n - 32] = k;
                    ++n; }
#pragma unroll
            for (int q = 2; q < 16; ++q) c3[q] = 0u;
        }
        sort16(c1); sort16(c2); { const unsigned a = c3[0], b = c3[1]; c3[0] = umax_(a, b); c3[1] = umin_(a, b); }
        merge16(c0, c1); merge16(c2, c3); merge16(c0, c2);
        asm volatile("s_waitcnt lgkmcnt(0)" ::: "memory");
        float gv[16]; unsigned ex[16]; float gs = 0.f;
        const float vmax = key2f(c0[0] & 0xFFFFFF00u);
#pragma unroll
        for (int k = 0; k < 16; ++k) {
            const unsigned code = c0[k] & 255u; const unsigned i = code >> 4, j = code & 15u;
            const unsigned ia = *(const LAS unsigned char*)(dec + r32 * 32 + i), ib = *(const LAS unsigned char*)(dec + r32 * 32 + 16 + j);
            ex[k] = ia * 128u + ib;
            gv[k] = __expf(key2f(c0[k] & 0xFFFFFF00u) - vmax); gs += gv[k];
        }
        const float ginv = 1.0f / gs;
        if (hi == 0) {
            u32x4 e0, e1;
            e0.x = ex[0] | (ex[1] << 16); e0.y = ex[2] | (ex[3] << 16); e0.z = ex[4] | (ex[5] << 16); e0.w = ex[6] | (ex[7] << 16);
            e1.x = ex[8] | (ex[9] << 16); e1.y = ex[10] | (ex[11] << 16); e1.z = ex[12] | (ex[13] << 16); e1.w = ex[14] | (ex[15] << 16);
            u32x4* ip = (u32x4*)((unsigned short*)(F.ws + WS_IDX) + (size_t)row * 16); ip[0] = e0; ip[1] = e1;
        } else {
            f32x4* gp = (f32x4*)((float*)(F.ws + WS_GATE) + (size_t)row * 16);
            gp[0] = (f32x4){gv[0] * ginv, gv[1] * ginv, gv[2] * ginv, gv[3] * ginv}; gp[1] = (f32x4){gv[4] * ginv, gv[5] * ginv, gv[6] * ginv, gv[7] * ginv};
            gp[2] = (f32x4){gv[8] * ginv, gv[9] * ginv, gv[10] * ginv, gv[11] * ginv}; gp[3] = (f32x4){gv[12] * ginv, gv[13] * ginv, gv[14] * ginv, gv[15] * ginv};
        }
    }
}

typedef __bf16 bf16x2v __attribute__((ext_vector_type(2)));
DI float dot2(unsigned a, unsigned b, float c) { return __builtin_amdgcn_fdot2_f32_bf16(__builtin_bit_cast(bf16x2v, a), __builtin_bit_cast(bf16x2v, b), c, false); }
struct RowBuf { u32x4 a[8], b[8]; };
DI void load_rows(RowBuf& rb, const bf16* tbl, int idxs, int k0, int lane) {
#pragma unroll
    for (int j = 0; j < 8; ++j) { const int e = __builtin_amdgcn_readlane(idxs, k0 + j); const u32x4* p = (const u32x4*)(tbl + (size_t)e * 1024) + lane; rb.a[j] = p[0]; rb.b[j] = p[64]; }
}
DI float udots(const RowBuf& rb, const unsigned (&hq)[8], int lane) {
    float p[8];
#pragma unroll
    for (int j = 0; j < 8; ++j) { float s0 = 0.f, s1 = 0.f;
        s0 = dot2(rb.a[j].x, hq[0], s0); s1 = dot2(rb.a[j].y, hq[1], s1); s0 = dot2(rb.a[j].z, hq[2], s0); s1 = dot2(rb.a[j].w, hq[3], s1);
        s0 = dot2(rb.b[j].x, hq[4], s0); s1 = dot2(rb.b[j].y, hq[5], s1); s0 = dot2(rb.b[j].z, hq[6], s0); s1 = dot2(rb.b[j].w, hq[7], s1);
        p[j] = s0 + s1; }
#pragma unroll
    for (int i = 0; i < 4; ++i) { const bool up = (lane & 4) != 0; const float send = up ? p[i] : p[i + 4], keep = up ? p[i + 4] : p[i]; p[i] = keep + __shfl_xor(send, 4); }
#pragma unroll
    for (int i = 0; i < 2; ++i) { const bool up = (lane & 2) != 0; const float send = up ? p[i] : p[i + 2], keep = up ? p[i + 2] : p[i]; p[i] = keep + __shfl_xor(send, 2); }
    { const bool up = (lane & 1) != 0; const float send = up ? p[0] : p[1], keep = up ? p[1] : p[0]; p[0] = keep + __shfl_xor(send, 1); }
    float s = p[0]; s += __shfl_xor(s, 8); s += __shfl_xor(s, 16); s += __shfl_xor(s, 32);
    return s;
}
DI void vaccum(const RowBuf& rb, float (&out)[16], unsigned wvb, int k0) {
#pragma unroll
    for (int j = 0; j < 8; ++j) { const unsigned wl = (unsigned)__builtin_amdgcn_readlane((int)wvb, k0 + j); const unsigned wh = wl << 16;
        out[0] = dot2(rb.a[j].x, wl, out[0]); out[1] = dot2(rb.a[j].x, wh, out[1]); out[2] = dot2(rb.a[j].y, wl, out[2]); out[3] = dot2(rb.a[j].y, wh, out[3]);
        out[4] = dot2(rb.a[j].z, wl, out[4]); out[5] = dot2(rb.a[j].z, wh, out[5]); out[6] = dot2(rb.a[j].w, wl, out[6]); out[7] = dot2(rb.a[j].w, wh, out[7]);
        out[8] = dot2(rb.b[j].x, wl, out[8]); out[9] = dot2(rb.b[j].x, wh, out[9]); out[10] = dot2(rb.b[j].y, wl, out[10]); out[11] = dot2(rb.b[j].y, wh, out[11]);
        out[12] = dot2(rb.b[j].z, wl, out[12]); out[13] = dot2(rb.b[j].z, wh, out[13]); out[14] = dot2(rb.b[j].w, wl, out[14]); out[15] = dot2(rb.b[j].w, wh, out[15]); }
}
template <bool LAST> DI void p_apply(Frame& F, int layer) {
    const bf16* U = (const bf16*)(F.ws + WS_U) + (size_t)layer * 16384 * 1024;
    const bf16* V = (const bf16*)(F.ws + WS_V) + (size_t)layer * 16384 * 1024;
    const bf16* H2 = (const bf16*)(F.ws + WS_H);
    const unsigned short* IDX = (const unsigned short*)(F.ws + WS_IDX); const float* GATE = (const float*)(F.ws + WS_GATE);
    const float* mods = (const float*)(F.ws + WS_MODS);
    const int lane = F.lane;
    const int gw = F.bid * NWAVES + F.wave, NGW = F.G * NWAVES;
    for (int chunk = gw; chunk < T_TOK / 16; chunk += NGW) {
        const int t0 = chunk * 16, b = t0 >> 11;
#pragma unroll 1
        for (int tt = 0; tt < 16; ++tt) {
            const size_t t = (size_t)t0 + tt;
            unsigned hq[8];
            { const u32x4* hp = (const u32x4*)(H2 + t * 1024) + lane; const u32x4 a = hp[0], c = hp[64]; hq[0] = a.x; hq[1] = a.y; hq[2] = a.z; hq[3] = a.w; hq[4] = c.x; hq[5] = c.y; hq[6] = c.z; hq[7] = c.w; }
            const int i0 = IDX[t * 128 + lane], i1 = IDX[t * 128 + 64 + lane];
            const float g0 = GATE[t * 128 + lane], g1 = GATE[t * 128 + 64 + lane];
            float out[16];
#pragma unroll
            for (int i = 0; i < 16; ++i) out[i] = 0.f;
#pragma unroll 1
            for (int half = 0; half < 2; ++half) {
                const int idxs = half ? i1 : i0; const float gts = half ? g1 : g0;
                float coll = 0.f;
                RowBuf A, B;
                load_rows(A, U, idxs, 0, lane);
#pragma unroll
                for (int bb = 0; bb < 8; bb += 2) {
                    load_rows(B, U, idxs, 8 * (bb + 1), lane);
                    { const float s = udots(A, hq, lane); coll = ((lane >> 3) == bb) ? s : coll; }
                    if (bb + 2 < 8) load_rows(A, U, idxs, 8 * (bb + 2), lane); else load_rows(A, V, idxs, 0, lane);
                    { const float s = udots(B, hq, lane); coll = ((lane >> 3) == bb + 1) ? s : coll; }
                }
                const unsigned wv = cvtpk(gts * 0.5f * coll * (1.0f + erff(coll * 0.70710678118654752f)), 0.f);
#pragma unroll
                for (int bb = 0; bb < 8; bb += 2) {
                    load_rows(B, V, idxs, 8 * (bb + 1), lane);
                    vaccum(A, out, wv, 8 * bb);
                    if (bb + 2 < 8) load_rows(A, V, idxs, 8 * (bb + 2), lane);
                    vaccum(B, out, wv, 8 * (bb + 1));
                }
            }
            float* xr = F.out + t * 1024;
            const float* g2 = mods + ((size_t)layer * 16 + b) * 6144 + 5 * 1024;
            f32x4 x[4];
            x[0] = *(const f32x4*)(xr + 8 * lane); x[1] = *(const f32x4*)(xr + 8 * lane + 4); x[2] = *(const f32x4*)(xr + 512 + 8 * lane); x[3] = *(const f32x4*)(xr + 512 + 8 * lane + 4);
#pragma unroll
            for (int q = 0; q < 4; ++q) { const int c = (q >> 1) * 512 + 8 * lane + 4 * (q & 1); const f32x4 gg = *(const f32x4*)(g2 + c);
                x[q] = x[q] + gg * (f32x4){out[4 * q], out[4 * q + 1], out[4 * q + 2], out[4 * q + 3]}; *(f32x4*)(xr + c) = x[q]; }
            if (!LAST) {
                float ss = 0.f;
#pragma unroll
                for (int q = 0; q < 4; ++q) ss += (x[q][0] * x[q][0] + x[q][1] * x[q][1]) + (x[q][2] * x[q][2] + x[q][3] * x[q][3]);
                const float rstd = 1.0f / sqrtf(wave_sum(ss) * (1.0f / DM) + EPS);
                const float* m1 = mods + ((size_t)16 + b) * 6144;
                const float* kvm = (const float*)(F.ws + WS_KVMODS) + (size_t)b * 2048;
                unsigned ha[8], hb[8];
#pragma unroll
                for (int q = 0; q < 4; ++q) { const int c = (q >> 1) * 512 + 8 * lane + 4 * (q & 1);
                    const f32x4 gm = *(const f32x4*)(F.in[4] + 1024 + c), s1 = *(const f32x4*)(m1 + 1024 + c), h1 = *(const f32x4*)(m1 + c);
                    const f32x4 gk = *(const f32x4*)(F.in[13] + c), sk = *(const f32x4*)(kvm + 1024 + c), hk = *(const f32x4*)(kvm + c);
                    const f32x4 xn = x[q] * rstd;
                    const f32x4 ya = xn * gm * (s1 + 1.0f) + h1, yb = xn * gk * (sk + 1.0f) + hk;
                    ha[2 * q] = cvtpk(ya[0], ya[1]); ha[2 * q + 1] = cvtpk(ya[2], ya[3]); hb[2 * q] = cvtpk(yb[0], yb[1]); hb[2 * q + 1] = cvtpk(yb[2], yb[3]); }
                u32x4* pa = (u32x4*)((bf16*)(F.ws + WS_H) + t * 1024) + lane; u32x4* pb = (u32x4*)((bf16*)(F.ws + WS_HB) + t * 1024) + lane;
                pa[0] = (u32x4){ha[0], ha[1], ha[2], ha[3]}; pa[64] = (u32x4){ha[4], ha[5], ha[6], ha[7]};
                pb[0] = (u32x4){hb[0], hb[1], hb[2], hb[3]}; pb[64] = (u32x4){hb[4], hb[5], hb[6], hb[7]};
            }
        }
    }
}
#ifndef PH_MASK
#define PH_MASK 0x3FFFF
#endif

#ifndef N_LAUNCH_MODE
#define N_LAUNCH_MODE 1
#endif
constexpr int NPH = 18;
template <class Epi> DI void run_gemm(Frame& F, const bf16* A, const bf16* Bt, int N, const Epi& E) {
    pg8::Gemm g{A, Bt, T_TOK, N, DM}; pg8::StaticOrder S; S.init(T_TOK, N, F.G, F.bid);
    pg8::gemm_phase<Epi, pg8::StaticOrder, true, true>(F.lds, g, S, E);
}
__global__ void __launch_bounds__(NT, 2) fwd(Args args) {
    extern __shared__ __attribute__((aligned(16))) unsigned char lds_raw[];
    cg::grid_group grid = cg::this_grid();
    Frame F;
    F.lds = (LAS unsigned char*)lds_raw;
#pragma unroll
    for (int i = 0; i < 23; ++i) F.in[i] = args.in[i];
    F.out = args.out; F.ws = args.ws;
    F.tid = threadIdx.x; F.lane = F.tid & 63; F.wave = __builtin_amdgcn_readfirstlane(F.tid >> 6); F.bid = blockIdx.x; F.G = gridDim.x;
    const int lo = args.ph_lo, hi = args.ph_hi;
#define IN(k) (lo <= (k) && (k) < hi)
#define SEAM(k) do { if (IN(k) && IN((k) + 1)) grid.sync(); } while (0)
    float* mods = (float*)(F.ws + WS_MODS);
    bf16* Hb = (bf16*)(F.ws + WS_H);
    if (((PH_MASK >> 0) & 1) && IN(0)) { p0_prologue(F); } SEAM(0);
    if (((PH_MASK >> 1) & 1) && IN(1)) { norm_phase<true>(F, F.in[0], F.in[4], mods, mods + 1024, 6144, Hb); } SEAM(1);
    if (((PH_MASK >> 2) & 1) && IN(2)) { pg8::EpiBf16<0> E{(bf16*)(F.ws + WS_PROJ), 3072, nullptr, 0, 0, 1.f}; run_gemm(F, Hb, (const bf16*)(F.ws + WS_WIN), 3072, E); } SEAM(2);
    if (((PH_MASK >> 3) & 1) && IN(3)) { p3_mlstm_local(F); } SEAM(3);
    if (((PH_MASK >> 4) & 1) && IN(4)) { p4_scan(F); } SEAM(4);
    if (((PH_MASK >> 5) & 1) && IN(5)) { p5_mlstm_out(F); } SEAM(5);
    if (((PH_MASK >> 6) & 1) && IN(6)) { pg8::EpiResid E{F.in[0], F.out, mods + 2 * 1024, 6144}; run_gemm(F, Hb, (const bf16*)(F.ws + WS_WOUT), 1024, E); } SEAM(6);
    if (((PH_MASK >> 7) & 1) && IN(7)) { norm_phase<false>(F, F.out, F.in[5], mods + 3 * 1024, mods + 4 * 1024, 6144, Hb); } SEAM(7);
    if (((PH_MASK >> 8) & 1) && IN(8)) { pg8::EpiBf16<0> E{(bf16*)(F.ws + WS_PQ), 2048, nullptr, 0, 0, 1.f}; run_gemm(F, Hb, (const bf16*)(F.ws + WS_WPQ), 2048, E); } SEAM(8);
    if (((PH_MASK >> 9) & 1) && IN(9)) { p_route(F, 0); } SEAM(9);
    if (((PH_MASK >> 10) & 1) && IN(10)) { p_apply<false>(F, 0); } SEAM(10);
    if (((PH_MASK >> 11) & 1) && IN(11)) {
        { pg8::EpiHeadNorm E{(bf16*)(F.ws + WS_Q), (bf16*)(F.ws + WS_Q), 4, F.in[17], 0.125f, EPS}; run_gemm(F, Hb, (const bf16*)(F.ws + WS_WSQ), 1024, E); }
        { pg8::EpiHeadNorm E{(bf16*)(F.ws + WS_K), (bf16*)(F.ws + WS_VV), 4, F.in[15], 1.0f, EPS}; run_gemm(F, (const bf16*)(F.ws + WS_HB), (const bf16*)(F.ws + WS_WKV), 2048, E); }
    } SEAM(11);
    if (((PH_MASK >> 12) & 1) && IN(12)) { p12_attn(F); } SEAM(12);
    if (((PH_MASK >> 13) & 1) && IN(13)) { pg8::EpiResid E{F.out, F.out, mods + 16 * 6144 + 2 * 1024, 6144}; run_gemm(F, Hb, (const bf16*)(F.ws + WS_WSO), 1024, E); } SEAM(13);
    if (((PH_MASK >> 14) & 1) && IN(14)) { norm_phase<false>(F, F.out, F.in[5] + 1024, mods + 16 * 6144 + 3 * 1024, mods + 16 * 6144 + 4 * 1024, 6144, Hb); } SEAM(14);
    if (((PH_MASK >> 15) & 1) && IN(15)) { pg8::EpiBf16<0> E{(bf16*)(F.ws + WS_PQ), 2048, nullptr, 0, 0, 1.f}; run_gemm(F, Hb, (const bf16*)(F.ws + WS_WPQ) + (size_t)2048 * 1024, 2048, E); } SEAM(15);
    if (((PH_MASK >> 16) & 1) && IN(16)) { p_route(F, 1); } SEAM(16);
    if (((PH_MASK >> 17) & 1) && IN(17)) { p_apply<true>(F, 1); }
#undef IN
#undef SEAM
}

extern "C" void kernel_launch(void* const* d_in, const int* in_sizes, int n_in, void* d_out, int out_size, void* d_ws, size_t ws_size, hipStream_t stream) {
    static int grid = 0;
    if (grid == 0) {
        int dev = 0, cus = 0, per_cu = 0;
        (void)hipGetDevice(&dev);
        (void)hipDeviceGetAttribute(&cus, hipDeviceAttributeMultiprocessorCount, dev);
        (void)hipFuncSetAttribute((const void*)fwd, hipFuncAttributeMaxDynamicSharedMemorySize, LDS_BYTES);
        (void)hipOccupancyMaxActiveBlocksPerMultiprocessor(&per_cu, (const void*)fwd, NT, LDS_BYTES);
        if (per_cu < 1) { fprintf(stderr, "kernel_launch: occupancy query says %d blocks per CU\n", per_cu); per_cu = 1; }
        grid = cus;
        if (n_in != 23 || ws_size < WS_END) fprintf(stderr, "kernel_launch: unexpected n_in %d / ws_size %zu\n", n_in, ws_size);
        (void)hipGetLastError();
    }
    Args a{};
    for (int i = 0; i < 23; ++i) a.in[i] = (const float*)d_in[i];
    a.out = (float*)d_out; a.ws = (unsigned char*)d_ws;
#if N_LAUNCH_MODE == 1
    a.ph_lo = 0; a.ph_hi = NPH;
    void* kargs[] = {&a};
    hipError_t e = hipLaunchCooperativeKernel((const void*)fwd, dim3(grid), dim3(NT), kargs, LDS_BYTES, stream);
    if (e != hipSuccess) fprintf(stderr, "kernel_launch: cooperative launch failed: %s (grid %d)\n", hipGetErrorString(e), grid);
#else
    for (int p = 0; p < NPH; ++p) { a.ph_lo = p; a.ph_hi = p + 1; hipLaunchKernelGGL(fwd, dim3(grid), dim3(NT), LDS_BYTES, stream, a); }
#endif
}
```

```cpp
#include <hip/hip_runtime.h>
#include <hip/hip_cooperative_groups.h>
#include <cstdio>
#include <cstdint>
namespace cg = cooperative_groups;
#define N_LAUNCH_MODE 1
namespace pg8 {
#define PG8_LAS __attribute__((address_space(3)))
typedef unsigned short bf16_t;
typedef short bf16x8 __attribute__((ext_vector_type(8)));
typedef float f32x4 __attribute__((ext_vector_type(4)));
typedef unsigned u32x4 __attribute__((ext_vector_type(4)));
constexpr int BM = 256, BK = 64, HALF = 128, HTB = HALF * BK * 2  , STAGE_BYTES = 8 * HTB, NXCD = 8, WGM = 8;

__host__ __device__ __forceinline__ int lds_byte(int r, int c) { const int st = (r >> 4) * 2 + (c >> 5), rr = r & 15, cc = c & 31, ob = rr * 64 + cc * 2; return st * 1024 + (ob ^ (((ob >> 9) & 1) << 5)); }
__host__ __device__ __forceinline__ void stage_rc(int b, int& R, int& C) { const int st = b / 1024, sb = b % 1024, swz = sb ^ (((sb >> 9) & 1) << 5); R = (st >> 1) * 16 + swz / 64; C = (st & 1) * 32 + (swz % 64) / 2; }
__host__ __device__ __forceinline__ int perm32(int rho) { const int n = rho >> 4, i = rho & 15; return 8 * (i >> 2) + 4 * n + (i & 3); }

struct Unit { int pm, pn; };
struct Gemm { const bf16_t* A; const bf16_t* Bt; int M, N, K; };

struct StaticOrder {
    int nM, nN, nwg, G, c;
    __host__ __device__ void init(int M, int N, int G_, int c_) { nM = M / BM; nN = N / BM; nwg = nM * nN; G = G_; c = c_; }
    __host__ __device__ bool next(int i, Unit& u) const {
        const long L = (long)i * G + c; if (L >= nwg) return false;
        int wgid = (int)L; { const int q = nwg / NXCD, r = nwg % NXCD, xcd = wgid % NXCD, off = wgid / NXCD; wgid = (xcd < r ? xcd * (q + 1) : r * (q + 1) + (xcd - r) * q) + off; }
        const int nig = WGM * nN, gid = wgid / nig, fm = gid * WGM, gsz = (nM - fm) < WGM ? (nM - fm) : WGM;
        u.pm = fm + ((wgid % nig) % gsz); u.pn = (wgid % nig) / gsz; return true;
    }
    __device__ __forceinline__ void a_ready(const Unit&) const {}
    __device__ __forceinline__ void done(const Unit&) const {}
};

__device__ __forceinline__ unsigned cvt_pk_bf16(float lo, float hi) { unsigned r; asm volatile("v_cvt_pk_bf16_f32 %0, %1, %2" : "=v"(r) : "v"(lo), "v"(hi)); return r; }
typedef float f32x2 __attribute__((ext_vector_type(2)));
__device__ __forceinline__ f32x2 gelu_pk(f32x2 v) {
    const f32x2 av = __builtin_elementwise_abs(v), d = av * 0.2316418882f + 1.0f;
    f32x2 t; t.x = __builtin_amdgcn_rcpf(d.x); t.y = __builtin_amdgcn_rcpf(d.y);
    f32x2 q = t * 0.5307027145f + (-0.7265760135f); q = q * t + 0.7107068705f; q = q * t + (-0.142248368f); q = q * t + 0.127414796f; q = q * t;
    const f32x2 s = (v * v) * (-0.72134752044f);
    f32x2 e; e.x = __builtin_amdgcn_exp2f(s.x); e.y = __builtin_amdgcn_exp2f(s.y);
    const f32x2 m = v * (q * e), r = v - m;
    f32x2 o; o.x = v.x < 0.f ? m.x : r.x; o.y = v.y < 0.f ? m.y : r.y; return o;
}

template <int ACT  > struct EpiBf16 {
    static constexpr bool PERM = true, AFTER_DRAIN = false; static_assert(ACT == 0 || ACT == 1, "EpiBf16: ACT is 0 (none) or 1 (gelu_pk)");
    bf16_t* O; int ldc; const float* bias; int split_cols; size_t split_stride; float scale0;
    __device__ __forceinline__ void operator()(const f32x4 (&acc)[2][2][4][2], const Unit& u, int wr, int wc, int fr, int fq) const {
        const int row0 = u.pm * BM + wr * 64 + fr; int colt = u.pn * BM; bf16_t* base = O;
        float sc = 1.f; if (split_cols) { const int t = colt / split_cols; base += (size_t)t * split_stride; colt -= t * split_cols; if (t == 0) sc = scale0; }
        const int col0 = colt + wc * 32 + 8 * fq, bcol0 = u.pn * BM + wc * 32 + 8 * fq;
        f32x4 bv[2][2];
#pragma unroll
        for (int bj = 0; bj < 2; ++bj)
#pragma unroll
            for (int n = 0; n < 2; ++n) bv[bj][n] = bias ? *(const f32x4*)(bias + bcol0 + bj * HALF + 4 * n) : (f32x4){0.f, 0.f, 0.f, 0.f};
#pragma unroll
        for (int ai = 0; ai < 2; ++ai)
#pragma unroll
            for (int m = 0; m < 4; ++m) { bf16_t* rowp = base + (size_t)(row0 + ai * HALF + m * 16) * ldc + col0;
#pragma unroll
                for (int bj = 0; bj < 2; ++bj) { f32x4 v0 = acc[ai][bj][m][0] + bv[bj][0], v1 = acc[ai][bj][m][1] + bv[bj][1];
                    if (ACT == 1) { f32x2 a = gelu_pk((f32x2){v0[0], v0[1]}), b = gelu_pk((f32x2){v0[2], v0[3]}), c = gelu_pk((f32x2){v1[0], v1[1]}), d = gelu_pk((f32x2){v1[2], v1[3]});
                        v0 = (f32x4){a.x, a.y, b.x, b.y}; v1 = (f32x4){c.x, c.y, d.x, d.y}; }
                    v0 = v0 * sc; v1 = v1 * sc; u32x4 w; w.x = cvt_pk_bf16(v0[0], v0[1]); w.y = cvt_pk_bf16(v0[2], v0[3]); w.z = cvt_pk_bf16(v1[0], v1[1]); w.w = cvt_pk_bf16(v1[2], v1[3]);
                    *(u32x4*)(rowp + bj * HALF) = w; } }
    }
};
struct EpiResid {
    static constexpr bool PERM = false, AFTER_DRAIN = false;
    const float* base; float* out; const float* gate; int gstride;
    __device__ __forceinline__ void operator()(const f32x4 (&acc)[2][2][4][2], const Unit& u, int wr, int wc, int fr, int fq) const {
        const int col0 = u.pn * BM + wc * 32 + 4 * fq;
        const int b = (u.pm * BM) >> 11;
        f32x4 gv[2][2];
#pragma unroll
        for (int bj = 0; bj < 2; ++bj)
#pragma unroll
            for (int n = 0; n < 2; ++n) gv[bj][n] = *(const f32x4*)(gate + (size_t)b * gstride + col0 + bj * HALF + n * 16);
#pragma unroll
        for (int ai = 0; ai < 2; ++ai)
#pragma unroll
            for (int m = 0; m < 4; ++m) { const size_t off = (size_t)(u.pm * BM + ai * HALF + wr * 64 + m * 16 + fr) * 1024 + col0;
#pragma unroll
                for (int bj = 0; bj < 2; ++bj)
#pragma unroll
                    for (int n = 0; n < 2; ++n) { const f32x4 bs = *(const f32x4*)(base + off + bj * HALF + n * 16);
                        *(f32x4*)(out + off + bj * HALF + n * 16) = bs + gv[bj][n] * acc[ai][bj][m][n]; }
                if (m & 1) asm volatile("" ::: "memory"); }
    }
};
struct EpiHeadNorm {
    static constexpr bool PERM = true, AFTER_DRAIN = false;
    bf16_t* O0; bf16_t* O1; int ntile_norm; const float* g; float scale; float eps;
    __device__ __forceinline__ void operator()(const f32x4 (&acc)[2][2][4][2], const Unit& u, int wr, int wc, int fr, int fq) const {
        const bool nrm = u.pn < ntile_norm; bf16_t* O = nrm ? O0 : O1; const int pnl = nrm ? u.pn : u.pn - ntile_norm;
        f32x4 gv[2][2];
#pragma unroll
        for (int bj = 0; bj < 2; ++bj)
#pragma unroll
            for (int n = 0; n < 2; ++n) { const f32x4 t = *(const f32x4*)(g + 32 * bj + 8 * fq + 4 * n); gv[bj][n] = nrm ? t * scale : (f32x4){1.f, 1.f, 1.f, 1.f}; }
#pragma unroll
        for (int ai = 0; ai < 2; ++ai)
#pragma unroll
            for (int m = 0; m < 4; ++m) {
                float ss = 0.f;
#pragma unroll
                for (int bj = 0; bj < 2; ++bj)
#pragma unroll
                    for (int n = 0; n < 2; ++n) { const f32x4 x = acc[ai][bj][m][n]; ss += (x[0] * x[0] + x[1] * x[1]) + (x[2] * x[2] + x[3] * x[3]); }
                ss += __shfl_xor(ss, 16); ss += __shfl_xor(ss, 32);
                const float rs = nrm ? 1.0f / sqrtf(ss * (1.0f / 64.0f) + eps) : 1.0f;
                bf16_t* rowp = O + (size_t)(u.pm * BM + ai * HALF + wr * 64 + m * 16 + fr) * 1024 + pnl * BM + wc * 64 + 8 * fq;
#pragma unroll
                for (int bj = 0; bj < 2; ++bj) { const f32x4 v0 = acc[ai][bj][m][0] * rs * gv[bj][0], v1 = acc[ai][bj][m][1] * rs * gv[bj][1];
                    u32x4 w; w.x = cvt_pk_bf16(v0[0], v0[1]); w.y = cvt_pk_bf16(v0[2], v0[3]); w.z = cvt_pk_bf16(v1[0], v1[1]); w.w = cvt_pk_bf16(v1[2], v1[3]);
                    *(u32x4*)(rowp + bj * 32) = w; }
            }
    }
};
template <class Epi, class Sched, bool ALIGN_EPI = false, bool SP2 = false>
__device__ __forceinline__ void gemm_phase(PG8_LAS unsigned char* lds, const Gemm g, const Sched& S, const Epi& E) {
    const int tid = threadIdx.x, wid = __builtin_amdgcn_readfirstlane(tid >> 6), lane = tid & 63, wr = wid >> 2, wc = wid & 3, fr = lane & 15, fq = lane >> 4;
    const int K = g.K, nt = K / BK;
    unsigned voffA[2], voffB[2];
#pragma unroll
    for (int i = 0; i < 2; ++i) { int R, C; stage_rc(tid * 16 + i * 8192, R, C); const int Rb = Epi::PERM ? ((R & ~31) + perm32(R & 31)) : R;
        voffA[i] = (unsigned)(R * K + C) * 2u; voffB[i] = (unsigned)(Rb * K + C) * 2u; }
    const size_t kstep = (size_t)(BK * 2);
    const size_t hstep = (size_t)HALF * K * 2;
    const size_t tstep = 2 * hstep;
    const unsigned ldsw = (unsigned)wid * 1024u;
    const int aoff = lds_byte(wr * 64 + fr, fq * 8), boff = lds_byte(wc * 32 + fr, fq * 8);
#define PG8_SA(b, h) (((b) * 2 + (h)) * HTB)
#define PG8_SB(b, h) ((4 + (b) * 2 + (h)) * HTB)
#define PG8_STAGE(bufoff, gbase, voff) do { _Pragma("unroll") for (int _i = 0; _i < 2; ++_i) \
        __builtin_amdgcn_global_load_lds((const unsigned*)((const char*)(gbase) + (voff)[_i]), (PG8_LAS unsigned*)(lds + (bufoff) + ldsw + _i * 8192), 16, 0, 0); } while (0)
#define PG8_LDA(dst, b, h) do { _Pragma("unroll") for (int m = 0; m < 4; ++m) _Pragma("unroll") for (int k = 0; k < 2; ++k) dst[m][k] = *(const PG8_LAS bf16x8*)(lds + PG8_SA(b, h) + aoff + m * 2048 + k * 1024); } while (0)
#define PG8_LDB(dst, b, h) do { _Pragma("unroll") for (int n = 0; n < 2; ++n) _Pragma("unroll") for (int k = 0; k < 2; ++k) dst[n][k] = *(const PG8_LAS bf16x8*)(lds + PG8_SB(b, h) + boff + n * 2048 + k * 1024); } while (0)
#define PG8_MMA(ai, bj, At, Bt) do { __builtin_amdgcn_s_setprio(1); _Pragma("unroll") for (int m = 0; m < 4; ++m) _Pragma("unroll") for (int n = 0; n < 2; ++n) _Pragma("unroll") for (int k = 0; k < 2; ++k) \
        acc[ai][bj][m][n] = __builtin_amdgcn_mfma_f32_16x16x32_bf16(Bt[n][k], At[m][k], acc[ai][bj][m][n], 0, 0, 0); __builtin_amdgcn_s_setprio(0); } while (0)
#define PG8_WAIT_V(n) asm volatile("s_waitcnt vmcnt(" #n ")" ::: "memory")
#define PG8_WAIT_L(n) asm volatile("s_waitcnt lgkmcnt(" #n ")" ::: "memory")
#define PG8_BAR __builtin_amdgcn_s_barrier()
#define PG8_SCHED __builtin_amdgcn_sched_barrier(0)
    Unit cur, nxt; int ui = 0;
    if (!S.next(0, cur)) return;
    f32x4 acc[2][2][4][2];
#pragma unroll
    for (int a = 0; a < 2; ++a)
#pragma unroll
        for (int b = 0; b < 2; ++b)
#pragma unroll
            for (int m = 0; m < 4; ++m)
#pragma unroll
                for (int n = 0; n < 2; ++n) acc[a][b][m][n] = (f32x4){0.f, 0.f, 0.f, 0.f};
    bf16x8 At[4][2], B0[2][2], B1[2][2];
    const char* cA = (const char*)g.A + (size_t)cur.pm * tstep; const char* cB = (const char*)g.Bt + (size_t)cur.pn * tstep;
    S.a_ready(cur);
    if constexpr (SP2) {
        PG8_STAGE(PG8_SB(0, 0), cB, voffB); PG8_STAGE(PG8_SB(0, 1), cB + hstep, voffB); PG8_STAGE(PG8_SA(0, 0), cA, voffA); PG8_STAGE(PG8_SA(0, 1), cA + hstep, voffA);
        if (wr == 1) PG8_BAR;
        PG8_WAIT_V(2); PG8_BAR;
        PG8_STAGE(PG8_SB(1, 0), cB + kstep, voffB); PG8_STAGE(PG8_SA(1, 0), cA + kstep, voffA); PG8_STAGE(PG8_SB(1, 1), cB + hstep + kstep, voffB);
        PG8_WAIT_V(6); PG8_BAR;
    } else {
        PG8_STAGE(PG8_SB(0, 0), cB, voffB); PG8_STAGE(PG8_SA(0, 0), cA, voffA); PG8_STAGE(PG8_SB(0, 1), cB + hstep, voffB); PG8_STAGE(PG8_SA(0, 1), cA + hstep, voffA);
        if (wr == 1) PG8_BAR;
        PG8_WAIT_V(4); PG8_BAR;
        PG8_STAGE(PG8_SB(1, 0), cB + kstep, voffB); PG8_STAGE(PG8_SA(1, 0), cA + kstep, voffA); PG8_STAGE(PG8_SB(1, 1), cB + hstep + kstep, voffB);
        PG8_WAIT_V(6); PG8_BAR;
    }
    for (;;) {
        const bool has_next = S.next(ui + 1, nxt);
        const char* nA = has_next ? (const char*)g.A + (size_t)nxt.pm * tstep : cA; const char* nB = has_next ? (const char*)g.Bt + (size_t)nxt.pn * tstep : cB;
        for (int t = 0; t < nt; t += 2) {
            const bool last = (t == nt - 2);
            const char* a1 = cA + (size_t)(t + 1) * kstep;
            const char* a2 = last ? nA : cA + (size_t)(t + 2) * kstep; const char* b2 = last ? nB : cB + (size_t)(t + 2) * kstep;
            const char* a3 = a2 + kstep; const char* b3 = b2 + kstep;
            if (last && has_next) S.a_ready(nxt);
            if constexpr (SP2) {
            PG8_LDB(B0, 0, 0); PG8_LDB(B1, 0, 1); PG8_SCHED; PG8_LDA(At, 0, 0); PG8_STAGE(PG8_SA(1, 1), a1 + hstep, voffA);
            PG8_WAIT_V(8); PG8_WAIT_L(0); PG8_BAR; PG8_MMA(0, 0, At, B0); PG8_MMA(0, 1, At, B1); PG8_BAR; PG8_SCHED;
            PG8_LDA(At, 0, 1); PG8_STAGE(PG8_SB(0, 0), b2, voffB); PG8_STAGE(PG8_SB(0, 1), b2 + hstep, voffB); PG8_STAGE(PG8_SA(0, 0), a2, voffA);
            PG8_WAIT_V(8); PG8_WAIT_L(0); PG8_BAR; PG8_MMA(1, 0, At, B0); PG8_MMA(1, 1, At, B1); PG8_BAR; PG8_SCHED;
            PG8_LDB(B0, 1, 0); PG8_LDB(B1, 1, 1); PG8_SCHED; PG8_LDA(At, 1, 0); PG8_STAGE(PG8_SA(0, 1), a2 + hstep, voffA);
            PG8_WAIT_V(8); PG8_WAIT_L(0); PG8_BAR; PG8_MMA(0, 0, At, B0); PG8_MMA(0, 1, At, B1); PG8_BAR; PG8_SCHED;
            PG8_LDA(At, 1, 1); PG8_STAGE(PG8_SB(1, 0), b3, voffB); PG8_STAGE(PG8_SB(1, 1), b3 + hstep, voffB); PG8_STAGE(PG8_SA(1, 0), a3, voffA);
            PG8_WAIT_V(8); PG8_WAIT_L(0); PG8_BAR; PG8_MMA(1, 0, At, B0); PG8_MMA(1, 1, At, B1); PG8_BAR; PG8_SCHED;
            } else {
            PG8_LDB(B0, 0, 0); PG8_SCHED; PG8_LDA(At, 0, 0); PG8_STAGE(PG8_SA(1, 1), a1 + hstep, voffA);
            PG8_WAIT_L(8); PG8_BAR; PG8_WAIT_L(0); PG8_MMA(0, 0, At, B0); PG8_BAR; PG8_SCHED;
            PG8_LDB(B1, 0, 1); PG8_STAGE(PG8_SB(0, 0), b2, voffB);
            PG8_BAR; PG8_WAIT_L(0); PG8_MMA(0, 1, At, B1); PG8_BAR;
            PG8_LDA(At, 0, 1); PG8_STAGE(PG8_SA(0, 0), a2, voffA);
            PG8_BAR; PG8_WAIT_L(0); PG8_MMA(1, 0, At, B0); PG8_BAR; PG8_SCHED;
            PG8_STAGE(PG8_SB(0, 1), b2 + hstep, voffB);
            PG8_WAIT_V(6); PG8_BAR; PG8_MMA(1, 1, At, B1); PG8_BAR;
            PG8_LDB(B0, 1, 0); PG8_SCHED; PG8_LDA(At, 1, 0); PG8_STAGE(PG8_SA(0, 1), a2 + hstep, voffA);
            PG8_WAIT_L(8); PG8_BAR; PG8_WAIT_L(0); PG8_MMA(0, 0, At, B0); PG8_BAR; PG8_SCHED;
            PG8_LDB(B1, 1, 1); PG8_STAGE(PG8_SB(1, 0), b3, voffB);
            PG8_BAR; PG8_WAIT_L(0); PG8_MMA(0, 1, At, B1); PG8_BAR;
            PG8_LDA(At, 1, 1); PG8_STAGE(PG8_SA(1, 0), a3, voffA);
            PG8_BAR; PG8_WAIT_L(0); PG8_MMA(1, 0, At, B0); PG8_BAR; PG8_SCHED;
            PG8_STAGE(PG8_SB(1, 1), b3 + hstep, voffB);
            PG8_WAIT_V(6); PG8_BAR; PG8_MMA(1, 1, At, B1); PG8_BAR;
            }
        }
        if constexpr (ALIGN_EPI) { if (wr == 0) PG8_BAR; }
        if constexpr (!Epi::AFTER_DRAIN) { E(acc, cur, wr, wc, fr, fq); S.done(cur); }
        if (!has_next) break;
#pragma unroll
        for (int a = 0; a < 2; ++a)
#pragma unroll
            for (int b = 0; b < 2; ++b)
#pragma unroll
                for (int m = 0; m < 4; ++m)
#pragma unroll
                    for (int n = 0; n < 2; ++n) acc[a][b][m][n] = (f32x4){0.f, 0.f, 0.f, 0.f};
        cur = nxt; cA = nA; cB = nB; ++ui;
        if constexpr (ALIGN_EPI) { if (wr == 1) PG8_BAR; }
    }
    PG8_WAIT_V(0);
    if constexpr (!ALIGN_EPI) { if (wr == 0) PG8_BAR; }
    PG8_BAR;
    if constexpr (Epi::AFTER_DRAIN) { E.fused(acc, cur, wr, wc, fr, fq, lds, wid, lane); S.done(cur); }
#undef PG8_SA
#undef PG8_SB
#undef PG8_STAGE
#undef PG8_LDA
#undef PG8_LDB
#undef PG8_MMA
#undef PG8_WAIT_V
#undef PG8_WAIT_L
#undef PG8_BAR
#undef PG8_SCHED
}
}

#define DI __device__ __forceinline__
#define LAS __attribute__((address_space(3)))
typedef unsigned short bf16;
typedef __bf16 bf16x2_t __attribute__((ext_vector_type(2)));
typedef float f32x2_t __attribute__((ext_vector_type(2)));
typedef float f32x4 __attribute__((ext_vector_type(4)));
typedef float f32x16 __attribute__((ext_vector_type(16)));
typedef short bf16x8 __attribute__((ext_vector_type(8)));
typedef short s16x4 __attribute__((ext_vector_type(4)));
typedef unsigned u32x4 __attribute__((ext_vector_type(4)));
typedef unsigned u32x2 __attribute__((ext_vector_type(2)));

constexpr int NT = 512, NWAVES = 8;
constexpr int LDS_BYTES = 147456;
constexpr int T_TOK = 32768, DM = 1024, SEQ = 2048, NB = 16;
constexpr float EPS = 1e-6f;
constexpr size_t MiB = 1u << 20;
constexpr size_t WS_MODS = 1 * MiB, WS_KVMODS = WS_MODS + (size_t)2 * 16 * 6144 * 4;
constexpr size_t WS_GATES = 2 * MiB, WS_BLAST = 4 * MiB, WS_MLOC = 4 * MiB + 65536, WS_MPREV = 4 * MiB + 131072, WS_NLOC = 5 * MiB;
constexpr size_t WS_WG = 6 * MiB, WS_SUBK = 7 * MiB;
constexpr size_t WS_WIN = 8 * MiB, WS_WOUT = 14 * MiB, WS_WKV = 16 * MiB, WS_WSQ = 20 * MiB, WS_WSO = 22 * MiB, WS_WPQ = 24 * MiB;
constexpr size_t WS_IDX = 36 * MiB, WS_GATE = 44 * MiB;
constexpr size_t WS_U = 64 * MiB, WS_V = 128 * MiB, WS_H = 192 * MiB, WS_HB = 256 * MiB, WS_PROJ = 320 * MiB, WS_END = 512 * MiB;
constexpr size_t WS_CST = WS_HB;
constexpr size_t WS_Q = WS_PROJ, WS_K = WS_PROJ + 64 * MiB, WS_VV = WS_PROJ + 128 * MiB, WS_PQ = WS_PROJ;

struct Args { const float* in[23]; float* out; unsigned char* ws; int ph_lo, ph_hi; };
struct Frame {
    LAS unsigned char* lds;
    const float* in[23]; float* out; unsigned char* ws;
    int tid, lane, wave, bid, G;
};

DI unsigned cvtpk(float lo, float hi) { f32x2_t v = {lo, hi}; bf16x2_t b = __builtin_convertvector(v, bf16x2_t); return __builtin_bit_cast(unsigned, b); }
DI float bflo(unsigned u) { return __uint_as_float(u << 16); }
DI float bfhi(unsigned u) { return __uint_as_float(u & 0xffff0000u); }
DI float wave_sum(float v) {
#pragma unroll
    for (int o = 1; o < 64; o <<= 1) v += __shfl_xor(v, o);
    return v;
}
DI float wave_max(float v) {
#pragma unroll
    for (int o = 1; o < 64; o <<= 1) v = fmaxf(v, __shfl_xor(v, o));
    return v;
}
DI int crow(int r, int hi) { return (r & 3) + 8 * (r >> 2) + 4 * hi; }
#define MFMA32(a, b, c) __builtin_amdgcn_mfma_f32_32x32x16_bf16((a), (b), (c), 0, 0, 0)
typedef short v4i16_t __attribute__((ext_vector_type(4)));
DI s16x4 tr16(const LAS unsigned char* p) { return __builtin_bit_cast(s16x4, __builtin_amdgcn_ds_read_tr16_b64_v4i16((LAS v4i16_t*)p)); }
DI int tr_off(int tok, int ch) { return (ch >> 2) * 4096 + (tok >> 4) * 1024 + (tok & 15) * 64 + (ch & 3) * 16; }
DI bf16x8 tr_frag(const LAS unsigned char* img, int dh, int ks, int lane) {
    const int hi = lane >> 5; const int vb = ((lane >> 4) & 1) * 32 + (lane & 3) * 8 + (4 * hi + ((lane & 15) >> 2)) * 64;
    const s16x4 lo = tr16(img + vb + dh * 4096 + ks * 1024), h2 = tr16(img + vb + dh * 4096 + ks * 1024 + 512);
    return __builtin_shufflevector(lo, h2, 0, 1, 2, 3, 4, 5, 6, 7);
}
template <int NTOK> DI bf16x8 row_frag(const LAS unsigned char* img, int tt, int ks, int lane) {
    const int hi = lane >> 5, r32 = lane & 31;
    return *(const LAS bf16x8*)(img + (2 * ks + hi) * (NTOK * 16) + (32 * tt + r32) * 16);
}
DI bf16x8 pack8(const f32x16& x, int s) {
    u32x4 p; p.x = cvtpk(x[8 * s], x[8 * s + 1]); p.y = cvtpk(x[8 * s + 2], x[8 * s + 3]); p.z = cvtpk(x[8 * s + 4], x[8 * s + 5]); p.w = cvtpk(x[8 * s + 6], x[8 * s + 7]);
    return __builtin_bit_cast(bf16x8, p);
}

DI void p0_ada(Frame& F) {
    LAS float* sil = (LAS float*)F.lds;
    LAS float* red = (LAS float*)(F.lds + 65536);
    const float* c = F.in[1];
    for (int i = F.tid; i < 16 * 1024; i += NT) { const int b = i >> 10, d = i & 1023; const float v = c[i]; sil[d * 16 + b] = v / (1.f + expf(-v)); }
    __syncthreads();
    for (int item = F.bid; item < 224; item += F.G) {
        const float* W; const float* bias; float* out; int N, col0;
        if (item < 192) { const int layer = item / 96, it = item % 96; W = F.in[2] + (size_t)layer * 1024 * 6144; bias = F.in[3] + layer * 6144; N = 6144; col0 = it * 64; out = (float*)(F.ws + WS_MODS) + (size_t)layer * 16 * 6144; }
        else { const int it = item - 192; W = F.in[11]; bias = F.in[12]; N = 2048; col0 = it * 64; out = (float*)(F.ws + WS_KVMODS); }
        float acc[16];
#pragma unroll
        for (int b = 0; b < 16; ++b) acc[b] = 0.f;
        const int d0 = F.wave * 128;
        const float* wp = W + (size_t)d0 * N + col0 + F.lane;
#pragma unroll 4
        for (int d = 0; d < 128; ++d) {
            const float w = wp[(size_t)d * N];
            const LAS f32x4* s4 = (const LAS f32x4*)(sil + (d0 + d) * 16);
            const f32x4 s0 = s4[0], s1 = s4[1], s2 = s4[2], s3 = s4[3];
            acc[0] += w * s0[0]; acc[1] += w * s0[1]; acc[2] += w * s0[2]; acc[3] += w * s0[3];
            acc[4] += w * s1[0]; acc[5] += w * s1[1]; acc[6] += w * s1[2]; acc[7] += w * s1[3];
            acc[8] += w * s2[0]; acc[9] += w * s2[1]; acc[10] += w * s2[2]; acc[11] += w * s2[3];
            acc[12] += w * s3[0]; acc[13] += w * s3[1]; acc[14] += w * s3[2]; acc[15] += w * s3[3];
        }
#pragma unroll
        for (int b = 0; b < 16; ++b) red[(F.wave * 16 + b) * 64 + F.lane] = acc[b];
        __syncthreads();
        for (int i = F.tid; i < 1024; i += NT) { const int b = i >> 6, l = i & 63; float s = 0.f;
#pragma unroll
            for (int w = 0; w < 8; ++w) s += red[(w * 16 + b) * 64 + l];
            out[(size_t)b * N + col0 + l] = s + bias[col0 + l]; }
        __syncthreads();
    }
}
DI void transpose_item(const float* W, int ldw, bf16* WT, int dst_row0, LAS float* scr, int k0, int n0, int lane) {
#pragma unroll 8
    for (int i = 0; i < 32; ++i) { const int kk = 2 * i + (lane >> 5); scr[kk * 33 + (lane & 31)] = W[(size_t)(k0 + kk) * ldw + n0 + (lane & 31)]; }
    asm volatile("s_waitcnt lgkmcnt(0)" ::: "memory");
    const int c = lane & 7;
#pragma unroll
    for (int j = 0; j < 4; ++j) { const int n = (lane >> 3) + 8 * j; const LAS float* s = scr + (8 * c) * 33 + n;
        u32x4 o; o.x = cvtpk(s[0 * 33], s[1 * 33]); o.y = cvtpk(s[2 * 33], s[3 * 33]); o.z = cvtpk(s[4 * 33], s[5 * 33]); o.w = cvtpk(s[6 * 33], s[7 * 33]);
        *(u32x4*)(WT + (size_t)(dst_row0 + n) * 1024 + k0 + 8 * c) = o; }
    asm volatile("s_waitcnt lgkmcnt(0)" ::: "memory");
}
DI int permrow(int c) { return (c & ~255) + 32 * (4 * ((c >> 5) & 1) + ((c >> 6) & 3)) + (c & 31); }
DI void p0_prologue(Frame& F) {
    p0_ada(F);
    LAS float* scr = (LAS float*)(F.lds + F.wave * 16384);
    const int gw = F.bid * NWAVES + F.wave, NGW = F.G * NWAVES;
    for (int it = gw; it < 6144; it += NGW) {
        int r = it; const float* W; int ldw, ncols; bf16* dst; bool perm;
        if (r < 1536) { W = F.in[6]; ldw = 3088; ncols = 3072; dst = (bf16*)(F.ws + WS_WIN); perm = false; }
        else if ((r -= 1536) < 512) { W = F.in[10]; ldw = 1024; ncols = 1024; dst = (bf16*)(F.ws + WS_WOUT); perm = false; }
        else if ((r -= 512) < 1024) { W = F.in[14]; ldw = 2048; ncols = 2048; dst = (bf16*)(F.ws + WS_WKV); perm = true; }
        else if ((r -= 1024) < 512) { W = F.in[16]; ldw = 1024; ncols = 1024; dst = (bf16*)(F.ws + WS_WSQ); perm = true; }
        else if ((r -= 512) < 512) { W = F.in[18]; ldw = 1024; ncols = 1024; dst = (bf16*)(F.ws + WS_WSO); perm = false; }
        else if ((r -= 512) < 1024) { W = F.in[19]; ldw = 2048; ncols = 2048; dst = (bf16*)(F.ws + WS_WPQ); perm = false; }
        else { r -= 1024; W = F.in[19] + (size_t)1024 * 2048; ldw = 2048; ncols = 2048; dst = (bf16*)(F.ws + WS_WPQ) + (size_t)2048 * 1024; perm = false; }
        const int nblk = ncols / 32, kb = r / nblk, nb = r % nblk, n0 = 32 * nb;
        transpose_item(W, ldw, dst, perm ? permrow(n0) : n0, scr, 64 * kb, n0, F.lane);
    }
    const size_t gt = (size_t)F.bid * NT + F.tid, NGT = (size_t)F.G * NT;
    constexpr size_t TBL16 = (size_t)2 * 16384 * 1024 / 16;
    for (size_t i = gt; i < 2 * TBL16; i += NGT) {
        const bool isv = i >= TBL16; const size_t j = isv ? i - TBL16 : i; const float sc = isv ? 4.f : 32.f;
        const f32x4* src = (const f32x4*)(isv ? F.in[22] : F.in[21]) + 4 * j;
        const f32x4 a = src[0] * sc, b = src[1] * sc, c2 = src[2] * sc, d = src[3] * sc;
        int p0 = 0, p1 = 0, p2 = 0, p3 = 0;
        p0 = __builtin_amdgcn_cvt_pk_fp8_f32(a[0], a[1], p0, false); p0 = __builtin_amdgcn_cvt_pk_fp8_f32(a[2], a[3], p0, true);
        p1 = __builtin_amdgcn_cvt_pk_fp8_f32(b[0], b[1], p1, false); p1 = __builtin_amdgcn_cvt_pk_fp8_f32(b[2], b[3], p1, true);
        p2 = __builtin_amdgcn_cvt_pk_fp8_f32(c2[0], c2[1], p2, false); p2 = __builtin_amdgcn_cvt_pk_fp8_f32(c2[2], c2[3], p2, true);
        p3 = __builtin_amdgcn_cvt_pk_fp8_f32(d[0], d[1], p3, false); p3 = __builtin_amdgcn_cvt_pk_fp8_f32(d[2], d[3], p3, true);
        ((u32x4*)(F.ws + (isv ? WS_V : WS_U)))[j] = (u32x4){(unsigned)p0, (unsigned)p1, (unsigned)p2, (unsigned)p3};
    }
    for (size_t i = gt; i < 65536 / 2; i += NGT) { const float a = F.in[20][2 * i], b = F.in[20][2 * i + 1]; ((unsigned*)(F.ws + WS_SUBK))[i] = cvtpk(a, b); }
    for (size_t i = gt; i < 16 * 1024; i += NGT) { const int g = (int)(i >> 10), k = (int)(i & 1023); ((float*)(F.ws + WS_WG))[i] = F.in[6][(size_t)k * 3088 + 3072 + g]; }
}

template <bool GATES> DI void norm_phase(Frame& F, const float* xin, const float* g, const float* shp, const float* scp, int bstride, bf16* hout) {
    const int gw = F.bid * NWAVES + F.wave, NGW = F.G * NWAVES;
    LAS float* wg = (LAS float*)F.lds;
    if (GATES) { const float* src = (const float*)(F.ws + WS_WG); for (int i = F.tid; i < 16 * 1024 / 4; i += NT) ((LAS f32x4*)wg)[i] = ((const f32x4*)src)[i]; __syncthreads(); }
    for (int chunk = gw; chunk < T_TOK / 16; chunk += NGW) {
        const int row0 = chunk * 16, b = row0 >> 11;
        f32x4 A[4], Bv[4];
#pragma unroll
        for (int j = 0; j < 4; ++j) { const int c = 4 * F.lane + 256 * j; const f32x4 gg = *(const f32x4*)(g + c), sc = *(const f32x4*)(scp + (size_t)b * bstride + c);
            A[j] = gg * (sc + 1.0f); Bv[j] = *(const f32x4*)(shp + (size_t)b * bstride + c); }
        for (int r = 0; r < 16; ++r) {
            const int row = row0 + r;
            const f32x4* xr = (const f32x4*)(xin + (size_t)row * DM) + F.lane;
            f32x4 v[4]; float ss = 0.f;
#pragma unroll
            for (int j = 0; j < 4; ++j) { v[j] = xr[64 * j]; ss += (v[j][0] * v[j][0] + v[j][1] * v[j][1]) + (v[j][2] * v[j][2] + v[j][3] * v[j][3]); }
            const float rstd = 1.0f / sqrtf(wave_sum(ss) * (1.0f / DM) + EPS);
            unsigned long long* o8 = (unsigned long long*)(hout + (size_t)row * DM) + F.lane;
#pragma unroll
            for (int j = 0; j < 4; ++j) { v[j] = v[j] * rstd * A[j] + Bv[j]; o8[64 * j] = (unsigned long long)cvtpk(v[j][0], v[j][1]) | ((unsigned long long)cvtpk(v[j][2], v[j][3]) << 32); }
            if (GATES) {
                float p[16];
#pragma unroll
                for (int q = 0; q < 16; ++q) { float s = 0.f;
#pragma unroll
                    for (int j = 0; j < 4; ++j) { const f32x4 w = *(const LAS f32x4*)(wg + q * 1024 + 4 * F.lane + 256 * j); s += (v[j][0] * w[0] + v[j][1] * w[1]) + (v[j][2] * w[2] + v[j][3] * w[3]); }
                    p[q] = s; if ((q & 3) == 3) { asm volatile("" ::: "memory"); __builtin_amdgcn_sched_barrier(0); } }
#pragma unroll
                for (int i = 0; i < 8; ++i) { const bool up = (F.lane & 32) != 0; const float send = up ? p[i] : p[i + 8], keep = up ? p[i + 8] : p[i]; p[i] = keep + __shfl_xor(send, 32); }
#pragma unroll
                for (int i = 0; i < 4; ++i) { const bool up = (F.lane & 16) != 0; const float send = up ? p[i] : p[i + 4], keep = up ? p[i + 4] : p[i]; p[i] = keep + __shfl_xor(send, 16); }
#pragma unroll
                for (int i = 0; i < 2; ++i) { const bool up = (F.lane & 8) != 0; const float send = up ? p[i] : p[i + 2], keep = up ? p[i + 2] : p[i]; p[i] = keep + __shfl_xor(send, 8); }
                { const bool up = (F.lane & 4) != 0; const float send = up ? p[0] : p[1], keep = up ? p[1] : p[0]; p[0] = keep + __shfl_xor(send, 4); }
                p[0] += __shfl_xor(p[0], 2); p[0] += __shfl_xor(p[0], 1);
                const int gi = ((F.lane >> 5) & 1) * 8 + ((F.lane >> 4) & 1) * 4 + ((F.lane >> 3) & 1) * 2 + ((F.lane >> 2) & 1);
                if ((F.lane & 3) == 0) ((float*)(F.ws + WS_GATES))[(size_t)row * 16 + gi] = p[0];
            }
        }
    }
}

DI void mlstm_gates(Frame& F, size_t trow0, int h, float& ipre, float& bcum, float& blast) {
    const float* gates = (const float*)(F.ws + WS_GATES); const float* bif = F.in[8];
    const float iv = gates[(trow0 + F.lane) * 16 + h] + bif[h];
    const float fv = gates[(trow0 + F.lane) * 16 + 8 + h] + bif[8 + h];
    float b = -(fmaxf(-fv, 0.f) + log1pf(expf(-fabsf(fv))));
#pragma unroll
    for (int d = 1; d < 64; d <<= 1) { const float t = __shfl_up(b, d); if (F.lane >= d) b += t; }
    ipre = iv; bcum = b; blast = __shfl(b, 63);
}
template <int MODE> DI void stage_qk(LAS unsigned char* dst, const LAS float* e_s, const bf16* proj, const float* convw, int tseq0, size_t trow0, int col0, int lane) {
    const int g8 = lane >> 3, ch = lane & 7, col = col0 + 8 * ch;
    float cw[4][8];
#pragma unroll
    for (int tap = 0; tap < 4; ++tap) { const f32x4 a = *(const f32x4*)(convw + tap * 1024 + col), b = *(const f32x4*)(convw + tap * 1024 + col + 4);
        cw[tap][0] = a[0]; cw[tap][1] = a[1]; cw[tap][2] = a[2]; cw[tap][3] = a[3]; cw[tap][4] = b[0]; cw[tap][5] = b[1]; cw[tap][6] = b[2]; cw[tap][7] = b[3]; }
#pragma unroll 1
    for (int ph = 0; ph < 2; ++ph) {
        float x[7][8];
#pragma unroll
        for (int i = 0; i < 7; ++i) {
            const int rel = 8 * g8 + 4 * ph + i - 3; const bool valid = (tseq0 + rel) >= 0; const long rr = valid ? (long)rel : 0;
            u32x4 raw = *(const u32x4*)(proj + (size_t)((long)trow0 + rr) * 3072 + col);
            if (!valid) raw = (u32x4){0u, 0u, 0u, 0u};
            x[i][0] = bflo(raw.x); x[i][1] = bfhi(raw.x); x[i][2] = bflo(raw.y); x[i][3] = bfhi(raw.y); x[i][4] = bflo(raw.z); x[i][5] = bfhi(raw.z); x[i][6] = bflo(raw.w); x[i][7] = bfhi(raw.w);
        }
#pragma unroll
        for (int o = 0; o < 4; ++o) {
            const int tok = 8 * g8 + 4 * ph + o;
            float y[8];
#pragma unroll
            for (int e = 0; e < 8; ++e) { float a = cw[0][e] * x[o][e] + cw[1][e] * x[o + 1][e] + cw[2][e] * x[o + 2][e] + cw[3][e] * x[o + 3][e]; y[e] = a / (1.f + __expf(-a)); }
            float sc = 1.f; if (MODE == 0) sc = e_s[tok]; if (MODE == 1) sc = 0.125f;
            u32x4 w; w.x = cvtpk(y[0] * sc, y[1] * sc); w.y = cvtpk(y[2] * sc, y[3] * sc); w.z = cvtpk(y[4] * sc, y[5] * sc); w.w = cvtpk(y[6] * sc, y[7] * sc);
            const int off = (MODE == 0) ? tr_off(tok, ch) : ch * 1024 + tok * 16;
            *(LAS u32x4*)(dst + off) = w;
        }
    }
}
DI void stage_v_half(LAS unsigned char* dst, const bf16* proj, size_t trow0, int col0, int lane) {
    const int g8 = lane >> 3, ch = lane & 7;
#pragma unroll
    for (int o = 0; o < 8; ++o) { const int tok = 8 * g8 + o; const u32x4 raw = *(const u32x4*)(proj + (trow0 + tok) * 3072 + col0 + 8 * ch); *(LAS u32x4*)(dst + tr_off(tok, ch)) = raw; }
}
constexpr int MW_LDS = 17408;

DI void p3_mlstm_local(Frame& F) {
    LAS unsigned char* wl = F.lds + F.wave * MW_LDS;
    LAS unsigned char* kimg = wl; LAS unsigned char* vimg = wl + 8192; LAS float* e_s = (LAS float*)(wl + 16384);
    const bf16* proj = (const bf16*)(F.ws + WS_PROJ);
    bf16* cst = (bf16*)(F.ws + WS_CST);
    const int lane = F.lane, r32 = lane & 31, hi = lane >> 5;
    for (int bu = F.bid; bu < 512; bu += F.G) {
        int h = F.wave; asm volatile("" : "+s"(h));
        const int b = bu >> 5, c = bu & 31; const int unit = bu * 8 + h; const size_t trow0 = (size_t)b * SEQ + c * 64;
        float ipre, bcum, blast; mlstm_gates(F, trow0, h, ipre, bcum, blast);
        const float w = blast - bcum + ipre; const float mloc = wave_max(w); const float e = expf(w - mloc);
        e_s[lane] = e;
        if (lane == 0) { ((float*)(F.ws + WS_BLAST))[unit] = blast; ((float*)(F.ws + WS_MLOC))[unit] = mloc; }
        stage_qk<0>(kimg, e_s, proj, F.in[7], c * 64, trow0, 512 + h * 64, lane);
        bf16x8 kef[2][4];
#pragma unroll
        for (int kt = 0; kt < 2; ++kt)
#pragma unroll
            for (int ks = 0; ks < 4; ++ks) kef[kt][ks] = tr_frag(kimg, kt, ks, lane);
        const bf16x8 ones = {0x3F80, 0x3F80, 0x3F80, 0x3F80, 0x3F80, 0x3F80, 0x3F80, 0x3F80};
#pragma unroll
        for (int kt = 0; kt < 2; ++kt) { f32x16 an = {};
#pragma unroll
            for (int ks = 0; ks < 4; ++ks) an = MFMA32(kef[kt][ks], ones, an);
            if (r32 == 0) {
#pragma unroll
                for (int r = 0; r < 16; ++r) ((float*)(F.ws + WS_NLOC))[(size_t)unit * 64 + 32 * kt + crow(r, hi)] = an[r]; } }
#pragma unroll 1
        for (int vh = 0; vh < 2; ++vh) {
            stage_v_half(vimg, proj, trow0, 1024 + h * 128 + 64 * vh, lane);
#pragma unroll
            for (int vt = 0; vt < 2; ++vt) {
                bf16x8 vf[4];
#pragma unroll
                for (int ks = 0; ks < 4; ++ks) vf[ks] = tr_frag(vimg, vt, ks, lane);
#pragma unroll
                for (int kt = 0; kt < 2; ++kt) { f32x16 acc = {};
#pragma unroll
                    for (int ks = 0; ks < 4; ++ks) acc = MFMA32(kef[kt][ks], vf[ks], acc);
                    bf16* dstp = cst + ((size_t)unit * 128 + 64 * vh + 32 * vt + r32) * 64 + 32 * kt + 4 * hi;
#pragma unroll
                    for (int rg = 0; rg < 4; ++rg) { u32x2 pk; pk.x = cvtpk(acc[4 * rg], acc[4 * rg + 1]); pk.y = cvtpk(acc[4 * rg + 2], acc[4 * rg + 3]); *(u32x2*)(dstp + 8 * rg) = pk; }
                }
            }
        }
    }
}
DI void p4_scan(Frame& F) {
    const int gt = F.bid * NT + F.tid, NGT = F.G * NT;
    const float* mlocp = (const float*)(F.ws + WS_MLOC); const float* blastp = (const float*)(F.ws + WS_BLAST);
    for (int item = gt; item < 128 * 1024; item += NGT) {
        const int bh = item >> 10, e8 = item & 1023, b = bh >> 3, h = bh & 7;
        float st[8]; float m = 0.f;
#pragma unroll
        for (int i = 0; i < 8; ++i) st[i] = 0.f;
#pragma unroll 4
        for (int c = 0; c < 32; ++c) {
            const int unit = (b * 32 + c) * 8 + h;
            u32x4* p = (u32x4*)((bf16*)(F.ws + WS_CST) + (size_t)unit * 8192) + e8;
            const u32x4 raw = *p; const float ml = mlocp[unit], bl = blastp[unit];
            u32x4 o; o.x = cvtpk(st[0], st[1]); o.y = cvtpk(st[2], st[3]); o.z = cvtpk(st[4], st[5]); o.w = cvtpk(st[6], st[7]); *p = o;
            const float mn = fmaxf(bl + m, ml), a = expf(bl + m - mn), r = expf(ml - mn);
            st[0] = a * st[0] + r * bflo(raw.x); st[1] = a * st[1] + r * bfhi(raw.x); st[2] = a * st[2] + r * bflo(raw.y); st[3] = a * st[3] + r * bfhi(raw.y);
            st[4] = a * st[4] + r * bflo(raw.z); st[5] = a * st[5] + r * bfhi(raw.z); st[6] = a * st[6] + r * bflo(raw.w); st[7] = a * st[7] + r * bfhi(raw.w);
            m = mn;
        }
    }
    for (int item = gt; item < 128 * 64; item += NGT) {
        const int bh = item >> 6, k = item & 63, b = bh >> 3, h = bh & 7;
        float ns = 0.f, m = 0.f;
        for (int c = 0; c < 32; ++c) {
            const int unit = (b * 32 + c) * 8 + h;
            float* np = (float*)(F.ws + WS_NLOC) + (size_t)unit * 64 + k;
            const float nl = *np, ml = mlocp[unit], bl = blastp[unit];
            *np = ns; if (k == 0) ((float*)(F.ws + WS_MPREV))[unit] = m;
            const float mn = fmaxf(bl + m, ml), a = expf(bl + m - mn), r = expf(ml - mn);
            ns = a * ns + r * nl; m = mn;
        }
    }
}
DI void p5_mlstm_out(Frame& F) {
    LAS unsigned char* wl = F.lds + F.wave * MW_LDS;
    LAS unsigned char* qimg = wl; LAS unsigned char* kimg = wl + 8192; LAS float* sc = (LAS float*)(wl + 16384);
    const bf16* proj = (const bf16*)(F.ws + WS_PROJ);
    const bf16* cst = (const bf16*)(F.ws + WS_CST);
    bf16* hh = (bf16*)(F.ws + WS_H);
    for (int bu = F.bid; bu < 512; bu += F.G) {
        int lane = F.lane; asm volatile("" : "+v"(lane)); const int r32 = lane & 31, hi = lane >> 5;
        int h = F.wave; asm volatile("" : "+s"(h));
        const int b = bu >> 5, c = bu & 31; const int unit = bu * 8 + h; const size_t trow0 = (size_t)b * SEQ + c * 64;
        {
            float ipre, bcum, blast; mlstm_gates(F, trow0, h, ipre, bcum, blast);
            const float mprev = ((const float*)(F.ws + WS_MPREV))[unit];
            const float gg = ipre - bcum; float pm = gg;
#pragma unroll
            for (int d = 1; d < 64; d <<= 1) { const float t = __shfl_up(pm, d); if (lane >= d) pm = fmaxf(pm, t); }
            const float Mx = fmaxf(mprev, pm), mt = bcum + Mx;
            sc[lane] = gg; sc[64 + lane] = Mx; sc[128 + lane] = expf(mprev - Mx); sc[192 + lane] = expf(-mt);
        }
#pragma unroll 1
        for (int lt = 0; lt < 2; ++lt) {
            stage_qk<1>(qimg, nullptr, proj, F.in[7], c * 64, trow0, h * 64, lane); asm volatile("" ::: "memory"); __builtin_amdgcn_sched_barrier(0);
            stage_qk<2>(kimg, nullptr, proj, F.in[7], c * 64, trow0, 512 + h * 64, lane);
            bf16x8 qf[4];
#pragma unroll
            for (int ks = 0; ks < 4; ++ks) qf[ks] = row_frag<64>(qimg, lt, ks, lane);
            const int l = 32 * lt + r32;
            const float Mxl = sc[64 + l];
            bf16x8 P[2][2]; float dsum = 0.f;
#pragma unroll
            for (int st = 0; st < 2; ++st) {
                P[st][0] = (bf16x8){0, 0, 0, 0, 0, 0, 0, 0}; P[st][1] = P[st][0];
                if (st <= lt) {
                    f32x16 acc = {};
#pragma unroll
                    for (int ks = 0; ks < 4; ++ks) acc = MFMA32(row_frag<64>(kimg, st, ks, lane), qf[ks], acc);
#pragma unroll
                    for (int r = 0; r < 16; ++r) { const int srow = crow(r, hi); float val = acc[r] * __expf(sc[32 * st + srow] - Mxl); if (st == lt && srow > r32) val = 0.f; acc[r] = val; dsum += val; }
                    P[st][0] = pack8(acc, 0); P[st][1] = pack8(acc, 1);
                }
            }
            float nq;
            { const float* np = (const float*)(F.ws + WS_NLOC) + (size_t)unit * 64; float s = 0.f;
#pragma unroll
              for (int ks = 0; ks < 4; ++ks) { const f32x4 n0 = *(const f32x4*)(np + 16 * ks + 8 * hi), n1 = *(const f32x4*)(np + 16 * ks + 8 * hi + 4); const u32x4 q = __builtin_bit_cast(u32x4, qf[ks]);
                  s += bflo(q.x) * n0[0] + bfhi(q.x) * n0[1] + bflo(q.y) * n0[2] + bfhi(q.y) * n0[3] + bflo(q.z) * n1[0] + bfhi(q.z) * n1[1] + bflo(q.w) * n1[2] + bfhi(q.w) * n1[3]; }
              nq = s + __shfl_xor(s, 32); }
            asm volatile("s_waitcnt lgkmcnt(0)" ::: "memory");
            stage_v_half(wl, proj, trow0, 1024 + h * 128, lane); asm volatile("" ::: "memory"); __builtin_amdgcn_sched_barrier(0);
            stage_v_half(wl + 8192, proj, trow0, 1024 + h * 128 + 64, lane); asm volatile("" ::: "memory"); __builtin_amdgcn_sched_barrier(0);
            f32x16 acc[4];
#pragma unroll
            for (int vt = 0; vt < 4; ++vt) { acc[vt] = (f32x16){};
#pragma unroll
                for (int ks = 0; ks < 4; ++ks) { const bf16x8 cf = *(const bf16x8*)(cst + ((size_t)unit * 128 + 32 * vt + r32) * 64 + 16 * ks + 8 * hi); acc[vt] = MFMA32(cf, qf[ks], acc[vt]); }
                asm volatile("" ::: "memory"); __builtin_amdgcn_sched_barrier(0); }
            const float iwl = sc[128 + l];
#pragma unroll
            for (int vt = 0; vt < 4; ++vt) acc[vt] = acc[vt] * iwl;
#pragma unroll
            for (int st = 0; st < 2; ++st) if (st <= lt) {
#pragma unroll
                for (int k2 = 0; k2 < 2; ++k2) {
#pragma unroll
                    for (int vt = 0; vt < 4; ++vt) acc[vt] = MFMA32(tr_frag(wl + (vt >> 1) * 8192, vt & 1, 2 * st + k2, lane), P[st][k2], acc[vt]);
                    asm volatile("" ::: "memory"); __builtin_amdgcn_sched_barrier(0); } }
            const float den = dsum + __shfl_xor(dsum, 32) + iwl * nq;
            const float inv = 1.0f / fmaxf(fabsf(den), sc[192 + l]);
            float ss = 0.f;
#pragma unroll
            for (int vt = 0; vt < 4; ++vt)
#pragma unroll
                for (int r = 0; r < 16; ++r) { const float v = acc[vt][r] * inv; acc[vt][r] = v; ss += v * v; }
            ss += __shfl_xor(ss, 32);
            const float rstd = 1.0f / sqrtf(ss * (1.0f / 128.0f) + EPS);
            const size_t t = trow0 + l;
#pragma unroll
            for (int vt = 0; vt < 4; ++vt)
#pragma unroll
                for (int rg = 0; rg < 4; ++rg) { const int v = 32 * vt + 8 * rg + 4 * hi;
                    const u32x2 o4 = *(const u32x2*)(proj + t * 3072 + 2048 + h * 128 + v); const f32x4 g4 = *(const f32x4*)(F.in[9] + h * 128 + v);
                    const float o0 = bflo(o4.x), o1 = bfhi(o4.x), o2 = bflo(o4.y), o3 = bfhi(o4.y);
                    const float y0 = acc[vt][4 * rg] * rstd * g4[0] / (1.f + __expf(-o0)), y1 = acc[vt][4 * rg + 1] * rstd * g4[1] / (1.f + __expf(-o1));
                    const float y2 = acc[vt][4 * rg + 2] * rstd * g4[2] / (1.f + __expf(-o2)), y3 = acc[vt][4 * rg + 3] * rstd * g4[3] / (1.f + __expf(-o3));
                    u32x2 pk; pk.x = cvtpk(y0, y1); pk.y = cvtpk(y2, y3); *(u32x2*)(hh + t * 1024 + h * 128 + v) = pk;
                    if ((rg & 1) == 1) { asm volatile("" ::: "memory"); __builtin_amdgcn_sched_barrier(0); } }
            asm volatile("s_waitcnt lgkmcnt(0)" ::: "memory");
        }
    }
}

DI float softplus_f(float z) { return fmaxf(z, 0.f) + __logf(1.f + __expf(-fabsf(z))); }
DI void p12_attn(Frame& F) {
    LAS unsigned char* kimg = F.lds; LAS unsigned char* vimg = F.lds + 8192;
    const bf16* Q = (const bf16*)(F.ws + WS_Q); const bf16* K = (const bf16*)(F.ws + WS_K); const bf16* V = (const bf16*)(F.ws + WS_VV);
    bf16* O = (bf16*)(F.ws + WS_H);
    const int lane = F.lane, r32 = lane & 31, hi = lane >> 5, wave = F.wave;
    const int skey = F.tid >> 3, schk = F.tid & 7;
    for (int bh = F.bid; bh < 256; bh += F.G) {
        const int b = bh >> 4, h = bh & 15;
        for (int qb = 7; qb >= 0; --qb) {
            const int qlo = qb * 256 + 32 * wave;
            const size_t tq0 = (size_t)b * SEQ + qlo;
            bf16x8 qr[4];
#pragma unroll
            for (int ks = 0; ks < 4; ++ks) qr[ks] = *(const bf16x8*)(Q + (tq0 + r32) * 1024 + h * 64 + 16 * ks + 8 * hi);
            f32x16 o0 = {}, o1 = {}; float R = 0.f;
            const int ntile = 4 * qb + 4;
            u32x4 kraw, vraw;
            { const size_t src = ((size_t)b * SEQ + 64 * (ntile - 1) + skey) * 1024 + h * 64 + 8 * schk; kraw = *(const u32x4*)(K + src); vraw = *(const u32x4*)(V + src); }
            for (int kt = ntile - 1; kt >= 0; --kt) {
                __syncthreads();
                *(LAS u32x4*)(kimg + schk * 1024 + skey * 16) = kraw;
                *(LAS u32x4*)(vimg + tr_off(skey, schk)) = vraw;
                if (kt > 0) { const size_t src = ((size_t)b * SEQ + 64 * (kt - 1) + skey) * 1024 + h * 64 + 8 * schk; kraw = *(const u32x4*)(K + src); vraw = *(const u32x4*)(V + src); }
                __syncthreads();
                if (64 * kt <= qlo + 30) {
                    f32x16 p0 = {}, p1 = {};
#pragma unroll
                    for (int ks = 0; ks < 4; ++ks) { p0 = MFMA32(row_frag<64>(kimg, 0, ks, lane), qr[ks], p0); p1 = MFMA32(row_frag<64>(kimg, 1, ks, lane), qr[ks], p1); }
                    const bool diag = (64 * kt + 63 >= qlo);
                    const int qrel = qlo + r32 - 64 * kt;
                    float s0[16], s1[16];
#pragma unroll
                    for (int r = 0; r < 16; ++r) { const int kr = crow(r, hi);
                        const bool v0 = !diag || kr < qrel, v1 = !diag || (kr + 32) < qrel;
                        s0[r] = v0 ? softplus_f(p0[r]) : 0.f; s1[r] = v1 ? softplus_f(p1[r]) : 0.f; }
#pragma unroll
                    for (int g = 0; g < 4; ++g) { s0[4 * g + 2] += s0[4 * g + 3]; s0[4 * g + 1] += s0[4 * g + 2]; s0[4 * g] += s0[4 * g + 1];
                                                  s1[4 * g + 2] += s1[4 * g + 3]; s1[4 * g + 1] += s1[4 * g + 2]; s1[4 * g] += s1[4 * g + 1]; }
                    float off0[4], off1[4]; float tot0, tot1;
                    { float og[4], T[4];
#pragma unroll
                      for (int g = 0; g < 4; ++g) og[g] = __shfl_xor(s1[4 * g], 32);
                      T[3] = 0.f; T[2] = s1[12] + og[3]; T[1] = T[2] + s1[8] + og[2]; T[0] = T[1] + s1[4] + og[1]; tot1 = T[0] + s1[0] + og[0];
#pragma unroll
                      for (int g = 0; g < 4; ++g) off1[g] = T[g] + (hi == 0 ? og[g] : 0.f) + R; }
                    { float og[4], T[4];
#pragma unroll
                      for (int g = 0; g < 4; ++g) og[g] = __shfl_xor(s0[4 * g], 32);
                      T[3] = 0.f; T[2] = s0[12] + og[3]; T[1] = T[2] + s0[8] + og[2]; T[0] = T[1] + s0[4] + og[1]; tot0 = T[0] + s0[0] + og[0];
#pragma unroll
                      for (int g = 0; g < 4; ++g) off0[g] = T[g] + (hi == 0 ? og[g] : 0.f) + R + tot1; }
#pragma unroll
                    for (int r = 0; r < 16; ++r) { const int kr = crow(r, hi);
                        const bool v0 = !diag || kr < qrel, v1 = !diag || (kr + 32) < qrel;
                        const float a0 = __expf(p0[r] - s0[r] - off0[r >> 2]), a1 = __expf(p1[r] - s1[r] - off1[r >> 2]);
                        p0[r] = v0 ? a0 : 0.f; p1[r] = v1 ? a1 : 0.f; }
                    R += tot0 + tot1;
                    const bf16x8 pa0 = pack8(p0, 0), pa1 = pack8(p0, 1), pa2 = pack8(p1, 0), pa3 = pack8(p1, 1);
                    o0 = MFMA32(pa0, tr_frag(vimg, 0, 0, lane), o0); o1 = MFMA32(pa0, tr_frag(vimg, 1, 0, lane), o1);
                    o0 = MFMA32(pa1, tr_frag(vimg, 0, 1, lane), o0); o1 = MFMA32(pa1, tr_frag(vimg, 1, 1, lane), o1);
                    o0 = MFMA32(pa2, tr_frag(vimg, 0, 2, lane), o0); o1 = MFMA32(pa2, tr_frag(vimg, 1, 2, lane), o1);
                    o0 = MFMA32(pa3, tr_frag(vimg, 0, 3, lane), o0); o1 = MFMA32(pa3, tr_frag(vimg, 1, 3, lane), o1);
                }
            }
#pragma unroll
            for (int r = 0; r < 16; ++r) { bf16* op = O + (tq0 + crow(r, hi)) * 1024 + h * 64 + r32;
                op[0] = (bf16)(cvtpk(o0[r], 0.f) & 0xffffu); op[32] = (bf16)(cvtpk(o1[r], 0.f) & 0xffffu); }
        }
    }
}

__device__ constexpr int NET16_A[63] = {0,2,0,1,1,4,6,4,5,5,0,2,2,1,3,3,1,3,5,8,10,8,9,9,12,14,12,13,13,8,10,10,9,11,11,9,11,13,0,4,4,2,6,6,2,6,10,1,5,5,3,7,7,3,7,11,1,3,5,7,9,11,13};
__device__ constexpr int NET16_B[63] = {1,3,2,3,2,5,7,6,7,6,4,6,4,5,7,5,2,4,6,9,11,10,11,10,13,15,14,15,14,12,14,12,13,15,13,10,12,14,8,12,8,10,14,10,4,8,12,9,13,9,11,15,11,5,9,13,2,4,6,8,10,12,14};
__device__ constexpr int BIT16_A[32] = {0,1,2,3,4,5,6,7,0,1,2,3,8,9,10,11,0,1,4,5,8,9,12,13,0,2,4,6,8,10,12,14};
__device__ constexpr int BIT16_B[32] = {8,9,10,11,12,13,14,15,4,5,6,7,12,13,14,15,2,3,6,7,10,11,14,15,1,3,5,7,9,11,13,15};
DI unsigned umax_(unsigned a, unsigned b) { return a > b ? a : b; }
DI unsigned umin_(unsigned a, unsigned b) { return a < b ? a : b; }
DI void sort16(unsigned (&k)[16]) {
#pragma unroll
    for (int c = 0; c < 63; ++c) { const unsigned a = k[NET16_A[c]], b = k[NET16_B[c]]; k[NET16_A[c]] = umax_(a, b); k[NET16_B[c]] = umin_(a, b); }
}
DI void bitonic16(unsigned (&k)[16]) {
#pragma unroll
    for (int c = 0; c < 32; ++c) { const unsigned a = k[BIT16_A[c]], b = k[BIT16_B[c]]; k[BIT16_A[c]] = umax_(a, b); k[BIT16_B[c]] = umin_(a, b); }
}
DI void merge16(unsigned (&x)[16], const unsigned (&y)[16]) {
#pragma unroll
    for (int i = 0; i < 16; ++i) x[i] = umax_(x[i], y[15 - i]);
    bitonic16(x);
}
DI unsigned f2key(float x) { const unsigned b = __float_as_uint(x); return b ^ ((unsigned)((int)b >> 31) | 0x80000000u); }
DI float key2f(unsigned k) { return __uint_as_float(k ^ (~(unsigned)((int)k >> 31) | 0x80000000u)); }

DI void p_route(Frame& F, int layer) {
    LAS unsigned char* simg = F.lds;
    LAS unsigned char* dec = F.lds + 65536 + F.wave * 1024;
    { const u32x4* src = (const u32x4*)((const bf16*)(F.ws + WS_SUBK) + (size_t)layer * 2 * 128 * 128);
      for (int i = F.tid; i < 2 * 128 * 16; i += NT) { const int p = i >> 11, n = (i >> 4) & 127, ch = i & 15; *(LAS u32x4*)(simg + p * 32768 + ch * 2048 + n * 16) = src[i]; } }
    __syncthreads();
    const bf16* PQ = (const bf16*)(F.ws + WS_PQ);
    const int lane = F.lane, r32 = lane & 31, hi = lane >> 5;
    const int gw = F.bid * NWAVES + F.wave, NGW = F.G * NWAVES;
    for (int wu = gw; wu < T_TOK * 8 / 32; wu += NGW) {
        const int row = wu * 32 + r32, t = row >> 3, hd = row & 7;
        unsigned top[2][16];
#pragma unroll
        for (int p = 0; p < 2; ++p) {
            bf16x8 qf[8];
#pragma unroll
            for (int ks = 0; ks < 8; ++ks) qf[ks] = *(const bf16x8*)(PQ + (size_t)t * 2048 + hd * 256 + p * 128 + 16 * ks + 8 * hi);
            unsigned keys[4][16];
#pragma unroll
            for (int nt = 0; nt < 4; ++nt) {
                f32x16 acc = {};
#pragma unroll
                for (int ks = 0; ks < 8; ++ks) acc = MFMA32(*(const LAS bf16x8*)(simg + p * 32768 + (2 * ks + hi) * 2048 + (32 * nt + r32) * 16), qf[ks], acc);
#pragma unroll
                for (int r = 0; r < 16; ++r) keys[nt][r] = (f2key(acc[r]) & 0xFFFFFF80u) | (unsigned)(32 * nt + crow(r, 0)) | (unsigned)(4 * hi);
                sort16(keys[nt]);
            }
            merge16(keys[0], keys[1]); merge16(keys[2], keys[3]); merge16(keys[0], keys[2]);
            unsigned lo[16], up[16];
#pragma unroll
            for (int i = 0; i < 16; ++i) { auto rr = __builtin_amdgcn_permlane32_swap(keys[0][i], keys[0][i], false, false); lo[i] = rr[0]; up[i] = rr[1]; }
#pragma unroll
            for (int i = 0; i < 16; ++i) top[p][i] = umax_(lo[i], up[15 - i]);
            bitonic16(top[p]);
        }
        if (hi == 0) {
            u32x4 w0, w1, w2, w3;
            w0.x = (top[0][0] & 127u) | ((top[0][1] & 127u) << 8) | ((top[0][2] & 127u) << 16) | ((top[0][3] & 127u) << 24);
            w0.y = (top[0][4] & 127u) | ((top[0][5] & 127u) << 8) | ((top[0][6] & 127u) << 16) | ((top[0][7] & 127u) << 24);
            w0.z = (top[0][8] & 127u) | ((top[0][9] & 127u) << 8) | ((top[0][10] & 127u) << 16) | ((top[0][11] & 127u) << 24);
            w0.w = (top[0][12] & 127u) | ((top[0][13] & 127u) << 8) | ((top[0][14] & 127u) << 16) | ((top[0][15] & 127u) << 24);
            w1.x = (top[1][0] & 127u) | ((top[1][1] & 127u) << 8) | ((top[1][2] & 127u) << 16) | ((top[1][3] & 127u) << 24);
            w1.y = (top[1][4] & 127u) | ((top[1][5] & 127u) << 8) | ((top[1][6] & 127u) << 16) | ((top[1][7] & 127u) << 24);
            w1.z = (top[1][8] & 127u) | ((top[1][9] & 127u) << 8) | ((top[1][10] & 127u) << 16) | ((top[1][11] & 127u) << 24);
            w1.w = (top[1][12] & 127u) | ((top[1][13] & 127u) << 8) | ((top[1][14] & 127u) << 16) | ((top[1][15] & 127u) << 24);
            *(LAS u32x4*)(dec + r32 * 32) = w0; *(LAS u32x4*)(dec + r32 * 32 + 16) = w1;
        }
        float av[16], bv[16];
#pragma unroll
        for (int i = 0; i < 16; ++i) { av[i] = key2f(top[0][i] & 0xFFFFFF80u); bv[i] = key2f(top[1][i] & 0xFFFFFF80u); }
        unsigned c0[16], c1[16], c2[16], c3[16];
#pragma unroll
        for (int j = 0; j < 16; ++j) c0[j] = (f2key(av[0] + bv[j]) & 0xFFFFFF00u) | (unsigned)j;
        {
            int n = 0;
#pragma unroll
            for (int i = 1; i < 16; ++i)
#pragma unroll
                for (int j = 0; j < 16; ++j) if ((i + 1) * (j + 1) <= 16) {
                    const unsigned k = (f2key(av[i] + bv[j]) & 0xFFFFFF00u) | (unsigned)(i * 16 + j);
                    if (n < 16) c1[n] = k; else if (n < 32) c2[n - 16] = k; else c3[n - 32] = k;
                    ++n; }
#pragma unroll
            for (int q = 2; q < 16; ++q) c3[q] = 0u;
        }
        sort16(c1); sort16(c2); { const unsigned a = c3[0], b = c3[1]; c3[0] = umax_(a, b); c3[1] = umin_(a, b); }
        merge16(c0, c1); merge16(c2, c3); merge16(c0, c2);
        asm volatile("s_waitcnt lgkmcnt(0)" ::: "memory");
        float gv[16]; unsigned ex[16]; float gs = 0.f;
        const float vmax = key2f(c0[0] & 0xFFFFFF00u);
#pragma unroll
        for (int k = 0; k < 16; ++k) {
            const unsigned code = c0[k] & 255u; const unsigned i = code >> 4, j = code & 15u;
            const unsigned ia = *(const LAS unsigned char*)(dec + r32 * 32 + i), ib = *(const LAS unsigned char*)(dec + r32 * 32 + 16 + j);
            ex[k] = ia * 128u + ib;
            gv[k] = __expf(key2f(c0[k] & 0xFFFFFF00u) - vmax); gs += gv[k];
        }
        const float ginv = 1.0f / gs;
        if (hi == 0) {
            u32x4 e0, e1;
            e0.x = ex[0] | (ex[1] << 16); e0.y = ex[2] | (ex[3] << 16); e0.z = ex[4] | (ex[5] << 16); e0.w = ex[6] | (ex[7] << 16);
            e1.x = ex[8] | (ex[9] << 16); e1.y = ex[10] | (ex[11] << 16); e1.z = ex[12] | (ex[13] << 16); e1.w = ex[14] | (ex[15] << 16);
            u32x4* ip = (u32x4*)((unsigned short*)(F.ws + WS_IDX) + (size_t)row * 16); ip[0] = e0; ip[1] = e1;
        } else {
            f32x4* gp = (f32x4*)((float*)(F.ws + WS_GATE) + (size_t)row * 16);
            gp[0] = (f32x4){gv[0] * ginv, gv[1] * ginv, gv[2] * ginv, gv[3] * ginv}; gp[1] = (f32x4){gv[4] * ginv, gv[5] * ginv, gv[6] * ginv, gv[7] * ginv};
            gp[2] = (f32x4){gv[8] * ginv, gv[9] * ginv, gv[10] * ginv, gv[11] * ginv}; gp[3] = (f32x4){gv[12] * ginv, gv[13] * ginv, gv[14] * ginv, gv[15] * ginv};
        }
    }
}

constexpr float U_SCALE = 32.f, V_SCALE = 4.f;
struct RowBuf { u32x4 r[16]; };
DI void load_rows(RowBuf& rb, const unsigned char* tbl, int idxs, int k0, int lane) {
#pragma unroll
    for (int j = 0; j < 16; ++j) { const int e = __builtin_amdgcn_readlane(idxs, k0 + j); rb.r[j] = *((const u32x4*)(tbl + (size_t)e * 1024) + lane); }
}
DI float udots(const RowBuf& rb, const f32x2_t (&hq)[8], int lane) {
    float p[16];
#pragma unroll
    for (int j = 0; j < 16; ++j) { f32x2_t a = {0.f, 0.f};
        a = __builtin_amdgcn_cvt_pk_f32_fp8((int)rb.r[j].x, false) * hq[0] + a; a = __builtin_amdgcn_cvt_pk_f32_fp8((int)rb.r[j].x, true) * hq[1] + a;
        a = __builtin_amdgcn_cvt_pk_f32_fp8((int)rb.r[j].y, false) * hq[2] + a; a = __builtin_amdgcn_cvt_pk_f32_fp8((int)rb.r[j].y, true) * hq[3] + a;
        a = __builtin_amdgcn_cvt_pk_f32_fp8((int)rb.r[j].z, false) * hq[4] + a; a = __builtin_amdgcn_cvt_pk_f32_fp8((int)rb.r[j].z, true) * hq[5] + a;
        a = __builtin_amdgcn_cvt_pk_f32_fp8((int)rb.r[j].w, false) * hq[6] + a; a = __builtin_amdgcn_cvt_pk_f32_fp8((int)rb.r[j].w, true) * hq[7] + a;
        p[j] = a.x + a.y; }
#pragma unroll
    for (int i = 0; i < 8; ++i) { const bool up = (lane & 8) != 0; const float send = up ? p[i] : p[i + 8], keep = up ? p[i + 8] : p[i]; p[i] = keep + __shfl_xor(send, 8); }
#pragma unroll
    for (int i = 0; i < 4; ++i) { const bool up = (lane & 4) != 0; const float send = up ? p[i] : p[i + 4], keep = up ? p[i + 4] : p[i]; p[i] = keep + __shfl_xor(send, 4); }
#pragma unroll
    for (int i = 0; i < 2; ++i) { const bool up = (lane & 2) != 0; const float send = up ? p[i] : p[i + 2], keep = up ? p[i + 2] : p[i]; p[i] = keep + __shfl_xor(send, 2); }
    { const bool up = (lane & 1) != 0; const float send = up ? p[0] : p[1], keep = up ? p[1] : p[0]; p[0] = keep + __shfl_xor(send, 1); }
    float s = p[0]; s += __shfl_xor(s, 16); s += __shfl_xor(s, 32);
    return s;
}
DI void vaccum(const RowBuf& rb, f32x2_t (&out)[8], float wv, int k0) {
#pragma unroll
    for (int j = 0; j < 16; ++j) { const float wk = __builtin_bit_cast(float, __builtin_amdgcn_readlane(__builtin_bit_cast(int, wv), k0 + j));
        out[0] = __builtin_amdgcn_cvt_pk_f32_fp8((int)rb.r[j].x, false) * wk + out[0]; out[1] = __builtin_amdgcn_cvt_pk_f32_fp8((int)rb.r[j].x, true) * wk + out[1];
        out[2] = __builtin_amdgcn_cvt_pk_f32_fp8((int)rb.r[j].y, false) * wk + out[2]; out[3] = __builtin_amdgcn_cvt_pk_f32_fp8((int)rb.r[j].y, true) * wk + out[3];
        out[4] = __builtin_amdgcn_cvt_pk_f32_fp8((int)rb.r[j].z, false) * wk + out[4]; out[5] = __builtin_amdgcn_cvt_pk_f32_fp8((int)rb.r[j].z, true) * wk + out[5];
        out[6] = __builtin_amdgcn_cvt_pk_f32_fp8((int)rb.r[j].w, false) * wk + out[6]; out[7] = __builtin_amdgcn_cvt_pk_f32_fp8((int)rb.r[j].w, true) * wk + out[7]; }
}
template <bool LAST> DI void p_apply(Frame& F, int layer, float* xout) {
    const unsigned char* U = F.ws + WS_U + (size_t)layer * 16384 * 1024;
    const unsigned char* V = F.ws + WS_V + (size_t)layer * 16384 * 1024;
    const bf16* H2 = (const bf16*)(F.ws + WS_H);
    const unsigned short* IDX = (const unsigned short*)(F.ws + WS_IDX); const float* GATE = (const float*)(F.ws + WS_GATE);
    const float* mods = (const float*)(F.ws + WS_MODS);
    const int lane = F.lane;
    const int gw = F.bid * NWAVES + F.wave, NGW = F.G * NWAVES;
    for (int chunk = gw; chunk < T_TOK / 16; chunk += NGW) {
        const int t0 = chunk * 16, b = t0 >> 11;
#pragma unroll 1
        for (int tt = 0; tt < 16; ++tt) {
            const size_t t = (size_t)t0 + tt;
            f32x2_t hq[8];
            { const u32x4* hp = (const u32x4*)(H2 + t * 1024) + 2 * lane; const u32x4 a = hp[0], c = hp[1];
              hq[0] = (f32x2_t){bflo(a.x), bfhi(a.x)}; hq[1] = (f32x2_t){bflo(a.y), bfhi(a.y)}; hq[2] = (f32x2_t){bflo(a.z), bfhi(a.z)}; hq[3] = (f32x2_t){bflo(a.w), bfhi(a.w)};
              hq[4] = (f32x2_t){bflo(c.x), bfhi(c.x)}; hq[5] = (f32x2_t){bflo(c.y), bfhi(c.y)}; hq[6] = (f32x2_t){bflo(c.z), bfhi(c.z)}; hq[7] = (f32x2_t){bflo(c.w), bfhi(c.w)}; }
            const int i0 = IDX[t * 128 + lane], i1 = IDX[t * 128 + 64 + lane];
            const float g0 = GATE[t * 128 + lane], g1 = GATE[t * 128 + 64 + lane];
            f32x2_t out[8];
#pragma unroll
            for (int i = 0; i < 8; ++i) out[i] = (f32x2_t){0.f, 0.f};
#pragma unroll 1
            for (int half = 0; half < 2; ++half) {
                const int idxs = half ? i1 : i0; const float gts = half ? g1 : g0;
                float coll = 0.f;
                RowBuf A, B;
                load_rows(A, U, idxs, 0, lane);
#pragma unroll
                for (int bb = 0; bb < 4; bb += 2) {
                    load_rows(B, U, idxs, 16 * (bb + 1), lane);
                    { const float s = udots(A, hq, lane); coll = ((lane >> 4) == bb) ? s : coll; }
                    if (bb + 2 < 4) load_rows(A, U, idxs, 16 * (bb + 2), lane); else load_rows(A, V, idxs, 0, lane);
                    { const float s = udots(B, hq, lane); coll = ((lane >> 4) == bb + 1) ? s : coll; }
                }
                coll *= (1.0f / U_SCALE);
                const float wv = gts * 0.5f * coll * (1.0f + erff(coll * 0.70710678118654752f)) * (1.0f / V_SCALE);
#pragma unroll
                for (int bb = 0; bb < 4; bb += 2) {
                    load_rows(B, V, idxs, 16 * (bb + 1), lane);
                    vaccum(A, out, wv, 16 * bb);
                    if (bb + 2 < 4) load_rows(A, V, idxs, 16 * (bb + 2), lane);
                    vaccum(B, out, wv, 16 * (bb + 1));
                }
            }
            const float* xr = F.out + t * 1024 + 16 * lane;
            const float* g2 = mods + ((size_t)layer * 16 + b) * 6144 + 5 * 1024 + 16 * lane;
            f32x4 x[4];
#pragma unroll
            for (int q = 0; q < 4; ++q) { const f32x4 gg = *(const f32x4*)(g2 + 4 * q);
                x[q] = *(const f32x4*)(xr + 4 * q) + gg * (f32x4){out[2 * q].x, out[2 * q].y, out[2 * q + 1].x, out[2 * q + 1].y}; *(f32x4*)(xout + t * 1024 + 16 * lane + 4 * q) = x[q]; }
            if (!LAST) {
                float ss = 0.f;
#pragma unroll
                for (int q = 0; q < 4; ++q) ss += (x[q][0] * x[q][0] + x[q][1] * x[q][1]) + (x[q][2] * x[q][2] + x[q][3] * x[q][3]);
                const float rstd = 1.0f / sqrtf(wave_sum(ss) * (1.0f / DM) + EPS);
                const float* m1 = mods + ((size_t)16 + b) * 6144 + 16 * lane;
                const float* kvm = (const float*)(F.ws + WS_KVMODS) + (size_t)b * 2048 + 16 * lane;
                unsigned ha[8], hb[8];
#pragma unroll
                for (int q = 0; q < 4; ++q) { const int c = 16 * lane + 4 * q;
                    const f32x4 gm = *(const f32x4*)(F.in[4] + 1024 + c), s1 = *(const f32x4*)(m1 + 1024 + 4 * q), h1 = *(const f32x4*)(m1 + 4 * q);
                    const f32x4 gk = *(const f32x4*)(F.in[13] + c), sk = *(const f32x4*)(kvm + 1024 + 4 * q), hk = *(const f32x4*)(kvm + 4 * q);
                    const f32x4 xn = x[q] * rstd;
                    const f32x4 ya = xn * gm * (s1 + 1.0f) + h1, yb = xn * gk * (sk + 1.0f) + hk;
                    ha[2 * q] = cvtpk(ya[0], ya[1]); ha[2 * q + 1] = cvtpk(ya[2], ya[3]); hb[2 * q] = cvtpk(yb[0], yb[1]); hb[2 * q + 1] = cvtpk(yb[2], yb[3]); }
                u32x4* pa = (u32x4*)((bf16*)(F.ws + WS_H) + t * 1024) + 2 * lane; u32x4* pb = (u32x4*)((bf16*)(F.ws + WS_HB) + t * 1024) + 2 * lane;
                pa[0] = (u32x4){ha[0], ha[1], ha[2], ha[3]}; pa[1] = (u32x4){ha[4], ha[5], ha[6], ha[7]};
                pb[0] = (u32x4){hb[0], hb[1], hb[2], hb[3]}; pb[1] = (u32x4){hb[4], hb[5], hb[6], hb[7]};
            }
        }
    }
}
#ifndef DUP
#define DUP -1
#endif
#ifndef PH_MASK
#define PH_MASK 0x3FFFF
#endif

#ifndef N_LAUNCH_MODE
#define N_LAUNCH_MODE 1
#endif
constexpr int NPH = 18;
template <class Epi> DI void run_gemm(Frame& F, const bf16* A, const bf16* Bt, int N, const Epi& E) {
    pg8::Gemm g{A, Bt, T_TOK, N, DM}; pg8::StaticOrder S; S.init(T_TOK, N, F.G, F.bid);
    pg8::gemm_phase<Epi, pg8::StaticOrder, true, true>(F.lds, g, S, E);
}
__global__ void __launch_bounds__(NT, 2) fwd(Args args) {
    extern __shared__ __attribute__((aligned(16))) unsigned char lds_raw[];
    cg::grid_group grid = cg::this_grid();
    Frame F;
    F.lds = (LAS unsigned char*)lds_raw;
#pragma unroll
    for (int i = 0; i < 23; ++i) F.in[i] = args.in[i];
    F.out = args.out; F.ws = args.ws;
    F.tid = threadIdx.x; F.lane = F.tid & 63; F.wave = __builtin_amdgcn_readfirstlane(F.tid >> 6); F.bid = blockIdx.x; F.G = gridDim.x;
    const int lo = args.ph_lo, hi = args.ph_hi;
#define IN(k) (lo <= (k) && (k) < hi)
#define SEAM(k) do { if (IN(k) && IN((k) + 1)) grid.sync(); } while (0)
    float* mods = (float*)(F.ws + WS_MODS);
    bf16* Hb = (bf16*)(F.ws + WS_H);
    if (((PH_MASK >> 0) & 1) && IN(0)) { p0_prologue(F); if (DUP == 0) { grid.sync(); p0_prologue(F); } } SEAM(0);
    if (((PH_MASK >> 1) & 1) && IN(1)) { norm_phase<true>(F, F.in[0], F.in[4], mods, mods + 1024, 6144, Hb); if (DUP == 1) { grid.sync(); norm_phase<true>(F, F.in[0], F.in[4], mods, mods + 1024, 6144, Hb); } } SEAM(1);
    if (((PH_MASK >> 2) & 1) && IN(2)) { pg8::EpiBf16<0> E{(bf16*)(F.ws + WS_PROJ), 3072, nullptr, 0, 0, 1.f}; run_gemm(F, Hb, (const bf16*)(F.ws + WS_WIN), 3072, E); if (DUP == 2) { grid.sync(); run_gemm(F, Hb, (const bf16*)(F.ws + WS_WIN), 3072, E); } } SEAM(2);
    if (((PH_MASK >> 3) & 1) && IN(3)) { p3_mlstm_local(F); if (DUP == 3) { grid.sync(); p3_mlstm_local(F); } } SEAM(3);
    if (((PH_MASK >> 4) & 1) && IN(4)) { p4_scan(F); } SEAM(4);
    if (((PH_MASK >> 5) & 1) && IN(5)) { p5_mlstm_out(F); if (DUP == 5) { grid.sync(); p5_mlstm_out(F); } } SEAM(5);
    if (((PH_MASK >> 6) & 1) && IN(6)) { pg8::EpiResid E{F.in[0], F.out, mods + 2 * 1024, 6144}; run_gemm(F, Hb, (const bf16*)(F.ws + WS_WOUT), 1024, E); } SEAM(6);
    if (((PH_MASK >> 7) & 1) && IN(7)) { norm_phase<false>(F, F.out, F.in[5], mods + 3 * 1024, mods + 4 * 1024, 6144, Hb); } SEAM(7);
    if (((PH_MASK >> 8) & 1) && IN(8)) { pg8::EpiBf16<0> E{(bf16*)(F.ws + WS_PQ), 2048, nullptr, 0, 0, 1.f}; run_gemm(F, Hb, (const bf16*)(F.ws + WS_WPQ), 2048, E); } SEAM(8);
    if (((PH_MASK >> 9) & 1) && IN(9)) { p_route(F, 0); if (DUP == 9) { grid.sync(); p_route(F, 0); } } SEAM(9);
    if (((PH_MASK >> 10) & 1) && IN(10)) { p_apply<false>(F, 0, F.out); if (DUP == 10) { grid.sync(); p_apply<true>(F, 0, (float*)(F.ws + WS_PROJ)); } } SEAM(10);
    if (((PH_MASK >> 11) & 1) && IN(11)) {
        { pg8::EpiHeadNorm E{(bf16*)(F.ws + WS_Q), (bf16*)(F.ws + WS_Q), 4, F.in[17], 0.125f, EPS}; run_gemm(F, Hb, (const bf16*)(F.ws + WS_WSQ), 1024, E); }
        { pg8::EpiHeadNorm E{(bf16*)(F.ws + WS_K), (bf16*)(F.ws + WS_VV), 4, F.in[15], 1.0f, EPS}; run_gemm(F, (const bf16*)(F.ws + WS_HB), (const bf16*)(F.ws + WS_WKV), 2048, E); }
    } SEAM(11);
    if (((PH_MASK >> 12) & 1) && IN(12)) { p12_attn(F); if (DUP == 12) { grid.sync(); p12_attn(F); } } SEAM(12);
    if (((PH_MASK >> 13) & 1) && IN(13)) { pg8::EpiResid E{F.out, F.out, mods + 16 * 6144 + 2 * 1024, 6144}; run_gemm(F, Hb, (const bf16*)(F.ws + WS_WSO), 1024, E); } SEAM(13);
    if (((PH_MASK >> 14) & 1) && IN(14)) { norm_phase<false>(F, F.out, F.in[5] + 1024, mods + 16 * 6144 + 3 * 1024, mods + 16 * 6144 + 4 * 1024, 6144, Hb); } SEAM(14);
    if (((PH_MASK >> 15) & 1) && IN(15)) { pg8::EpiBf16<0> E{(bf16*)(F.ws + WS_PQ), 2048, nullptr, 0, 0, 1.f}; run_gemm(F, Hb, (const bf16*)(F.ws + WS_WPQ) + (size_t)2048 * 1024, 2048, E); } SEAM(15);
    if (((PH_MASK >> 16) & 1) && IN(16)) { p_route(F, 1); } SEAM(16);
    if (((PH_MASK >> 17) & 1) && IN(17)) { p_apply<true>(F, 1, F.out); }
#undef IN
#undef SEAM
}

extern "C" void kernel_launch(void* const* d_in, const int* in_sizes, int n_in, void* d_out, int out_size, void* d_ws, size_t ws_size, hipStream_t stream) {
    static int grid = 0;
    if (grid == 0) {
        int dev = 0, cus = 0, per_cu = 0;
        (void)hipGetDevice(&dev);
        (void)hipDeviceGetAttribute(&cus, hipDeviceAttributeMultiprocessorCount, dev);
        (void)hipFuncSetAttribute((const void*)fwd, hipFuncAttributeMaxDynamicSharedMemorySize, LDS_BYTES);
        (void)hipOccupancyMaxActiveBlocksPerMultiprocessor(&per_cu, (const void*)fwd, NT, LDS_BYTES);
        if (per_cu < 1) { fprintf(stderr, "kernel_launch: occupancy query says %d blocks per CU\n", per_cu); per_cu = 1; }
        grid = cus;
        if (n_in != 23 || ws_size < WS_END) fprintf(stderr, "kernel_launch: unexpected n_in %d / ws_size %zu\n", n_in, ws_size);
        (void)hipGetLastError();
    }
    Args a{};
    for (int i = 0; i < 23; ++i) a.in[i] = (const float*)d_in[i];
    a.out = (float*)d_out; a.ws = (unsigned char*)d_ws;
#if N_LAUNCH_MODE == 1
    a.ph_lo = 0; a.ph_hi = NPH;
    void* kargs[] = {&a};
    hipError_t e = hipLaunchCooperativeKernel((const void*)fwd, dim3(grid), dim3(NT), kargs, LDS_BYTES, stream);
    if (e != hipSuccess) fprintf(stderr, "kernel_launch: cooperative launch failed: %s (grid %d)\n", hipGetErrorString(e), grid);
#else
    for (int p = 0; p < NPH; ++p) { a.ph_lo = p; a.ph_hi = p + 1; hipLaunchKernelGGL(fwd, dim3(grid), dim3(NT), LDS_BYTES, stream, a); }
#endif
}
```

```cpp
#include <hip/hip_runtime.h>
#include <hip/hip_cooperative_groups.h>
#include <cstdio>
#include <cstdint>
namespace cg = cooperative_groups;
#define N_LAUNCH_MODE 1
namespace pg8 {
#define PG8_LAS __attribute__((address_space(3)))
typedef unsigned short bf16_t;
typedef short bf16x8 __attribute__((ext_vector_type(8)));
typedef float f32x4 __attribute__((ext_vector_type(4)));
typedef unsigned u32x4 __attribute__((ext_vector_type(4)));
constexpr int BM = 256, BK = 64, HALF = 128, HTB = HALF * BK * 2  , STAGE_BYTES = 8 * HTB, NXCD = 8, WGM = 8;

__host__ __device__ __forceinline__ int lds_byte(int r, int c) { const int st = (r >> 4) * 2 + (c >> 5), rr = r & 15, cc = c & 31, ob = rr * 64 + cc * 2; return st * 1024 + (ob ^ (((ob >> 9) & 1) << 5)); }
__host__ __device__ __forceinline__ void stage_rc(int b, int& R, int& C) { const int st = b / 1024, sb = b % 1024, swz = sb ^ (((sb >> 9) & 1) << 5); R = (st >> 1) * 16 + swz / 64; C = (st & 1) * 32 + (swz % 64) / 2; }
__host__ __device__ __forceinline__ int perm32(int rho) { const int n = rho >> 4, i = rho & 15; return 8 * (i >> 2) + 4 * n + (i & 3); }

struct Unit { int pm, pn; };
struct Gemm { const bf16_t* A; const bf16_t* Bt; int M, N, K; };

struct StaticOrder {
    int nM, nN, nwg, G, c;
    __host__ __device__ void init(int M, int N, int G_, int c_) { nM = M / BM; nN = N / BM; nwg = nM * nN; G = G_; c = c_; }
    __host__ __device__ bool next(int i, Unit& u) const {
        const long L = (long)i * G + c; if (L >= nwg) return false;
        int wgid = (int)L; { const int q = nwg / NXCD, r = nwg % NXCD, xcd = wgid % NXCD, off = wgid / NXCD; wgid = (xcd < r ? xcd * (q + 1) : r * (q + 1) + (xcd - r) * q) + off; }
        const int nig = WGM * nN, gid = wgid / nig, fm = gid * WGM, gsz = (nM - fm) < WGM ? (nM - fm) : WGM;
        u.pm = fm + ((wgid % nig) % gsz); u.pn = (wgid % nig) / gsz; return true;
    }
    __device__ __forceinline__ void a_ready(const Unit&) const {}
    __device__ __forceinline__ void done(const Unit&) const {}
};

__device__ __forceinline__ unsigned cvt_pk_bf16(float lo, float hi) { unsigned r; asm volatile("v_cvt_pk_bf16_f32 %0, %1, %2" : "=v"(r) : "v"(lo), "v"(hi)); return r; }
typedef float f32x2 __attribute__((ext_vector_type(2)));
__device__ __forceinline__ f32x2 gelu_pk(f32x2 v) {
    const f32x2 av = __builtin_elementwise_abs(v), d = av * 0.2316418882f + 1.0f;
    f32x2 t; t.x = __builtin_amdgcn_rcpf(d.x); t.y = __builtin_amdgcn_rcpf(d.y);
    f32x2 q = t * 0.5307027145f + (-0.7265760135f); q = q * t + 0.7107068705f; q = q * t + (-0.142248368f); q = q * t + 0.127414796f; q = q * t;
    const f32x2 s = (v * v) * (-0.72134752044f);
    f32x2 e; e.x = __builtin_amdgcn_exp2f(s.x); e.y = __builtin_amdgcn_exp2f(s.y);
    const f32x2 m = v * (q * e), r = v - m;
    f32x2 o; o.x = v.x < 0.f ? m.x : r.x; o.y = v.y < 0.f ? m.y : r.y; return o;
}

template <int ACT  > struct EpiBf16 {
    static constexpr bool PERM = true, AFTER_DRAIN = false; static_assert(ACT == 0 || ACT == 1, "EpiBf16: ACT is 0 (none) or 1 (gelu_pk)");
    bf16_t* O; int ldc; const float* bias; int split_cols; size_t split_stride; float scale0;
    __device__ __forceinline__ void operator()(const f32x4 (&acc)[2][2][4][2], const Unit& u, int wr, int wc, int fr, int fq) const {
        const int row0 = u.pm * BM + wr * 64 + fr; int colt = u.pn * BM; bf16_t* base = O;
        float sc = 1.f; if (split_cols) { const int t = colt / split_cols; base += (size_t)t * split_stride; colt -= t * split_cols; if (t == 0) sc = scale0; }
        const int col0 = colt + wc * 32 + 8 * fq, bcol0 = u.pn * BM + wc * 32 + 8 * fq;
        f32x4 bv[2][2];
#pragma unroll
        for (int bj = 0; bj < 2; ++bj)
#pragma unroll
            for (int n = 0; n < 2; ++n) bv[bj][n] = bias ? *(const f32x4*)(bias + bcol0 + bj * HALF + 4 * n) : (f32x4){0.f, 0.f, 0.f, 0.f};
#pragma unroll
        for (int ai = 0; ai < 2; ++ai)
#pragma unroll
            for (int m = 0; m < 4; ++m) { bf16_t* rowp = base + (size_t)(row0 + ai * HALF + m * 16) * ldc + col0;
#pragma unroll
                for (int bj = 0; bj < 2; ++bj) { f32x4 v0 = acc[ai][bj][m][0] + bv[bj][0], v1 = acc[ai][bj][m][1] + bv[bj][1];
                    if (ACT == 1) { f32x2 a = gelu_pk((f32x2){v0[0], v0[1]}), b = gelu_pk((f32x2){v0[2], v0[3]}), c = gelu_pk((f32x2){v1[0], v1[1]}), d = gelu_pk((f32x2){v1[2], v1[3]});
                        v0 = (f32x4){a.x, a.y, b.x, b.y}; v1 = (f32x4){c.x, c.y, d.x, d.y}; }
                    v0 = v0 * sc; v1 = v1 * sc; u32x4 w; w.x = cvt_pk_bf16(v0[0], v0[1]); w.y = cvt_pk_bf16(v0[2], v0[3]); w.z = cvt_pk_bf16(v1[0], v1[1]); w.w = cvt_pk_bf16(v1[2], v1[3]);
                    *(u32x4*)(rowp + bj * HALF) = w; } }
    }
};
struct EpiResid {
    static constexpr bool PERM = false, AFTER_DRAIN = false;
    const float* base; float* out; const float* gate; int gstride;
    __device__ __forceinline__ void operator()(const f32x4 (&acc)[2][2][4][2], const Unit& u, int wr, int wc, int fr, int fq) const {
        const int col0 = u.pn * BM + wc * 32 + 4 * fq;
        const int b = (u.pm * BM) >> 11;
        f32x4 gv[2][2];
#pragma unroll
        for (int bj = 0; bj < 2; ++bj)
#pragma unroll
            for (int n = 0; n < 2; ++n) gv[bj][n] = *(const f32x4*)(gate + (size_t)b * gstride + col0 + bj * HALF + n * 16);
#pragma unroll
        for (int ai = 0; ai < 2; ++ai)
#pragma unroll
            for (int m = 0; m < 4; ++m) { const size_t off = (size_t)(u.pm * BM + ai * HALF + wr * 64 + m * 16 + fr) * 1024 + col0;
#pragma unroll
                for (int bj = 0; bj < 2; ++bj)
#pragma unroll
                    for (int n = 0; n < 2; ++n) { const f32x4 bs = *(const f32x4*)(base + off + bj * HALF + n * 16);
                        *(f32x4*)(out + off + bj * HALF + n * 16) = bs + gv[bj][n] * acc[ai][bj][m][n]; }
                if (m & 1) asm volatile("" ::: "memory"); }
    }
};
struct EpiHeadNorm {
    static constexpr bool PERM = true, AFTER_DRAIN = false;
    bf16_t* O0; bf16_t* O1; int ntile_norm; const float* g; float scale; float eps;
    __device__ __forceinline__ void operator()(const f32x4 (&acc)[2][2][4][2], const Unit& u, int wr, int wc, int fr, int fq) const {
        const bool nrm = u.pn < ntile_norm; bf16_t* O = nrm ? O0 : O1; const int pnl = nrm ? u.pn : u.pn - ntile_norm;
        f32x4 gv[2][2];
#pragma unroll
        for (int bj = 0; bj < 2; ++bj)
#pragma unroll
            for (int n = 0; n < 2; ++n) { const f32x4 t = *(const f32x4*)(g + 32 * bj + 8 * fq + 4 * n); gv[bj][n] = nrm ? t * scale : (f32x4){1.f, 1.f, 1.f, 1.f}; }
#pragma unroll
        for (int ai = 0; ai < 2; ++ai)
#pragma unroll
            for (int m = 0; m < 4; ++m) {
                float ss = 0.f;
#pragma unroll
                for (int bj = 0; bj < 2; ++bj)
#pragma unroll
                    for (int n = 0; n < 2; ++n) { const f32x4 x = acc[ai][bj][m][n]; ss += (x[0] * x[0] + x[1] * x[1]) + (x[2] * x[2] + x[3] * x[3]); }
                ss += __shfl_xor(ss, 16); ss += __shfl_xor(ss, 32);
                const float rs = nrm ? 1.0f / sqrtf(ss * (1.0f / 64.0f) + eps) : 1.0f;
                bf16_t* rowp = O + (size_t)(u.pm * BM + ai * HALF + wr * 64 + m * 16 + fr) * 1024 + pnl * BM + wc * 64 + 8 * fq;
#pragma unroll
                for (int bj = 0; bj < 2; ++bj) { const f32x4 v0 = acc[ai][bj][m][0] * rs * gv[bj][0], v1 = acc[ai][bj][m][1] * rs * gv[bj][1];
                    u32x4 w; w.x = cvt_pk_bf16(v0[0], v0[1]); w.y = cvt_pk_bf16(v0[2], v0[3]); w.z = cvt_pk_bf16(v1[0], v1[1]); w.w = cvt_pk_bf16(v1[2], v1[3]);
                    *(u32x4*)(rowp + bj * 32) = w; }
            }
    }
};
template <class Epi, class Sched, bool ALIGN_EPI = false, bool SP2 = false>
__device__ __forceinline__ void gemm_phase(PG8_LAS unsigned char* lds, const Gemm g, const Sched& S, const Epi& E) {
    const int tid = threadIdx.x, wid = __builtin_amdgcn_readfirstlane(tid >> 6), lane = tid & 63, wr = wid >> 2, wc = wid & 3, fr = lane & 15, fq = lane >> 4;
    const int K = g.K, nt = K / BK;
    unsigned voffA[2], voffB[2];
#pragma unroll
    for (int i = 0; i < 2; ++i) { int R, C; stage_rc(tid * 16 + i * 8192, R, C); const int Rb = Epi::PERM ? ((R & ~31) + perm32(R & 31)) : R;
        voffA[i] = (unsigned)(R * K + C) * 2u; voffB[i] = (unsigned)(Rb * K + C) * 2u; }
    const size_t kstep = (size_t)(BK * 2);
    const size_t hstep = (size_t)HALF * K * 2;
    const size_t tstep = 2 * hstep;
    const unsigned ldsw = (unsigned)wid * 1024u;
    const int aoff = lds_byte(wr * 64 + fr, fq * 8), boff = lds_byte(wc * 32 + fr, fq * 8);
#define PG8_SA(b, h) (((b) * 2 + (h)) * HTB)
#define PG8_SB(b, h) ((4 + (b) * 2 + (h)) * HTB)
#define PG8_STAGE(bufoff, gbase, voff) do { _Pragma("unroll") for (int _i = 0; _i < 2; ++_i) \
        __builtin_amdgcn_global_load_lds((const unsigned*)((const char*)(gbase) + (voff)[_i]), (PG8_LAS unsigned*)(lds + (bufoff) + ldsw + _i * 8192), 16, 0, 0); } while (0)
#define PG8_LDA(dst, b, h) do { _Pragma("unroll") for (int m = 0; m < 4; ++m) _Pragma("unroll") for (int k = 0; k < 2; ++k) dst[m][k] = *(const PG8_LAS bf16x8*)(lds + PG8_SA(b, h) + aoff + m * 2048 + k * 1024); } while (0)
#define PG8_LDB(dst, b, h) do { _Pragma("unroll") for (int n = 0; n < 2; ++n) _Pragma("unroll") for (int k = 0; k < 2; ++k) dst[n][k] = *(const PG8_LAS bf16x8*)(lds + PG8_SB(b, h) + boff + n * 2048 + k * 1024); } while (0)
#define PG8_MMA(ai, bj, At, Bt) do { __builtin_amdgcn_s_setprio(1); _Pragma("unroll") for (int m = 0; m < 4; ++m) _Pragma("unroll") for (int n = 0; n < 2; ++n) _Pragma("unroll") for (int k = 0; k < 2; ++k) \
        acc[ai][bj][m][n] = __builtin_amdgcn_mfma_f32_16x16x32_bf16(Bt[n][k], At[m][k], acc[ai][bj][m][n], 0, 0, 0); __builtin_amdgcn_s_setprio(0); } while (0)
#define PG8_WAIT_V(n) asm volatile("s_waitcnt vmcnt(" #n ")" ::: "memory")
#define PG8_WAIT_L(n) asm volatile("s_waitcnt lgkmcnt(" #n ")" ::: "memory")
#define PG8_BAR __builtin_amdgcn_s_barrier()
#define PG8_SCHED __builtin_amdgcn_sched_barrier(0)
    Unit cur, nxt; int ui = 0;
    if (!S.next(0, cur)) return;
    f32x4 acc[2][2][4][2];
#pragma unroll
    for (int a = 0; a < 2; ++a)
#pragma unroll
        for (int b = 0; b < 2; ++b)
#pragma unroll
            for (int m = 0; m < 4; ++m)
#pragma unroll
                for (int n = 0; n < 2; ++n) acc[a][b][m][n] = (f32x4){0.f, 0.f, 0.f, 0.f};
    bf16x8 At[4][2], B0[2][2], B1[2][2];
    const char* cA = (const char*)g.A + (size_t)cur.pm * tstep; const char* cB = (const char*)g.Bt + (size_t)cur.pn * tstep;
    S.a_ready(cur);
    if constexpr (SP2) {
        PG8_STAGE(PG8_SB(0, 0), cB, voffB); PG8_STAGE(PG8_SB(0, 1), cB + hstep, voffB); PG8_STAGE(PG8_SA(0, 0), cA, voffA); PG8_STAGE(PG8_SA(0, 1), cA + hstep, voffA);
        if (wr == 1) PG8_BAR;
        PG8_WAIT_V(2); PG8_BAR;
        PG8_STAGE(PG8_SB(1, 0), cB + kstep, voffB); PG8_STAGE(PG8_SA(1, 0), cA + kstep, voffA); PG8_STAGE(PG8_SB(1, 1), cB + hstep + kstep, voffB);
        PG8_WAIT_V(6); PG8_BAR;
    } else {
        PG8_STAGE(PG8_SB(0, 0), cB, voffB); PG8_STAGE(PG8_SA(0, 0), cA, voffA); PG8_STAGE(PG8_SB(0, 1), cB + hstep, voffB); PG8_STAGE(PG8_SA(0, 1), cA + hstep, voffA);
        if (wr == 1) PG8_BAR;
        PG8_WAIT_V(4); PG8_BAR;
        PG8_STAGE(PG8_SB(1, 0), cB + kstep, voffB); PG8_STAGE(PG8_SA(1, 0), cA + kstep, voffA); PG8_STAGE(PG8_SB(1, 1), cB + hstep + kstep, voffB);
        PG8_WAIT_V(6); PG8_BAR;
    }
    for (;;) {
        const bool has_next = S.next(ui + 1, nxt);
        const char* nA = has_next ? (const char*)g.A + (size_t)nxt.pm * tstep : cA; const char* nB = has_next ? (const char*)g.Bt + (size_t)nxt.pn * tstep : cB;
        for (int t = 0; t < nt; t += 2) {
            const bool last = (t == nt - 2);
            const char* a1 = cA + (size_t)(t + 1) * kstep;
            const char* a2 = last ? nA : cA + (size_t)(t + 2) * kstep; const char* b2 = last ? nB : cB + (size_t)(t + 2) * kstep;
            const char* a3 = a2 + kstep; const char* b3 = b2 + kstep;
            if (last && has_next) S.a_ready(nxt);
            if constexpr (SP2) {
            PG8_LDB(B0, 0, 0); PG8_LDB(B1, 0, 1); PG8_SCHED; PG8_LDA(At, 0, 0); PG8_STAGE(PG8_SA(1, 1), a1 + hstep, voffA);
            PG8_WAIT_V(8); PG8_WAIT_L(0); PG8_BAR; PG8_MMA(0, 0, At, B0); PG8_MMA(0, 1, At, B1); PG8_BAR; PG8_SCHED;
            PG8_LDA(At, 0, 1); PG8_STAGE(PG8_SB(0, 0), b2, voffB); PG8_STAGE(PG8_SB(0, 1), b2 + hstep, voffB); PG8_STAGE(PG8_SA(0, 0), a2, voffA);
            PG8_WAIT_V(8); PG8_WAIT_L(0); PG8_BAR; PG8_MMA(1, 0, At, B0); PG8_MMA(1, 1, At, B1); PG8_BAR; PG8_SCHED;
            PG8_LDB(B0, 1, 0); PG8_LDB(B1, 1, 1); PG8_SCHED; PG8_LDA(At, 1, 0); PG8_STAGE(PG8_SA(0, 1), a2 + hstep, voffA);
            PG8_WAIT_V(8); PG8_WAIT_L(0); PG8_BAR; PG8_MMA(0, 0, At, B0); PG8_MMA(0, 1, At, B1); PG8_BAR; PG8_SCHED;
            PG8_LDA(At, 1, 1); PG8_STAGE(PG8_SB(1, 0), b3, voffB); PG8_STAGE(PG8_SB(1, 1), b3 + hstep, voffB); PG8_STAGE(PG8_SA(1, 0), a3, voffA);
            PG8_WAIT_V(8); PG8_WAIT_L(0); PG8_BAR; PG8_MMA(1, 0, At, B0); PG8_MMA(1, 1, At, B1); PG8_BAR; PG8_SCHED;
            } else {
            PG8_LDB(B0, 0, 0); PG8_SCHED; PG8_LDA(At, 0, 0); PG8_STAGE(PG8_SA(1, 1), a1 + hstep, voffA);
            PG8_WAIT_L(8); PG8_BAR; PG8_WAIT_L(0); PG8_MMA(0, 0, At, B0); PG8_BAR; PG8_SCHED;
            PG8_LDB(B1, 0, 1); PG8_STAGE(PG8_SB(0, 0), b2, voffB);
            PG8_BAR; PG8_WAIT_L(0); PG8_MMA(0, 1, At, B1); PG8_BAR;
            PG8_LDA(At, 0, 1); PG8_STAGE(PG8_SA(0, 0), a2, voffA);
            PG8_BAR; PG8_WAIT_L(0); PG8_MMA(1, 0, At, B0); PG8_BAR; PG8_SCHED;
            PG8_STAGE(PG8_SB(0, 1), b2 + hstep, voffB);
            PG8_WAIT_V(6); PG8_BAR; PG8_MMA(1, 1, At, B1); PG8_BAR;
            PG8_LDB(B0, 1, 0); PG8_SCHED; PG8_LDA(At, 1, 0); PG8_STAGE(PG8_SA(0, 1), a2 + hstep, voffA);
            PG8_WAIT_L(8); PG8_BAR; PG8_WAIT_L(0); PG8_MMA(0, 0, At, B0); PG8_BAR; PG8_SCHED;
            PG8_LDB(B1, 1, 1); PG8_STAGE(PG8_SB(1, 0), b3, voffB);
            PG8_BAR; PG8_WAIT_L(0); PG8_MMA(0, 1, At, B1); PG8_BAR;
            PG8_LDA(At, 1, 1); PG8_STAGE(PG8_SA(1, 0), a3, voffA);
            PG8_BAR; PG8_WAIT_L(0); PG8_MMA(1, 0, At, B0); PG8_BAR; PG8_SCHED;
            PG8_STAGE(PG8_SB(1, 1), b3 + hstep, voffB);
            PG8_WAIT_V(6); PG8_BAR; PG8_MMA(1, 1, At, B1); PG8_BAR;
            }
        }
        if constexpr (ALIGN_EPI) { if (wr == 0) PG8_BAR; }
        if constexpr (!Epi::AFTER_DRAIN) { E(acc, cur, wr, wc, fr, fq); S.done(cur); }
        if (!has_next) break;
#pragma unroll
        for (int a = 0; a < 2; ++a)
#pragma unroll
            for (int b = 0; b < 2; ++b)
#pragma unroll
                for (int m = 0; m < 4; ++m)
#pragma unroll
                    for (int n = 0; n < 2; ++n) acc[a][b][m][n] = (f32x4){0.f, 0.f, 0.f, 0.f};
        cur = nxt; cA = nA; cB = nB; ++ui;
        if constexpr (ALIGN_EPI) { if (wr == 1) PG8_BAR; }
    }
    PG8_WAIT_V(0);
    if constexpr (!ALIGN_EPI) { if (wr == 0) PG8_BAR; }
    PG8_BAR;
    if constexpr (Epi::AFTER_DRAIN) { E.fused(acc, cur, wr, wc, fr, fq, lds, wid, lane); S.done(cur); }
#undef PG8_SA
#undef PG8_SB
#undef PG8_STAGE
#undef PG8_LDA
#undef PG8_LDB
#undef PG8_MMA
#undef PG8_WAIT_V
#undef PG8_WAIT_L
#undef PG8_BAR
#undef PG8_SCHED
}
}

#define DI __device__ __forceinline__
#define LAS __attribute__((address_space(3)))
typedef unsigned short bf16;
typedef __bf16 bf16x2_t __attribute__((ext_vector_type(2)));
typedef float f32x2_t __attribute__((ext_vector_type(2)));
typedef float f32x4 __attribute__((ext_vector_type(4)));
typedef float f32x16 __attribute__((ext_vector_type(16)));
typedef short bf16x8 __attribute__((ext_vector_type(8)));
typedef short s16x4 __attribute__((ext_vector_type(4)));
typedef unsigned u32x4 __attribute__((ext_vector_type(4)));
typedef unsigned u32x2 __attribute__((ext_vector_type(2)));

constexpr int NT = 512, NWAVES = 8;
constexpr int LDS_BYTES = 147456;
constexpr int T_TOK = 32768, DM = 1024, SEQ = 2048, NB = 16;
constexpr float EPS = 1e-6f;
constexpr size_t MiB = 1u << 20;
constexpr size_t WS_MODS = 1 * MiB, WS_KVMODS = WS_MODS + (size_t)2 * 16 * 6144 * 4;
constexpr size_t WS_GATES = 2 * MiB, WS_BLAST = 4 * MiB, WS_MLOC = 4 * MiB + 65536, WS_MPREV = 4 * MiB + 131072, WS_NLOC = 5 * MiB;
constexpr size_t WS_WG = 6 * MiB, WS_SUBK = 7 * MiB;
constexpr size_t WS_WIN = 8 * MiB, WS_WOUT = 14 * MiB, WS_WKV = 16 * MiB, WS_WSQ = 20 * MiB, WS_WSO = 22 * MiB, WS_WPQ = 24 * MiB;
constexpr size_t WS_IDX = 36 * MiB, WS_GATE = 44 * MiB;
constexpr size_t WS_U = 64 * MiB, WS_V = 128 * MiB, WS_H = 192 * MiB, WS_HB = 256 * MiB, WS_PROJ = 320 * MiB, WS_END = 512 * MiB;
constexpr size_t WS_CST = WS_HB;
constexpr size_t WS_Q = WS_PROJ, WS_K = WS_PROJ + 64 * MiB, WS_VV = WS_PROJ + 128 * MiB, WS_PQ = WS_PROJ;

struct Args { const float* in[23]; float* out; unsigned char* ws; int ph_lo, ph_hi; };
struct Frame {
    LAS unsigned char* lds;
    const float* in[23]; float* out; unsigned char* ws;
    int tid, lane, wave, bid, G;
};

DI unsigned cvtpk(float lo, float hi) { f32x2_t v = {lo, hi}; bf16x2_t b = __builtin_convertvector(v, bf16x2_t); return __builtin_bit_cast(unsigned, b); }
DI float bflo(unsigned u) { return __uint_as_float(u << 16); }
DI float bfhi(unsigned u) { return __uint_as_float(u & 0xffff0000u); }
DI float wave_sum(float v) {
#pragma unroll
    for (int o = 1; o < 64; o <<= 1) v += __shfl_xor(v, o);
    return v;
}
DI float wave_max(float v) {
#pragma unroll
    for (int o = 1; o < 64; o <<= 1) v = fmaxf(v, __shfl_xor(v, o));
    return v;
}
DI int crow(int r, int hi) { return (r & 3) + 8 * (r >> 2) + 4 * hi; }
#define MFMA32(a, b, c) __builtin_amdgcn_mfma_f32_32x32x16_bf16((a), (b), (c), 0, 0, 0)
typedef short v4i16_t __attribute__((ext_vector_type(4)));
DI s16x4 tr16(const LAS unsigned char* p) { return __builtin_bit_cast(s16x4, __builtin_amdgcn_ds_read_tr16_b64_v4i16((LAS v4i16_t*)p)); }
DI int tr_off(int tok, int ch) { return (ch >> 2) * 4096 + (tok >> 4) * 1024 + (tok & 15) * 64 + (ch & 3) * 16; }
DI bf16x8 tr_frag(const LAS unsigned char* img, int dh, int ks, int lane) {
    const int hi = lane >> 5; const int vb = ((lane >> 4) & 1) * 32 + (lane & 3) * 8 + (4 * hi + ((lane & 15) >> 2)) * 64;
    const s16x4 lo = tr16(img + vb + dh * 4096 + ks * 1024), h2 = tr16(img + vb + dh * 4096 + ks * 1024 + 512);
    return __builtin_shufflevector(lo, h2, 0, 1, 2, 3, 4, 5, 6, 7);
}
template <int NTOK> DI bf16x8 row_frag(const LAS unsigned char* img, int tt, int ks, int lane) {
    const int hi = lane >> 5, r32 = lane & 31;
    return *(const LAS bf16x8*)(img + (2 * ks + hi) * (NTOK * 16) + (32 * tt + r32) * 16);
}
DI bf16x8 pack8(const f32x16& x, int s) {
    u32x4 p; p.x = cvtpk(x[8 * s], x[8 * s + 1]); p.y = cvtpk(x[8 * s + 2], x[8 * s + 3]); p.z = cvtpk(x[8 * s + 4], x[8 * s + 5]); p.w = cvtpk(x[8 * s + 6], x[8 * s + 7]);
    return __builtin_bit_cast(bf16x8, p);
}

DI void p0_ada(Frame& F) {
    LAS float* sil = (LAS float*)F.lds;
    LAS float* red = (LAS float*)(F.lds + 65536);
    const float* c = F.in[1];
    for (int i = F.tid; i < 16 * 1024; i += NT) { const int b = i >> 10, d = i & 1023; const float v = c[i]; sil[d * 16 + b] = v / (1.f + expf(-v)); }
    __syncthreads();
    for (int item = F.bid; item < 224; item += F.G) {
        const float* W; const float* bias; float* out; int N, col0;
        if (item < 192) { const int layer = item / 96, it = item % 96; W = F.in[2] + (size_t)layer * 1024 * 6144; bias = F.in[3] + layer * 6144; N = 6144; col0 = it * 64; out = (float*)(F.ws + WS_MODS) + (size_t)layer * 16 * 6144; }
        else { const int it = item - 192; W = F.in[11]; bias = F.in[12]; N = 2048; col0 = it * 64; out = (float*)(F.ws + WS_KVMODS); }
        float acc[16];
#pragma unroll
        for (int b = 0; b < 16; ++b) acc[b] = 0.f;
        const int d0 = F.wave * 128;
        const float* wp = W + (size_t)d0 * N + col0 + F.lane;
#pragma unroll 4
        for (int d = 0; d < 128; ++d) {
            const float w = wp[(size_t)d * N];
            const LAS f32x4* s4 = (const LAS f32x4*)(sil + (d0 + d) * 16);
            const f32x4 s0 = s4[0], s1 = s4[1], s2 = s4[2], s3 = s4[3];
            acc[0] += w * s0[0]; acc[1] += w * s0[1]; acc[2] += w * s0[2]; acc[3] += w * s0[3];
            acc[4] += w * s1[0]; acc[5] += w * s1[1]; acc[6] += w * s1[2]; acc[7] += w * s1[3];
            acc[8] += w * s2[0]; acc[9] += w * s2[1]; acc[10] += w * s2[2]; acc[11] += w * s2[3];
            acc[12] += w * s3[0]; acc[13] += w * s3[1]; acc[14] += w * s3[2]; acc[15] += w * s3[3];
        }
#pragma unroll
        for (int b = 0; b < 16; ++b) red[(F.wave * 16 + b) * 64 + F.lane] = acc[b];
        __syncthreads();
        for (int i = F.tid; i < 1024; i += NT) { const int b = i >> 6, l = i & 63; float s = 0.f;
#pragma unroll
            for (int w = 0; w < 8; ++w) s += red[(w * 16 + b) * 64 + l];
            out[(size_t)b * N + col0 + l] = s + bias[col0 + l]; }
        __syncthreads();
    }
}
DI void transpose_item(const float* W, int ldw, bf16* WT, int dst_row0, LAS float* scr, int k0, int n0, int lane) {
#pragma unroll 8
    for (int i = 0; i < 32; ++i) { const int kk = 2 * i + (lane >> 5); scr[kk * 33 + (lane & 31)] = W[(size_t)(k0 + kk) * ldw + n0 + (lane & 31)]; }
    asm volatile("s_waitcnt lgkmcnt(0)" ::: "memory");
    const int c = lane & 7;
#pragma unroll
    for (int j = 0; j < 4; ++j) { const int n = (lane >> 3) + 8 * j; const LAS float* s = scr + (8 * c) * 33 + n;
        u32x4 o; o.x = cvtpk(s[0 * 33], s[1 * 33]); o.y = cvtpk(s[2 * 33], s[3 * 33]); o.z = cvtpk(s[4 * 33], s[5 * 33]); o.w = cvtpk(s[6 * 33], s[7 * 33]);
        *(u32x4*)(WT + (size_t)(dst_row0 + n) * 1024 + k0 + 8 * c) = o; }
    asm volatile("s_waitcnt lgkmcnt(0)" ::: "memory");
}
DI int permrow(int c) { return (c & ~255) + 32 * (4 * ((c >> 5) & 1) + ((c >> 6) & 3)) + (c & 31); }
DI void p0_prologue(Frame& F) {
    p0_ada(F);
    LAS float* scr = (LAS float*)(F.lds + F.wave * 16384);
    const int gw = F.bid * NWAVES + F.wave, NGW = F.G * NWAVES;
    for (int it = gw; it < 6144; it += NGW) {
        int r = it; const float* W; int ldw, ncols; bf16* dst; bool perm;
        if (r < 1536) { W = F.in[6]; ldw = 3088; ncols = 3072; dst = (bf16*)(F.ws + WS_WIN); perm = false; }
        else if ((r -= 1536) < 512) { W = F.in[10]; ldw = 1024; ncols = 1024; dst = (bf16*)(F.ws + WS_WOUT); perm = false; }
        else if ((r -= 512) < 1024) { W = F.in[14]; ldw = 2048; ncols = 2048; dst = (bf16*)(F.ws + WS_WKV); perm = true; }
        else if ((r -= 1024) < 512) { W = F.in[16]; ldw = 1024; ncols = 1024; dst = (bf16*)(F.ws + WS_WSQ); perm = true; }
        else if ((r -= 512) < 512) { W = F.in[18]; ldw = 1024; ncols = 1024; dst = (bf16*)(F.ws + WS_WSO); perm = false; }
        else if ((r -= 512) < 1024) { W = F.in[19]; ldw = 2048; ncols = 2048; dst = (bf16*)(F.ws + WS_WPQ); perm = false; }
        else { r -= 1024; W = F.in[19] + (size_t)1024 * 2048; ldw = 2048; ncols = 2048; dst = (bf16*)(F.ws + WS_WPQ) + (size_t)2048 * 1024; perm = false; }
        const int nblk = ncols / 32, kb = r / nblk, nb = r % nblk, n0 = 32 * nb;
        transpose_item(W, ldw, dst, perm ? permrow(n0) : n0, scr, 64 * kb, n0, F.lane);
    }
    const size_t gt = (size_t)F.bid * NT + F.tid, NGT = (size_t)F.G * NT;
    constexpr size_t TBL16 = (size_t)2 * 16384 * 1024 / 16;
    for (size_t i = gt; i < 2 * TBL16; i += NGT) {
        const bool isv = i >= TBL16; const size_t j = isv ? i - TBL16 : i; const float sc = isv ? 4.f : 32.f;
        const f32x4* src = (const f32x4*)(isv ? F.in[22] : F.in[21]) + 4 * j;
        const f32x4 a = src[0] * sc, b = src[1] * sc, c2 = src[2] * sc, d = src[3] * sc;
        int p0 = 0, p1 = 0, p2 = 0, p3 = 0;
        p0 = __builtin_amdgcn_cvt_pk_fp8_f32(a[0], a[1], p0, false); p0 = __builtin_amdgcn_cvt_pk_fp8_f32(a[2], a[3], p0, true);
        p1 = __builtin_amdgcn_cvt_pk_fp8_f32(b[0], b[1], p1, false); p1 = __builtin_amdgcn_cvt_pk_fp8_f32(b[2], b[3], p1, true);
        p2 = __builtin_amdgcn_cvt_pk_fp8_f32(c2[0], c2[1], p2, false); p2 = __builtin_amdgcn_cvt_pk_fp8_f32(c2[2], c2[3], p2, true);
        p3 = __builtin_amdgcn_cvt_pk_fp8_f32(d[0], d[1], p3, false); p3 = __builtin_amdgcn_cvt_pk_fp8_f32(d[2], d[3], p3, true);
        ((u32x4*)(F.ws + (isv ? WS_V : WS_U)))[j] = (u32x4){(unsigned)p0, (unsigned)p1, (unsigned)p2, (unsigned)p3};
    }
    for (size_t i = gt; i < 65536 / 2; i += NGT) { const float a = F.in[20][2 * i], b = F.in[20][2 * i + 1]; ((unsigned*)(F.ws + WS_SUBK))[i] = cvtpk(a, b); }
    for (size_t i = gt; i < 16 * 1024; i += NGT) { const int g = (int)(i >> 10), k = (int)(i & 1023); ((float*)(F.ws + WS_WG))[i] = F.in[6][(size_t)k * 3088 + 3072 + g]; }
}

template <bool GATES> DI void norm_phase(Frame& F, const float* xin, const float* g, const float* shp, const float* scp, int bstride, bf16* hout) {
    const int gw = F.bid * NWAVES + F.wave, NGW = F.G * NWAVES;
    LAS float* wg = (LAS float*)F.lds;
    if (GATES) { const float* src = (const float*)(F.ws + WS_WG); for (int i = F.tid; i < 16 * 1024 / 4; i += NT) ((LAS f32x4*)wg)[i] = ((const f32x4*)src)[i]; __syncthreads(); }
    for (int chunk = gw; chunk < T_TOK / 16; chunk += NGW) {
        const int row0 = chunk * 16, b = row0 >> 11;
        f32x4 A[4], Bv[4];
#pragma unroll
        for (int j = 0; j < 4; ++j) { const int c = 4 * F.lane + 256 * j; const f32x4 gg = *(const f32x4*)(g + c), sc = *(const f32x4*)(scp + (size_t)b * bstride + c);
            A[j] = gg * (sc + 1.0f); Bv[j] = *(const f32x4*)(shp + (size_t)b * bstride + c); }
        for (int r = 0; r < 16; ++r) {
            const int row = row0 + r;
            const f32x4* xr = (const f32x4*)(xin + (size_t)row * DM) + F.lane;
            f32x4 v[4]; float ss = 0.f;
#pragma unroll
            for (int j = 0; j < 4; ++j) { v[j] = xr[64 * j]; ss += (v[j][0] * v[j][0] + v[j][1] * v[j][1]) + (v[j][2] * v[j][2] + v[j][3] * v[j][3]); }
            const float rstd = 1.0f / sqrtf(wave_sum(ss) * (1.0f / DM) + EPS);
            unsigned long long* o8 = (unsigned long long*)(hout + (size_t)row * DM) + F.lane;
#pragma unroll
            for (int j = 0; j < 4; ++j) { v[j] = v[j] * rstd * A[j] + Bv[j]; o8[64 * j] = (unsigned long long)cvtpk(v[j][0], v[j][1]) | ((unsigned long long)cvtpk(v[j][2], v[j][3]) << 32); }
            if (GATES) {
                float p[16];
#pragma unroll
                for (int q = 0; q < 16; ++q) { float s = 0.f;
#pragma unroll
                    for (int j = 0; j < 4; ++j) { const f32x4 w = *(const LAS f32x4*)(wg + q * 1024 + 4 * F.lane + 256 * j); s += (v[j][0] * w[0] + v[j][1] * w[1]) + (v[j][2] * w[2] + v[j][3] * w[3]); }
                    p[q] = s; if ((q & 3) == 3) { asm volatile("" ::: "memory"); __builtin_amdgcn_sched_barrier(0); } }
#pragma unroll
                for (int i = 0; i < 8; ++i) { const bool up = (F.lane & 32) != 0; const float send = up ? p[i] : p[i + 8], keep = up ? p[i + 8] : p[i]; p[i] = keep + __shfl_xor(send, 32); }
#pragma unroll
                for (int i = 0; i < 4; ++i) { const bool up = (F.lane & 16) != 0; const float send = up ? p[i] : p[i + 4], keep = up ? p[i + 4] : p[i]; p[i] = keep + __shfl_xor(send, 16); }
#pragma unroll
                for (int i = 0; i < 2; ++i) { const bool up = (F.lane & 8) != 0; const float send = up ? p[i] : p[i + 2], keep = up ? p[i + 2] : p[i]; p[i] = keep + __shfl_xor(send, 8); }
                { const bool up = (F.lane & 4) != 0; const float send = up ? p[0] : p[1], keep = up ? p[1] : p[0]; p[0] = keep + __shfl_xor(send, 4); }
                p[0] += __shfl_xor(p[0], 2); p[0] += __shfl_xor(p[0], 1);
                const int gi = ((F.lane >> 5) & 1) * 8 + ((F.lane >> 4) & 1) * 4 + ((F.lane >> 3) & 1) * 2 + ((F.lane >> 2) & 1);
                if ((F.lane & 3) == 0) ((float*)(F.ws + WS_GATES))[(size_t)row * 16 + gi] = p[0];
            }
        }
    }
}

DI void mlstm_gates(Frame& F, size_t trow0, int h, float& ipre, float& bcum, float& blast) {
    const float* gates = (const float*)(F.ws + WS_GATES); const float* bif = F.in[8];
    const float iv = gates[(trow0 + F.lane) * 16 + h] + bif[h];
    const float fv = gates[(trow0 + F.lane) * 16 + 8 + h] + bif[8 + h];
    float b = -(fmaxf(-fv, 0.f) + log1pf(expf(-fabsf(fv))));
#pragma unroll
    for (int d = 1; d < 64; d <<= 1) { const float t = __shfl_up(b, d); if (F.lane >= d) b += t; }
    ipre = iv; bcum = b; blast = __shfl(b, 63);
}
template <int MODE> DI void stage_qk(LAS unsigned char* dst, const LAS float* e_s, const bf16* proj, const float* convw, int tseq0, size_t trow0, int col0, int lane) {
    const int g8 = lane >> 3, ch = lane & 7, col = col0 + 8 * ch;
    float cw[4][8];
#pragma unroll
    for (int tap = 0; tap < 4; ++tap) { const f32x4 a = *(const f32x4*)(convw + tap * 1024 + col), b = *(const f32x4*)(convw + tap * 1024 + col + 4);
        cw[tap][0] = a[0]; cw[tap][1] = a[1]; cw[tap][2] = a[2]; cw[tap][3] = a[3]; cw[tap][4] = b[0]; cw[tap][5] = b[1]; cw[tap][6] = b[2]; cw[tap][7] = b[3]; }
#pragma unroll 1
    for (int ph = 0; ph < 2; ++ph) {
        float x[7][8];
#pragma unroll
        for (int i = 0; i < 7; ++i) {
            const int rel = 8 * g8 + 4 * ph + i - 3; const bool valid = (tseq0 + rel) >= 0; const long rr = valid ? (long)rel : 0;
            u32x4 raw = *(const u32x4*)(proj + (size_t)((long)trow0 + rr) * 3072 + col);
            if (!valid) raw = (u32x4){0u, 0u, 0u, 0u};
            x[i][0] = bflo(raw.x); x[i][1] = bfhi(raw.x); x[i][2] = bflo(raw.y); x[i][3] = bfhi(raw.y); x[i][4] = bflo(raw.z); x[i][5] = bfhi(raw.z); x[i][6] = bflo(raw.w); x[i][7] = bfhi(raw.w);
        }
#pragma unroll
        for (int o = 0; o < 4; ++o) {
            const int tok = 8 * g8 + 4 * ph + o;
            float y[8];
#pragma unroll
            for (int e = 0; e < 8; ++e) { float a = cw[0][e] * x[o][e] + cw[1][e] * x[o + 1][e] + cw[2][e] * x[o + 2][e] + cw[3][e] * x[o + 3][e]; y[e] = a / (1.f + __expf(-a)); }
            float sc = 1.f; if (MODE == 0) sc = e_s[tok]; if (MODE == 1) sc = 0.125f;
            u32x4 w; w.x = cvtpk(y[0] * sc, y[1] * sc); w.y = cvtpk(y[2] * sc, y[3] * sc); w.z = cvtpk(y[4] * sc, y[5] * sc); w.w = cvtpk(y[6] * sc, y[7] * sc);
            const int off = (MODE == 0) ? tr_off(tok, ch) : ch * 1024 + tok * 16;
            *(LAS u32x4*)(dst + off) = w;
        }
    }
}
DI void stage_v_half(LAS unsigned char* dst, const bf16* proj, size_t trow0, int col0, int lane) {
    const int g8 = lane >> 3, ch = lane & 7;
#pragma unroll
    for (int o = 0; o < 8; ++o) { const int tok = 8 * g8 + o; const u32x4 raw = *(const u32x4*)(proj + (trow0 + tok) * 3072 + col0 + 8 * ch); *(LAS u32x4*)(dst + tr_off(tok, ch)) = raw; }
}
constexpr int MW_LDS = 17408;

DI void p3_mlstm_local(Frame& F) {
    LAS unsigned char* wl = F.lds + F.wave * MW_LDS;
    LAS unsigned char* kimg = wl; LAS unsigned char* vimg = wl + 8192; LAS float* e_s = (LAS float*)(wl + 16384);
    const bf16* proj = (const bf16*)(F.ws + WS_PROJ);
    bf16* cst = (bf16*)(F.ws + WS_CST);
    const int lane = F.lane, r32 = lane & 31, hi = lane >> 5;
    for (int bu = F.bid; bu < 512; bu += F.G) {
        int h = F.wave; asm volatile("" : "+s"(h));
        const int b = bu >> 5, c = bu & 31; const int unit = bu * 8 + h; const size_t trow0 = (size_t)b * SEQ + c * 64;
        float ipre, bcum, blast; mlstm_gates(F, trow0, h, ipre, bcum, blast);
        const float w = blast - bcum + ipre; const float mloc = wave_max(w); const float e = expf(w - mloc);
        e_s[lane] = e;
        if (lane == 0) { ((float*)(F.ws + WS_BLAST))[unit] = blast; ((float*)(F.ws + WS_MLOC))[unit] = mloc; }
        stage_qk<0>(kimg, e_s, proj, F.in[7], c * 64, trow0, 512 + h * 64, lane);
        bf16x8 kef[2][4];
#pragma unroll
        for (int kt = 0; kt < 2; ++kt)
#pragma unroll
            for (int ks = 0; ks < 4; ++ks) kef[kt][ks] = tr_frag(kimg, kt, ks, lane);
        const bf16x8 ones = {0x3F80, 0x3F80, 0x3F80, 0x3F80, 0x3F80, 0x3F80, 0x3F80, 0x3F80};
#pragma unroll
        for (int kt = 0; kt < 2; ++kt) { f32x16 an = {};
#pragma unroll
            for (int ks = 0; ks < 4; ++ks) an = MFMA32(kef[kt][ks], ones, an);
            if (r32 == 0) {
#pragma unroll
                for (int r = 0; r < 16; ++r) ((float*)(F.ws + WS_NLOC))[(size_t)unit * 64 + 32 * kt + crow(r, hi)] = an[r]; } }
#pragma unroll 1
        for (int vh = 0; vh < 2; ++vh) {
            stage_v_half(vimg, proj, trow0, 1024 + h * 128 + 64 * vh, lane);
#pragma unroll
            for (int vt = 0; vt < 2; ++vt) {
                bf16x8 vf[4];
#pragma unroll
                for (int ks = 0; ks < 4; ++ks) vf[ks] = tr_frag(vimg, vt, ks, lane);
#pragma unroll
                for (int kt = 0; kt < 2; ++kt) { f32x16 acc = {};
#pragma unroll
                    for (int ks = 0; ks < 4; ++ks) acc = MFMA32(kef[kt][ks], vf[ks], acc);
                    bf16* dstp = cst + ((size_t)unit * 128 + 64 * vh + 32 * vt + r32) * 64 + 32 * kt + 4 * hi;
#pragma unroll
                    for (int rg = 0; rg < 4; ++rg) { u32x2 pk; pk.x = cvtpk(acc[4 * rg], acc[4 * rg + 1]); pk.y = cvtpk(acc[4 * rg + 2], acc[4 * rg + 3]); *(u32x2*)(dstp + 8 * rg) = pk; }
                }
            }
        }
    }
}
DI void p4_scan(Frame& F) {
    const int gt = F.bid * NT + F.tid, NGT = F.G * NT;
    const float* mlocp = (const float*)(F.ws + WS_MLOC); const float* blastp = (const float*)(F.ws + WS_BLAST);
    for (int item = gt; item < 128 * 1024; item += NGT) {
        const int bh = item >> 10, e8 = item & 1023, b = bh >> 3, h = bh & 7;
        float st[8]; float m = 0.f;
#pragma unroll
        for (int i = 0; i < 8; ++i) st[i] = 0.f;
#pragma unroll 4
        for (int c = 0; c < 32; ++c) {
            const int unit = (b * 32 + c) * 8 + h;
            u32x4* p = (u32x4*)((bf16*)(F.ws + WS_CST) + (size_t)unit * 8192) + e8;
            const u32x4 raw = *p; const float ml = mlocp[unit], bl = blastp[unit];
            u32x4 o; o.x = cvtpk(st[0], st[1]); o.y = cvtpk(st[2], st[3]); o.z = cvtpk(st[4], st[5]); o.w = cvtpk(st[6], st[7]); *p = o;
            const float mn = fmaxf(bl + m, ml), a = expf(bl + m - mn), r = expf(ml - mn);
            st[0] = a * st[0] + r * bflo(raw.x); st[1] = a * st[1] + r * bfhi(raw.x); st[2] = a * st[2] + r * bflo(raw.y); st[3] = a * st[3] + r * bfhi(raw.y);
            st[4] = a * st[4] + r * bflo(raw.z); st[5] = a * st[5] + r * bfhi(raw.z); st[6] = a * st[6] + r * bflo(raw.w); st[7] = a * st[7] + r * bfhi(raw.w);
            m = mn;
        }
    }
    for (int item = gt; item < 128 * 64; item += NGT) {
        const int bh = item >> 6, k = item & 63, b = bh >> 3, h = bh & 7;
        float ns = 0.f, m = 0.f;
        for (int c = 0; c < 32; ++c) {
            const int unit = (b * 32 + c) * 8 + h;
            float* np = (float*)(F.ws + WS_NLOC) + (size_t)unit * 64 + k;
            const float nl = *np, ml = mlocp[unit], bl = blastp[unit];
            *np = ns; if (k == 0) ((float*)(F.ws + WS_MPREV))[unit] = m;
            const float mn = fmaxf(bl + m, ml), a = expf(bl + m - mn), r = expf(ml - mn);
            ns = a * ns + r * nl; m = mn;
        }
    }
}
DI void p5_mlstm_out(Frame& F) {
    LAS unsigned char* wl = F.lds + F.wave * MW_LDS;
    LAS unsigned char* qimg = wl; LAS unsigned char* kimg = wl + 8192; LAS float* sc = (LAS float*)(wl + 16384);
    const bf16* proj = (const bf16*)(F.ws + WS_PROJ);
    const bf16* cst = (const bf16*)(F.ws + WS_CST);
    bf16* hh = (bf16*)(F.ws + WS_H);
    for (int bu = F.bid; bu < 512; bu += F.G) {
        int lane = F.lane; asm volatile("" : "+v"(lane)); const int r32 = lane & 31, hi = lane >> 5;
        int h = F.wave; asm volatile("" : "+s"(h));
        const int b = bu >> 5, c = bu & 31; const int unit = bu * 8 + h; const size_t trow0 = (size_t)b * SEQ + c * 64;
        {
            float ipre, bcum, blast; mlstm_gates(F, trow0, h, ipre, bcum, blast);
            const float mprev = ((const float*)(F.ws + WS_MPREV))[unit];
            const float gg = ipre - bcum; float pm = gg;
#pragma unroll
            for (int d = 1; d < 64; d <<= 1) { const float t = __shfl_up(pm, d); if (lane >= d) pm = fmaxf(pm, t); }
            const float Mx = fmaxf(mprev, pm), mt = bcum + Mx;
            sc[lane] = gg; sc[64 + lane] = Mx; sc[128 + lane] = expf(mprev - Mx); sc[192 + lane] = expf(-mt);
        }
#pragma unroll 1
        for (int lt = 0; lt < 2; ++lt) {
            stage_qk<1>(qimg, nullptr, proj, F.in[7], c * 64, trow0, h * 64, lane); asm volatile("" ::: "memory"); __builtin_amdgcn_sched_barrier(0);
            stage_qk<2>(kimg, nullptr, proj, F.in[7], c * 64, trow0, 512 + h * 64, lane);
            bf16x8 qf[4];
#pragma unroll
            for (int ks = 0; ks < 4; ++ks) qf[ks] = row_frag<64>(qimg, lt, ks, lane);
            const int l = 32 * lt + r32;
            const float Mxl = sc[64 + l];
            bf16x8 P[2][2]; float dsum = 0.f;
#pragma unroll
            for (int st = 0; st < 2; ++st) {
                P[st][0] = (bf16x8){0, 0, 0, 0, 0, 0, 0, 0}; P[st][1] = P[st][0];
                if (st <= lt) {
                    f32x16 acc = {};
#pragma unroll
                    for (int ks = 0; ks < 4; ++ks) acc = MFMA32(row_frag<64>(kimg, st, ks, lane), qf[ks], acc);
#pragma unroll
                    for (int r = 0; r < 16; ++r) { const int srow = crow(r, hi); float val = acc[r] * __expf(sc[32 * st + srow] - Mxl); if (st == lt && srow > r32) val = 0.f; acc[r] = val; dsum += val; }
                    P[st][0] = pack8(acc, 0); P[st][1] = pack8(acc, 1);
                }
            }
            float nq;
            { const float* np = (const float*)(F.ws + WS_NLOC) + (size_t)unit * 64; float s = 0.f;
#pragma unroll
              for (int ks = 0; ks < 4; ++ks) { const f32x4 n0 = *(const f32x4*)(np + 16 * ks + 8 * hi), n1 = *(const f32x4*)(np + 16 * ks + 8 * hi + 4); const u32x4 q = __builtin_bit_cast(u32x4, qf[ks]);
                  s += bflo(q.x) * n0[0] + bfhi(q.x) * n0[1] + bflo(q.y) * n0[2] + bfhi(q.y) * n0[3] + bflo(q.z) * n1[0] + bfhi(q.z) * n1[1] + bflo(q.w) * n1[2] + bfhi(q.w) * n1[3]; }
              nq = s + __shfl_xor(s, 32); }
            asm volatile("s_waitcnt lgkmcnt(0)" ::: "memory");
            stage_v_half(wl, proj, trow0, 1024 + h * 128, lane); asm volatile("" ::: "memory"); __builtin_amdgcn_sched_barrier(0);
            stage_v_half(wl + 8192, proj, trow0, 1024 + h * 128 + 64, lane); asm volatile("" ::: "memory"); __builtin_amdgcn_sched_barrier(0);
            f32x16 acc[4];
#pragma unroll
            for (int vt = 0; vt < 4; ++vt) { acc[vt] = (f32x16){};
#pragma unroll
                for (int ks = 0; ks < 4; ++ks) { const bf16x8 cf = *(const bf16x8*)(cst + ((size_t)unit * 128 + 32 * vt + r32) * 64 + 16 * ks + 8 * hi); acc[vt] = MFMA32(cf, qf[ks], acc[vt]); }
                asm volatile("" ::: "memory"); __builtin_amdgcn_sched_barrier(0); }
            const float iwl = sc[128 + l];
#pragma unroll
            for (int vt = 0; vt < 4; ++vt) acc[vt] = acc[vt] * iwl;
#pragma unroll
            for (int st = 0; st < 2; ++st) if (st <= lt) {
#pragma unroll
                for (int k2 = 0; k2 < 2; ++k2) {
#pragma unroll
                    for (int vt = 0; vt < 4; ++vt) acc[vt] = MFMA32(tr_frag(wl + (vt >> 1) * 8192, vt & 1, 2 * st + k2, lane), P[st][k2], acc[vt]);
                    asm volatile("" ::: "memory"); __builtin_amdgcn_sched_barrier(0); } }
            const float den = dsum + __shfl_xor(dsum, 32) + iwl * nq;
            const float inv = 1.0f / fmaxf(fabsf(den), sc[192 + l]);
            float ss = 0.f;
#pragma unroll
            for (int vt = 0; vt < 4; ++vt)
#pragma unroll
                for (int r = 0; r < 16; ++r) { const float v = acc[vt][r] * inv; acc[vt][r] = v; ss += v * v; }
            ss += __shfl_xor(ss, 32);
            const float rstd = 1.0f / sqrtf(ss * (1.0f / 128.0f) + EPS);
            const size_t t = trow0 + l;
#pragma unroll
            for (int vt = 0; vt < 4; ++vt)
#pragma unroll
                for (int rg = 0; rg < 4; ++rg) { const int v = 32 * vt + 8 * rg + 4 * hi;
                    const u32x2 o4 = *(const u32x2*)(proj + t * 3072 + 2048 + h * 128 + v); const f32x4 g4 = *(const f32x4*)(F.in[9] + h * 128 + v);
                    const float o0 = bflo(o4.x), o1 = bfhi(o4.x), o2 = bflo(o4.y), o3 = bfhi(o4.y);
                    const float y0 = acc[vt][4 * rg] * rstd * g4[0] / (1.f + __expf(-o0)), y1 = acc[vt][4 * rg + 1] * rstd * g4[1] / (1.f + __expf(-o1));
                    const float y2 = acc[vt][4 * rg + 2] * rstd * g4[2] / (1.f + __expf(-o2)), y3 = acc[vt][4 * rg + 3] * rstd * g4[3] / (1.f + __expf(-o3));
                    u32x2 pk; pk.x = cvtpk(y0, y1); pk.y = cvtpk(y2, y3); *(u32x2*)(hh + t * 1024 + h * 128 + v) = pk;
                    if ((rg & 1) == 1) { asm volatile("" ::: "memory"); __builtin_amdgcn_sched_barrier(0); } }
            asm volatile("s_waitcnt lgkmcnt(0)" ::: "memory");
        }
    }
}

DI float softplus_f(float z) { return fmaxf(z, 0.f) + __logf(1.f + __expf(-fabsf(z))); }
DI void p12_attn(Frame& F) {
    LAS unsigned char* kimg = F.lds; LAS unsigned char* vimg = F.lds + 8192;
    const bf16* Q = (const bf16*)(F.ws + WS_Q); const bf16* K = (const bf16*)(F.ws + WS_K); const bf16* V = (const bf16*)(F.ws + WS_VV);
    bf16* O = (bf16*)(F.ws + WS_H);
    const int lane = F.lane, r32 = lane & 31, hi = lane >> 5, wave = F.wave;
    const int skey = F.tid >> 3, schk = F.tid & 7;
    for (int bh = F.bid; bh < 256; bh += F.G) {
        const int b = bh >> 4, h = bh & 15;
        for (int qb = 7; qb >= 0; --qb) {
            const int qlo = qb * 256 + 32 * wave;
            const size_t tq0 = (size_t)b * SEQ + qlo;
            bf16x8 qr[4];
#pragma unroll
            for (int ks = 0; ks < 4; ++ks) qr[ks] = *(const bf16x8*)(Q + (tq0 + r32) * 1024 + h * 64 + 16 * ks + 8 * hi);
            f32x16 o0 = {}, o1 = {}; float R = 0.f; bool wdone = false;
            const int ntile = 4 * qb + 4;
            u32x4 kraw, vraw;
            { const size_t src = ((size_t)b * SEQ + 64 * (ntile - 1) + skey) * 1024 + h * 64 + 8 * schk; kraw = *(const u32x4*)(K + src); vraw = *(const u32x4*)(V + src); }
            for (int kt = ntile - 1; kt >= 0; --kt) {
                __syncthreads();
                *(LAS u32x4*)(kimg + schk * 1024 + skey * 16) = kraw;
                *(LAS u32x4*)(vimg + tr_off(skey, schk)) = vraw;
                if (kt > 0) { const size_t src = ((size_t)b * SEQ + 64 * (kt - 1) + skey) * 1024 + h * 64 + 8 * schk; kraw = *(const u32x4*)(K + src); vraw = *(const u32x4*)(V + src); }
                if (__syncthreads_and(wdone ? 1 : 0)) break;
                if (!wdone && 64 * kt <= qlo + 30) {
                    f32x16 p0 = {}, p1 = {};
#pragma unroll
                    for (int ks = 0; ks < 4; ++ks) { p0 = MFMA32(row_frag<64>(kimg, 0, ks, lane), qr[ks], p0); p1 = MFMA32(row_frag<64>(kimg, 1, ks, lane), qr[ks], p1); }
                    const bool diag = (64 * kt + 63 >= qlo);
                    const int qrel = qlo + r32 - 64 * kt;
                    float s0[16], s1[16];
#pragma unroll
                    for (int r = 0; r < 16; ++r) { const int kr = crow(r, hi);
                        const bool v0 = !diag || kr < qrel, v1 = !diag || (kr + 32) < qrel;
                        s0[r] = v0 ? softplus_f(p0[r]) : 0.f; s1[r] = v1 ? softplus_f(p1[r]) : 0.f; }
#pragma unroll
                    for (int g = 0; g < 4; ++g) { s0[4 * g + 2] += s0[4 * g + 3]; s0[4 * g + 1] += s0[4 * g + 2]; s0[4 * g] += s0[4 * g + 1];
                                                  s1[4 * g + 2] += s1[4 * g + 3]; s1[4 * g + 1] += s1[4 * g + 2]; s1[4 * g] += s1[4 * g + 1]; }
                    float off0[4], off1[4]; float tot0, tot1;
                    { float og[4], T[4];
#pragma unroll
                      for (int g = 0; g < 4; ++g) og[g] = __shfl_xor(s1[4 * g], 32);
                      T[3] = 0.f; T[2] = s1[12] + og[3]; T[1] = T[2] + s1[8] + og[2]; T[0] = T[1] + s1[4] + og[1]; tot1 = T[0] + s1[0] + og[0];
#pragma unroll
                      for (int g = 0; g < 4; ++g) off1[g] = T[g] + (hi == 0 ? og[g] : 0.f) + R; }
                    { float og[4], T[4];
#pragma unroll
                      for (int g = 0; g < 4; ++g) og[g] = __shfl_xor(s0[4 * g], 32);
                      T[3] = 0.f; T[2] = s0[12] + og[3]; T[1] = T[2] + s0[8] + og[2]; T[0] = T[1] + s0[4] + og[1]; tot0 = T[0] + s0[0] + og[0];
#pragma unroll
                      for (int g = 0; g < 4; ++g) off0[g] = T[g] + (hi == 0 ? og[g] : 0.f) + R + tot1; }
#pragma unroll
                    for (int r = 0; r < 16; ++r) { const int kr = crow(r, hi);
                        const bool v0 = !diag || kr < qrel, v1 = !diag || (kr + 32) < qrel;
                        const float a0 = __expf(p0[r] - s0[r] - off0[r >> 2]), a1 = __expf(p1[r] - s1[r] - off1[r >> 2]);
                        p0[r] = v0 ? a0 : 0.f; p1[r] = v1 ? a1 : 0.f; }
                    R += tot0 + tot1;
                    wdone = __all(R >= 104.0f);
                    const bf16x8 pa0 = pack8(p0, 0), pa1 = pack8(p0, 1), pa2 = pack8(p1, 0), pa3 = pack8(p1, 1);
                    o0 = MFMA32(pa0, tr_frag(vimg, 0, 0, lane), o0); o1 = MFMA32(pa0, tr_frag(vimg, 1, 0, lane), o1);
                    o0 = MFMA32(pa1, tr_frag(vimg, 0, 1, lane), o0); o1 = MFMA32(pa1, tr_frag(vimg, 1, 1, lane), o1);
                    o0 = MFMA32(pa2, tr_frag(vimg, 0, 2, lane), o0); o1 = MFMA32(pa2, tr_frag(vimg, 1, 2, lane), o1);
                    o0 = MFMA32(pa3, tr_frag(vimg, 0, 3, lane), o0); o1 = MFMA32(pa3, tr_frag(vimg, 1, 3, lane), o1);
                }
            }
#pragma unroll
            for (int r = 0; r < 16; ++r) { bf16* op = O + (tq0 + crow(r, hi)) * 1024 + h * 64 + r32;
                op[0] = (bf16)(cvtpk(o0[r], 0.f) & 0xffffu); op[32] = (bf16)(cvtpk(o1[r], 0.f) & 0xffffu); }
        }
    }
}

__device__ constexpr int NET16_A[63] = {0,2,0,1,1,4,6,4,5,5,0,2,2,1,3,3,1,3,5,8,10,8,9,9,12,14,12,13,13,8,10,10,9,11,11,9,11,13,0,4,4,2,6,6,2,6,10,1,5,5,3,7,7,3,7,11,1,3,5,7,9,11,13};
__device__ constexpr int NET16_B[63] = {1,3,2,3,2,5,7,6,7,6,4,6,4,5,7,5,2,4,6,9,11,10,11,10,13,15,14,15,14,12,14,12,13,15,13,10,12,14,8,12,8,10,14,10,4,8,12,9,13,9,11,15,11,5,9,13,2,4,6,8,10,12,14};
__device__ constexpr int BIT16_A[32] = {0,1,2,3,4,5,6,7,0,1,2,3,8,9,10,11,0,1,4,5,8,9,12,13,0,2,4,6,8,10,12,14};
__device__ constexpr int BIT16_B[32] = {8,9,10,11,12,13,14,15,4,5,6,7,12,13,14,15,2,3,6,7,10,11,14,15,1,3,5,7,9,11,13,15};
DI unsigned umax_(unsigned a, unsigned b) { return a > b ? a : b; }
DI unsigned umin_(unsigned a, unsigned b) { return a < b ? a : b; }
DI void sort16(unsigned (&k)[16]) {
#pragma unroll
    for (int c = 0; c < 63; ++c) { const unsigned a = k[NET16_A[c]], b = k[NET16_B[c]]; k[NET16_A[c]] = umax_(a, b); k[NET16_B[c]] = umin_(a, b); }
}
DI void bitonic16(unsigned (&k)[16]) {
#pragma unroll
    for (int c = 0; c < 32; ++c) { const unsigned a = k[BIT16_A[c]], b = k[BIT16_B[c]]; k[BIT16_A[c]] = umax_(a, b); k[BIT16_B[c]] = umin_(a, b); }
}
DI void merge16(unsigned (&x)[16], const unsigned (&y)[16]) {
#pragma unroll
    for (int i = 0; i < 16; ++i) x[i] = umax_(x[i], y[15 - i]);
    bitonic16(x);
}
DI unsigned f2key(float x) { const unsigned b = __float_as_uint(x); return b ^ ((unsigned)((int)b >> 31) | 0x80000000u); }
DI float key2f(unsigned k) { return __uint_as_float(k ^ (~(unsigned)((int)k >> 31) | 0x80000000u)); }

DI void p_route(Frame& F, int layer) {
    LAS unsigned char* simg = F.lds;
    LAS unsigned char* dec = F.lds + 65536 + F.wave * 1024;
    { const u32x4* src = (const u32x4*)((const bf16*)(F.ws + WS_SUBK) + (size_t)layer * 2 * 128 * 128);
      for (int i = F.tid; i < 2 * 128 * 16; i += NT) { const int p = i >> 11, n = (i >> 4) & 127, ch = i & 15; *(LAS u32x4*)(simg + p * 32768 + ch * 2048 + n * 16) = src[i]; } }
    __syncthreads();
    const bf16* PQ = (const bf16*)(F.ws + WS_PQ);
    const int lane = F.lane, r32 = lane & 31, hi = lane >> 5;
    const int gw = F.bid * NWAVES + F.wave, NGW = F.G * NWAVES;
    for (int wu = gw; wu < T_TOK * 8 / 32; wu += NGW) {
        const int row = wu * 32 + r32, t = row >> 3, hd = row & 7;
        unsigned top[2][16];
#pragma unroll
        for (int p = 0; p < 2; ++p) {
            bf16x8 qf[8];
#pragma unroll
            for (int ks = 0; ks < 8; ++ks) qf[ks] = *(const bf16x8*)(PQ + (size_t)t * 2048 + hd * 256 + p * 128 + 16 * ks + 8 * hi);
            unsigned keys[4][16];
#pragma unroll
            for (int nt = 0; nt < 4; ++nt) {
                f32x16 acc = {};
#pragma unroll
                for (int ks = 0; ks < 8; ++ks) acc = MFMA32(*(const LAS bf16x8*)(simg + p * 32768 + (2 * ks + hi) * 2048 + (32 * nt + r32) * 16), qf[ks], acc);
#pragma unroll
                for (int r = 0; r < 16; ++r) keys[nt][r] = (f2key(acc[r]) & 0xFFFFFF80u) | (unsigned)(32 * nt + crow(r, 0)) | (unsigned)(4 * hi);
                sort16(keys[nt]);
            }
            merge16(keys[0], keys[1]); merge16(keys[2], keys[3]); merge16(keys[0], keys[2]);
            unsigned lo[16], up[16];
#pragma unroll
            for (int i = 0; i < 16; ++i) { auto rr = __builtin_amdgcn_permlane32_swap(keys[0][i], keys[0][i], false, false); lo[i] = rr[0]; up[i] = rr[1]; }
#pragma unroll
            for (int i = 0; i < 16; ++i) top[p][i] = umax_(lo[i], up[15 - i]);
            bitonic16(top[p]);
        }
        if (hi == 0) {
            u32x4 w0, w1, w2, w3;
            w0.x = (top[0][0] & 127u) | ((top[0][1] & 127u) << 8) | ((top[0][2] & 127u) << 16) | ((top[0][3] & 127u) << 24);
            w0.y = (top[0][4] & 127u) | ((top[0][5] & 127u) << 8) | ((top[0][6] & 127u) << 16) | ((top[0][7] & 127u) << 24);
            w0.z = (top[0][8] & 127u) | ((top[0][9] & 127u) << 8) | ((top[0][10] & 127u) << 16) | ((top[0][11] & 127u) << 24);
            w0.w = (top[0][12] & 127u) | ((top[0][13] & 127u) << 8) | ((top[0][14] & 127u) << 16) | ((top[0][15] & 127u) << 24);
            w1.x = (top[1][0] & 127u) | ((top[1][1] & 127u) << 8) | ((top[1][2] & 127u) << 16) | ((top[1][3] & 127u) << 24);
            w1.y = (top[1][4] & 127u) | ((top[1][5] & 127u) << 8) | ((top[1][6] & 127u) << 16) | ((top[1][7] & 127u) << 24);
            w1.z = (top[1][8] & 127u) | ((top[1][9] & 127u) << 8) | ((top[1][10] & 127u) << 16) | ((top[1][11] & 127u) << 24);
            w1.w = (top[1][12] & 127u) | ((top[1][13] & 127u) << 8) | ((top[1][14] & 127u) << 16) | ((top[1][15] & 127u) << 24);
            *(LAS u32x4*)(dec + r32 * 32) = w0; *(LAS u32x4*)(dec + r32 * 32 + 16) = w1;
        }
        float av[16], bv[16];
#pragma unroll
        for (int i = 0; i < 16; ++i) { av[i] = key2f(top[0][i] & 0xFFFFFF80u); bv[i] = key2f(top[1][i] & 0xFFFFFF80u); }
        unsigned c0[16], c1[16], c2[16], c3[16];
#pragma unroll
        for (int j = 0; j < 16; ++j) c0[j] = (f2key(av[0] + bv[j]) & 0xFFFFFF00u) | (unsigned)j;
        {
            int n = 0;
#pragma unroll
            for (int i = 1; i < 16; ++i)
#pragma unroll
                for (int j = 0; j < 16; ++j) if ((i + 1) * (j + 1) <= 16) {
                    const unsigned k = (f2key(av[i] + bv[j]) & 0xFFFFFF00u) | (unsigned)(i * 16 + j);
                    if (n < 16) c1[n] = k; else if (n < 32) c2[n - 16] = k; else c3[n - 32] = k;
                    ++n; }
#pragma unroll
            for (int q = 2; q < 16; ++q) c3[q] = 0u;
        }
        sort16(c1); sort16(c2); { const unsigned a = c3[0], b = c3[1]; c3[0] = umax_(a, b); c3[1] = umin_(a, b); }
        merge16(c0, c1); merge16(c2, c3); merge16(c0, c2);
        asm volatile("s_waitcnt lgkmcnt(0)" ::: "memory");
        float gv[16]; unsigned ex[16]; float gs = 0.f;
        const float vmax = key2f(c0[0] & 0xFFFFFF00u);
#pragma unroll
        for (int k = 0; k < 16; ++k) {
            const unsigned code = c0[k] & 255u; const unsigned i = code >> 4, j = code & 15u;
            const unsigned ia = *(const LAS unsigned char*)(dec + r32 * 32 + i), ib = *(const LAS unsigned char*)(dec + r32 * 32 + 16 + j);
            ex[k] = ia * 128u + ib;
            gv[k] = __expf(key2f(c0[k] & 0xFFFFFF00u) - vmax); gs += gv[k];
        }
        const float ginv = 1.0f / gs;
        if (hi == 0) {
            u32x4 e0, e1;
            e0.x = ex[0] | (ex[1] << 16); e0.y = ex[2] | (ex[3] << 16); e0.z = ex[4] | (ex[5] << 16); e0.w = ex[6] | (ex[7] << 16);
            e1.x = ex[8] | (ex[9] << 16); e1.y = ex[10] | (ex[11] << 16); e1.z = ex[12] | (ex[13] << 16); e1.w = ex[14] | (ex[15] << 16);
            u32x4* ip = (u32x4*)((unsigned short*)(F.ws + WS_IDX) + (size_t)row * 16); ip[0] = e0; ip[1] = e1;
        } else {
            f32x4* gp = (f32x4*)((float*)(F.ws + WS_GATE) + (size_t)row * 16);
            gp[0] = (f32x4){gv[0] * ginv, gv[1] * ginv, gv[2] * ginv, gv[3] * ginv}; gp[1] = (f32x4){gv[4] * ginv, gv[5] * ginv, gv[6] * ginv, gv[7] * ginv};
            gp[2] = (f32x4){gv[8] * ginv, gv[9] * ginv, gv[10] * ginv, gv[11] * ginv}; gp[3] = (f32x4){gv[12] * ginv, gv[13] * ginv, gv[14] * ginv, gv[15] * ginv};
        }
    }
}

constexpr float U_SCALE = 32.f, V_SCALE = 4.f;
struct RowBuf { u32x4 r[16]; };
DI void load_rows(RowBuf& rb, const unsigned char* tbl, int idxs, int k0, int lane) {
#pragma unroll
    for (int j = 0; j < 16; ++j) { const int e = __builtin_amdgcn_readlane(idxs, k0 + j); rb.r[j] = *((const u32x4*)(tbl + (size_t)e * 1024) + lane); }
}
DI float udots(const RowBuf& rb, const f32x2_t (&hq)[8], int lane) {
    float p[16];
#pragma unroll
    for (int j = 0; j < 16; ++j) { f32x2_t a = {0.f, 0.f};
        a = __builtin_amdgcn_cvt_pk_f32_fp8((int)rb.r[j].x, false) * hq[0] + a; a = __builtin_amdgcn_cvt_pk_f32_fp8((int)rb.r[j].x, true) * hq[1] + a;
        a = __builtin_amdgcn_cvt_pk_f32_fp8((int)rb.r[j].y, false) * hq[2] + a; a = __builtin_amdgcn_cvt_pk_f32_fp8((int)rb.r[j].y, true) * hq[3] + a;
        a = __builtin_amdgcn_cvt_pk_f32_fp8((int)rb.r[j].z, false) * hq[4] + a; a = __builtin_amdgcn_cvt_pk_f32_fp8((int)rb.r[j].z, true) * hq[5] + a;
        a = __builtin_amdgcn_cvt_pk_f32_fp8((int)rb.r[j].w, false) * hq[6] + a; a = __builtin_amdgcn_cvt_pk_f32_fp8((int)rb.r[j].w, true) * hq[7] + a;
        p[j] = a.x + a.y; }
#pragma unroll
    for (int i = 0; i < 8; ++i) { const bool up = (lane & 8) != 0; const float send = up ? p[i] : p[i + 8], keep = up ? p[i + 8] : p[i]; p[i] = keep + __shfl_xor(send, 8); }
#pragma unroll
    for (int i = 0; i < 4; ++i) { const bool up = (lane & 4) != 0; const float send = up ? p[i] : p[i + 4], keep = up ? p[i + 4] : p[i]; p[i] = keep + __shfl_xor(send, 4); }
#pragma unroll
    for (int i = 0; i < 2; ++i) { const bool up = (lane & 2) != 0; const float send = up ? p[i] : p[i + 2], keep = up ? p[i + 2] : p[i]; p[i] = keep + __shfl_xor(send, 2); }
    { const bool up = (lane & 1) != 0; const float send = up ? p[0] : p[1], keep = up ? p[1] : p[0]; p[0] = keep + __shfl_xor(send, 1); }
    float s = p[0]; s += __shfl_xor(s, 16); s += __shfl_xor(s, 32);
    return s;
}
DI void vaccum(const RowBuf& rb, f32x2_t (&out)[8], float wv, int k0) {
#pragma unroll
    for (int j = 0; j < 16; ++j) { const float wk = __builtin_bit_cast(float, __builtin_amdgcn_readlane(__builtin_bit_cast(int, wv), k0 + j));
        out[0] = __builtin_amdgcn_cvt_pk_f32_fp8((int)rb.r[j].x, false) * wk + out[0]; out[1] = __builtin_amdgcn_cvt_pk_f32_fp8((int)rb.r[j].x, true) * wk + out[1];
        out[2] = __builtin_amdgcn_cvt_pk_f32_fp8((int)rb.r[j].y, false) * wk + out[2]; out[3] = __builtin_amdgcn_cvt_pk_f32_fp8((int)rb.r[j].y, true) * wk + out[3];
        out[4] = __builtin_amdgcn_cvt_pk_f32_fp8((int)rb.r[j].z, false) * wk + out[4]; out[5] = __builtin_amdgcn_cvt_pk_f32_fp8((int)rb.r[j].z, true) * wk + out[5];
        out[6] = __builtin_amdgcn_cvt_pk_f32_fp8((int)rb.r[j].w, false) * wk + out[6]; out[7] = __builtin_amdgcn_cvt_pk_f32_fp8((int)rb.r[j].w, true) * wk + out[7]; }
}
template <bool LAST> DI void p_apply(Frame& F, int layer, float* xout) {
    const unsigned char* U = F.ws + WS_U + (size_t)layer * 16384 * 1024;
    const unsigned char* V = F.ws + WS_V + (size_t)layer * 16384 * 1024;
    const bf16* H2 = (const bf16*)(F.ws + WS_H);
    const unsigned short* IDX = (const unsigned short*)(F.ws + WS_IDX); const float* GATE = (const float*)(F.ws + WS_GATE);
    const float* mods = (const float*)(F.ws + WS_MODS);
    const int lane = F.lane;
    const int gw = F.bid * NWAVES + F.wave, NGW = F.G * NWAVES;
    for (int chunk = gw; chunk < T_TOK / 16; chunk += NGW) {
        const int t0 = chunk * 16, b = t0 >> 11;
#pragma unroll 1
        for (int tt = 0; tt < 16; ++tt) {
            const size_t t = (size_t)t0 + tt;
            f32x2_t hq[8];
            { const u32x4* hp = (const u32x4*)(H2 + t * 1024) + 2 * lane; const u32x4 a = hp[0], c = hp[1];
              hq[0] = (f32x2_t){bflo(a.x), bfhi(a.x)}; hq[1] = (f32x2_t){bflo(a.y), bfhi(a.y)}; hq[2] = (f32x2_t){bflo(a.z), bfhi(a.z)}; hq[3] = (f32x2_t){bflo(a.w), bfhi(a.w)};
              hq[4] = (f32x2_t){bflo(c.x), bfhi(c.x)}; hq[5] = (f32x2_t){bflo(c.y), bfhi(c.y)}; hq[6] = (f32x2_t){bflo(c.z), bfhi(c.z)}; hq[7] = (f32x2_t){bflo(c.w), bfhi(c.w)}; }
            const int i0 = IDX[t * 128 + lane], i1 = IDX[t * 128 + 64 + lane];
            const float g0 = GATE[t * 128 + lane], g1 = GATE[t * 128 + 64 + lane];
            f32x2_t out[8];
#pragma unroll
            for (int i = 0; i < 8; ++i) out[i] = (f32x2_t){0.f, 0.f};
#pragma unroll 1
            for (int half = 0; half < 2; ++half) {
                const int idxs = half ? i1 : i0; const float gts = half ? g1 : g0;
                float coll = 0.f;
                RowBuf A, B;
                load_rows(A, U, idxs, 0, lane);
#pragma unroll
                for (int bb = 0; bb < 4; bb += 2) {
                    load_rows(B, U, idxs, 16 * (bb + 1), lane);
                    { const float s = udots(A, hq, lane); coll = ((lane >> 4) == bb) ? s : coll; }
                    if (bb + 2 < 4) load_rows(A, U, idxs, 16 * (bb + 2), lane); else load_rows(A, V, idxs, 0, lane);
                    { const float s = udots(B, hq, lane); coll = ((lane >> 4) == bb + 1) ? s : coll; }
                }
                coll *= (1.0f / U_SCALE);
                const float wv = gts * 0.5f * coll * (1.0f + erff(coll * 0.70710678118654752f)) * (1.0f / V_SCALE);
#pragma unroll
                for (int bb = 0; bb < 4; bb += 2) {
                    load_rows(B, V, idxs, 16 * (bb + 1), lane);
                    vaccum(A, out, wv, 16 * bb);
                    if (bb + 2 < 4) load_rows(A, V, idxs, 16 * (bb + 2), lane);
                    vaccum(B, out, wv, 16 * (bb + 1));
                }
            }
            const float* xr = F.out + t * 1024 + 16 * lane;
            const float* g2 = mods + ((size_t)layer * 16 + b) * 6144 + 5 * 1024 + 16 * lane;
            f32x4 x[4];
#pragma unroll
            for (int q = 0; q < 4; ++q) { const f32x4 gg = *(const f32x4*)(g2 + 4 * q);
                x[q] = *(const f32x4*)(xr + 4 * q) + gg * (f32x4){out[2 * q].x, out[2 * q].y, out[2 * q + 1].x, out[2 * q + 1].y}; *(f32x4*)(xout + t * 1024 + 16 * lane + 4 * q) = x[q]; }
            if (!LAST) {
                float ss = 0.f;
#pragma unroll
                for (int q = 0; q < 4; ++q) ss += (x[q][0] * x[q][0] + x[q][1] * x[q][1]) + (x[q][2] * x[q][2] + x[q][3] * x[q][3]);
                const float rstd = 1.0f / sqrtf(wave_sum(ss) * (1.0f / DM) + EPS);
                const float* m1 = mods + ((size_t)16 + b) * 6144 + 16 * lane;
                const float* kvm = (const float*)(F.ws + WS_KVMODS) + (size_t)b * 2048 + 16 * lane;
                unsigned ha[8], hb[8];
#pragma unroll
                for (int q = 0; q < 4; ++q) { const int c = 16 * lane + 4 * q;
                    const f32x4 gm = *(const f32x4*)(F.in[4] + 1024 + c), s1 = *(const f32x4*)(m1 + 1024 + 4 * q), h1 = *(const f32x4*)(m1 + 4 * q);
                    const f32x4 gk = *(const f32x4*)(F.in[13] + c), sk = *(const f32x4*)(kvm + 1024 + 4 * q), hk = *(const f32x4*)(kvm + 4 * q);
                    const f32x4 xn = x[q] * rstd;
                    const f32x4 ya = xn * gm * (s1 + 1.0f) + h1, yb = xn * gk * (sk + 1.0f) + hk;
                    ha[2 * q] = cvtpk(ya[0], ya[1]); ha[2 * q + 1] = cvtpk(ya[2], ya[3]); hb[2 * q] = cvtpk(yb[0], yb[1]); hb[2 * q + 1] = cvtpk(yb[2], yb[3]); }
                u32x4* pa = (u32x4*)((bf16*)(F.ws + WS_H) + t * 1024) + 2 * lane; u32x4* pb = (u32x4*)((bf16*)(F.ws + WS_HB) + t * 1024) + 2 * lane;
                pa[0] = (u32x4){ha[0], ha[1], ha[2], ha[3]}; pa[1] = (u32x4){ha[4], ha[5], ha[6], ha[7]};
                pb[0] = (u32x4){hb[0], hb[1], hb[2], hb[3]}; pb[1] = (u32x4){hb[4], hb[5], hb[6], hb[7]};
            }
        }
    }
}
#ifndef DUP
#define DUP -1
#endif
#ifndef PH_MASK
#define PH_MASK 0x3FFFF
#endif

#ifndef N_LAUNCH_MODE
#define N_LAUNCH_MODE 1
#endif
constexpr int NPH = 18;
template <class Epi> DI void run_gemm(Frame& F, const bf16* A, const bf16* Bt, int N, const Epi& E) {
    pg8::Gemm g{A, Bt, T_TOK, N, DM}; pg8::StaticOrder S; S.init(T_TOK, N, F.G, F.bid);
    pg8::gemm_phase<Epi, pg8::StaticOrder, true, true>(F.lds, g, S, E);
}
__global__ void __launch_bounds__(NT, 2) fwd(Args args) {
    extern __shared__ __attribute__((aligned(16))) unsigned char lds_raw[];
    cg::grid_group grid = cg::this_grid();
    Frame F;
    F.lds = (LAS unsigned char*)lds_raw;
#pragma unroll
    for (int i = 0; i < 23; ++i) F.in[i] = args.in[i];
    F.out = args.out; F.ws = args.ws;
    F.tid = threadIdx.x; F.lane = F.tid & 63; F.wave = __builtin_amdgcn_readfirstlane(F.tid >> 6); F.bid = blockIdx.x; F.G = gridDim.x;
    const int lo = args.ph_lo, hi = args.ph_hi;
#define IN(k) (lo <= (k) && (k) < hi)
#define SEAM(k) do { if (IN(k) && IN((k) + 1)) grid.sync(); } while (0)
    float* mods = (float*)(F.ws + WS_MODS);
    bf16* Hb = (bf16*)(F.ws + WS_H);
    if (((PH_MASK >> 0) & 1) && IN(0)) { p0_prologue(F); if (DUP == 0) { grid.sync(); p0_prologue(F); } } SEAM(0);
    if (((PH_MASK >> 1) & 1) && IN(1)) { norm_phase<true>(F, F.in[0], F.in[4], mods, mods + 1024, 6144, Hb); if (DUP == 1) { grid.sync(); norm_phase<true>(F, F.in[0], F.in[4], mods, mods + 1024, 6144, Hb); } } SEAM(1);
    if (((PH_MASK >> 2) & 1) && IN(2)) { pg8::EpiBf16<0> E{(bf16*)(F.ws + WS_PROJ), 3072, nullptr, 0, 0, 1.f}; run_gemm(F, Hb, (const bf16*)(F.ws + WS_WIN), 3072, E); if (DUP == 2) { grid.sync(); run_gemm(F, Hb, (const bf16*)(F.ws + WS_WIN), 3072, E); } } SEAM(2);
    if (((PH_MASK >> 3) & 1) && IN(3)) { p3_mlstm_local(F); if (DUP == 3) { grid.sync(); p3_mlstm_local(F); } } SEAM(3);
    if (((PH_MASK >> 4) & 1) && IN(4)) { p4_scan(F); } SEAM(4);
    if (((PH_MASK >> 5) & 1) && IN(5)) { p5_mlstm_out(F); if (DUP == 5) { grid.sync(); p5_mlstm_out(F); } } SEAM(5);
    if (((PH_MASK >> 6) & 1) && IN(6)) { pg8::EpiResid E{F.in[0], F.out, mods + 2 * 1024, 6144}; run_gemm(F, Hb, (const bf16*)(F.ws + WS_WOUT), 1024, E); } SEAM(6);
    if (((PH_MASK >> 7) & 1) && IN(7)) { norm_phase<false>(F, F.out, F.in[5], mods + 3 * 1024, mods + 4 * 1024, 6144, Hb); } SEAM(7);
    if (((PH_MASK >> 8) & 1) && IN(8)) { pg8::EpiBf16<0> E{(bf16*)(F.ws + WS_PQ), 2048, nullptr, 0, 0, 1.f}; run_gemm(F, Hb, (const bf16*)(F.ws + WS_WPQ), 2048, E); } SEAM(8);
    if (((PH_MASK >> 9) & 1) && IN(9)) { p_route(F, 0); if (DUP == 9) { grid.sync(); p_route(F, 0); } } SEAM(9);
    if (((PH_MASK >> 10) & 1) && IN(10)) { p_apply<false>(F, 0, F.out); if (DUP == 10) { grid.sync(); p_apply<true>(F, 0, (float*)(F.ws + WS_PROJ)); } } SEAM(10);
    if (((PH_MASK >> 11) & 1) && IN(11)) {
        { pg8::EpiHeadNorm E{(bf16*)(F.ws + WS_Q), (bf16*)(F.ws + WS_Q), 4, F.in[17], 0.125f, EPS}; run_gemm(F, Hb, (const bf16*)(F.ws + WS_WSQ), 1024, E); }
        { pg8::EpiHeadNorm E{(bf16*)(F.ws + WS_K), (bf16*)(F.ws + WS_VV), 4, F.in[15], 1.0f, EPS}; run_gemm(F, (const bf16*)(F.ws + WS_HB), (const bf16*)(F.ws + WS_WKV), 2048, E); }
    } SEAM(11);
    if (((PH_MASK >> 12) & 1) && IN(12)) { p12_attn(F); if (DUP == 12) { grid.sync(); p12_attn(F); } } SEAM(12);
    if (((PH_MASK >> 13) & 1) && IN(13)) { pg8::EpiResid E{F.out, F.out, mods + 16 * 6144 + 2 * 1024, 6144}; run_gemm(F, Hb, (const bf16*)(F.ws + WS_WSO), 1024, E); } SEAM(13);
    if (((PH_MASK >> 14) & 1) && IN(14)) { norm_phase<false>(F, F.out, F.in[5] + 1024, mods + 16 * 6144 + 3 * 1024, mods + 16 * 6144 + 4 * 1024, 6144, Hb); } SEAM(14);
    if (((PH_MASK >> 15) & 1) && IN(15)) { pg8::EpiBf16<0> E{(bf16*)(F.ws + WS_PQ), 2048, nullptr, 0, 0, 1.f}; run_gemm(F, Hb, (const bf16*)(F.ws + WS_WPQ) + (size_t)2048 * 1024, 2048, E); } SEAM(15);
    if (((PH_MASK >> 16) & 1) && IN(16)) { p_route(F, 1); } SEAM(16);
    if (((PH_MASK >> 17) & 1) && IN(17)) { p_apply<true>(F, 1, F.out); }
#undef IN
#undef SEAM
}

extern "C" void kernel_launch(void* const* d_in, const int* in_sizes, int n_in, void* d_out, int out_size, void* d_ws, size_t ws_size, hipStream_t stream) {
    static int grid = 0;
    if (grid == 0) {
        int dev = 0, cus = 0, per_cu = 0;
        (void)hipGetDevice(&dev);
        (void)hipDeviceGetAttribute(&cus, hipDeviceAttributeMultiprocessorCount, dev);
        (void)hipFuncSetAttribute((const void*)fwd, hipFuncAttributeMaxDynamicSharedMemorySize, LDS_BYTES);
        (void)hipOccupancyMaxActiveBlocksPerMultiprocessor(&per_cu, (const void*)fwd, NT, LDS_BYTES);
        if (per_cu < 1) { fprintf(stderr, "kernel_launch: occupancy query says %d blocks per CU\n", per_cu); per_cu = 1; }
        grid = cus;
        if (n_in != 23 || ws_size < WS_END) fprintf(stderr, "kernel_launch: unexpected n_in %d / ws_size %zu\n", n_in, ws_size);
        (void)hipGetLastError();
    }
    Args a{};
    for (int i = 0; i < 23; ++i) a.in[i] = (const float*)d_in[i];
    a.out = (float*)d_out; a.ws = (unsigned char*)d_ws;
#if N_LAUNCH_MODE == 1
    a.ph_lo = 0; a.ph_hi = NPH;
    void* kargs[] = {&a};
    hipError_t e = hipLaunchCooperativeKernel((const void*)fwd, dim3(grid), dim3(NT), kargs, LDS_BYTES, stream);
    if (e != hipSuccess) fprintf(stderr, "kernel_launch: cooperative launch failed: %s (grid %d)\n", hipGetErrorString(e), grid);
#else
    for (int p = 0; p < NPH; ++p) { a.ph_lo = p; a.ph_hi = p + 1; hipLaunchKernelGGL(fwd, dim3(grid), dim3(NT), LDS_BYTES, stream, a); }
#endif
}
```

```cpp
#include <hip/hip_runtime.h>
#include <hip/hip_cooperative_groups.h>
#include <cstdio>
#include <cstdint>
namespace cg = cooperative_groups;
#define N_LAUNCH_MODE 1
#define DUP 21
namespace pg8 {
#define PG8_LAS __attribute__((address_space(3)))
typedef unsigned short bf16_t;
typedef short bf16x8 __attribute__((ext_vector_type(8)));
typedef float f32x4 __attribute__((ext_vector_type(4)));
typedef unsigned u32x4 __attribute__((ext_vector_type(4)));
constexpr int BM = 256, BK = 64, HALF = 128, HTB = HALF * BK * 2  , STAGE_BYTES = 8 * HTB, NXCD = 8, WGM = 8;

__host__ __device__ __forceinline__ int lds_byte(int r, int c) { const int st = (r >> 4) * 2 + (c >> 5), rr = r & 15, cc = c & 31, ob = rr * 64 + cc * 2; return st * 1024 + (ob ^ (((ob >> 9) & 1) << 5)); }
__host__ __device__ __forceinline__ void stage_rc(int b, int& R, int& C) { const int st = b / 1024, sb = b % 1024, swz = sb ^ (((sb >> 9) & 1) << 5); R = (st >> 1) * 16 + swz / 64; C = (st & 1) * 32 + (swz % 64) / 2; }
__host__ __device__ __forceinline__ int perm32(int rho) { const int n = rho >> 4, i = rho & 15; return 8 * (i >> 2) + 4 * n + (i & 3); }

struct Unit { int pm, pn; };
struct Gemm { const bf16_t* A; const bf16_t* Bt; int M, N, K; };

struct StaticOrder {
    int nM, nN, nwg, G, c;
    __host__ __device__ void init(int M, int N, int G_, int c_) { nM = M / BM; nN = N / BM; nwg = nM * nN; G = G_; c = c_; }
    __host__ __device__ bool next(int i, Unit& u) const {
        const long L = (long)i * G + c; if (L >= nwg) return false;
        int wgid = (int)L; { const int q = nwg / NXCD, r = nwg % NXCD, xcd = wgid % NXCD, off = wgid / NXCD; wgid = (xcd < r ? xcd * (q + 1) : r * (q + 1) + (xcd - r) * q) + off; }
        const int nig = WGM * nN, gid = wgid / nig, fm = gid * WGM, gsz = (nM - fm) < WGM ? (nM - fm) : WGM;
        u.pm = fm + ((wgid % nig) % gsz); u.pn = (wgid % nig) / gsz; return true;
    }
    __device__ __forceinline__ void a_ready(const Unit&) const {}
    __device__ __forceinline__ void done(const Unit&) const {}
};

__device__ __forceinline__ unsigned cvt_pk_bf16(float lo, float hi) { unsigned r; asm volatile("v_cvt_pk_bf16_f32 %0, %1, %2" : "=v"(r) : "v"(lo), "v"(hi)); return r; }
typedef float f32x2 __attribute__((ext_vector_type(2)));
__device__ __forceinline__ f32x2 gelu_pk(f32x2 v) {
    const f32x2 av = __builtin_elementwise_abs(v), d = av * 0.2316418882f + 1.0f;
    f32x2 t; t.x = __builtin_amdgcn_rcpf(d.x); t.y = __builtin_amdgcn_rcpf(d.y);
    f32x2 q = t * 0.5307027145f + (-0.7265760135f); q = q * t + 0.7107068705f; q = q * t + (-0.142248368f); q = q * t + 0.127414796f; q = q * t;
    const f32x2 s = (v * v) * (-0.72134752044f);
    f32x2 e; e.x = __builtin_amdgcn_exp2f(s.x); e.y = __builtin_amdgcn_exp2f(s.y);
    const f32x2 m = v * (q * e), r = v - m;
    f32x2 o; o.x = v.x < 0.f ? m.x : r.x; o.y = v.y < 0.f ? m.y : r.y; return o;
}

template <int ACT  > struct EpiBf16 {
    static constexpr bool PERM = true, AFTER_DRAIN = false; static_assert(ACT == 0 || ACT == 1, "EpiBf16: ACT is 0 (none) or 1 (gelu_pk)");
    bf16_t* O; int ldc; const float* bias; int split_cols; size_t split_stride; float scale0;
    __device__ __forceinline__ void operator()(const f32x4 (&acc)[2][2][4][2], const Unit& u, int wr, int wc, int fr, int fq) const {
        const int row0 = u.pm * BM + wr * 64 + fr; int colt = u.pn * BM; bf16_t* base = O;
        float sc = 1.f; if (split_cols) { const int t = colt / split_cols; base += (size_t)t * split_stride; colt -= t * split_cols; if (t == 0) sc = scale0; }
        const int col0 = colt + wc * 32 + 8 * fq, bcol0 = u.pn * BM + wc * 32 + 8 * fq;
        f32x4 bv[2][2];
#pragma unroll
        for (int bj = 0; bj < 2; ++bj)
#pragma unroll
            for (int n = 0; n < 2; ++n) bv[bj][n] = bias ? *(const f32x4*)(bias + bcol0 + bj * HALF + 4 * n) : (f32x4){0.f, 0.f, 0.f, 0.f};
#pragma unroll
        for (int ai = 0; ai < 2; ++ai)
#pragma unroll
            for (int m = 0; m < 4; ++m) { bf16_t* rowp = base + (size_t)(row0 + ai * HALF + m * 16) * ldc + col0;
#pragma unroll
                for (int bj = 0; bj < 2; ++bj) { f32x4 v0 = acc[ai][bj][m][0] + bv[bj][0], v1 = acc[ai][bj][m][1] + bv[bj][1];
                    if (ACT == 1) { f32x2 a = gelu_pk((f32x2){v0[0], v0[1]}), b = gelu_pk((f32x2){v0[2], v0[3]}), c = gelu_pk((f32x2){v1[0], v1[1]}), d = gelu_pk((f32x2){v1[2], v1[3]});
                        v0 = (f32x4){a.x, a.y, b.x, b.y}; v1 = (f32x4){c.x, c.y, d.x, d.y}; }
                    v0 = v0 * sc; v1 = v1 * sc; u32x4 w; w.x = cvt_pk_bf16(v0[0], v0[1]); w.y = cvt_pk_bf16(v0[2], v0[3]); w.z = cvt_pk_bf16(v1[0], v1[1]); w.w = cvt_pk_bf16(v1[2], v1[3]);
                    *(u32x4*)(rowp + bj * HALF) = w; } }
    }
};
struct EpiResid {
    static constexpr bool PERM = false, AFTER_DRAIN = false;
    const float* base; float* out; const float* gate; int gstride;
    __device__ __forceinline__ void operator()(const f32x4 (&acc)[2][2][4][2], const Unit& u, int wr, int wc, int fr, int fq) const {
        const int col0 = u.pn * BM + wc * 32 + 4 * fq;
        const int b = (u.pm * BM) >> 11;
        f32x4 gv[2][2];
#pragma unroll
        for (int bj = 0; bj < 2; ++bj)
#pragma unroll
            for (int n = 0; n < 2; ++n) gv[bj][n] = *(const f32x4*)(gate + (size_t)b * gstride + col0 + bj * HALF + n * 16);
#pragma unroll
        for (int ai = 0; ai < 2; ++ai)
#pragma unroll
            for (int m = 0; m < 4; ++m) { const size_t off = (size_t)(u.pm * BM + ai * HALF + wr * 64 + m * 16 + fr) * 1024 + col0;
#pragma unroll
                for (int bj = 0; bj < 2; ++bj)
#pragma unroll
                    for (int n = 0; n < 2; ++n) { const f32x4 bs = *(const f32x4*)(base + off + bj * HALF + n * 16);
                        *(f32x4*)(out + off + bj * HALF + n * 16) = bs + gv[bj][n] * acc[ai][bj][m][n]; }
                if (m & 1) asm volatile("" ::: "memory"); }
    }
};
struct EpiHeadNorm {
    static constexpr bool PERM = true, AFTER_DRAIN = false;
    bf16_t* O0; bf16_t* O1; int ntile_norm; const float* g; float scale; float eps;
    __device__ __forceinline__ void operator()(const f32x4 (&acc)[2][2][4][2], const Unit& u, int wr, int wc, int fr, int fq) const {
        const bool nrm = u.pn < ntile_norm; bf16_t* O = nrm ? O0 : O1; const int pnl = nrm ? u.pn : u.pn - ntile_norm;
        f32x4 gv[2][2];
#pragma unroll
        for (int bj = 0; bj < 2; ++bj)
#pragma unroll
            for (int n = 0; n < 2; ++n) { const f32x4 t = *(const f32x4*)(g + 32 * bj + 8 * fq + 4 * n); gv[bj][n] = nrm ? t * scale : (f32x4){1.f, 1.f, 1.f, 1.f}; }
#pragma unroll
        for (int ai = 0; ai < 2; ++ai)
#pragma unroll
            for (int m = 0; m < 4; ++m) {
                float ss = 0.f;
#pragma unroll
                for (int bj = 0; bj < 2; ++bj)
#pragma unroll
                    for (int n = 0; n < 2; ++n) { const f32x4 x = acc[ai][bj][m][n]; ss += (x[0] * x[0] + x[1] * x[1]) + (x[2] * x[2] + x[3] * x[3]); }
                ss += __shfl_xor(ss, 16); ss += __shfl_xor(ss, 32);
                const float rs = nrm ? 1.0f / sqrtf(ss * (1.0f / 64.0f) + eps) : 1.0f;
                bf16_t* rowp = O + (size_t)(u.pm * BM + ai * HALF + wr * 64 + m * 16 + fr) * 1024 + pnl * BM + wc * 64 + 8 * fq;
#pragma unroll
                for (int bj = 0; bj < 2; ++bj) { const f32x4 v0 = acc[ai][bj][m][0] * rs * gv[bj][0], v1 = acc[ai][bj][m][1] * rs * gv[bj][1];
                    u32x4 w; w.x = cvt_pk_bf16(v0[0], v0[1]); w.y = cvt_pk_bf16(v0[2], v0[3]); w.z = cvt_pk_bf16(v1[0], v1[1]); w.w = cvt_pk_bf16(v1[2], v1[3]);
                    *(u32x4*)(rowp + bj * 32) = w; }
            }
    }
};
template <class Epi, class Sched, bool ALIGN_EPI = false, bool SP2 = false>
__device__ __forceinline__ void gemm_phase(PG8_LAS unsigned char* lds, const Gemm g, const Sched& S, const Epi& E) {
    const int tid = threadIdx.x, wid = __builtin_amdgcn_readfirstlane(tid >> 6), lane = tid & 63, wr = wid >> 2, wc = wid & 3, fr = lane & 15, fq = lane >> 4;
    const int K = g.K, nt = K / BK;
    unsigned voffA[2], voffB[2];
#pragma unroll
    for (int i = 0; i < 2; ++i) { int R, C; stage_rc(tid * 16 + i * 8192, R, C); const int Rb = Epi::PERM ? ((R & ~31) + perm32(R & 31)) : R;
        voffA[i] = (unsigned)(R * K + C) * 2u; voffB[i] = (unsigned)(Rb * K + C) * 2u; }
    const size_t kstep = (size_t)(BK * 2);
    const size_t hstep = (size_t)HALF * K * 2;
    const size_t tstep = 2 * hstep;
    const unsigned ldsw = (unsigned)wid * 1024u;
    const int aoff = lds_byte(wr * 64 + fr, fq * 8), boff = lds_byte(wc * 32 + fr, fq * 8);
#define PG8_SA(b, h) (((b) * 2 + (h)) * HTB)
#define PG8_SB(b, h) ((4 + (b) * 2 + (h)) * HTB)
#define PG8_STAGE(bufoff, gbase, voff) do { _Pragma("unroll") for (int _i = 0; _i < 2; ++_i) \
        __builtin_amdgcn_global_load_lds((const unsigned*)((const char*)(gbase) + (voff)[_i]), (PG8_LAS unsigned*)(lds + (bufoff) + ldsw + _i * 8192), 16, 0, 0); } while (0)
#define PG8_LDA(dst, b, h) do { _Pragma("unroll") for (int m = 0; m < 4; ++m) _Pragma("unroll") for (int k = 0; k < 2; ++k) dst[m][k] = *(const PG8_LAS bf16x8*)(lds + PG8_SA(b, h) + aoff + m * 2048 + k * 1024); } while (0)
#define PG8_LDB(dst, b, h) do { _Pragma("unroll") for (int n = 0; n < 2; ++n) _Pragma("unroll") for (int k = 0; k < 2; ++k) dst[n][k] = *(const PG8_LAS bf16x8*)(lds + PG8_SB(b, h) + boff + n * 2048 + k * 1024); } while (0)
#define PG8_MMA(ai, bj, At, Bt) do { __builtin_amdgcn_s_setprio(1); _Pragma("unroll") for (int m = 0; m < 4; ++m) _Pragma("unroll") for (int n = 0; n < 2; ++n) _Pragma("unroll") for (int k = 0; k < 2; ++k) \
        acc[ai][bj][m][n] = __builtin_amdgcn_mfma_f32_16x16x32_bf16(Bt[n][k], At[m][k], acc[ai][bj][m][n], 0, 0, 0); __builtin_amdgcn_s_setprio(0); } while (0)
#define PG8_WAIT_V(n) asm volatile("s_waitcnt vmcnt(" #n ")" ::: "memory")
#define PG8_WAIT_L(n) asm volatile("s_waitcnt lgkmcnt(" #n ")" ::: "memory")
#define PG8_BAR __builtin_amdgcn_s_barrier()
#define PG8_SCHED __builtin_amdgcn_sched_barrier(0)
    Unit cur, nxt; int ui = 0;
    if (!S.next(0, cur)) return;
    f32x4 acc[2][2][4][2];
#pragma unroll
    for (int a = 0; a < 2; ++a)
#pragma unroll
        for (int b = 0; b < 2; ++b)
#pragma unroll
            for (int m = 0; m < 4; ++m)
#pragma unroll
                for (int n = 0; n < 2; ++n) acc[a][b][m][n] = (f32x4){0.f, 0.f, 0.f, 0.f};
    bf16x8 At[4][2], B0[2][2], B1[2][2];
    const char* cA = (const char*)g.A + (size_t)cur.pm * tstep; const char* cB = (const char*)g.Bt + (size_t)cur.pn * tstep;
    S.a_ready(cur);
    if constexpr (SP2) {
        PG8_STAGE(PG8_SB(0, 0), cB, voffB); PG8_STAGE(PG8_SB(0, 1), cB + hstep, voffB); PG8_STAGE(PG8_SA(0, 0), cA, voffA); PG8_STAGE(PG8_SA(0, 1), cA + hstep, voffA);
        if (wr == 1) PG8_BAR;
        PG8_WAIT_V(2); PG8_BAR;
        PG8_STAGE(PG8_SB(1, 0), cB + kstep, voffB); PG8_STAGE(PG8_SA(1, 0), cA + kstep, voffA); PG8_STAGE(PG8_SB(1, 1), cB + hstep + kstep, voffB);
        PG8_WAIT_V(6); PG8_BAR;
    } else {
        PG8_STAGE(PG8_SB(0, 0), cB, voffB); PG8_STAGE(PG8_SA(0, 0), cA, voffA); PG8_STAGE(PG8_SB(0, 1), cB + hstep, voffB); PG8_STAGE(PG8_SA(0, 1), cA + hstep, voffA);
        if (wr == 1) PG8_BAR;
        PG8_WAIT_V(4); PG8_BAR;
        PG8_STAGE(PG8_SB(1, 0), cB + kstep, voffB); PG8_STAGE(PG8_SA(1, 0), cA + kstep, voffA); PG8_STAGE(PG8_SB(1, 1), cB + hstep + kstep, voffB);
        PG8_WAIT_V(6); PG8_BAR;
    }
    for (;;) {
        const bool has_next = S.next(ui + 1, nxt);
        const char* nA = has_next ? (const char*)g.A + (size_t)nxt.pm * tstep : cA; const char* nB = has_next ? (const char*)g.Bt + (size_t)nxt.pn * tstep : cB;
        for (int t = 0; t < nt; t += 2) {
            const bool last = (t == nt - 2);
            const char* a1 = cA + (size_t)(t + 1) * kstep;
            const char* a2 = last ? nA : cA + (size_t)(t + 2) * kstep; const char* b2 = last ? nB : cB + (size_t)(t + 2) * kstep;
            const char* a3 = a2 + kstep; const char* b3 = b2 + kstep;
            if (last && has_next) S.a_ready(nxt);
            if constexpr (SP2) {
            PG8_LDB(B0, 0, 0); PG8_LDB(B1, 0, 1); PG8_SCHED; PG8_LDA(At, 0, 0); PG8_STAGE(PG8_SA(1, 1), a1 + hstep, voffA);
            PG8_WAIT_V(8); PG8_WAIT_L(0); PG8_BAR; PG8_MMA(0, 0, At, B0); PG8_MMA(0, 1, At, B1); PG8_BAR; PG8_SCHED;
            PG8_LDA(At, 0, 1); PG8_STAGE(PG8_SB(0, 0), b2, voffB); PG8_STAGE(PG8_SB(0, 1), b2 + hstep, voffB); PG8_STAGE(PG8_SA(0, 0), a2, voffA);
            PG8_WAIT_V(8); PG8_WAIT_L(0); PG8_BAR; PG8_MMA(1, 0, At, B0); PG8_MMA(1, 1, At, B1); PG8_BAR; PG8_SCHED;
            PG8_LDB(B0, 1, 0); PG8_LDB(B1, 1, 1); PG8_SCHED; PG8_LDA(At, 1, 0); PG8_STAGE(PG8_SA(0, 1), a2 + hstep, voffA);
            PG8_WAIT_V(8); PG8_WAIT_L(0); PG8_BAR; PG8_MMA(0, 0, At, B0); PG8_MMA(0, 1, At, B1); PG8_BAR; PG8_SCHED;
            PG8_LDA(At, 1, 1); PG8_STAGE(PG8_SB(1, 0), b3, voffB); PG8_STAGE(PG8_SB(1, 1), b3 + hstep, voffB); PG8_STAGE(PG8_SA(1, 0), a3, voffA);
            PG8_WAIT_V(8); PG8_WAIT_L(0); PG8_BAR; PG8_MMA(1, 0, At, B0); PG8_MMA(1, 1, At, B1); PG8_BAR; PG8_SCHED;
            } else {
            PG8_LDB(B0, 0, 0); PG8_SCHED; PG8_LDA(At, 0, 0); PG8_STAGE(PG8_SA(1, 1), a1 + hstep, voffA);
            PG8_WAIT_L(8); PG8_BAR; PG8_WAIT_L(0); PG8_MMA(0, 0, At, B0); PG8_BAR; PG8_SCHED;
            PG8_LDB(B1, 0, 1); PG8_STAGE(PG8_SB(0, 0), b2, voffB);
            PG8_BAR; PG8_WAIT_L(0); PG8_MMA(0, 1, At, B1); PG8_BAR;
            PG8_LDA(At, 0, 1); PG8_STAGE(PG8_SA(0, 0), a2, voffA);
            PG8_BAR; PG8_WAIT_L(0); PG8_MMA(1, 0, At, B0); PG8_BAR; PG8_SCHED;
            PG8_STAGE(PG8_SB(0, 1), b2 + hstep, voffB);
            PG8_WAIT_V(6); PG8_BAR; PG8_MMA(1, 1, At, B1); PG8_BAR;
            PG8_LDB(B0, 1, 0); PG8_SCHED; PG8_LDA(At, 1, 0); PG8_STAGE(PG8_SA(0, 1), a2 + hstep, voffA);
            PG8_WAIT_L(8); PG8_BAR; PG8_WAIT_L(0); PG8_MMA(0, 0, At, B0); PG8_BAR; PG8_SCHED;
            PG8_LDB(B1, 1, 1); PG8_STAGE(PG8_SB(1, 0), b3, voffB);
            PG8_BAR; PG8_WAIT_L(0); PG8_MMA(0, 1, At, B1); PG8_BAR;
            PG8_LDA(At, 1, 1); PG8_STAGE(PG8_SA(1, 0), a3, voffA);
            PG8_BAR; PG8_WAIT_L(0); PG8_MMA(1, 0, At, B0); PG8_BAR; PG8_SCHED;
            PG8_STAGE(PG8_SB(1, 1), b3 + hstep, voffB);
            PG8_WAIT_V(6); PG8_BAR; PG8_MMA(1, 1, At, B1); PG8_BAR;
            }
        }
        if constexpr (ALIGN_EPI) { if (wr == 0) PG8_BAR; }
        if constexpr (!Epi::AFTER_DRAIN) { E(acc, cur, wr, wc, fr, fq); S.done(cur); }
        if (!has_next) break;
#pragma unroll
        for (int a = 0; a < 2; ++a)
#pragma unroll
            for (int b = 0; b < 2; ++b)
#pragma unroll
                for (int m = 0; m < 4; ++m)
#pragma unroll
                    for (int n = 0; n < 2; ++n) acc[a][b][m][n] = (f32x4){0.f, 0.f, 0.f, 0.f};
        cur = nxt; cA = nA; cB = nB; ++ui;
        if constexpr (ALIGN_EPI) { if (wr == 1) PG8_BAR; }
    }
    PG8_WAIT_V(0);
    if constexpr (!ALIGN_EPI) { if (wr == 0) PG8_BAR; }
    PG8_BAR;
    if constexpr (Epi::AFTER_DRAIN) { E.fused(acc, cur, wr, wc, fr, fq, lds, wid, lane); S.done(cur); }
#undef PG8_SA
#undef PG8_SB
#undef PG8_STAGE
#undef PG8_LDA
#undef PG8_LDB
#undef PG8_MMA
#undef PG8_WAIT_V
#undef PG8_WAIT_L
#undef PG8_BAR
#undef PG8_SCHED
}
}

#define DI __device__ __forceinline__
#define LAS __attribute__((address_space(3)))
typedef unsigned short bf16;
typedef __bf16 bf16x2_t __attribute__((ext_vector_type(2)));
typedef float f32x2_t __attribute__((ext_vector_type(2)));
typedef float f32x4 __attribute__((ext_vector_type(4)));
typedef float f32x16 __attribute__((ext_vector_type(16)));
typedef short bf16x8 __attribute__((ext_vector_type(8)));
typedef short s16x4 __attribute__((ext_vector_type(4)));
typedef unsigned u32x4 __attribute__((ext_vector_type(4)));
typedef unsigned u32x2 __attribute__((ext_vector_type(2)));

constexpr int NT = 512, NWAVES = 8;
constexpr int LDS_BYTES = 147456;
constexpr int T_TOK = 32768, DM = 1024, SEQ = 2048, NB = 16;
constexpr float EPS = 1e-6f;
constexpr size_t MiB = 1u << 20;
constexpr size_t WS_MODS = 1 * MiB, WS_KVMODS = WS_MODS + (size_t)2 * 16 * 6144 * 4;
constexpr size_t WS_GATES = 2 * MiB, WS_BLAST = 4 * MiB, WS_MLOC = 4 * MiB + 65536, WS_MPREV = 4 * MiB + 131072, WS_NLOC = 5 * MiB;
constexpr size_t WS_WG = 6 * MiB, WS_SUBK = 7 * MiB;
constexpr size_t WS_WIN = 8 * MiB, WS_WOUT = 14 * MiB, WS_WKV = 16 * MiB, WS_WSQ = 20 * MiB, WS_WSO = 22 * MiB, WS_WPQ = 24 * MiB;
constexpr size_t WS_IDX = 36 * MiB, WS_GATE = 44 * MiB;
constexpr size_t WS_U = 64 * MiB, WS_V = 128 * MiB, WS_H = 192 * MiB, WS_HB = 256 * MiB, WS_PROJ = 320 * MiB, WS_END = 512 * MiB;
constexpr size_t WS_CST = WS_HB;
constexpr size_t WS_Q = WS_PROJ, WS_K = WS_PROJ + 64 * MiB, WS_VV = WS_PROJ + 128 * MiB, WS_PQ = WS_PROJ;

struct Args { const float* in[23]; float* out; unsigned char* ws; int ph_lo, ph_hi; };
struct Frame {
    LAS unsigned char* lds;
    const float* in[23]; float* out; unsigned char* ws;
    int tid, lane, wave, bid, G;
};

DI unsigned cvtpk(float lo, float hi) { f32x2_t v = {lo, hi}; bf16x2_t b = __builtin_convertvector(v, bf16x2_t); return __builtin_bit_cast(unsigned, b); }
DI float bflo(unsigned u) { return __uint_as_float(u << 16); }
DI float bfhi(unsigned u) { return __uint_as_float(u & 0xffff0000u); }
DI float wave_sum(float v) {
#pragma unroll
    for (int o = 1; o < 64; o <<= 1) v += __shfl_xor(v, o);
    return v;
}
DI float wave_max(float v) {
#pragma unroll
    for (int o = 1; o < 64; o <<= 1) v = fmaxf(v, __shfl_xor(v, o));
    return v;
}
DI int crow(int r, int hi) { return (r & 3) + 8 * (r >> 2) + 4 * hi; }
#define MFMA32(a, b, c) __builtin_amdgcn_mfma_f32_32x32x16_bf16((a), (b), (c), 0, 0, 0)
typedef short v4i16_t __attribute__((ext_vector_type(4)));
DI s16x4 tr16(const LAS unsigned char* p) { return __builtin_bit_cast(s16x4, __builtin_amdgcn_ds_read_tr16_b64_v4i16((LAS v4i16_t*)p)); }
DI int tr_off(int tok, int ch) { return (ch >> 2) * 4096 + (tok >> 4) * 1024 + (tok & 15) * 64 + (ch & 3) * 16; }
DI bf16x8 tr_frag(const LAS unsigned char* img, int dh, int ks, int lane) {
    const int hi = lane >> 5; const int vb = ((lane >> 4) & 1) * 32 + (lane & 3) * 8 + (4 * hi + ((lane & 15) >> 2)) * 64;
    const s16x4 lo = tr16(img + vb + dh * 4096 + ks * 1024), h2 = tr16(img + vb + dh * 4096 + ks * 1024 + 512);
    return __builtin_shufflevector(lo, h2, 0, 1, 2, 3, 4, 5, 6, 7);
}
template <int NTOK> DI bf16x8 row_frag(const LAS unsigned char* img, int tt, int ks, int lane) {
    const int hi = lane >> 5, r32 = lane & 31;
    return *(const LAS bf16x8*)(img + (2 * ks + hi) * (NTOK * 16) + (32 * tt + r32) * 16);
}
DI bf16x8 pack8(const f32x16& x, int s) {
    u32x4 p; p.x = cvtpk(x[8 * s], x[8 * s + 1]); p.y = cvtpk(x[8 * s + 2], x[8 * s + 3]); p.z = cvtpk(x[8 * s + 4], x[8 * s + 5]); p.w = cvtpk(x[8 * s + 6], x[8 * s + 7]);
    return __builtin_bit_cast(bf16x8, p);
}

DI void p0_ada(Frame& F) {
    LAS float* sil = (LAS float*)F.lds;
    LAS float* red = (LAS float*)(F.lds + 65536);
    const float* c = F.in[1];
    for (int i = F.tid; i < 16 * 1024; i += NT) { const int b = i >> 10, d = i & 1023; const float v = c[i]; sil[d * 16 + b] = v / (1.f + expf(-v)); }
    __syncthreads();
    for (int item = F.bid; item < 224; item += F.G) {
        const float* W; const float* bias; float* out; int N, col0;
        if (item < 192) { const int layer = item / 96, it = item % 96; W = F.in[2] + (size_t)layer * 1024 * 6144; bias = F.in[3] + layer * 6144; N = 6144; col0 = it * 64; out = (float*)(F.ws + WS_MODS) + (size_t)layer * 16 * 6144; }
        else { const int it = item - 192; W = F.in[11]; bias = F.in[12]; N = 2048; col0 = it * 64; out = (float*)(F.ws + WS_KVMODS); }
        float acc[16];
#pragma unroll
        for (int b = 0; b < 16; ++b) acc[b] = 0.f;
        const int d0 = F.wave * 128;
        const float* wp = W + (size_t)d0 * N + col0 + F.lane;
#pragma unroll 4
        for (int d = 0; d < 128; ++d) {
            const float w = wp[(size_t)d * N];
            const LAS f32x4* s4 = (const LAS f32x4*)(sil + (d0 + d) * 16);
            const f32x4 s0 = s4[0], s1 = s4[1], s2 = s4[2], s3 = s4[3];
            acc[0] += w * s0[0]; acc[1] += w * s0[1]; acc[2] += w * s0[2]; acc[3] += w * s0[3];
            acc[4] += w * s1[0]; acc[5] += w * s1[1]; acc[6] += w * s1[2]; acc[7] += w * s1[3];
            acc[8] += w * s2[0]; acc[9] += w * s2[1]; acc[10] += w * s2[2]; acc[11] += w * s2[3];
            acc[12] += w * s3[0]; acc[13] += w * s3[1]; acc[14] += w * s3[2]; acc[15] += w * s3[3];
        }
#pragma unroll
        for (int b = 0; b < 16; ++b) red[(F.wave * 16 + b) * 64 + F.lane] = acc[b];
        __syncthreads();
        for (int i = F.tid; i < 1024; i += NT) { const int b = i >> 6, l = i & 63; float s = 0.f;
#pragma unroll
            for (int w = 0; w < 8; ++w) s += red[(w * 16 + b) * 64 + l];
            out[(size_t)b * N + col0 + l] = s + bias[col0 + l]; }
        __syncthreads();
    }
}
DI void transpose_item(const float* W, int ldw, bf16* WT, int dst_row0, LAS float* scr, int k0, int n0, int lane) {
#pragma unroll 8
    for (int i = 0; i < 32; ++i) { const int kk = 2 * i + (lane >> 5); scr[kk * 33 + (lane & 31)] = W[(size_t)(k0 + kk) * ldw + n0 + (lane & 31)]; }
    asm volatile("s_waitcnt lgkmcnt(0)" ::: "memory");
    const int c = lane & 7;
#pragma unroll
    for (int j = 0; j < 4; ++j) { const int n = (lane >> 3) + 8 * j; const LAS float* s = scr + (8 * c) * 33 + n;
        u32x4 o; o.x = cvtpk(s[0 * 33], s[1 * 33]); o.y = cvtpk(s[2 * 33], s[3 * 33]); o.z = cvtpk(s[4 * 33], s[5 * 33]); o.w = cvtpk(s[6 * 33], s[7 * 33]);
        *(u32x4*)(WT + (size_t)(dst_row0 + n) * 1024 + k0 + 8 * c) = o; }
    asm volatile("s_waitcnt lgkmcnt(0)" ::: "memory");
}
DI int permrow(int c) { return (c & ~255) + 32 * (4 * ((c >> 5) & 1) + ((c >> 6) & 3)) + (c & 31); }
DI void p0_prologue(Frame& F) {
    p0_ada(F);
    LAS float* scr = (LAS float*)(F.lds + F.wave * 16384);
    const int gw = F.bid * NWAVES + F.wave, NGW = F.G * NWAVES;
    for (int it = gw; it < 6144; it += NGW) {
        int r = it; const float* W; int ldw, ncols; bf16* dst; bool perm;
        if (r < 1536) { W = F.in[6]; ldw = 3088; ncols = 3072; dst = (bf16*)(F.ws + WS_WIN); perm = false; }
        else if ((r -= 1536) < 512) { W = F.in[10]; ldw = 1024; ncols = 1024; dst = (bf16*)(F.ws + WS_WOUT); perm = false; }
        else if ((r -= 512) < 1024) { W = F.in[14]; ldw = 2048; ncols = 2048; dst = (bf16*)(F.ws + WS_WKV); perm = true; }
        else if ((r -= 1024) < 512) { W = F.in[16]; ldw = 1024; ncols = 1024; dst = (bf16*)(F.ws + WS_WSQ); perm = true; }
        else if ((r -= 512) < 512) { W = F.in[18]; ldw = 1024; ncols = 1024; dst = (bf16*)(F.ws + WS_WSO); perm = false; }
        else if ((r -= 512) < 1024) { W = F.in[19]; ldw = 2048; ncols = 2048; dst = (bf16*)(F.ws + WS_WPQ); perm = false; }
        else { r -= 1024; W = F.in[19] + (size_t)1024 * 2048; ldw = 2048; ncols = 2048; dst = (bf16*)(F.ws + WS_WPQ) + (size_t)2048 * 1024; perm = false; }
        const int nblk = ncols / 32, kb = r / nblk, nb = r % nblk, n0 = 32 * nb;
        transpose_item(W, ldw, dst, perm ? permrow(n0) : n0, scr, 64 * kb, n0, F.lane);
    }
    const size_t gt = (size_t)F.bid * NT + F.tid, NGT = (size_t)F.G * NT;
    constexpr size_t TBL16 = (size_t)2 * 16384 * 1024 / 16;
    for (size_t i = gt; i < 2 * TBL16; i += NGT) {
        const bool isv = i >= TBL16; const size_t j = isv ? i - TBL16 : i; const float sc = isv ? 4.f : 32.f;
        const f32x4* src = (const f32x4*)(isv ? F.in[22] : F.in[21]) + 4 * j;
        const f32x4 a = src[0] * sc, b = src[1] * sc, c2 = src[2] * sc, d = src[3] * sc;
        int p0 = 0, p1 = 0, p2 = 0, p3 = 0;
        p0 = __builtin_amdgcn_cvt_pk_fp8_f32(a[0], a[1], p0, false); p0 = __builtin_amdgcn_cvt_pk_fp8_f32(a[2], a[3], p0, true);
        p1 = __builtin_amdgcn_cvt_pk_fp8_f32(b[0], b[1], p1, false); p1 = __builtin_amdgcn_cvt_pk_fp8_f32(b[2], b[3], p1, true);
        p2 = __builtin_amdgcn_cvt_pk_fp8_f32(c2[0], c2[1], p2, false); p2 = __builtin_amdgcn_cvt_pk_fp8_f32(c2[2], c2[3], p2, true);
        p3 = __builtin_amdgcn_cvt_pk_fp8_f32(d[0], d[1], p3, false); p3 = __builtin_amdgcn_cvt_pk_fp8_f32(d[2], d[3], p3, true);
        size_t dj = j;
        if (isv) { const size_t q = j & 63, e = (j >> 6) & 16383, ly = j >> 20; dj = (((ly * 8 + (q >> 3)) * 16384 + e) << 3) + (q & 7); }
        ((u32x4*)(F.ws + (isv ? WS_V : WS_U)))[dj] = (u32x4){(unsigned)p0, (unsigned)p1, (unsigned)p2, (unsigned)p3};
    }
    for (size_t i = gt; i < 65536 / 2; i += NGT) { const float a = F.in[20][2 * i], b = F.in[20][2 * i + 1]; ((unsigned*)(F.ws + WS_SUBK))[i] = cvtpk(a, b); }
    for (size_t i = gt; i < 16 * 1024; i += NGT) { const int g = (int)(i >> 10), k = (int)(i & 1023); ((float*)(F.ws + WS_WG))[i] = F.in[6][(size_t)k * 3088 + 3072 + g]; }
}

template <bool GATES> DI void norm_phase(Frame& F, const float* xin, const float* g, const float* shp, const float* scp, int bstride, bf16* hout) {
    const int gw = F.bid * NWAVES + F.wave, NGW = F.G * NWAVES;
    LAS float* wg = (LAS float*)F.lds;
    if (GATES) { const float* src = (const float*)(F.ws + WS_WG); for (int i = F.tid; i < 16 * 1024 / 4; i += NT) ((LAS f32x4*)wg)[i] = ((const f32x4*)src)[i]; __syncthreads(); }
    for (int chunk = gw; chunk < T_TOK / 16; chunk += NGW) {
        const int row0 = chunk * 16, b = row0 >> 11;
        f32x4 A[4], Bv[4];
#pragma unroll
        for (int j = 0; j < 4; ++j) { const int c = 4 * F.lane + 256 * j; const f32x4 gg = *(const f32x4*)(g + c), sc = *(const f32x4*)(scp + (size_t)b * bstride + c);
            A[j] = gg * (sc + 1.0f); Bv[j] = *(const f32x4*)(shp + (size_t)b * bstride + c); }
        for (int r = 0; r < 16; ++r) {
            const int row = row0 + r;
            const f32x4* xr = (const f32x4*)(xin + (size_t)row * DM) + F.lane;
            f32x4 v[4]; float ss = 0.f;
#pragma unroll
            for (int j = 0; j < 4; ++j) { v[j] = xr[64 * j]; ss += (v[j][0] * v[j][0] + v[j][1] * v[j][1]) + (v[j][2] * v[j][2] + v[j][3] * v[j][3]); }
            const float rstd = 1.0f / sqrtf(wave_sum(ss) * (1.0f / DM) + EPS);
            unsigned long long* o8 = (unsigned long long*)(hout + (size_t)row * DM) + F.lane;
#pragma unroll
            for (int j = 0; j < 4; ++j) { v[j] = v[j] * rstd * A[j] + Bv[j]; o8[64 * j] = (unsigned long long)cvtpk(v[j][0], v[j][1]) | ((unsigned long long)cvtpk(v[j][2], v[j][3]) << 32); }
            if (GATES) {
                float p[16];
#pragma unroll
                for (int q = 0; q < 16; ++q) { float s = 0.f;
#pragma unroll
                    for (int j = 0; j < 4; ++j) { const f32x4 w = *(const LAS f32x4*)(wg + q * 1024 + 4 * F.lane + 256 * j); s += (v[j][0] * w[0] + v[j][1] * w[1]) + (v[j][2] * w[2] + v[j][3] * w[3]); }
                    p[q] = s; if ((q & 3) == 3) { asm volatile("" ::: "memory"); __builtin_amdgcn_sched_barrier(0); } }
#pragma unroll
                for (int i = 0; i < 8; ++i) { const bool up = (F.lane & 32) != 0; const float send = up ? p[i] : p[i + 8], keep = up ? p[i + 8] : p[i]; p[i] = keep + __shfl_xor(send, 32); }
#pragma unroll
                for (int i = 0; i < 4; ++i) { const bool up = (F.lane & 16) != 0; const float send = up ? p[i] : p[i + 4], keep = up ? p[i + 4] : p[i]; p[i] = keep + __shfl_xor(send, 16); }
#pragma unroll
                for (int i = 0; i < 2; ++i) { const bool up = (F.lane & 8) != 0; const float send = up ? p[i] : p[i + 2], keep = up ? p[i + 2] : p[i]; p[i] = keep + __shfl_xor(send, 8); }
                { const bool up = (F.lane & 4) != 0; const float send = up ? p[0] : p[1], keep = up ? p[1] : p[0]; p[0] = keep + __shfl_xor(send, 4); }
                p[0] += __shfl_xor(p[0], 2); p[0] += __shfl_xor(p[0], 1);
                const int gi = ((F.lane >> 5) & 1) * 8 + ((F.lane >> 4) & 1) * 4 + ((F.lane >> 3) & 1) * 2 + ((F.lane >> 2) & 1);
                if ((F.lane & 3) == 0) ((float*)(F.ws + WS_GATES))[(size_t)row * 16 + gi] = p[0];
            }
        }
    }
}

DI void norm2_phase(Frame& F, const float* xin, const float* gA, const float* shA, const float* scA, int strideA, bf16* outA, const float* gB, const float* shB, const float* scB, int strideB, bf16* outB) {
    const int gw = F.bid * NWAVES + F.wave, NGW = F.G * NWAVES;
    for (int chunk = gw; chunk < T_TOK / 16; chunk += NGW) {
        const int row0 = chunk * 16, b = row0 >> 11;
        f32x4 A1[4], B1[4], A2[4], B2[4];
#pragma unroll
        for (int j = 0; j < 4; ++j) { const int c = 4 * F.lane + 256 * j;
            A1[j] = *(const f32x4*)(gA + c) * (*(const f32x4*)(scA + (size_t)b * strideA + c) + 1.0f); B1[j] = *(const f32x4*)(shA + (size_t)b * strideA + c);
            A2[j] = *(const f32x4*)(gB + c) * (*(const f32x4*)(scB + (size_t)b * strideB + c) + 1.0f); B2[j] = *(const f32x4*)(shB + (size_t)b * strideB + c); }
        for (int r = 0; r < 16; ++r) {
            const int row = row0 + r;
            const f32x4* xr = (const f32x4*)(xin + (size_t)row * DM) + F.lane;
            f32x4 v[4]; float ss = 0.f;
#pragma unroll
            for (int j = 0; j < 4; ++j) { v[j] = xr[64 * j]; ss += (v[j][0] * v[j][0] + v[j][1] * v[j][1]) + (v[j][2] * v[j][2] + v[j][3] * v[j][3]); }
            const float rstd = 1.0f / sqrtf(wave_sum(ss) * (1.0f / DM) + EPS);
            unsigned long long* oa = (unsigned long long*)(outA + (size_t)row * DM) + F.lane; unsigned long long* ob = (unsigned long long*)(outB + (size_t)row * DM) + F.lane;
#pragma unroll
            for (int j = 0; j < 4; ++j) { const f32x4 xn = v[j] * rstd; const f32x4 ya = xn * A1[j] + B1[j], yb = xn * A2[j] + B2[j];
                oa[64 * j] = (unsigned long long)cvtpk(ya[0], ya[1]) | ((unsigned long long)cvtpk(ya[2], ya[3]) << 32);
                ob[64 * j] = (unsigned long long)cvtpk(yb[0], yb[1]) | ((unsigned long long)cvtpk(yb[2], yb[3]) << 32); }
        }
    }
}

DI void mlstm_gates(Frame& F, size_t trow0, int h, float& ipre, float& bcum, float& blast) {
    const float* gates = (const float*)(F.ws + WS_GATES); const float* bif = F.in[8];
    const float iv = gates[(trow0 + F.lane) * 16 + h] + bif[h];
    const float fv = gates[(trow0 + F.lane) * 16 + 8 + h] + bif[8 + h];
    float b = -(fmaxf(-fv, 0.f) + log1pf(expf(-fabsf(fv))));
#pragma unroll
    for (int d = 1; d < 64; d <<= 1) { const float t = __shfl_up(b, d); if (F.lane >= d) b += t; }
    ipre = iv; bcum = b; blast = __shfl(b, 63);
}
template <int MODE> DI void stage_qk(LAS unsigned char* dst, const LAS float* e_s, const bf16* proj, const float* convw, int tseq0, size_t trow0, int col0, int lane) {
    const int g8 = lane >> 3, ch = lane & 7, col = col0 + 8 * ch;
    float cw[4][8];
#pragma unroll
    for (int tap = 0; tap < 4; ++tap) { const f32x4 a = *(const f32x4*)(convw + tap * 1024 + col), b = *(const f32x4*)(convw + tap * 1024 + col + 4);
        cw[tap][0] = a[0]; cw[tap][1] = a[1]; cw[tap][2] = a[2]; cw[tap][3] = a[3]; cw[tap][4] = b[0]; cw[tap][5] = b[1]; cw[tap][6] = b[2]; cw[tap][7] = b[3]; }
#pragma unroll 1
    for (int ph = 0; ph < 2; ++ph) {
        float x[7][8];
#pragma unroll
        for (int i = 0; i < 7; ++i) {
            const int rel = 8 * g8 + 4 * ph + i - 3; const bool valid = (tseq0 + rel) >= 0; const long rr = valid ? (long)rel : 0;
            u32x4 raw = *(const u32x4*)(proj + (size_t)((long)trow0 + rr) * 3072 + col);
            if (!valid) raw = (u32x4){0u, 0u, 0u, 0u};
            x[i][0] = bflo(raw.x); x[i][1] = bfhi(raw.x); x[i][2] = bflo(raw.y); x[i][3] = bfhi(raw.y); x[i][4] = bflo(raw.z); x[i][5] = bfhi(raw.z); x[i][6] = bflo(raw.w); x[i][7] = bfhi(raw.w);
        }
#pragma unroll
        for (int o = 0; o < 4; ++o) {
            const int tok = 8 * g8 + 4 * ph + o;
            float y[8];
#pragma unroll
            for (int e = 0; e < 8; ++e) { float a = cw[0][e] * x[o][e] + cw[1][e] * x[o + 1][e] + cw[2][e] * x[o + 2][e] + cw[3][e] * x[o + 3][e]; y[e] = a / (1.f + __expf(-a)); }
            float sc = 1.f; if (MODE == 0) sc = e_s[tok]; if (MODE == 1) sc = 0.125f;
            u32x4 w; w.x = cvtpk(y[0] * sc, y[1] * sc); w.y = cvtpk(y[2] * sc, y[3] * sc); w.z = cvtpk(y[4] * sc, y[5] * sc); w.w = cvtpk(y[6] * sc, y[7] * sc);
            const int off = (MODE == 0) ? tr_off(tok, ch) : ch * 1024 + tok * 16;
            *(LAS u32x4*)(dst + off) = w;
        }
    }
}
DI void stage_v_half(LAS unsigned char* dst, const bf16* proj, size_t trow0, int col0, int lane) {
    const int g8 = lane >> 3, ch = lane & 7;
#pragma unroll
    for (int o = 0; o < 8; ++o) { const int tok = 8 * g8 + o; const u32x4 raw = *(const u32x4*)(proj + (trow0 + tok) * 3072 + col0 + 8 * ch); *(LAS u32x4*)(dst + tr_off(tok, ch)) = raw; }
}
constexpr int MW_LDS = 17408;

DI void p3_mlstm_local(Frame& F) {
    LAS unsigned char* wl = F.lds + F.wave * MW_LDS;
    LAS unsigned char* kimg = wl; LAS unsigned char* vimg = wl + 8192; LAS float* e_s = (LAS float*)(wl + 16384);
    const bf16* proj = (const bf16*)(F.ws + WS_PROJ);
    bf16* cst = (bf16*)(F.ws + WS_CST);
    const int lane = F.lane, r32 = lane & 31, hi = lane >> 5;
    for (int bu = F.bid; bu < 512; bu += F.G) {
        int h = F.wave; asm volatile("" : "+s"(h));
        const int b = bu >> 5, c = bu & 31; const int unit = bu * 8 + h; const size_t trow0 = (size_t)b * SEQ + c * 64;
        float ipre, bcum, blast; mlstm_gates(F, trow0, h, ipre, bcum, blast);
        const float w = blast - bcum + ipre; const float mloc = wave_max(w); const float e = expf(w - mloc);
        e_s[lane] = e;
        if (lane == 0) { ((float*)(F.ws + WS_BLAST))[unit] = blast; ((float*)(F.ws + WS_MLOC))[unit] = mloc; }
        stage_qk<0>(kimg, e_s, proj, F.in[7], c * 64, trow0, 512 + h * 64, lane);
        bf16x8 kef[2][4];
#pragma unroll
        for (int kt = 0; kt < 2; ++kt)
#pragma unroll
            for (int ks = 0; ks < 4; ++ks) kef[kt][ks] = tr_frag(kimg, kt, ks, lane);
        const bf16x8 ones = {0x3F80, 0x3F80, 0x3F80, 0x3F80, 0x3F80, 0x3F80, 0x3F80, 0x3F80};
#pragma unroll
        for (int kt = 0; kt < 2; ++kt) { f32x16 an = {};
#pragma unroll
            for (int ks = 0; ks < 4; ++ks) an = MFMA32(kef[kt][ks], ones, an);
            if (r32 == 0) {
#pragma unroll
                for (int r = 0; r < 16; ++r) ((float*)(F.ws + WS_NLOC))[(size_t)unit * 64 + 32 * kt + crow(r, hi)] = an[r]; } }
#pragma unroll 1
        for (int vh = 0; vh < 2; ++vh) {
            stage_v_half(vimg, proj, trow0, 1024 + h * 128 + 64 * vh, lane);
#pragma unroll
            for (int vt = 0; vt < 2; ++vt) {
                bf16x8 vf[4];
#pragma unroll
                for (int ks = 0; ks < 4; ++ks) vf[ks] = tr_frag(vimg, vt, ks, lane);
#pragma unroll
                for (int kt = 0; kt < 2; ++kt) { f32x16 acc = {};
#pragma unroll
                    for (int ks = 0; ks < 4; ++ks) acc = MFMA32(kef[kt][ks], vf[ks], acc);
                    bf16* dstp = cst + ((size_t)unit * 128 + 64 * vh + 32 * vt + r32) * 64 + 32 * kt + 4 * hi;
#pragma unroll
                    for (int rg = 0; rg < 4; ++rg) { u32x2 pk; pk.x = cvtpk(acc[4 * rg], acc[4 * rg + 1]); pk.y = cvtpk(acc[4 * rg + 2], acc[4 * rg + 3]); *(u32x2*)(dstp + 8 * rg) = pk; }
                }
            }
        }
    }
}
DI void p4_scan(Frame& F) {
    const int gt = F.bid * NT + F.tid, NGT = F.G * NT;
    const float* mlocp = (const float*)(F.ws + WS_MLOC); const float* blastp = (const float*)(F.ws + WS_BLAST);
    for (int item = gt; item < 128 * 1024; item += NGT) {
        const int bh = item >> 10, e8 = item & 1023, b = bh >> 3, h = bh & 7;
        float st[8]; float m = 0.f;
#pragma unroll
        for (int i = 0; i < 8; ++i) st[i] = 0.f;
        u32x4* p0 = (u32x4*)((bf16*)(F.ws + WS_CST) + (size_t)((b * 32) * 8 + h) * 8192) + e8;
        const int u0 = (b * 32) * 8 + h;
#pragma unroll 1
        for (int c0 = 0; c0 < 32; c0 += 8) {
            u32x4 raw[8]; float ml[8], bl[8];
#pragma unroll
            for (int j = 0; j < 8; ++j) { raw[j] = p0[(size_t)(c0 + j) * 8192]; ml[j] = mlocp[u0 + (c0 + j) * 8]; bl[j] = blastp[u0 + (c0 + j) * 8]; }
#pragma unroll
            for (int j = 0; j < 8; ++j) {
                u32x4 o; o.x = cvtpk(st[0], st[1]); o.y = cvtpk(st[2], st[3]); o.z = cvtpk(st[4], st[5]); o.w = cvtpk(st[6], st[7]); p0[(size_t)(c0 + j) * 8192] = o;
                const float mn = fmaxf(bl[j] + m, ml[j]), a = __expf(bl[j] + m - mn), r = __expf(ml[j] - mn);
                st[0] = a * st[0] + r * bflo(raw[j].x); st[1] = a * st[1] + r * bfhi(raw[j].x); st[2] = a * st[2] + r * bflo(raw[j].y); st[3] = a * st[3] + r * bfhi(raw[j].y);
                st[4] = a * st[4] + r * bflo(raw[j].z); st[5] = a * st[5] + r * bfhi(raw[j].z); st[6] = a * st[6] + r * bflo(raw[j].w); st[7] = a * st[7] + r * bfhi(raw[j].w);
                m = mn;
            }
        }
    }
    for (int item = gt; item < 128 * 64; item += NGT) {
        const int bh = item >> 6, k = item & 63, b = bh >> 3, h = bh & 7;
        float ns = 0.f, m = 0.f;
        const int u0 = (b * 32) * 8 + h;
#pragma unroll 1
        for (int c0 = 0; c0 < 32; c0 += 8) {
            float nl[8], ml[8], bl[8];
#pragma unroll
            for (int j = 0; j < 8; ++j) { const int unit = u0 + (c0 + j) * 8; nl[j] = ((const float*)(F.ws + WS_NLOC))[(size_t)unit * 64 + k]; ml[j] = mlocp[unit]; bl[j] = blastp[unit]; }
#pragma unroll
            for (int j = 0; j < 8; ++j) { const int unit = u0 + (c0 + j) * 8;
                ((float*)(F.ws + WS_NLOC))[(size_t)unit * 64 + k] = ns; if (k == 0) ((float*)(F.ws + WS_MPREV))[unit] = m;
                const float mn = fmaxf(bl[j] + m, ml[j]), a = __expf(bl[j] + m - mn), r = __expf(ml[j] - mn);
                ns = a * ns + r * nl[j]; m = mn; }
        }
    }
}
DI void p5_mlstm_out(Frame& F) {
    LAS unsigned char* wl = F.lds + F.wave * MW_LDS;
    LAS unsigned char* qimg = wl; LAS unsigned char* kimg = wl + 8192; LAS float* sc = (LAS float*)(wl + 16384);
    const bf16* proj = (const bf16*)(F.ws + WS_PROJ);
    const bf16* cst = (const bf16*)(F.ws + WS_CST);
    bf16* hh = (bf16*)(F.ws + WS_H);
    for (int bu = F.bid; bu < 512; bu += F.G) {
        int lane = F.lane; asm volatile("" : "+v"(lane)); const int r32 = lane & 31, hi = lane >> 5;
        int h = F.wave; asm volatile("" : "+s"(h));
        const int b = bu >> 5, c = bu & 31; const int unit = bu * 8 + h; const size_t trow0 = (size_t)b * SEQ + c * 64;
        {
            float ipre, bcum, blast; mlstm_gates(F, trow0, h, ipre, bcum, blast);
            const float mprev = ((const float*)(F.ws + WS_MPREV))[unit];
            const float gg = ipre - bcum; float pm = gg;
#pragma unroll
            for (int d = 1; d < 64; d <<= 1) { const float t = __shfl_up(pm, d); if (lane >= d) pm = fmaxf(pm, t); }
            const float Mx = fmaxf(mprev, pm), mt = bcum + Mx;
            sc[lane] = gg; sc[64 + lane] = Mx; sc[128 + lane] = expf(mprev - Mx); sc[192 + lane] = expf(-mt);
        }
#pragma unroll 1
        for (int lt = 0; lt < 2; ++lt) {
            const int l = 32 * lt + r32;
            const size_t t = trow0 + l;
            stage_qk<1>(qimg, nullptr, proj, F.in[7], c * 64, trow0, h * 64, lane);
            stage_qk<2>(kimg, nullptr, proj, F.in[7], c * 64, trow0, 512 + h * 64, lane);
            asm volatile("" ::: "memory"); __builtin_amdgcn_sched_barrier(0);
            bf16x8 cf[4][4];
#pragma unroll
            for (int vt = 0; vt < 4; ++vt)
#pragma unroll
                for (int ks = 0; ks < 4; ++ks) cf[vt][ks] = *(const bf16x8*)(cst + ((size_t)unit * 128 + 32 * vt + r32) * 64 + 16 * ks + 8 * hi);
            bf16x8 qf[4];
#pragma unroll
            for (int ks = 0; ks < 4; ++ks) qf[ks] = row_frag<64>(qimg, lt, ks, lane);
            const float Mxl = sc[64 + l];
            bf16x8 P[2][2]; float dsum = 0.f;
#pragma unroll
            for (int st = 0; st < 2; ++st) {
                P[st][0] = (bf16x8){0, 0, 0, 0, 0, 0, 0, 0}; P[st][1] = P[st][0];
                if (st <= lt) {
                    f32x16 acc = {};
#pragma unroll
                    for (int ks = 0; ks < 4; ++ks) acc = MFMA32(row_frag<64>(kimg, st, ks, lane), qf[ks], acc);
#pragma unroll
                    for (int r = 0; r < 16; ++r) { const int srow = crow(r, hi); float val = acc[r] * __expf(sc[32 * st + srow] - Mxl); if (st == lt && srow > r32) val = 0.f; acc[r] = val; dsum += val; }
                    P[st][0] = pack8(acc, 0); P[st][1] = pack8(acc, 1);
                }
            }
            float nq;
            { const float* np = (const float*)(F.ws + WS_NLOC) + (size_t)unit * 64; float s = 0.f;
#pragma unroll
              for (int ks = 0; ks < 4; ++ks) { const f32x4 n0 = *(const f32x4*)(np + 16 * ks + 8 * hi), n1 = *(const f32x4*)(np + 16 * ks + 8 * hi + 4); const u32x4 q = __builtin_bit_cast(u32x4, qf[ks]);
                  s += bflo(q.x) * n0[0] + bfhi(q.x) * n0[1] + bflo(q.y) * n0[2] + bfhi(q.y) * n0[3] + bflo(q.z) * n1[0] + bfhi(q.z) * n1[1] + bflo(q.w) * n1[2] + bfhi(q.w) * n1[3]; }
              nq = s + __shfl_xor(s, 32); }
            asm volatile("s_waitcnt lgkmcnt(0)" ::: "memory");
            stage_v_half(wl, proj, trow0, 1024 + h * 128, lane); stage_v_half(wl + 8192, proj, trow0, 1024 + h * 128 + 64, lane);
            f32x16 acc[4];
#pragma unroll
            for (int vt = 0; vt < 4; ++vt) { acc[vt] = (f32x16){};
#pragma unroll
                for (int ks = 0; ks < 4; ++ks) acc[vt] = MFMA32(cf[vt][ks], qf[ks], acc[vt]); }
            const float iwl = sc[128 + l];
#pragma unroll
            for (int vt = 0; vt < 4; ++vt) acc[vt] = acc[vt] * iwl;
#pragma unroll
            for (int st = 0; st < 2; ++st) if (st <= lt) {
#pragma unroll
                for (int k2 = 0; k2 < 2; ++k2) {
#pragma unroll
                    for (int vt = 0; vt < 4; ++vt) acc[vt] = MFMA32(tr_frag(wl + (vt >> 1) * 8192, vt & 1, 2 * st + k2, lane), P[st][k2], acc[vt]); } }
            u32x2 o4[4][4];
#pragma unroll
            for (int vt = 0; vt < 4; ++vt)
#pragma unroll
                for (int rg = 0; rg < 4; ++rg) o4[vt][rg] = *(const u32x2*)(proj + t * 3072 + 2048 + h * 128 + 32 * vt + 8 * rg + 4 * hi);
            const float den = dsum + __shfl_xor(dsum, 32) + iwl * nq;
            const float inv = 1.0f / fmaxf(fabsf(den), sc[192 + l]);
            float ss = 0.f;
#pragma unroll
            for (int vt = 0; vt < 4; ++vt)
#pragma unroll
                for (int r = 0; r < 16; ++r) { const float v = acc[vt][r] * inv; acc[vt][r] = v; ss += v * v; }
            ss += __shfl_xor(ss, 32);
            const float rstd = 1.0f / sqrtf(ss * (1.0f / 128.0f) + EPS);
#pragma unroll
            for (int vt = 0; vt < 4; ++vt)
#pragma unroll
                for (int rg = 0; rg < 4; ++rg) { const int v = 32 * vt + 8 * rg + 4 * hi;
                    const f32x4 g4 = *(const f32x4*)(F.in[9] + h * 128 + v);
                    const float o0 = bflo(o4[vt][rg].x), o1 = bfhi(o4[vt][rg].x), o2 = bflo(o4[vt][rg].y), o3 = bfhi(o4[vt][rg].y);
                    const float y0 = acc[vt][4 * rg] * rstd * g4[0] / (1.f + __expf(-o0)), y1 = acc[vt][4 * rg + 1] * rstd * g4[1] / (1.f + __expf(-o1));
                    const float y2 = acc[vt][4 * rg + 2] * rstd * g4[2] / (1.f + __expf(-o2)), y3 = acc[vt][4 * rg + 3] * rstd * g4[3] / (1.f + __expf(-o3));
                    u32x2 pk; pk.x = cvtpk(y0, y1); pk.y = cvtpk(y2, y3); *(u32x2*)(hh + t * 1024 + h * 128 + v) = pk; }
            asm volatile("s_waitcnt lgkmcnt(0)" ::: "memory");
        }
    }
}

DI float softplus_f(float z) { return fmaxf(z, 0.f) + __logf(1.f + __expf(-fabsf(z))); }
DI void p12_attn(Frame& F) {
    LAS unsigned char* kimg = F.lds; LAS unsigned char* vimg = F.lds + 8192;
    const bf16* Q = (const bf16*)(F.ws + WS_Q); const bf16* K = (const bf16*)(F.ws + WS_K); const bf16* V = (const bf16*)(F.ws + WS_VV);
    bf16* O = (bf16*)(F.ws + WS_H);
    const int lane = F.lane, r32 = lane & 31, hi = lane >> 5, wave = F.wave;
    const int skey = F.tid >> 3, schk = F.tid & 7;
    for (int bh = F.bid; bh < 256; bh += F.G) {
        const int b = bh >> 4, h = bh & 15;
        for (int qb = 7; qb >= 0; --qb) {
            const int qlo = qb * 256 + 32 * wave;
            const size_t tq0 = (size_t)b * SEQ + qlo;
            bf16x8 qr[4];
#pragma unroll
            for (int ks = 0; ks < 4; ++ks) qr[ks] = *(const bf16x8*)(Q + (tq0 + r32) * 1024 + h * 64 + 16 * ks + 8 * hi);
            f32x16 o0 = {}, o1 = {}; float R = 0.f; bool wdone = false;
            const int ntile = 4 * qb + 4;
            u32x4 kraw, vraw;
            { const size_t src = ((size_t)b * SEQ + 64 * (ntile - 1) + skey) * 1024 + h * 64 + 8 * schk; kraw = *(const u32x4*)(K + src); vraw = *(const u32x4*)(V + src); }
            for (int kt = ntile - 1; kt >= 0; --kt) {
                __syncthreads();
                *(LAS u32x4*)(kimg + schk * 1024 + skey * 16) = kraw;
                *(LAS u32x4*)(vimg + tr_off(skey, schk)) = vraw;
                if (kt > 0) { const size_t src = ((size_t)b * SEQ + 64 * (kt - 1) + skey) * 1024 + h * 64 + 8 * schk; kraw = *(const u32x4*)(K + src); vraw = *(const u32x4*)(V + src); }
                if (__syncthreads_and(wdone ? 1 : 0)) break;
                if (!wdone && 64 * kt <= qlo + 30) {
                    f32x16 p0 = {}, p1 = {};
#pragma unroll
                    for (int ks = 0; ks < 4; ++ks) { p0 = MFMA32(row_frag<64>(kimg, 0, ks, lane), qr[ks], p0); p1 = MFMA32(row_frag<64>(kimg, 1, ks, lane), qr[ks], p1); }
                    const bool diag = (64 * kt + 63 >= qlo);
                    const int qrel = qlo + r32 - 64 * kt;
                    float s0[16], s1[16];
#pragma unroll
                    for (int r = 0; r < 16; ++r) { const int kr = crow(r, hi);
                        const bool v0 = !diag || kr < qrel, v1 = !diag || (kr + 32) < qrel;
                        s0[r] = v0 ? softplus_f(p0[r]) : 0.f; s1[r] = v1 ? softplus_f(p1[r]) : 0.f; }
#pragma unroll
                    for (int g = 0; g < 4; ++g) { s0[4 * g + 2] += s0[4 * g + 3]; s0[4 * g + 1] += s0[4 * g + 2]; s0[4 * g] += s0[4 * g + 1];
                                                  s1[4 * g + 2] += s1[4 * g + 3]; s1[4 * g + 1] += s1[4 * g + 2]; s1[4 * g] += s1[4 * g + 1]; }
                    float off0[4], off1[4]; float tot0, tot1;
                    { float og[4], T[4];
#pragma unroll
                      for (int g = 0; g < 4; ++g) og[g] = __shfl_xor(s1[4 * g], 32);
                      T[3] = 0.f; T[2] = s1[12] + og[3]; T[1] = T[2] + s1[8] + og[2]; T[0] = T[1] + s1[4] + og[1]; tot1 = T[0] + s1[0] + og[0];
#pragma unroll
                      for (int g = 0; g < 4; ++g) off1[g] = T[g] + (hi == 0 ? og[g] : 0.f) + R; }
                    { float og[4], T[4];
#pragma unroll
                      for (int g = 0; g < 4; ++g) og[g] = __shfl_xor(s0[4 * g], 32);
                      T[3] = 0.f; T[2] = s0[12] + og[3]; T[1] = T[2] + s0[8] + og[2]; T[0] = T[1] + s0[4] + og[1]; tot0 = T[0] + s0[0] + og[0];
#pragma unroll
                      for (int g = 0; g < 4; ++g) off0[g] = T[g] + (hi == 0 ? og[g] : 0.f) + R + tot1; }
#pragma unroll
                    for (int r = 0; r < 16; ++r) { const int kr = crow(r, hi);
                        const bool v0 = !diag || kr < qrel, v1 = !diag || (kr + 32) < qrel;
                        const float a0 = __expf(p0[r] - s0[r] - off0[r >> 2]), a1 = __expf(p1[r] - s1[r] - off1[r >> 2]);
                        p0[r] = v0 ? a0 : 0.f; p1[r] = v1 ? a1 : 0.f; }
                    R += tot0 + tot1;
                    wdone = __all(R >= 104.0f);
                    const bf16x8 pa0 = pack8(p0, 0), pa1 = pack8(p0, 1), pa2 = pack8(p1, 0), pa3 = pack8(p1, 1);
                    o0 = MFMA32(pa0, tr_frag(vimg, 0, 0, lane), o0); o1 = MFMA32(pa0, tr_frag(vimg, 1, 0, lane), o1);
                    o0 = MFMA32(pa1, tr_frag(vimg, 0, 1, lane), o0); o1 = MFMA32(pa1, tr_frag(vimg, 1, 1, lane), o1);
                    o0 = MFMA32(pa2, tr_frag(vimg, 0, 2, lane), o0); o1 = MFMA32(pa2, tr_frag(vimg, 1, 2, lane), o1);
                    o0 = MFMA32(pa3, tr_frag(vimg, 0, 3, lane), o0); o1 = MFMA32(pa3, tr_frag(vimg, 1, 3, lane), o1);
                }
            }
#pragma unroll
            for (int r = 0; r < 16; ++r) { bf16* op = O + (tq0 + crow(r, hi)) * 1024 + h * 64 + r32;
                op[0] = (bf16)(cvtpk(o0[r], 0.f) & 0xffffu); op[32] = (bf16)(cvtpk(o1[r], 0.f) & 0xffffu); }
        }
    }
}

__device__ constexpr int NET16_A[63] = {0,2,0,1,1,4,6,4,5,5,0,2,2,1,3,3,1,3,5,8,10,8,9,9,12,14,12,13,13,8,10,10,9,11,11,9,11,13,0,4,4,2,6,6,2,6,10,1,5,5,3,7,7,3,7,11,1,3,5,7,9,11,13};
__device__ constexpr int NET16_B[63] = {1,3,2,3,2,5,7,6,7,6,4,6,4,5,7,5,2,4,6,9,11,10,11,10,13,15,14,15,14,12,14,12,13,15,13,10,12,14,8,12,8,10,14,10,4,8,12,9,13,9,11,15,11,5,9,13,2,4,6,8,10,12,14};
__device__ constexpr int BIT16_A[32] = {0,1,2,3,4,5,6,7,0,1,2,3,8,9,10,11,0,1,4,5,8,9,12,13,0,2,4,6,8,10,12,14};
__device__ constexpr int BIT16_B[32] = {8,9,10,11,12,13,14,15,4,5,6,7,12,13,14,15,2,3,6,7,10,11,14,15,1,3,5,7,9,11,13,15};
DI unsigned umax_(unsigned a, unsigned b) { return a > b ? a : b; }
DI unsigned umin_(unsigned a, unsigned b) { return a < b ? a : b; }
DI void sort16(unsigned (&k)[16]) {
#pragma unroll
    for (int c = 0; c < 63; ++c) { const unsigned a = k[NET16_A[c]], b = k[NET16_B[c]]; k[NET16_A[c]] = umax_(a, b); k[NET16_B[c]] = umin_(a, b); }
}
DI void bitonic16(unsigned (&k)[16]) {
#pragma unroll
    for (int c = 0; c < 32; ++c) { const unsigned a = k[BIT16_A[c]], b = k[BIT16_B[c]]; k[BIT16_A[c]] = umax_(a, b); k[BIT16_B[c]] = umin_(a, b); }
}
DI void merge16(unsigned (&x)[16], const unsigned (&y)[16]) {
#pragma unroll
    for (int i = 0; i < 16; ++i) x[i] = umax_(x[i], y[15 - i]);
    bitonic16(x);
}
DI unsigned f2key(float x) { const unsigned b = __float_as_uint(x); return b ^ ((unsigned)((int)b >> 31) | 0x80000000u); }
DI float key2f(unsigned k) { return __uint_as_float(k ^ (~(unsigned)((int)k >> 31) | 0x80000000u)); }

DI void p_route(Frame& F, int layer) {
    LAS unsigned char* simg = F.lds;
    LAS unsigned char* dec = F.lds + 65536 + F.wave * 1024;
    { const u32x4* src = (const u32x4*)((const bf16*)(F.ws + WS_SUBK) + (size_t)layer * 2 * 128 * 128);
      for (int i = F.tid; i < 2 * 128 * 16; i += NT) { const int p = i >> 11, n = (i >> 4) & 127, ch = i & 15; *(LAS u32x4*)(simg + p * 32768 + ch * 2048 + n * 16) = src[i]; } }
    __syncthreads();
    const bf16* PQ = (const bf16*)(F.ws + WS_PQ);
    const int lane = F.lane, r32 = lane & 31, hi = lane >> 5;
    const int gw = F.bid * NWAVES + F.wave, NGW = F.G * NWAVES;
    for (int wu = gw; wu < T_TOK * 8 / 32; wu += NGW) {
        const int row = wu * 32 + r32, t = row >> 3, hd = row & 7;
        unsigned top[2][16];
#pragma unroll
        for (int p = 0; p < 2; ++p) {
            bf16x8 qf[8];
#pragma unroll
            for (int ks = 0; ks < 8; ++ks) qf[ks] = *(const bf16x8*)(PQ + (size_t)t * 2048 + hd * 256 + p * 128 + 16 * ks + 8 * hi);
            unsigned keys[4][16];
#pragma unroll
            for (int nt = 0; nt < 4; ++nt) {
                f32x16 acc = {};
#pragma unroll
                for (int ks = 0; ks < 8; ++ks) acc = MFMA32(*(const LAS bf16x8*)(simg + p * 32768 + (2 * ks + hi) * 2048 + (32 * nt + r32) * 16), qf[ks], acc);
#pragma unroll
                for (int r = 0; r < 16; ++r) keys[nt][r] = (f2key(acc[r]) & 0xFFFFFF80u) | (unsigned)(32 * nt + crow(r, 0)) | (unsigned)(4 * hi);
                sort16(keys[nt]);
            }
            merge16(keys[0], keys[1]); merge16(keys[2], keys[3]); merge16(keys[0], keys[2]);
            unsigned lo[16], up[16];
#pragma unroll
            for (int i = 0; i < 16; ++i) { auto rr = __builtin_amdgcn_permlane32_swap(keys[0][i], keys[0][i], false, false); lo[i] = rr[0]; up[i] = rr[1]; }
#pragma unroll
            for (int i = 0; i < 16; ++i) top[p][i] = umax_(lo[i], up[15 - i]);
            bitonic16(top[p]);
        }
        if (hi == 0) {
            u32x4 w0, w1, w2, w3;
            w0.x = (top[0][0] & 127u) | ((top[0][1] & 127u) << 8) | ((top[0][2] & 127u) << 16) | ((top[0][3] & 127u) << 24);
            w0.y = (top[0][4] & 127u) | ((top[0][5] & 127u) << 8) | ((top[0][6] & 127u) << 16) | ((top[0][7] & 127u) << 24);
            w0.z = (top[0][8] & 127u) | ((top[0][9] & 127u) << 8) | ((top[0][10] & 127u) << 16) | ((top[0][11] & 127u) << 24);
            w0.w = (top[0][12] & 127u) | ((top[0][13] & 127u) << 8) | ((top[0][14] & 127u) << 16) | ((top[0][15] & 127u) << 24);
            w1.x = (top[1][0] & 127u) | ((top[1][1] & 127u) << 8) | ((top[1][2] & 127u) << 16) | ((top[1][3] & 127u) << 24);
            w1.y = (top[1][4] & 127u) | ((top[1][5] & 127u) << 8) | ((top[1][6] & 127u) << 16) | ((top[1][7] & 127u) << 24);
            w1.z = (top[1][8] & 127u) | ((top[1][9] & 127u) << 8) | ((top[1][10] & 127u) << 16) | ((top[1][11] & 127u) << 24);
            w1.w = (top[1][12] & 127u) | ((top[1][13] & 127u) << 8) | ((top[1][14] & 127u) << 16) | ((top[1][15] & 127u) << 24);
            *(LAS u32x4*)(dec + r32 * 32) = w0; *(LAS u32x4*)(dec + r32 * 32 + 16) = w1;
        }
        float av[16], bv[16];
#pragma unroll
        for (int i = 0; i < 16; ++i) { av[i] = key2f(top[0][i] & 0xFFFFFF80u); bv[i] = key2f(top[1][i] & 0xFFFFFF80u); }
        unsigned c0[16], c1[16], c2[16], c3[16];
#pragma unroll
        for (int j = 0; j < 16; ++j) c0[j] = (f2key(av[0] + bv[j]) & 0xFFFFFF00u) | (unsigned)j;
        {
            int n = 0;
#pragma unroll
            for (int i = 1; i < 16; ++i)
#pragma unroll
                for (int j = 0; j < 16; ++j) if ((i + 1) * (j + 1) <= 16) {
                    const unsigned k = (f2key(av[i] + bv[j]) & 0xFFFFFF00u) | (unsigned)(i * 16 + j);
                    if (n < 16) c1[n] = k; else if (n < 32) c2[n - 16] = k; else c3[n - 32] = k;
                    ++n; }
#pragma unroll
            for (int q = 2; q < 16; ++q) c3[q] = 0u;
        }
        sort16(c1); sort16(c2); { const unsigned a = c3[0], b = c3[1]; c3[0] = umax_(a, b); c3[1] = umin_(a, b); }
        merge16(c0, c1); merge16(c2, c3); merge16(c0, c2);
        asm volatile("s_waitcnt lgkmcnt(0)" ::: "memory");
        float gv[16]; unsigned ex[16]; float gs = 0.f;
        const float vmax = key2f(c0[0] & 0xFFFFFF00u);
#pragma unroll
        for (int k = 0; k < 16; ++k) {
            const unsigned code = c0[k] & 255u; const unsigned i = code >> 4, j = code & 15u;
            const unsigned ia = *(const LAS unsigned char*)(dec + r32 * 32 + i), ib = *(const LAS unsigned char*)(dec + r32 * 32 + 16 + j);
            ex[k] = ia * 128u + ib;
            gv[k] = __expf(key2f(c0[k] & 0xFFFFFF00u) - vmax); gs += gv[k];
        }
        const float ginv = 1.0f / gs;
        if (hi == 0) {
            u32x4 e0, e1;
            e0.x = ex[0] | (ex[1] << 16); e0.y = ex[2] | (ex[3] << 16); e0.z = ex[4] | (ex[5] << 16); e0.w = ex[6] | (ex[7] << 16);
            e1.x = ex[8] | (ex[9] << 16); e1.y = ex[10] | (ex[11] << 16); e1.z = ex[12] | (ex[13] << 16); e1.w = ex[14] | (ex[15] << 16);
            u32x4* ip = (u32x4*)((unsigned short*)(F.ws + WS_IDX) + (size_t)row * 16); ip[0] = e0; ip[1] = e1;
        } else {
            f32x4* gp = (f32x4*)((float*)(F.ws + WS_GATE) + (size_t)row * 16);
            gp[0] = (f32x4){gv[0] * ginv, gv[1] * ginv, gv[2] * ginv, gv[3] * ginv}; gp[1] = (f32x4){gv[4] * ginv, gv[5] * ginv, gv[6] * ginv, gv[7] * ginv};
            gp[2] = (f32x4){gv[8] * ginv, gv[9] * ginv, gv[10] * ginv, gv[11] * ginv}; gp[3] = (f32x4){gv[12] * ginv, gv[13] * ginv, gv[14] * ginv, gv[15] * ginv};
        }
    }
}

constexpr float U_SCALE = 32.f, V_SCALE = 4.f;
struct RowBuf { u32x4 r[16]; };
DI void load_rows(RowBuf& rb, const unsigned char* tbl, int idxs, int k0, int lane) {
#pragma unroll
    for (int j = 0; j < 16; ++j) { const int e = __builtin_amdgcn_readlane(idxs, k0 + j); rb.r[j] = *((const u32x4*)(tbl + (size_t)e * 1024) + lane); }
}
DI float udots(const RowBuf& rb, const f32x2_t (&hq)[8], int lane) {
    float p[16];
#pragma unroll
    for (int j = 0; j < 16; ++j) { f32x2_t a = {0.f, 0.f};
        a = __builtin_amdgcn_cvt_pk_f32_fp8((int)rb.r[j].x, false) * hq[0] + a; a = __builtin_amdgcn_cvt_pk_f32_fp8((int)rb.r[j].x, true) * hq[1] + a;
        a = __builtin_amdgcn_cvt_pk_f32_fp8((int)rb.r[j].y, false) * hq[2] + a; a = __builtin_amdgcn_cvt_pk_f32_fp8((int)rb.r[j].y, true) * hq[3] + a;
        a = __builtin_amdgcn_cvt_pk_f32_fp8((int)rb.r[j].z, false) * hq[4] + a; a = __builtin_amdgcn_cvt_pk_f32_fp8((int)rb.r[j].z, true) * hq[5] + a;
        a = __builtin_amdgcn_cvt_pk_f32_fp8((int)rb.r[j].w, false) * hq[6] + a; a = __builtin_amdgcn_cvt_pk_f32_fp8((int)rb.r[j].w, true) * hq[7] + a;
        p[j] = a.x + a.y; }
#pragma unroll
    for (int i = 0; i < 8; ++i) { const bool up = (lane & 8) != 0; const float send = up ? p[i] : p[i + 8], keep = up ? p[i + 8] : p[i]; p[i] = keep + __shfl_xor(send, 8); }
#pragma unroll
    for (int i = 0; i < 4; ++i) { const bool up = (lane & 4) != 0; const float send = up ? p[i] : p[i + 4], keep = up ? p[i + 4] : p[i]; p[i] = keep + __shfl_xor(send, 4); }
#pragma unroll
    for (int i = 0; i < 2; ++i) { const bool up = (lane & 2) != 0; const float send = up ? p[i] : p[i + 2], keep = up ? p[i + 2] : p[i]; p[i] = keep + __shfl_xor(send, 2); }
    { const bool up = (lane & 1) != 0; const float send = up ? p[0] : p[1], keep = up ? p[1] : p[0]; p[0] = keep + __shfl_xor(send, 1); }
    float s = p[0]; s += __shfl_xor(s, 16); s += __shfl_xor(s, 32);
    return s;
}
DI void vaccum(const RowBuf& rb, f32x2_t (&out)[8], float wv, int k0) {
#pragma unroll
    for (int j = 0; j < 16; ++j) { const float wk = __builtin_bit_cast(float, __builtin_amdgcn_readlane(__builtin_bit_cast(int, wv), k0 + j));
        out[0] = __builtin_amdgcn_cvt_pk_f32_fp8((int)rb.r[j].x, false) * wk + out[0]; out[1] = __builtin_amdgcn_cvt_pk_f32_fp8((int)rb.r[j].x, true) * wk + out[1];
        out[2] = __builtin_amdgcn_cvt_pk_f32_fp8((int)rb.r[j].y, false) * wk + out[2]; out[3] = __builtin_amdgcn_cvt_pk_f32_fp8((int)rb.r[j].y, true) * wk + out[3];
        out[4] = __builtin_amdgcn_cvt_pk_f32_fp8((int)rb.r[j].z, false) * wk + out[4]; out[5] = __builtin_amdgcn_cvt_pk_f32_fp8((int)rb.r[j].z, true) * wk + out[5];
        out[6] = __builtin_amdgcn_cvt_pk_f32_fp8((int)rb.r[j].w, false) * wk + out[6]; out[7] = __builtin_amdgcn_cvt_pk_f32_fp8((int)rb.r[j].w, true) * wk + out[7]; }
}
constexpr size_t WS_W = WS_PROJ;
constexpr int UP_LDS = 16384;
DI void up_load_h2(f32x2_t (&hq)[8], const bf16* H2, size_t t, int lane) {
    const u32x4* hp = (const u32x4*)(H2 + t * 1024) + 2 * lane; const u32x4 a = hp[0], c = hp[1];
    hq[0] = (f32x2_t){bflo(a.x), bfhi(a.x)}; hq[1] = (f32x2_t){bflo(a.y), bfhi(a.y)}; hq[2] = (f32x2_t){bflo(a.z), bfhi(a.z)}; hq[3] = (f32x2_t){bflo(a.w), bfhi(a.w)};
    hq[4] = (f32x2_t){bflo(c.x), bfhi(c.x)}; hq[5] = (f32x2_t){bflo(c.y), bfhi(c.y)}; hq[6] = (f32x2_t){bflo(c.z), bfhi(c.z)}; hq[7] = (f32x2_t){bflo(c.w), bfhi(c.w)};
}
DI int up_prepare(LAS unsigned* cmp, const LAS unsigned short* lidx, const LAS float* lgate, int tt, int x, int lane) {
    LAS unsigned* c = cmp + (tt & 1) * 384;
    const int i0 = lidx[tt * 128 + lane], i1 = lidx[tt * 128 + 64 + lane];
    const float g0 = lgate[tt * 128 + lane], g1 = lgate[tt * 128 + 64 + lane];
    const bool in0 = (i0 >> 11) == x, in1 = (i1 >> 11) == x;
    const unsigned long long m0 = __ballot(in0), m1 = __ballot(in1);
    const int n0 = __popcll(m0), n = n0 + __popcll(m1);
    const int below0 = __builtin_amdgcn_mbcnt_hi((unsigned)(m0 >> 32), __builtin_amdgcn_mbcnt_lo((unsigned)m0, 0));
    const int below1 = __builtin_amdgcn_mbcnt_hi((unsigned)(m1 >> 32), __builtin_amdgcn_mbcnt_lo((unsigned)m1, 0));
    if (in0) { c[below0] = (unsigned)i0; c[128 + below0] = (unsigned)lane; c[256 + below0] = __float_as_uint(g0); }
    if (in1) { c[n0 + below1] = (unsigned)i1; c[128 + n0 + below1] = (unsigned)(64 + lane); c[256 + n0 + below1] = __float_as_uint(g1); }
    return n;
}
DI void up_issue(RowBuf& R, const unsigned char* U, const LAS unsigned* cmp, int tt, int bb, int nn, int x, int lane) {
    const LAS unsigned* c = cmp + (tt & 1) * 384;
    const int pos = 16 * bb + (lane & 15);
    const int first = nn > 0 ? (int)c[0] : (x << 11);
    const int ia = pos < nn ? (int)c[pos & 127] : first;
    load_rows(R, U, ia, 0, lane);
}
DI void up_finish(const RowBuf& R, const f32x2_t (&hq)[8], const LAS unsigned* cmp, float* W, size_t t, int tt, int b, int n, int lane) {
    const float d = udots(R, hq, lane) * (1.0f / U_SCALE);
    const LAS unsigned* c = cmp + (tt & 1) * 384;
    const int pos = 16 * b + lane;
    if (lane < 16 && pos < n) { const float g = __uint_as_float(c[256 + pos]); W[t * 128 + c[128 + pos]] = g * 0.5f * d * (1.0f + erff(d * 0.70710678118654752f)) * (1.0f / V_SCALE); }
}
DI void p_upass(Frame& F, int layer) {
    const unsigned char* U = F.ws + WS_U + (size_t)layer * 16384 * 1024;
    const bf16* H2 = (const bf16*)(F.ws + WS_H);
    const unsigned short* IDX = (const unsigned short*)(F.ws + WS_IDX); const float* GATE = (const float*)(F.ws + WS_GATE);
    float* W = (float*)(F.ws + WS_W);
    LAS unsigned char* wl = F.lds + F.wave * UP_LDS;
    LAS unsigned short* lidx = (LAS unsigned short*)wl; LAS float* lgate = (LAS float*)(wl + 4096); LAS unsigned* cmp = (LAS unsigned*)(wl + 12288);
    const int lane = F.lane;
    const int x = F.bid & 7, jb = F.bid >> 3, nj = F.G >> 3;
    for (int t0 = (jb * NWAVES + F.wave) * 16; t0 < T_TOK; t0 += nj * NWAVES * 16) {
        { const u32x4* si = (const u32x4*)(IDX + (size_t)t0 * 128) + lane;
#pragma unroll
          for (int q = 0; q < 4; ++q) ((LAS u32x4*)lidx)[lane + 64 * q] = si[64 * q];
          const u32x4* sg = (const u32x4*)(GATE + (size_t)t0 * 128) + lane;
#pragma unroll
          for (int q = 0; q < 8; ++q) ((LAS u32x4*)lgate)[lane + 64 * q] = sg[64 * q]; }
        f32x2_t hq[8], hqN[8];
        up_load_h2(hq, H2, (size_t)t0, lane);
        int tt = 0, b = 0, n = up_prepare(cmp, lidx, lgate, 0, x, lane), nb = n > 16 ? (n + 15) >> 4 : 1;
        RowBuf RA, RB;
        up_issue(RA, U, cmp, 0, 0, n, x, lane);
        up_load_h2(hqN, H2, (size_t)t0 + 1, lane);
#define UP_STEP(RC, RN) { \
            int ntt = tt, nbb = b + 1, nn = n; bool last = false; \
            if (nbb >= nb) { ntt = tt + 1; nbb = 0; if (ntt < 16) nn = up_prepare(cmp, lidx, lgate, ntt, x, lane); else last = true; } \
            if (!last) up_issue(RN, U, cmp, ntt, nbb, nn, x, lane); \
            up_finish(RC, hq, cmp, W, (size_t)t0 + tt, tt, b, n, lane); \
            if (last) break; \
            if (ntt != tt) { _Pragma("unroll") for (int q = 0; q < 8; ++q) hq[q] = hqN[q]; if (ntt + 1 < 16) up_load_h2(hqN, H2, (size_t)t0 + ntt + 1, lane); n = nn; nb = n > 16 ? (n + 15) >> 4 : 1; } \
            tt = ntt; b = nbb; }
        for (;;) { UP_STEP(RA, RB) UP_STEP(RB, RA) }
#undef UP_STEP
    }
}
struct TokBuf { u32x4 r[16]; f32x4 w[4]; };
DI void vp_load(TokBuf& tb, const unsigned char* Vs, const LAS unsigned short* lidx, const LAS float* lw, int tt, int lane) {
    const int g = lane >> 3, c = lane & 7;
    const LAS u32x4* ip = (const LAS u32x4*)(lidx + tt * 128 + 16 * g); const u32x4 ia = ip[0], ib = ip[1];
    const LAS f32x4* wp = (const LAS f32x4*)(lw + tt * 128 + 16 * g); tb.w[0] = wp[0]; tb.w[1] = wp[1]; tb.w[2] = wp[2]; tb.w[3] = wp[3];
    const unsigned e[16] = {ia.x & 0xffffu, ia.x >> 16, ia.y & 0xffffu, ia.y >> 16, ia.z & 0xffffu, ia.z >> 16, ia.w & 0xffffu, ia.w >> 16,
                            ib.x & 0xffffu, ib.x >> 16, ib.y & 0xffffu, ib.y >> 16, ib.z & 0xffffu, ib.z >> 16, ib.w & 0xffffu, ib.w >> 16};
#pragma unroll
    for (int i = 0; i < 16; ++i) tb.r[i] = *(const u32x4*)(Vs + (size_t)e[i] * 128 + c * 16);
}
DI void vp_compute(const TokBuf& tb, Frame& F, const float* g2s, float* xout, size_t t, int x, int lane) {
    f32x2_t out[8];
#pragma unroll
    for (int i = 0; i < 8; ++i) out[i] = (f32x2_t){0.f, 0.f};
#pragma unroll
    for (int i = 0; i < 16; ++i) { const float wk = tb.w[i >> 2][i & 3];
        out[0] = __builtin_amdgcn_cvt_pk_f32_fp8((int)tb.r[i].x, false) * wk + out[0]; out[1] = __builtin_amdgcn_cvt_pk_f32_fp8((int)tb.r[i].x, true) * wk + out[1];
        out[2] = __builtin_amdgcn_cvt_pk_f32_fp8((int)tb.r[i].y, false) * wk + out[2]; out[3] = __builtin_amdgcn_cvt_pk_f32_fp8((int)tb.r[i].y, true) * wk + out[3];
        out[4] = __builtin_amdgcn_cvt_pk_f32_fp8((int)tb.r[i].z, false) * wk + out[4]; out[5] = __builtin_amdgcn_cvt_pk_f32_fp8((int)tb.r[i].z, true) * wk + out[5];
        out[6] = __builtin_amdgcn_cvt_pk_f32_fp8((int)tb.r[i].w, false) * wk + out[6]; out[7] = __builtin_amdgcn_cvt_pk_f32_fp8((int)tb.r[i].w, true) * wk + out[7]; }
    float p[16];
#pragma unroll
    for (int i = 0; i < 8; ++i) { p[2 * i] = out[i].x; p[2 * i + 1] = out[i].y; }
#pragma unroll
    for (int i = 0; i < 8; ++i) { const bool up = (lane & 32) != 0; const float send = up ? p[i] : p[i + 8], keep = up ? p[i + 8] : p[i]; p[i] = keep + __shfl_xor(send, 32); }
#pragma unroll
    for (int i = 0; i < 4; ++i) { const bool up = (lane & 16) != 0; const float send = up ? p[i] : p[i + 4], keep = up ? p[i + 4] : p[i]; p[i] = keep + __shfl_xor(send, 16); }
#pragma unroll
    for (int i = 0; i < 2; ++i) { const bool up = (lane & 8) != 0; const float send = up ? p[i] : p[i + 2], keep = up ? p[i + 2] : p[i]; p[i] = keep + __shfl_xor(send, 8); }
    const int col = 128 * x + 16 * (lane & 7) + 8 * ((lane >> 5) & 1) + 4 * ((lane >> 4) & 1) + 2 * ((lane >> 3) & 1);
    const f32x2_t gg = *(const f32x2_t*)(g2s + col);
    const f32x2_t xv = *(const f32x2_t*)(F.out + t * 1024 + col);
    *(f32x2_t*)(xout + t * 1024 + col) = xv + gg * (f32x2_t){p[0], p[1]};
}
DI void p_vpass(Frame& F, int layer, float* xout) {
    const int x = F.bid & 7, jb = F.bid >> 3, nj = F.G >> 3;
    const unsigned char* Vs = F.ws + WS_V + ((size_t)layer * 8 + x) * 16384 * 128;
    const unsigned short* IDX = (const unsigned short*)(F.ws + WS_IDX); const float* W = (const float*)(F.ws + WS_W);
    const float* mods = (const float*)(F.ws + WS_MODS);
    LAS unsigned char* wl = F.lds + F.wave * UP_LDS;
    LAS unsigned short* lidx = (LAS unsigned short*)wl; LAS float* lw = (LAS float*)(wl + 4096);
    const int lane = F.lane;
    for (int t0 = (jb * NWAVES + F.wave) * 16; t0 < T_TOK; t0 += nj * NWAVES * 16) {
        const int b = t0 >> 11;
        const float* g2s = mods + ((size_t)layer * 16 + b) * 6144 + 5 * 1024;
        { const u32x4* si = (const u32x4*)(IDX + (size_t)t0 * 128) + lane;
#pragma unroll
          for (int q = 0; q < 4; ++q) ((LAS u32x4*)lidx)[lane + 64 * q] = si[64 * q];
          const u32x4* sg = (const u32x4*)(W + (size_t)t0 * 128) + lane;
#pragma unroll
          for (int q = 0; q < 8; ++q) ((LAS u32x4*)lw)[lane + 64 * q] = sg[64 * q]; }
        TokBuf A, B;
        vp_load(A, Vs, lidx, lw, 0, lane);
#pragma unroll 1
        for (int tt = 0; tt < 16; tt += 2) {
            vp_load(B, Vs, lidx, lw, tt + 1, lane);
            vp_compute(A, F, g2s, xout, (size_t)t0 + tt, x, lane);
            if (tt + 2 < 16) vp_load(A, Vs, lidx, lw, tt + 2, lane);
            vp_compute(B, F, g2s, xout, (size_t)t0 + tt + 1, x, lane);
        }
    }
}
#ifndef DUP
#define DUP -1
#endif
#ifndef PH_MASK
#define PH_MASK 0x3FFFF
#endif

#ifndef N_LAUNCH_MODE
#define N_LAUNCH_MODE 1
#endif
constexpr int NPH = 18;
template <class Epi> DI void run_gemm(Frame& F, const bf16* A, const bf16* Bt, int N, const Epi& E) {
    pg8::Gemm g{A, Bt, T_TOK, N, DM}; pg8::StaticOrder S; S.init(T_TOK, N, F.G, F.bid);
    pg8::gemm_phase<Epi, pg8::StaticOrder, true, true>(F.lds, g, S, E);
}
__global__ void __launch_bounds__(NT, 2) fwd(Args args) {
    extern __shared__ __attribute__((aligned(16))) unsigned char lds_raw[];
    cg::grid_group grid = cg::this_grid();
    Frame F;
    F.lds = (LAS unsigned char*)lds_raw;
#pragma unroll
    for (int i = 0; i < 23; ++i) F.in[i] = args.in[i];
    F.out = args.out; F.ws = args.ws;
    F.tid = threadIdx.x; F.lane = F.tid & 63; F.wave = __builtin_amdgcn_readfirstlane(F.tid >> 6); F.bid = blockIdx.x; F.G = gridDim.x;
    const int lo = args.ph_lo, hi = args.ph_hi;
#define IN(k) (lo <= (k) && (k) < hi)
#define SEAM(k) do { if (IN(k) && IN((k) + 1)) grid.sync(); } while (0)
    float* mods = (float*)(F.ws + WS_MODS);
    bf16* Hb = (bf16*)(F.ws + WS_H);
    if (((PH_MASK >> 0) & 1) && IN(0)) { p0_prologue(F); if (DUP == 0) { grid.sync(); p0_prologue(F); } } SEAM(0);
    if (((PH_MASK >> 1) & 1) && IN(1)) { norm_phase<true>(F, F.in[0], F.in[4], mods, mods + 1024, 6144, Hb); if (DUP == 1) { grid.sync(); norm_phase<true>(F, F.in[0], F.in[4], mods, mods + 1024, 6144, Hb); } } SEAM(1);
    if (((PH_MASK >> 2) & 1) && IN(2)) { pg8::EpiBf16<0> E{(bf16*)(F.ws + WS_PROJ), 3072, nullptr, 0, 0, 1.f}; run_gemm(F, Hb, (const bf16*)(F.ws + WS_WIN), 3072, E); if (DUP == 2) { grid.sync(); run_gemm(F, Hb, (const bf16*)(F.ws + WS_WIN), 3072, E); } } SEAM(2);
    if (((PH_MASK >> 3) & 1) && IN(3)) { p3_mlstm_local(F); if (DUP == 3) { grid.sync(); p3_mlstm_local(F); } } SEAM(3);
    if (((PH_MASK >> 4) & 1) && IN(4)) { p4_scan(F); if (DUP == 4) { grid.sync(); p3_mlstm_local(F); grid.sync(); p4_scan(F); } } SEAM(4);
    if (((PH_MASK >> 5) & 1) && IN(5)) { p5_mlstm_out(F); if (DUP == 5) { grid.sync(); p5_mlstm_out(F); } } SEAM(5);
    if (((PH_MASK >> 6) & 1) && IN(6)) { pg8::EpiResid E{F.in[0], F.out, mods + 2 * 1024, 6144}; run_gemm(F, Hb, (const bf16*)(F.ws + WS_WOUT), 1024, E); if (DUP == 6) { grid.sync(); run_gemm(F, Hb, (const bf16*)(F.ws + WS_WOUT), 1024, E); } } SEAM(6);
    if (((PH_MASK >> 7) & 1) && IN(7)) { norm_phase<false>(F, F.out, F.in[5], mods + 3 * 1024, mods + 4 * 1024, 6144, Hb); if (DUP == 7) { grid.sync(); norm_phase<false>(F, F.out, F.in[5], mods + 3 * 1024, mods + 4 * 1024, 6144, Hb); } } SEAM(7);
    if (((PH_MASK >> 8) & 1) && IN(8)) { pg8::EpiBf16<0> E{(bf16*)(F.ws + WS_PQ), 2048, nullptr, 0, 0, 1.f}; run_gemm(F, Hb, (const bf16*)(F.ws + WS_WPQ), 2048, E); if (DUP == 8) { grid.sync(); run_gemm(F, Hb, (const bf16*)(F.ws + WS_WPQ), 2048, E); } } SEAM(8);
    if (((PH_MASK >> 9) & 1) && IN(9)) { p_route(F, 0); if (DUP == 9) { grid.sync(); p_route(F, 0); } } SEAM(9);
    if (((PH_MASK >> 10) & 1) && IN(10)) {
        p_upass(F, 0); grid.sync(); p_vpass(F, 0, F.out); grid.sync();
        norm2_phase(F, F.out, F.in[4] + 1024, mods + 16 * 6144, mods + 16 * 6144 + 1024, 6144, Hb, F.in[13], (const float*)(F.ws + WS_KVMODS), (const float*)(F.ws + WS_KVMODS) + 1024, 2048, (bf16*)(F.ws + WS_HB));
    } SEAM(10);
    if (((PH_MASK >> 11) & 1) && IN(11)) {
        { pg8::EpiHeadNorm E{(bf16*)(F.ws + WS_Q), (bf16*)(F.ws + WS_Q), 4, F.in[17], 0.125f, EPS}; run_gemm(F, Hb, (const bf16*)(F.ws + WS_WSQ), 1024, E); }
        { pg8::EpiHeadNorm E{(bf16*)(F.ws + WS_K), (bf16*)(F.ws + WS_VV), 4, F.in[15], 1.0f, EPS}; run_gemm(F, (const bf16*)(F.ws + WS_HB), (const bf16*)(F.ws + WS_WKV), 2048, E);
          if (DUP == 11) { grid.sync(); run_gemm(F, (const bf16*)(F.ws + WS_HB), (const bf16*)(F.ws + WS_WKV), 2048, E); } }
    } SEAM(11);
    if (((PH_MASK >> 12) & 1) && IN(12)) { p12_attn(F); if (DUP == 12) { grid.sync(); p12_attn(F); } } SEAM(12);
    if (((PH_MASK >> 13) & 1) && IN(13)) { pg8::EpiResid E{F.out, F.out, mods + 16 * 6144 + 2 * 1024, 6144}; run_gemm(F, Hb, (const bf16*)(F.ws + WS_WSO), 1024, E); } SEAM(13);
    if (((PH_MASK >> 14) & 1) && IN(14)) { norm_phase<false>(F, F.out, F.in[5] + 1024, mods + 16 * 6144 + 3 * 1024, mods + 16 * 6144 + 4 * 1024, 6144, Hb); } SEAM(14);
    if (((PH_MASK >> 15) & 1) && IN(15)) { pg8::EpiBf16<0> E{(bf16*)(F.ws + WS_PQ), 2048, nullptr, 0, 0, 1.f}; run_gemm(F, Hb, (const bf16*)(F.ws + WS_WPQ) + (size_t)2048 * 1024, 2048, E); } SEAM(15);
    if (((PH_MASK >> 16) & 1) && IN(16)) { p_route(F, 1); } SEAM(16);
    if (((PH_MASK >> 17) & 1) && IN(17)) { p_upass(F, 1); grid.sync(); if (DUP == 20) { p_upass(F, 1); grid.sync(); } if (DUP == 21) { p_vpass(F, 1, (float*)(F.ws + WS_Q + 32 * MiB)); grid.sync(); } p_vpass(F, 1, F.out); }
#undef IN
#undef SEAM
}

extern "C" void kernel_launch(void* const* d_in, const int* in_sizes, int n_in, void* d_out, int out_size, void* d_ws, size_t ws_size, hipStream_t stream) {
    static int grid = 0;
    if (grid == 0) {
        int dev = 0, cus = 0, per_cu = 0;
        (void)hipGetDevice(&dev);
        (void)hipDeviceGetAttribute(&cus, hipDeviceAttributeMultiprocessorCount, dev);
        (void)hipFuncSetAttribute((const void*)fwd, hipFuncAttributeMaxDynamicSharedMemorySize, LDS_BYTES);
        (void)hipOccupancyMaxActiveBlocksPerMultiprocessor(&per_cu, (const void*)fwd, NT, LDS_BYTES);
        if (per_cu < 1) { fprintf(stderr, "kernel_launch: occupancy query says %d blocks per CU\n", per_cu); per_cu = 1; }
        grid = cus;
        if (n_in != 23 || ws_size < WS_END) fprintf(stderr, "kernel_launch: unexpected n_in %d / ws_size %zu\n", n_in, ws_size);
        (void)hipGetLastError();
    }
    Args a{};
    for (int i = 0; i < 23; ++i) a.in[i] = (const float*)d_in[i];
    a.out = (float*)d_out; a.ws = (unsigned char*)d_ws;
#if N_LAUNCH_MODE == 1
    a.ph_lo = 0; a.ph_hi = NPH;
    void* kargs[] = {&a};
    hipError_t e = hipLaunchCooperativeKernel((const void*)fwd, dim3(grid), dim3(NT), kargs, LDS_BYTES, stream);
    if (e != hipSuccess) fprintf(stderr, "kernel_launch: cooperative launch failed: %s (grid %d)\n", hipGetErrorString(e), grid);
#else
    for (int p = 0; p < NPH; ++p) { a.ph_lo = p; a.ph_hi = p + 1; hipLaunchKernelGGL(fwd, dim3(grid), dim3(NT), LDS_BYTES, stream, a); }
#endif
}
```

```cpp
#include <hip/hip_runtime.h>
#include <hip/hip_cooperative_groups.h>
#include <cstdio>
#include <cstdint>
namespace cg = cooperative_groups;
#define N_LAUNCH_MODE 1
namespace pg8 {
#define PG8_LAS __attribute__((address_space(3)))
typedef unsigned short bf16_t;
typedef short bf16x8 __attribute__((ext_vector_type(8)));
typedef float f32x4 __attribute__((ext_vector_type(4)));
typedef unsigned u32x4 __attribute__((ext_vector_type(4)));
constexpr int BM = 256, BK = 64, HALF = 128, HTB = HALF * BK * 2  , STAGE_BYTES = 8 * HTB, NXCD = 8, WGM = 8;

__host__ __device__ __forceinline__ int lds_byte(int r, int c) { const int st = (r >> 4) * 2 + (c >> 5), rr = r & 15, cc = c & 31, ob = rr * 64 + cc * 2; return st * 1024 + (ob ^ (((ob >> 9) & 1) << 5)); }
__host__ __device__ __forceinline__ void stage_rc(int b, int& R, int& C) { const int st = b / 1024, sb = b % 1024, swz = sb ^ (((sb >> 9) & 1) << 5); R = (st >> 1) * 16 + swz / 64; C = (st & 1) * 32 + (swz % 64) / 2; }
__host__ __device__ __forceinline__ int perm32(int rho) { const int n = rho >> 4, i = rho & 15; return 8 * (i >> 2) + 4 * n + (i & 3); }

struct Unit { int pm, pn; };
struct Gemm { const bf16_t* A; const bf16_t* Bt; int M, N, K; };

struct StaticOrder {
    int nM, nN, nwg, G, c;
    __host__ __device__ void init(int M, int N, int G_, int c_) { nM = M / BM; nN = N / BM; nwg = nM * nN; G = G_; c = c_; }
    __host__ __device__ bool next(int i, Unit& u) const {
        const long L = (long)i * G + c; if (L >= nwg) return false;
        int wgid = (int)L; { const int q = nwg / NXCD, r = nwg % NXCD, xcd = wgid % NXCD, off = wgid / NXCD; wgid = (xcd < r ? xcd * (q + 1) : r * (q + 1) + (xcd - r) * q) + off; }
        const int nig = WGM * nN, gid = wgid / nig, fm = gid * WGM, gsz = (nM - fm) < WGM ? (nM - fm) : WGM;
        u.pm = fm + ((wgid % nig) % gsz); u.pn = (wgid % nig) / gsz; return true;
    }
    __device__ __forceinline__ void a_ready(const Unit&) const {}
    __device__ __forceinline__ void done(const Unit&) const {}
};

__device__ __forceinline__ unsigned cvt_pk_bf16(float lo, float hi) { unsigned r; asm volatile("v_cvt_pk_bf16_f32 %0, %1, %2" : "=v"(r) : "v"(lo), "v"(hi)); return r; }
typedef float f32x2 __attribute__((ext_vector_type(2)));
__device__ __forceinline__ f32x2 gelu_pk(f32x2 v) {
    const f32x2 av = __builtin_elementwise_abs(v), d = av * 0.2316418882f + 1.0f;
    f32x2 t; t.x = __builtin_amdgcn_rcpf(d.x); t.y = __builtin_amdgcn_rcpf(d.y);
    f32x2 q = t * 0.5307027145f + (-0.7265760135f); q = q * t + 0.7107068705f; q = q * t + (-0.142248368f); q = q * t + 0.127414796f; q = q * t;
    const f32x2 s = (v * v) * (-0.72134752044f);
    f32x2 e; e.x = __builtin_amdgcn_exp2f(s.x); e.y = __builtin_amdgcn_exp2f(s.y);
    const f32x2 m = v * (q * e), r = v - m;
    f32x2 o; o.x = v.x < 0.f ? m.x : r.x; o.y = v.y < 0.f ? m.y : r.y; return o;
}

template <int ACT  > struct EpiBf16 {
    static constexpr bool PERM = true, AFTER_DRAIN = false; static_assert(ACT == 0 || ACT == 1, "EpiBf16: ACT is 0 (none) or 1 (gelu_pk)");
    bf16_t* O; int ldc; const float* bias; int split_cols; size_t split_stride; float scale0;
    __device__ __forceinline__ void operator()(const f32x4 (&acc)[2][2][4][2], const Unit& u, int wr, int wc, int fr, int fq) const {
        const int row0 = u.pm * BM + wr * 64 + fr; int colt = u.pn * BM; bf16_t* base = O;
        float sc = 1.f; if (split_cols) { const int t = colt / split_cols; base += (size_t)t * split_stride; colt -= t * split_cols; if (t == 0) sc = scale0; }
        const int col0 = colt + wc * 32 + 8 * fq, bcol0 = u.pn * BM + wc * 32 + 8 * fq;
        f32x4 bv[2][2];
#pragma unroll
        for (int bj = 0; bj < 2; ++bj)
#pragma unroll
            for (int n = 0; n < 2; ++n) bv[bj][n] = bias ? *(const f32x4*)(bias + bcol0 + bj * HALF + 4 * n) : (f32x4){0.f, 0.f, 0.f, 0.f};
#pragma unroll
        for (int ai = 0; ai < 2; ++ai)
#pragma unroll
            for (int m = 0; m < 4; ++m) { bf16_t* rowp = base + (size_t)(row0 + ai * HALF + m * 16) * ldc + col0;
#pragma unroll
                for (int bj = 0; bj < 2; ++bj) { f32x4 v0 = acc[ai][bj][m][0] + bv[bj][0], v1 = acc[ai][bj][m][1] + bv[bj][1];
                    if (ACT == 1) { f32x2 a = gelu_pk((f32x2){v0[0], v0[1]}), b = gelu_pk((f32x2){v0[2], v0[3]}), c = gelu_pk((f32x2){v1[0], v1[1]}), d = gelu_pk((f32x2){v1[2], v1[3]});
                        v0 = (f32x4){a.x, a.y, b.x, b.y}; v1 = (f32x4){c.x, c.y, d.x, d.y}; }
                    v0 = v0 * sc; v1 = v1 * sc; u32x4 w; w.x = cvt_pk_bf16(v0[0], v0[1]); w.y = cvt_pk_bf16(v0[2], v0[3]); w.z = cvt_pk_bf16(v1[0], v1[1]); w.w = cvt_pk_bf16(v1[2], v1[3]);
                    *(u32x4*)(rowp + bj * HALF) = w; } }
    }
};
struct EpiResid {
    static constexpr bool PERM = false, AFTER_DRAIN = false;
    const float* base; float* out; const float* gate; int gstride;
    __device__ __forceinline__ void operator()(const f32x4 (&acc)[2][2][4][2], const Unit& u, int wr, int wc, int fr, int fq) const {
        const int col0 = u.pn * BM + wc * 32 + 4 * fq;
        const int b = (u.pm * BM) >> 11;
        f32x4 gv[2][2];
#pragma unroll
        for (int bj = 0; bj < 2; ++bj)
#pragma unroll
            for (int n = 0; n < 2; ++n) gv[bj][n] = *(const f32x4*)(gate + (size_t)b * gstride + col0 + bj * HALF + n * 16);
#pragma unroll
        for (int ai = 0; ai < 2; ++ai)
#pragma unroll
            for (int m = 0; m < 4; ++m) { const size_t off = (size_t)(u.pm * BM + ai * HALF + wr * 64 + m * 16 + fr) * 1024 + col0;
#pragma unroll
                for (int bj = 0; bj < 2; ++bj)
#pragma unroll
                    for (int n = 0; n < 2; ++n) { const f32x4 bs = *(const f32x4*)(base + off + bj * HALF + n * 16);
                        *(f32x4*)(out + off + bj * HALF + n * 16) = bs + gv[bj][n] * acc[ai][bj][m][n]; }
                if (m & 1) asm volatile("" ::: "memory"); }
    }
};
struct EpiHeadNorm {
    static constexpr bool PERM = true, AFTER_DRAIN = false;
    bf16_t* O0; bf16_t* O1; int ntile_norm; const float* g; float scale; float eps;
    __device__ __forceinline__ void operator()(const f32x4 (&acc)[2][2][4][2], const Unit& u, int wr, int wc, int fr, int fq) const {
        const bool nrm = u.pn < ntile_norm; bf16_t* O = nrm ? O0 : O1; const int pnl = nrm ? u.pn : u.pn - ntile_norm;
        f32x4 gv[2][2];
#pragma unroll
        for (int bj = 0; bj < 2; ++bj)
#pragma unroll
            for (int n = 0; n < 2; ++n) { const f32x4 t = *(const f32x4*)(g + 32 * bj + 8 * fq + 4 * n); gv[bj][n] = nrm ? t * scale : (f32x4){1.f, 1.f, 1.f, 1.f}; }
#pragma unroll
        for (int ai = 0; ai < 2; ++ai)
#pragma unroll
            for (int m = 0; m < 4; ++m) {
                float ss = 0.f;
#pragma unroll
                for (int bj = 0; bj < 2; ++bj)
#pragma unroll
                    for (int n = 0; n < 2; ++n) { const f32x4 x = acc[ai][bj][m][n]; ss += (x[0] * x[0] + x[1] * x[1]) + (x[2] * x[2] + x[3] * x[3]); }
                ss += __shfl_xor(ss, 16); ss += __shfl_xor(ss, 32);
                const float rs = nrm ? 1.0f / sqrtf(ss * (1.0f / 64.0f) + eps) : 1.0f;
                bf16_t* rowp = O + (size_t)(u.pm * BM + ai * HALF + wr * 64 + m * 16 + fr) * 1024 + pnl * BM + wc * 64 + 8 * fq;
#pragma unroll
                for (int bj = 0; bj < 2; ++bj) { const f32x4 v0 = acc[ai][bj][m][0] * rs * gv[bj][0], v1 = acc[ai][bj][m][1] * rs * gv[bj][1];
                    u32x4 w; w.x = cvt_pk_bf16(v0[0], v0[1]); w.y = cvt_pk_bf16(v0[2], v0[3]); w.z = cvt_pk_bf16(v1[0], v1[1]); w.w = cvt_pk_bf16(v1[2], v1[3]);
                    *(u32x4*)(rowp + bj * 32) = w; }
            }
    }
};
template <class Epi, class Sched, bool ALIGN_EPI = false, bool SP2 = false>
__device__ __forceinline__ void gemm_phase(PG8_LAS unsigned char* lds, const Gemm g, const Sched& S, const Epi& E) {
    const int tid = threadIdx.x, wid = __builtin_amdgcn_readfirstlane(tid >> 6), lane = tid & 63, wr = wid >> 2, wc = wid & 3, fr = lane & 15, fq = lane >> 4;
    const int K = g.K, nt = K / BK;
    unsigned voffA[2], voffB[2];
#pragma unroll
    for (int i = 0; i < 2; ++i) { int R, C; stage_rc(tid * 16 + i * 8192, R, C); const int Rb = Epi::PERM ? ((R & ~31) + perm32(R & 31)) : R;
        voffA[i] = (unsigned)(R * K + C) * 2u; voffB[i] = (unsigned)(Rb * K + C) * 2u; }
    const size_t kstep = (size_t)(BK * 2);
    const size_t hstep = (size_t)HALF * K * 2;
    const size_t tstep = 2 * hstep;
    const unsigned ldsw = (unsigned)wid * 1024u;
    const int aoff = lds_byte(wr * 64 + fr, fq * 8), boff = lds_byte(wc * 32 + fr, fq * 8);
#define PG8_SA(b, h) (((b) * 2 + (h)) * HTB)
#define PG8_SB(b, h) ((4 + (b) * 2 + (h)) * HTB)
#define PG8_STAGE(bufoff, gbase, voff) do { _Pragma("unroll") for (int _i = 0; _i < 2; ++_i) \
        __builtin_amdgcn_global_load_lds((const unsigned*)((const char*)(gbase) + (voff)[_i]), (PG8_LAS unsigned*)(lds + (bufoff) + ldsw + _i * 8192), 16, 0, 0); } while (0)
#define PG8_LDA(dst, b, h) do { _Pragma("unroll") for (int m = 0; m < 4; ++m) _Pragma("unroll") for (int k = 0; k < 2; ++k) dst[m][k] = *(const PG8_LAS bf16x8*)(lds + PG8_SA(b, h) + aoff + m * 2048 + k * 1024); } while (0)
#define PG8_LDB(dst, b, h) do { _Pragma("unroll") for (int n = 0; n < 2; ++n) _Pragma("unroll") for (int k = 0; k < 2; ++k) dst[n][k] = *(const PG8_LAS bf16x8*)(lds + PG8_SB(b, h) + boff + n * 2048 + k * 1024); } while (0)
#define PG8_MMA(ai, bj, At, Bt) do { __builtin_amdgcn_s_setprio(1); _Pragma("unroll") for (int m = 0; m < 4; ++m) _Pragma("unroll") for (int n = 0; n < 2; ++n) _Pragma("unroll") for (int k = 0; k < 2; ++k) \
        acc[ai][bj][m][n] = __builtin_amdgcn_mfma_f32_16x16x32_bf16(Bt[n][k], At[m][k], acc[ai][bj][m][n], 0, 0, 0); __builtin_amdgcn_s_setprio(0); } while (0)
#define PG8_WAIT_V(n) asm volatile("s_waitcnt vmcnt(" #n ")" ::: "memory")
#define PG8_WAIT_L(n) asm volatile("s_waitcnt lgkmcnt(" #n ")" ::: "memory")
#define PG8_BAR __builtin_amdgcn_s_barrier()
#define PG8_SCHED __builtin_amdgcn_sched_barrier(0)
    Unit cur, nxt; int ui = 0;
    if (!S.next(0, cur)) return;
    f32x4 acc[2][2][4][2];
#pragma unroll
    for (int a = 0; a < 2; ++a)
#pragma unroll
        for (int b = 0; b < 2; ++b)
#pragma unroll
            for (int m = 0; m < 4; ++m)
#pragma unroll
                for (int n = 0; n < 2; ++n) acc[a][b][m][n] = (f32x4){0.f, 0.f, 0.f, 0.f};
    bf16x8 At[4][2], B0[2][2], B1[2][2];
    const char* cA = (const char*)g.A + (size_t)cur.pm * tstep; const char* cB = (const char*)g.Bt + (size_t)cur.pn * tstep;
    S.a_ready(cur);
    if constexpr (SP2) {
        PG8_STAGE(PG8_SB(0, 0), cB, voffB); PG8_STAGE(PG8_SB(0, 1), cB + hstep, voffB); PG8_STAGE(PG8_SA(0, 0), cA, voffA); PG8_STAGE(PG8_SA(0, 1), cA + hstep, voffA);
        if (wr == 1) PG8_BAR;
        PG8_WAIT_V(2); PG8_BAR;
        PG8_STAGE(PG8_SB(1, 0), cB + kstep, voffB); PG8_STAGE(PG8_SA(1, 0), cA + kstep, voffA); PG8_STAGE(PG8_SB(1, 1), cB + hstep + kstep, voffB);
        PG8_WAIT_V(6); PG8_BAR;
    } else {
        PG8_STAGE(PG8_SB(0, 0), cB, voffB); PG8_STAGE(PG8_SA(0, 0), cA, voffA); PG8_STAGE(PG8_SB(0, 1), cB + hstep, voffB); PG8_STAGE(PG8_SA(0, 1), cA + hstep, voffA);
        if (wr == 1) PG8_BAR;
        PG8_WAIT_V(4); PG8_BAR;
        PG8_STAGE(PG8_SB(1, 0), cB + kstep, voffB); PG8_STAGE(PG8_SA(1, 0), cA + kstep, voffA); PG8_STAGE(PG8_SB(1, 1), cB + hstep + kstep, voffB);
        PG8_WAIT_V(6); PG8_BAR;
    }
    for (;;) {
        const bool has_next = S.next(ui + 1, nxt);
        const char* nA = has_next ? (const char*)g.A + (size_t)nxt.pm * tstep : cA; const char* nB = has_next ? (const char*)g.Bt + (size_t)nxt.pn * tstep : cB;
        for (int t = 0; t < nt; t += 2) {
            const bool last = (t == nt - 2);
            const char* a1 = cA + (size_t)(t + 1) * kstep;
            const char* a2 = last ? nA : cA + (size_t)(t + 2) * kstep; const char* b2 = last ? nB : cB + (size_t)(t + 2) * kstep;
            const char* a3 = a2 + kstep; const char* b3 = b2 + kstep;
            if (last && has_next) S.a_ready(nxt);
            if constexpr (SP2) {
            PG8_LDB(B0, 0, 0); PG8_LDB(B1, 0, 1); PG8_SCHED; PG8_LDA(At, 0, 0); PG8_STAGE(PG8_SA(1, 1), a1 + hstep, voffA);
            PG8_WAIT_V(8); PG8_WAIT_L(0); PG8_BAR; PG8_MMA(0, 0, At, B0); PG8_MMA(0, 1, At, B1); PG8_BAR; PG8_SCHED;
            PG8_LDA(At, 0, 1); PG8_STAGE(PG8_SB(0, 0), b2, voffB); PG8_STAGE(PG8_SB(0, 1), b2 + hstep, voffB); PG8_STAGE(PG8_SA(0, 0), a2, voffA);
            PG8_WAIT_V(8); PG8_WAIT_L(0); PG8_BAR; PG8_MMA(1, 0, At, B0); PG8_MMA(1, 1, At, B1); PG8_BAR; PG8_SCHED;
            PG8_LDB(B0, 1, 0); PG8_LDB(B1, 1, 1); PG8_SCHED; PG8_LDA(At, 1, 0); PG8_STAGE(PG8_SA(0, 1), a2 + hstep, voffA);
            PG8_WAIT_V(8); PG8_WAIT_L(0); PG8_BAR; PG8_MMA(0, 0, At, B0); PG8_MMA(0, 1, At, B1); PG8_BAR; PG8_SCHED;
            PG8_LDA(At, 1, 1); PG8_STAGE(PG8_SB(1, 0), b3, voffB); PG8_STAGE(PG8_SB(1, 1), b3 + hstep, voffB); PG8_STAGE(PG8_SA(1, 0), a3, voffA);
            PG8_WAIT_V(8); PG8_WAIT_L(0); PG8_BAR; PG8_MMA(1, 0, At, B0); PG8_MMA(1, 1, At, B1); PG8_BAR; PG8_SCHED;
            } else {
            PG8_LDB(B0, 0, 0); PG8_SCHED; PG8_LDA(At, 0, 0); PG8_STAGE(PG8_SA(1, 1), a1 + hstep, voffA);
            PG8_WAIT_L(8); PG8_BAR; PG8_WAIT_L(0); PG8_MMA(0, 0, At, B0); PG8_BAR; PG8_SCHED;
            PG8_LDB(B1, 0, 1); PG8_STAGE(PG8_SB(0, 0), b2, voffB);
            PG8_BAR; PG8_WAIT_L(0); PG8_MMA(0, 1, At, B1); PG8_BAR;
            PG8_LDA(At, 0, 1); PG8_STAGE(PG8_SA(0, 0), a2, voffA);
            PG8_BAR; PG8_WAIT_L(0); PG8_MMA(1, 0, At, B0); PG8_BAR; PG8_SCHED;
            PG8_STAGE(PG8_SB(0, 1), b2 + hstep, voffB);
            PG8_WAIT_V(6); PG8_BAR; PG8_MMA(1, 1, At, B1); PG8_BAR;
            PG8_LDB(B0, 1, 0); PG8_SCHED; PG8_LDA(At, 1, 0); PG8_STAGE(PG8_SA(0, 1), a2 + hstep, voffA);
            PG8_WAIT_L(8); PG8_BAR; PG8_WAIT_L(0); PG8_MMA(0, 0, At, B0); PG8_BAR; PG8_SCHED;
            PG8_LDB(B1, 1, 1); PG8_STAGE(PG8_SB(1, 0), b3, voffB);
            PG8_BAR; PG8_WAIT_L(0); PG8_MMA(0, 1, At, B1); PG8_BAR;
            PG8_LDA(At, 1, 1); PG8_STAGE(PG8_SA(1, 0), a3, voffA);
            PG8_BAR; PG8_WAIT_L(0); PG8_MMA(1, 0, At, B0); PG8_BAR; PG8_SCHED;
            PG8_STAGE(PG8_SB(1, 1), b3 + hstep, voffB);
            PG8_WAIT_V(6); PG8_BAR; PG8_MMA(1, 1, At, B1); PG8_BAR;
            }
        }
        if constexpr (ALIGN_EPI) { if (wr == 0) PG8_BAR; }
        if constexpr (!Epi::AFTER_DRAIN) { E(acc, cur, wr, wc, fr, fq); S.done(cur); }
        if (!has_next) break;
#pragma unroll
        for (int a = 0; a < 2; ++a)
#pragma unroll
            for (int b = 0; b < 2; ++b)
#pragma unroll
                for (int m = 0; m < 4; ++m)
#pragma unroll
                    for (int n = 0; n < 2; ++n) acc[a][b][m][n] = (f32x4){0.f, 0.f, 0.f, 0.f};
        cur = nxt; cA = nA; cB = nB; ++ui;
        if constexpr (ALIGN_EPI) { if (wr == 1) PG8_BAR; }
    }
    PG8_WAIT_V(0);
    if constexpr (!ALIGN_EPI) { if (wr == 0) PG8_BAR; }
    PG8_BAR;
    if constexpr (Epi::AFTER_DRAIN) { E.fused(acc, cur, wr, wc, fr, fq, lds, wid, lane); S.done(cur); }
#undef PG8_SA
#undef PG8_SB
#undef PG8_STAGE
#undef PG8_LDA
#undef PG8_LDB
#undef PG8_MMA
#undef PG8_WAIT_V
#undef PG8_WAIT_L
#undef PG8_BAR
#undef PG8_SCHED
}
}

#define DI __device__ __forceinline__
#define LAS __attribute__((address_space(3)))
typedef unsigned short bf16;
typedef __bf16 bf16x2_t __attribute__((ext_vector_type(2)));
typedef float f32x2_t __attribute__((ext_vector_type(2)));
typedef float f32x4 __attribute__((ext_vector_type(4)));
typedef float f32x16 __attribute__((ext_vector_type(16)));
typedef short bf16x8 __attribute__((ext_vector_type(8)));
typedef short s16x4 __attribute__((ext_vector_type(4)));
typedef unsigned u32x4 __attribute__((ext_vector_type(4)));
typedef unsigned u32x2 __attribute__((ext_vector_type(2)));

constexpr int NT = 512, NWAVES = 8;
constexpr int LDS_BYTES = 147456;
constexpr int T_TOK = 32768, DM = 1024, SEQ = 2048, NB = 16;
constexpr float EPS = 1e-6f;
constexpr size_t MiB = 1u << 20;
constexpr size_t WS_MODS = 1 * MiB, WS_KVMODS = WS_MODS + (size_t)2 * 16 * 6144 * 4;
constexpr size_t WS_GATES = 2 * MiB, WS_BLAST = 4 * MiB, WS_MLOC = 4 * MiB + 65536, WS_MPREV = 4 * MiB + 131072, WS_NLOC = 5 * MiB;
constexpr size_t WS_WG = 6 * MiB, WS_SUBK = 7 * MiB;
constexpr size_t WS_WIN = 8 * MiB, WS_WOUT = 14 * MiB, WS_WKV = 16 * MiB, WS_WSQ = 20 * MiB, WS_WSO = 22 * MiB, WS_WPQ = 24 * MiB;
constexpr size_t WS_IDX = 36 * MiB, WS_GATE = 44 * MiB;
constexpr size_t WS_U = 64 * MiB, WS_V = 128 * MiB, WS_H = 192 * MiB, WS_HB = 256 * MiB, WS_PROJ = 320 * MiB, WS_END = 512 * MiB;
constexpr size_t WS_CST = WS_HB;
constexpr size_t WS_Q = WS_PROJ, WS_K = WS_PROJ + 64 * MiB, WS_VV = WS_PROJ + 128 * MiB, WS_PQ = WS_PROJ;

struct Args { const float* in[23]; float* out; unsigned char* ws; int ph_lo, ph_hi; };
struct Frame {
    LAS unsigned char* lds;
    const float* in[23]; float* out; unsigned char* ws;
    int tid, lane, wave, bid, G;
};

DI unsigned cvtpk(float lo, float hi) { f32x2_t v = {lo, hi}; bf16x2_t b = __builtin_convertvector(v, bf16x2_t); return __builtin_bit_cast(unsigned, b); }
DI float bflo(unsigned u) { return __uint_as_float(u << 16); }
DI float bfhi(unsigned u) { return __uint_as_float(u & 0xffff0000u); }
DI float wave_sum(float v) {
#pragma unroll
    for (int o = 1; o < 64; o <<= 1) v += __shfl_xor(v, o);
    return v;
}
DI float wave_max(float v) {
#pragma unroll
    for (int o = 1; o < 64; o <<= 1) v = fmaxf(v, __shfl_xor(v, o));
    return v;
}
DI int crow(int r, int hi) { return (r & 3) + 8 * (r >> 2) + 4 * hi; }
#define MFMA32(a, b, c) __builtin_amdgcn_mfma_f32_32x32x16_bf16((a), (b), (c), 0, 0, 0)
typedef short v4i16_t __attribute__((ext_vector_type(4)));
DI s16x4 tr16(const LAS unsigned char* p) { return __builtin_bit_cast(s16x4, __builtin_amdgcn_ds_read_tr16_b64_v4i16((LAS v4i16_t*)p)); }
DI int tr_off(int tok, int ch) { return (ch >> 2) * 4096 + (tok >> 4) * 1024 + (tok & 15) * 64 + (ch & 3) * 16; }
DI bf16x8 tr_frag(const LAS unsigned char* img, int dh, int ks, int lane) {
    const int hi = lane >> 5; const int vb = ((lane >> 4) & 1) * 32 + (lane & 3) * 8 + (4 * hi + ((lane & 15) >> 2)) * 64;
    const s16x4 lo = tr16(img + vb + dh * 4096 + ks * 1024), h2 = tr16(img + vb + dh * 4096 + ks * 1024 + 512);
    return __builtin_shufflevector(lo, h2, 0, 1, 2, 3, 4, 5, 6, 7);
}
template <int NTOK> DI bf16x8 row_frag(const LAS unsigned char* img, int tt, int ks, int lane) {
    const int hi = lane >> 5, r32 = lane & 31;
    return *(const LAS bf16x8*)(img + (2 * ks + hi) * (NTOK * 16) + (32 * tt + r32) * 16);
}
DI bf16x8 pack8(const f32x16& x, int s) {
    u32x4 p; p.x = cvtpk(x[8 * s], x[8 * s + 1]); p.y = cvtpk(x[8 * s + 2], x[8 * s + 3]); p.z = cvtpk(x[8 * s + 4], x[8 * s + 5]); p.w = cvtpk(x[8 * s + 6], x[8 * s + 7]);
    return __builtin_bit_cast(bf16x8, p);
}

DI void p0_ada(Frame& F) {
    LAS float* sil = (LAS float*)F.lds;
    LAS float* red = (LAS float*)(F.lds + 65536);
    const float* c = F.in[1];
    for (int i = F.tid; i < 16 * 1024; i += NT) { const int b = i >> 10, d = i & 1023; const float v = c[i]; sil[d * 16 + b] = v / (1.f + expf(-v)); }
    __syncthreads();
    for (int item = F.bid; item < 224; item += F.G) {
        const float* W; const float* bias; float* out; int N, col0;
        if (item < 192) { const int layer = item / 96, it = item % 96; W = F.in[2] + (size_t)layer * 1024 * 6144; bias = F.in[3] + layer * 6144; N = 6144; col0 = it * 64; out = (float*)(F.ws + WS_MODS) + (size_t)layer * 16 * 6144; }
        else { const int it = item - 192; W = F.in[11]; bias = F.in[12]; N = 2048; col0 = it * 64; out = (float*)(F.ws + WS_KVMODS); }
        float acc[16];
#pragma unroll
        for (int b = 0; b < 16; ++b) acc[b] = 0.f;
        const int d0 = F.wave * 128;
        const float* wp = W + (size_t)d0 * N + col0 + F.lane;
#pragma unroll 4
        for (int d = 0; d < 128; ++d) {
            const float w = wp[(size_t)d * N];
            const LAS f32x4* s4 = (const LAS f32x4*)(sil + (d0 + d) * 16);
            const f32x4 s0 = s4[0], s1 = s4[1], s2 = s4[2], s3 = s4[3];
            acc[0] += w * s0[0]; acc[1] += w * s0[1]; acc[2] += w * s0[2]; acc[3] += w * s0[3];
            acc[4] += w * s1[0]; acc[5] += w * s1[1]; acc[6] += w * s1[2]; acc[7] += w * s1[3];
            acc[8] += w * s2[0]; acc[9] += w * s2[1]; acc[10] += w * s2[2]; acc[11] += w * s2[3];
            acc[12] += w * s3[0]; acc[13] += w * s3[1]; acc[14] += w * s3[2]; acc[15] += w * s3[3];
        }
#pragma unroll
        for (int b = 0; b < 16; ++b) red[(F.wave * 16 + b) * 64 + F.lane] = acc[b];
        __syncthreads();
        for (int i = F.tid; i < 1024; i += NT) { const int b = i >> 6, l = i & 63; float s = 0.f;
#pragma unroll
            for (int w = 0; w < 8; ++w) s += red[(w * 16 + b) * 64 + l];
            out[(size_t)b * N + col0 + l] = s + bias[col0 + l]; }
        __syncthreads();
    }
}
DI void transpose_item(const float* W, int ldw, bf16* WT, int dst_row0, LAS float* scr, int k0, int n0, int lane) {
#pragma unroll 8
    for (int i = 0; i < 32; ++i) { const int kk = 2 * i + (lane >> 5); scr[kk * 33 + (lane & 31)] = W[(size_t)(k0 + kk) * ldw + n0 + (lane & 31)]; }
    asm volatile("s_waitcnt lgkmcnt(0)" ::: "memory");
    const int c = lane & 7;
#pragma unroll
    for (int j = 0; j < 4; ++j) { const int n = (lane >> 3) + 8 * j; const LAS float* s = scr + (8 * c) * 33 + n;
        u32x4 o; o.x = cvtpk(s[0 * 33], s[1 * 33]); o.y = cvtpk(s[2 * 33], s[3 * 33]); o.z = cvtpk(s[4 * 33], s[5 * 33]); o.w = cvtpk(s[6 * 33], s[7 * 33]);
        *(u32x4*)(WT + (size_t)(dst_row0 + n) * 1024 + k0 + 8 * c) = o; }
    asm volatile("s_waitcnt lgkmcnt(0)" ::: "memory");
}
DI int permrow(int c) { return (c & ~255) + 32 * (4 * ((c >> 5) & 1) + ((c >> 6) & 3)) + (c & 31); }
DI void p0_prologue(Frame& F) {
    if (F.bid == 0) for (int i = F.tid; i < 1024; i += NT) ((unsigned*)(F.ws + 4096))[i] = 0u;
    p0_ada(F);
    LAS float* scr = (LAS float*)(F.lds + F.wave * 16384);
    const int gw = F.bid * NWAVES + F.wave, NGW = F.G * NWAVES;
    for (int it = gw; it < 6144; it += NGW) {
        int r = it; const float* W; int ldw, ncols; bf16* dst; bool perm;
        if (r < 1536) { W = F.in[6]; ldw = 3088; ncols = 3072; dst = (bf16*)(F.ws + WS_WIN); perm = false; }
        else if ((r -= 1536) < 512) { W = F.in[10]; ldw = 1024; ncols = 1024; dst = (bf16*)(F.ws + WS_WOUT); perm = false; }
        else if ((r -= 512) < 1024) { W = F.in[14]; ldw = 2048; ncols = 2048; dst = (bf16*)(F.ws + WS_WKV); perm = true; }
        else if ((r -= 1024) < 512) { W = F.in[16]; ldw = 1024; ncols = 1024; dst = (bf16*)(F.ws + WS_WSQ); perm = true; }
        else if ((r -= 512) < 512) { W = F.in[18]; ldw = 1024; ncols = 1024; dst = (bf16*)(F.ws + WS_WSO); perm = false; }
        else if ((r -= 512) < 1024) { W = F.in[19]; ldw = 2048; ncols = 2048; dst = (bf16*)(F.ws + WS_WPQ); perm = false; }
        else { r -= 1024; W = F.in[19] + (size_t)1024 * 2048; ldw = 2048; ncols = 2048; dst = (bf16*)(F.ws + WS_WPQ) + (size_t)2048 * 1024; perm = false; }
        const int nblk = ncols / 32, kb = r / nblk, nb = r % nblk, n0 = 32 * nb;
        transpose_item(W, ldw, dst, perm ? permrow(n0) : n0, scr, 64 * kb, n0, F.lane);
    }
    const size_t gt = (size_t)F.bid * NT + F.tid, NGT = (size_t)F.G * NT;
    constexpr size_t TBL16 = (size_t)2 * 16384 * 1024 / 16;
    for (size_t i = gt; i < 2 * TBL16; i += NGT) {
        const bool isv = i >= TBL16; const size_t j = isv ? i - TBL16 : i; const float sc = isv ? 4.f : 32.f;
        const f32x4* src = (const f32x4*)(isv ? F.in[22] : F.in[21]) + 4 * j;
        const f32x4 a = src[0] * sc, b = src[1] * sc, c2 = src[2] * sc, d = src[3] * sc;
        int p0 = 0, p1 = 0, p2 = 0, p3 = 0;
        p0 = __builtin_amdgcn_cvt_pk_fp8_f32(a[0], a[1], p0, false); p0 = __builtin_amdgcn_cvt_pk_fp8_f32(a[2], a[3], p0, true);
        p1 = __builtin_amdgcn_cvt_pk_fp8_f32(b[0], b[1], p1, false); p1 = __builtin_amdgcn_cvt_pk_fp8_f32(b[2], b[3], p1, true);
        p2 = __builtin_amdgcn_cvt_pk_fp8_f32(c2[0], c2[1], p2, false); p2 = __builtin_amdgcn_cvt_pk_fp8_f32(c2[2], c2[3], p2, true);
        p3 = __builtin_amdgcn_cvt_pk_fp8_f32(d[0], d[1], p3, false); p3 = __builtin_amdgcn_cvt_pk_fp8_f32(d[2], d[3], p3, true);
        size_t dj = j;
        if (isv) { const size_t q = j & 63, e = (j >> 6) & 16383, ly = j >> 20; dj = (((ly * 8 + (q >> 3)) * 16384 + e) << 3) + (q & 7); }
        ((u32x4*)(F.ws + (isv ? WS_V : WS_U)))[dj] = (u32x4){(unsigned)p0, (unsigned)p1, (unsigned)p2, (unsigned)p3};
    }
    for (size_t i = gt; i < 65536 / 2; i += NGT) { const float a = F.in[20][2 * i], b = F.in[20][2 * i + 1]; ((unsigned*)(F.ws + WS_SUBK))[i] = cvtpk(a, b); }
    for (size_t i = gt; i < 16 * 1024; i += NGT) { const int g = (int)(i >> 10), k = (int)(i & 1023); ((float*)(F.ws + WS_WG))[i] = F.in[6][(size_t)k * 3088 + 3072 + g]; }
}

template <bool GATES> DI void norm_phase(Frame& F, const float* xin, const float* g, const float* shp, const float* scp, int bstride, bf16* hout) {
    const int gw = F.bid * NWAVES + F.wave, NGW = F.G * NWAVES;
    LAS float* wg = (LAS float*)F.lds;
    if (GATES) { const float* src = (const float*)(F.ws + WS_WG); for (int i = F.tid; i < 16 * 1024 / 4; i += NT) ((LAS f32x4*)wg)[i] = ((const f32x4*)src)[i]; __syncthreads(); }
    for (int chunk = gw; chunk < T_TOK / 16; chunk += NGW) {
        const int row0 = chunk * 16, b = row0 >> 11;
        f32x4 A[4], Bv[4];
#pragma unroll
        for (int j = 0; j < 4; ++j) { const int c = 4 * F.lane + 256 * j; const f32x4 gg = *(const f32x4*)(g + c), sc = *(const f32x4*)(scp + (size_t)b * bstride + c);
            A[j] = gg * (sc + 1.0f); Bv[j] = *(const f32x4*)(shp + (size_t)b * bstride + c); }
        for (int r = 0; r < 16; ++r) {
            const int row = row0 + r;
            const f32x4* xr = (const f32x4*)(xin + (size_t)row * DM) + F.lane;
            f32x4 v[4]; float ss = 0.f;
#pragma unroll
            for (int j = 0; j < 4; ++j) { v[j] = xr[64 * j]; ss += (v[j][0] * v[j][0] + v[j][1] * v[j][1]) + (v[j][2] * v[j][2] + v[j][3] * v[j][3]); }
            const float rstd = 1.0f / sqrtf(wave_sum(ss) * (1.0f / DM) + EPS);
            unsigned long long* o8 = (unsigned long long*)(hout + (size_t)row * DM) + F.lane;
#pragma unroll
            for (int j = 0; j < 4; ++j) { v[j] = v[j] * rstd * A[j] + Bv[j]; o8[64 * j] = (unsigned long long)cvtpk(v[j][0], v[j][1]) | ((unsigned long long)cvtpk(v[j][2], v[j][3]) << 32); }
            if (GATES) {
                float p[16];
#pragma unroll
                for (int q = 0; q < 16; ++q) { float s = 0.f;
#pragma unroll
                    for (int j = 0; j < 4; ++j) { const f32x4 w = *(const LAS f32x4*)(wg + q * 1024 + 4 * F.lane + 256 * j); s += (v[j][0] * w[0] + v[j][1] * w[1]) + (v[j][2] * w[2] + v[j][3] * w[3]); }
                    p[q] = s; if ((q & 3) == 3) { asm volatile("" ::: "memory"); __builtin_amdgcn_sched_barrier(0); } }
#pragma unroll
                for (int i = 0; i < 8; ++i) { const bool up = (F.lane & 32) != 0; const float send = up ? p[i] : p[i + 8], keep = up ? p[i + 8] : p[i]; p[i] = keep + __shfl_xor(send, 32); }
#pragma unroll
                for (int i = 0; i < 4; ++i) { const bool up = (F.lane & 16) != 0; const float send = up ? p[i] : p[i + 4], keep = up ? p[i + 4] : p[i]; p[i] = keep + __shfl_xor(send, 16); }
#pragma unroll
                for (int i = 0; i < 2; ++i) { const bool up = (F.lane & 8) != 0; const float send = up ? p[i] : p[i + 2], keep = up ? p[i + 2] : p[i]; p[i] = keep + __shfl_xor(send, 8); }
                { const bool up = (F.lane & 4) != 0; const float send = up ? p[0] : p[1], keep = up ? p[1] : p[0]; p[0] = keep + __shfl_xor(send, 4); }
                p[0] += __shfl_xor(p[0], 2); p[0] += __shfl_xor(p[0], 1);
                const int gi = ((F.lane >> 5) & 1) * 8 + ((F.lane >> 4) & 1) * 4 + ((F.lane >> 3) & 1) * 2 + ((F.lane >> 2) & 1);
                if ((F.lane & 3) == 0) ((float*)(F.ws + WS_GATES))[(size_t)row * 16 + gi] = p[0];
            }
        }
    }
}

DI void norm2_phase(Frame& F, const float* xin, const float* gA, const float* shA, const float* scA, int strideA, bf16* outA, const float* gB, const float* shB, const float* scB, int strideB, bf16* outB) {
    const int gw = F.bid * NWAVES + F.wave, NGW = F.G * NWAVES;
    for (int chunk = gw; chunk < T_TOK / 16; chunk += NGW) {
        const int row0 = chunk * 16, b = row0 >> 11;
        f32x4 A1[4], B1[4], A2[4], B2[4];
#pragma unroll
        for (int j = 0; j < 4; ++j) { const int c = 4 * F.lane + 256 * j;
            A1[j] = *(const f32x4*)(gA + c) * (*(const f32x4*)(scA + (size_t)b * strideA + c) + 1.0f); B1[j] = *(const f32x4*)(shA + (size_t)b * strideA + c);
            A2[j] = *(const f32x4*)(gB + c) * (*(const f32x4*)(scB + (size_t)b * strideB + c) + 1.0f); B2[j] = *(const f32x4*)(shB + (size_t)b * strideB + c); }
        for (int r = 0; r < 16; ++r) {
            const int row = row0 + r;
            const f32x4* xr = (const f32x4*)(xin + (size_t)row * DM) + F.lane;
            f32x4 v[4]; float ss = 0.f;
#pragma unroll
            for (int j = 0; j < 4; ++j) { v[j] = xr[64 * j]; ss += (v[j][0] * v[j][0] + v[j][1] * v[j][1]) + (v[j][2] * v[j][2] + v[j][3] * v[j][3]); }
            const float rstd = 1.0f / sqrtf(wave_sum(ss) * (1.0f / DM) + EPS);
            unsigned long long* oa = (unsigned long long*)(outA + (size_t)row * DM) + F.lane; unsigned long long* ob = (unsigned long long*)(outB + (size_t)row * DM) + F.lane;
#pragma unroll
            for (int j = 0; j < 4; ++j) { const f32x4 xn = v[j] * rstd; const f32x4 ya = xn * A1[j] + B1[j], yb = xn * A2[j] + B2[j];
                oa[64 * j] = (unsigned long long)cvtpk(ya[0], ya[1]) | ((unsigned long long)cvtpk(ya[2], ya[3]) << 32);
                ob[64 * j] = (unsigned long long)cvtpk(yb[0], yb[1]) | ((unsigned long long)cvtpk(yb[2], yb[3]) << 32); }
        }
    }
}

DI void mlstm_gates(Frame& F, size_t trow0, int h, float& ipre, float& bcum, float& blast) {
    const float* gates = (const float*)(F.ws + WS_GATES); const float* bif = F.in[8];
    const float iv = gates[(trow0 + F.lane) * 16 + h] + bif[h];
    const float fv = gates[(trow0 + F.lane) * 16 + 8 + h] + bif[8 + h];
    float b = -(fmaxf(-fv, 0.f) + log1pf(expf(-fabsf(fv))));
#pragma unroll
    for (int d = 1; d < 64; d <<= 1) { const float t = __shfl_up(b, d); if (F.lane >= d) b += t; }
    ipre = iv; bcum = b; blast = __shfl(b, 63);
}
template <int MODE> DI void stage_qk(LAS unsigned char* dst, const LAS float* e_s, const bf16* proj, const float* convw, int tseq0, size_t trow0, int col0, int lane) {
    const int g8 = lane >> 3, ch = lane & 7, col = col0 + 8 * ch;
    float cw[4][8];
#pragma unroll
    for (int tap = 0; tap < 4; ++tap) { const f32x4 a = *(const f32x4*)(convw + tap * 1024 + col), b = *(const f32x4*)(convw + tap * 1024 + col + 4);
        cw[tap][0] = a[0]; cw[tap][1] = a[1]; cw[tap][2] = a[2]; cw[tap][3] = a[3]; cw[tap][4] = b[0]; cw[tap][5] = b[1]; cw[tap][6] = b[2]; cw[tap][7] = b[3]; }
#pragma unroll 1
    for (int ph = 0; ph < 2; ++ph) {
        float x[7][8];
#pragma unroll
        for (int i = 0; i < 7; ++i) {
            const int rel = 8 * g8 + 4 * ph + i - 3; const bool valid = (tseq0 + rel) >= 0; const long rr = valid ? (long)rel : 0;
            u32x4 raw = *(const u32x4*)(proj + (size_t)((long)trow0 + rr) * 3072 + col);
            if (!valid) raw = (u32x4){0u, 0u, 0u, 0u};
            x[i][0] = bflo(raw.x); x[i][1] = bfhi(raw.x); x[i][2] = bflo(raw.y); x[i][3] = bfhi(raw.y); x[i][4] = bflo(raw.z); x[i][5] = bfhi(raw.z); x[i][6] = bflo(raw.w); x[i][7] = bfhi(raw.w);
        }
#pragma unroll
        for (int o = 0; o < 4; ++o) {
            const int tok = 8 * g8 + 4 * ph + o;
            float y[8];
#pragma unroll
            for (int e = 0; e < 8; ++e) { float a = cw[0][e] * x[o][e] + cw[1][e] * x[o + 1][e] + cw[2][e] * x[o + 2][e] + cw[3][e] * x[o + 3][e]; y[e] = a / (1.f + __expf(-a)); }
            float sc = 1.f; if (MODE == 0) sc = e_s[tok]; if (MODE == 1) sc = 0.125f;
            u32x4 w; w.x = cvtpk(y[0] * sc, y[1] * sc); w.y = cvtpk(y[2] * sc, y[3] * sc); w.z = cvtpk(y[4] * sc, y[5] * sc); w.w = cvtpk(y[6] * sc, y[7] * sc);
            const int off = (MODE == 0) ? tr_off(tok, ch) : ch * 1024 + tok * 16;
            *(LAS u32x4*)(dst + off) = w;
        }
    }
}
DI void stage_v_half(LAS unsigned char* dst, const bf16* proj, size_t trow0, int col0, int lane) {
    const int g8 = lane >> 3, ch = lane & 7;
#pragma unroll
    for (int o = 0; o < 8; ++o) { const int tok = 8 * g8 + o; const u32x4 raw = *(const u32x4*)(proj + (trow0 + tok) * 3072 + col0 + 8 * ch); *(LAS u32x4*)(dst + tr_off(tok, ch)) = raw; }
}
constexpr int MW_LDS = 17408;

DI void p3_mlstm_local(Frame& F) {
    LAS unsigned char* wl = F.lds + F.wave * MW_LDS;
    LAS unsigned char* kimg = wl; LAS unsigned char* vimg = wl + 8192; LAS float* e_s = (LAS float*)(wl + 16384);
    const bf16* proj = (const bf16*)(F.ws + WS_PROJ);
    bf16* cst = (bf16*)(F.ws + WS_CST);
    const int lane = F.lane, r32 = lane & 31, hi = lane >> 5;
    for (int bu = F.bid; bu < 512; bu += F.G) {
        int h = F.wave; asm volatile("" : "+s"(h));
        const int b = bu >> 5, c = bu & 31; const int unit = bu * 8 + h; const size_t trow0 = (size_t)b * SEQ + c * 64;
        float ipre, bcum, blast; mlstm_gates(F, trow0, h, ipre, bcum, blast);
        const float w = blast - bcum + ipre; const float mloc = wave_max(w); const float e = expf(w - mloc);
        e_s[lane] = e;
        if (lane == 0) { ((float*)(F.ws + WS_BLAST))[unit] = blast; ((float*)(F.ws + WS_MLOC))[unit] = mloc; }
        stage_qk<0>(kimg, e_s, proj, F.in[7], c * 64, trow0, 512 + h * 64, lane);
        bf16x8 kef[2][4];
#pragma unroll
        for (int kt = 0; kt < 2; ++kt)
#pragma unroll
            for (int ks = 0; ks < 4; ++ks) kef[kt][ks] = tr_frag(kimg, kt, ks, lane);
        const bf16x8 ones = {0x3F80, 0x3F80, 0x3F80, 0x3F80, 0x3F80, 0x3F80, 0x3F80, 0x3F80};
#pragma unroll
        for (int kt = 0; kt < 2; ++kt) { f32x16 an = {};
#pragma unroll
            for (int ks = 0; ks < 4; ++ks) an = MFMA32(kef[kt][ks], ones, an);
            if (r32 == 0) {
#pragma unroll
                for (int r = 0; r < 16; ++r) ((float*)(F.ws + WS_NLOC))[(size_t)unit * 64 + 32 * kt + crow(r, hi)] = an[r]; } }
#pragma unroll 1
        for (int vh = 0; vh < 2; ++vh) {
            stage_v_half(vimg, proj, trow0, 1024 + h * 128 + 64 * vh, lane);
#pragma unroll
            for (int vt = 0; vt < 2; ++vt) {
                bf16x8 vf[4];
#pragma unroll
                for (int ks = 0; ks < 4; ++ks) vf[ks] = tr_frag(vimg, vt, ks, lane);
#pragma unroll
                for (int kt = 0; kt < 2; ++kt) { f32x16 acc = {};
#pragma unroll
                    for (int ks = 0; ks < 4; ++ks) acc = MFMA32(kef[kt][ks], vf[ks], acc);
                    bf16* dstp = cst + ((size_t)unit * 128 + 64 * vh + 32 * vt + r32) * 64 + 32 * kt + 4 * hi;
#pragma unroll
                    for (int rg = 0; rg < 4; ++rg) { u32x2 pk; pk.x = cvtpk(acc[4 * rg], acc[4 * rg + 1]); pk.y = cvtpk(acc[4 * rg + 2], acc[4 * rg + 3]); *(u32x2*)(dstp + 8 * rg) = pk; }
                }
            }
        }
    }
}
DI void p4_scan(Frame& F) {
    const int gt = F.bid * NT + F.tid, NGT = F.G * NT;
    const float* mlocp = (const float*)(F.ws + WS_MLOC); const float* blastp = (const float*)(F.ws + WS_BLAST);
    for (int item = gt; item < 128 * 1024; item += NGT) {
        const int bh = item >> 10, e8 = item & 1023, b = bh >> 3, h = bh & 7;
        float st[8]; float m = 0.f;
#pragma unroll
        for (int i = 0; i < 8; ++i) st[i] = 0.f;
        u32x4* p0 = (u32x4*)((bf16*)(F.ws + WS_CST) + (size_t)((b * 32) * 8 + h) * 8192) + e8;
        const int u0 = (b * 32) * 8 + h;
#pragma unroll 1
        for (int c0 = 0; c0 < 32; c0 += 8) {
            u32x4 raw[8]; float ml[8], bl[8];
#pragma unroll
            for (int j = 0; j < 8; ++j) { raw[j] = p0[(size_t)(c0 + j) * 8192]; ml[j] = mlocp[u0 + (c0 + j) * 8]; bl[j] = blastp[u0 + (c0 + j) * 8]; }
#pragma unroll
            for (int j = 0; j < 8; ++j) {
                u32x4 o; o.x = cvtpk(st[0], st[1]); o.y = cvtpk(st[2], st[3]); o.z = cvtpk(st[4], st[5]); o.w = cvtpk(st[6], st[7]); p0[(size_t)(c0 + j) * 8192] = o;
                const float mn = fmaxf(bl[j] + m, ml[j]), a = __expf(bl[j] + m - mn), r = __expf(ml[j] - mn);
                st[0] = a * st[0] + r * bflo(raw[j].x); st[1] = a * st[1] + r * bfhi(raw[j].x); st[2] = a * st[2] + r * bflo(raw[j].y); st[3] = a * st[3] + r * bfhi(raw[j].y);
                st[4] = a * st[4] + r * bflo(raw[j].z); st[5] = a * st[5] + r * bfhi(raw[j].z); st[6] = a * st[6] + r * bflo(raw[j].w); st[7] = a * st[7] + r * bfhi(raw[j].w);
                m = mn;
            }
        }
    }
    for (int item = gt; item < 128 * 64; item += NGT) {
        const int bh = item >> 6, k = item & 63, b = bh >> 3, h = bh & 7;
        float ns = 0.f, m = 0.f;
        const int u0 = (b * 32) * 8 + h;
#pragma unroll 1
        for (int c0 = 0; c0 < 32; c0 += 8) {
            float nl[8], ml[8], bl[8];
#pragma unroll
            for (int j = 0; j < 8; ++j) { const int unit = u0 + (c0 + j) * 8; nl[j] = ((const float*)(F.ws + WS_NLOC))[(size_t)unit * 64 + k]; ml[j] = mlocp[unit]; bl[j] = blastp[unit]; }
#pragma unroll
            for (int j = 0; j < 8; ++j) { const int unit = u0 + (c0 + j) * 8;
                ((float*)(F.ws + WS_NLOC))[(size_t)unit * 64 + k] = ns; if (k == 0) ((float*)(F.ws + WS_MPREV))[unit] = m;
                const float mn = fmaxf(bl[j] + m, ml[j]), a = __expf(bl[j] + m - mn), r = __expf(ml[j] - mn);
                ns = a * ns + r * nl[j]; m = mn; }
        }
    }
}
DI void p5_mlstm_out(Frame& F) {
    LAS unsigned char* wl = F.lds + F.wave * MW_LDS;
    LAS unsigned char* qimg = wl; LAS unsigned char* kimg = wl + 8192; LAS float* sc = (LAS float*)(wl + 16384);
    const bf16* proj = (const bf16*)(F.ws + WS_PROJ);
    const bf16* cst = (const bf16*)(F.ws + WS_CST);
    bf16* hh = (bf16*)(F.ws + WS_H);
    for (int bu = F.bid; bu < 512; bu += F.G) {
        int lane = F.lane; asm volatile("" : "+v"(lane)); const int r32 = lane & 31, hi = lane >> 5;
        int h = F.wave; asm volatile("" : "+s"(h));
        const int b = bu >> 5, c = bu & 31; const int unit = bu * 8 + h; const size_t trow0 = (size_t)b * SEQ + c * 64;
        {
            float ipre, bcum, blast; mlstm_gates(F, trow0, h, ipre, bcum, blast);
            const float mprev = ((const float*)(F.ws + WS_MPREV))[unit];
            const float gg = ipre - bcum; float pm = gg;
#pragma unroll
            for (int d = 1; d < 64; d <<= 1) { const float t = __shfl_up(pm, d); if (lane >= d) pm = fmaxf(pm, t); }
            const float Mx = fmaxf(mprev, pm), mt = bcum + Mx;
            sc[lane] = gg; sc[64 + lane] = Mx; sc[128 + lane] = expf(mprev - Mx); sc[192 + lane] = expf(-mt);
        }
#pragma unroll 1
        for (int lt = 0; lt < 2; ++lt) {
            const int l = 32 * lt + r32;
            const size_t t = trow0 + l;
            stage_qk<1>(qimg, nullptr, proj, F.in[7], c * 64, trow0, h * 64, lane);
            stage_qk<2>(kimg, nullptr, proj, F.in[7], c * 64, trow0, 512 + h * 64, lane);
            asm volatile("" ::: "memory"); __builtin_amdgcn_sched_barrier(0);
            bf16x8 cf[4][4];
#pragma unroll
            for (int vt = 0; vt < 4; ++vt)
#pragma unroll
                for (int ks = 0; ks < 4; ++ks) cf[vt][ks] = *(const bf16x8*)(cst + ((size_t)unit * 128 + 32 * vt + r32) * 64 + 16 * ks + 8 * hi);
            bf16x8 qf[4];
#pragma unroll
            for (int ks = 0; ks < 4; ++ks) qf[ks] = row_frag<64>(qimg, lt, ks, lane);
            const float Mxl = sc[64 + l];
            bf16x8 P[2][2]; float dsum = 0.f;
#pragma unroll
            for (int st = 0; st < 2; ++st) {
                P[st][0] = (bf16x8){0, 0, 0, 0, 0, 0, 0, 0}; P[st][1] = P[st][0];
                if (st <= lt) {
                    f32x16 acc = {};
#pragma unroll
                    for (int ks = 0; ks < 4; ++ks) acc = MFMA32(row_frag<64>(kimg, st, ks, lane), qf[ks], acc);
#pragma unroll
                    for (int r = 0; r < 16; ++r) { const int srow = crow(r, hi); float val = acc[r] * __expf(sc[32 * st + srow] - Mxl); if (st == lt && srow > r32) val = 0.f; acc[r] = val; dsum += val; }
                    P[st][0] = pack8(acc, 0); P[st][1] = pack8(acc, 1);
                }
            }
            float nq;
            { const float* np = (const float*)(F.ws + WS_NLOC) + (size_t)unit * 64; float s = 0.f;
#pragma unroll
              for (int ks = 0; ks < 4; ++ks) { const f32x4 n0 = *(const f32x4*)(np + 16 * ks + 8 * hi), n1 = *(const f32x4*)(np + 16 * ks + 8 * hi + 4); const u32x4 q = __builtin_bit_cast(u32x4, qf[ks]);
                  s += bflo(q.x) * n0[0] + bfhi(q.x) * n0[1] + bflo(q.y) * n0[2] + bfhi(q.y) * n0[3] + bflo(q.z) * n1[0] + bfhi(q.z) * n1[1] + bflo(q.w) * n1[2] + bfhi(q.w) * n1[3]; }
              nq = s + __shfl_xor(s, 32); }
            asm volatile("s_waitcnt lgkmcnt(0)" ::: "memory");
            stage_v_half(wl, proj, trow0, 1024 + h * 128, lane); stage_v_half(wl + 8192, proj, trow0, 1024 + h * 128 + 64, lane);
            f32x16 acc[4];
#pragma unroll
            for (int vt = 0; vt < 4; ++vt) { acc[vt] = (f32x16){};
#pragma unroll
                for (int ks = 0; ks < 4; ++ks) acc[vt] = MFMA32(cf[vt][ks], qf[ks], acc[vt]); }
            const float iwl = sc[128 + l];
#pragma unroll
            for (int vt = 0; vt < 4; ++vt) acc[vt] = acc[vt] * iwl;
#pragma unroll
            for (int st = 0; st < 2; ++st) if (st <= lt) {
#pragma unroll
                for (int k2 = 0; k2 < 2; ++k2) {
#pragma unroll
                    for (int vt = 0; vt < 4; ++vt) acc[vt] = MFMA32(tr_frag(wl + (vt >> 1) * 8192, vt & 1, 2 * st + k2, lane), P[st][k2], acc[vt]); } }
            u32x2 o4[4][4];
#pragma unroll
            for (int vt = 0; vt < 4; ++vt)
#pragma unroll
                for (int rg = 0; rg < 4; ++rg) o4[vt][rg] = *(const u32x2*)(proj + t * 3072 + 2048 + h * 128 + 32 * vt + 8 * rg + 4 * hi);
            const float den = dsum + __shfl_xor(dsum, 32) + iwl * nq;
            const float inv = 1.0f / fmaxf(fabsf(den), sc[192 + l]);
            float ss = 0.f;
#pragma unroll
            for (int vt = 0; vt < 4; ++vt)
#pragma unroll
                for (int r = 0; r < 16; ++r) { const float v = acc[vt][r] * inv; acc[vt][r] = v; ss += v * v; }
            ss += __shfl_xor(ss, 32);
            const float rstd = 1.0f / sqrtf(ss * (1.0f / 128.0f) + EPS);
#pragma unroll
            for (int vt = 0; vt < 4; ++vt)
#pragma unroll
                for (int rg = 0; rg < 4; ++rg) { const int v = 32 * vt + 8 * rg + 4 * hi;
                    const f32x4 g4 = *(const f32x4*)(F.in[9] + h * 128 + v);
                    const float o0 = bflo(o4[vt][rg].x), o1 = bfhi(o4[vt][rg].x), o2 = bflo(o4[vt][rg].y), o3 = bfhi(o4[vt][rg].y);
                    const float y0 = acc[vt][4 * rg] * rstd * g4[0] / (1.f + __expf(-o0)), y1 = acc[vt][4 * rg + 1] * rstd * g4[1] / (1.f + __expf(-o1));
                    const float y2 = acc[vt][4 * rg + 2] * rstd * g4[2] / (1.f + __expf(-o2)), y3 = acc[vt][4 * rg + 3] * rstd * g4[3] / (1.f + __expf(-o3));
                    u32x2 pk; pk.x = cvtpk(y0, y1); pk.y = cvtpk(y2, y3); *(u32x2*)(hh + t * 1024 + h * 128 + v) = pk; }
            asm volatile("s_waitcnt lgkmcnt(0)" ::: "memory");
        }
    }
}

DI float softplus_f(float z) { return fmaxf(z, 0.f) + __logf(1.f + __expf(-fabsf(z))); }
DI void p12_attn(Frame& F) {
    LAS unsigned char* kimg = F.lds; LAS unsigned char* vimg = F.lds + 8192;
    const bf16* Q = (const bf16*)(F.ws + WS_Q); const bf16* K = (const bf16*)(F.ws + WS_K); const bf16* V = (const bf16*)(F.ws + WS_VV);
    bf16* O = (bf16*)(F.ws + WS_H);
    const int lane = F.lane, r32 = lane & 31, hi = lane >> 5, wave = F.wave;
    const int skey = F.tid >> 3, schk = F.tid & 7;
    for (int bh = F.bid; bh < 256; bh += F.G) {
        const int b = bh >> 4, h = bh & 15;
        for (int qb = 7; qb >= 0; --qb) {
            const int qlo = qb * 256 + 32 * wave;
            const size_t tq0 = (size_t)b * SEQ + qlo;
            bf16x8 qr[4];
#pragma unroll
            for (int ks = 0; ks < 4; ++ks) qr[ks] = *(const bf16x8*)(Q + (tq0 + r32) * 1024 + h * 64 + 16 * ks + 8 * hi);
            f32x16 o0 = {}, o1 = {}; float R = 0.f; bool wdone = false;
            const int ntile = 4 * qb + 4;
            u32x4 kraw, vraw;
            { const size_t src = ((size_t)b * SEQ + 64 * (ntile - 1) + skey) * 1024 + h * 64 + 8 * schk; kraw = *(const u32x4*)(K + src); vraw = *(const u32x4*)(V + src); }
            for (int kt = ntile - 1; kt >= 0; --kt) {
                __syncthreads();
                *(LAS u32x4*)(kimg + schk * 1024 + skey * 16) = kraw;
                *(LAS u32x4*)(vimg + tr_off(skey, schk)) = vraw;
                if (kt > 0) { const size_t src = ((size_t)b * SEQ + 64 * (kt - 1) + skey) * 1024 + h * 64 + 8 * schk; kraw = *(const u32x4*)(K + src); vraw = *(const u32x4*)(V + src); }
                if (__syncthreads_and(wdone ? 1 : 0)) break;
                if (!wdone && 64 * kt <= qlo + 30) {
                    f32x16 p0 = {}, p1 = {};
#pragma unroll
                    for (int ks = 0; ks < 4; ++ks) { p0 = MFMA32(row_frag<64>(kimg, 0, ks, lane), qr[ks], p0); p1 = MFMA32(row_frag<64>(kimg, 1, ks, lane), qr[ks], p1); }
                    const bool diag = (64 * kt + 63 >= qlo);
                    const int qrel = qlo + r32 - 64 * kt;
                    float s0[16], s1[16];
#pragma unroll
                    for (int r = 0; r < 16; ++r) { const int kr = crow(r, hi);
                        const bool v0 = !diag || kr < qrel, v1 = !diag || (kr + 32) < qrel;
                        s0[r] = v0 ? softplus_f(p0[r]) : 0.f; s1[r] = v1 ? softplus_f(p1[r]) : 0.f; }
#pragma unroll
                    for (int g = 0; g < 4; ++g) { s0[4 * g + 2] += s0[4 * g + 3]; s0[4 * g + 1] += s0[4 * g + 2]; s0[4 * g] += s0[4 * g + 1];
                                                  s1[4 * g + 2] += s1[4 * g + 3]; s1[4 * g + 1] += s1[4 * g + 2]; s1[4 * g] += s1[4 * g + 1]; }
                    float off0[4], off1[4]; float tot0, tot1;
                    { float og[4], T[4];
#pragma unroll
                      for (int g = 0; g < 4; ++g) og[g] = __shfl_xor(s1[4 * g], 32);
                      T[3] = 0.f; T[2] = s1[12] + og[3]; T[1] = T[2] + s1[8] + og[2]; T[0] = T[1] + s1[4] + og[1]; tot1 = T[0] + s1[0] + og[0];
#pragma unroll
                      for (int g = 0; g < 4; ++g) off1[g] = T[g] + (hi == 0 ? og[g] : 0.f) + R; }
                    { float og[4], T[4];
#pragma unroll
                      for (int g = 0; g < 4; ++g) og[g] = __shfl_xor(s0[4 * g], 32);
                      T[3] = 0.f; T[2] = s0[12] + og[3]; T[1] = T[2] + s0[8] + og[2]; T[0] = T[1] + s0[4] + og[1]; tot0 = T[0] + s0[0] + og[0];
#pragma unroll
                      for (int g = 0; g < 4; ++g) off0[g] = T[g] + (hi == 0 ? og[g] : 0.f) + R + tot1; }
#pragma unroll
                    for (int r = 0; r < 16; ++r) { const int kr = crow(r, hi);
                        const bool v0 = !diag || kr < qrel, v1 = !diag || (kr + 32) < qrel;
                        const float a0 = __expf(p0[r] - s0[r] - off0[r >> 2]), a1 = __expf(p1[r] - s1[r] - off1[r >> 2]);
                        p0[r] = v0 ? a0 : 0.f; p1[r] = v1 ? a1 : 0.f; }
                    R += tot0 + tot1;
                    wdone = __all(R >= 104.0f);
                    const bf16x8 pa0 = pack8(p0, 0), pa1 = pack8(p0, 1), pa2 = pack8(p1, 0), pa3 = pack8(p1, 1);
                    o0 = MFMA32(pa0, tr_frag(vimg, 0, 0, lane), o0); o1 = MFMA32(pa0, tr_frag(vimg, 1, 0, lane), o1);
                    o0 = MFMA32(pa1, tr_frag(vimg, 0, 1, lane), o0); o1 = MFMA32(pa1, tr_frag(vimg, 1, 1, lane), o1);
                    o0 = MFMA32(pa2, tr_frag(vimg, 0, 2, lane), o0); o1 = MFMA32(pa2, tr_frag(vimg, 1, 2, lane), o1);
                    o0 = MFMA32(pa3, tr_frag(vimg, 0, 3, lane), o0); o1 = MFMA32(pa3, tr_frag(vimg, 1, 3, lane), o1);
                }
            }
#pragma unroll
            for (int r = 0; r < 16; ++r) { bf16* op = O + (tq0 + crow(r, hi)) * 1024 + h * 64 + r32;
                op[0] = (bf16)(cvtpk(o0[r], 0.f) & 0xffffu); op[32] = (bf16)(cvtpk(o1[r], 0.f) & 0xffffu); }
        }
    }
}

__device__ constexpr int NET16_A[63] = {0,2,0,1,1,4,6,4,5,5,0,2,2,1,3,3,1,3,5,8,10,8,9,9,12,14,12,13,13,8,10,10,9,11,11,9,11,13,0,4,4,2,6,6,2,6,10,1,5,5,3,7,7,3,7,11,1,3,5,7,9,11,13};
__device__ constexpr int NET16_B[63] = {1,3,2,3,2,5,7,6,7,6,4,6,4,5,7,5,2,4,6,9,11,10,11,10,13,15,14,15,14,12,14,12,13,15,13,10,12,14,8,12,8,10,14,10,4,8,12,9,13,9,11,15,11,5,9,13,2,4,6,8,10,12,14};
__device__ constexpr int BIT16_A[32] = {0,1,2,3,4,5,6,7,0,1,2,3,8,9,10,11,0,1,4,5,8,9,12,13,0,2,4,6,8,10,12,14};
__device__ constexpr int BIT16_B[32] = {8,9,10,11,12,13,14,15,4,5,6,7,12,13,14,15,2,3,6,7,10,11,14,15,1,3,5,7,9,11,13,15};
DI unsigned umax_(unsigned a, unsigned b) { return a > b ? a : b; }
DI unsigned umin_(unsigned a, unsigned b) { return a < b ? a : b; }
DI void sort16(unsigned (&k)[16]) {
#pragma unroll
    for (int c = 0; c < 63; ++c) { const unsigned a = k[NET16_A[c]], b = k[NET16_B[c]]; k[NET16_A[c]] = umax_(a, b); k[NET16_B[c]] = umin_(a, b); }
}
DI void bitonic16(unsigned (&k)[16]) {
#pragma unroll
    for (int c = 0; c < 32; ++c) { const unsigned a = k[BIT16_A[c]], b = k[BIT16_B[c]]; k[BIT16_A[c]] = umax_(a, b); k[BIT16_B[c]] = umin_(a, b); }
}
DI void merge16(unsigned (&x)[16], const unsigned (&y)[16]) {
#pragma unroll
    for (int i = 0; i < 16; ++i) x[i] = umax_(x[i], y[15 - i]);
    bitonic16(x);
}
DI unsigned f2key(float x) { const unsigned b = __float_as_uint(x); return b ^ ((unsigned)((int)b >> 31) | 0x80000000u); }
DI float key2f(unsigned k) { return __uint_as_float(k ^ (~(unsigned)((int)k >> 31) | 0x80000000u)); }

DI void p_route(Frame& F, int layer) {
    LAS unsigned char* simg = F.lds;
    LAS unsigned char* dec = F.lds + 65536 + F.wave * 1024;
    { const u32x4* src = (const u32x4*)((const bf16*)(F.ws + WS_SUBK) + (size_t)layer * 2 * 128 * 128);
      for (int i = F.tid; i < 2 * 128 * 16; i += NT) { const int p = i >> 11, n = (i >> 4) & 127, ch = i & 15; *(LAS u32x4*)(simg + p * 32768 + ch * 2048 + n * 16) = src[i]; } }
    __syncthreads();
    const bf16* PQ = (const bf16*)(F.ws + WS_PQ);
    const int lane = F.lane, r32 = lane & 31, hi = lane >> 5;
    const int gw = F.bid * NWAVES + F.wave, NGW = F.G * NWAVES;
    for (int wu = gw; wu < T_TOK * 8 / 32; wu += NGW) {
        const int row = wu * 32 + r32, t = row >> 3, hd = row & 7;
        unsigned top[2][16];
#pragma unroll
        for (int p = 0; p < 2; ++p) {
            bf16x8 qf[8];
#pragma unroll
            for (int ks = 0; ks < 8; ++ks) qf[ks] = *(const bf16x8*)(PQ + (size_t)t * 2048 + hd * 256 + p * 128 + 16 * ks + 8 * hi);
            unsigned keys[4][16];
#pragma unroll
            for (int nt = 0; nt < 4; ++nt) {
                f32x16 acc = {};
#pragma unroll
                for (int ks = 0; ks < 8; ++ks) acc = MFMA32(*(const LAS bf16x8*)(simg + p * 32768 + (2 * ks + hi) * 2048 + (32 * nt + r32) * 16), qf[ks], acc);
#pragma unroll
                for (int r = 0; r < 16; ++r) keys[nt][r] = (f2key(acc[r]) & 0xFFFFFF80u) | (unsigned)(32 * nt + crow(r, 0)) | (unsigned)(4 * hi);
                sort16(keys[nt]);
            }
            merge16(keys[0], keys[1]); merge16(keys[2], keys[3]); merge16(keys[0], keys[2]);
            unsigned lo[16], up[16];
#pragma unroll
            for (int i = 0; i < 16; ++i) { auto rr = __builtin_amdgcn_permlane32_swap(keys[0][i], keys[0][i], false, false); lo[i] = rr[0]; up[i] = rr[1]; }
#pragma unroll
            for (int i = 0; i < 16; ++i) top[p][i] = umax_(lo[i], up[15 - i]);
            bitonic16(top[p]);
        }
        if (hi == 0) {
            u32x4 w0, w1, w2, w3;
            w0.x = (top[0][0] & 127u) | ((top[0][1] & 127u) << 8) | ((top[0][2] & 127u) << 16) | ((top[0][3] & 127u) << 24);
            w0.y = (top[0][4] & 127u) | ((top[0][5] & 127u) << 8) | ((top[0][6] & 127u) << 16) | ((top[0][7] & 127u) << 24);
            w0.z = (top[0][8] & 127u) | ((top[0][9] & 127u) << 8) | ((top[0][10] & 127u) << 16) | ((top[0][11] & 127u) << 24);
            w0.w = (top[0][12] & 127u) | ((top[0][13] & 127u) << 8) | ((top[0][14] & 127u) << 16) | ((top[0][15] & 127u) << 24);
            w1.x = (top[1][0] & 127u) | ((top[1][1] & 127u) << 8) | ((top[1][2] & 127u) << 16) | ((top[1][3] & 127u) << 24);
            w1.y = (top[1][4] & 127u) | ((top[1][5] & 127u) << 8) | ((top[1][6] & 127u) << 16) | ((top[1][7] & 127u) << 24);
            w1.z = (top[1][8] & 127u) | ((top[1][9] & 127u) << 8) | ((top[1][10] & 127u) << 16) | ((top[1][11] & 127u) << 24);
            w1.w = (top[1][12] & 127u) | ((top[1][13] & 127u) << 8) | ((top[1][14] & 127u) << 16) | ((top[1][15] & 127u) << 24);
            *(LAS u32x4*)(dec + r32 * 32) = w0; *(LAS u32x4*)(dec + r32 * 32 + 16) = w1;
        }
        float av[16], bv[16];
#pragma unroll
        for (int i = 0; i < 16; ++i) { av[i] = key2f(top[0][i] & 0xFFFFFF80u); bv[i] = key2f(top[1][i] & 0xFFFFFF80u); }
        unsigned c0[16], c1[16], c2[16], c3[16];
#pragma unroll
        for (int j = 0; j < 16; ++j) c0[j] = (f2key(av[0] + bv[j]) & 0xFFFFFF00u) | (unsigned)j;
        {
            int n = 0;
#pragma unroll
            for (int i = 1; i < 16; ++i)
#pragma unroll
                for (int j = 0; j < 16; ++j) if ((i + 1) * (j + 1) <= 16) {
                    const unsigned k = (f2key(av[i] + bv[j]) & 0xFFFFFF00u) | (unsigned)(i * 16 + j);
                    if (n < 16) c1[n] = k; else if (n < 32) c2[n - 16] = k; else c3[n - 32] = k;
                    ++n; }
#pragma unroll
            for (int q = 2; q < 16; ++q) c3[q] = 0u;
        }
        sort16(c1); sort16(c2); { const unsigned a = c3[0], b = c3[1]; c3[0] = umax_(a, b); c3[1] = umin_(a, b); }
        merge16(c0, c1); merge16(c2, c3); merge16(c0, c2);
        asm volatile("s_waitcnt lgkmcnt(0)" ::: "memory");
        float gv[16]; unsigned ex[16]; float gs = 0.f;
        const float vmax = key2f(c0[0] & 0xFFFFFF00u);
#pragma unroll
        for (int k = 0; k < 16; ++k) {
            const unsigned code = c0[k] & 255u; const unsigned i = code >> 4, j = code & 15u;
            const unsigned ia = *(const LAS unsigned char*)(dec + r32 * 32 + i), ib = *(const LAS unsigned char*)(dec + r32 * 32 + 16 + j);
            ex[k] = ia * 128u + ib;
            gv[k] = __expf(key2f(c0[k] & 0xFFFFFF00u) - vmax); gs += gv[k];
        }
        const float ginv = 1.0f / gs;
        if (hi == 0) {
            u32x4 e0, e1;
            e0.x = ex[0] | (ex[1] << 16); e0.y = ex[2] | (ex[3] << 16); e0.z = ex[4] | (ex[5] << 16); e0.w = ex[6] | (ex[7] << 16);
            e1.x = ex[8] | (ex[9] << 16); e1.y = ex[10] | (ex[11] << 16); e1.z = ex[12] | (ex[13] << 16); e1.w = ex[14] | (ex[15] << 16);
            u32x4* ip = (u32x4*)((unsigned short*)(F.ws + WS_IDX) + (size_t)row * 16); ip[0] = e0; ip[1] = e1;
        } else {
            f32x4* gp = (f32x4*)((float*)(F.ws + WS_GATE) + (size_t)row * 16);
            gp[0] = (f32x4){gv[0] * ginv, gv[1] * ginv, gv[2] * ginv, gv[3] * ginv}; gp[1] = (f32x4){gv[4] * ginv, gv[5] * ginv, gv[6] * ginv, gv[7] * ginv};
            gp[2] = (f32x4){gv[8] * ginv, gv[9] * ginv, gv[10] * ginv, gv[11] * ginv}; gp[3] = (f32x4){gv[12] * ginv, gv[13] * ginv, gv[14] * ginv, gv[15] * ginv};
        }
    }
}

constexpr float U_SCALE = 32.f, V_SCALE = 4.f;
struct RowBuf { u32x4 r[16]; };
DI void load_rows(RowBuf& rb, const unsigned char* tbl, int idxs, int k0, int lane) {
#pragma unroll
    for (int j = 0; j < 16; ++j) { const int e = __builtin_amdgcn_readlane(idxs, k0 + j); rb.r[j] = *((const u32x4*)(tbl + (size_t)e * 1024) + lane); }
}
DI float udots(const RowBuf& rb, const f32x2_t (&hq)[8], int lane) {
    float p[16];
#pragma unroll
    for (int j = 0; j < 16; ++j) { f32x2_t a = {0.f, 0.f};
        a = __builtin_amdgcn_cvt_pk_f32_fp8((int)rb.r[j].x, false) * hq[0] + a; a = __builtin_amdgcn_cvt_pk_f32_fp8((int)rb.r[j].x, true) * hq[1] + a;
        a = __builtin_amdgcn_cvt_pk_f32_fp8((int)rb.r[j].y, false) * hq[2] + a; a = __builtin_amdgcn_cvt_pk_f32_fp8((int)rb.r[j].y, true) * hq[3] + a;
        a = __builtin_amdgcn_cvt_pk_f32_fp8((int)rb.r[j].z, false) * hq[4] + a; a = __builtin_amdgcn_cvt_pk_f32_fp8((int)rb.r[j].z, true) * hq[5] + a;
        a = __builtin_amdgcn_cvt_pk_f32_fp8((int)rb.r[j].w, false) * hq[6] + a; a = __builtin_amdgcn_cvt_pk_f32_fp8((int)rb.r[j].w, true) * hq[7] + a;
        p[j] = a.x + a.y; }
#pragma unroll
    for (int i = 0; i < 8; ++i) { const bool up = (lane & 8) != 0; const float send = up ? p[i] : p[i + 8], keep = up ? p[i + 8] : p[i]; p[i] = keep + __shfl_xor(send, 8); }
#pragma unroll
    for (int i = 0; i < 4; ++i) { const bool up = (lane & 4) != 0; const float send = up ? p[i] : p[i + 4], keep = up ? p[i + 4] : p[i]; p[i] = keep + __shfl_xor(send, 4); }
#pragma unroll
    for (int i = 0; i < 2; ++i) { const bool up = (lane & 2) != 0; const float send = up ? p[i] : p[i + 2], keep = up ? p[i + 2] : p[i]; p[i] = keep + __shfl_xor(send, 2); }
    { const bool up = (lane & 1) != 0; const float send = up ? p[0] : p[1], keep = up ? p[1] : p[0]; p[0] = keep + __shfl_xor(send, 1); }
    float s = p[0]; s += __shfl_xor(s, 16); s += __shfl_xor(s, 32);
    return s;
}
DI void vaccum(const RowBuf& rb, f32x2_t (&out)[8], float wv, int k0) {
#pragma unroll
    for (int j = 0; j < 16; ++j) { const float wk = __builtin_bit_cast(float, __builtin_amdgcn_readlane(__builtin_bit_cast(int, wv), k0 + j));
        out[0] = __builtin_amdgcn_cvt_pk_f32_fp8((int)rb.r[j].x, false) * wk + out[0]; out[1] = __builtin_amdgcn_cvt_pk_f32_fp8((int)rb.r[j].x, true) * wk + out[1];
        out[2] = __builtin_amdgcn_cvt_pk_f32_fp8((int)rb.r[j].y, false) * wk + out[2]; out[3] = __builtin_amdgcn_cvt_pk_f32_fp8((int)rb.r[j].y, true) * wk + out[3];
        out[4] = __builtin_amdgcn_cvt_pk_f32_fp8((int)rb.r[j].z, false) * wk + out[4]; out[5] = __builtin_amdgcn_cvt_pk_f32_fp8((int)rb.r[j].z, true) * wk + out[5];
        out[6] = __builtin_amdgcn_cvt_pk_f32_fp8((int)rb.r[j].w, false) * wk + out[6]; out[7] = __builtin_amdgcn_cvt_pk_f32_fp8((int)rb.r[j].w, true) * wk + out[7]; }
}
constexpr size_t WS_W = WS_PROJ;
constexpr int UP_LDS = 16384;
DI void up_load_h2(f32x2_t (&hq)[8], const bf16* H2, size_t t, int lane) {
    const u32x4* hp = (const u32x4*)(H2 + t * 1024) + 2 * lane; const u32x4 a = hp[0], c = hp[1];
    hq[0] = (f32x2_t){bflo(a.x), bfhi(a.x)}; hq[1] = (f32x2_t){bflo(a.y), bfhi(a.y)}; hq[2] = (f32x2_t){bflo(a.z), bfhi(a.z)}; hq[3] = (f32x2_t){bflo(a.w), bfhi(a.w)};
    hq[4] = (f32x2_t){bflo(c.x), bfhi(c.x)}; hq[5] = (f32x2_t){bflo(c.y), bfhi(c.y)}; hq[6] = (f32x2_t){bflo(c.z), bfhi(c.z)}; hq[7] = (f32x2_t){bflo(c.w), bfhi(c.w)};
}
DI int up_prepare(LAS unsigned* cmp, const LAS unsigned short* lidx, const LAS float* lgate, int tt, int x, int lane) {
    LAS unsigned* c = cmp + (tt & 1) * 384;
    const int i0 = lidx[tt * 128 + lane], i1 = lidx[tt * 128 + 64 + lane];
    const float g0 = lgate[tt * 128 + lane], g1 = lgate[tt * 128 + 64 + lane];
    const bool in0 = (i0 >> 11) == x, in1 = (i1 >> 11) == x;
    const unsigned long long m0 = __ballot(in0), m1 = __ballot(in1);
    const int n0 = __popcll(m0), n = n0 + __popcll(m1);
    const int below0 = __builtin_amdgcn_mbcnt_hi((unsigned)(m0 >> 32), __builtin_amdgcn_mbcnt_lo((unsigned)m0, 0));
    const int below1 = __builtin_amdgcn_mbcnt_hi((unsigned)(m1 >> 32), __builtin_amdgcn_mbcnt_lo((unsigned)m1, 0));
    if (in0) { c[below0] = (unsigned)i0; c[128 + below0] = (unsigned)lane; c[256 + below0] = __float_as_uint(g0); }
    if (in1) { c[n0 + below1] = (unsigned)i1; c[128 + n0 + below1] = (unsigned)(64 + lane); c[256 + n0 + below1] = __float_as_uint(g1); }
    return n;
}
DI void up_issue(RowBuf& R, const unsigned char* U, const LAS unsigned* cmp, int tt, int bb, int nn, int x, int lane) {
    const LAS unsigned* c = cmp + (tt & 1) * 384;
    const int pos = 16 * bb + (lane & 15);
    const int first = nn > 0 ? (int)c[0] : (x << 11);
    const int ia = pos < nn ? (int)c[pos & 127] : first;
    load_rows(R, U, ia, 0, lane);
}
DI void up_finish(const RowBuf& R, const f32x2_t (&hq)[8], const LAS unsigned* cmp, float* W, size_t t, int tt, int b, int n, int lane) {
    const float d = udots(R, hq, lane) * (1.0f / U_SCALE);
    const LAS unsigned* c = cmp + (tt & 1) * 384;
    const int pos = 16 * b + lane;
    if (lane < 16 && pos < n) { const float g = __uint_as_float(c[256 + pos]); W[t * 128 + c[128 + pos]] = g * 0.5f * d * (1.0f + erff(d * 0.70710678118654752f)) * (1.0f / V_SCALE); }
}
constexpr size_t WS_CLAIM = 4096;
DI unsigned xcc_id() { return (unsigned)__builtin_amdgcn_s_getreg((3 << 11) | 20) & 7u; }
DI int claim_unit(Frame& F, int set) {
    LAS int* bc = (LAS int*)(F.lds + LDS_BYTES - 64);
    __syncthreads();
    if (F.tid == 0) {
        unsigned* cnt = (unsigned*)(F.ws + WS_CLAIM) + set * 256;
        const unsigned x0 = xcc_id(); int unit = -1;
        for (unsigned a = 0; a < 8; ++a) { const unsigned sl = (x0 + a) & 7u; const unsigned tk = __hip_atomic_fetch_add(cnt + sl * 32, 1u, __ATOMIC_RELAXED, __HIP_MEMORY_SCOPE_AGENT); if (tk < 32u) { unit = (int)(sl * 32 + tk); break; } }
        bc[0] = unit;
    }
    __syncthreads();
    return bc[0];
}
DI void p_upass(Frame& F, int layer) {
    const unsigned char* U = F.ws + WS_U + (size_t)layer * 16384 * 1024;
    const bf16* H2 = (const bf16*)(F.ws + WS_H);
    const unsigned short* IDX = (const unsigned short*)(F.ws + WS_IDX); const float* GATE = (const float*)(F.ws + WS_GATE);
    float* W = (float*)(F.ws + WS_W);
    LAS unsigned char* wl = F.lds + F.wave * UP_LDS;
    LAS unsigned short* lidx = (LAS unsigned short*)wl; LAS float* lgate = (LAS float*)(wl + 4096); LAS unsigned* cmp = (LAS unsigned*)(wl + 12288);
    const int lane = F.lane;
    for (int unit = claim_unit(F, 2 * layer); unit >= 0; unit = claim_unit(F, 2 * layer)) {
    const int x = unit >> 5, jb = unit & 31;
    for (int t0 = jb * 1024 + F.wave * 128; t0 < jb * 1024 + F.wave * 128 + 128; t0 += 16) {
        { const u32x4* si = (const u32x4*)(IDX + (size_t)t0 * 128) + lane;
#pragma unroll
          for (int q = 0; q < 4; ++q) ((LAS u32x4*)lidx)[lane + 64 * q] = si[64 * q];
          const u32x4* sg = (const u32x4*)(GATE + (size_t)t0 * 128) + lane;
#pragma unroll
          for (int q = 0; q < 8; ++q) ((LAS u32x4*)lgate)[lane + 64 * q] = sg[64 * q]; }
        f32x2_t hq[8], hqN[8];
        up_load_h2(hq, H2, (size_t)t0, lane);
        int tt = 0, b = 0, n = up_prepare(cmp, lidx, lgate, 0, x, lane), nb = n > 16 ? (n + 15) >> 4 : 1;
        RowBuf RA, RB;
        up_issue(RA, U, cmp, 0, 0, n, x, lane);
        up_load_h2(hqN, H2, (size_t)t0 + 1, lane);
#define UP_STEP(RC, RN) { \
            int ntt = tt, nbb = b + 1, nn = n; bool last = false; \
            if (nbb >= nb) { ntt = tt + 1; nbb = 0; if (ntt < 16) nn = up_prepare(cmp, lidx, lgate, ntt, x, lane); else last = true; } \
            if (!last) up_issue(RN, U, cmp, ntt, nbb, nn, x, lane); \
            up_finish(RC, hq, cmp, W, (size_t)t0 + tt, tt, b, n, lane); \
            if (last) break; \
            if (ntt != tt) { _Pragma("unroll") for (int q = 0; q < 8; ++q) hq[q] = hqN[q]; if (ntt + 1 < 16) up_load_h2(hqN, H2, (size_t)t0 + ntt + 1, lane); n = nn; nb = n > 16 ? (n + 15) >> 4 : 1; } \
            tt = ntt; b = nbb; }
        for (;;) { UP_STEP(RA, RB) UP_STEP(RB, RA) }
#undef UP_STEP
    }
    }
}
struct TokBuf { u32x4 r[16]; f32x4 w[4]; };
DI void vp_load(TokBuf& tb, const unsigned char* Vs, const LAS unsigned short* lidx, const LAS float* lw, int tt, int lane) {
    const int g = lane >> 3, c = lane & 7;
    const LAS u32x4* ip = (const LAS u32x4*)(lidx + tt * 128 + 16 * g); const u32x4 ia = ip[0], ib = ip[1];
    const LAS f32x4* wp = (const LAS f32x4*)(lw + tt * 128 + 16 * g); tb.w[0] = wp[0]; tb.w[1] = wp[1]; tb.w[2] = wp[2]; tb.w[3] = wp[3];
    const unsigned e[16] = {ia.x & 0xffffu, ia.x >> 16, ia.y & 0xffffu, ia.y >> 16, ia.z & 0xffffu, ia.z >> 16, ia.w & 0xffffu, ia.w >> 16,
                            ib.x & 0xffffu, ib.x >> 16, ib.y & 0xffffu, ib.y >> 16, ib.z & 0xffffu, ib.z >> 16, ib.w & 0xffffu, ib.w >> 16};
#pragma unroll
    for (int i = 0; i < 16; ++i) tb.r[i] = *(const u32x4*)(Vs + (size_t)e[i] * 128 + c * 16);
}
DI void vp_compute(const TokBuf& tb, Frame& F, const float* g2s, float* xout, size_t t, int x, int lane) {
    f32x2_t out[8];
#pragma unroll
    for (int i = 0; i < 8; ++i) out[i] = (f32x2_t){0.f, 0.f};
#pragma unroll
    for (int i = 0; i < 16; ++i) { const float wk = tb.w[i >> 2][i & 3];
        out[0] = __builtin_amdgcn_cvt_pk_f32_fp8((int)tb.r[i].x, false) * wk + out[0]; out[1] = __builtin_amdgcn_cvt_pk_f32_fp8((int)tb.r[i].x, true) * wk + out[1];
        out[2] = __builtin_amdgcn_cvt_pk_f32_fp8((int)tb.r[i].y, false) * wk + out[2]; out[3] = __builtin_amdgcn_cvt_pk_f32_fp8((int)tb.r[i].y, true) * wk + out[3];
        out[4] = __builtin_amdgcn_cvt_pk_f32_fp8((int)tb.r[i].z, false) * wk + out[4]; out[5] = __builtin_amdgcn_cvt_pk_f32_fp8((int)tb.r[i].z, true) * wk + out[5];
        out[6] = __builtin_amdgcn_cvt_pk_f32_fp8((int)tb.r[i].w, false) * wk + out[6]; out[7] = __builtin_amdgcn_cvt_pk_f32_fp8((int)tb.r[i].w, true) * wk + out[7]; }
    float p[16];
#pragma unroll
    for (int i = 0; i < 8; ++i) { p[2 * i] = out[i].x; p[2 * i + 1] = out[i].y; }
#pragma unroll
    for (int i = 0; i < 8; ++i) { const bool up = (lane & 32) != 0; const float send = up ? p[i] : p[i + 8], keep = up ? p[i + 8] : p[i]; p[i] = keep + __shfl_xor(send, 32); }
#pragma unroll
    for (int i = 0; i < 4; ++i) { const bool up = (lane & 16) != 0; const float send = up ? p[i] : p[i + 4], keep = up ? p[i + 4] : p[i]; p[i] = keep + __shfl_xor(send, 16); }
#pragma unroll
    for (int i = 0; i < 2; ++i) { const bool up = (lane & 8) != 0; const float send = up ? p[i] : p[i + 2], keep = up ? p[i + 2] : p[i]; p[i] = keep + __shfl_xor(send, 8); }
    const int col = 128 * x + 16 * (lane & 7) + 8 * ((lane >> 5) & 1) + 4 * ((lane >> 4) & 1) + 2 * ((lane >> 3) & 1);
    const f32x2_t gg = *(const f32x2_t*)(g2s + col);
    const f32x2_t xv = *(const f32x2_t*)(F.out + t * 1024 + col);
    *(f32x2_t*)(xout + t * 1024 + col) = xv + gg * (f32x2_t){p[0], p[1]};
}
DI void p_vpass(Frame& F, int layer, float* xout) {

    const unsigned short* IDX = (const unsigned short*)(F.ws + WS_IDX); const float* W = (const float*)(F.ws + WS_W);
    const float* mods = (const float*)(F.ws + WS_MODS);
    LAS unsigned char* wl = F.lds + F.wave * UP_LDS;
    LAS unsigned short* lidx = (LAS unsigned short*)wl; LAS float* lw = (LAS float*)(wl + 4096);
    const int lane = F.lane;
    for (int unit = claim_unit(F, 2 * layer + 1); unit >= 0; unit = claim_unit(F, 2 * layer + 1)) {
    const int x = unit >> 5, jb = unit & 31;
    const unsigned char* Vs = F.ws + WS_V + ((size_t)layer * 8 + x) * 16384 * 128;
    for (int t0 = jb * 1024 + F.wave * 128; t0 < jb * 1024 + F.wave * 128 + 128; t0 += 16) {
        const int b = t0 >> 11;
        const float* g2s = mods + ((size_t)layer * 16 + b) * 6144 + 5 * 1024;
        { const u32x4* si = (const u32x4*)(IDX + (size_t)t0 * 128) + lane;
#pragma unroll
          for (int q = 0; q < 4; ++q) ((LAS u32x4*)lidx)[lane + 64 * q] = si[64 * q];
          const u32x4* sg = (const u32x4*)(W + (size_t)t0 * 128) + lane;
#pragma unroll
          for (int q = 0; q < 8; ++q) ((LAS u32x4*)lw)[lane + 64 * q] = sg[64 * q]; }
        TokBuf A, B;
        vp_load(A, Vs, lidx, lw, 0, lane);
#pragma unroll 1
        for (int tt = 0; tt < 16; tt += 2) {
            vp_load(B, Vs, lidx, lw, tt + 1, lane);
            vp_compute(A, F, g2s, xout, (size_t)t0 + tt, x, lane);
            if (tt + 2 < 16) vp_load(A, Vs, lidx, lw, tt + 2, lane);
            vp_compute(B, F, g2s, xout, (size_t)t0 + tt + 1, x, lane);
        }
    }
    }
}
#ifndef DUP
#define DUP -1
#endif
#ifndef PH_MASK
#define PH_MASK 0x3FFFF
#endif

#ifndef N_LAUNCH_MODE
#define N_LAUNCH_MODE 1
#endif
constexpr int NPH = 18;
template <class Epi> DI void run_gemm(Frame& F, const bf16* A, const bf16* Bt, int N, const Epi& E) {
    pg8::Gemm g{A, Bt, T_TOK, N, DM}; pg8::StaticOrder S; S.init(T_TOK, N, F.G, F.bid);
    pg8::gemm_phase<Epi, pg8::StaticOrder, true, true>(F.lds, g, S, E);
}
__global__ void __launch_bounds__(NT, 2) fwd(Args args) {
    extern __shared__ __attribute__((aligned(16))) unsigned char lds_raw[];
    cg::grid_group grid = cg::this_grid();
    Frame F;
    F.lds = (LAS unsigned char*)lds_raw;
#pragma unroll
    for (int i = 0; i < 23; ++i) F.in[i] = args.in[i];
    F.out = args.out; F.ws = args.ws;
    F.tid = threadIdx.x; F.lane = F.tid & 63; F.wave = __builtin_amdgcn_readfirstlane(F.tid >> 6); F.bid = blockIdx.x; F.G = gridDim.x;
    const int lo = args.ph_lo, hi = args.ph_hi;
#define IN(k) (lo <= (k) && (k) < hi)
#define SEAM(k) do { if (IN(k) && IN((k) + 1)) grid.sync(); } while (0)
    float* mods = (float*)(F.ws + WS_MODS);
    bf16* Hb = (bf16*)(F.ws + WS_H);
    if (((PH_MASK >> 0) & 1) && IN(0)) { p0_prologue(F); if (DUP == 0) { grid.sync(); p0_prologue(F); } } SEAM(0);
    if (((PH_MASK >> 1) & 1) && IN(1)) { norm_phase<true>(F, F.in[0], F.in[4], mods, mods + 1024, 6144, Hb); if (DUP == 1) { grid.sync(); norm_phase<true>(F, F.in[0], F.in[4], mods, mods + 1024, 6144, Hb); } } SEAM(1);
    if (((PH_MASK >> 2) & 1) && IN(2)) { pg8::EpiBf16<0> E{(bf16*)(F.ws + WS_PROJ), 3072, nullptr, 0, 0, 1.f}; run_gemm(F, Hb, (const bf16*)(F.ws + WS_WIN), 3072, E); if (DUP == 2) { grid.sync(); run_gemm(F, Hb, (const bf16*)(F.ws + WS_WIN), 3072, E); } } SEAM(2);
    if (((PH_MASK >> 3) & 1) && IN(3)) { p3_mlstm_local(F); if (DUP == 3) { grid.sync(); p3_mlstm_local(F); } } SEAM(3);
    if (((PH_MASK >> 4) & 1) && IN(4)) { p4_scan(F); if (DUP == 4) { grid.sync(); p3_mlstm_local(F); grid.sync(); p4_scan(F); } } SEAM(4);
    if (((PH_MASK >> 5) & 1) && IN(5)) { p5_mlstm_out(F); if (DUP == 5) { grid.sync(); p5_mlstm_out(F); } } SEAM(5);
    if (((PH_MASK >> 6) & 1) && IN(6)) { pg8::EpiResid E{F.in[0], F.out, mods + 2 * 1024, 6144}; run_gemm(F, Hb, (const bf16*)(F.ws + WS_WOUT), 1024, E); if (DUP == 6) { grid.sync(); run_gemm(F, Hb, (const bf16*)(F.ws + WS_WOUT), 1024, E); } } SEAM(6);
    if (((PH_MASK >> 7) & 1) && IN(7)) { norm_phase<false>(F, F.out, F.in[5], mods + 3 * 1024, mods + 4 * 1024, 6144, Hb); if (DUP == 7) { grid.sync(); norm_phase<false>(F, F.out, F.in[5], mods + 3 * 1024, mods + 4 * 1024, 6144, Hb); } } SEAM(7);
    if (((PH_MASK >> 8) & 1) && IN(8)) { pg8::EpiBf16<0> E{(bf16*)(F.ws + WS_PQ), 2048, nullptr, 0, 0, 1.f}; run_gemm(F, Hb, (const bf16*)(F.ws + WS_WPQ), 2048, E); if (DUP == 8) { grid.sync(); run_gemm(F, Hb, (const bf16*)(F.ws + WS_WPQ), 2048, E); } } SEAM(8);
    if (((PH_MASK >> 9) & 1) && IN(9)) { p_route(F, 0); if (DUP == 9) { grid.sync(); p_route(F, 0); } } SEAM(9);
    if (((PH_MASK >> 10) & 1) && IN(10)) {
        p_upass(F, 0); grid.sync(); p_vpass(F, 0, F.out); grid.sync();
        norm2_phase(F, F.out, F.in[4] + 1024, mods + 16 * 6144, mods + 16 * 6144 + 1024, 6144, Hb, F.in[13], (const float*)(F.ws + WS_KVMODS), (const float*)(F.ws + WS_KVMODS) + 1024, 2048, (bf16*)(F.ws + WS_HB));
    } SEAM(10);
    if (((PH_MASK >> 11) & 1) && IN(11)) {
        { pg8::EpiHeadNorm E{(bf16*)(F.ws + WS_Q), (bf16*)(F.ws + WS_Q), 4, F.in[17], 0.125f, EPS}; run_gemm(F, Hb, (const bf16*)(F.ws + WS_WSQ), 1024, E); }
        { pg8::EpiHeadNorm E{(bf16*)(F.ws + WS_K), (bf16*)(F.ws + WS_VV), 4, F.in[15], 1.0f, EPS}; run_gemm(F, (const bf16*)(F.ws + WS_HB), (const bf16*)(F.ws + WS_WKV), 2048, E);
          if (DUP == 11) { grid.sync(); run_gemm(F, (const bf16*)(F.ws + WS_HB), (const bf16*)(F.ws + WS_WKV), 2048, E); } }
    } SEAM(11);
    if (((PH_MASK >> 12) & 1) && IN(12)) { p12_attn(F); if (DUP == 12) { grid.sync(); p12_attn(F); } } SEAM(12);
    if (((PH_MASK >> 13) & 1) && IN(13)) { pg8::EpiResid E{F.out, F.out, mods + 16 * 6144 + 2 * 1024, 6144}; run_gemm(F, Hb, (const bf16*)(F.ws + WS_WSO), 1024, E); } SEAM(13);
    if (((PH_MASK >> 14) & 1) && IN(14)) { norm_phase<false>(F, F.out, F.in[5] + 1024, mods + 16 * 6144 + 3 * 1024, mods + 16 * 6144 + 4 * 1024, 6144, Hb); } SEAM(14);
    if (((PH_MASK >> 15) & 1) && IN(15)) { pg8::EpiBf16<0> E{(bf16*)(F.ws + WS_PQ), 2048, nullptr, 0, 0, 1.f}; run_gemm(F, Hb, (const bf16*)(F.ws + WS_WPQ) + (size_t)2048 * 1024, 2048, E); } SEAM(15);
    if (((PH_MASK >> 16) & 1) && IN(16)) { p_route(F, 1); } SEAM(16);
    if (((PH_MASK >> 17) & 1) && IN(17)) { p_upass(F, 1); grid.sync(); if (DUP == 20) { p_upass(F, 1); grid.sync(); } if (DUP == 21) { p_vpass(F, 1, (float*)(F.ws + WS_Q + 32 * MiB)); grid.sync(); } p_vpass(F, 1, F.out); }
#undef IN
#undef SEAM
}

extern "C" void kernel_launch(void* const* d_in, const int* in_sizes, int n_in, void* d_out, int out_size, void* d_ws, size_t ws_size, hipStream_t stream) {
    static int grid = 0;
    if (grid == 0) {
        int dev = 0, cus = 0, per_cu = 0;
        (void)hipGetDevice(&dev);
        (void)hipDeviceGetAttribute(&cus, hipDeviceAttributeMultiprocessorCount, dev);
        (void)hipFuncSetAttribute((const void*)fwd, hipFuncAttributeMaxDynamicSharedMemorySize, LDS_BYTES);
        (void)hipOccupancyMaxActiveBlocksPerMultiprocessor(&per_cu, (const void*)fwd, NT, LDS_BYTES);
        if (per_cu < 1) { fprintf(stderr, "kernel_launch: occupancy query says %d blocks per CU\n", per_cu); per_cu = 1; }
        grid = cus;
        if (n_in != 23 || ws_size < WS_END) fprintf(stderr, "kernel_launch: unexpected n_in %d / ws_size %zu\n", n_in, ws_size);
        (void)hipGetLastError();
    }
    Args a{};
    for (int i = 0; i < 23; ++i) a.in[i] = (const float*)d_in[i];
    a.out = (float*)d_out; a.ws = (unsigned char*)d_ws;
#if N_LAUNCH_MODE == 1
    a.ph_lo = 0; a.ph_hi = NPH;
    void* kargs[] = {&a};
    hipError_t e = hipLaunchCooperativeKernel((const void*)fwd, dim3(grid), dim3(NT), kargs, LDS_BYTES, stream);
    if (e != hipSuccess) fprintf(stderr, "kernel_launch: cooperative launch failed: %s (grid %d)\n", hipGetErrorString(e), grid);
#else
    for (int p = 0; p < NPH; ++p) { a.ph_lo = p; a.ph_hi = p + 1; hipLaunchKernelGGL(fwd, dim3(grid), dim3(NT), LDS_BYTES, stream, a); }
#endif
}
```

```cpp
#include <hip/hip_runtime.h>
#include <hip/hip_cooperative_groups.h>
#include <cstdio>
#include <cstdint>
namespace cg = cooperative_groups;
#define N_LAUNCH_MODE 1
namespace pg8 {
#define PG8_LAS __attribute__((address_space(3)))
typedef unsigned short bf16_t;
typedef short bf16x8 __attribute__((ext_vector_type(8)));
typedef float f32x4 __attribute__((ext_vector_type(4)));
typedef unsigned u32x4 __attribute__((ext_vector_type(4)));
constexpr int BM = 256, BK = 64, HALF = 128, HTB = HALF * BK * 2  , STAGE_BYTES = 8 * HTB, NXCD = 8, WGM = 8;

__host__ __device__ __forceinline__ int lds_byte(int r, int c) { const int st = (r >> 4) * 2 + (c >> 5), rr = r & 15, cc = c & 31, ob = rr * 64 + cc * 2; return st * 1024 + (ob ^ (((ob >> 9) & 1) << 5)); }
__host__ __device__ __forceinline__ void stage_rc(int b, int& R, int& C) { const int st = b / 1024, sb = b % 1024, swz = sb ^ (((sb >> 9) & 1) << 5); R = (st >> 1) * 16 + swz / 64; C = (st & 1) * 32 + (swz % 64) / 2; }
__host__ __device__ __forceinline__ int perm32(int rho) { const int n = rho >> 4, i = rho & 15; return 8 * (i >> 2) + 4 * n + (i & 3); }

struct Unit { int pm, pn; };
struct Gemm { const bf16_t* A; const bf16_t* Bt; int M, N, K; };

struct StaticOrder {
    int nM, nN, nwg, G, c;
    __host__ __device__ void init(int M, int N, int G_, int c_) { nM = M / BM; nN = N / BM; nwg = nM * nN; G = G_; c = c_; }
    __host__ __device__ bool next(int i, Unit& u) const {
        const long L = (long)i * G + c; if (L >= nwg) return false;
        int wgid = (int)L; { const int q = nwg / NXCD, r = nwg % NXCD, xcd = wgid % NXCD, off = wgid / NXCD; wgid = (xcd < r ? xcd * (q + 1) : r * (q + 1) + (xcd - r) * q) + off; }
        const int nig = WGM * nN, gid = wgid / nig, fm = gid * WGM, gsz = (nM - fm) < WGM ? (nM - fm) : WGM;
        u.pm = fm + ((wgid % nig) % gsz); u.pn = (wgid % nig) / gsz; return true;
    }
    __device__ __forceinline__ void a_ready(const Unit&) const {}
    __device__ __forceinline__ void done(const Unit&) const {}
};

__device__ __forceinline__ unsigned cvt_pk_bf16(float lo, float hi) { unsigned r; asm volatile("v_cvt_pk_bf16_f32 %0, %1, %2" : "=v"(r) : "v"(lo), "v"(hi)); return r; }
typedef float f32x2 __attribute__((ext_vector_type(2)));
__device__ __forceinline__ f32x2 gelu_pk(f32x2 v) {
    const f32x2 av = __builtin_elementwise_abs(v), d = av * 0.2316418882f + 1.0f;
    f32x2 t; t.x = __builtin_amdgcn_rcpf(d.x); t.y = __builtin_amdgcn_rcpf(d.y);
    f32x2 q = t * 0.5307027145f + (-0.7265760135f); q = q * t + 0.7107068705f; q = q * t + (-0.142248368f); q = q * t + 0.127414796f; q = q * t;
    const f32x2 s = (v * v) * (-0.72134752044f);
    f32x2 e; e.x = __builtin_amdgcn_exp2f(s.x); e.y = __builtin_amdgcn_exp2f(s.y);
    const f32x2 m = v * (q * e), r = v - m;
    f32x2 o; o.x = v.x < 0.f ? m.x : r.x; o.y = v.y < 0.f ? m.y : r.y; return o;
}

template <int ACT  > struct EpiBf16 {
    static constexpr bool PERM = true, AFTER_DRAIN = false; static_assert(ACT == 0 || ACT == 1, "EpiBf16: ACT is 0 (none) or 1 (gelu_pk)");
    bf16_t* O; int ldc; const float* bias; int split_cols; size_t split_stride; float scale0;
    __device__ __forceinline__ void operator()(const f32x4 (&acc)[2][2][4][2], const Unit& u, int wr, int wc, int fr, int fq) const {
        const int row0 = u.pm * BM + wr * 64 + fr; int colt = u.pn * BM; bf16_t* base = O;
        float sc = 1.f; if (split_cols) { const int t = colt / split_cols; base += (size_t)t * split_stride; colt -= t * split_cols; if (t == 0) sc = scale0; }
        const int col0 = colt + wc * 32 + 8 * fq, bcol0 = u.pn * BM + wc * 32 + 8 * fq;
        f32x4 bv[2][2];
#pragma unroll
        for (int bj = 0; bj < 2; ++bj)
#pragma unroll
            for (int n = 0; n < 2; ++n) bv[bj][n] = bias ? *(const f32x4*)(bias + bcol0 + bj * HALF + 4 * n) : (f32x4){0.f, 0.f, 0.f, 0.f};
#pragma unroll
        for (int ai = 0; ai < 2; ++ai)
#pragma unroll
            for (int m = 0; m < 4; ++m) { bf16_t* rowp = base + (size_t)(row0 + ai * HALF + m * 16) * ldc + col0;
#pragma unroll
                for (int bj = 0; bj < 2; ++bj) { f32x4 v0 = acc[ai][bj][m][0] + bv[bj][0], v1 = acc[ai][bj][m][1] + bv[bj][1];
                    if (ACT == 1) { f32x2 a = gelu_pk((f32x2){v0[0], v0[1]}), b = gelu_pk((f32x2){v0[2], v0[3]}), c = gelu_pk((f32x2){v1[0], v1[1]}), d = gelu_pk((f32x2){v1[2], v1[3]});
                        v0 = (f32x4){a.x, a.y, b.x, b.y}; v1 = (f32x4){c.x, c.y, d.x, d.y}; }
                    v0 = v0 * sc; v1 = v1 * sc; u32x4 w; w.x = cvt_pk_bf16(v0[0], v0[1]); w.y = cvt_pk_bf16(v0[2], v0[3]); w.z = cvt_pk_bf16(v1[0], v1[1]); w.w = cvt_pk_bf16(v1[2], v1[3]);
                    *(u32x4*)(rowp + bj * HALF) = w; } }
    }
};
struct EpiResid {
    static constexpr bool PERM = false, AFTER_DRAIN = false;
    const float* base; float* out; const float* gate; int gstride;
    __device__ __forceinline__ void operator()(const f32x4 (&acc)[2][2][4][2], const Unit& u, int wr, int wc, int fr, int fq) const {
        const int col0 = u.pn * BM + wc * 32 + 4 * fq;
        const int b = (u.pm * BM) >> 11;
        f32x4 gv[2][2];
#pragma unroll
        for (int bj = 0; bj < 2; ++bj)
#pragma unroll
            for (int n = 0; n < 2; ++n) gv[bj][n] = *(const f32x4*)(gate + (size_t)b * gstride + col0 + bj * HALF + n * 16);
#pragma unroll
        for (int ai = 0; ai < 2; ++ai)
#pragma unroll
            for (int m = 0; m < 4; ++m) { const size_t off = (size_t)(u.pm * BM + ai * HALF + wr * 64 + m * 16 + fr) * 1024 + col0;
#pragma unroll
                for (int bj = 0; bj < 2; ++bj)
#pragma unroll
                    for (int n = 0; n < 2; ++n) { const f32x4 bs = *(const f32x4*)(base + off + bj * HALF + n * 16);
                        *(f32x4*)(out + off + bj * HALF + n * 16) = bs + gv[bj][n] * acc[ai][bj][m][n]; }
                if (m & 1) asm volatile("" ::: "memory"); }
    }
};
struct EpiHeadNorm {
    static constexpr bool PERM = true, AFTER_DRAIN = false;
    bf16_t* O0; bf16_t* O1; int ntile_norm; const float* g; float scale; float eps;
    __device__ __forceinline__ void operator()(const f32x4 (&acc)[2][2][4][2], const Unit& u, int wr, int wc, int fr, int fq) const {
        const bool nrm = u.pn < ntile_norm; bf16_t* O = nrm ? O0 : O1; const int pnl = nrm ? u.pn : u.pn - ntile_norm;
        f32x4 gv[2][2];
#pragma unroll
        for (int bj = 0; bj < 2; ++bj)
#pragma unroll
            for (int n = 0; n < 2; ++n) { const f32x4 t = *(const f32x4*)(g + 32 * bj + 8 * fq + 4 * n); gv[bj][n] = nrm ? t * scale : (f32x4){1.f, 1.f, 1.f, 1.f}; }
#pragma unroll
        for (int ai = 0; ai < 2; ++ai)
#pragma unroll
            for (int m = 0; m < 4; ++m) {
                float ss = 0.f;
#pragma unroll
                for (int bj = 0; bj < 2; ++bj)
#pragma unroll
                    for (int n = 0; n < 2; ++n) { const f32x4 x = acc[ai][bj][m][n]; ss += (x[0] * x[0] + x[1] * x[1]) + (x[2] * x[2] + x[3] * x[3]); }
                ss += __shfl_xor(ss, 16); ss += __shfl_xor(ss, 32);
                const float rs = nrm ? 1.0f / sqrtf(ss * (1.0f / 64.0f) + eps) : 1.0f;
                bf16_t* rowp = O + (size_t)(u.pm * BM + ai * HALF + wr * 64 + m * 16 + fr) * 1024 + pnl * BM + wc * 64 + 8 * fq;
#pragma unroll
                for (int bj = 0; bj < 2; ++bj) { const f32x4 v0 = acc[ai][bj][m][0] * rs * gv[bj][0], v1 = acc[ai][bj][m][1] * rs * gv[bj][1];
                    u32x4 w; w.x = cvt_pk_bf16(v0[0], v0[1]); w.y = cvt_pk_bf16(v0[2], v0[3]); w.z = cvt_pk_bf16(v1[0], v1[1]); w.w = cvt_pk_bf16(v1[2], v1[3]);
                    *(u32x4*)(rowp + bj * 32) = w; }
            }
    }
};
template <class Epi, class Sched, bool ALIGN_EPI = false, bool SP2 = false>
__device__ __forceinline__ void gemm_phase(PG8_LAS unsigned char* lds, const Gemm g, const Sched& S, const Epi& E) {
    const int tid = threadIdx.x, wid = __builtin_amdgcn_readfirstlane(tid >> 6), lane = tid & 63, wr = wid >> 2, wc = wid & 3, fr = lane & 15, fq = lane >> 4;
    const int K = g.K, nt = K / BK;
    unsigned voffA[2], voffB[2];
#pragma unroll
    for (int i = 0; i < 2; ++i) { int R, C; stage_rc(tid * 16 + i * 8192, R, C); const int Rb = Epi::PERM ? ((R & ~31) + perm32(R & 31)) : R;
        voffA[i] = (unsigned)(R * K + C) * 2u; voffB[i] = (unsigned)(Rb * K + C) * 2u; }
    const size_t kstep = (size_t)(BK * 2);
    const size_t hstep = (size_t)HALF * K * 2;
    const size_t tstep = 2 * hstep;
    const unsigned ldsw = (unsigned)wid * 1024u;
    const int aoff = lds_byte(wr * 64 + fr, fq * 8), boff = lds_byte(wc * 32 + fr, fq * 8);
#define PG8_SA(b, h) (((b) * 2 + (h)) * HTB)
#define PG8_SB(b, h) ((4 + (b) * 2 + (h)) * HTB)
#define PG8_STAGE(bufoff, gbase, voff) do { _Pragma("unroll") for (int _i = 0; _i < 2; ++_i) \
        __builtin_amdgcn_global_load_lds((const unsigned*)((const char*)(gbase) + (voff)[_i]), (PG8_LAS unsigned*)(lds + (bufoff) + ldsw + _i * 8192), 16, 0, 0); } while (0)
#define PG8_LDA(dst, b, h) do { _Pragma("unroll") for (int m = 0; m < 4; ++m) _Pragma("unroll") for (int k = 0; k < 2; ++k) dst[m][k] = *(const PG8_LAS bf16x8*)(lds + PG8_SA(b, h) + aoff + m * 2048 + k * 1024); } while (0)
#define PG8_LDB(dst, b, h) do { _Pragma("unroll") for (int n = 0; n < 2; ++n) _Pragma("unroll") for (int k = 0; k < 2; ++k) dst[n][k] = *(const PG8_LAS bf16x8*)(lds + PG8_SB(b, h) + boff + n * 2048 + k * 1024); } while (0)
#define PG8_MMA(ai, bj, At, Bt) do { __builtin_amdgcn_s_setprio(1); _Pragma("unroll") for (int m = 0; m < 4; ++m) _Pragma("unroll") for (int n = 0; n < 2; ++n) _Pragma("unroll") for (int k = 0; k < 2; ++k) \
        acc[ai][bj][m][n] = __builtin_amdgcn_mfma_f32_16x16x32_bf16(Bt[n][k], At[m][k], acc[ai][bj][m][n], 0, 0, 0); __builtin_amdgcn_s_setprio(0); } while (0)
#define PG8_WAIT_V(n) asm volatile("s_waitcnt vmcnt(" #n ")" ::: "memory")
#define PG8_WAIT_L(n) asm volatile("s_waitcnt lgkmcnt(" #n ")" ::: "memory")
#define PG8_BAR __builtin_amdgcn_s_barrier()
#define PG8_SCHED __builtin_amdgcn_sched_barrier(0)
    Unit cur, nxt; int ui = 0;
    if (!S.next(0, cur)) return;
    f32x4 acc[2][2][4][2];
#pragma unroll
    for (int a = 0; a < 2; ++a)
#pragma unroll
        for (int b = 0; b < 2; ++b)
#pragma unroll
            for (int m = 0; m < 4; ++m)
#pragma unroll
                for (int n = 0; n < 2; ++n) acc[a][b][m][n] = (f32x4){0.f, 0.f, 0.f, 0.f};
    bf16x8 At[4][2], B0[2][2], B1[2][2];
    const char* cA = (const char*)g.A + (size_t)cur.pm * tstep; const char* cB = (const char*)g.Bt + (size_t)cur.pn * tstep;
    S.a_ready(cur);
    if constexpr (SP2) {
        PG8_STAGE(PG8_SB(0, 0), cB, voffB); PG8_STAGE(PG8_SB(0, 1), cB + hstep, voffB); PG8_STAGE(PG8_SA(0, 0), cA, voffA); PG8_STAGE(PG8_SA(0, 1), cA + hstep, voffA);
        if (wr == 1) PG8_BAR;
        PG8_WAIT_V(2); PG8_BAR;
        PG8_STAGE(PG8_SB(1, 0), cB + kstep, voffB); PG8_STAGE(PG8_SA(1, 0), cA + kstep, voffA); PG8_STAGE(PG8_SB(1, 1), cB + hstep + kstep, voffB);
        PG8_WAIT_V(6); PG8_BAR;
    } else {
        PG8_STAGE(PG8_SB(0, 0), cB, voffB); PG8_STAGE(PG8_SA(0, 0), cA, voffA); PG8_STAGE(PG8_SB(0, 1), cB + hstep, voffB); PG8_STAGE(PG8_SA(0, 1), cA + hstep, voffA);
        if (wr == 1) PG8_BAR;
        PG8_WAIT_V(4); PG8_BAR;
        PG8_STAGE(PG8_SB(1, 0), cB + kstep, voffB); PG8_STAGE(PG8_SA(1, 0), cA + kstep, voffA); PG8_STAGE(PG8_SB(1, 1), cB + hstep + kstep, voffB);
        PG8_WAIT_V(6); PG8_BAR;
    }
    for (;;) {
        const bool has_next = S.next(ui + 1, nxt);
        const char* nA = has_next ? (const char*)g.A + (size_t)nxt.pm * tstep : cA; const char* nB = has_next ? (const char*)g.Bt + (size_t)nxt.pn * tstep : cB;
        for (int t = 0; t < nt; t += 2) {
            const bool last = (t == nt - 2);
            const char* a1 = cA + (size_t)(t + 1) * kstep;
            const char* a2 = last ? nA : cA + (size_t)(t + 2) * kstep; const char* b2 = last ? nB : cB + (size_t)(t + 2) * kstep;
            const char* a3 = a2 + kstep; const char* b3 = b2 + kstep;
            if (last && has_next) S.a_ready(nxt);
            if constexpr (SP2) {
            PG8_LDB(B0, 0, 0); PG8_LDB(B1, 0, 1); PG8_SCHED; PG8_LDA(At, 0, 0); PG8_STAGE(PG8_SA(1, 1), a1 + hstep, voffA);
            PG8_WAIT_V(8); PG8_WAIT_L(0); PG8_BAR; PG8_MMA(0, 0, At, B0); PG8_MMA(0, 1, At, B1); PG8_BAR; PG8_SCHED;
            PG8_LDA(At, 0, 1); PG8_STAGE(PG8_SB(0, 0), b2, voffB); PG8_STAGE(PG8_SB(0, 1), b2 + hstep, voffB); PG8_STAGE(PG8_SA(0, 0), a2, voffA);
            PG8_WAIT_V(8); PG8_WAIT_L(0); PG8_BAR; PG8_MMA(1, 0, At, B0); PG8_MMA(1, 1, At, B1); PG8_BAR; PG8_SCHED;
            PG8_LDB(B0, 1, 0); PG8_LDB(B1, 1, 1); PG8_SCHED; PG8_LDA(At, 1, 0); PG8_STAGE(PG8_SA(0, 1), a2 + hstep, voffA);
            PG8_WAIT_V(8); PG8_WAIT_L(0); PG8_BAR; PG8_MMA(0, 0, At, B0); PG8_MMA(0, 1, At, B1); PG8_BAR; PG8_SCHED;
            PG8_LDA(At, 1, 1); PG8_STAGE(PG8_SB(1, 0), b3, voffB); PG8_STAGE(PG8_SB(1, 1), b3 + hstep, voffB); PG8_STAGE(PG8_SA(1, 0), a3, voffA);
            PG8_WAIT_V(8); PG8_WAIT_L(0); PG8_BAR; PG8_MMA(1, 0, At, B0); PG8_MMA(1, 1, At, B1); PG8_BAR; PG8_SCHED;
            } else {
            PG8_LDB(B0, 0, 0); PG8_SCHED; PG8_LDA(At, 0, 0); PG8_STAGE(PG8_SA(1, 1), a1 + hstep, voffA);
            PG8_WAIT_L(8); PG8_BAR; PG8_WAIT_L(0); PG8_MMA(0, 0, At, B0); PG8_BAR; PG8_SCHED;
            PG8_LDB(B1, 0, 1); PG8_STAGE(PG8_SB(0, 0), b2, voffB);
            PG8_BAR; PG8_WAIT_L(0); PG8_MMA(0, 1, At, B1); PG8_BAR;
            PG8_LDA(At, 0, 1); PG8_STAGE(PG8_SA(0, 0), a2, voffA);
            PG8_BAR; PG8_WAIT_L(0); PG8_MMA(1, 0, At, B0); PG8_BAR; PG8_SCHED;
            PG8_STAGE(PG8_SB(0, 1), b2 + hstep, voffB);
            PG8_WAIT_V(6); PG8_BAR; PG8_MMA(1, 1, At, B1); PG8_BAR;
            PG8_LDB(B0, 1, 0); PG8_SCHED; PG8_LDA(At, 1, 0); PG8_STAGE(PG8_SA(0, 1), a2 + hstep, voffA);
            PG8_WAIT_L(8); PG8_BAR; PG8_WAIT_L(0); PG8_MMA(0, 0, At, B0); PG8_BAR; PG8_SCHED;
            PG8_LDB(B1, 1, 1); PG8_STAGE(PG8_SB(1, 0), b3, voffB);
            PG8_BAR; PG8_WAIT_L(0); PG8_MMA(0, 1, At, B1); PG8_BAR;
            PG8_LDA(At, 1, 1); PG8_STAGE(PG8_SA(1, 0), a3, voffA);
            PG8_BAR; PG8_WAIT_L(0); PG8_MMA(1, 0, At, B0); PG8_BAR; PG8_SCHED;
            PG8_STAGE(PG8_SB(1, 1), b3 + hstep, voffB);
            PG8_WAIT_V(6); PG8_BAR; PG8_MMA(1, 1, At, B1); PG8_BAR;
            }
        }
        if constexpr (ALIGN_EPI) { if (wr == 0) PG8_BAR; }
        if constexpr (!Epi::AFTER_DRAIN) { E(acc, cur, wr, wc, fr, fq); S.done(cur); }
        if (!has_next) break;
#pragma unroll
        for (int a = 0; a < 2; ++a)
#pragma unroll
            for (int b = 0; b < 2; ++b)
#pragma unroll
                for (int m = 0; m < 4; ++m)
#pragma unroll
                    for (int n = 0; n < 2; ++n) acc[a][b][m][n] = (f32x4){0.f, 0.f, 0.f, 0.f};
        cur = nxt; cA = nA; cB = nB; ++ui;
        if constexpr (ALIGN_EPI) { if (wr == 1) PG8_BAR; }
    }
    PG8_WAIT_V(0);
    if constexpr (!ALIGN_EPI) { if (wr == 0) PG8_BAR; }
    PG8_BAR;
    if constexpr (Epi::AFTER_DRAIN) { E.fused(acc, cur, wr, wc, fr, fq, lds, wid, lane); S.done(cur); }
#undef PG8_SA
#undef PG8_SB
#undef PG8_STAGE
#undef PG8_LDA
#undef PG8_LDB
#undef PG8_MMA
#undef PG8_WAIT_V
#undef PG8_WAIT_L
#undef PG8_BAR
#undef PG8_SCHED
}
}

#define DI __device__ __forceinline__
#define LAS __attribute__((address_space(3)))
typedef unsigned short bf16;
typedef __bf16 bf16x2_t __attribute__((ext_vector_type(2)));
typedef float f32x2_t __attribute__((ext_vector_type(2)));
typedef float f32x4 __attribute__((ext_vector_type(4)));
typedef float f32x16 __attribute__((ext_vector_type(16)));
typedef short bf16x8 __attribute__((ext_vector_type(8)));
typedef short s16x4 __attribute__((ext_vector_type(4)));
typedef unsigned u32x4 __attribute__((ext_vector_type(4)));
typedef unsigned u32x2 __attribute__((ext_vector_type(2)));

constexpr int NT = 512, NWAVES = 8;
constexpr int LDS_BYTES = 147456;
constexpr int T_TOK = 32768, DM = 1024, SEQ = 2048, NB = 16;
constexpr float EPS = 1e-6f;
constexpr size_t MiB = 1u << 20;
constexpr size_t WS_MODS = 1 * MiB, WS_KVMODS = WS_MODS + (size_t)2 * 16 * 6144 * 4;
constexpr size_t WS_GATES = 2 * MiB, WS_BLAST = 4 * MiB, WS_MLOC = 4 * MiB + 65536, WS_MPREV = 4 * MiB + 131072, WS_NLOC = 5 * MiB;
constexpr size_t WS_WG = 6 * MiB, WS_SUBK = 7 * MiB;
constexpr size_t WS_WIN = 8 * MiB, WS_WOUT = 14 * MiB, WS_WKV = 16 * MiB, WS_WSQ = 20 * MiB, WS_WSO = 22 * MiB, WS_WPQ = 24 * MiB;
constexpr size_t WS_IDX = 36 * MiB, WS_GATE = 44 * MiB, WS_SU = 60 * MiB;
constexpr size_t WS_H2Q = 256 * MiB, WS_SH = 288 * MiB + 0;
constexpr size_t WS_U = 64 * MiB, WS_V = 128 * MiB, WS_H = 192 * MiB, WS_HB = 256 * MiB, WS_PROJ = 320 * MiB, WS_END = 512 * MiB;
constexpr size_t WS_CST = WS_HB;
constexpr size_t WS_Q = WS_PROJ, WS_K = WS_PROJ + 64 * MiB, WS_VV = WS_PROJ + 128 * MiB, WS_PQ = WS_PROJ;

struct Args { const float* in[23]; float* out; unsigned char* ws; int ph_lo, ph_hi; };
struct Frame {
    LAS unsigned char* lds;
    const float* in[23]; float* out; unsigned char* ws;
    int tid, lane, wave, bid, G;
};

DI unsigned cvtpk(float lo, float hi) { f32x2_t v = {lo, hi}; bf16x2_t b = __builtin_convertvector(v, bf16x2_t); return __builtin_bit_cast(unsigned, b); }
DI float bflo(unsigned u) { return __uint_as_float(u << 16); }
DI float bfhi(unsigned u) { return __uint_as_float(u & 0xffff0000u); }
DI float wave_sum(float v) {
#pragma unroll
    for (int o = 1; o < 64; o <<= 1) v += __shfl_xor(v, o);
    return v;
}
DI float wave_max(float v) {
#pragma unroll
    for (int o = 1; o < 64; o <<= 1) v = fmaxf(v, __shfl_xor(v, o));
    return v;
}
DI int crow(int r, int hi) { return (r & 3) + 8 * (r >> 2) + 4 * hi; }
#define MFMA32(a, b, c) __builtin_amdgcn_mfma_f32_32x32x16_bf16((a), (b), (c), 0, 0, 0)
typedef short v4i16_t __attribute__((ext_vector_type(4)));
DI s16x4 tr16(const LAS unsigned char* p) { return __builtin_bit_cast(s16x4, __builtin_amdgcn_ds_read_tr16_b64_v4i16((LAS v4i16_t*)p)); }
DI int tr_off(int tok, int ch) { return (ch >> 2) * 4096 + (tok >> 4) * 1024 + (tok & 15) * 64 + (ch & 3) * 16; }
DI bf16x8 tr_frag(const LAS unsigned char* img, int dh, int ks, int lane) {
    const int hi = lane >> 5; const int vb = ((lane >> 4) & 1) * 32 + (lane & 3) * 8 + (4 * hi + ((lane & 15) >> 2)) * 64;
    const s16x4 lo = tr16(img + vb + dh * 4096 + ks * 1024), h2 = tr16(img + vb + dh * 4096 + ks * 1024 + 512);
    return __builtin_shufflevector(lo, h2, 0, 1, 2, 3, 4, 5, 6, 7);
}
template <int NTOK> DI bf16x8 row_frag(const LAS unsigned char* img, int tt, int ks, int lane) {
    const int hi = lane >> 5, r32 = lane & 31;
    return *(const LAS bf16x8*)(img + (2 * ks + hi) * (NTOK * 16) + (32 * tt + r32) * 16);
}
DI bf16x8 pack8(const f32x16& x, int s) {
    u32x4 p; p.x = cvtpk(x[8 * s], x[8 * s + 1]); p.y = cvtpk(x[8 * s + 2], x[8 * s + 3]); p.z = cvtpk(x[8 * s + 4], x[8 * s + 5]); p.w = cvtpk(x[8 * s + 6], x[8 * s + 7]);
    return __builtin_bit_cast(bf16x8, p);
}

DI void p0_ada(Frame& F) {
    LAS float* sil = (LAS float*)F.lds;
    LAS float* red = (LAS float*)(F.lds + 65536);
    const float* c = F.in[1];
    for (int i = F.tid; i < 16 * 1024; i += NT) { const int b = i >> 10, d = i & 1023; const float v = c[i]; sil[d * 16 + b] = v / (1.f + expf(-v)); }
    __syncthreads();
    for (int item = F.bid; item < 224; item += F.G) {
        const float* W; const float* bias; float* out; int N, col0;
        if (item < 192) { const int layer = item / 96, it = item % 96; W = F.in[2] + (size_t)layer * 1024 * 6144; bias = F.in[3] + layer * 6144; N = 6144; col0 = it * 64; out = (float*)(F.ws + WS_MODS) + (size_t)layer * 16 * 6144; }
        else { const int it = item - 192; W = F.in[11]; bias = F.in[12]; N = 2048; col0 = it * 64; out = (float*)(F.ws + WS_KVMODS); }
        float acc[16];
#pragma unroll
        for (int b = 0; b < 16; ++b) acc[b] = 0.f;
        const int d0 = F.wave * 128;
        const float* wp = W + (size_t)d0 * N + col0 + F.lane;
#pragma unroll 4
        for (int d = 0; d < 128; ++d) {
            const float w = wp[(size_t)d * N];
            const LAS f32x4* s4 = (const LAS f32x4*)(sil + (d0 + d) * 16);
            const f32x4 s0 = s4[0], s1 = s4[1], s2 = s4[2], s3 = s4[3];
            acc[0] += w * s0[0]; acc[1] += w * s0[1]; acc[2] += w * s0[2]; acc[3] += w * s0[3];
            acc[4] += w * s1[0]; acc[5] += w * s1[1]; acc[6] += w * s1[2]; acc[7] += w * s1[3];
            acc[8] += w * s2[0]; acc[9] += w * s2[1]; acc[10] += w * s2[2]; acc[11] += w * s2[3];
            acc[12] += w * s3[0]; acc[13] += w * s3[1]; acc[14] += w * s3[2]; acc[15] += w * s3[3];
        }
#pragma unroll
        for (int b = 0; b < 16; ++b) red[(F.wave * 16 + b) * 64 + F.lane] = acc[b];
        __syncthreads();
        for (int i = F.tid; i < 1024; i += NT) { const int b = i >> 6, l = i & 63; float s = 0.f;
#pragma unroll
            for (int w = 0; w < 8; ++w) s += red[(w * 16 + b) * 64 + l];
            out[(size_t)b * N + col0 + l] = s + bias[col0 + l]; }
        __syncthreads();
    }
}
DI void transpose_item(const float* W, int ldw, bf16* WT, int dst_row0, LAS float* scr, int k0, int n0, int lane) {
#pragma unroll 8
    for (int i = 0; i < 32; ++i) { const int kk = 2 * i + (lane >> 5); scr[kk * 33 + (lane & 31)] = W[(size_t)(k0 + kk) * ldw + n0 + (lane & 31)]; }
    asm volatile("s_waitcnt lgkmcnt(0)" ::: "memory");
    const int c = lane & 7;
#pragma unroll
    for (int j = 0; j < 4; ++j) { const int n = (lane >> 3) + 8 * j; const LAS float* s = scr + (8 * c) * 33 + n;
        u32x4 o; o.x = cvtpk(s[0 * 33], s[1 * 33]); o.y = cvtpk(s[2 * 33], s[3 * 33]); o.z = cvtpk(s[4 * 33], s[5 * 33]); o.w = cvtpk(s[6 * 33], s[7 * 33]);
        *(u32x4*)(WT + (size_t)(dst_row0 + n) * 1024 + k0 + 8 * c) = o; }
    asm volatile("s_waitcnt lgkmcnt(0)" ::: "memory");
}
DI int permrow(int c) { return (c & ~255) + 32 * (4 * ((c >> 5) & 1) + ((c >> 6) & 3)) + (c & 31); }
DI void p0_prologue(Frame& F) {
    if (F.bid == 0) for (int i = F.tid; i < 1024; i += NT) ((unsigned*)(F.ws + 4096))[i] = 0u;
    p0_ada(F);
    LAS float* scr = (LAS float*)(F.lds + F.wave * 16384);
    const int gw = F.bid * NWAVES + F.wave, NGW = F.G * NWAVES;
    for (int it = gw; it < 6144; it += NGW) {
        int r = it; const float* W; int ldw, ncols; bf16* dst; bool perm;
        if (r < 1536) { W = F.in[6]; ldw = 3088; ncols = 3072; dst = (bf16*)(F.ws + WS_WIN); perm = false; }
        else if ((r -= 1536) < 512) { W = F.in[10]; ldw = 1024; ncols = 1024; dst = (bf16*)(F.ws + WS_WOUT); perm = false; }
        else if ((r -= 512) < 1024) { W = F.in[14]; ldw = 2048; ncols = 2048; dst = (bf16*)(F.ws + WS_WKV); perm = true; }
        else if ((r -= 1024) < 512) { W = F.in[16]; ldw = 1024; ncols = 1024; dst = (bf16*)(F.ws + WS_WSQ); perm = true; }
        else if ((r -= 512) < 512) { W = F.in[18]; ldw = 1024; ncols = 1024; dst = (bf16*)(F.ws + WS_WSO); perm = false; }
        else if ((r -= 512) < 1024) { W = F.in[19]; ldw = 2048; ncols = 2048; dst = (bf16*)(F.ws + WS_WPQ); perm = false; }
        else { r -= 1024; W = F.in[19] + (size_t)1024 * 2048; ldw = 2048; ncols = 2048; dst = (bf16*)(F.ws + WS_WPQ) + (size_t)2048 * 1024; perm = false; }
        const int nblk = ncols / 32, kb = r / nblk, nb = r % nblk, n0 = 32 * nb;
        transpose_item(W, ldw, dst, perm ? permrow(n0) : n0, scr, 64 * kb, n0, F.lane);
    }
    const size_t gt = (size_t)F.bid * NT + F.tid, NGT = (size_t)F.G * NT;
    constexpr size_t TBL16 = (size_t)2 * 16384 * 1024 / 16;
    for (size_t j = gt; j < TBL16; j += NGT) {
        const f32x4* src = (const f32x4*)F.in[22] + 4 * j;
        const f32x4 a = src[0] * 4.f, b = src[1] * 4.f, c2 = src[2] * 4.f, d = src[3] * 4.f;
        int p0 = 0, p1 = 0, p2 = 0, p3 = 0;
        p0 = __builtin_amdgcn_cvt_pk_fp8_f32(a[0], a[1], p0, false); p0 = __builtin_amdgcn_cvt_pk_fp8_f32(a[2], a[3], p0, true);
        p1 = __builtin_amdgcn_cvt_pk_fp8_f32(b[0], b[1], p1, false); p1 = __builtin_amdgcn_cvt_pk_fp8_f32(b[2], b[3], p1, true);
        p2 = __builtin_amdgcn_cvt_pk_fp8_f32(c2[0], c2[1], p2, false); p2 = __builtin_amdgcn_cvt_pk_fp8_f32(c2[2], c2[3], p2, true);
        p3 = __builtin_amdgcn_cvt_pk_fp8_f32(d[0], d[1], p3, false); p3 = __builtin_amdgcn_cvt_pk_fp8_f32(d[2], d[3], p3, true);
        const size_t q = j & 63, e = (j >> 6) & 16383, ly = j >> 20;
        ((u32x4*)(F.ws + WS_V))[(((ly * 8 + (q >> 3)) * 16384 + e) << 3) + (q & 7)] = (u32x4){(unsigned)p0, (unsigned)p1, (unsigned)p2, (unsigned)p3};
    }
    for (int row = gw; row < 2 * 16384; row += NGW) {
        const f32x4* src = (const f32x4*)(F.in[21] + (size_t)row * 1024) + 4 * F.lane;
        const f32x4 a = src[0], b = src[1], c2 = src[2], d = src[3];
        float m = fmaxf(fmaxf(fmaxf(fabsf(a[0]), fabsf(a[1])), fmaxf(fabsf(a[2]), fabsf(a[3]))), fmaxf(fmaxf(fabsf(b[0]), fabsf(b[1])), fmaxf(fabsf(b[2]), fabsf(b[3]))));
        m = fmaxf(m, fmaxf(fmaxf(fmaxf(fabsf(c2[0]), fabsf(c2[1])), fmaxf(fabsf(c2[2]), fabsf(c2[3]))), fmaxf(fmaxf(fabsf(d[0]), fabsf(d[1])), fmaxf(fabsf(d[2]), fabsf(d[3])))));
        m = fmaxf(wave_max(m), 1e-30f);
        const float inv = 127.0f / m;
        auto q4 = [&](const f32x4& v) -> unsigned { const int x0 = (int)rintf(v[0] * inv), x1 = (int)rintf(v[1] * inv), x2 = (int)rintf(v[2] * inv), x3 = (int)rintf(v[3] * inv);
            return (unsigned)(x0 & 255) | ((unsigned)(x1 & 255) << 8) | ((unsigned)(x2 & 255) << 16) | ((unsigned)(x3 & 255) << 24); };
        ((u32x4*)(F.ws + WS_U + (size_t)row * 1024))[F.lane] = (u32x4){q4(a), q4(b), q4(c2), q4(d)};
        if (F.lane == 0) ((float*)(F.ws + WS_SU))[row] = m * (1.0f / 127.0f);
    }
    for (size_t i = gt; i < 65536 / 2; i += NGT) { const float a = F.in[20][2 * i], b = F.in[20][2 * i + 1]; ((unsigned*)(F.ws + WS_SUBK))[i] = cvtpk(a, b); }
    for (size_t i = gt; i < 16 * 1024; i += NGT) { const int g = (int)(i >> 10), k = (int)(i & 1023); ((float*)(F.ws + WS_WG))[i] = F.in[6][(size_t)k * 3088 + 3072 + g]; }
}

template <bool GATES, bool Q8 = false> DI void norm_phase(Frame& F, const float* xin, const float* g, const float* shp, const float* scp, int bstride, bf16* hout) {
    const int gw = F.bid * NWAVES + F.wave, NGW = F.G * NWAVES;
    LAS float* wg = (LAS float*)F.lds;
    if (GATES) { const float* src = (const float*)(F.ws + WS_WG); for (int i = F.tid; i < 16 * 1024 / 4; i += NT) ((LAS f32x4*)wg)[i] = ((const f32x4*)src)[i]; __syncthreads(); }
    for (int chunk = gw; chunk < T_TOK / 16; chunk += NGW) {
        const int row0 = chunk * 16, b = row0 >> 11;
        f32x4 A[4], Bv[4];
#pragma unroll
        for (int j = 0; j < 4; ++j) { const int c = 4 * F.lane + 256 * j; const f32x4 gg = *(const f32x4*)(g + c), sc = *(const f32x4*)(scp + (size_t)b * bstride + c);
            A[j] = gg * (sc + 1.0f); Bv[j] = *(const f32x4*)(shp + (size_t)b * bstride + c); }
        for (int r = 0; r < 16; ++r) {
            const int row = row0 + r;
            const f32x4* xr = (const f32x4*)(xin + (size_t)row * DM) + F.lane;
            f32x4 v[4]; float ss = 0.f;
#pragma unroll
            for (int j = 0; j < 4; ++j) { v[j] = xr[64 * j]; ss += (v[j][0] * v[j][0] + v[j][1] * v[j][1]) + (v[j][2] * v[j][2] + v[j][3] * v[j][3]); }
            const float rstd = 1.0f / sqrtf(wave_sum(ss) * (1.0f / DM) + EPS);
            unsigned long long* o8 = (unsigned long long*)(hout + (size_t)row * DM) + F.lane;
#pragma unroll
            for (int j = 0; j < 4; ++j) { v[j] = v[j] * rstd * A[j] + Bv[j]; o8[64 * j] = (unsigned long long)cvtpk(v[j][0], v[j][1]) | ((unsigned long long)cvtpk(v[j][2], v[j][3]) << 32); }
            if (Q8) {
                float m = 0.f;
#pragma unroll
                for (int j = 0; j < 4; ++j) m = fmaxf(m, fmaxf(fmaxf(fabsf(v[j][0]), fabsf(v[j][1])), fmaxf(fabsf(v[j][2]), fabsf(v[j][3]))));
                m = fmaxf(wave_max(m), 1e-30f);
                const float inv = 127.0f / m;
                unsigned* q8 = (unsigned*)(F.ws + WS_H2Q + (size_t)row * DM) + F.lane;
#pragma unroll
                for (int j = 0; j < 4; ++j) { const int x0 = (int)rintf(v[j][0] * inv), x1 = (int)rintf(v[j][1] * inv), x2 = (int)rintf(v[j][2] * inv), x3 = (int)rintf(v[j][3] * inv);
                    q8[64 * j] = (unsigned)(x0 & 255) | ((unsigned)(x1 & 255) << 8) | ((unsigned)(x2 & 255) << 16) | ((unsigned)(x3 & 255) << 24); }
                if (F.lane == 0) ((float*)(F.ws + WS_SH))[row] = m * (1.0f / 127.0f);
            }
            if (GATES) {
                float p[16];
#pragma unroll
                for (int q = 0; q < 16; ++q) { float s = 0.f;
#pragma unroll
                    for (int j = 0; j < 4; ++j) { const f32x4 w = *(const LAS f32x4*)(wg + q * 1024 + 4 * F.lane + 256 * j); s += (v[j][0] * w[0] + v[j][1] * w[1]) + (v[j][2] * w[2] + v[j][3] * w[3]); }
                    p[q] = s; if ((q & 3) == 3) { asm volatile("" ::: "memory"); __builtin_amdgcn_sched_barrier(0); } }
#pragma unroll
                for (int i = 0; i < 8; ++i) { const bool up = (F.lane & 32) != 0; const float send = up ? p[i] : p[i + 8], keep = up ? p[i + 8] : p[i]; p[i] = keep + __shfl_xor(send, 32); }
#pragma unroll
                for (int i = 0; i < 4; ++i) { const bool up = (F.lane & 16) != 0; const float send = up ? p[i] : p[i + 4], keep = up ? p[i + 4] : p[i]; p[i] = keep + __shfl_xor(send, 16); }
#pragma unroll
                for (int i = 0; i < 2; ++i) { const bool up = (F.lane & 8) != 0; const float send = up ? p[i] : p[i + 2], keep = up ? p[i + 2] : p[i]; p[i] = keep + __shfl_xor(send, 8); }
                { const bool up = (F.lane & 4) != 0; const float send = up ? p[0] : p[1], keep = up ? p[1] : p[0]; p[0] = keep + __shfl_xor(send, 4); }
                p[0] += __shfl_xor(p[0], 2); p[0] += __shfl_xor(p[0], 1);
                const int gi = ((F.lane >> 5) & 1) * 8 + ((F.lane >> 4) & 1) * 4 + ((F.lane >> 3) & 1) * 2 + ((F.lane >> 2) & 1);
                if ((F.lane & 3) == 0) ((float*)(F.ws + WS_GATES))[(size_t)row * 16 + gi] = p[0];
            }
        }
    }
}

DI void norm2_phase(Frame& F, const float* xin, const float* gA, const float* shA, const float* scA, int strideA, bf16* outA, const float* gB, const float* shB, const float* scB, int strideB, bf16* outB) {
    const int gw = F.bid * NWAVES + F.wave, NGW = F.G * NWAVES;
    for (int chunk = gw; chunk < T_TOK / 16; chunk += NGW) {
        const int row0 = chunk * 16, b = row0 >> 11;
        f32x4 A1[4], B1[4], A2[4], B2[4];
#pragma unroll
        for (int j = 0; j < 4; ++j) { const int c = 4 * F.lane + 256 * j;
            A1[j] = *(const f32x4*)(gA + c) * (*(const f32x4*)(scA + (size_t)b * strideA + c) + 1.0f); B1[j] = *(const f32x4*)(shA + (size_t)b * strideA + c);
            A2[j] = *(const f32x4*)(gB + c) * (*(const f32x4*)(scB + (size_t)b * strideB + c) + 1.0f); B2[j] = *(const f32x4*)(shB + (size_t)b * strideB + c); }
        for (int r = 0; r < 16; ++r) {
            const int row = row0 + r;
            const f32x4* xr = (const f32x4*)(xin + (size_t)row * DM) + F.lane;
            f32x4 v[4]; float ss = 0.f;
#pragma unroll
            for (int j = 0; j < 4; ++j) { v[j] = xr[64 * j]; ss += (v[j][0] * v[j][0] + v[j][1] * v[j][1]) + (v[j][2] * v[j][2] + v[j][3] * v[j][3]); }
            const float rstd = 1.0f / sqrtf(wave_sum(ss) * (1.0f / DM) + EPS);
            unsigned long long* oa = (unsigned long long*)(outA + (size_t)row * DM) + F.lane; unsigned long long* ob = (unsigned long long*)(outB + (size_t)row * DM) + F.lane;
#pragma unroll
            for (int j = 0; j < 4; ++j) { const f32x4 xn = v[j] * rstd; const f32x4 ya = xn * A1[j] + B1[j], yb = xn * A2[j] + B2[j];
                oa[64 * j] = (unsigned long long)cvtpk(ya[0], ya[1]) | ((unsigned long long)cvtpk(ya[2], ya[3]) << 32);
                ob[64 * j] = (unsigned long long)cvtpk(yb[0], yb[1]) | ((unsigned long long)cvtpk(yb[2], yb[3]) << 32); }
        }
    }
}

DI void mlstm_gates(Frame& F, size_t trow0, int h, float& ipre, float& bcum, float& blast) {
    const float* gates = (const float*)(F.ws + WS_GATES); const float* bif = F.in[8];
    const float iv = gates[(trow0 + F.lane) * 16 + h] + bif[h];
    const float fv = gates[(trow0 + F.lane) * 16 + 8 + h] + bif[8 + h];
    float b = -(fmaxf(-fv, 0.f) + log1pf(expf(-fabsf(fv))));
#pragma unroll
    for (int d = 1; d < 64; d <<= 1) { const float t = __shfl_up(b, d); if (F.lane >= d) b += t; }
    ipre = iv; bcum = b; blast = __shfl(b, 63);
}
template <int MODE> DI void stage_qk(LAS unsigned char* dst, const LAS float* e_s, const bf16* proj, const float* convw, int tseq0, size_t trow0, int col0, int lane) {
    const int g8 = lane >> 3, ch = lane & 7, col = col0 + 8 * ch;
    float cw[4][8];
#pragma unroll
    for (int tap = 0; tap < 4; ++tap) { const f32x4 a = *(const f32x4*)(convw + tap * 1024 + col), b = *(const f32x4*)(convw + tap * 1024 + col + 4);
        cw[tap][0] = a[0]; cw[tap][1] = a[1]; cw[tap][2] = a[2]; cw[tap][3] = a[3]; cw[tap][4] = b[0]; cw[tap][5] = b[1]; cw[tap][6] = b[2]; cw[tap][7] = b[3]; }
#pragma unroll 1
    for (int ph = 0; ph < 2; ++ph) {
        float x[7][8];
#pragma unroll
        for (int i = 0; i < 7; ++i) {
            const int rel = 8 * g8 + 4 * ph + i - 3; const bool valid = (tseq0 + rel) >= 0; const long rr = valid ? (long)rel : 0;
            u32x4 raw = *(const u32x4*)(proj + (size_t)((long)trow0 + rr) * 3072 + col);
            if (!valid) raw = (u32x4){0u, 0u, 0u, 0u};
            x[i][0] = bflo(raw.x); x[i][1] = bfhi(raw.x); x[i][2] = bflo(raw.y); x[i][3] = bfhi(raw.y); x[i][4] = bflo(raw.z); x[i][5] = bfhi(raw.z); x[i][6] = bflo(raw.w); x[i][7] = bfhi(raw.w);
        }
#pragma unroll
        for (int o = 0; o < 4; ++o) {
            const int tok = 8 * g8 + 4 * ph + o;
            float y[8];
#pragma unroll
            for (int e = 0; e < 8; ++e) { float a = cw[0][e] * x[o][e] + cw[1][e] * x[o + 1][e] + cw[2][e] * x[o + 2][e] + cw[3][e] * x[o + 3][e]; y[e] = a / (1.f + __expf(-a)); }
            float sc = 1.f; if (MODE == 0) sc = e_s[tok]; if (MODE == 1) sc = 0.125f;
            u32x4 w; w.x = cvtpk(y[0] * sc, y[1] * sc); w.y = cvtpk(y[2] * sc, y[3] * sc); w.z = cvtpk(y[4] * sc, y[5] * sc); w.w = cvtpk(y[6] * sc, y[7] * sc);
            const int off = (MODE == 0) ? tr_off(tok, ch) : ch * 1024 + tok * 16;
            *(LAS u32x4*)(dst + off) = w;
        }
    }
}
DI void stage_v_half(LAS unsigned char* dst, const bf16* proj, size_t trow0, int col0, int lane) {
    const int g8 = lane >> 3, ch = lane & 7;
#pragma unroll
    for (int o = 0; o < 8; ++o) { const int tok = 8 * g8 + o; const u32x4 raw = *(const u32x4*)(proj + (trow0 + tok) * 3072 + col0 + 8 * ch); *(LAS u32x4*)(dst + tr_off(tok, ch)) = raw; }
}
constexpr int MW_LDS = 17408;

DI void p3_mlstm_local(Frame& F) {
    LAS unsigned char* wl = F.lds + F.wave * MW_LDS;
    LAS unsigned char* kimg = wl; LAS unsigned char* vimg = wl + 8192; LAS float* e_s = (LAS float*)(wl + 16384);
    const bf16* proj = (const bf16*)(F.ws + WS_PROJ);
    bf16* cst = (bf16*)(F.ws + WS_CST);
    const int lane = F.lane, r32 = lane & 31, hi = lane >> 5;
    for (int bu = F.bid; bu < 512; bu += F.G) {
        int h = F.wave; asm volatile("" : "+s"(h));
        const int b = bu >> 5, c = bu & 31; const int unit = bu * 8 + h; const size_t trow0 = (size_t)b * SEQ + c * 64;
        float ipre, bcum, blast; mlstm_gates(F, trow0, h, ipre, bcum, blast);
        const float w = blast - bcum + ipre; const float mloc = wave_max(w); const float e = expf(w - mloc);
        e_s[lane] = e;
        if (lane == 0) { ((float*)(F.ws + WS_BLAST))[unit] = blast; ((float*)(F.ws + WS_MLOC))[unit] = mloc; }
        stage_qk<0>(kimg, e_s, proj, F.in[7], c * 64, trow0, 512 + h * 64, lane);
        bf16x8 kef[2][4];
#pragma unroll
        for (int kt = 0; kt < 2; ++kt)
#pragma unroll
            for (int ks = 0; ks < 4; ++ks) kef[kt][ks] = tr_frag(kimg, kt, ks, lane);
        const bf16x8 ones = {0x3F80, 0x3F80, 0x3F80, 0x3F80, 0x3F80, 0x3F80, 0x3F80, 0x3F80};
#pragma unroll
        for (int kt = 0; kt < 2; ++kt) { f32x16 an = {};
#pragma unroll
            for (int ks = 0; ks < 4; ++ks) an = MFMA32(kef[kt][ks], ones, an);
            if (r32 == 0) {
#pragma unroll
                for (int r = 0; r < 16; ++r) ((float*)(F.ws + WS_NLOC))[(size_t)unit * 64 + 32 * kt + crow(r, hi)] = an[r]; } }
#pragma unroll 1
        for (int vh = 0; vh < 2; ++vh) {
            stage_v_half(vimg, proj, trow0, 1024 + h * 128 + 64 * vh, lane);
#pragma unroll
            for (int vt = 0; vt < 2; ++vt) {
                bf16x8 vf[4];
#pragma unroll
                for (int ks = 0; ks < 4; ++ks) vf[ks] = tr_frag(vimg, vt, ks, lane);
#pragma unroll
                for (int kt = 0; kt < 2; ++kt) { f32x16 acc = {};
#pragma unroll
                    for (int ks = 0; ks < 4; ++ks) acc = MFMA32(kef[kt][ks], vf[ks], acc);
                    bf16* dstp = cst + ((size_t)unit * 128 + 64 * vh + 32 * vt + r32) * 64 + 32 * kt + 4 * hi;
#pragma unroll
                    for (int rg = 0; rg < 4; ++rg) { u32x2 pk; pk.x = cvtpk(acc[4 * rg], acc[4 * rg + 1]); pk.y = cvtpk(acc[4 * rg + 2], acc[4 * rg + 3]); *(u32x2*)(dstp + 8 * rg) = pk; }
                }
            }
        }
    }
}
DI void p4_scan(Frame& F) {
    const int gt = F.bid * NT + F.tid, NGT = F.G * NT;
    const float* mlocp = (const float*)(F.ws + WS_MLOC); const float* blastp = (const float*)(F.ws + WS_BLAST);
    for (int item = gt; item < 128 * 1024; item += NGT) {
        const int bh = item >> 10, e8 = item & 1023, b = bh >> 3, h = bh & 7;
        float st[8]; float m = 0.f;
#pragma unroll
        for (int i = 0; i < 8; ++i) st[i] = 0.f;
        u32x4* p0 = (u32x4*)((bf16*)(F.ws + WS_CST) + (size_t)((b * 32) * 8 + h) * 8192) + e8;
        const int u0 = (b * 32) * 8 + h;
#pragma unroll 1
        for (int c0 = 0; c0 < 32; c0 += 8) {
            u32x4 raw[8]; float ml[8], bl[8];
#pragma unroll
            for (int j = 0; j < 8; ++j) { raw[j] = p0[(size_t)(c0 + j) * 8192]; ml[j] = mlocp[u0 + (c0 + j) * 8]; bl[j] = blastp[u0 + (c0 + j) * 8]; }
#pragma unroll
            for (int j = 0; j < 8; ++j) {
                u32x4 o; o.x = cvtpk(st[0], st[1]); o.y = cvtpk(st[2], st[3]); o.z = cvtpk(st[4], st[5]); o.w = cvtpk(st[6], st[7]); p0[(size_t)(c0 + j) * 8192] = o;
                const float mn = fmaxf(bl[j] + m, ml[j]), a = __expf(bl[j] + m - mn), r = __expf(ml[j] - mn);
                st[0] = a * st[0] + r * bflo(raw[j].x); st[1] = a * st[1] + r * bfhi(raw[j].x); st[2] = a * st[2] + r * bflo(raw[j].y); st[3] = a * st[3] + r * bfhi(raw[j].y);
                st[4] = a * st[4] + r * bflo(raw[j].z); st[5] = a * st[5] + r * bfhi(raw[j].z); st[6] = a * st[6] + r * bflo(raw[j].w); st[7] = a * st[7] + r * bfhi(raw[j].w);
                m = mn;
            }
        }
    }
    for (int item = gt; item < 128 * 64; item += NGT) {
        const int bh = item >> 6, k = item & 63, b = bh >> 3, h = bh & 7;
        float ns = 0.f, m = 0.f;
        const int u0 = (b * 32) * 8 + h;
#pragma unroll 1
        for (int c0 = 0; c0 < 32; c0 += 8) {
            float nl[8], ml[8], bl[8];
#pragma unroll
            for (int j = 0; j < 8; ++j) { const int unit = u0 + (c0 + j) * 8; nl[j] = ((const float*)(F.ws + WS_NLOC))[(size_t)unit * 64 + k]; ml[j] = mlocp[unit]; bl[j] = blastp[unit]; }
#pragma unroll
            for (int j = 0; j < 8; ++j) { const int unit = u0 + (c0 + j) * 8;
                ((float*)(F.ws + WS_NLOC))[(size_t)unit * 64 + k] = ns; if (k == 0) ((float*)(F.ws + WS_MPREV))[unit] = m;
                const float mn = fmaxf(bl[j] + m, ml[j]), a = __expf(bl[j] + m - mn), r = __expf(ml[j] - mn);
                ns = a * ns + r * nl[j]; m = mn; }
        }
    }
}
DI void p5_mlstm_out(Frame& F) {
    LAS unsigned char* wl = F.lds + F.wave * MW_LDS;
    LAS unsigned char* qimg = wl; LAS unsigned char* kimg = wl + 8192; LAS float* sc = (LAS float*)(wl + 16384);
    const bf16* proj = (const bf16*)(F.ws + WS_PROJ);
    const bf16* cst = (const bf16*)(F.ws + WS_CST);
    bf16* hh = (bf16*)(F.ws + WS_H);
    for (int bu = F.bid; bu < 512; bu += F.G) {
        int lane = F.lane; asm volatile("" : "+v"(lane)); const int r32 = lane & 31, hi = lane >> 5;
        int h = F.wave; asm volatile("" : "+s"(h));
        const int b = bu >> 5, c = bu & 31; const int unit = bu * 8 + h; const size_t trow0 = (size_t)b * SEQ + c * 64;
        {
            float ipre, bcum, blast; mlstm_gates(F, trow0, h, ipre, bcum, blast);
            const float mprev = ((const float*)(F.ws + WS_MPREV))[unit];
            const float gg = ipre - bcum; float pm = gg;
#pragma unroll
            for (int d = 1; d < 64; d <<= 1) { const float t = __shfl_up(pm, d); if (lane >= d) pm = fmaxf(pm, t); }
            const float Mx = fmaxf(mprev, pm), mt = bcum + Mx;
            sc[lane] = gg; sc[64 + lane] = Mx; sc[128 + lane] = expf(mprev - Mx); sc[192 + lane] = expf(-mt);
        }
#pragma unroll 1
        for (int lt = 0; lt < 2; ++lt) {
            const int l = 32 * lt + r32;
            const size_t t = trow0 + l;
            stage_qk<1>(qimg, nullptr, proj, F.in[7], c * 64, trow0, h * 64, lane);
            stage_qk<2>(kimg, nullptr, proj, F.in[7], c * 64, trow0, 512 + h * 64, lane);
            asm volatile("" ::: "memory"); __builtin_amdgcn_sched_barrier(0);
            bf16x8 cf[4][4];
#pragma unroll
            for (int vt = 0; vt < 4; ++vt)
#pragma unroll
                for (int ks = 0; ks < 4; ++ks) cf[vt][ks] = *(const bf16x8*)(cst + ((size_t)unit * 128 + 32 * vt + r32) * 64 + 16 * ks + 8 * hi);
            bf16x8 qf[4];
#pragma unroll
            for (int ks = 0; ks < 4; ++ks) qf[ks] = row_frag<64>(qimg, lt, ks, lane);
            const float Mxl = sc[64 + l];
            bf16x8 P[2][2]; float dsum = 0.f;
#pragma unroll
            for (int st = 0; st < 2; ++st) {
                P[st][0] = (bf16x8){0, 0, 0, 0, 0, 0, 0, 0}; P[st][1] = P[st][0];
                if (st <= lt) {
                    f32x16 acc = {};
#pragma unroll
                    for (int ks = 0; ks < 4; ++ks) acc = MFMA32(row_frag<64>(kimg, st, ks, lane), qf[ks], acc);
#pragma unroll
                    for (int r = 0; r < 16; ++r) { const int srow = crow(r, hi); float val = acc[r] * __expf(sc[32 * st + srow] - Mxl); if (st == lt && srow > r32) val = 0.f; acc[r] = val; dsum += val; }
                    P[st][0] = pack8(acc, 0); P[st][1] = pack8(acc, 1);
                }
            }
            float nq;
            { const float* np = (const float*)(F.ws + WS_NLOC) + (size_t)unit * 64; float s = 0.f;
#pragma unroll
              for (int ks = 0; ks < 4; ++ks) { const f32x4 n0 = *(const f32x4*)(np + 16 * ks + 8 * hi), n1 = *(const f32x4*)(np + 16 * ks + 8 * hi + 4); const u32x4 q = __builtin_bit_cast(u32x4, qf[ks]);
                  s += bflo(q.x) * n0[0] + bfhi(q.x) * n0[1] + bflo(q.y) * n0[2] + bfhi(q.y) * n0[3] + bflo(q.z) * n1[0] + bfhi(q.z) * n1[1] + bflo(q.w) * n1[2] + bfhi(q.w) * n1[3]; }
              nq = s + __shfl_xor(s, 32); }
            asm volatile("s_waitcnt lgkmcnt(0)" ::: "memory");
            stage_v_half(wl, proj, trow0, 1024 + h * 128, lane); stage_v_half(wl + 8192, proj, trow0, 1024 + h * 128 + 64, lane);
            f32x16 acc[4];
#pragma unroll
            for (int vt = 0; vt < 4; ++vt) { acc[vt] = (f32x16){};
#pragma unroll
                for (int ks = 0; ks < 4; ++ks) acc[vt] = MFMA32(cf[vt][ks], qf[ks], acc[vt]); }
            const float iwl = sc[128 + l];
#pragma unroll
            for (int vt = 0; vt < 4; ++vt) acc[vt] = acc[vt] * iwl;
#pragma unroll
            for (int st = 0; st < 2; ++st) if (st <= lt) {
#pragma unroll
                for (int k2 = 0; k2 < 2; ++k2) {
#pragma unroll
                    for (int vt = 0; vt < 4; ++vt) acc[vt] = MFMA32(tr_frag(wl + (vt >> 1) * 8192, vt & 1, 2 * st + k2, lane), P[st][k2], acc[vt]); } }
            u32x2 o4[4][4];
#pragma unroll
            for (int vt = 0; vt < 4; ++vt)
#pragma unroll
                for (int rg = 0; rg < 4; ++rg) o4[vt][rg] = *(const u32x2*)(proj + t * 3072 + 2048 + h * 128 + 32 * vt + 8 * rg + 4 * hi);
            const float den = dsum + __shfl_xor(dsum, 32) + iwl * nq;
            const float inv = 1.0f / fmaxf(fabsf(den), sc[192 + l]);
            float ss = 0.f;
#pragma unroll
            for (int vt = 0; vt < 4; ++vt)
#pragma unroll
                for (int r = 0; r < 16; ++r) { const float v = acc[vt][r] * inv; acc[vt][r] = v; ss += v * v; }
            ss += __shfl_xor(ss, 32);
            const float rstd = 1.0f / sqrtf(ss * (1.0f / 128.0f) + EPS);
#pragma unroll
            for (int vt = 0; vt < 4; ++vt)
#pragma unroll
                for (int rg = 0; rg < 4; ++rg) { const int v = 32 * vt + 8 * rg + 4 * hi;
                    const f32x4 g4 = *(const f32x4*)(F.in[9] + h * 128 + v);
                    const float o0 = bflo(o4[vt][rg].x), o1 = bfhi(o4[vt][rg].x), o2 = bflo(o4[vt][rg].y), o3 = bfhi(o4[vt][rg].y);
                    const float y0 = acc[vt][4 * rg] * rstd * g4[0] / (1.f + __expf(-o0)), y1 = acc[vt][4 * rg + 1] * rstd * g4[1] / (1.f + __expf(-o1));
                    const float y2 = acc[vt][4 * rg + 2] * rstd * g4[2] / (1.f + __expf(-o2)), y3 = acc[vt][4 * rg + 3] * rstd * g4[3] / (1.f + __expf(-o3));
                    u32x2 pk; pk.x = cvtpk(y0, y1); pk.y = cvtpk(y2, y3); *(u32x2*)(hh + t * 1024 + h * 128 + v) = pk; }
            asm volatile("s_waitcnt lgkmcnt(0)" ::: "memory");
        }
    }
}

DI float softplus_f(float z) { return fmaxf(z, 0.f) + __logf(1.f + __expf(-fabsf(z))); }
DI void p12_attn(Frame& F) {
    LAS unsigned char* kimg = F.lds; LAS unsigned char* vimg = F.lds + 8192;
    const bf16* Q = (const bf16*)(F.ws + WS_Q); const bf16* K = (const bf16*)(F.ws + WS_K); const bf16* V = (const bf16*)(F.ws + WS_VV);
    bf16* O = (bf16*)(F.ws + WS_H);
    const int lane = F.lane, r32 = lane & 31, hi = lane >> 5, wave = F.wave;
    const int skey = F.tid >> 3, schk = F.tid & 7;
    for (int bh = F.bid; bh < 256; bh += F.G) {
        const int b = bh >> 4, h = bh & 15;
        for (int qb = 7; qb >= 0; --qb) {
            const int qlo = qb * 256 + 32 * wave;
            const size_t tq0 = (size_t)b * SEQ + qlo;
            bf16x8 qr[4];
#pragma unroll
            for (int ks = 0; ks < 4; ++ks) qr[ks] = *(const bf16x8*)(Q + (tq0 + r32) * 1024 + h * 64 + 16 * ks + 8 * hi);
            f32x16 o0 = {}, o1 = {}; float R = 0.f; bool wdone = false;
            const int ntile = 4 * qb + 4;
            u32x4 kraw, vraw;
            { const size_t src = ((size_t)b * SEQ + 64 * (ntile - 1) + skey) * 1024 + h * 64 + 8 * schk; kraw = *(const u32x4*)(K + src); vraw = *(const u32x4*)(V + src); }
            for (int kt = ntile - 1; kt >= 0; --kt) {
                __syncthreads();
                *(LAS u32x4*)(kimg + schk * 1024 + skey * 16) = kraw;
                *(LAS u32x4*)(vimg + tr_off(skey, schk)) = vraw;
                if (kt > 0) { const size_t src = ((size_t)b * SEQ + 64 * (kt - 1) + skey) * 1024 + h * 64 + 8 * schk; kraw = *(const u32x4*)(K + src); vraw = *(const u32x4*)(V + src); }
                if (__syncthreads_and(wdone ? 1 : 0)) break;
                if (!wdone && 64 * kt <= qlo + 30) {
                    f32x16 p0 = {}, p1 = {};
#pragma unroll
                    for (int ks = 0; ks < 4; ++ks) { p0 = MFMA32(row_frag<64>(kimg, 0, ks, lane), qr[ks], p0); p1 = MFMA32(row_frag<64>(kimg, 1, ks, lane), qr[ks], p1); }
                    const bool diag = (64 * kt + 63 >= qlo);
                    const int qrel = qlo + r32 - 64 * kt;
                    float s0[16], s1[16];
#pragma unroll
                    for (int r = 0; r < 16; ++r) { const int kr = crow(r, hi);
                        const bool v0 = !diag || kr < qrel, v1 = !diag || (kr + 32) < qrel;
                        s0[r] = v0 ? softplus_f(p0[r]) : 0.f; s1[r] = v1 ? softplus_f(p1[r]) : 0.f; }
#pragma unroll
                    for (int g = 0; g < 4; ++g) { s0[4 * g + 2] += s0[4 * g + 3]; s0[4 * g + 1] += s0[4 * g + 2]; s0[4 * g] += s0[4 * g + 1];
                                                  s1[4 * g + 2] += s1[4 * g + 3]; s1[4 * g + 1] += s1[4 * g + 2]; s1[4 * g] += s1[4 * g + 1]; }
                    float off0[4], off1[4]; float tot0, tot1;
                    { float og[4], T[4];
#pragma unroll
                      for (int g = 0; g < 4; ++g) og[g] = __shfl_xor(s1[4 * g], 32);
                      T[3] = 0.f; T[2] = s1[12] + og[3]; T[1] = T[2] + s1[8] + og[2]; T[0] = T[1] + s1[4] + og[1]; tot1 = T[0] + s1[0] + og[0];
#pragma unroll
                      for (int g = 0; g < 4; ++g) off1[g] = T[g] + (hi == 0 ? og[g] : 0.f) + R; }
                    { float og[4], T[4];
#pragma unroll
                      for (int g = 0; g < 4; ++g) og[g] = __shfl_xor(s0[4 * g], 32);
                      T[3] = 0.f; T[2] = s0[12] + og[3]; T[1] = T[2] + s0[8] + og[2]; T[0] = T[1] + s0[4] + og[1]; tot0 = T[0] + s0[0] + og[0];
#pragma unroll
                      for (int g = 0; g < 4; ++g) off0[g] = T[g] + (hi == 0 ? og[g] : 0.f) + R + tot1; }
#pragma unroll
                    for (int r = 0; r < 16; ++r) { const int kr = crow(r, hi);
                        const bool v0 = !diag || kr < qrel, v1 = !diag || (kr + 32) < qrel;
                        const float a0 = __expf(p0[r] - s0[r] - off0[r >> 2]), a1 = __expf(p1[r] - s1[r] - off1[r >> 2]);
                        p0[r] = v0 ? a0 : 0.f; p1[r] = v1 ? a1 : 0.f; }
                    R += tot0 + tot1;
                    wdone = __all(R >= 104.0f);
                    const bf16x8 pa0 = pack8(p0, 0), pa1 = pack8(p0, 1), pa2 = pack8(p1, 0), pa3 = pack8(p1, 1);
                    o0 = MFMA32(pa0, tr_frag(vimg, 0, 0, lane), o0); o1 = MFMA32(pa0, tr_frag(vimg, 1, 0, lane), o1);
                    o0 = MFMA32(pa1, tr_frag(vimg, 0, 1, lane), o0); o1 = MFMA32(pa1, tr_frag(vimg, 1, 1, lane), o1);
                    o0 = MFMA32(pa2, tr_frag(vimg, 0, 2, lane), o0); o1 = MFMA32(pa2, tr_frag(vimg, 1, 2, lane), o1);
                    o0 = MFMA32(pa3, tr_frag(vimg, 0, 3, lane), o0); o1 = MFMA32(pa3, tr_frag(vimg, 1, 3, lane), o1);
                }
            }
#pragma unroll
            for (int r = 0; r < 16; ++r) { bf16* op = O + (tq0 + crow(r, hi)) * 1024 + h * 64 + r32;
                op[0] = (bf16)(cvtpk(o0[r], 0.f) & 0xffffu); op[32] = (bf16)(cvtpk(o1[r], 0.f) & 0xffffu); }
        }
    }
}

__device__ constexpr int NET16_A[63] = {0,2,0,1,1,4,6,4,5,5,0,2,2,1,3,3,1,3,5,8,10,8,9,9,12,14,12,13,13,8,10,10,9,11,11,9,11,13,0,4,4,2,6,6,2,6,10,1,5,5,3,7,7,3,7,11,1,3,5,7,9,11,13};
__device__ constexpr int NET16_B[63] = {1,3,2,3,2,5,7,6,7,6,4,6,4,5,7,5,2,4,6,9,11,10,11,10,13,15,14,15,14,12,14,12,13,15,13,10,12,14,8,12,8,10,14,10,4,8,12,9,13,9,11,15,11,5,9,13,2,4,6,8,10,12,14};
__device__ constexpr int BIT16_A[32] = {0,1,2,3,4,5,6,7,0,1,2,3,8,9,10,11,0,1,4,5,8,9,12,13,0,2,4,6,8,10,12,14};
__device__ constexpr int BIT16_B[32] = {8,9,10,11,12,13,14,15,4,5,6,7,12,13,14,15,2,3,6,7,10,11,14,15,1,3,5,7,9,11,13,15};
DI unsigned umax_(unsigned a, unsigned b) { return a > b ? a : b; }
DI unsigned umin_(unsigned a, unsigned b) { return a < b ? a : b; }
DI void sort16(unsigned (&k)[16]) {
#pragma unroll
    for (int c = 0; c < 63; ++c) { const unsigned a = k[NET16_A[c]], b = k[NET16_B[c]]; k[NET16_A[c]] = umax_(a, b); k[NET16_B[c]] = umin_(a, b); }
}
DI void bitonic16(unsigned (&k)[16]) {
#pragma unroll
    for (int c = 0; c < 32; ++c) { const unsigned a = k[BIT16_A[c]], b = k[BIT16_B[c]]; k[BIT16_A[c]] = umax_(a, b); k[BIT16_B[c]] = umin_(a, b); }
}
DI void merge16(unsigned (&x)[16], const unsigned (&y)[16]) {
#pragma unroll
    for (int i = 0; i < 16; ++i) x[i] = umax_(x[i], y[15 - i]);
    bitonic16(x);
}
DI unsigned f2key(float x) { const unsigned b = __float_as_uint(x); return b ^ ((unsigned)((int)b >> 31) | 0x80000000u); }
DI float key2f(unsigned k) { return __uint_as_float(k ^ (~(unsigned)((int)k >> 31) | 0x80000000u)); }

DI void p_route(Frame& F, int layer) {
    LAS unsigned char* simg = F.lds;
    LAS unsigned char* dec = F.lds + 65536 + F.wave * 1024;
    { const u32x4* src = (const u32x4*)((const bf16*)(F.ws + WS_SUBK) + (size_t)layer * 2 * 128 * 128);
      for (int i = F.tid; i < 2 * 128 * 16; i += NT) { const int p = i >> 11, n = (i >> 4) & 127, ch = i & 15; *(LAS u32x4*)(simg + p * 32768 + ch * 2048 + n * 16) = src[i]; } }
    __syncthreads();
    const bf16* PQ = (const bf16*)(F.ws + WS_PQ);
    const int lane = F.lane, r32 = lane & 31, hi = lane >> 5;
    const int gw = F.bid * NWAVES + F.wave, NGW = F.G * NWAVES;
    for (int wu = gw; wu < T_TOK * 8 / 32; wu += NGW) {
        const int row = wu * 32 + r32, t = row >> 3, hd = row & 7;
        unsigned top[2][16];
#pragma unroll
        for (int p = 0; p < 2; ++p) {
            bf16x8 qf[8];
#pragma unroll
            for (int ks = 0; ks < 8; ++ks) qf[ks] = *(const bf16x8*)(PQ + (size_t)t * 2048 + hd * 256 + p * 128 + 16 * ks + 8 * hi);
            unsigned keys[4][16];
#pragma unroll
            for (int nt = 0; nt < 4; ++nt) {
                f32x16 acc = {};
#pragma unroll
                for (int ks = 0; ks < 8; ++ks) acc = MFMA32(*(const LAS bf16x8*)(simg + p * 32768 + (2 * ks + hi) * 2048 + (32 * nt + r32) * 16), qf[ks], acc);
#pragma unroll
                for (int r = 0; r < 16; ++r) keys[nt][r] = (f2key(acc[r]) & 0xFFFFFF80u) | (unsigned)(32 * nt + crow(r, 0)) | (unsigned)(4 * hi);
                sort16(keys[nt]);
            }
            merge16(keys[0], keys[1]); merge16(keys[2], keys[3]); merge16(keys[0], keys[2]);
            unsigned lo[16], up[16];
#pragma unroll
            for (int i = 0; i < 16; ++i) { auto rr = __builtin_amdgcn_permlane32_swap(keys[0][i], keys[0][i], false, false); lo[i] = rr[0]; up[i] = rr[1]; }
#pragma unroll
            for (int i = 0; i < 16; ++i) top[p][i] = umax_(lo[i], up[15 - i]);
            bitonic16(top[p]);
        }
        if (hi == 0) {
            u32x4 w0, w1, w2, w3;
            w0.x = (top[0][0] & 127u) | ((top[0][1] & 127u) << 8) | ((top[0][2] & 127u) << 16) | ((top[0][3] & 127u) << 24);
            w0.y = (top[0][4] & 127u) | ((top[0][5] & 127u) << 8) | ((top[0][6] & 127u) << 16) | ((top[0][7] & 127u) << 24);
            w0.z = (top[0][8] & 127u) | ((top[0][9] & 127u) << 8) | ((top[0][10] & 127u) << 16) | ((top[0][11] & 127u) << 24);
            w0.w = (top[0][12] & 127u) | ((top[0][13] & 127u) << 8) | ((top[0][14] & 127u) << 16) | ((top[0][15] & 127u) << 24);
            w1.x = (top[1][0] & 127u) | ((top[1][1] & 127u) << 8) | ((top[1][2] & 127u) << 16) | ((top[1][3] & 127u) << 24);
            w1.y = (top[1][4] & 127u) | ((top[1][5] & 127u) << 8) | ((top[1][6] & 127u) << 16) | ((top[1][7] & 127u) << 24);
            w1.z = (top[1][8] & 127u) | ((top[1][9] & 127u) << 8) | ((top[1][10] & 127u) << 16) | ((top[1][11] & 127u) << 24);
            w1.w = (top[1][12] & 127u) | ((top[1][13] & 127u) << 8) | ((top[1][14] & 127u) << 16) | ((top[1][15] & 127u) << 24);
            *(LAS u32x4*)(dec + r32 * 32) = w0; *(LAS u32x4*)(dec + r32 * 32 + 16) = w1;
        }
        float av[16], bv[16];
#pragma unroll
        for (int i = 0; i < 16; ++i) { av[i] = key2f(top[0][i] & 0xFFFFFF80u); bv[i] = key2f(top[1][i] & 0xFFFFFF80u); }
        unsigned c0[16], c1[16], c2[16], c3[16];
#pragma unroll
        for (int j = 0; j < 16; ++j) c0[j] = (f2key(av[0] + bv[j]) & 0xFFFFFF00u) | (unsigned)j;
        {
            int n = 0;
#pragma unroll
            for (int i = 1; i < 16; ++i)
#pragma unroll
                for (int j = 0; j < 16; ++j) if ((i + 1) * (j + 1) <= 16) {
                    const unsigned k = (f2key(av[i] + bv[j]) & 0xFFFFFF00u) | (unsigned)(i * 16 + j);
                    if (n < 16) c1[n] = k; else if (n < 32) c2[n - 16] = k; else c3[n - 32] = k;
                    ++n; }
#pragma unroll
            for (int q = 2; q < 16; ++q) c3[q] = 0u;
        }
        sort16(c1); sort16(c2); { const unsigned a = c3[0], b = c3[1]; c3[0] = umax_(a, b); c3[1] = umin_(a, b); }
        merge16(c0, c1); merge16(c2, c3); merge16(c0, c2);
        asm volatile("s_waitcnt lgkmcnt(0)" ::: "memory");
        float gv[16]; unsigned ex[16]; float gs = 0.f;
        const float vmax = key2f(c0[0] & 0xFFFFFF00u);
#pragma unroll
        for (int k = 0; k < 16; ++k) {
            const unsigned code = c0[k] & 255u; const unsigned i = code >> 4, j = code & 15u;
            const unsigned ia = *(const LAS unsigned char*)(dec + r32 * 32 + i), ib = *(const LAS unsigned char*)(dec + r32 * 32 + 16 + j);
            ex[k] = ia * 128u + ib;
            gv[k] = __expf(key2f(c0[k] & 0xFFFFFF00u) - vmax); gs += gv[k];
        }
        const float ginv = 1.0f / gs;
        if (hi == 0) {
            u32x4 e0, e1;
            e0.x = ex[0] | (ex[1] << 16); e0.y = ex[2] | (ex[3] << 16); e0.z = ex[4] | (ex[5] << 16); e0.w = ex[6] | (ex[7] << 16);
            e1.x = ex[8] | (ex[9] << 16); e1.y = ex[10] | (ex[11] << 16); e1.z = ex[12] | (ex[13] << 16); e1.w = ex[14] | (ex[15] << 16);
            u32x4* ip = (u32x4*)((unsigned short*)(F.ws + WS_IDX) + (size_t)row * 16); ip[0] = e0; ip[1] = e1;
        } else {
            f32x4* gp = (f32x4*)((float*)(F.ws + WS_GATE) + (size_t)row * 16);
            gp[0] = (f32x4){gv[0] * ginv, gv[1] * ginv, gv[2] * ginv, gv[3] * ginv}; gp[1] = (f32x4){gv[4] * ginv, gv[5] * ginv, gv[6] * ginv, gv[7] * ginv};
            gp[2] = (f32x4){gv[8] * ginv, gv[9] * ginv, gv[10] * ginv, gv[11] * ginv}; gp[3] = (f32x4){gv[12] * ginv, gv[13] * ginv, gv[14] * ginv, gv[15] * ginv};
        }
    }
}

constexpr float U_SCALE = 32.f, V_SCALE = 4.f;
struct RowBuf { u32x4 r[16]; };
DI void load_rows(RowBuf& rb, const unsigned char* tbl, int idxs, int k0, int lane) {
#pragma unroll
    for (int j = 0; j < 16; ++j) { const int e = __builtin_amdgcn_readlane(idxs, k0 + j); rb.r[j] = *((const u32x4*)(tbl + (size_t)e * 1024) + lane); }
}
DI int udots(const RowBuf& rb, const int (&hq)[4], int lane) {
    int p[16];
#pragma unroll
    for (int j = 0; j < 16; ++j) { int a = __builtin_amdgcn_sdot4((int)rb.r[j].x, hq[0], 0, false); a = __builtin_amdgcn_sdot4((int)rb.r[j].y, hq[1], a, false);
        a = __builtin_amdgcn_sdot4((int)rb.r[j].z, hq[2], a, false); p[j] = __builtin_amdgcn_sdot4((int)rb.r[j].w, hq[3], a, false); }
#pragma unroll
    for (int i = 0; i < 8; ++i) { const bool up = (lane & 8) != 0; const int send = up ? p[i] : p[i + 8], keep = up ? p[i + 8] : p[i]; p[i] = keep + __shfl_xor(send, 8); }
#pragma unroll
    for (int i = 0; i < 4; ++i) { const bool up = (lane & 4) != 0; const int send = up ? p[i] : p[i + 4], keep = up ? p[i + 4] : p[i]; p[i] = keep + __shfl_xor(send, 4); }
#pragma unroll
    for (int i = 0; i < 2; ++i) { const bool up = (lane & 2) != 0; const int send = up ? p[i] : p[i + 2], keep = up ? p[i + 2] : p[i]; p[i] = keep + __shfl_xor(send, 2); }
    { const bool up = (lane & 1) != 0; const int send = up ? p[0] : p[1], keep = up ? p[1] : p[0]; p[0] = keep + __shfl_xor(send, 1); }
    int s = p[0]; s += __shfl_xor(s, 16); s += __shfl_xor(s, 32);
    return s;
}
DI void vaccum(const RowBuf& rb, f32x2_t (&out)[8], float wv, int k0) {
#pragma unroll
    for (int j = 0; j < 16; ++j) { const float wk = __builtin_bit_cast(float, __builtin_amdgcn_readlane(__builtin_bit_cast(int, wv), k0 + j));
        out[0] = __builtin_amdgcn_cvt_pk_f32_fp8((int)rb.r[j].x, false) * wk + out[0]; out[1] = __builtin_amdgcn_cvt_pk_f32_fp8((int)rb.r[j].x, true) * wk + out[1];
        out[2] = __builtin_amdgcn_cvt_pk_f32_fp8((int)rb.r[j].y, false) * wk + out[2]; out[3] = __builtin_amdgcn_cvt_pk_f32_fp8((int)rb.r[j].y, true) * wk + out[3];
        out[4] = __builtin_amdgcn_cvt_pk_f32_fp8((int)rb.r[j].z, false) * wk + out[4]; out[5] = __builtin_amdgcn_cvt_pk_f32_fp8((int)rb.r[j].z, true) * wk + out[5];
        out[6] = __builtin_amdgcn_cvt_pk_f32_fp8((int)rb.r[j].w, false) * wk + out[6]; out[7] = __builtin_amdgcn_cvt_pk_f32_fp8((int)rb.r[j].w, true) * wk + out[7]; }
}
constexpr size_t WS_W = WS_PROJ;
constexpr int UP_LDS = 16384;
DI void up_load_h2(int (&hq)[4], const unsigned char* H2Q, size_t t, int lane) {
    const u32x4 a = *((const u32x4*)(H2Q + t * 1024) + lane); hq[0] = (int)a.x; hq[1] = (int)a.y; hq[2] = (int)a.z; hq[3] = (int)a.w;
}
DI int up_prepare(LAS unsigned* cmp, const LAS unsigned short* lidx, const LAS float* lgate, int tt, int x, int lane) {
    LAS unsigned* c = cmp + (tt & 1) * 384;
    const int i0 = lidx[tt * 128 + lane], i1 = lidx[tt * 128 + 64 + lane];
    const float g0 = lgate[tt * 128 + lane], g1 = lgate[tt * 128 + 64 + lane];
    const bool in0 = (i0 >> 11) == x, in1 = (i1 >> 11) == x;
    const unsigned long long m0 = __ballot(in0), m1 = __ballot(in1);
    const int n0 = __popcll(m0), n = n0 + __popcll(m1);
    const int below0 = __builtin_amdgcn_mbcnt_hi((unsigned)(m0 >> 32), __builtin_amdgcn_mbcnt_lo((unsigned)m0, 0));
    const int below1 = __builtin_amdgcn_mbcnt_hi((unsigned)(m1 >> 32), __builtin_amdgcn_mbcnt_lo((unsigned)m1, 0));
    if (in0) { c[below0] = (unsigned)i0; c[128 + below0] = (unsigned)lane; c[256 + below0] = __float_as_uint(g0); }
    if (in1) { c[n0 + below1] = (unsigned)i1; c[128 + n0 + below1] = (unsigned)(64 + lane); c[256 + n0 + below1] = __float_as_uint(g1); }
    return n;
}
DI void up_issue(RowBuf& R, float& rs, const unsigned char* U, const float* SU, const LAS unsigned* cmp, int tt, int bb, int nn, int x, int lane) {
    const LAS unsigned* c = cmp + (tt & 1) * 384;
    const int pos = 16 * bb + (lane & 15);
    const int first = nn > 0 ? (int)c[0] : (x << 11);
    const int ia = pos < nn ? (int)c[pos & 127] : first;
    load_rows(R, U, ia, 0, lane);
    rs = SU[ia];
}
DI void up_finish(const RowBuf& R, float rs, const int (&hq)[4], float sh, const LAS unsigned* cmp, float* W, size_t t, int tt, int b, int n, int lane) {
    const float d = (float)udots(R, hq, lane) * rs * sh;
    const LAS unsigned* c = cmp + (tt & 1) * 384;
    const int pos = 16 * b + lane;
    if (lane < 16 && pos < n) { const float g = __uint_as_float(c[256 + pos]); W[t * 128 + c[128 + pos]] = g * 0.5f * d * (1.0f + erff(d * 0.70710678118654752f)) * (1.0f / V_SCALE); }
}
constexpr size_t WS_CLAIM = 4096;
DI unsigned xcc_id() { return (unsigned)__builtin_amdgcn_s_getreg((3 << 11) | 20) & 7u; }
DI int claim_unit(Frame& F, int set) {
    LAS int* bc = (LAS int*)(F.lds + LDS_BYTES - 64);
    __syncthreads();
    if (F.tid == 0) {
        unsigned* cnt = (unsigned*)(F.ws + WS_CLAIM) + set * 256;
        const unsigned x0 = xcc_id(); int unit = -1;
        for (unsigned a = 0; a < 8; ++a) { const unsigned sl = (x0 + a) & 7u; const unsigned tk = __hip_atomic_fetch_add(cnt + sl * 32, 1u, __ATOMIC_RELAXED, __HIP_MEMORY_SCOPE_AGENT); if (tk < 32u) { unit = (int)(sl * 32 + tk); break; } }
        bc[0] = unit;
    }
    __syncthreads();
    return bc[0];
}
DI void p_upass(Frame& F, int layer) {
    const unsigned char* U = F.ws + WS_U + (size_t)layer * 16384 * 1024;
    const unsigned char* H2 = F.ws + WS_H2Q; const float* SH = (const float*)(F.ws + WS_SH); const float* SU = (const float*)(F.ws + WS_SU) + (size_t)layer * 16384;
    const unsigned short* IDX = (const unsigned short*)(F.ws + WS_IDX); const float* GATE = (const float*)(F.ws + WS_GATE);
    float* W = (float*)(F.ws + WS_W);
    LAS unsigned char* wl = F.lds + F.wave * UP_LDS;
    LAS unsigned short* lidx = (LAS unsigned short*)wl; LAS float* lgate = (LAS float*)(wl + 4096); LAS unsigned* cmp = (LAS unsigned*)(wl + 12288);
    const int lane = F.lane;
    for (int unit = claim_unit(F, 2 * layer); unit >= 0; unit = claim_unit(F, 2 * layer)) {
    const int x = unit >> 5, jb = unit & 31;
    for (int t0 = jb * 1024 + F.wave * 128; t0 < jb * 1024 + F.wave * 128 + 128; t0 += 16) {
        { const u32x4* si = (const u32x4*)(IDX + (size_t)t0 * 128) + lane;
#pragma unroll
          for (int q = 0; q < 4; ++q) ((LAS u32x4*)lidx)[lane + 64 * q] = si[64 * q];
          const u32x4* sg = (const u32x4*)(GATE + (size_t)t0 * 128) + lane;
#pragma unroll
          for (int q = 0; q < 8; ++q) ((LAS u32x4*)lgate)[lane + 64 * q] = sg[64 * q]; }
        int hq[4], hqN[4]; float sh = SH[t0], shN = SH[t0 + 1];
        up_load_h2(hq, H2, (size_t)t0, lane);
        int tt = 0, b = 0, n = up_prepare(cmp, lidx, lgate, 0, x, lane), nb = n > 16 ? (n + 15) >> 4 : 1;
        RowBuf RA, RB; float sA, sB;
        up_issue(RA, sA, U, SU, cmp, 0, 0, n, x, lane);
        up_load_h2(hqN, H2, (size_t)t0 + 1, lane);
#define UP_STEP(RC, SC, RN, SN) { \
            int ntt = tt, nbb = b + 1, nn = n; bool last = false; \
            if (nbb >= nb) { ntt = tt + 1; nbb = 0; if (ntt < 16) nn = up_prepare(cmp, lidx, lgate, ntt, x, lane); else last = true; } \
            if (!last) up_issue(RN, SN, U, SU, cmp, ntt, nbb, nn, x, lane); \
            up_finish(RC, SC, hq, sh, cmp, W, (size_t)t0 + tt, tt, b, n, lane); \
            if (last) break; \
            if (ntt != tt) { _Pragma("unroll") for (int q = 0; q < 4; ++q) hq[q] = hqN[q]; sh = shN; if (ntt + 1 < 16) { up_load_h2(hqN, H2, (size_t)t0 + ntt + 1, lane); shN = SH[t0 + ntt + 1]; } n = nn; nb = n > 16 ? (n + 15) >> 4 : 1; } \
            tt = ntt; b = nbb; }
        for (;;) { UP_STEP(RA, sA, RB, sB) UP_STEP(RB, sB, RA, sA) }
#undef UP_STEP
    }
    }
}
struct TokBuf { u32x4 r[16]; f32x4 w[4]; };
DI void vp_load(TokBuf& tb, const unsigned char* Vs, const LAS unsigned short* lidx, const LAS float* lw, int tt, int lane) {
    const int g = lane >> 3, c = lane & 7;
    const LAS u32x4* ip = (const LAS u32x4*)(lidx + tt * 128 + 16 * g); const u32x4 ia = ip[0], ib = ip[1];
    const LAS f32x4* wp = (const LAS f32x4*)(lw + tt * 128 + 16 * g); tb.w[0] = wp[0]; tb.w[1] = wp[1]; tb.w[2] = wp[2]; tb.w[3] = wp[3];
    const unsigned e[16] = {ia.x & 0xffffu, ia.x >> 16, ia.y & 0xffffu, ia.y >> 16, ia.z & 0xffffu, ia.z >> 16, ia.w & 0xffffu, ia.w >> 16,
                            ib.x & 0xffffu, ib.x >> 16, ib.y & 0xffffu, ib.y >> 16, ib.z & 0xffffu, ib.z >> 16, ib.w & 0xffffu, ib.w >> 16};
#pragma unroll
    for (int i = 0; i < 16; ++i) tb.r[i] = *(const u32x4*)(Vs + (size_t)e[i] * 128 + c * 16);
}
DI void vp_compute(const TokBuf& tb, Frame& F, const float* g2s, float* xout, size_t t, int x, int lane) {
    f32x2_t out[8];
#pragma unroll
    for (int i = 0; i < 8; ++i) out[i] = (f32x2_t){0.f, 0.f};
#pragma unroll
    for (int i = 0; i < 16; ++i) { const float wk = tb.w[i >> 2][i & 3];
        out[0] = __builtin_amdgcn_cvt_pk_f32_fp8((int)tb.r[i].x, false) * wk + out[0]; out[1] = __builtin_amdgcn_cvt_pk_f32_fp8((int)tb.r[i].x, true) * wk + out[1];
        out[2] = __builtin_amdgcn_cvt_pk_f32_fp8((int)tb.r[i].y, false) * wk + out[2]; out[3] = __builtin_amdgcn_cvt_pk_f32_fp8((int)tb.r[i].y, true) * wk + out[3];
        out[4] = __builtin_amdgcn_cvt_pk_f32_fp8((int)tb.r[i].z, false) * wk + out[4]; out[5] = __builtin_amdgcn_cvt_pk_f32_fp8((int)tb.r[i].z, true) * wk + out[5];
        out[6] = __builtin_amdgcn_cvt_pk_f32_fp8((int)tb.r[i].w, false) * wk + out[6]; out[7] = __builtin_amdgcn_cvt_pk_f32_fp8((int)tb.r[i].w, true) * wk + out[7]; }
    float p[16];
#pragma unroll
    for (int i = 0; i < 8; ++i) { p[2 * i] = out[i].x; p[2 * i + 1] = out[i].y; }
#pragma unroll
    for (int i = 0; i < 8; ++i) { const bool up = (lane & 32) != 0; const float send = up ? p[i] : p[i + 8], keep = up ? p[i + 8] : p[i]; p[i] = keep + __shfl_xor(send, 32); }
#pragma unroll
    for (int i = 0; i < 4; ++i) { const bool up = (lane & 16) != 0; const float send = up ? p[i] : p[i + 4], keep = up ? p[i + 4] : p[i]; p[i] = keep + __shfl_xor(send, 16); }
#pragma unroll
    for (int i = 0; i < 2; ++i) { const bool up = (lane & 8) != 0; const float send = up ? p[i] : p[i + 2], keep = up ? p[i + 2] : p[i]; p[i] = keep + __shfl_xor(send, 8); }
    const int col = 128 * x + 16 * (lane & 7) + 8 * ((lane >> 5) & 1) + 4 * ((lane >> 4) & 1) + 2 * ((lane >> 3) & 1);
    const f32x2_t gg = *(const f32x2_t*)(g2s + col);
    const f32x2_t xv = *(const f32x2_t*)(F.out + t * 1024 + col);
    *(f32x2_t*)(xout + t * 1024 + col) = xv + gg * (f32x2_t){p[0], p[1]};
}
DI void p_vpass(Frame& F, int layer, float* xout) {

    const unsigned short* IDX = (const unsigned short*)(F.ws + WS_IDX); const float* W = (const float*)(F.ws + WS_W);
    const float* mods = (const float*)(F.ws + WS_MODS);
    LAS unsigned char* wl = F.lds + F.wave * UP_LDS;
    LAS unsigned short* lidx = (LAS unsigned short*)wl; LAS float* lw = (LAS float*)(wl + 4096);
    const int lane = F.lane;
    for (int unit = claim_unit(F, 2 * layer + 1); unit >= 0; unit = claim_unit(F, 2 * layer + 1)) {
    const int x = unit >> 5, jb = unit & 31;
    const unsigned char* Vs = F.ws + WS_V + ((size_t)layer * 8 + x) * 16384 * 128;
    for (int t0 = jb * 1024 + F.wave * 128; t0 < jb * 1024 + F.wave * 128 + 128; t0 += 16) {
        const int b = t0 >> 11;
        const float* g2s = mods + ((size_t)layer * 16 + b) * 6144 + 5 * 1024;
        { const u32x4* si = (const u32x4*)(IDX + (size_t)t0 * 128) + lane;
#pragma unroll
          for (int q = 0; q < 4; ++q) ((LAS u32x4*)lidx)[lane + 64 * q] = si[64 * q];
          const u32x4* sg = (const u32x4*)(W + (size_t)t0 * 128) + lane;
#pragma unroll
          for (int q = 0; q < 8; ++q) ((LAS u32x4*)lw)[lane + 64 * q] = sg[64 * q]; }
        TokBuf A, B;
        vp_load(A, Vs, lidx, lw, 0, lane);
#pragma unroll 1
        for (int tt = 0; tt < 16; tt += 2) {
            vp_load(B, Vs, lidx, lw, tt + 1, lane);
            vp_compute(A, F, g2s, xout, (size_t)t0 + tt, x, lane);
            if (tt + 2 < 16) vp_load(A, Vs, lidx, lw, tt + 2, lane);
            vp_compute(B, F, g2s, xout, (size_t)t0 + tt + 1, x, lane);
        }
    }
    }
}
#ifndef DUP
#define DUP -1
#endif
#ifndef PH_MASK
#define PH_MASK 0x3FFFF
#endif

#ifndef N_LAUNCH_MODE
#define N_LAUNCH_MODE 1
#endif
constexpr int NPH = 18;
template <class Epi> DI void run_gemm(Frame& F, const bf16* A, const bf16* Bt, int N, const Epi& E) {
    pg8::Gemm g{A, Bt, T_TOK, N, DM}; pg8::StaticOrder S; S.init(T_TOK, N, F.G, F.bid);
    pg8::gemm_phase<Epi, pg8::StaticOrder, true, true>(F.lds, g, S, E);
}
__global__ void __launch_bounds__(NT, 2) fwd(Args args) {
    extern __shared__ __attribute__((aligned(16))) unsigned char lds_raw[];
    cg::grid_group grid = cg::this_grid();
    Frame F;
    F.lds = (LAS unsigned char*)lds_raw;
#pragma unroll
    for (int i = 0; i < 23; ++i) F.in[i] = args.in[i];
    F.out = args.out; F.ws = args.ws;
    F.tid = threadIdx.x; F.lane = F.tid & 63; F.wave = __builtin_amdgcn_readfirstlane(F.tid >> 6); F.bid = blockIdx.x; F.G = gridDim.x;
    const int lo = args.ph_lo, hi = args.ph_hi;
#define IN(k) (lo <= (k) && (k) < hi)
#define SEAM(k) do { if (IN(k) && IN((k) + 1)) grid.sync(); } while (0)
    float* mods = (float*)(F.ws + WS_MODS);
    bf16* Hb = (bf16*)(F.ws + WS_H);
    if (((PH_MASK >> 0) & 1) && IN(0)) { p0_prologue(F); if (DUP == 0) { grid.sync(); p0_prologue(F); } } SEAM(0);
    if (((PH_MASK >> 1) & 1) && IN(1)) { norm_phase<true>(F, F.in[0], F.in[4], mods, mods + 1024, 6144, Hb); if (DUP == 1) { grid.sync(); norm_phase<true>(F, F.in[0], F.in[4], mods, mods + 1024, 6144, Hb); } } SEAM(1);
    if (((PH_MASK >> 2) & 1) && IN(2)) { pg8::EpiBf16<0> E{(bf16*)(F.ws + WS_PROJ), 3072, nullptr, 0, 0, 1.f}; run_gemm(F, Hb, (const bf16*)(F.ws + WS_WIN), 3072, E); if (DUP == 2) { grid.sync(); run_gemm(F, Hb, (const bf16*)(F.ws + WS_WIN), 3072, E); } } SEAM(2);
    if (((PH_MASK >> 3) & 1) && IN(3)) { p3_mlstm_local(F); if (DUP == 3) { grid.sync(); p3_mlstm_local(F); } } SEAM(3);
    if (((PH_MASK >> 4) & 1) && IN(4)) { p4_scan(F); if (DUP == 4) { grid.sync(); p3_mlstm_local(F); grid.sync(); p4_scan(F); } } SEAM(4);
    if (((PH_MASK >> 5) & 1) && IN(5)) { p5_mlstm_out(F); if (DUP == 5) { grid.sync(); p5_mlstm_out(F); } } SEAM(5);
    if (((PH_MASK >> 6) & 1) && IN(6)) { pg8::EpiResid E{F.in[0], F.out, mods + 2 * 1024, 6144}; run_gemm(F, Hb, (const bf16*)(F.ws + WS_WOUT), 1024, E); if (DUP == 6) { grid.sync(); run_gemm(F, Hb, (const bf16*)(F.ws + WS_WOUT), 1024, E); } } SEAM(6);
    if (((PH_MASK >> 7) & 1) && IN(7)) { norm_phase<false, true>(F, F.out, F.in[5], mods + 3 * 1024, mods + 4 * 1024, 6144, Hb); if (DUP == 7) { grid.sync(); norm_phase<false, true>(F, F.out, F.in[5], mods + 3 * 1024, mods + 4 * 1024, 6144, Hb); } } SEAM(7);
    if (((PH_MASK >> 8) & 1) && IN(8)) { pg8::EpiBf16<0> E{(bf16*)(F.ws + WS_PQ), 2048, nullptr, 0, 0, 1.f}; run_gemm(F, Hb, (const bf16*)(F.ws + WS_WPQ), 2048, E); if (DUP == 8) { grid.sync(); run_gemm(F, Hb, (const bf16*)(F.ws + WS_WPQ), 2048, E); } } SEAM(8);
    if (((PH_MASK >> 9) & 1) && IN(9)) { p_route(F, 0); if (DUP == 9) { grid.sync(); p_route(F, 0); } } SEAM(9);
    if (((PH_MASK >> 10) & 1) && IN(10)) {
        p_upass(F, 0); grid.sync(); p_vpass(F, 0, F.out); grid.sync();
        norm2_phase(F, F.out, F.in[4] + 1024, mods + 16 * 6144, mods + 16 * 6144 + 1024, 6144, Hb, F.in[13], (const float*)(F.ws + WS_KVMODS), (const float*)(F.ws + WS_KVMODS) + 1024, 2048, (bf16*)(F.ws + WS_HB));
    } SEAM(10);
    if (((PH_MASK >> 11) & 1) && IN(11)) {
        { pg8::EpiHeadNorm E{(bf16*)(F.ws + WS_Q), (bf16*)(F.ws + WS_Q), 4, F.in[17], 0.125f, EPS}; run_gemm(F, Hb, (const bf16*)(F.ws + WS_WSQ), 1024, E); }
        { pg8::EpiHeadNorm E{(bf16*)(F.ws + WS_K), (bf16*)(F.ws + WS_VV), 4, F.in[15], 1.0f, EPS}; run_gemm(F, (const bf16*)(F.ws + WS_HB), (const bf16*)(F.ws + WS_WKV), 2048, E);
          if (DUP == 11) { grid.sync(); run_gemm(F, (const bf16*)(F.ws + WS_HB), (const bf16*)(F.ws + WS_WKV), 2048, E); } }
    } SEAM(11);
    if (((PH_MASK >> 12) & 1) && IN(12)) { p12_attn(F); if (DUP == 12) { grid.sync(); p12_attn(F); } } SEAM(12);
    if (((PH_MASK >> 13) & 1) && IN(13)) { pg8::EpiResid E{F.out, F.out, mods + 16 * 6144 + 2 * 1024, 6144}; run_gemm(F, Hb, (const bf16*)(F.ws + WS_WSO), 1024, E); } SEAM(13);
    if (((PH_MASK >> 14) & 1) && IN(14)) { norm_phase<false, true>(F, F.out, F.in[5] + 1024, mods + 16 * 6144 + 3 * 1024, mods + 16 * 6144 + 4 * 1024, 6144, Hb); } SEAM(14);
    if (((PH_MASK >> 15) & 1) && IN(15)) { pg8::EpiBf16<0> E{(bf16*)(F.ws + WS_PQ), 2048, nullptr, 0, 0, 1.f}; run_gemm(F, Hb, (const bf16*)(F.ws + WS_WPQ) + (size_t)2048 * 1024, 2048, E); } SEAM(15);
    if (((PH_MASK >> 16) & 1) && IN(16)) { p_route(F, 1); } SEAM(16);
    if (((PH_MASK >> 17) & 1) && IN(17)) { p_upass(F, 1); grid.sync(); if (DUP == 20) { p_upass(F, 1); grid.sync(); } if (DUP == 21) { p_vpass(F, 1, (float*)(F.ws + WS_Q + 32 * MiB)); grid.sync(); } p_vpass(F, 1, F.out); }
#undef IN
#undef SEAM
}

extern "C" void kernel_launch(void* const* d_in, const int* in_sizes, int n_in, void* d_out, int out_size, void* d_ws, size_t ws_size, hipStream_t stream) {
    static int grid = 0;
    if (grid == 0) {
        int dev = 0, cus = 0, per_cu = 0;
        (void)hipGetDevice(&dev);
        (void)hipDeviceGetAttribute(&cus, hipDeviceAttributeMultiprocessorCount, dev);
        (void)hipFuncSetAttribute((const void*)fwd, hipFuncAttributeMaxDynamicSharedMemorySize, LDS_BYTES);
        (void)hipOccupancyMaxActiveBlocksPerMultiprocessor(&per_cu, (const void*)fwd, NT, LDS_BYTES);
        if (per_cu < 1) { fprintf(stderr, "kernel_launch: occupancy query says %d blocks per CU\n", per_cu); per_cu = 1; }
        grid = cus;
        if (n_in != 23 || ws_size < WS_END) fprintf(stderr, "kernel_launch: unexpected n_in %d / ws_size %zu\n", n_in, ws_size);
        (void)hipGetLastError();
    }
    Args a{};
    for (int i = 0; i < 23; ++i) a.in[i] = (const float*)d_in[i];
    a.out = (float*)d_out; a.ws = (unsigned char*)d_ws;
#if N_LAUNCH_MODE == 1
    a.ph_lo = 0; a.ph_hi = NPH;
    void* kargs[] = {&a};
    hipError_t e = hipLaunchCooperativeKernel((const void*)fwd, dim3(grid), dim3(NT), kargs, LDS_BYTES, stream);
    if (e != hipSuccess) fprintf(stderr, "kernel_launch: cooperative launch failed: %s (grid %d)\n", hipGetErrorString(e), grid);
#else
    for (int p = 0; p < NPH; ++p) { a.ph_lo = p; a.ph_hi = p + 1; hipLaunchKernelGGL(fwd, dim3(grid), dim3(NT), LDS_BYTES, stream, a); }
#endif
}
```

```cpp
#include <hip/hip_runtime.h>
#include <hip/hip_cooperative_groups.h>
#include <cstdio>
#include <cstdint>
namespace cg = cooperative_groups;
#define N_LAUNCH_MODE 1
namespace pg8 {
#define PG8_LAS __attribute__((address_space(3)))
typedef unsigned short bf16_t;
typedef short bf16x8 __attribute__((ext_vector_type(8)));
typedef float f32x4 __attribute__((ext_vector_type(4)));
typedef unsigned u32x4 __attribute__((ext_vector_type(4)));
constexpr int BM = 256, BK = 64, HALF = 128, HTB = HALF * BK * 2  , STAGE_BYTES = 8 * HTB, NXCD = 8, WGM = 8;

__host__ __device__ __forceinline__ int lds_byte(int r, int c) { const int st = (r >> 4) * 2 + (c >> 5), rr = r & 15, cc = c & 31, ob = rr * 64 + cc * 2; return st * 1024 + (ob ^ (((ob >> 9) & 1) << 5)); }
__host__ __device__ __forceinline__ void stage_rc(int b, int& R, int& C) { const int st = b / 1024, sb = b % 1024, swz = sb ^ (((sb >> 9) & 1) << 5); R = (st >> 1) * 16 + swz / 64; C = (st & 1) * 32 + (swz % 64) / 2; }
__host__ __device__ __forceinline__ int perm32(int rho) { const int n = rho >> 4, i = rho & 15; return 8 * (i >> 2) + 4 * n + (i & 3); }

struct Unit { int pm, pn; };
struct Gemm { const bf16_t* A; const bf16_t* Bt; int M, N, K; };

struct StaticOrder {
    int nM, nN, nwg, G, c;
    __host__ __device__ void init(int M, int N, int G_, int c_) { nM = M / BM; nN = N / BM; nwg = nM * nN; G = G_; c = c_; }
    __host__ __device__ bool next(int i, Unit& u) const {
        const long L = (long)i * G + c; if (L >= nwg) return false;
        int wgid = (int)L; { const int q = nwg / NXCD, r = nwg % NXCD, xcd = wgid % NXCD, off = wgid / NXCD; wgid = (xcd < r ? xcd * (q + 1) : r * (q + 1) + (xcd - r) * q) + off; }
        const int nig = WGM * nN, gid = wgid / nig, fm = gid * WGM, gsz = (nM - fm) < WGM ? (nM - fm) : WGM;
        u.pm = fm + ((wgid % nig) % gsz); u.pn = (wgid % nig) / gsz; return true;
    }
    __device__ __forceinline__ void a_ready(const Unit&) const {}
    __device__ __forceinline__ void done(const Unit&) const {}
};

__device__ __forceinline__ unsigned cvt_pk_bf16(float lo, float hi) { unsigned r; asm volatile("v_cvt_pk_bf16_f32 %0, %1, %2" : "=v"(r) : "v"(lo), "v"(hi)); return r; }
typedef float f32x2 __attribute__((ext_vector_type(2)));
__device__ __forceinline__ f32x2 gelu_pk(f32x2 v) {
    const f32x2 av = __builtin_elementwise_abs(v), d = av * 0.2316418882f + 1.0f;
    f32x2 t; t.x = __builtin_amdgcn_rcpf(d.x); t.y = __builtin_amdgcn_rcpf(d.y);
    f32x2 q = t * 0.5307027145f + (-0.7265760135f); q = q * t + 0.7107068705f; q = q * t + (-0.142248368f); q = q * t + 0.127414796f; q = q * t;
    const f32x2 s = (v * v) * (-0.72134752044f);
    f32x2 e; e.x = __builtin_amdgcn_exp2f(s.x); e.y = __builtin_amdgcn_exp2f(s.y);
    const f32x2 m = v * (q * e), r = v - m;
    f32x2 o; o.x = v.x < 0.f ? m.x : r.x; o.y = v.y < 0.f ? m.y : r.y; return o;
}

template <int ACT  > struct EpiBf16 {
    static constexpr bool PERM = true, AFTER_DRAIN = false; static_assert(ACT == 0 || ACT == 1, "EpiBf16: ACT is 0 (none) or 1 (gelu_pk)");
    bf16_t* O; int ldc; const float* bias; int split_cols; size_t split_stride; float scale0;
    __device__ __forceinline__ void operator()(const f32x4 (&acc)[2][2][4][2], const Unit& u, int wr, int wc, int fr, int fq) const {
        const int row0 = u.pm * BM + wr * 64 + fr; int colt = u.pn * BM; bf16_t* base = O;
        float sc = 1.f; if (split_cols) { const int t = colt / split_cols; base += (size_t)t * split_stride; colt -= t * split_cols; if (t == 0) sc = scale0; }
        const int col0 = colt + wc * 32 + 8 * fq, bcol0 = u.pn * BM + wc * 32 + 8 * fq;
        f32x4 bv[2][2];
#pragma unroll
        for (int bj = 0; bj < 2; ++bj)
#pragma unroll
            for (int n = 0; n < 2; ++n) bv[bj][n] = bias ? *(const f32x4*)(bias + bcol0 + bj * HALF + 4 * n) : (f32x4){0.f, 0.f, 0.f, 0.f};
#pragma unroll
        for (int ai = 0; ai < 2; ++ai)
#pragma unroll
            for (int m = 0; m < 4; ++m) { bf16_t* rowp = base + (size_t)(row0 + ai * HALF + m * 16) * ldc + col0;
#pragma unroll
                for (int bj = 0; bj < 2; ++bj) { f32x4 v0 = acc[ai][bj][m][0] + bv[bj][0], v1 = acc[ai][bj][m][1] + bv[bj][1];
                    if (ACT == 1) { f32x2 a = gelu_pk((f32x2){v0[0], v0[1]}), b = gelu_pk((f32x2){v0[2], v0[3]}), c = gelu_pk((f32x2){v1[0], v1[1]}), d = gelu_pk((f32x2){v1[2], v1[3]});
                        v0 = (f32x4){a.x, a.y, b.x, b.y}; v1 = (f32x4){c.x, c.y, d.x, d.y}; }
                    v0 = v0 * sc; v1 = v1 * sc; u32x4 w; w.x = cvt_pk_bf16(v0[0], v0[1]); w.y = cvt_pk_bf16(v0[2], v0[3]); w.z = cvt_pk_bf16(v1[0], v1[1]); w.w = cvt_pk_bf16(v1[2], v1[3]);
                    *(u32x4*)(rowp + bj * HALF) = w; } }
    }
};
struct EpiResid {
    static constexpr bool PERM = false, AFTER_DRAIN = false;
    const float* base; float* out; const float* gate; int gstride;
    __device__ __forceinline__ void operator()(const f32x4 (&acc)[2][2][4][2], const Unit& u, int wr, int wc, int fr, int fq) const {
        const int col0 = u.pn * BM + wc * 32 + 4 * fq;
        const int b = (u.pm * BM) >> 11;
        f32x4 gv[2][2];
#pragma unroll
        for (int bj = 0; bj < 2; ++bj)
#pragma unroll
            for (int n = 0; n < 2; ++n) gv[bj][n] = *(const f32x4*)(gate + (size_t)b * gstride + col0 + bj * HALF + n * 16);
#pragma unroll
        for (int ai = 0; ai < 2; ++ai)
#pragma unroll
            for (int m = 0; m < 4; ++m) { const size_t off = (size_t)(u.pm * BM + ai * HALF + wr * 64 + m * 16 + fr) * 1024 + col0;
#pragma unroll
                for (int bj = 0; bj < 2; ++bj)
#pragma unroll
                    for (int n = 0; n < 2; ++n) { const f32x4 bs = *(const f32x4*)(base + off + bj * HALF + n * 16);
                        *(f32x4*)(out + off + bj * HALF + n * 16) = bs + gv[bj][n] * acc[ai][bj][m][n]; }
                if (m & 1) asm volatile("" ::: "memory"); }
    }
};
struct EpiHeadNorm {
    static constexpr bool PERM = true, AFTER_DRAIN = false;
    bf16_t* O0; bf16_t* O1; int ntile_norm; const float* g; float scale; float eps;
    __device__ __forceinline__ void operator()(const f32x4 (&acc)[2][2][4][2], const Unit& u, int wr, int wc, int fr, int fq) const {
        const bool nrm = u.pn < ntile_norm; bf16_t* O = nrm ? O0 : O1; const int pnl = nrm ? u.pn : u.pn - ntile_norm;
        f32x4 gv[2][2];
#pragma unroll
        for (int bj = 0; bj < 2; ++bj)
#pragma unroll
            for (int n = 0; n < 2; ++n) { const f32x4 t = *(const f32x4*)(g + 32 * bj + 8 * fq + 4 * n); gv[bj][n] = nrm ? t * scale : (f32x4){1.f, 1.f, 1.f, 1.f}; }
#pragma unroll
        for (int ai = 0; ai < 2; ++ai)
#pragma unroll
            for (int m = 0; m < 4; ++m) {
                float ss = 0.f;
#pragma unroll
                for (int bj = 0; bj < 2; ++bj)
#pragma unroll
                    for (int n = 0; n < 2; ++n) { const f32x4 x = acc[ai][bj][m][n]; ss += (x[0] * x[0] + x[1] * x[1]) + (x[2] * x[2] + x[3] * x[3]); }
                ss += __shfl_xor(ss, 16); ss += __shfl_xor(ss, 32);
                const float rs = nrm ? 1.0f / sqrtf(ss * (1.0f / 64.0f) + eps) : 1.0f;
                bf16_t* rowp = O + (size_t)(u.pm * BM + ai * HALF + wr * 64 + m * 16 + fr) * 1024 + pnl * BM + wc * 64 + 8 * fq;
#pragma unroll
                for (int bj = 0; bj < 2; ++bj) { const f32x4 v0 = acc[ai][bj][m][0] * rs * gv[bj][0], v1 = acc[ai][bj][m][1] * rs * gv[bj][1];
                    u32x4 w; w.x = cvt_pk_bf16(v0[0], v0[1]); w.y = cvt_pk_bf16(v0[2], v0[3]); w.z = cvt_pk_bf16(v1[0], v1[1]); w.w = cvt_pk_bf16(v1[2], v1[3]);
                    *(u32x4*)(rowp + bj * 32) = w; }
            }
    }
};
template <class Epi, class Sched, bool ALIGN_EPI = false, bool SP2 = false>
__device__ __forceinline__ void gemm_phase(PG8_LAS unsigned char* lds, const Gemm g, const Sched& S, const Epi& E) {
    const int tid = threadIdx.x, wid = __builtin_amdgcn_readfirstlane(tid >> 6), lane = tid & 63, wr = wid >> 2, wc = wid & 3, fr = lane & 15, fq = lane >> 4;
    const int K = g.K, nt = K / BK;
    unsigned voffA[2], voffB[2];
#pragma unroll
    for (int i = 0; i < 2; ++i) { int R, C; stage_rc(tid * 16 + i * 8192, R, C); const int Rb = Epi::PERM ? ((R & ~31) + perm32(R & 31)) : R;
        voffA[i] = (unsigned)(R * K + C) * 2u; voffB[i] = (unsigned)(Rb * K + C) * 2u; }
    const size_t kstep = (size_t)(BK * 2);
    const size_t hstep = (size_t)HALF * K * 2;
    const size_t tstep = 2 * hstep;
    const unsigned ldsw = (unsigned)wid * 1024u;
    const int aoff = lds_byte(wr * 64 + fr, fq * 8), boff = lds_byte(wc * 32 + fr, fq * 8);
#define PG8_SA(b, h) (((b) * 2 + (h)) * HTB)
#define PG8_SB(b, h) ((4 + (b) * 2 + (h)) * HTB)
#define PG8_STAGE(bufoff, gbase, voff) do { _Pragma("unroll") for (int _i = 0; _i < 2; ++_i) \
        __builtin_amdgcn_global_load_lds((const unsigned*)((const char*)(gbase) + (voff)[_i]), (PG8_LAS unsigned*)(lds + (bufoff) + ldsw + _i * 8192), 16, 0, 0); } while (0)
#define PG8_LDA(dst, b, h) do { _Pragma("unroll") for (int m = 0; m < 4; ++m) _Pragma("unroll") for (int k = 0; k < 2; ++k) dst[m][k] = *(const PG8_LAS bf16x8*)(lds + PG8_SA(b, h) + aoff + m * 2048 + k * 1024); } while (0)
#define PG8_LDB(dst, b, h) do { _Pragma("unroll") for (int n = 0; n < 2; ++n) _Pragma("unroll") for (int k = 0; k < 2; ++k) dst[n][k] = *(const PG8_LAS bf16x8*)(lds + PG8_SB(b, h) + boff + n * 2048 + k * 1024); } while (0)
#define PG8_MMA(ai, bj, At, Bt) do { __builtin_amdgcn_s_setprio(1); _Pragma("unroll") for (int m = 0; m < 4; ++m) _Pragma("unroll") for (int n = 0; n < 2; ++n) _Pragma("unroll") for (int k = 0; k < 2; ++k) \
        acc[ai][bj][m][n] = __builtin_amdgcn_mfma_f32_16x16x32_bf16(Bt[n][k], At[m][k], acc[ai][bj][m][n], 0, 0, 0); __builtin_amdgcn_s_setprio(0); } while (0)
#define PG8_WAIT_V(n) asm volatile("s_waitcnt vmcnt(" #n ")" ::: "memory")
#define PG8_WAIT_L(n) asm volatile("s_waitcnt lgkmcnt(" #n ")" ::: "memory")
#define PG8_BAR __builtin_amdgcn_s_barrier()
#define PG8_SCHED __builtin_amdgcn_sched_barrier(0)
    Unit cur, nxt; int ui = 0;
    if (!S.next(0, cur)) return;
    f32x4 acc[2][2][4][2];
#pragma unroll
    for (int a = 0; a < 2; ++a)
#pragma unroll
        for (int b = 0; b < 2; ++b)
#pragma unroll
            for (int m = 0; m < 4; ++m)
#pragma unroll
                for (int n = 0; n < 2; ++n) acc[a][b][m][n] = (f32x4){0.f, 0.f, 0.f, 0.f};
    bf16x8 At[4][2], B0[2][2], B1[2][2];
    const char* cA = (const char*)g.A + (size_t)cur.pm * tstep; const char* cB = (const char*)g.Bt + (size_t)cur.pn * tstep;
    S.a_ready(cur);
    if constexpr (SP2) {
        PG8_STAGE(PG8_SB(0, 0), cB, voffB); PG8_STAGE(PG8_SB(0, 1), cB + hstep, voffB); PG8_STAGE(PG8_SA(0, 0), cA, voffA); PG8_STAGE(PG8_SA(0, 1), cA + hstep, voffA);
        if (wr == 1) PG8_BAR;
        PG8_WAIT_V(2); PG8_BAR;
        PG8_STAGE(PG8_SB(1, 0), cB + kstep, voffB); PG8_STAGE(PG8_SA(1, 0), cA + kstep, voffA); PG8_STAGE(PG8_SB(1, 1), cB + hstep + kstep, voffB);
        PG8_WAIT_V(6); PG8_BAR;
    } else {
        PG8_STAGE(PG8_SB(0, 0), cB, voffB); PG8_STAGE(PG8_SA(0, 0), cA, voffA); PG8_STAGE(PG8_SB(0, 1), cB + hstep, voffB); PG8_STAGE(PG8_SA(0, 1), cA + hstep, voffA);
        if (wr == 1) PG8_BAR;
        PG8_WAIT_V(4); PG8_BAR;
        PG8_STAGE(PG8_SB(1, 0), cB + kstep, voffB); PG8_STAGE(PG8_SA(1, 0), cA + kstep, voffA); PG8_STAGE(PG8_SB(1, 1), cB + hstep + kstep, voffB);
        PG8_WAIT_V(6); PG8_BAR;
    }
    for (;;) {
        const bool has_next = S.next(ui + 1, nxt);
        const char* nA = has_next ? (const char*)g.A + (size_t)nxt.pm * tstep : cA; const char* nB = has_next ? (const char*)g.Bt + (size_t)nxt.pn * tstep : cB;
        for (int t = 0; t < nt; t += 2) {
            const bool last = (t == nt - 2);
            const char* a1 = cA + (size_t)(t + 1) * kstep;
            const char* a2 = last ? nA : cA + (size_t)(t + 2) * kstep; const char* b2 = last ? nB : cB + (size_t)(t + 2) * kstep;
            const char* a3 = a2 + kstep; const char* b3 = b2 + kstep;
            if (last && has_next) S.a_ready(nxt);
            if constexpr (SP2) {
            PG8_LDB(B0, 0, 0); PG8_LDB(B1, 0, 1); PG8_SCHED; PG8_LDA(At, 0, 0); PG8_STAGE(PG8_SA(1, 1), a1 + hstep, voffA);
            PG8_WAIT_V(8); PG8_WAIT_L(0); PG8_BAR; PG8_MMA(0, 0, At, B0); PG8_MMA(0, 1, At, B1); PG8_BAR; PG8_SCHED;
            PG8_LDA(At, 0, 1); PG8_STAGE(PG8_SB(0, 0), b2, voffB); PG8_STAGE(PG8_SB(0, 1), b2 + hstep, voffB); PG8_STAGE(PG8_SA(0, 0), a2, voffA);
            PG8_WAIT_V(8); PG8_WAIT_L(0); PG8_BAR; PG8_MMA(1, 0, At, B0); PG8_MMA(1, 1, At, B1); PG8_BAR; PG8_SCHED;
            PG8_LDB(B0, 1, 0); PG8_LDB(B1, 1, 1); PG8_SCHED; PG8_LDA(At, 1, 0); PG8_STAGE(PG8_SA(0, 1), a2 + hstep, voffA);
            PG8_WAIT_V(8); PG8_WAIT_L(0); PG8_BAR; PG8_MMA(0, 0, At, B0); PG8_MMA(0, 1, At, B1); PG8_BAR; PG8_SCHED;
            PG8_LDA(At, 1, 1); PG8_STAGE(PG8_SB(1, 0), b3, voffB); PG8_STAGE(PG8_SB(1, 1), b3 + hstep, voffB); PG8_STAGE(PG8_SA(1, 0), a3, voffA);
            PG8_WAIT_V(8); PG8_WAIT_L(0); PG8_BAR; PG8_MMA(1, 0, At, B0); PG8_MMA(1, 1, At, B1); PG8_BAR; PG8_SCHED;
            } else {
            PG8_LDB(B0, 0, 0); PG8_SCHED; PG8_LDA(At, 0, 0); PG8_STAGE(PG8_SA(1, 1), a1 + hstep, voffA);
            PG8_WAIT_L(8); PG8_BAR; PG8_WAIT_L(0); PG8_MMA(0, 0, At, B0); PG8_BAR; PG8_SCHED;
            PG8_LDB(B1, 0, 1); PG8_STAGE(PG8_SB(0, 0), b2, voffB);
            PG8_BAR; PG8_WAIT_L(0); PG8_MMA(0, 1, At, B1); PG8_BAR;
            PG8_LDA(At, 0, 1); PG8_STAGE(PG8_SA(0, 0), a2, voffA);
            PG8_BAR; PG8_WAIT_L(0); PG8_MMA(1, 0, At, B0); PG8_BAR; PG8_SCHED;
            PG8_STAGE(PG8_SB(0, 1), b2 + hstep, voffB);
            PG8_WAIT_V(6); PG8_BAR; PG8_MMA(1, 1, At, B1); PG8_BAR;
            PG8_LDB(B0, 1, 0); PG8_SCHED; PG8_LDA(At, 1, 0); PG8_STAGE(PG8_SA(0, 1), a2 + hstep, voffA);
            PG8_WAIT_L(8); PG8_BAR; PG8_WAIT_L(0); PG8_MMA(0, 0, At, B0); PG8_BAR; PG8_SCHED;
            PG8_LDB(B1, 1, 1); PG8_STAGE(PG8_SB(1, 0), b3, voffB);
            PG8_BAR; PG8_WAIT_L(0); PG8_MMA(0, 1, At, B1); PG8_BAR;
            PG8_LDA(At, 1, 1); PG8_STAGE(PG8_SA(1, 0), a3, voffA);
            PG8_BAR; PG8_WAIT_L(0); PG8_MMA(1, 0, At, B0); PG8_BAR; PG8_SCHED;
            PG8_STAGE(PG8_SB(1, 1), b3 + hstep, voffB);
            PG8_WAIT_V(6); PG8_BAR; PG8_MMA(1, 1, At, B1); PG8_BAR;
            }
        }
        if constexpr (ALIGN_EPI) { if (wr == 0) PG8_BAR; }
        if constexpr (!Epi::AFTER_DRAIN) { E(acc, cur, wr, wc, fr, fq); S.done(cur); }
        if (!has_next) break;
#pragma unroll
        for (int a = 0; a < 2; ++a)
#pragma unroll
            for (int b = 0; b < 2; ++b)
#pragma unroll
                for (int m = 0; m < 4; ++m)
#pragma unroll
                    for (int n = 0; n < 2; ++n) acc[a][b][m][n] = (f32x4){0.f, 0.f, 0.f, 0.f};
        cur = nxt; cA = nA; cB = nB; ++ui;
        if constexpr (ALIGN_EPI) { if (wr == 1) PG8_BAR; }
    }
    PG8_WAIT_V(0);
    if constexpr (!ALIGN_EPI) { if (wr == 0) PG8_BAR; }
    PG8_BAR;
    if constexpr (Epi::AFTER_DRAIN) { E.fused(acc, cur, wr, wc, fr, fq, lds, wid, lane); S.done(cur); }
#undef PG8_SA
#undef PG8_SB
#undef PG8_STAGE
#undef PG8_LDA
#undef PG8_LDB
#undef PG8_MMA
#undef PG8_WAIT_V
#undef PG8_WAIT_L
#undef PG8_BAR
#undef PG8_SCHED
}
}

#define DI __device__ __forceinline__
#define LAS __attribute__((address_space(3)))
typedef unsigned short bf16;
typedef __bf16 bf16x2_t __attribute__((ext_vector_type(2)));
typedef float f32x2_t __attribute__((ext_vector_type(2)));
typedef float f32x4 __attribute__((ext_vector_type(4)));
typedef float f32x16 __attribute__((ext_vector_type(16)));
typedef short bf16x8 __attribute__((ext_vector_type(8)));
typedef short s16x4 __attribute__((ext_vector_type(4)));
typedef unsigned u32x4 __attribute__((ext_vector_type(4)));
typedef unsigned u32x2 __attribute__((ext_vector_type(2)));

constexpr int NT = 512, NWAVES = 8;
constexpr int LDS_BYTES = 147456;
constexpr int T_TOK = 32768, DM = 1024, SEQ = 2048, NB = 16;
constexpr float EPS = 1e-6f;
constexpr size_t MiB = 1u << 20;
constexpr size_t WS_MODS = 1 * MiB, WS_KVMODS = WS_MODS + (size_t)2 * 16 * 6144 * 4;
constexpr size_t WS_GATES = 2 * MiB, WS_BLAST = 4 * MiB, WS_MLOC = 4 * MiB + 65536, WS_MPREV = 4 * MiB + 131072, WS_NLOC = 5 * MiB;
constexpr size_t WS_WG = 6 * MiB, WS_SUBK = 7 * MiB;
constexpr size_t WS_WIN = 8 * MiB, WS_WOUT = 14 * MiB, WS_WKV = 16 * MiB, WS_WSQ = 20 * MiB, WS_WSO = 22 * MiB, WS_WPQ = 24 * MiB;
constexpr size_t WS_IDX = 36 * MiB, WS_GATE = 44 * MiB, WS_SU = 60 * MiB;
constexpr size_t WS_H2Q = 256 * MiB, WS_SH = 288 * MiB + 0;
constexpr size_t WS_U = 64 * MiB, WS_V = 128 * MiB, WS_H = 192 * MiB, WS_HB = 256 * MiB, WS_PROJ = 320 * MiB, WS_END = 512 * MiB;
constexpr size_t WS_CST = WS_HB;
constexpr size_t WS_Q = WS_PROJ, WS_K = WS_PROJ + 64 * MiB, WS_VV = WS_PROJ + 128 * MiB, WS_PQ = WS_PROJ;

struct Args { const float* in[23]; float* out; unsigned char* ws; int ph_lo, ph_hi; };
struct Frame {
    LAS unsigned char* lds;
    const float* in[23]; float* out; unsigned char* ws;
    int tid, lane, wave, bid, G;
};

DI unsigned cvtpk(float lo, float hi) { f32x2_t v = {lo, hi}; bf16x2_t b = __builtin_convertvector(v, bf16x2_t); return __builtin_bit_cast(unsigned, b); }
DI float bflo(unsigned u) { return __uint_as_float(u << 16); }
DI float bfhi(unsigned u) { return __uint_as_float(u & 0xffff0000u); }
DI float wave_sum(float v) {
#pragma unroll
    for (int o = 1; o < 64; o <<= 1) v += __shfl_xor(v, o);
    return v;
}
DI float wave_max(float v) {
#pragma unroll
    for (int o = 1; o < 64; o <<= 1) v = fmaxf(v, __shfl_xor(v, o));
    return v;
}
DI int crow(int r, int hi) { return (r & 3) + 8 * (r >> 2) + 4 * hi; }
#define MFMA32(a, b, c) __builtin_amdgcn_mfma_f32_32x32x16_bf16((a), (b), (c), 0, 0, 0)
typedef short v4i16_t __attribute__((ext_vector_type(4)));
DI s16x4 tr16(const LAS unsigned char* p) { return __builtin_bit_cast(s16x4, __builtin_amdgcn_ds_read_tr16_b64_v4i16((LAS v4i16_t*)p)); }
DI int tr_off(int tok, int ch) { return (ch >> 2) * 4096 + (tok >> 4) * 1024 + (tok & 15) * 64 + (ch & 3) * 16; }
DI bf16x8 tr_frag(const LAS unsigned char* img, int dh, int ks, int lane) {
    const int hi = lane >> 5; const int vb = ((lane >> 4) & 1) * 32 + (lane & 3) * 8 + (4 * hi + ((lane & 15) >> 2)) * 64;
    const s16x4 lo = tr16(img + vb + dh * 4096 + ks * 1024), h2 = tr16(img + vb + dh * 4096 + ks * 1024 + 512);
    return __builtin_shufflevector(lo, h2, 0, 1, 2, 3, 4, 5, 6, 7);
}
template <int NTOK> DI bf16x8 row_frag(const LAS unsigned char* img, int tt, int ks, int lane) {
    const int hi = lane >> 5, r32 = lane & 31;
    return *(const LAS bf16x8*)(img + (2 * ks + hi) * (NTOK * 16) + (32 * tt + r32) * 16);
}
DI bf16x8 pack8(const f32x16& x, int s) {
    u32x4 p; p.x = cvtpk(x[8 * s], x[8 * s + 1]); p.y = cvtpk(x[8 * s + 2], x[8 * s + 3]); p.z = cvtpk(x[8 * s + 4], x[8 * s + 5]); p.w = cvtpk(x[8 * s + 6], x[8 * s + 7]);
    return __builtin_bit_cast(bf16x8, p);
}

DI void p0_ada(Frame& F) {
    LAS float* sil = (LAS float*)F.lds;
    LAS float* red = (LAS float*)(F.lds + 65536);
    const float* c = F.in[1];
    for (int i = F.tid; i < 16 * 1024; i += NT) { const int b = i >> 10, d = i & 1023; const float v = c[i]; sil[d * 16 + b] = v / (1.f + expf(-v)); }
    __syncthreads();
    for (int item = F.bid; item < 224; item += F.G) {
        const float* W; const float* bias; float* out; int N, col0;
        if (item < 192) { const int layer = item / 96, it = item % 96; W = F.in[2] + (size_t)layer * 1024 * 6144; bias = F.in[3] + layer * 6144; N = 6144; col0 = it * 64; out = (float*)(F.ws + WS_MODS) + (size_t)layer * 16 * 6144; }
        else { const int it = item - 192; W = F.in[11]; bias = F.in[12]; N = 2048; col0 = it * 64; out = (float*)(F.ws + WS_KVMODS); }
        float acc[16];
#pragma unroll
        for (int b = 0; b < 16; ++b) acc[b] = 0.f;
        const int d0 = F.wave * 128;
        const float* wp = W + (size_t)d0 * N + col0 + F.lane;
#pragma unroll 4
        for (int d = 0; d < 128; ++d) {
            const float w = wp[(size_t)d * N];
            const LAS f32x4* s4 = (const LAS f32x4*)(sil + (d0 + d) * 16);
            const f32x4 s0 = s4[0], s1 = s4[1], s2 = s4[2], s3 = s4[3];
            acc[0] += w * s0[0]; acc[1] += w * s0[1]; acc[2] += w * s0[2]; acc[3] += w * s0[3];
            acc[4] += w * s1[0]; acc[5] += w * s1[1]; acc[6] += w * s1[2]; acc[7] += w * s1[3];
            acc[8] += w * s2[0]; acc[9] += w * s2[1]; acc[10] += w * s2[2]; acc[11] += w * s2[3];
            acc[12] += w * s3[0]; acc[13] += w * s3[1]; acc[14] += w * s3[2]; acc[15] += w * s3[3];
        }
#pragma unroll
        for (int b = 0; b < 16; ++b) red[(F.wave * 16 + b) * 64 + F.lane] = acc[b];
        __syncthreads();
        for (int i = F.tid; i < 1024; i += NT) { const int b = i >> 6, l = i & 63; float s = 0.f;
#pragma unroll
            for (int w = 0; w < 8; ++w) s += red[(w * 16 + b) * 64 + l];
            out[(size_t)b * N + col0 + l] = s + bias[col0 + l]; }
        __syncthreads();
    }
}
DI void transpose_item(const float* W, int ldw, bf16* WT, int dst_row0, LAS float* scr, int k0, int n0, int lane) {
#pragma unroll 8
    for (int i = 0; i < 32; ++i) { const int kk = 2 * i + (lane >> 5); scr[kk * 33 + (lane & 31)] = W[(size_t)(k0 + kk) * ldw + n0 + (lane & 31)]; }
    asm volatile("s_waitcnt lgkmcnt(0)" ::: "memory");
    const int c = lane & 7;
#pragma unroll
    for (int j = 0; j < 4; ++j) { const int n = (lane >> 3) + 8 * j; const LAS float* s = scr + (8 * c) * 33 + n;
        u32x4 o; o.x = cvtpk(s[0 * 33], s[1 * 33]); o.y = cvtpk(s[2 * 33], s[3 * 33]); o.z = cvtpk(s[4 * 33], s[5 * 33]); o.w = cvtpk(s[6 * 33], s[7 * 33]);
        *(u32x4*)(WT + (size_t)(dst_row0 + n) * 1024 + k0 + 8 * c) = o; }
    asm volatile("s_waitcnt lgkmcnt(0)" ::: "memory");
}
DI int permrow(int c) { return (c & ~255) + 32 * (4 * ((c >> 5) & 1) + ((c >> 6) & 3)) + (c & 31); }
DI void p0_prologue(Frame& F) {
    if (F.bid == 0) for (int i = F.tid; i < 1024; i += NT) ((unsigned*)(F.ws + 4096))[i] = 0u;
    if (F.bid == 0) for (int i = F.tid; i < 4096; i += NT) ((unsigned*)(F.ws + 65536))[i] = 0u;
    p0_ada(F);
    LAS float* scr = (LAS float*)(F.lds + F.wave * 16384);
    const int gw = F.bid * NWAVES + F.wave, NGW = F.G * NWAVES;
    for (int it = gw; it < 6144; it += NGW) {
        int r = it; const float* W; int ldw, ncols; bf16* dst; bool perm;
        if (r < 1536) { W = F.in[6]; ldw = 3088; ncols = 3072; dst = (bf16*)(F.ws + WS_WIN); perm = false; }
        else if ((r -= 1536) < 512) { W = F.in[10]; ldw = 1024; ncols = 1024; dst = (bf16*)(F.ws + WS_WOUT); perm = false; }
        else if ((r -= 512) < 1024) { W = F.in[14]; ldw = 2048; ncols = 2048; dst = (bf16*)(F.ws + WS_WKV); perm = true; }
        else if ((r -= 1024) < 512) { W = F.in[16]; ldw = 1024; ncols = 1024; dst = (bf16*)(F.ws + WS_WSQ); perm = true; }
        else if ((r -= 512) < 512) { W = F.in[18]; ldw = 1024; ncols = 1024; dst = (bf16*)(F.ws + WS_WSO); perm = false; }
        else if ((r -= 512) < 1024) { W = F.in[19]; ldw = 2048; ncols = 2048; dst = (bf16*)(F.ws + WS_WPQ); perm = false; }
        else { r -= 1024; W = F.in[19] + (size_t)1024 * 2048; ldw = 2048; ncols = 2048; dst = (bf16*)(F.ws + WS_WPQ) + (size_t)2048 * 1024; perm = false; }
        const int nblk = ncols / 32, kb = r / nblk, nb = r % nblk, n0 = 32 * nb;
        transpose_item(W, ldw, dst, perm ? permrow(n0) : n0, scr, 64 * kb, n0, F.lane);
    }
    const size_t gt = (size_t)F.bid * NT + F.tid, NGT = (size_t)F.G * NT;
    constexpr size_t TBL16 = (size_t)2 * 16384 * 1024 / 16;
    for (size_t j = gt; j < TBL16; j += NGT) {
        const f32x4* src = (const f32x4*)F.in[22] + 4 * j;
        const f32x4 a = src[0] * 4.f, b = src[1] * 4.f, c2 = src[2] * 4.f, d = src[3] * 4.f;
        int p0 = 0, p1 = 0, p2 = 0, p3 = 0;
        p0 = __builtin_amdgcn_cvt_pk_fp8_f32(a[0], a[1], p0, false); p0 = __builtin_amdgcn_cvt_pk_fp8_f32(a[2], a[3], p0, true);
        p1 = __builtin_amdgcn_cvt_pk_fp8_f32(b[0], b[1], p1, false); p1 = __builtin_amdgcn_cvt_pk_fp8_f32(b[2], b[3], p1, true);
        p2 = __builtin_amdgcn_cvt_pk_fp8_f32(c2[0], c2[1], p2, false); p2 = __builtin_amdgcn_cvt_pk_fp8_f32(c2[2], c2[3], p2, true);
        p3 = __builtin_amdgcn_cvt_pk_fp8_f32(d[0], d[1], p3, false); p3 = __builtin_amdgcn_cvt_pk_fp8_f32(d[2], d[3], p3, true);
        const size_t q = j & 63, e = (j >> 6) & 16383, ly = j >> 20;
        ((u32x4*)(F.ws + WS_V))[(((ly * 8 + (q >> 3)) * 16384 + e) << 3) + (q & 7)] = (u32x4){(unsigned)p0, (unsigned)p1, (unsigned)p2, (unsigned)p3};
    }
    for (int row = gw; row < 2 * 16384; row += NGW) {
        const f32x4* src = (const f32x4*)(F.in[21] + (size_t)row * 1024) + 4 * F.lane;
        const f32x4 a = src[0], b = src[1], c2 = src[2], d = src[3];
        float m = fmaxf(fmaxf(fmaxf(fabsf(a[0]), fabsf(a[1])), fmaxf(fabsf(a[2]), fabsf(a[3]))), fmaxf(fmaxf(fabsf(b[0]), fabsf(b[1])), fmaxf(fabsf(b[2]), fabsf(b[3]))));
        m = fmaxf(m, fmaxf(fmaxf(fmaxf(fabsf(c2[0]), fabsf(c2[1])), fmaxf(fabsf(c2[2]), fabsf(c2[3]))), fmaxf(fmaxf(fabsf(d[0]), fabsf(d[1])), fmaxf(fabsf(d[2]), fabsf(d[3])))));
        m = fmaxf(wave_max(m), 1e-30f);
        const float inv = 127.0f / m;
        auto q4 = [&](const f32x4& v) -> unsigned { const int x0 = (int)rintf(v[0] * inv), x1 = (int)rintf(v[1] * inv), x2 = (int)rintf(v[2] * inv), x3 = (int)rintf(v[3] * inv);
            return (unsigned)(x0 & 255) | ((unsigned)(x1 & 255) << 8) | ((unsigned)(x2 & 255) << 16) | ((unsigned)(x3 & 255) << 24); };
        ((u32x4*)(F.ws + WS_U + (size_t)row * 1024))[F.lane] = (u32x4){q4(a), q4(b), q4(c2), q4(d)};
        if (F.lane == 0) ((float*)(F.ws + WS_SU))[row] = m * (1.0f / 127.0f);
    }
    for (size_t i = gt; i < 65536 / 2; i += NGT) { const float a = F.in[20][2 * i], b = F.in[20][2 * i + 1]; ((unsigned*)(F.ws + WS_SUBK))[i] = cvtpk(a, b); }
    for (size_t i = gt; i < 16 * 1024; i += NGT) { const int g = (int)(i >> 10), k = (int)(i & 1023); ((float*)(F.ws + WS_WG))[i] = F.in[6][(size_t)k * 3088 + 3072 + g]; }
}

template <bool GATES, bool Q8 = false> DI void norm_phase(Frame& F, const float* xin, const float* g, const float* shp, const float* scp, int bstride, bf16* hout) {
    const int gw = F.bid * NWAVES + F.wave, NGW = F.G * NWAVES;
    LAS float* wg = (LAS float*)F.lds;
    if (GATES) { const float* src = (const float*)(F.ws + WS_WG); for (int i = F.tid; i < 16 * 1024 / 4; i += NT) ((LAS f32x4*)wg)[i] = ((const f32x4*)src)[i]; __syncthreads(); }
    for (int chunk = gw; chunk < T_TOK / 16; chunk += NGW) {
        const int row0 = chunk * 16, b = row0 >> 11;
        f32x4 A[4], Bv[4];
#pragma unroll
        for (int j = 0; j < 4; ++j) { const int c = 4 * F.lane + 256 * j; const f32x4 gg = *(const f32x4*)(g + c), sc = *(const f32x4*)(scp + (size_t)b * bstride + c);
            A[j] = gg * (sc + 1.0f); Bv[j] = *(const f32x4*)(shp + (size_t)b * bstride + c); }
        for (int r = 0; r < 16; ++r) {
            const int row = row0 + r;
            const f32x4* xr = (const f32x4*)(xin + (size_t)row * DM) + F.lane;
            f32x4 v[4]; float ss = 0.f;
#pragma unroll
            for (int j = 0; j < 4; ++j) { v[j] = xr[64 * j]; ss += (v[j][0] * v[j][0] + v[j][1] * v[j][1]) + (v[j][2] * v[j][2] + v[j][3] * v[j][3]); }
            const float rstd = 1.0f / sqrtf(wave_sum(ss) * (1.0f / DM) + EPS);
            unsigned long long* o8 = (unsigned long long*)(hout + (size_t)row * DM) + F.lane;
#pragma unroll
            for (int j = 0; j < 4; ++j) { v[j] = v[j] * rstd * A[j] + Bv[j]; o8[64 * j] = (unsigned long long)cvtpk(v[j][0], v[j][1]) | ((unsigned long long)cvtpk(v[j][2], v[j][3]) << 32); }
            if (Q8) {
                float m = 0.f;
#pragma unroll
                for (int j = 0; j < 4; ++j) m = fmaxf(m, fmaxf(fmaxf(fabsf(v[j][0]), fabsf(v[j][1])), fmaxf(fabsf(v[j][2]), fabsf(v[j][3]))));
                m = fmaxf(wave_max(m), 1e-30f);
                const float inv = 127.0f / m;
                unsigned* q8 = (unsigned*)(F.ws + WS_H2Q + (size_t)row * DM) + F.lane;
#pragma unroll
                for (int j = 0; j < 4; ++j) { const int x0 = (int)rintf(v[j][0] * inv), x1 = (int)rintf(v[j][1] * inv), x2 = (int)rintf(v[j][2] * inv), x3 = (int)rintf(v[j][3] * inv);
                    q8[64 * j] = (unsigned)(x0 & 255) | ((unsigned)(x1 & 255) << 8) | ((unsigned)(x2 & 255) << 16) | ((unsigned)(x3 & 255) << 24); }
                if (F.lane == 0) ((float*)(F.ws + WS_SH))[row] = m * (1.0f / 127.0f);
            }
            if (GATES) {
                float p[16];
#pragma unroll
                for (int q = 0; q < 16; ++q) { float s = 0.f;
#pragma unroll
                    for (int j = 0; j < 4; ++j) { const f32x4 w = *(const LAS f32x4*)(wg + q * 1024 + 4 * F.lane + 256 * j); s += (v[j][0] * w[0] + v[j][1] * w[1]) + (v[j][2] * w[2] + v[j][3] * w[3]); }
                    p[q] = s; if ((q & 3) == 3) { asm volatile("" ::: "memory"); __builtin_amdgcn_sched_barrier(0); } }
#pragma unroll
                for (int i = 0; i < 8; ++i) { const bool up = (F.lane & 32) != 0; const float send = up ? p[i] : p[i + 8], keep = up ? p[i + 8] : p[i]; p[i] = keep + __shfl_xor(send, 32); }
#pragma unroll
                for (int i = 0; i < 4; ++i) { const bool up = (F.lane & 16) != 0; const float send = up ? p[i] : p[i + 4], keep = up ? p[i + 4] : p[i]; p[i] = keep + __shfl_xor(send, 16); }
#pragma unroll
                for (int i = 0; i < 2; ++i) { const bool up = (F.lane & 8) != 0; const float send = up ? p[i] : p[i + 2], keep = up ? p[i + 2] : p[i]; p[i] = keep + __shfl_xor(send, 8); }
                { const bool up = (F.lane & 4) != 0; const float send = up ? p[0] : p[1], keep = up ? p[1] : p[0]; p[0] = keep + __shfl_xor(send, 4); }
                p[0] += __shfl_xor(p[0], 2); p[0] += __shfl_xor(p[0], 1);
                const int gi = ((F.lane >> 5) & 1) * 8 + ((F.lane >> 4) & 1) * 4 + ((F.lane >> 3) & 1) * 2 + ((F.lane >> 2) & 1);
                if ((F.lane & 3) == 0) ((float*)(F.ws + WS_GATES))[(size_t)row * 16 + gi] = p[0];
            }
        }
    }
}

DI void norm2_phase(Frame& F, const float* xin, const float* gA, const float* shA, const float* scA, int strideA, bf16* outA, const float* gB, const float* shB, const float* scB, int strideB, bf16* outB) {
    const int gw = F.bid * NWAVES + F.wave, NGW = F.G * NWAVES;
    for (int chunk = gw; chunk < T_TOK / 16; chunk += NGW) {
        const int row0 = chunk * 16, b = row0 >> 11;
        f32x4 A1[4], B1[4], A2[4], B2[4];
#pragma unroll
        for (int j = 0; j < 4; ++j) { const int c = 4 * F.lane + 256 * j;
            A1[j] = *(const f32x4*)(gA + c) * (*(const f32x4*)(scA + (size_t)b * strideA + c) + 1.0f); B1[j] = *(const f32x4*)(shA + (size_t)b * strideA + c);
            A2[j] = *(const f32x4*)(gB + c) * (*(const f32x4*)(scB + (size_t)b * strideB + c) + 1.0f); B2[j] = *(const f32x4*)(shB + (size_t)b * strideB + c); }
        for (int r = 0; r < 16; ++r) {
            const int row = row0 + r;
            const f32x4* xr = (const f32x4*)(xin + (size_t)row * DM) + F.lane;
            f32x4 v[4]; float ss = 0.f;
#pragma unroll
            for (int j = 0; j < 4; ++j) { v[j] = xr[64 * j]; ss += (v[j][0] * v[j][0] + v[j][1] * v[j][1]) + (v[j][2] * v[j][2] + v[j][3] * v[j][3]); }
            const float rstd = 1.0f / sqrtf(wave_sum(ss) * (1.0f / DM) + EPS);
            unsigned long long* oa = (unsigned long long*)(outA + (size_t)row * DM) + F.lane; unsigned long long* ob = (unsigned long long*)(outB + (size_t)row * DM) + F.lane;
#pragma unroll
            for (int j = 0; j < 4; ++j) { const f32x4 xn = v[j] * rstd; const f32x4 ya = xn * A1[j] + B1[j], yb = xn * A2[j] + B2[j];
                oa[64 * j] = (unsigned long long)cvtpk(ya[0], ya[1]) | ((unsigned long long)cvtpk(ya[2], ya[3]) << 32);
                ob[64 * j] = (unsigned long long)cvtpk(yb[0], yb[1]) | ((unsigned long long)cvtpk(yb[2], yb[3]) << 32); }
        }
    }
}

DI void mlstm_gates(Frame& F, size_t trow0, int h, float& ipre, float& bcum, float& blast) {
    const float* gates = (const float*)(F.ws + WS_GATES); const float* bif = F.in[8];
    const float iv = gates[(trow0 + F.lane) * 16 + h] + bif[h];
    const float fv = gates[(trow0 + F.lane) * 16 + 8 + h] + bif[8 + h];
    float b = -(fmaxf(-fv, 0.f) + log1pf(expf(-fabsf(fv))));
#pragma unroll
    for (int d = 1; d < 64; d <<= 1) { const float t = __shfl_up(b, d); if (F.lane >= d) b += t; }
    ipre = iv; bcum = b; blast = __shfl(b, 63);
}
template <int MODE> DI void stage_qk(LAS unsigned char* dst, const LAS float* e_s, const bf16* proj, const float* convw, int tseq0, size_t trow0, int col0, int lane) {
    const int g8 = lane >> 3, ch = lane & 7, col = col0 + 8 * ch;
    float cw[4][8];
#pragma unroll
    for (int tap = 0; tap < 4; ++tap) { const f32x4 a = *(const f32x4*)(convw + tap * 1024 + col), b = *(const f32x4*)(convw + tap * 1024 + col + 4);
        cw[tap][0] = a[0]; cw[tap][1] = a[1]; cw[tap][2] = a[2]; cw[tap][3] = a[3]; cw[tap][4] = b[0]; cw[tap][5] = b[1]; cw[tap][6] = b[2]; cw[tap][7] = b[3]; }
#pragma unroll 1
    for (int ph = 0; ph < 2; ++ph) {
        float x[7][8];
#pragma unroll
        for (int i = 0; i < 7; ++i) {
            const int rel = 8 * g8 + 4 * ph + i - 3; const bool valid = (tseq0 + rel) >= 0; const long rr = valid ? (long)rel : 0;
            u32x4 raw = *(const u32x4*)(proj + (size_t)((long)trow0 + rr) * 3072 + col);
            if (!valid) raw = (u32x4){0u, 0u, 0u, 0u};
            x[i][0] = bflo(raw.x); x[i][1] = bfhi(raw.x); x[i][2] = bflo(raw.y); x[i][3] = bfhi(raw.y); x[i][4] = bflo(raw.z); x[i][5] = bfhi(raw.z); x[i][6] = bflo(raw.w); x[i][7] = bfhi(raw.w);
        }
#pragma unroll
        for (int o = 0; o < 4; ++o) {
            const int tok = 8 * g8 + 4 * ph + o;
            float y[8];
#pragma unroll
            for (int e = 0; e < 8; ++e) { float a = cw[0][e] * x[o][e] + cw[1][e] * x[o + 1][e] + cw[2][e] * x[o + 2][e] + cw[3][e] * x[o + 3][e]; y[e] = a / (1.f + __expf(-a)); }
            float sc = 1.f; if (MODE == 0) sc = e_s[tok]; if (MODE == 1) sc = 0.125f;
            u32x4 w; w.x = cvtpk(y[0] * sc, y[1] * sc); w.y = cvtpk(y[2] * sc, y[3] * sc); w.z = cvtpk(y[4] * sc, y[5] * sc); w.w = cvtpk(y[6] * sc, y[7] * sc);
            const int off = (MODE == 0) ? tr_off(tok, ch) : ch * 1024 + tok * 16;
            *(LAS u32x4*)(dst + off) = w;
        }
    }
}
DI void stage_v_half(LAS unsigned char* dst, const bf16* proj, size_t trow0, int col0, int lane) {
    const int g8 = lane >> 3, ch = lane & 7;
#pragma unroll
    for (int o = 0; o < 8; ++o) { const int tok = 8 * g8 + o; const u32x4 raw = *(const u32x4*)(proj + (trow0 + tok) * 3072 + col0 + 8 * ch); *(LAS u32x4*)(dst + tr_off(tok, ch)) = raw; }
}
constexpr int MW_LDS = 17408;

DI void p3_mlstm_local(Frame& F) {
    LAS unsigned char* wl = F.lds + F.wave * MW_LDS;
    LAS unsigned char* kimg = wl; LAS unsigned char* vimg = wl + 8192; LAS float* e_s = (LAS float*)(wl + 16384);
    const bf16* proj = (const bf16*)(F.ws + WS_PROJ);
    bf16* cst = (bf16*)(F.ws + WS_CST);
    const int lane = F.lane, r32 = lane & 31, hi = lane >> 5;
    for (int bu = F.bid; bu < 512; bu += F.G) {
        int h = F.wave; asm volatile("" : "+s"(h));
        const int b = bu >> 5, c = bu & 31; const int unit = bu * 8 + h; const size_t trow0 = (size_t)b * SEQ + c * 64;
        float ipre, bcum, blast; mlstm_gates(F, trow0, h, ipre, bcum, blast);
        const float w = blast - bcum + ipre; const float mloc = wave_max(w); const float e = expf(w - mloc);
        e_s[lane] = e;
        if (lane == 0) { ((float*)(F.ws + WS_BLAST))[unit] = blast; ((float*)(F.ws + WS_MLOC))[unit] = mloc; }
        stage_qk<0>(kimg, e_s, proj, F.in[7], c * 64, trow0, 512 + h * 64, lane);
        bf16x8 kef[2][4];
#pragma unroll
        for (int kt = 0; kt < 2; ++kt)
#pragma unroll
            for (int ks = 0; ks < 4; ++ks) kef[kt][ks] = tr_frag(kimg, kt, ks, lane);
        const bf16x8 ones = {0x3F80, 0x3F80, 0x3F80, 0x3F80, 0x3F80, 0x3F80, 0x3F80, 0x3F80};
#pragma unroll
        for (int kt = 0; kt < 2; ++kt) { f32x16 an = {};
#pragma unroll
            for (int ks = 0; ks < 4; ++ks) an = MFMA32(kef[kt][ks], ones, an);
            if (r32 == 0) {
#pragma unroll
                for (int r = 0; r < 16; ++r) ((float*)(F.ws + WS_NLOC))[(size_t)unit * 64 + 32 * kt + crow(r, hi)] = an[r]; } }
#pragma unroll 1
        for (int vh = 0; vh < 2; ++vh) {
            stage_v_half(vimg, proj, trow0, 1024 + h * 128 + 64 * vh, lane);
#pragma unroll
            for (int vt = 0; vt < 2; ++vt) {
                bf16x8 vf[4];
#pragma unroll
                for (int ks = 0; ks < 4; ++ks) vf[ks] = tr_frag(vimg, vt, ks, lane);
#pragma unroll
                for (int kt = 0; kt < 2; ++kt) { f32x16 acc = {};
#pragma unroll
                    for (int ks = 0; ks < 4; ++ks) acc = MFMA32(kef[kt][ks], vf[ks], acc);
                    bf16* dstp = cst + ((size_t)unit * 128 + 64 * vh + 32 * vt + r32) * 64 + 32 * kt + 4 * hi;
#pragma unroll
                    for (int rg = 0; rg < 4; ++rg) { u32x2 pk; pk.x = cvtpk(acc[4 * rg], acc[4 * rg + 1]); pk.y = cvtpk(acc[4 * rg + 2], acc[4 * rg + 3]); *(u32x2*)(dstp + 8 * rg) = pk; }
                }
            }
        }
    }
}
DI void p4_scan(Frame& F) {
    const int gt = F.bid * NT + F.tid, NGT = F.G * NT;
    const float* mlocp = (const float*)(F.ws + WS_MLOC); const float* blastp = (const float*)(F.ws + WS_BLAST);
    for (int item = gt; item < 128 * 1024; item += NGT) {
        const int bh = item >> 10, e8 = item & 1023, b = bh >> 3, h = bh & 7;
        float st[8]; float m = 0.f;
#pragma unroll
        for (int i = 0; i < 8; ++i) st[i] = 0.f;
        u32x4* p0 = (u32x4*)((bf16*)(F.ws + WS_CST) + (size_t)((b * 32) * 8 + h) * 8192) + e8;
        const int u0 = (b * 32) * 8 + h;
#pragma unroll 1
        for (int c0 = 0; c0 < 32; c0 += 8) {
            u32x4 raw[8]; float ml[8], bl[8];
#pragma unroll
            for (int j = 0; j < 8; ++j) { raw[j] = p0[(size_t)(c0 + j) * 8192]; ml[j] = mlocp[u0 + (c0 + j) * 8]; bl[j] = blastp[u0 + (c0 + j) * 8]; }
#pragma unroll
            for (int j = 0; j < 8; ++j) {
                u32x4 o; o.x = cvtpk(st[0], st[1]); o.y = cvtpk(st[2], st[3]); o.z = cvtpk(st[4], st[5]); o.w = cvtpk(st[6], st[7]); p0[(size_t)(c0 + j) * 8192] = o;
                const float mn = fmaxf(bl[j] + m, ml[j]), a = __expf(bl[j] + m - mn), r = __expf(ml[j] - mn);
                st[0] = a * st[0] + r * bflo(raw[j].x); st[1] = a * st[1] + r * bfhi(raw[j].x); st[2] = a * st[2] + r * bflo(raw[j].y); st[3] = a * st[3] + r * bfhi(raw[j].y);
                st[4] = a * st[4] + r * bflo(raw[j].z); st[5] = a * st[5] + r * bfhi(raw[j].z); st[6] = a * st[6] + r * bflo(raw[j].w); st[7] = a * st[7] + r * bfhi(raw[j].w);
                m = mn;
            }
        }
    }
    for (int item = gt; item < 128 * 64; item += NGT) {
        const int bh = item >> 6, k = item & 63, b = bh >> 3, h = bh & 7;
        float ns = 0.f, m = 0.f;
        const int u0 = (b * 32) * 8 + h;
#pragma unroll 1
        for (int c0 = 0; c0 < 32; c0 += 8) {
            float nl[8], ml[8], bl[8];
#pragma unroll
            for (int j = 0; j < 8; ++j) { const int unit = u0 + (c0 + j) * 8; nl[j] = ((const float*)(F.ws + WS_NLOC))[(size_t)unit * 64 + k]; ml[j] = mlocp[unit]; bl[j] = blastp[unit]; }
#pragma unroll
            for (int j = 0; j < 8; ++j) { const int unit = u0 + (c0 + j) * 8;
                ((float*)(F.ws + WS_NLOC))[(size_t)unit * 64 + k] = ns; if (k == 0) ((float*)(F.ws + WS_MPREV))[unit] = m;
                const float mn = fmaxf(bl[j] + m, ml[j]), a = __expf(bl[j] + m - mn), r = __expf(ml[j] - mn);
                ns = a * ns + r * nl[j]; m = mn; }
        }
    }
}
DI void p5_mlstm_out(Frame& F) {
    LAS unsigned char* wl = F.lds + F.wave * MW_LDS;
    LAS unsigned char* qimg = wl; LAS unsigned char* kimg = wl + 8192; LAS float* sc = (LAS float*)(wl + 16384);
    const bf16* proj = (const bf16*)(F.ws + WS_PROJ);
    const bf16* cst = (const bf16*)(F.ws + WS_CST);
    bf16* hh = (bf16*)(F.ws + WS_H);
    for (int bu = F.bid; bu < 512; bu += F.G) {
        int lane = F.lane; asm volatile("" : "+v"(lane)); const int r32 = lane & 31, hi = lane >> 5;
        int h = F.wave; asm volatile("" : "+s"(h));
        const int b = bu >> 5, c = bu & 31; const int unit = bu * 8 + h; const size_t trow0 = (size_t)b * SEQ + c * 64;
        {
            float ipre, bcum, blast; mlstm_gates(F, trow0, h, ipre, bcum, blast);
            const float mprev = ((const float*)(F.ws + WS_MPREV))[unit];
            const float gg = ipre - bcum; float pm = gg;
#pragma unroll
            for (int d = 1; d < 64; d <<= 1) { const float t = __shfl_up(pm, d); if (lane >= d) pm = fmaxf(pm, t); }
            const float Mx = fmaxf(mprev, pm), mt = bcum + Mx;
            sc[lane] = gg; sc[64 + lane] = Mx; sc[128 + lane] = expf(mprev - Mx); sc[192 + lane] = expf(-mt);
        }
#pragma unroll 1
        for (int lt = 0; lt < 2; ++lt) {
            const int l = 32 * lt + r32;
            const size_t t = trow0 + l;
            stage_qk<1>(qimg, nullptr, proj, F.in[7], c * 64, trow0, h * 64, lane);
            stage_qk<2>(kimg, nullptr, proj, F.in[7], c * 64, trow0, 512 + h * 64, lane);
            asm volatile("" ::: "memory"); __builtin_amdgcn_sched_barrier(0);
            bf16x8 cf[4][4];
#pragma unroll
            for (int vt = 0; vt < 4; ++vt)
#pragma unroll
                for (int ks = 0; ks < 4; ++ks) cf[vt][ks] = *(const bf16x8*)(cst + ((size_t)unit * 128 + 32 * vt + r32) * 64 + 16 * ks + 8 * hi);
            bf16x8 qf[4];
#pragma unroll
            for (int ks = 0; ks < 4; ++ks) qf[ks] = row_frag<64>(qimg, lt, ks, lane);
            const float Mxl = sc[64 + l];
            bf16x8 P[2][2]; float dsum = 0.f;
#pragma unroll
            for (int st = 0; st < 2; ++st) {
                P[st][0] = (bf16x8){0, 0, 0, 0, 0, 0, 0, 0}; P[st][1] = P[st][0];
                if (st <= lt) {
                    f32x16 acc = {};
#pragma unroll
                    for (int ks = 0; ks < 4; ++ks) acc = MFMA32(row_frag<64>(kimg, st, ks, lane), qf[ks], acc);
#pragma unroll
                    for (int r = 0; r < 16; ++r) { const int srow = crow(r, hi); float val = acc[r] * __expf(sc[32 * st + srow] - Mxl); if (st == lt && srow > r32) val = 0.f; acc[r] = val; dsum += val; }
                    P[st][0] = pack8(acc, 0); P[st][1] = pack8(acc, 1);
                }
            }
            float nq;
            { const float* np = (const float*)(F.ws + WS_NLOC) + (size_t)unit * 64; float s = 0.f;
#pragma unroll
              for (int ks = 0; ks < 4; ++ks) { const f32x4 n0 = *(const f32x4*)(np + 16 * ks + 8 * hi), n1 = *(const f32x4*)(np + 16 * ks + 8 * hi + 4); const u32x4 q = __builtin_bit_cast(u32x4, qf[ks]);
                  s += bflo(q.x) * n0[0] + bfhi(q.x) * n0[1] + bflo(q.y) * n0[2] + bfhi(q.y) * n0[3] + bflo(q.z) * n1[0] + bfhi(q.z) * n1[1] + bflo(q.w) * n1[2] + bfhi(q.w) * n1[3]; }
              nq = s + __shfl_xor(s, 32); }
            asm volatile("s_waitcnt lgkmcnt(0)" ::: "memory");
            stage_v_half(wl, proj, trow0, 1024 + h * 128, lane); stage_v_half(wl + 8192, proj, trow0, 1024 + h * 128 + 64, lane);
            f32x16 acc[4];
#pragma unroll
            for (int vt = 0; vt < 4; ++vt) { acc[vt] = (f32x16){};
#pragma unroll
                for (int ks = 0; ks < 4; ++ks) acc[vt] = MFMA32(cf[vt][ks], qf[ks], acc[vt]); }
            const float iwl = sc[128 + l];
#pragma unroll
            for (int vt = 0; vt < 4; ++vt) acc[vt] = acc[vt] * iwl;
#pragma unroll
            for (int st = 0; st < 2; ++st) if (st <= lt) {
#pragma unroll
                for (int k2 = 0; k2 < 2; ++k2) {
#pragma unroll
                    for (int vt = 0; vt < 4; ++vt) acc[vt] = MFMA32(tr_frag(wl + (vt >> 1) * 8192, vt & 1, 2 * st + k2, lane), P[st][k2], acc[vt]); } }
            u32x2 o4[4][4];
#pragma unroll
            for (int vt = 0; vt < 4; ++vt)
#pragma unroll
                for (int rg = 0; rg < 4; ++rg) o4[vt][rg] = *(const u32x2*)(proj + t * 3072 + 2048 + h * 128 + 32 * vt + 8 * rg + 4 * hi);
            const float den = dsum + __shfl_xor(dsum, 32) + iwl * nq;
            const float inv = 1.0f / fmaxf(fabsf(den), sc[192 + l]);
            float ss = 0.f;
#pragma unroll
            for (int vt = 0; vt < 4; ++vt)
#pragma unroll
                for (int r = 0; r < 16; ++r) { const float v = acc[vt][r] * inv; acc[vt][r] = v; ss += v * v; }
            ss += __shfl_xor(ss, 32);
            const float rstd = 1.0f / sqrtf(ss * (1.0f / 128.0f) + EPS);
#pragma unroll
            for (int vt = 0; vt < 4; ++vt)
#pragma unroll
                for (int rg = 0; rg < 4; ++rg) { const int v = 32 * vt + 8 * rg + 4 * hi;
                    const f32x4 g4 = *(const f32x4*)(F.in[9] + h * 128 + v);
                    const float o0 = bflo(o4[vt][rg].x), o1 = bfhi(o4[vt][rg].x), o2 = bflo(o4[vt][rg].y), o3 = bfhi(o4[vt][rg].y);
                    const float y0 = acc[vt][4 * rg] * rstd * g4[0] / (1.f + __expf(-o0)), y1 = acc[vt][4 * rg + 1] * rstd * g4[1] / (1.f + __expf(-o1));
                    const float y2 = acc[vt][4 * rg + 2] * rstd * g4[2] / (1.f + __expf(-o2)), y3 = acc[vt][4 * rg + 3] * rstd * g4[3] / (1.f + __expf(-o3));
                    u32x2 pk; pk.x = cvtpk(y0, y1); pk.y = cvtpk(y2, y3); *(u32x2*)(hh + t * 1024 + h * 128 + v) = pk; }
            asm volatile("s_waitcnt lgkmcnt(0)" ::: "memory");
        }
    }
}

DI float softplus_f(float z) { return fmaxf(z, 0.f) + __logf(1.f + __expf(-fabsf(z))); }
DI void p12_attn(Frame& F) {
    LAS unsigned char* kimg = F.lds; LAS unsigned char* vimg = F.lds + 8192;
    const bf16* Q = (const bf16*)(F.ws + WS_Q); const bf16* K = (const bf16*)(F.ws + WS_K); const bf16* V = (const bf16*)(F.ws + WS_VV);
    bf16* O = (bf16*)(F.ws + WS_H);
    const int lane = F.lane, r32 = lane & 31, hi = lane >> 5, wave = F.wave;
    const int skey = F.tid >> 3, schk = F.tid & 7;
    for (int bh = F.bid; bh < 256; bh += F.G) {
        const int b = bh >> 4, h = bh & 15;
        for (int qb = 7; qb >= 0; --qb) {
            const int qlo = qb * 256 + 32 * wave;
            const size_t tq0 = (size_t)b * SEQ + qlo;
            bf16x8 qr[4];
#pragma unroll
            for (int ks = 0; ks < 4; ++ks) qr[ks] = *(const bf16x8*)(Q + (tq0 + r32) * 1024 + h * 64 + 16 * ks + 8 * hi);
            f32x16 o0 = {}, o1 = {}; float R = 0.f; bool wdone = false;
            const int ntile = 4 * qb + 4;
            u32x4 kraw, vraw;
            { const size_t src = ((size_t)b * SEQ + 64 * (ntile - 1) + skey) * 1024 + h * 64 + 8 * schk; kraw = *(const u32x4*)(K + src); vraw = *(const u32x4*)(V + src); }
            for (int kt = ntile - 1; kt >= 0; --kt) {
                __syncthreads();
                *(LAS u32x4*)(kimg + schk * 1024 + skey * 16) = kraw;
                *(LAS u32x4*)(vimg + tr_off(skey, schk)) = vraw;
                if (kt > 0) { const size_t src = ((size_t)b * SEQ + 64 * (kt - 1) + skey) * 1024 + h * 64 + 8 * schk; kraw = *(const u32x4*)(K + src); vraw = *(const u32x4*)(V + src); }
                if (__syncthreads_and(wdone ? 1 : 0)) break;
                if (!wdone && 64 * kt <= qlo + 30) {
                    f32x16 p0 = {}, p1 = {};
#pragma unroll
                    for (int ks = 0; ks < 4; ++ks) { p0 = MFMA32(row_frag<64>(kimg, 0, ks, lane), qr[ks], p0); p1 = MFMA32(row_frag<64>(kimg, 1, ks, lane), qr[ks], p1); }
                    const bool diag = (64 * kt + 63 >= qlo);
                    const int qrel = qlo + r32 - 64 * kt;
                    float s0[16], s1[16];
#pragma unroll
                    for (int r = 0; r < 16; ++r) { const int kr = crow(r, hi);
                        const bool v0 = !diag || kr < qrel, v1 = !diag || (kr + 32) < qrel;
                        s0[r] = v0 ? softplus_f(p0[r]) : 0.f; s1[r] = v1 ? softplus_f(p1[r]) : 0.f; }
#pragma unroll
                    for (int g = 0; g < 4; ++g) { s0[4 * g + 2] += s0[4 * g + 3]; s0[4 * g + 1] += s0[4 * g + 2]; s0[4 * g] += s0[4 * g + 1];
                                                  s1[4 * g + 2] += s1[4 * g + 3]; s1[4 * g + 1] += s1[4 * g + 2]; s1[4 * g] += s1[4 * g + 1]; }
                    float off0[4], off1[4]; float tot0, tot1;
                    { float og[4], T[4];
#pragma unroll
                      for (int g = 0; g < 4; ++g) og[g] = __shfl_xor(s1[4 * g], 32);
                      T[3] = 0.f; T[2] = s1[12] + og[3]; T[1] = T[2] + s1[8] + og[2]; T[0] = T[1] + s1[4] + og[1]; tot1 = T[0] + s1[0] + og[0];
#pragma unroll
                      for (int g = 0; g < 4; ++g) off1[g] = T[g] + (hi == 0 ? og[g] : 0.f) + R; }
                    { float og[4], T[4];
#pragma unroll
                      for (int g = 0; g < 4; ++g) og[g] = __shfl_xor(s0[4 * g], 32);
                      T[3] = 0.f; T[2] = s0[12] + og[3]; T[1] = T[2] + s0[8] + og[2]; T[0] = T[1] + s0[4] + og[1]; tot0 = T[0] + s0[0] + og[0];
#pragma unroll
                      for (int g = 0; g < 4; ++g) off0[g] = T[g] + (hi == 0 ? og[g] : 0.f) + R + tot1; }
#pragma unroll
                    for (int r = 0; r < 16; ++r) { const int kr = crow(r, hi);
                        const bool v0 = !diag || kr < qrel, v1 = !diag || (kr + 32) < qrel;
                        const float a0 = __expf(p0[r] - s0[r] - off0[r >> 2]), a1 = __expf(p1[r] - s1[r] - off1[r >> 2]);
                        p0[r] = v0 ? a0 : 0.f; p1[r] = v1 ? a1 : 0.f; }
                    R += tot0 + tot1;
                    wdone = __all(R >= 104.0f);
                    const bf16x8 pa0 = pack8(p0, 0), pa1 = pack8(p0, 1), pa2 = pack8(p1, 0), pa3 = pack8(p1, 1);
                    o0 = MFMA32(pa0, tr_frag(vimg, 0, 0, lane), o0); o1 = MFMA32(pa0, tr_frag(vimg, 1, 0, lane), o1);
                    o0 = MFMA32(pa1, tr_frag(vimg, 0, 1, lane), o0); o1 = MFMA32(pa1, tr_frag(vimg, 1, 1, lane), o1);
                    o0 = MFMA32(pa2, tr_frag(vimg, 0, 2, lane), o0); o1 = MFMA32(pa2, tr_frag(vimg, 1, 2, lane), o1);
                    o0 = MFMA32(pa3, tr_frag(vimg, 0, 3, lane), o0); o1 = MFMA32(pa3, tr_frag(vimg, 1, 3, lane), o1);
                }
            }
#pragma unroll
            for (int r = 0; r < 16; ++r) { bf16* op = O + (tq0 + crow(r, hi)) * 1024 + h * 64 + r32;
                op[0] = (bf16)(cvtpk(o0[r], 0.f) & 0xffffu); op[32] = (bf16)(cvtpk(o1[r], 0.f) & 0xffffu); }
        }
    }
}

__device__ constexpr int NET16_A[63] = {0,2,0,1,1,4,6,4,5,5,0,2,2,1,3,3,1,3,5,8,10,8,9,9,12,14,12,13,13,8,10,10,9,11,11,9,11,13,0,4,4,2,6,6,2,6,10,1,5,5,3,7,7,3,7,11,1,3,5,7,9,11,13};
__device__ constexpr int NET16_B[63] = {1,3,2,3,2,5,7,6,7,6,4,6,4,5,7,5,2,4,6,9,11,10,11,10,13,15,14,15,14,12,14,12,13,15,13,10,12,14,8,12,8,10,14,10,4,8,12,9,13,9,11,15,11,5,9,13,2,4,6,8,10,12,14};
__device__ constexpr int BIT16_A[32] = {0,1,2,3,4,5,6,7,0,1,2,3,8,9,10,11,0,1,4,5,8,9,12,13,0,2,4,6,8,10,12,14};
__device__ constexpr int BIT16_B[32] = {8,9,10,11,12,13,14,15,4,5,6,7,12,13,14,15,2,3,6,7,10,11,14,15,1,3,5,7,9,11,13,15};
DI unsigned umax_(unsigned a, unsigned b) { return a > b ? a : b; }
DI unsigned umin_(unsigned a, unsigned b) { return a < b ? a : b; }
DI void sort16(unsigned (&k)[16]) {
#pragma unroll
    for (int c = 0; c < 63; ++c) { const unsigned a = k[NET16_A[c]], b = k[NET16_B[c]]; k[NET16_A[c]] = umax_(a, b); k[NET16_B[c]] = umin_(a, b); }
}
DI void bitonic16(unsigned (&k)[16]) {
#pragma unroll
    for (int c = 0; c < 32; ++c) { const unsigned a = k[BIT16_A[c]], b = k[BIT16_B[c]]; k[BIT16_A[c]] = umax_(a, b); k[BIT16_B[c]] = umin_(a, b); }
}
DI void merge16(unsigned (&x)[16], const unsigned (&y)[16]) {
#pragma unroll
    for (int i = 0; i < 16; ++i) x[i] = umax_(x[i], y[15 - i]);
    bitonic16(x);
}
DI unsigned f2key(float x) { const unsigned b = __float_as_uint(x); return b ^ ((unsigned)((int)b >> 31) | 0x80000000u); }
DI float key2f(unsigned k) { return __uint_as_float(k ^ (~(unsigned)((int)k >> 31) | 0x80000000u)); }

DI void p_route(Frame& F, int layer) {
    LAS unsigned char* simg = F.lds;
    LAS unsigned char* dec = F.lds + 65536 + F.wave * 1024;
    { const u32x4* src = (const u32x4*)((const bf16*)(F.ws + WS_SUBK) + (size_t)layer * 2 * 128 * 128);
      for (int i = F.tid; i < 2 * 128 * 16; i += NT) { const int p = i >> 11, n = (i >> 4) & 127, ch = i & 15; *(LAS u32x4*)(simg + p * 32768 + ch * 2048 + n * 16) = src[i]; } }
    __syncthreads();
    const bf16* PQ = (const bf16*)(F.ws + WS_PQ);
    const int lane = F.lane, r32 = lane & 31, hi = lane >> 5;
    const int gw = F.bid * NWAVES + F.wave, NGW = F.G * NWAVES;
    for (int wu = gw; wu < T_TOK * 8 / 32; wu += NGW) {
        const int row = wu * 32 + r32, t = row >> 3, hd = row & 7;
        unsigned top[2][16];
#pragma unroll
        for (int p = 0; p < 2; ++p) {
            bf16x8 qf[8];
#pragma unroll
            for (int ks = 0; ks < 8; ++ks) qf[ks] = *(const bf16x8*)(PQ + (size_t)t * 2048 + hd * 256 + p * 128 + 16 * ks + 8 * hi);
            unsigned keys[4][16];
#pragma unroll
            for (int nt = 0; nt < 4; ++nt) {
                f32x16 acc = {};
#pragma unroll
                for (int ks = 0; ks < 8; ++ks) acc = MFMA32(*(const LAS bf16x8*)(simg + p * 32768 + (2 * ks + hi) * 2048 + (32 * nt + r32) * 16), qf[ks], acc);
#pragma unroll
                for (int r = 0; r < 16; ++r) keys[nt][r] = (f2key(acc[r]) & 0xFFFFFF80u) | (unsigned)(32 * nt + crow(r, 0)) | (unsigned)(4 * hi);
                sort16(keys[nt]);
            }
            merge16(keys[0], keys[1]); merge16(keys[2], keys[3]); merge16(keys[0], keys[2]);
            unsigned lo[16], up[16];
#pragma unroll
            for (int i = 0; i < 16; ++i) { auto rr = __builtin_amdgcn_permlane32_swap(keys[0][i], keys[0][i], false, false); lo[i] = rr[0]; up[i] = rr[1]; }
#pragma unroll
            for (int i = 0; i < 16; ++i) top[p][i] = umax_(lo[i], up[15 - i]);
            bitonic16(top[p]);
        }
        if (hi == 0) {
            u32x4 w0, w1, w2, w3;
            w0.x = (top[0][0] & 127u) | ((top[0][1] & 127u) << 8) | ((top[0][2] & 127u) << 16) | ((top[0][3] & 127u) << 24);
            w0.y = (top[0][4] & 127u) | ((top[0][5] & 127u) << 8) | ((top[0][6] & 127u) << 16) | ((top[0][7] & 127u) << 24);
            w0.z = (top[0][8] & 127u) | ((top[0][9] & 127u) << 8) | ((top[0][10] & 127u) << 16) | ((top[0][11] & 127u) << 24);
            w0.w = (top[0][12] & 127u) | ((top[0][13] & 127u) << 8) | ((top[0][14] & 127u) << 16) | ((top[0][15] & 127u) << 24);
            w1.x = (top[1][0] & 127u) | ((top[1][1] & 127u) << 8) | ((top[1][2] & 127u) << 16) | ((top[1][3] & 127u) << 24);
            w1.y = (top[1][4] & 127u) | ((top[1][5] & 127u) << 8) | ((top[1][6] & 127u) << 16) | ((top[1][7] & 127u) << 24);
            w1.z = (top[1][8] & 127u) | ((top[1][9] & 127u) << 8) | ((top[1][10] & 127u) << 16) | ((top[1][11] & 127u) << 24);
            w1.w = (top[1][12] & 127u) | ((top[1][13] & 127u) << 8) | ((top[1][14] & 127u) << 16) | ((top[1][15] & 127u) << 24);
            *(LAS u32x4*)(dec + r32 * 32) = w0; *(LAS u32x4*)(dec + r32 * 32 + 16) = w1;
        }
        float av[16], bv[16];
#pragma unroll
        for (int i = 0; i < 16; ++i) { av[i] = key2f(top[0][i] & 0xFFFFFF80u); bv[i] = key2f(top[1][i] & 0xFFFFFF80u); }
        unsigned c0[16], c1[16], c2[16], c3[16];
#pragma unroll
        for (int j = 0; j < 16; ++j) c0[j] = (f2key(av[0] + bv[j]) & 0xFFFFFF00u) | (unsigned)j;
        {
            int n = 0;
#pragma unroll
            for (int i = 1; i < 16; ++i)
#pragma unroll
                for (int j = 0; j < 16; ++j) if ((i + 1) * (j + 1) <= 16) {
                    const unsigned k = (f2key(av[i] + bv[j]) & 0xFFFFFF00u) | (unsigned)(i * 16 + j);
                    if (n < 16) c1[n] = k; else if (n < 32) c2[n - 16] = k; else c3[n - 32] = k;
                    ++n; }
#pragma unroll
            for (int q = 2; q < 16; ++q) c3[q] = 0u;
        }
        sort16(c1); sort16(c2); { const unsigned a = c3[0], b = c3[1]; c3[0] = umax_(a, b); c3[1] = umin_(a, b); }
        merge16(c0, c1); merge16(c2, c3); merge16(c0, c2);
        asm volatile("s_waitcnt lgkmcnt(0)" ::: "memory");
        float gv[16]; unsigned ex[16]; float gs = 0.f;
        const float vmax = key2f(c0[0] & 0xFFFFFF00u);
#pragma unroll
        for (int k = 0; k < 16; ++k) {
            const unsigned code = c0[k] & 255u; const unsigned i = code >> 4, j = code & 15u;
            const unsigned ia = *(const LAS unsigned char*)(dec + r32 * 32 + i), ib = *(const LAS unsigned char*)(dec + r32 * 32 + 16 + j);
            ex[k] = ia * 128u + ib;
            gv[k] = __expf(key2f(c0[k] & 0xFFFFFF00u) - vmax); gs += gv[k];
        }
        const float ginv = 1.0f / gs;
        if (hi == 0) {
            u32x4 e0, e1;
            e0.x = ex[0] | (ex[1] << 16); e0.y = ex[2] | (ex[3] << 16); e0.z = ex[4] | (ex[5] << 16); e0.w = ex[6] | (ex[7] << 16);
            e1.x = ex[8] | (ex[9] << 16); e1.y = ex[10] | (ex[11] << 16); e1.z = ex[12] | (ex[13] << 16); e1.w = ex[14] | (ex[15] << 16);
            u32x4* ip = (u32x4*)((unsigned short*)(F.ws + WS_IDX) + (size_t)row * 16); ip[0] = e0; ip[1] = e1;
        } else {
            f32x4* gp = (f32x4*)((float*)(F.ws + WS_GATE) + (size_t)row * 16);
            gp[0] = (f32x4){gv[0] * ginv, gv[1] * ginv, gv[2] * ginv, gv[3] * ginv}; gp[1] = (f32x4){gv[4] * ginv, gv[5] * ginv, gv[6] * ginv, gv[7] * ginv};
            gp[2] = (f32x4){gv[8] * ginv, gv[9] * ginv, gv[10] * ginv, gv[11] * ginv}; gp[3] = (f32x4){gv[12] * ginv, gv[13] * ginv, gv[14] * ginv, gv[15] * ginv};
        }
    }
}

constexpr float U_SCALE = 32.f, V_SCALE = 4.f;
struct RowBuf { u32x4 r[16]; };
DI void load_rows(RowBuf& rb, const unsigned char* tbl, int idxs, int k0, int lane) {
#pragma unroll
    for (int j = 0; j < 16; ++j) { const int e = __builtin_amdgcn_readlane(idxs, k0 + j); rb.r[j] = *((const u32x4*)(tbl + (size_t)e * 1024) + lane); }
}
DI int udots(const RowBuf& rb, const int (&hq)[4], int lane) {
    int p[16];
#pragma unroll
    for (int j = 0; j < 16; ++j) { int a = __builtin_amdgcn_sdot4((int)rb.r[j].x, hq[0], 0, false); a = __builtin_amdgcn_sdot4((int)rb.r[j].y, hq[1], a, false);
        a = __builtin_amdgcn_sdot4((int)rb.r[j].z, hq[2], a, false); p[j] = __builtin_amdgcn_sdot4((int)rb.r[j].w, hq[3], a, false); }
#pragma unroll
    for (int i = 0; i < 8; ++i) { const bool up = (lane & 8) != 0; const int send = up ? p[i] : p[i + 8], keep = up ? p[i + 8] : p[i]; p[i] = keep + __shfl_xor(send, 8); }
#pragma unroll
    for (int i = 0; i < 4; ++i) { const bool up = (lane & 4) != 0; const int send = up ? p[i] : p[i + 4], keep = up ? p[i + 4] : p[i]; p[i] = keep + __shfl_xor(send, 4); }
#pragma unroll
    for (int i = 0; i < 2; ++i) { const bool up = (lane & 2) != 0; const int send = up ? p[i] : p[i + 2], keep = up ? p[i + 2] : p[i]; p[i] = keep + __shfl_xor(send, 2); }
    { const bool up = (lane & 1) != 0; const int send = up ? p[0] : p[1], keep = up ? p[1] : p[0]; p[0] = keep + __shfl_xor(send, 1); }
    int s = p[0]; s += __shfl_xor(s, 16); s += __shfl_xor(s, 32);
    return s;
}
DI void vaccum(const RowBuf& rb, f32x2_t (&out)[8], float wv, int k0) {
#pragma unroll
    for (int j = 0; j < 16; ++j) { const float wk = __builtin_bit_cast(float, __builtin_amdgcn_readlane(__builtin_bit_cast(int, wv), k0 + j));
        out[0] = __builtin_amdgcn_cvt_pk_f32_fp8((int)rb.r[j].x, false) * wk + out[0]; out[1] = __builtin_amdgcn_cvt_pk_f32_fp8((int)rb.r[j].x, true) * wk + out[1];
        out[2] = __builtin_amdgcn_cvt_pk_f32_fp8((int)rb.r[j].y, false) * wk + out[2]; out[3] = __builtin_amdgcn_cvt_pk_f32_fp8((int)rb.r[j].y, true) * wk + out[3];
        out[4] = __builtin_amdgcn_cvt_pk_f32_fp8((int)rb.r[j].z, false) * wk + out[4]; out[5] = __builtin_amdgcn_cvt_pk_f32_fp8((int)rb.r[j].z, true) * wk + out[5];
        out[6] = __builtin_amdgcn_cvt_pk_f32_fp8((int)rb.r[j].w, false) * wk + out[6]; out[7] = __builtin_amdgcn_cvt_pk_f32_fp8((int)rb.r[j].w, true) * wk + out[7]; }
}
constexpr size_t WS_W = WS_PROJ;
constexpr int UP_LDS = 16384;
DI void up_load_h2(int (&hq)[4], const unsigned char* H2Q, size_t t, int lane) {
    const u32x4 a = *((const u32x4*)(H2Q + t * 1024) + lane); hq[0] = (int)a.x; hq[1] = (int)a.y; hq[2] = (int)a.z; hq[3] = (int)a.w;
}
DI int up_prepare(LAS unsigned* cmp, const LAS unsigned short* lidx, const LAS float* lgate, int tt, int x, int lane) {
    LAS unsigned* c = cmp + (tt & 1) * 384;
    const int i0 = lidx[tt * 128 + lane], i1 = lidx[tt * 128 + 64 + lane];
    const float g0 = lgate[tt * 128 + lane], g1 = lgate[tt * 128 + 64 + lane];
    const bool in0 = (i0 >> 11) == x, in1 = (i1 >> 11) == x;
    const unsigned long long m0 = __ballot(in0), m1 = __ballot(in1);
    const int n0 = __popcll(m0), n = n0 + __popcll(m1);
    const int below0 = __builtin_amdgcn_mbcnt_hi((unsigned)(m0 >> 32), __builtin_amdgcn_mbcnt_lo((unsigned)m0, 0));
    const int below1 = __builtin_amdgcn_mbcnt_hi((unsigned)(m1 >> 32), __builtin_amdgcn_mbcnt_lo((unsigned)m1, 0));
    if (in0) { c[below0] = (unsigned)i0; c[128 + below0] = (unsigned)lane; c[256 + below0] = __float_as_uint(g0); }
    if (in1) { c[n0 + below1] = (unsigned)i1; c[128 + n0 + below1] = (unsigned)(64 + lane); c[256 + n0 + below1] = __float_as_uint(g1); }
    return n;
}
DI void up_issue(RowBuf& R, float& rs, const unsigned char* U, const float* SU, const LAS unsigned* cmp, int tt, int bb, int nn, int x, int lane) {
    const LAS unsigned* c = cmp + (tt & 1) * 384;
    const int pos = 16 * bb + (lane & 15);
    const int first = nn > 0 ? (int)c[0] : (x << 11);
    const int ia = pos < nn ? (int)c[pos & 127] : first;
    load_rows(R, U, ia, 0, lane);
    rs = SU[ia];
}
DI void up_finish(const RowBuf& R, float rs, const int (&hq)[4], float sh, const LAS unsigned* cmp, float* W, size_t t, int tt, int b, int n, int lane) {
    const float d = (float)udots(R, hq, lane) * rs * sh;
    const LAS unsigned* c = cmp + (tt & 1) * 384;
    const int pos = 16 * b + lane;
    if (lane < 16 && pos < n) { const float g = __uint_as_float(c[256 + pos]); W[t * 128 + c[128 + pos]] = g * 0.5f * d * (1.0f + erff(d * 0.70710678118654752f)) * (1.0f / V_SCALE); }
}
constexpr size_t WS_CLAIM = 4096;
DI unsigned xcc_id() { return (unsigned)__builtin_amdgcn_s_getreg((3 << 11) | 20) & 7u; }
DI int claim_unit(Frame& F, int set) {
    LAS int* bc = (LAS int*)(F.lds + LDS_BYTES - 64);
    __syncthreads();
    if (F.tid == 0) {
        unsigned* cnt = (unsigned*)(F.ws + WS_CLAIM) + set * 256;
        const unsigned x0 = xcc_id(); int unit = -1;
        for (unsigned a = 0; a < 8; ++a) { const unsigned sl = (x0 + a) & 7u; const unsigned tk = __hip_atomic_fetch_add(cnt + sl * 32, 1u, __ATOMIC_RELAXED, __HIP_MEMORY_SCOPE_AGENT); if (tk < 32u) { unit = (int)(sl * 32 + tk); break; } }
        bc[0] = unit;
    }
    __syncthreads();
    return bc[0];
}
DI void p_upass(Frame& F, int layer) {
    const unsigned char* U = F.ws + WS_U + (size_t)layer * 16384 * 1024;
    const unsigned char* H2 = F.ws + WS_H2Q; const float* SH = (const float*)(F.ws + WS_SH); const float* SU = (const float*)(F.ws + WS_SU) + (size_t)layer * 16384;
    const unsigned short* IDX = (const unsigned short*)(F.ws + WS_IDX); const float* GATE = (const float*)(F.ws + WS_GATE);
    float* W = (float*)(F.ws + WS_W);
    LAS unsigned char* wl = F.lds + F.wave * UP_LDS;
    LAS unsigned short* lidx = (LAS unsigned short*)wl; LAS float* lgate = (LAS float*)(wl + 4096); LAS unsigned* cmp = (LAS unsigned*)(wl + 12288);
    const int lane = F.lane;
    for (int unit = claim_unit(F, 2 * layer); unit >= 0; unit = claim_unit(F, 2 * layer)) {
    const int x = unit >> 5, jb = unit & 31;
    for (int t0 = jb * 1024 + F.wave * 128; t0 < jb * 1024 + F.wave * 128 + 128; t0 += 16) {
        { const u32x4* si = (const u32x4*)(IDX + (size_t)t0 * 128) + lane;
#pragma unroll
          for (int q = 0; q < 4; ++q) ((LAS u32x4*)lidx)[lane + 64 * q] = si[64 * q];
          const u32x4* sg = (const u32x4*)(GATE + (size_t)t0 * 128) + lane;
#pragma unroll
          for (int q = 0; q < 8; ++q) ((LAS u32x4*)lgate)[lane + 64 * q] = sg[64 * q]; }
        int hq[4], hqN[4]; float sh = SH[t0], shN = SH[t0 + 1];
        up_load_h2(hq, H2, (size_t)t0, lane);
        int tt = 0, b = 0, n = up_prepare(cmp, lidx, lgate, 0, x, lane), nb = n > 16 ? (n + 15) >> 4 : 1;
        RowBuf RA, RB; float sA, sB;
        up_issue(RA, sA, U, SU, cmp, 0, 0, n, x, lane);
        up_load_h2(hqN, H2, (size_t)t0 + 1, lane);
#define UP_STEP(RC, SC, RN, SN) { \
            int ntt = tt, nbb = b + 1, nn = n; bool last = false; \
            if (nbb >= nb) { ntt = tt + 1; nbb = 0; if (ntt < 16) nn = up_prepare(cmp, lidx, lgate, ntt, x, lane); else last = true; } \
            if (!last) up_issue(RN, SN, U, SU, cmp, ntt, nbb, nn, x, lane); \
            up_finish(RC, SC, hq, sh, cmp, W, (size_t)t0 + tt, tt, b, n, lane); \
            if (last) break; \
            if (ntt != tt) { _Pragma("unroll") for (int q = 0; q < 4; ++q) hq[q] = hqN[q]; sh = shN; if (ntt + 1 < 16) { up_load_h2(hqN, H2, (size_t)t0 + ntt + 1, lane); shN = SH[t0 + ntt + 1]; } n = nn; nb = n > 16 ? (n + 15) >> 4 : 1; } \
            tt = ntt; b = nbb; }
        for (;;) { UP_STEP(RA, sA, RB, sB) UP_STEP(RB, sB, RA, sA) }
#undef UP_STEP
    }
    }
}
struct TokBuf { u32x4 r[16]; f32x4 w[4]; };
DI void vp_load(TokBuf& tb, const unsigned char* Vs, const LAS unsigned short* lidx, const LAS float* lw, int tt, int lane) {
    const int g = lane >> 3, c = lane & 7;
    const LAS u32x4* ip = (const LAS u32x4*)(lidx + tt * 128 + 16 * g); const u32x4 ia = ip[0], ib = ip[1];
    const LAS f32x4* wp = (const LAS f32x4*)(lw + tt * 128 + 16 * g); tb.w[0] = wp[0]; tb.w[1] = wp[1]; tb.w[2] = wp[2]; tb.w[3] = wp[3];
    const unsigned e[16] = {ia.x & 0xffffu, ia.x >> 16, ia.y & 0xffffu, ia.y >> 16, ia.z & 0xffffu, ia.z >> 16, ia.w & 0xffffu, ia.w >> 16,
                            ib.x & 0xffffu, ib.x >> 16, ib.y & 0xffffu, ib.y >> 16, ib.z & 0xffffu, ib.z >> 16, ib.w & 0xffffu, ib.w >> 16};
#pragma unroll
    for (int i = 0; i < 16; ++i) tb.r[i] = *(const u32x4*)(Vs + (size_t)e[i] * 128 + c * 16);
}
DI void vp_compute(const TokBuf& tb, Frame& F, const float* g2s, float* xout, size_t t, int x, int lane) {
    f32x2_t out[8];
#pragma unroll
    for (int i = 0; i < 8; ++i) out[i] = (f32x2_t){0.f, 0.f};
#pragma unroll
    for (int i = 0; i < 16; ++i) { const float wk = tb.w[i >> 2][i & 3];
        out[0] = __builtin_amdgcn_cvt_pk_f32_fp8((int)tb.r[i].x, false) * wk + out[0]; out[1] = __builtin_amdgcn_cvt_pk_f32_fp8((int)tb.r[i].x, true) * wk + out[1];
        out[2] = __builtin_amdgcn_cvt_pk_f32_fp8((int)tb.r[i].y, false) * wk + out[2]; out[3] = __builtin_amdgcn_cvt_pk_f32_fp8((int)tb.r[i].y, true) * wk + out[3];
        out[4] = __builtin_amdgcn_cvt_pk_f32_fp8((int)tb.r[i].z, false) * wk + out[4]; out[5] = __builtin_amdgcn_cvt_pk_f32_fp8((int)tb.r[i].z, true) * wk + out[5];
        out[6] = __builtin_amdgcn_cvt_pk_f32_fp8((int)tb.r[i].w, false) * wk + out[6]; out[7] = __builtin_amdgcn_cvt_pk_f32_fp8((int)tb.r[i].w, true) * wk + out[7]; }
    float p[16];
#pragma unroll
    for (int i = 0; i < 8; ++i) { p[2 * i] = out[i].x; p[2 * i + 1] = out[i].y; }
#pragma unroll
    for (int i = 0; i < 8; ++i) { const bool up = (lane & 32) != 0; const float send = up ? p[i] : p[i + 8], keep = up ? p[i + 8] : p[i]; p[i] = keep + __shfl_xor(send, 32); }
#pragma unroll
    for (int i = 0; i < 4; ++i) { const bool up = (lane & 16) != 0; const float send = up ? p[i] : p[i + 4], keep = up ? p[i + 4] : p[i]; p[i] = keep + __shfl_xor(send, 16); }
#pragma unroll
    for (int i = 0; i < 2; ++i) { const bool up = (lane & 8) != 0; const float send = up ? p[i] : p[i + 2], keep = up ? p[i + 2] : p[i]; p[i] = keep + __shfl_xor(send, 8); }
    const int col = 128 * x + 16 * (lane & 7) + 8 * ((lane >> 5) & 1) + 4 * ((lane >> 4) & 1) + 2 * ((lane >> 3) & 1);
    const f32x2_t gg = *(const f32x2_t*)(g2s + col);
    const f32x2_t xv = *(const f32x2_t*)(F.out + t * 1024 + col);
    *(f32x2_t*)(xout + t * 1024 + col) = xv + gg * (f32x2_t){p[0], p[1]};
}
DI void p_vpass(Frame& F, int layer, float* xout) {

    const unsigned short* IDX = (const unsigned short*)(F.ws + WS_IDX); const float* W = (const float*)(F.ws + WS_W);
    const float* mods = (const float*)(F.ws + WS_MODS);
    LAS unsigned char* wl = F.lds + F.wave * UP_LDS;
    LAS unsigned short* lidx = (LAS unsigned short*)wl; LAS float* lw = (LAS float*)(wl + 4096);
    const int lane = F.lane;
    for (int unit = claim_unit(F, 2 * layer + 1); unit >= 0; unit = claim_unit(F, 2 * layer + 1)) {
    const int x = unit >> 5, jb = unit & 31;
    const unsigned char* Vs = F.ws + WS_V + ((size_t)layer * 8 + x) * 16384 * 128;
    for (int t0 = jb * 1024 + F.wave * 128; t0 < jb * 1024 + F.wave * 128 + 128; t0 += 16) {
        const int b = t0 >> 11;
        const float* g2s = mods + ((size_t)layer * 16 + b) * 6144 + 5 * 1024;
        { const u32x4* si = (const u32x4*)(IDX + (size_t)t0 * 128) + lane;
#pragma unroll
          for (int q = 0; q < 4; ++q) ((LAS u32x4*)lidx)[lane + 64 * q] = si[64 * q];
          const u32x4* sg = (const u32x4*)(W + (size_t)t0 * 128) + lane;
#pragma unroll
          for (int q = 0; q < 8; ++q) ((LAS u32x4*)lw)[lane + 64 * q] = sg[64 * q]; }
        TokBuf A, B;
        vp_load(A, Vs, lidx, lw, 0, lane);
#pragma unroll 1
        for (int tt = 0; tt < 16; tt += 2) {
            vp_load(B, Vs, lidx, lw, tt + 1, lane);
            vp_compute(A, F, g2s, xout, (size_t)t0 + tt, x, lane);
            if (tt + 2 < 16) vp_load(A, Vs, lidx, lw, tt + 2, lane);
            vp_compute(B, F, g2s, xout, (size_t)t0 + tt + 1, x, lane);
        }
    }
    }
}
#ifndef DUP
#define DUP -1
#endif
#ifndef PH_MASK
#define PH_MASK 0x3FFFF
#endif

constexpr size_t WS_BAR = 65536;
#define XB_TMO      128
#define XB_XCNT(j)  (256  + 64 * (j))
#define XB_XSUB(j)  (1280 + 64 * (j))
#define XB_XGEN(j)  (2304 + 64 * (j))
#define XB_TOP      3328
#define XB_TOPGEN   3392
#define XCD_BAR_WORDS 3456
#define XB_SPIN_CAP (1u << 18)

__device__ __forceinline__ unsigned xb_ld(unsigned* p)              { return __hip_atomic_load(p, __ATOMIC_RELAXED, __HIP_MEMORY_SCOPE_AGENT); }
__device__ __forceinline__ unsigned xb_add(unsigned* p, unsigned v) { return __hip_atomic_fetch_add(p, v, __ATOMIC_RELAXED, __HIP_MEMORY_SCOPE_AGENT); }
__device__ __forceinline__ unsigned xb_xcc_id() { return (unsigned)__builtin_amdgcn_s_getreg((3 << 11) | 20) & 0xFu; }
#define XB_SPIN(cond, bar) do { unsigned _sp = 0; while (cond) { __builtin_amdgcn_s_sleep(1); \
    if ((++_sp & 255u) == 0u) { if (xb_ld(&(bar)[XB_TMO])) break; if (_sp > XB_SPIN_CAP) { atomicAdd(&(bar)[XB_TMO], 1u); break; } } } } while (0)

struct XcdBarrier {
    unsigned* bar; unsigned x;
    volatile LAS unsigned* st;
};

__device__ __forceinline__ XcdBarrier xcd_barrier_post(unsigned* bar, volatile LAS unsigned* st) {
    XcdBarrier b; b.bar = bar; b.x = xb_xcc_id(); b.st = st;
    if (threadIdx.x == 0) (void)xb_add(&bar[XB_XCNT(b.x)], 1u);
    return b;
}
__device__ __forceinline__ void xcd_barrier_complete(unsigned* bar, unsigned x, unsigned& nloc, unsigned& nx) {
    const unsigned G = gridDim.x * gridDim.y * gridDim.z;
    unsigned sum, cnt, mine, sp = 0u;
    for (;;) {
        sum = 0u; cnt = 0u; mine = 0u;
#pragma unroll
        for (unsigned j = 0; j < 16; ++j) { const unsigned c = xb_ld(&bar[XB_XCNT(j)]); sum += c; cnt += (c > 0u) ? 1u : 0u; mine = (j == x) ? c : mine; }
        if (sum == G) break;
        __builtin_amdgcn_s_sleep(1);
        if ((++sp & 255u) == 0u) { if (xb_ld(&bar[XB_TMO])) break; if (sp > XB_SPIN_CAP) { atomicAdd(&bar[XB_TMO], 1u); break; } }
    }
    nloc = mine > 0u ? mine : 1u; nx = cnt > 0u ? cnt : 1u;
}

__device__ __forceinline__ void xcd_barrier(const XcdBarrier& b) {
    asm volatile("s_waitcnt vmcnt(0)" ::: "memory");
    __syncthreads();
    if (threadIdx.x == 0) {
        unsigned* bar = b.bar;
        __builtin_amdgcn_s_waitcnt(0);
        unsigned nloc = b.st[0], nx = b.st[1];
        if (nloc == 0u) { xcd_barrier_complete(bar, b.x, nloc, nx); b.st[0] = nloc; b.st[1] = nx; }
        const unsigned old = xb_add(&bar[XB_XSUB(b.x)], 1u);
        const unsigned gen = old / nloc;
        if (old + 1u == (gen + 1u) * nloc) {
            __builtin_amdgcn_fence(__ATOMIC_RELEASE, "agent");
            asm volatile("s_waitcnt vmcnt(0)" ::: "memory");
            const unsigned og = xb_add(&bar[XB_TOP], 1u);
            const unsigned tg = og / nx;
            if (og + 1u == (tg + 1u) * nx) xb_add(&bar[XB_TOPGEN], 1u);
            else XB_SPIN(xb_ld(&bar[XB_TOPGEN]) == tg, bar);
            __builtin_amdgcn_fence(__ATOMIC_ACQUIRE, "agent");
            xb_add(&bar[XB_XGEN(b.x)], 1u);
            asm volatile("s_waitcnt vmcnt(0)" ::: "memory");
        } else {
            XB_SPIN(xb_ld(&bar[XB_XGEN(b.x)]) == gen, bar);
            __builtin_amdgcn_fence(__ATOMIC_ACQUIRE, "agent");
            asm volatile("s_waitcnt vmcnt(0)" ::: "memory");
        }
    }
    __syncthreads();
}

#ifndef N_LAUNCH_MODE
#define N_LAUNCH_MODE 1
#endif
constexpr int NPH = 18;
template <class Epi> DI void run_gemm(Frame& F, const bf16* A, const bf16* Bt, int N, const Epi& E) {
    pg8::Gemm g{A, Bt, T_TOK, N, DM}; pg8::StaticOrder S; S.init(T_TOK, N, F.G, F.bid);
    pg8::gemm_phase<Epi, pg8::StaticOrder, true, true>(F.lds, g, S, E);
}
__global__ void __launch_bounds__(NT, 2) fwd(Args args) {
    extern __shared__ __attribute__((aligned(16))) unsigned char lds_raw[];
    cg::grid_group grid = cg::this_grid();
    Frame F;
    F.lds = (LAS unsigned char*)lds_raw;
#pragma unroll
    for (int i = 0; i < 23; ++i) F.in[i] = args.in[i];
    F.out = args.out; F.ws = args.ws;
    F.tid = threadIdx.x; F.lane = F.tid & 63; F.wave = __builtin_amdgcn_readfirstlane(F.tid >> 6); F.bid = blockIdx.x; F.G = gridDim.x;
    const int lo = args.ph_lo, hi = args.ph_hi;
    volatile LAS unsigned* bst = (volatile LAS unsigned*)(F.lds + LDS_BYTES - 128);
    if (F.tid < 2) bst[F.tid] = 0u;
    __syncthreads();
    XcdBarrier xbar; xbar.bar = (unsigned*)(F.ws + WS_BAR); xbar.x = xb_xcc_id(); xbar.st = bst;
    bool bar_ready = false;
#define IN(k) (lo <= (k) && (k) < hi)
#define GSYNC() do { if (!bar_ready) { grid.sync(); if (F.tid == 0) (void)xb_add(&xbar.bar[XB_XCNT(xbar.x)], 1u); bar_ready = true; } else xcd_barrier(xbar); } while (0)
#define SEAM(k) do { if (IN(k) && IN((k) + 1)) GSYNC(); } while (0)
    float* mods = (float*)(F.ws + WS_MODS);
    bf16* Hb = (bf16*)(F.ws + WS_H);
    if (((PH_MASK >> 0) & 1) && IN(0)) { p0_prologue(F); if (DUP == 0) { GSYNC(); p0_prologue(F); } } SEAM(0);
    if (((PH_MASK >> 1) & 1) && IN(1)) { norm_phase<true>(F, F.in[0], F.in[4], mods, mods + 1024, 6144, Hb); if (DUP == 1) { GSYNC(); norm_phase<true>(F, F.in[0], F.in[4], mods, mods + 1024, 6144, Hb); } } SEAM(1);
    if (((PH_MASK >> 2) & 1) && IN(2)) { pg8::EpiBf16<0> E{(bf16*)(F.ws + WS_PROJ), 3072, nullptr, 0, 0, 1.f}; run_gemm(F, Hb, (const bf16*)(F.ws + WS_WIN), 3072, E); if (DUP == 2) { GSYNC(); run_gemm(F, Hb, (const bf16*)(F.ws + WS_WIN), 3072, E); } } SEAM(2);
    if (((PH_MASK >> 3) & 1) && IN(3)) { p3_mlstm_local(F); if (DUP == 3) { GSYNC(); p3_mlstm_local(F); } } SEAM(3);
    if (((PH_MASK >> 4) & 1) && IN(4)) { p4_scan(F); if (DUP == 4) { GSYNC(); p3_mlstm_local(F); GSYNC(); p4_scan(F); } } SEAM(4);
    if (((PH_MASK >> 5) & 1) && IN(5)) { p5_mlstm_out(F); if (DUP == 5) { GSYNC(); p5_mlstm_out(F); } } SEAM(5);
    if (((PH_MASK >> 6) & 1) && IN(6)) { pg8::EpiResid E{F.in[0], F.out, mods + 2 * 1024, 6144}; run_gemm(F, Hb, (const bf16*)(F.ws + WS_WOUT), 1024, E); if (DUP == 6) { GSYNC(); run_gemm(F, Hb, (const bf16*)(F.ws + WS_WOUT), 1024, E); } } SEAM(6);
    if (((PH_MASK >> 7) & 1) && IN(7)) { norm_phase<false, true>(F, F.out, F.in[5], mods + 3 * 1024, mods + 4 * 1024, 6144, Hb); if (DUP == 7) { GSYNC(); norm_phase<false, true>(F, F.out, F.in[5], mods + 3 * 1024, mods + 4 * 1024, 6144, Hb); } } SEAM(7);
    if (((PH_MASK >> 8) & 1) && IN(8)) { pg8::EpiBf16<0> E{(bf16*)(F.ws + WS_PQ), 2048, nullptr, 0, 0, 1.f}; run_gemm(F, Hb, (const bf16*)(F.ws + WS_WPQ), 2048, E); if (DUP == 8) { GSYNC(); run_gemm(F, Hb, (const bf16*)(F.ws + WS_WPQ), 2048, E); } } SEAM(8);
    if (((PH_MASK >> 9) & 1) && IN(9)) { p_route(F, 0); if (DUP == 9) { GSYNC(); p_route(F, 0); } } SEAM(9);
    if (((PH_MASK >> 10) & 1) && IN(10)) {
        p_upass(F, 0); GSYNC(); p_vpass(F, 0, F.out); GSYNC();
        norm2_phase(F, F.out, F.in[4] + 1024, mods + 16 * 6144, mods + 16 * 6144 + 1024, 6144, Hb, F.in[13], (const float*)(F.ws + WS_KVMODS), (const float*)(F.ws + WS_KVMODS) + 1024, 2048, (bf16*)(F.ws + WS_HB));
    } SEAM(10);
    if (((PH_MASK >> 11) & 1) && IN(11)) {
        { pg8::EpiHeadNorm E{(bf16*)(F.ws + WS_Q), (bf16*)(F.ws + WS_Q), 4, F.in[17], 0.125f, EPS}; run_gemm(F, Hb, (const bf16*)(F.ws + WS_WSQ), 1024, E); }
        { pg8::EpiHeadNorm E{(bf16*)(F.ws + WS_K), (bf16*)(F.ws + WS_VV), 4, F.in[15], 1.0f, EPS}; run_gemm(F, (const bf16*)(F.ws + WS_HB), (const bf16*)(F.ws + WS_WKV), 2048, E);
          if (DUP == 11) { GSYNC(); run_gemm(F, (const bf16*)(F.ws + WS_HB), (const bf16*)(F.ws + WS_WKV), 2048, E); } }
    } SEAM(11);
    if (((PH_MASK >> 12) & 1) && IN(12)) { p12_attn(F); if (DUP == 12) { GSYNC(); p12_attn(F); } } SEAM(12);
    if (((PH_MASK >> 13) & 1) && IN(13)) { pg8::EpiResid E{F.out, F.out, mods + 16 * 6144 + 2 * 1024, 6144}; run_gemm(F, Hb, (const bf16*)(F.ws + WS_WSO), 1024, E); } SEAM(13);
    if (((PH_MASK >> 14) & 1) && IN(14)) { norm_phase<false, true>(F, F.out, F.in[5] + 1024, mods + 16 * 6144 + 3 * 1024, mods + 16 * 6144 + 4 * 1024, 6144, Hb); } SEAM(14);
    if (((PH_MASK >> 15) & 1) && IN(15)) { pg8::EpiBf16<0> E{(bf16*)(F.ws + WS_PQ), 2048, nullptr, 0, 0, 1.f}; run_gemm(F, Hb, (const bf16*)(F.ws + WS_WPQ) + (size_t)2048 * 1024, 2048, E); } SEAM(15);
    if (((PH_MASK >> 16) & 1) && IN(16)) { p_route(F, 1); } SEAM(16);
    if (((PH_MASK >> 17) & 1) && IN(17)) { p_upass(F, 1); GSYNC(); if (DUP == 20) { p_upass(F, 1); GSYNC(); } if (DUP == 21) { p_vpass(F, 1, (float*)(F.ws + WS_Q + 32 * MiB)); GSYNC(); } p_vpass(F, 1, F.out); }
    if (DUP == 30) { for (int i = 0; i < 10; ++i) GSYNC(); }
#undef IN
#undef SEAM
#undef GSYNC
}

extern "C" void kernel_launch(void* const* d_in, const int* in_sizes, int n_in, void* d_out, int out_size, void* d_ws, size_t ws_size, hipStream_t stream) {
    static int grid = 0;
    if (grid == 0) {
        int dev = 0, cus = 0, per_cu = 0;
        (void)hipGetDevice(&dev);
        (void)hipDeviceGetAttribute(&cus, hipDeviceAttributeMultiprocessorCount, dev);
        (void)hipFuncSetAttribute((const void*)fwd, hipFuncAttributeMaxDynamicSharedMemorySize, LDS_BYTES);
        (void)hipOccupancyMaxActiveBlocksPerMultiprocessor(&per_cu, (const void*)fwd, NT, LDS_BYTES);
        if (per_cu < 1) { fprintf(stderr, "kernel_launch: occupancy query says %d blocks per CU\n", per_cu); per_cu = 1; }
        grid = cus;
        if (n_in != 23 || ws_size < WS_END) fprintf(stderr, "kernel_launch: unexpected n_in %d / ws_size %zu\n", n_in, ws_size);
        (void)hipGetLastError();
    }
    Args a{};
    for (int i = 0; i < 23; ++i) a.in[i] = (const float*)d_in[i];
    a.out = (float*)d_out; a.ws = (unsigned char*)d_ws;
#if N_LAUNCH_MODE == 1
    a.ph_lo = 0; a.ph_hi = NPH;
    void* kargs[] = {&a};
    hipError_t e = hipLaunchCooperativeKernel((const void*)fwd, dim3(grid), dim3(NT), kargs, LDS_BYTES, stream);
    if (e != hipSuccess) fprintf(stderr, "kernel_launch: cooperative launch failed: %s (grid %d)\n", hipGetErrorString(e), grid);
#else
    for (int p = 0; p < NPH; ++p) { a.ph_lo = p; a.ph_hi = p + 1; hipLaunchKernelGGL(fwd, dim3(grid), dim3(NT), LDS_BYTES, stream, a); }
#endif
}
```

```cpp
#include <hip/hip_runtime.h>
#include <hip/hip_cooperative_groups.h>
#include <cstdio>
#include <cstdint>
namespace cg = cooperative_groups;
#define N_LAUNCH_MODE 1
namespace pg8 {
#define PG8_LAS __attribute__((address_space(3)))
typedef unsigned short bf16_t;
typedef short bf16x8 __attribute__((ext_vector_type(8)));
typedef float f32x4 __attribute__((ext_vector_type(4)));
typedef unsigned u32x4 __attribute__((ext_vector_type(4)));
constexpr int BM = 256, BK = 64, HALF = 128, HTB = HALF * BK * 2  , STAGE_BYTES = 8 * HTB, NXCD = 8, WGM = 8;

__host__ __device__ __forceinline__ int lds_byte(int r, int c) { const int st = (r >> 4) * 2 + (c >> 5), rr = r & 15, cc = c & 31, ob = rr * 64 + cc * 2; return st * 1024 + (ob ^ (((ob >> 9) & 1) << 5)); }
__host__ __device__ __forceinline__ void stage_rc(int b, int& R, int& C) { const int st = b / 1024, sb = b % 1024, swz = sb ^ (((sb >> 9) & 1) << 5); R = (st >> 1) * 16 + swz / 64; C = (st & 1) * 32 + (swz % 64) / 2; }
__host__ __device__ __forceinline__ int perm32(int rho) { const int n = rho >> 4, i = rho & 15; return 8 * (i >> 2) + 4 * n + (i & 3); }

struct Unit { int pm, pn; };
struct Gemm { const bf16_t* A; const bf16_t* Bt; int M, N, K; };

struct StaticOrder {
    int nM, nN, nwg, G, c;
    __host__ __device__ void init(int M, int N, int G_, int c_) { nM = M / BM; nN = N / BM; nwg = nM * nN; G = G_; c = c_; }
    __host__ __device__ bool next(int i, Unit& u) const {
        const long L = (long)i * G + c; if (L >= nwg) return false;
        int wgid = (int)L; { const int q = nwg / NXCD, r = nwg % NXCD, xcd = wgid % NXCD, off = wgid / NXCD; wgid = (xcd < r ? xcd * (q + 1) : r * (q + 1) + (xcd - r) * q) + off; }
        const int nig = WGM * nN, gid = wgid / nig, fm = gid * WGM, gsz = (nM - fm) < WGM ? (nM - fm) : WGM;
        u.pm = fm + ((wgid % nig) % gsz); u.pn = (wgid % nig) / gsz; return true;
    }
    __device__ __forceinline__ void a_ready(const Unit&) const {}
    __device__ __forceinline__ void done(const Unit&) const {}
};

__device__ __forceinline__ unsigned cvt_pk_bf16(float lo, float hi) { unsigned r; asm volatile("v_cvt_pk_bf16_f32 %0, %1, %2" : "=v"(r) : "v"(lo), "v"(hi)); return r; }
typedef float f32x2 __attribute__((ext_vector_type(2)));
__device__ __forceinline__ f32x2 gelu_pk(f32x2 v) {
    const f32x2 av = __builtin_elementwise_abs(v), d = av * 0.2316418882f + 1.0f;
    f32x2 t; t.x = __builtin_amdgcn_rcpf(d.x); t.y = __builtin_amdgcn_rcpf(d.y);
    f32x2 q = t * 0.5307027145f + (-0.7265760135f); q = q * t + 0.7107068705f; q = q * t + (-0.142248368f); q = q * t + 0.127414796f; q = q * t;
    const f32x2 s = (v * v) * (-0.72134752044f);
    f32x2 e; e.x = __builtin_amdgcn_exp2f(s.x); e.y = __builtin_amdgcn_exp2f(s.y);
    const f32x2 m = v * (q * e), r = v - m;
    f32x2 o; o.x = v.x < 0.f ? m.x : r.x; o.y = v.y < 0.f ? m.y : r.y; return o;
}

template <int ACT  > struct EpiBf16 {
    static constexpr bool PERM = true, AFTER_DRAIN = false; static_assert(ACT == 0 || ACT == 1, "EpiBf16: ACT is 0 (none) or 1 (gelu_pk)");
    bf16_t* O; int ldc; const float* bias; int split_cols; size_t split_stride; float scale0;
    __device__ __forceinline__ void operator()(const f32x4 (&acc)[2][2][4][2], const Unit& u, int wr, int wc, int fr, int fq) const {
        const int row0 = u.pm * BM + wr * 64 + fr; int colt = u.pn * BM; bf16_t* base = O;
        float sc = 1.f; if (split_cols) { const int t = colt / split_cols; base += (size_t)t * split_stride; colt -= t * split_cols; if (t == 0) sc = scale0; }
        const int col0 = colt + wc * 32 + 8 * fq, bcol0 = u.pn * BM + wc * 32 + 8 * fq;
        f32x4 bv[2][2];
#pragma unroll
        for (int bj = 0; bj < 2; ++bj)
#pragma unroll
            for (int n = 0; n < 2; ++n) bv[bj][n] = bias ? *(const f32x4*)(bias + bcol0 + bj * HALF + 4 * n) : (f32x4){0.f, 0.f, 0.f, 0.f};
#pragma unroll
        for (int ai = 0; ai < 2; ++ai)
#pragma unroll
            for (int m = 0; m < 4; ++m) { bf16_t* rowp = base + (size_t)(row0 + ai * HALF + m * 16) * ldc + col0;
#pragma unroll
                for (int bj = 0; bj < 2; ++bj) { f32x4 v0 = acc[ai][bj][m][0] + bv[bj][0], v1 = acc[ai][bj][m][1] + bv[bj][1];
                    if (ACT == 1) { f32x2 a = gelu_pk((f32x2){v0[0], v0[1]}), b = gelu_pk((f32x2){v0[2], v0[3]}), c = gelu_pk((f32x2){v1[0], v1[1]}), d = gelu_pk((f32x2){v1[2], v1[3]});
                        v0 = (f32x4){a.x, a.y, b.x, b.y}; v1 = (f32x4){c.x, c.y, d.x, d.y}; }
                    v0 = v0 * sc; v1 = v1 * sc; u32x4 w; w.x = cvt_pk_bf16(v0[0], v0[1]); w.y = cvt_pk_bf16(v0[2], v0[3]); w.z = cvt_pk_bf16(v1[0], v1[1]); w.w = cvt_pk_bf16(v1[2], v1[3]);
                    *(u32x4*)(rowp + bj * HALF) = w; } }
    }
};
struct EpiResid {
    static constexpr bool PERM = false, AFTER_DRAIN = false;
    const float* base; float* out; const float* gate; int gstride;
    __device__ __forceinline__ void operator()(const f32x4 (&acc)[2][2][4][2], const Unit& u, int wr, int wc, int fr, int fq) const {
        const int col0 = u.pn * BM + wc * 32 + 4 * fq;
        const int b = (u.pm * BM) >> 11;
        f32x4 gv[2][2];
#pragma unroll
        for (int bj = 0; bj < 2; ++bj)
#pragma unroll
            for (int n = 0; n < 2; ++n) gv[bj][n] = *(const f32x4*)(gate + (size_t)b * gstride + col0 + bj * HALF + n * 16);
#pragma unroll
        for (int ai = 0; ai < 2; ++ai)
#pragma unroll
            for (int m = 0; m < 4; ++m) { const size_t off = (size_t)(u.pm * BM + ai * HALF + wr * 64 + m * 16 + fr) * 1024 + col0;
#pragma unroll
                for (int bj = 0; bj < 2; ++bj)
#pragma unroll
                    for (int n = 0; n < 2; ++n) { const f32x4 bs = *(const f32x4*)(base + off + bj * HALF + n * 16);
                        *(f32x4*)(out + off + bj * HALF + n * 16) = bs + gv[bj][n] * acc[ai][bj][m][n]; }
                if (m & 1) asm volatile("" ::: "memory"); }
    }
};
struct EpiHeadNorm {
    static constexpr bool PERM = true, AFTER_DRAIN = false;
    bf16_t* O0; bf16_t* O1; int ntile_norm; const float* g; float scale; float eps;
    __device__ __forceinline__ void operator()(const f32x4 (&acc)[2][2][4][2], const Unit& u, int wr, int wc, int fr, int fq) const {
        const bool nrm = u.pn < ntile_norm; bf16_t* O = nrm ? O0 : O1; const int pnl = nrm ? u.pn : u.pn - ntile_norm;
        f32x4 gv[2][2];
#pragma unroll
        for (int bj = 0; bj < 2; ++bj)
#pragma unroll
            for (int n = 0; n < 2; ++n) { const f32x4 t = *(const f32x4*)(g + 32 * bj + 8 * fq + 4 * n); gv[bj][n] = nrm ? t * scale : (f32x4){1.f, 1.f, 1.f, 1.f}; }
#pragma unroll
        for (int ai = 0; ai < 2; ++ai)
#pragma unroll
            for (int m = 0; m < 4; ++m) {
                float ss = 0.f;
#pragma unroll
                for (int bj = 0; bj < 2; ++bj)
#pragma unroll
                    for (int n = 0; n < 2; ++n) { const f32x4 x = acc[ai][bj][m][n]; ss += (x[0] * x[0] + x[1] * x[1]) + (x[2] * x[2] + x[3] * x[3]); }
                ss += __shfl_xor(ss, 16); ss += __shfl_xor(ss, 32);
                const float rs = nrm ? 1.0f / sqrtf(ss * (1.0f / 64.0f) + eps) : 1.0f;
                bf16_t* rowp = O + (size_t)(u.pm * BM + ai * HALF + wr * 64 + m * 16 + fr) * 1024 + pnl * BM + wc * 64 + 8 * fq;
#pragma unroll
                for (int bj = 0; bj < 2; ++bj) { const f32x4 v0 = acc[ai][bj][m][0] * rs * gv[bj][0], v1 = acc[ai][bj][m][1] * rs * gv[bj][1];
                    u32x4 w; w.x = cvt_pk_bf16(v0[0], v0[1]); w.y = cvt_pk_bf16(v0[2], v0[3]); w.z = cvt_pk_bf16(v1[0], v1[1]); w.w = cvt_pk_bf16(v1[2], v1[3]);
                    *(u32x4*)(rowp + bj * 32) = w; }
            }
    }
};
template <class Epi, class Sched, bool ALIGN_EPI = false, bool SP2 = false>
__device__ __forceinline__ void gemm_phase(PG8_LAS unsigned char* lds, const Gemm g, const Sched& S, const Epi& E) {
    const int tid = threadIdx.x, wid = __builtin_amdgcn_readfirstlane(tid >> 6), lane = tid & 63, wr = wid >> 2, wc = wid & 3, fr = lane & 15, fq = lane >> 4;
    const int K = g.K, nt = K / BK;
    unsigned voffA[2], voffB[2];
#pragma unroll
    for (int i = 0; i < 2; ++i) { int R, C; stage_rc(tid * 16 + i * 8192, R, C); const int Rb = Epi::PERM ? ((R & ~31) + perm32(R & 31)) : R;
        voffA[i] = (unsigned)(R * K + C) * 2u; voffB[i] = (unsigned)(Rb * K + C) * 2u; }
    const size_t kstep = (size_t)(BK * 2);
    const size_t hstep = (size_t)HALF * K * 2;
    const size_t tstep = 2 * hstep;
    const unsigned ldsw = (unsigned)wid * 1024u;
    const int aoff = lds_byte(wr * 64 + fr, fq * 8), boff = lds_byte(wc * 32 + fr, fq * 8);
#define PG8_SA(b, h) (((b) * 2 + (h)) * HTB)
#define PG8_SB(b, h) ((4 + (b) * 2 + (h)) * HTB)
#define PG8_STAGE(bufoff, gbase, voff) do { _Pragma("unroll") for (int _i = 0; _i < 2; ++_i) \
        __builtin_amdgcn_global_load_lds((const unsigned*)((const char*)(gbase) + (voff)[_i]), (PG8_LAS unsigned*)(lds + (bufoff) + ldsw + _i * 8192), 16, 0, 0); } while (0)
#define PG8_LDA(dst, b, h) do { _Pragma("unroll") for (int m = 0; m < 4; ++m) _Pragma("unroll") for (int k = 0; k < 2; ++k) dst[m][k] = *(const PG8_LAS bf16x8*)(lds + PG8_SA(b, h) + aoff + m * 2048 + k * 1024); } while (0)
#define PG8_LDB(dst, b, h) do { _Pragma("unroll") for (int n = 0; n < 2; ++n) _Pragma("unroll") for (int k = 0; k < 2; ++k) dst[n][k] = *(const PG8_LAS bf16x8*)(lds + PG8_SB(b, h) + boff + n * 2048 + k * 1024); } while (0)
#define PG8_MMA(ai, bj, At, Bt) do { __builtin_amdgcn_s_setprio(1); _Pragma("unroll") for (int m = 0; m < 4; ++m) _Pragma("unroll") for (int n = 0; n < 2; ++n) _Pragma("unroll") for (int k = 0; k < 2; ++k) \
        acc[ai][bj][m][n] = __builtin_amdgcn_mfma_f32_16x16x32_bf16(Bt[n][k], At[m][k], acc[ai][bj][m][n], 0, 0, 0); __builtin_amdgcn_s_setprio(0); } while (0)
#define PG8_WAIT_V(n) asm volatile("s_waitcnt vmcnt(" #n ")" ::: "memory")
#define PG8_WAIT_L(n) asm volatile("s_waitcnt lgkmcnt(" #n ")" ::: "memory")
#define PG8_BAR __builtin_amdgcn_s_barrier()
#define PG8_SCHED __builtin_amdgcn_sched_barrier(0)
    Unit cur, nxt; int ui = 0;
    if (!S.next(0, cur)) return;
    f32x4 acc[2][2][4][2];
#pragma unroll
    for (int a = 0; a < 2; ++a)
#pragma unroll
        for (int b = 0; b < 2; ++b)
#pragma unroll
            for (int m = 0; m < 4; ++m)
#pragma unroll
                for (int n = 0; n < 2; ++n) acc[a][b][m][n] = (f32x4){0.f, 0.f, 0.f, 0.f};
    bf16x8 At[4][2], B0[2][2], B1[2][2];
    const char* cA = (const char*)g.A + (size_t)cur.pm * tstep; const char* cB = (const char*)g.Bt + (size_t)cur.pn * tstep;
    S.a_ready(cur);
    if constexpr (SP2) {
        PG8_STAGE(PG8_SB(0, 0), cB, voffB); PG8_STAGE(PG8_SB(0, 1), cB + hstep, voffB); PG8_STAGE(PG8_SA(0, 0), cA, voffA); PG8_STAGE(PG8_SA(0, 1), cA + hstep, voffA);
        if (wr == 1) PG8_BAR;
        PG8_WAIT_V(2); PG8_BAR;
        PG8_STAGE(PG8_SB(1, 0), cB + kstep, voffB); PG8_STAGE(PG8_SA(1, 0), cA + kstep, voffA); PG8_STAGE(PG8_SB(1, 1), cB + hstep + kstep, voffB);
        PG8_WAIT_V(6); PG8_BAR;
    } else {
        PG8_STAGE(PG8_SB(0, 0), cB, voffB); PG8_STAGE(PG8_SA(0, 0), cA, voffA); PG8_STAGE(PG8_SB(0, 1), cB + hstep, voffB); PG8_STAGE(PG8_SA(0, 1), cA + hstep, voffA);
        if (wr == 1) PG8_BAR;
        PG8_WAIT_V(4); PG8_BAR;
        PG8_STAGE(PG8_SB(1, 0), cB + kstep, voffB); PG8_STAGE(PG8_SA(1, 0), cA + kstep, voffA); PG8_STAGE(PG8_SB(1, 1), cB + hstep + kstep, voffB);
        PG8_WAIT_V(6); PG8_BAR;
    }
    for (;;) {
        const bool has_next = S.next(ui + 1, nxt);
        const char* nA = has_next ? (const char*)g.A + (size_t)nxt.pm * tstep : cA; const char* nB = has_next ? (const char*)g.Bt + (size_t)nxt.pn * tstep : cB;
        for (int t = 0; t < nt; t += 2) {
            const bool last = (t == nt - 2);
            const char* a1 = cA + (size_t)(t + 1) * kstep;
            const char* a2 = last ? nA : cA + (size_t)(t + 2) * kstep; const char* b2 = last ? nB : cB + (size_t)(t + 2) * kstep;
            const char* a3 = a2 + kstep; const char* b3 = b2 + kstep;
            if (last && has_next) S.a_ready(nxt);
            if constexpr (SP2) {
            PG8_LDB(B0, 0, 0); PG8_LDB(B1, 0, 1); PG8_SCHED; PG8_LDA(At, 0, 0); PG8_STAGE(PG8_SA(1, 1), a1 + hstep, voffA);
            PG8_WAIT_V(8); PG8_WAIT_L(0); PG8_BAR; PG8_MMA(0, 0, At, B0); PG8_MMA(0, 1, At, B1); PG8_BAR; PG8_SCHED;
            PG8_LDA(At, 0, 1); PG8_STAGE(PG8_SB(0, 0), b2, voffB); PG8_STAGE(PG8_SB(0, 1), b2 + hstep, voffB); PG8_STAGE(PG8_SA(0, 0), a2, voffA);
            PG8_WAIT_V(8); PG8_WAIT_L(0); PG8_BAR; PG8_MMA(1, 0, At, B0); PG8_MMA(1, 1, At, B1); PG8_BAR; PG8_SCHED;
            PG8_LDB(B0, 1, 0); PG8_LDB(B1, 1, 1); PG8_SCHED; PG8_LDA(At, 1, 0); PG8_STAGE(PG8_SA(0, 1), a2 + hstep, voffA);
            PG8_WAIT_V(8); PG8_WAIT_L(0); PG8_BAR; PG8_MMA(0, 0, At, B0); PG8_MMA(0, 1, At, B1); PG8_BAR; PG8_SCHED;
            PG8_LDA(At, 1, 1); PG8_STAGE(PG8_SB(1, 0), b3, voffB); PG8_STAGE(PG8_SB(1, 1), b3 + hstep, voffB); PG8_STAGE(PG8_SA(1, 0), a3, voffA);
            PG8_WAIT_V(8); PG8_WAIT_L(0); PG8_BAR; PG8_MMA(1, 0, At, B0); PG8_MMA(1, 1, At, B1); PG8_BAR; PG8_SCHED;
            } else {
            PG8_LDB(B0, 0, 0); PG8_SCHED; PG8_LDA(At, 0, 0); PG8_STAGE(PG8_SA(1, 1), a1 + hstep, voffA);
            PG8_WAIT_L(8); PG8_BAR; PG8_WAIT_L(0); PG8_MMA(0, 0, At, B0); PG8_BAR; PG8_SCHED;
            PG8_LDB(B1, 0, 1); PG8_STAGE(PG8_SB(0, 0), b2, voffB);
            PG8_BAR; PG8_WAIT_L(0); PG8_MMA(0, 1, At, B1); PG8_BAR;
            PG8_LDA(At, 0, 1); PG8_STAGE(PG8_SA(0, 0), a2, voffA);
            PG8_BAR; PG8_WAIT_L(0); PG8_MMA(1, 0, At, B0); PG8_BAR; PG8_SCHED;
            PG8_STAGE(PG8_SB(0, 1), b2 + hstep, voffB);
            PG8_WAIT_V(6); PG8_BAR; PG8_MMA(1, 1, At, B1); PG8_BAR;
            PG8_LDB(B0, 1, 0); PG8_SCHED; PG8_LDA(At, 1, 0); PG8_STAGE(PG8_SA(0, 1), a2 + hstep, voffA);
            PG8_WAIT_L(8); PG8_BAR; PG8_WAIT_L(0); PG8_MMA(0, 0, At, B0); PG8_BAR; PG8_SCHED;
            PG8_LDB(B1, 1, 1); PG8_STAGE(PG8_SB(1, 0), b3, voffB);
            PG8_BAR; PG8_WAIT_L(0); PG8_MMA(0, 1, At, B1); PG8_BAR;
            PG8_LDA(At, 1, 1); PG8_STAGE(PG8_SA(1, 0), a3, voffA);
            PG8_BAR; PG8_WAIT_L(0); PG8_MMA(1, 0, At, B0); PG8_BAR; PG8_SCHED;
            PG8_STAGE(PG8_SB(1, 1), b3 + hstep, voffB);
            PG8_WAIT_V(6); PG8_BAR; PG8_MMA(1, 1, At, B1); PG8_BAR;
            }
        }
        if constexpr (ALIGN_EPI) { if (wr == 0) PG8_BAR; }
        if constexpr (!Epi::AFTER_DRAIN) { E(acc, cur, wr, wc, fr, fq); S.done(cur); }
        if (!has_next) break;
#pragma unroll
        for (int a = 0; a < 2; ++a)
#pragma unroll
            for (int b = 0; b < 2; ++b)
#pragma unroll
                for (int m = 0; m < 4; ++m)
#pragma unroll
                    for (int n = 0; n < 2; ++n) acc[a][b][m][n] = (f32x4){0.f, 0.f, 0.f, 0.f};
        cur = nxt; cA = nA; cB = nB; ++ui;
        if constexpr (ALIGN_EPI) { if (wr == 1) PG8_BAR; }
    }
    PG8_WAIT_V(0);
    if constexpr (!ALIGN_EPI) { if (wr == 0) PG8_BAR; }
    PG8_BAR;
    if constexpr (Epi::AFTER_DRAIN) { E.fused(acc, cur, wr, wc, fr, fq, lds, wid, lane); S.done(cur); }
#undef PG8_SA
#undef PG8_SB
#undef PG8_STAGE
#undef PG8_LDA
#undef PG8_LDB
#undef PG8_MMA
#undef PG8_WAIT_V
#undef PG8_WAIT_L
#undef PG8_BAR
#undef PG8_SCHED
}
}

#define DI __device__ __forceinline__
#define LAS __attribute__((address_space(3)))
typedef unsigned short bf16;
typedef __bf16 bf16x2_t __attribute__((ext_vector_type(2)));
typedef float f32x2_t __attribute__((ext_vector_type(2)));
typedef float f32x4 __attribute__((ext_vector_type(4)));
typedef float f32x16 __attribute__((ext_vector_type(16)));
typedef short bf16x8 __attribute__((ext_vector_type(8)));
typedef short s16x4 __attribute__((ext_vector_type(4)));
typedef unsigned u32x4 __attribute__((ext_vector_type(4)));
typedef unsigned u32x2 __attribute__((ext_vector_type(2)));

constexpr int NT = 512, NWAVES = 8;
constexpr int LDS_BYTES = 147456;
constexpr int T_TOK = 32768, DM = 1024, SEQ = 2048, NB = 16;
constexpr float EPS = 1e-6f;
constexpr size_t MiB = 1u << 20;
constexpr size_t WS_MODS = 1 * MiB, WS_KVMODS = WS_MODS + (size_t)2 * 16 * 6144 * 4;
constexpr size_t WS_GATES = 2 * MiB, WS_BLAST = 4 * MiB, WS_MLOC = 4 * MiB + 65536, WS_MPREV = 4 * MiB + 131072, WS_NLOC = 5 * MiB;
constexpr size_t WS_WG = 6 * MiB, WS_SUBK = 7 * MiB;
constexpr size_t WS_WIN = 8 * MiB, WS_WOUT = 14 * MiB, WS_WKV = 16 * MiB, WS_WSQ = 20 * MiB, WS_WSO = 22 * MiB, WS_WPQ = 24 * MiB;
constexpr size_t WS_IDX = 36 * MiB, WS_GATE = 44 * MiB, WS_SU = 60 * MiB;
constexpr size_t WS_H2Q = 256 * MiB, WS_SH = 288 * MiB + 0;
constexpr size_t WS_U = 64 * MiB, WS_V = 128 * MiB, WS_H = 192 * MiB, WS_HB = 256 * MiB, WS_PROJ = 320 * MiB, WS_END = 512 * MiB;
constexpr size_t WS_CST = WS_HB;
constexpr size_t WS_Q = WS_PROJ, WS_K = WS_PROJ + 64 * MiB, WS_VV = WS_PROJ + 128 * MiB, WS_PQ = WS_PROJ;

struct Args { const float* in[23]; float* out; unsigned char* ws; int ph_lo, ph_hi; };
struct Frame {
    LAS unsigned char* lds;
    const float* in[23]; float* out; unsigned char* ws;
    int tid, lane, wave, bid, G;
};

DI unsigned cvtpk(float lo, float hi) { f32x2_t v = {lo, hi}; bf16x2_t b = __builtin_convertvector(v, bf16x2_t); return __builtin_bit_cast(unsigned, b); }
DI float bflo(unsigned u) { return __uint_as_float(u << 16); }
DI float bfhi(unsigned u) { return __uint_as_float(u & 0xffff0000u); }

template <int M> DI unsigned lxu(unsigned v) {
    if constexpr (M == 1) return (unsigned)__builtin_amdgcn_mov_dpp((int)v, 0xB1, 0xf, 0xf, true);
    else if constexpr (M == 2) return (unsigned)__builtin_amdgcn_mov_dpp((int)v, 0x4E, 0xf, 0xf, true);
    else if constexpr (M == 7) return (unsigned)__builtin_amdgcn_mov_dpp((int)v, 0x141, 0xf, 0xf, true);
    else if constexpr (M == 8) return (unsigned)__builtin_amdgcn_mov_dpp((int)v, 0x128, 0xf, 0xf, true);
    else if constexpr (M == 16) { auto r = __builtin_amdgcn_permlane16_swap(v, v, false, false); return r[0] ^ r[1] ^ v; }
    else { static_assert(M == 32, "lxu: M"); auto r = __builtin_amdgcn_permlane32_swap(v, v, false, false); return r[0] ^ r[1] ^ v; }
}
template <int M> DI float lx(float v) { return __uint_as_float(lxu<M>(__float_as_uint(v))); }
template <int M> DI int lx(int v) { return (int)lxu<M>((unsigned)v); }
DI float wave_sum(float v) { v += lx<1>(v); v += lx<2>(v); v += lx<7>(v); v += lx<8>(v); v += lx<16>(v); v += lx<32>(v); return v; }
DI float wave_max(float v) { v = fmaxf(v, lx<1>(v)); v = fmaxf(v, lx<2>(v)); v = fmaxf(v, lx<7>(v)); v = fmaxf(v, lx<8>(v)); v = fmaxf(v, lx<16>(v)); v = fmaxf(v, lx<32>(v)); return v; }
DI int crow(int r, int hi) { return (r & 3) + 8 * (r >> 2) + 4 * hi; }
#define MFMA32(a, b, c) __builtin_amdgcn_mfma_f32_32x32x16_bf16((a), (b), (c), 0, 0, 0)
typedef short v4i16_t __attribute__((ext_vector_type(4)));
DI s16x4 tr16(const LAS unsigned char* p) { return __builtin_bit_cast(s16x4, __builtin_amdgcn_ds_read_tr16_b64_v4i16((LAS v4i16_t*)p)); }
DI int tr_off(int tok, int ch) { return (ch >> 2) * 4096 + (tok >> 4) * 1024 + (tok & 15) * 64 + (ch & 3) * 16; }
DI bf16x8 tr_frag(const LAS unsigned char* img, int dh, int ks, int lane) {
    const int hi = lane >> 5; const int vb = ((lane >> 4) & 1) * 32 + (lane & 3) * 8 + (4 * hi + ((lane & 15) >> 2)) * 64;
    const s16x4 lo = tr16(img + vb + dh * 4096 + ks * 1024), h2 = tr16(img + vb + dh * 4096 + ks * 1024 + 512);
    return __builtin_shufflevector(lo, h2, 0, 1, 2, 3, 4, 5, 6, 7);
}
template <int NTOK> DI bf16x8 row_frag(const LAS unsigned char* img, int tt, int ks, int lane) {
    const int hi = lane >> 5, r32 = lane & 31;
    return *(const LAS bf16x8*)(img + (2 * ks + hi) * (NTOK * 16) + (32 * tt + r32) * 16);
}
DI bf16x8 pack8(const f32x16& x, int s) {
    u32x4 p; p.x = cvtpk(x[8 * s], x[8 * s + 1]); p.y = cvtpk(x[8 * s + 2], x[8 * s + 3]); p.z = cvtpk(x[8 * s + 4], x[8 * s + 5]); p.w = cvtpk(x[8 * s + 6], x[8 * s + 7]);
    return __builtin_bit_cast(bf16x8, p);
}

DI void p0_ada(Frame& F) {
    LAS float* sil = (LAS float*)F.lds;
    LAS float* red = (LAS float*)(F.lds + 65536);
    const float* c = F.in[1];
    for (int i = F.tid; i < 16 * 1024; i += NT) { const int b = i >> 10, d = i & 1023; const float v = c[i]; sil[d * 16 + b] = v / (1.f + expf(-v)); }
    __syncthreads();
    for (int item = F.bid; item < 224; item += F.G) {
        const float* W; const float* bias; float* out; int N, col0;
        if (item < 192) { const int layer = item / 96, it = item % 96; W = F.in[2] + (size_t)layer * 1024 * 6144; bias = F.in[3] + layer * 6144; N = 6144; col0 = it * 64; out = (float*)(F.ws + WS_MODS) + (size_t)layer * 16 * 6144; }
        else { const int it = item - 192; W = F.in[11]; bias = F.in[12]; N = 2048; col0 = it * 64; out = (float*)(F.ws + WS_KVMODS); }
        float acc[16];
#pragma unroll
        for (int b = 0; b < 16; ++b) acc[b] = 0.f;
        const int d0 = F.wave * 128;
        const float* wp = W + (size_t)d0 * N + col0 + F.lane;
#pragma unroll 4
        for (int d = 0; d < 128; ++d) {
            const float w = wp[(size_t)d * N];
            const LAS f32x4* s4 = (const LAS f32x4*)(sil + (d0 + d) * 16);
            const f32x4 s0 = s4[0], s1 = s4[1], s2 = s4[2], s3 = s4[3];
            acc[0] += w * s0[0]; acc[1] += w * s0[1]; acc[2] += w * s0[2]; acc[3] += w * s0[3];
            acc[4] += w * s1[0]; acc[5] += w * s1[1]; acc[6] += w * s1[2]; acc[7] += w * s1[3];
            acc[8] += w * s2[0]; acc[9] += w * s2[1]; acc[10] += w * s2[2]; acc[11] += w * s2[3];
            acc[12] += w * s3[0]; acc[13] += w * s3[1]; acc[14] += w * s3[2]; acc[15] += w * s3[3];
        }
#pragma unroll
        for (int b = 0; b < 16; ++b) red[(F.wave * 16 + b) * 64 + F.lane] = acc[b];
        __syncthreads();
        for (int i = F.tid; i < 1024; i += NT) { const int b = i >> 6, l = i & 63; float s = 0.f;
#pragma unroll
            for (int w = 0; w < 8; ++w) s += red[(w * 16 + b) * 64 + l];
            out[(size_t)b * N + col0 + l] = s + bias[col0 + l]; }
        __syncthreads();
    }
}
DI void transpose_item(const float* W, int ldw, bf16* WT, int dst_row0, LAS float* scr, int k0, int n0, int lane) {
#pragma unroll 8
    for (int i = 0; i < 32; ++i) { const int kk = 2 * i + (lane >> 5); scr[kk * 33 + (lane & 31)] = W[(size_t)(k0 + kk) * ldw + n0 + (lane & 31)]; }
    asm volatile("s_waitcnt lgkmcnt(0)" ::: "memory");
    const int c = lane & 7;
#pragma unroll
    for (int j = 0; j < 4; ++j) { const int n = (lane >> 3) + 8 * j; const LAS float* s = scr + (8 * c) * 33 + n;
        u32x4 o; o.x = cvtpk(s[0 * 33], s[1 * 33]); o.y = cvtpk(s[2 * 33], s[3 * 33]); o.z = cvtpk(s[4 * 33], s[5 * 33]); o.w = cvtpk(s[6 * 33], s[7 * 33]);
        *(u32x4*)(WT + (size_t)(dst_row0 + n) * 1024 + k0 + 8 * c) = o; }
    asm volatile("s_waitcnt lgkmcnt(0)" ::: "memory");
}
DI int permrow(int c) { return (c & ~255) + 32 * (4 * ((c >> 5) & 1) + ((c >> 6) & 3)) + (c & 31); }
DI void p0a_prologue(Frame& F) {
    if (F.bid == 0) for (int i = F.tid; i < 2048; i += NT) ((unsigned*)(F.ws + 4096))[i] = 0u;
    if (F.bid == 0) for (int i = F.tid; i < 4096; i += NT) ((unsigned*)(F.ws + 65536))[i] = 0u;
    p0_ada(F);
    for (size_t i = (size_t)F.bid * NT + F.tid; i < 16 * 1024; i += (size_t)F.G * NT) { const int g = (int)(i >> 10), k = (int)(i & 1023); ((float*)(F.ws + WS_WG))[i] = F.in[6][(size_t)k * 3088 + 3072 + g]; }
}
DI void p0b_prologue(Frame& F) {
    LAS float* scr = (LAS float*)(F.lds + F.wave * 16384);
    const int gw = F.bid * NWAVES + F.wave, NGW = F.G * NWAVES;
    for (int it = gw; it < 6144; it += NGW) {
        int r = it; const float* W; int ldw, ncols; bf16* dst; bool perm;
        if (r < 1536) { W = F.in[6]; ldw = 3088; ncols = 3072; dst = (bf16*)(F.ws + WS_WIN); perm = false; }
        else if ((r -= 1536) < 512) { W = F.in[10]; ldw = 1024; ncols = 1024; dst = (bf16*)(F.ws + WS_WOUT); perm = false; }
        else if ((r -= 512) < 1024) { W = F.in[14]; ldw = 2048; ncols = 2048; dst = (bf16*)(F.ws + WS_WKV); perm = true; }
        else if ((r -= 1024) < 512) { W = F.in[16]; ldw = 1024; ncols = 1024; dst = (bf16*)(F.ws + WS_WSQ); perm = true; }
        else if ((r -= 512) < 512) { W = F.in[18]; ldw = 1024; ncols = 1024; dst = (bf16*)(F.ws + WS_WSO); perm = false; }
        else if ((r -= 512) < 1024) { W = F.in[19]; ldw = 2048; ncols = 2048; dst = (bf16*)(F.ws + WS_WPQ); perm = false; }
        else { r -= 1024; W = F.in[19] + (size_t)1024 * 2048; ldw = 2048; ncols = 2048; dst = (bf16*)(F.ws + WS_WPQ) + (size_t)2048 * 1024; perm = false; }
        const int nblk = ncols / 32, kb = r / nblk, nb = r % nblk, n0 = 32 * nb;
        transpose_item(W, ldw, dst, perm ? permrow(n0) : n0, scr, 64 * kb, n0, F.lane);
    }
    const size_t gt = (size_t)F.bid * NT + F.tid, NGT = (size_t)F.G * NT;
    constexpr size_t TBL16 = (size_t)2 * 16384 * 1024 / 16;
    for (size_t j = gt; j < TBL16; j += NGT) {
        const f32x4* src = (const f32x4*)F.in[22] + 4 * j;
        const f32x4 a = src[0] * 4.f, b = src[1] * 4.f, c2 = src[2] * 4.f, d = src[3] * 4.f;
        int p0 = 0, p1 = 0, p2 = 0, p3 = 0;
        p0 = __builtin_amdgcn_cvt_pk_fp8_f32(a[0], a[1], p0, false); p0 = __builtin_amdgcn_cvt_pk_fp8_f32(a[2], a[3], p0, true);
        p1 = __builtin_amdgcn_cvt_pk_fp8_f32(b[0], b[1], p1, false); p1 = __builtin_amdgcn_cvt_pk_fp8_f32(b[2], b[3], p1, true);
        p2 = __builtin_amdgcn_cvt_pk_fp8_f32(c2[0], c2[1], p2, false); p2 = __builtin_amdgcn_cvt_pk_fp8_f32(c2[2], c2[3], p2, true);
        p3 = __builtin_amdgcn_cvt_pk_fp8_f32(d[0], d[1], p3, false); p3 = __builtin_amdgcn_cvt_pk_fp8_f32(d[2], d[3], p3, true);
        const size_t q = j & 63, e = (j >> 6) & 16383, ly = j >> 20;
        ((u32x4*)(F.ws + WS_V))[(((ly * 8 + (q >> 3)) * 16384 + e) << 3) + (q & 7)] = (u32x4){(unsigned)p0, (unsigned)p1, (unsigned)p2, (unsigned)p3};
    }
    for (int row = gw; row < 2 * 16384; row += NGW) {
        const f32x4* src = (const f32x4*)(F.in[21] + (size_t)row * 1024) + 4 * F.lane;
        const f32x4 a = src[0], b = src[1], c2 = src[2], d = src[3];
        float m = fmaxf(fmaxf(fmaxf(fabsf(a[0]), fabsf(a[1])), fmaxf(fabsf(a[2]), fabsf(a[3]))), fmaxf(fmaxf(fabsf(b[0]), fabsf(b[1])), fmaxf(fabsf(b[2]), fabsf(b[3]))));
        m = fmaxf(m, fmaxf(fmaxf(fmaxf(fabsf(c2[0]), fabsf(c2[1])), fmaxf(fabsf(c2[2]), fabsf(c2[3]))), fmaxf(fmaxf(fabsf(d[0]), fabsf(d[1])), fmaxf(fabsf(d[2]), fabsf(d[3])))));
        m = fmaxf(wave_max(m), 1e-30f);
        const float inv = 127.0f / m;
        auto q4 = [&](const f32x4& v) -> unsigned { const int x0 = (int)rintf(v[0] * inv), x1 = (int)rintf(v[1] * inv), x2 = (int)rintf(v[2] * inv), x3 = (int)rintf(v[3] * inv);
            return (unsigned)(x0 & 255) | ((unsigned)(x1 & 255) << 8) | ((unsigned)(x2 & 255) << 16) | ((unsigned)(x3 & 255) << 24); };
        { const size_t ly = (size_t)row >> 14, e = (size_t)row & 16383;
          ((u32x4*)(F.ws + WS_U))[(((ly * 8 + (F.lane >> 3)) * 16384 + e) << 3) + (F.lane & 7)] = (u32x4){q4(a), q4(b), q4(c2), q4(d)}; }
        if (F.lane == 0) ((float*)(F.ws + WS_SU))[row] = m * (1.0f / 127.0f);
    }
    for (size_t i = gt; i < 65536 / 2; i += NGT) { const float a = F.in[20][2 * i], b = F.in[20][2 * i + 1]; ((unsigned*)(F.ws + WS_SUBK))[i] = cvtpk(a, b); }
}

template <bool GATES, bool Q8 = false> DI void norm_phase(Frame& F, const float* xin, const float* g, const float* shp, const float* scp, int bstride, bf16* hout) {
    const int gw = F.bid * NWAVES + F.wave, NGW = F.G * NWAVES;
    LAS float* wg = (LAS float*)F.lds;
    if (GATES) { const float* src = (const float*)(F.ws + WS_WG); for (int i = F.tid; i < 16 * 1024 / 4; i += NT) ((LAS f32x4*)wg)[i] = ((const f32x4*)src)[i]; __syncthreads(); }
    for (int chunk = gw; chunk < T_TOK / 16; chunk += NGW) {
        const int row0 = chunk * 16, b = row0 >> 11;
        f32x4 A[4], Bv[4];
#pragma unroll
        for (int j = 0; j < 4; ++j) { const int c = 4 * F.lane + 256 * j; const f32x4 gg = *(const f32x4*)(g + c), sc = *(const f32x4*)(scp + (size_t)b * bstride + c);
            A[j] = gg * (sc + 1.0f); Bv[j] = *(const f32x4*)(shp + (size_t)b * bstride + c); }
        f32x4 nx[4];
        { const f32x4* xr = (const f32x4*)(xin + (size_t)row0 * DM) + F.lane;
#pragma unroll
          for (int j = 0; j < 4; ++j) nx[j] = xr[64 * j]; }
#pragma unroll 2
        for (int r = 0; r < 16; ++r) {
            const int row = row0 + r;
            f32x4 v[4]; float ss = 0.f;
#pragma unroll
            for (int j = 0; j < 4; ++j) { v[j] = nx[j]; ss += (v[j][0] * v[j][0] + v[j][1] * v[j][1]) + (v[j][2] * v[j][2] + v[j][3] * v[j][3]); }
            { const f32x4* xr = (const f32x4*)(xin + (size_t)(r < 15 ? row + 1 : row) * DM) + F.lane;
#pragma unroll
              for (int j = 0; j < 4; ++j) nx[j] = xr[64 * j]; }
            const float rstd = 1.0f / sqrtf(wave_sum(ss) * (1.0f / DM) + EPS);
            unsigned long long* o8 = (unsigned long long*)(hout + (size_t)row * DM) + F.lane;
#pragma unroll
            for (int j = 0; j < 4; ++j) { v[j] = v[j] * rstd * A[j] + Bv[j]; o8[64 * j] = (unsigned long long)cvtpk(v[j][0], v[j][1]) | ((unsigned long long)cvtpk(v[j][2], v[j][3]) << 32); }
            if (Q8) {
                float m = 0.f;
#pragma unroll
                for (int j = 0; j < 4; ++j) m = fmaxf(m, fmaxf(fmaxf(fabsf(v[j][0]), fabsf(v[j][1])), fmaxf(fabsf(v[j][2]), fabsf(v[j][3]))));
                m = fmaxf(wave_max(m), 1e-30f);
                const float inv = 127.0f / m;
                unsigned* q8 = (unsigned*)(F.ws + WS_H2Q + (size_t)row * DM) + F.lane;
#pragma unroll
                for (int j = 0; j < 4; ++j) { const int x0 = (int)rintf(v[j][0] * inv), x1 = (int)rintf(v[j][1] * inv), x2 = (int)rintf(v[j][2] * inv), x3 = (int)rintf(v[j][3] * inv);
                    q8[64 * j] = (unsigned)(x0 & 255) | ((unsigned)(x1 & 255) << 8) | ((unsigned)(x2 & 255) << 16) | ((unsigned)(x3 & 255) << 24); }
                if (F.lane == 0) ((float*)(F.ws + WS_SH))[row] = m * (1.0f / 127.0f);
            }
            if (GATES) {
                float p[16];
#pragma unroll
                for (int q = 0; q < 16; ++q) { float s = 0.f;
#pragma unroll
                    for (int j = 0; j < 4; ++j) { const f32x4 w = *(const LAS f32x4*)(wg + q * 1024 + 4 * F.lane + 256 * j); s += (v[j][0] * w[0] + v[j][1] * w[1]) + (v[j][2] * w[2] + v[j][3] * w[3]); }
                    p[q] = s; if ((q & 3) == 3) { asm volatile("" ::: "memory"); __builtin_amdgcn_sched_barrier(0); } }
#pragma unroll
                for (int i = 0; i < 8; ++i) { const bool up = (F.lane & 32) != 0; const float send = up ? p[i] : p[i + 8], keep = up ? p[i + 8] : p[i]; p[i] = keep + lx<32>(send); }
#pragma unroll
                for (int i = 0; i < 4; ++i) { const bool up = (F.lane & 16) != 0; const float send = up ? p[i] : p[i + 4], keep = up ? p[i + 4] : p[i]; p[i] = keep + lx<16>(send); }
#pragma unroll
                for (int i = 0; i < 2; ++i) { const bool up = (F.lane & 8) != 0; const float send = up ? p[i] : p[i + 2], keep = up ? p[i + 2] : p[i]; p[i] = keep + lx<8>(send); }
                { const bool up = (F.lane & 4) != 0; const float send = up ? p[0] : p[1], keep = up ? p[1] : p[0]; p[0] = keep + lx<7>(send); }
                p[0] += lx<2>(p[0]); p[0] += lx<1>(p[0]);
                const int gi = ((F.lane >> 5) & 1) * 8 + ((F.lane >> 4) & 1) * 4 + ((F.lane >> 3) & 1) * 2 + ((F.lane >> 2) & 1);
                if ((F.lane & 3) == 0) ((float*)(F.ws + WS_GATES))[(size_t)row * 16 + gi] = p[0];
            }
        }
    }
}

DI void norm2_phase(Frame& F, const float* xin, const float* gA, const float* shA, const float* scA, int strideA, bf16* outA, const float* gB, const float* shB, const float* scB, int strideB, bf16* outB) {
    const int gw = F.bid * NWAVES + F.wave, NGW = F.G * NWAVES;
    for (int chunk = gw; chunk < T_TOK / 16; chunk += NGW) {
        const int row0 = chunk * 16, b = row0 >> 11;
        f32x4 A1[4], B1[4], A2[4], B2[4];
#pragma unroll
        for (int j = 0; j < 4; ++j) { const int c = 4 * F.lane + 256 * j;
            A1[j] = *(const f32x4*)(gA + c) * (*(const f32x4*)(scA + (size_t)b * strideA + c) + 1.0f); B1[j] = *(const f32x4*)(shA + (size_t)b * strideA + c);
            A2[j] = *(const f32x4*)(gB + c) * (*(const f32x4*)(scB + (size_t)b * strideB + c) + 1.0f); B2[j] = *(const f32x4*)(shB + (size_t)b * strideB + c); }
        f32x4 nx[4];
        { const f32x4* xr = (const f32x4*)(xin + (size_t)row0 * DM) + F.lane;
#pragma unroll
          for (int j = 0; j < 4; ++j) nx[j] = xr[64 * j]; }
#pragma unroll 2
        for (int r = 0; r < 16; ++r) {
            const int row = row0 + r;
            f32x4 v[4]; float ss = 0.f;
#pragma unroll
            for (int j = 0; j < 4; ++j) { v[j] = nx[j]; ss += (v[j][0] * v[j][0] + v[j][1] * v[j][1]) + (v[j][2] * v[j][2] + v[j][3] * v[j][3]); }
            { const f32x4* xr = (const f32x4*)(xin + (size_t)(r < 15 ? row + 1 : row) * DM) + F.lane;
#pragma unroll
              for (int j = 0; j < 4; ++j) nx[j] = xr[64 * j]; }
            const float rstd = 1.0f / sqrtf(wave_sum(ss) * (1.0f / DM) + EPS);
            unsigned long long* oa = (unsigned long long*)(outA + (size_t)row * DM) + F.lane; unsigned long long* ob = (unsigned long long*)(outB + (size_t)row * DM) + F.lane;
#pragma unroll
            for (int j = 0; j < 4; ++j) { const f32x4 xn = v[j] * rstd; const f32x4 ya = xn * A1[j] + B1[j], yb = xn * A2[j] + B2[j];
                oa[64 * j] = (unsigned long long)cvtpk(ya[0], ya[1]) | ((unsigned long long)cvtpk(ya[2], ya[3]) << 32);
                ob[64 * j] = (unsigned long long)cvtpk(yb[0], yb[1]) | ((unsigned long long)cvtpk(yb[2], yb[3]) << 32); }
        }
    }
}

DI void mlstm_gates(Frame& F, size_t trow0, int h, float& ipre, float& bcum, float& blast) {
    const float* gates = (const float*)(F.ws + WS_GATES); const float* bif = F.in[8];
    const float iv = gates[(trow0 + F.lane) * 16 + h] + bif[h];
    const float fv = gates[(trow0 + F.lane) * 16 + 8 + h] + bif[8 + h];
    float b = -(fmaxf(-fv, 0.f) + log1pf(expf(-fabsf(fv))));
#pragma unroll
    for (int d = 1; d < 64; d <<= 1) { const float t = __shfl_up(b, d); if (F.lane >= d) b += t; }
    ipre = iv; bcum = b; blast = __shfl(b, 63);
}
template <int MODE> DI void stage_qk(LAS unsigned char* dst, const LAS float* e_s, const bf16* proj, const float* convw, int tseq0, size_t trow0, int col0, int lane) {
    const int g8 = lane >> 3, ch = lane & 7, col = col0 + 8 * ch;
    float cw[4][8];
#pragma unroll
    for (int tap = 0; tap < 4; ++tap) { const f32x4 a = *(const f32x4*)(convw + tap * 1024 + col), b = *(const f32x4*)(convw + tap * 1024 + col + 4);
        cw[tap][0] = a[0]; cw[tap][1] = a[1]; cw[tap][2] = a[2]; cw[tap][3] = a[3]; cw[tap][4] = b[0]; cw[tap][5] = b[1]; cw[tap][6] = b[2]; cw[tap][7] = b[3]; }
#pragma unroll 1
    for (int ph = 0; ph < 2; ++ph) {
        float x[7][8];
#pragma unroll
        for (int i = 0; i < 7; ++i) {
            const int rel = 8 * g8 + 4 * ph + i - 3; const bool valid = (tseq0 + rel) >= 0; const long rr = valid ? (long)rel : 0;
            u32x4 raw = *(const u32x4*)(proj + (size_t)((long)trow0 + rr) * 3072 + col);
            if (!valid) raw = (u32x4){0u, 0u, 0u, 0u};
            x[i][0] = bflo(raw.x); x[i][1] = bfhi(raw.x); x[i][2] = bflo(raw.y); x[i][3] = bfhi(raw.y); x[i][4] = bflo(raw.z); x[i][5] = bfhi(raw.z); x[i][6] = bflo(raw.w); x[i][7] = bfhi(raw.w);
        }
#pragma unroll
        for (int o = 0; o < 4; ++o) {
            const int tok = 8 * g8 + 4 * ph + o;
            float y[8];
#pragma unroll
            for (int e = 0; e < 8; ++e) { float a = cw[0][e] * x[o][e] + cw[1][e] * x[o + 1][e] + cw[2][e] * x[o + 2][e] + cw[3][e] * x[o + 3][e]; y[e] = a / (1.f + __expf(-a)); }
            float sc = 1.f; if (MODE == 0) sc = e_s[tok]; if (MODE == 1) sc = 0.125f;
            u32x4 w; w.x = cvtpk(y[0] * sc, y[1] * sc); w.y = cvtpk(y[2] * sc, y[3] * sc); w.z = cvtpk(y[4] * sc, y[5] * sc); w.w = cvtpk(y[6] * sc, y[7] * sc);
            const int off = (MODE == 0) ? tr_off(tok, ch) : ch * 1024 + tok * 16;
            *(LAS u32x4*)(dst + off) = w;
        }
    }
}
DI void stage_v_half(LAS unsigned char* dst, const bf16* proj, size_t trow0, int col0, int lane) {
    const int g8 = lane >> 3, ch = lane & 7;
#pragma unroll
    for (int o = 0; o < 8; ++o) { const int tok = 8 * g8 + o; const u32x4 raw = *(const u32x4*)(proj + (trow0 + tok) * 3072 + col0 + 8 * ch); *(LAS u32x4*)(dst + tr_off(tok, ch)) = raw; }
}
constexpr int MW_LDS = 17408;

DI void p3_mlstm_local(Frame& F) {
    LAS unsigned char* wl = F.lds + F.wave * MW_LDS;
    LAS unsigned char* kimg = wl; LAS unsigned char* vimg = wl + 8192; LAS float* e_s = (LAS float*)(wl + 16384);
    const bf16* proj = (const bf16*)(F.ws + WS_PROJ);
    bf16* cst = (bf16*)(F.ws + WS_CST);
    const int lane = F.lane, r32 = lane & 31, hi = lane >> 5;
    for (int bu = F.bid; bu < 512; bu += F.G) {
        int h = F.wave; asm volatile("" : "+s"(h));
        const int b = bu >> 5, c = bu & 31; const int unit = bu * 8 + h; const size_t trow0 = (size_t)b * SEQ + c * 64;
        float ipre, bcum, blast; mlstm_gates(F, trow0, h, ipre, bcum, blast);
        const float w = blast - bcum + ipre; const float mloc = wave_max(w); const float e = expf(w - mloc);
        e_s[lane] = e;
        if (lane == 0) { ((float*)(F.ws + WS_BLAST))[unit] = blast; ((float*)(F.ws + WS_MLOC))[unit] = mloc; }
        stage_qk<0>(kimg, e_s, proj, F.in[7], c * 64, trow0, 512 + h * 64, lane);
        bf16x8 kef[2][4];
#pragma unroll
        for (int kt = 0; kt < 2; ++kt)
#pragma unroll
            for (int ks = 0; ks < 4; ++ks) kef[kt][ks] = tr_frag(kimg, kt, ks, lane);
        const bf16x8 ones = {0x3F80, 0x3F80, 0x3F80, 0x3F80, 0x3F80, 0x3F80, 0x3F80, 0x3F80};
#pragma unroll
        for (int kt = 0; kt < 2; ++kt) { f32x16 an = {};
#pragma unroll
            for (int ks = 0; ks < 4; ++ks) an = MFMA32(kef[kt][ks], ones, an);
            if (r32 == 0) {
#pragma unroll
                for (int r = 0; r < 16; ++r) ((float*)(F.ws + WS_NLOC))[(size_t)unit * 64 + 32 * kt + crow(r, hi)] = an[r]; } }
#pragma unroll 1
        for (int vh = 0; vh < 2; ++vh) {
            stage_v_half(vimg, proj, trow0, 1024 + h * 128 + 64 * vh, lane);
#pragma unroll
            for (int vt = 0; vt < 2; ++vt) {
                bf16x8 vf[4];
#pragma unroll
                for (int ks = 0; ks < 4; ++ks) vf[ks] = tr_frag(vimg, vt, ks, lane);
#pragma unroll
                for (int kt = 0; kt < 2; ++kt) { f32x16 acc = {};
#pragma unroll
                    for (int ks = 0; ks < 4; ++ks) acc = MFMA32(kef[kt][ks], vf[ks], acc);
                    bf16* dstp = cst + ((size_t)unit * 128 + 64 * vh + 32 * vt + r32) * 64 + 32 * kt + 4 * hi;
#pragma unroll
                    for (int rg = 0; rg < 4; ++rg) { u32x2 pk; pk.x = cvtpk(acc[4 * rg], acc[4 * rg + 1]); pk.y = cvtpk(acc[4 * rg + 2], acc[4 * rg + 3]); *(u32x2*)(dstp + 8 * rg) = pk; }
                }
            }
        }
    }
}
DI void p4_scan(Frame& F) {
    const int gt = F.bid * NT + F.tid, NGT = F.G * NT;
    const float* mlocp = (const float*)(F.ws + WS_MLOC); const float* blastp = (const float*)(F.ws + WS_BLAST);
    for (int item = gt; item < 128 * 1024; item += NGT) {
        const int bh = item >> 10, e8 = item & 1023, b = bh >> 3, h = bh & 7;
        float st[8]; float m = 0.f;
#pragma unroll
        for (int i = 0; i < 8; ++i) st[i] = 0.f;
        u32x4* p0 = (u32x4*)((bf16*)(F.ws + WS_CST) + (size_t)((b * 32) * 8 + h) * 8192) + e8;
        const int u0 = (b * 32) * 8 + h;
#pragma unroll 1
        for (int c0 = 0; c0 < 32; c0 += 8) {
            u32x4 raw[8]; float ml[8], bl[8];
#pragma unroll
            for (int j = 0; j < 8; ++j) { raw[j] = p0[(size_t)(c0 + j) * 8192]; ml[j] = mlocp[u0 + (c0 + j) * 8]; bl[j] = blastp[u0 + (c0 + j) * 8]; }
#pragma unroll
            for (int j = 0; j < 8; ++j) {
                u32x4 o; o.x = cvtpk(st[0], st[1]); o.y = cvtpk(st[2], st[3]); o.z = cvtpk(st[4], st[5]); o.w = cvtpk(st[6], st[7]); p0[(size_t)(c0 + j) * 8192] = o;
                const float mn = fmaxf(bl[j] + m, ml[j]), a = __expf(bl[j] + m - mn), r = __expf(ml[j] - mn);
                st[0] = a * st[0] + r * bflo(raw[j].x); st[1] = a * st[1] + r * bfhi(raw[j].x); st[2] = a * st[2] + r * bflo(raw[j].y); st[3] = a * st[3] + r * bfhi(raw[j].y);
                st[4] = a * st[4] + r * bflo(raw[j].z); st[5] = a * st[5] + r * bfhi(raw[j].z); st[6] = a * st[6] + r * bflo(raw[j].w); st[7] = a * st[7] + r * bfhi(raw[j].w);
                m = mn;
            }
        }
    }
    for (int item = gt; item < 128 * 64; item += NGT) {
        const int bh = item >> 6, k = item & 63, b = bh >> 3, h = bh & 7;
        float ns = 0.f, m = 0.f;
        const int u0 = (b * 32) * 8 + h;
#pragma unroll 1
        for (int c0 = 0; c0 < 32; c0 += 8) {
            float nl[8], ml[8], bl[8];
#pragma unroll
            for (int j = 0; j < 8; ++j) { const int unit = u0 + (c0 + j) * 8; nl[j] = ((const float*)(F.ws + WS_NLOC))[(size_t)unit * 64 + k]; ml[j] = mlocp[unit]; bl[j] = blastp[unit]; }
#pragma unroll
            for (int j = 0; j < 8; ++j) { const int unit = u0 + (c0 + j) * 8;
                ((float*)(F.ws + WS_NLOC))[(size_t)unit * 64 + k] = ns; if (k == 0) ((float*)(F.ws + WS_MPREV))[unit] = m;
                const float mn = fmaxf(bl[j] + m, ml[j]), a = __expf(bl[j] + m - mn), r = __expf(ml[j] - mn);
                ns = a * ns + r * nl[j]; m = mn; }
        }
    }
}
DI void p5_mlstm_out(Frame& F) {
    LAS unsigned char* wl = F.lds + F.wave * MW_LDS;
    LAS unsigned char* qimg = wl; LAS unsigned char* kimg = wl + 8192; LAS float* sc = (LAS float*)(wl + 16384);
    const bf16* proj = (const bf16*)(F.ws + WS_PROJ);
    const bf16* cst = (const bf16*)(F.ws + WS_CST);
    bf16* hh = (bf16*)(F.ws + WS_H);
    for (int bu = F.bid; bu < 512; bu += F.G) {
        int lane = F.lane; asm volatile("" : "+v"(lane)); const int r32 = lane & 31, hi = lane >> 5;
        int h = F.wave; asm volatile("" : "+s"(h));
        const int b = bu >> 5, c = bu & 31; const int unit = bu * 8 + h; const size_t trow0 = (size_t)b * SEQ + c * 64;
        {
            float ipre, bcum, blast; mlstm_gates(F, trow0, h, ipre, bcum, blast);
            const float mprev = ((const float*)(F.ws + WS_MPREV))[unit];
            const float gg = ipre - bcum; float pm = gg;
#pragma unroll
            for (int d = 1; d < 64; d <<= 1) { const float t = __shfl_up(pm, d); if (lane >= d) pm = fmaxf(pm, t); }
            const float Mx = fmaxf(mprev, pm), mt = bcum + Mx;
            sc[lane] = gg; sc[64 + lane] = Mx; sc[128 + lane] = expf(mprev - Mx); sc[192 + lane] = expf(-mt);
        }
#pragma unroll 1
        for (int lt = 0; lt < 2; ++lt) {
            const int l = 32 * lt + r32;
            const size_t t = trow0 + l;
            stage_qk<1>(qimg, nullptr, proj, F.in[7], c * 64, trow0, h * 64, lane);
            stage_qk<2>(kimg, nullptr, proj, F.in[7], c * 64, trow0, 512 + h * 64, lane);
            asm volatile("" ::: "memory"); __builtin_amdgcn_sched_barrier(0);
            bf16x8 cf[4][4];
#pragma unroll
            for (int vt = 0; vt < 4; ++vt)
#pragma unroll
                for (int ks = 0; ks < 4; ++ks) cf[vt][ks] = *(const bf16x8*)(cst + ((size_t)unit * 128 + 32 * vt + r32) * 64 + 16 * ks + 8 * hi);
            bf16x8 qf[4];
#pragma unroll
            for (int ks = 0; ks < 4; ++ks) qf[ks] = row_frag<64>(qimg, lt, ks, lane);
            const float Mxl = sc[64 + l];
            bf16x8 P[2][2]; float dsum = 0.f;
#pragma unroll
            for (int st = 0; st < 2; ++st) {
                P[st][0] = (bf16x8){0, 0, 0, 0, 0, 0, 0, 0}; P[st][1] = P[st][0];
                if (st <= lt) {
                    f32x16 acc = {};
#pragma unroll
                    for (int ks = 0; ks < 4; ++ks) acc = MFMA32(row_frag<64>(kimg, st, ks, lane), qf[ks], acc);
#pragma unroll
                    for (int r = 0; r < 16; ++r) { const int srow = crow(r, hi); float val = acc[r] * __expf(sc[32 * st + srow] - Mxl); if (st == lt && srow > r32) val = 0.f; acc[r] = val; dsum += val; }
                    P[st][0] = pack8(acc, 0); P[st][1] = pack8(acc, 1);
                }
            }
            float nq;
            { const float* np = (const float*)(F.ws + WS_NLOC) + (size_t)unit * 64; float s = 0.f;
#pragma unroll
              for (int ks = 0; ks < 4; ++ks) { const f32x4 n0 = *(const f32x4*)(np + 16 * ks + 8 * hi), n1 = *(const f32x4*)(np + 16 * ks + 8 * hi + 4); const u32x4 q = __builtin_bit_cast(u32x4, qf[ks]);
                  s += bflo(q.x) * n0[0] + bfhi(q.x) * n0[1] + bflo(q.y) * n0[2] + bfhi(q.y) * n0[3] + bflo(q.z) * n1[0] + bfhi(q.z) * n1[1] + bflo(q.w) * n1[2] + bfhi(q.w) * n1[3]; }
              nq = s + __shfl_xor(s, 32); }
            asm volatile("s_waitcnt lgkmcnt(0)" ::: "memory");
            stage_v_half(wl, proj, trow0, 1024 + h * 128, lane); stage_v_half(wl + 8192, proj, trow0, 1024 + h * 128 + 64, lane);
            f32x16 acc[4];
#pragma unroll
            for (int vt = 0; vt < 4; ++vt) { acc[vt] = (f32x16){};
#pragma unroll
                for (int ks = 0; ks < 4; ++ks) acc[vt] = MFMA32(cf[vt][ks], qf[ks], acc[vt]); }
            const float iwl = sc[128 + l];
#pragma unroll
            for (int vt = 0; vt < 4; ++vt) acc[vt] = acc[vt] * iwl;
#pragma unroll
            for (int st = 0; st < 2; ++st) if (st <= lt) {
#pragma unroll
                for (int k2 = 0; k2 < 2; ++k2) {
#pragma unroll
                    for (int vt = 0; vt < 4; ++vt) acc[vt] = MFMA32(tr_frag(wl + (vt >> 1) * 8192, vt & 1, 2 * st + k2, lane), P[st][k2], acc[vt]); } }
            u32x2 o4[4][4];
#pragma unroll
            for (int vt = 0; vt < 4; ++vt)
#pragma unroll
                for (int rg = 0; rg < 4; ++rg) o4[vt][rg] = *(const u32x2*)(proj + t * 3072 + 2048 + h * 128 + 32 * vt + 8 * rg + 4 * hi);
            const float den = dsum + __shfl_xor(dsum, 32) + iwl * nq;
            const float inv = 1.0f / fmaxf(fabsf(den), sc[192 + l]);
            float ss = 0.f;
#pragma unroll
            for (int vt = 0; vt < 4; ++vt)
#pragma unroll
                for (int r = 0; r < 16; ++r) { const float v = acc[vt][r] * inv; acc[vt][r] = v; ss += v * v; }
            ss += __shfl_xor(ss, 32);
            const float rstd = 1.0f / sqrtf(ss * (1.0f / 128.0f) + EPS);
#pragma unroll
            for (int vt = 0; vt < 4; ++vt)
#pragma unroll
                for (int rg = 0; rg < 4; ++rg) { const int v = 32 * vt + 8 * rg + 4 * hi;
                    const f32x4 g4 = *(const f32x4*)(F.in[9] + h * 128 + v);
                    const float o0 = bflo(o4[vt][rg].x), o1 = bfhi(o4[vt][rg].x), o2 = bflo(o4[vt][rg].y), o3 = bfhi(o4[vt][rg].y);
                    const float y0 = acc[vt][4 * rg] * rstd * g4[0] / (1.f + __expf(-o0)), y1 = acc[vt][4 * rg + 1] * rstd * g4[1] / (1.f + __expf(-o1));
                    const float y2 = acc[vt][4 * rg + 2] * rstd * g4[2] / (1.f + __expf(-o2)), y3 = acc[vt][4 * rg + 3] * rstd * g4[3] / (1.f + __expf(-o3));
                    u32x2 pk; pk.x = cvtpk(y0, y1); pk.y = cvtpk(y2, y3); *(u32x2*)(hh + t * 1024 + h * 128 + v) = pk; }
            asm volatile("s_waitcnt lgkmcnt(0)" ::: "memory");
        }
    }
}

DI float softplus2(float z) { return fmaxf(z, 0.f) + __builtin_amdgcn_logf(1.f + __builtin_amdgcn_exp2f(-fabsf(z))); }
DI void p12_attn(Frame& F) {
    LAS unsigned char* kimg = F.lds + F.wave * 16384; LAS unsigned char* vimg = kimg + 8192;
    const bf16* Q = (const bf16*)(F.ws + WS_Q); const bf16* K = (const bf16*)(F.ws + WS_K); const bf16* V = (const bf16*)(F.ws + WS_VV);
    bf16* O = (bf16*)(F.ws + WS_H);
    const int wave = F.wave;
    for (int bh = F.bid; bh < 256; bh += F.G) {
        const int b = bh >> 4, h = bh & 15;
#pragma unroll 1
        for (int qi = 0; qi < 8; ++qi) {
            int lane = F.lane; asm volatile("" : "+v"(lane)); const int r32 = lane & 31, hi = lane >> 5;
            const int skey = lane >> 3, schk = lane & 7;
            const int qt = 63 - (wave + 8 * qi);
            const int qlo = qt * 32;
            const size_t tq0 = (size_t)b * SEQ + qlo;
            bf16x8 qr[4];
#pragma unroll
            for (int ks = 0; ks < 4; ++ks) qr[ks] = *(const bf16x8*)(Q + (tq0 + r32) * 1024 + h * 64 + 16 * ks + 8 * hi);
            f32x16 o0 = {}, o1 = {}; float R = 0.f;
            const int kt0 = (qlo + 30) >> 5;
            u32x4 kraw[4], vraw[4];
            { const bf16* kp = K + ((size_t)b * SEQ + 32 * kt0 + skey) * 1024 + h * 64 + 8 * schk; const bf16* vp = V + ((size_t)b * SEQ + 32 * kt0 + skey) * 1024 + h * 64 + 8 * schk;
#pragma unroll
              for (int i = 0; i < 4; ++i) { kraw[i] = *(const u32x4*)(kp + (size_t)i * 8 * 1024); vraw[i] = *(const u32x4*)(vp + (size_t)i * 8 * 1024); } }
#pragma unroll 1
            for (int kt = kt0; kt >= 0; --kt) {
#pragma unroll
                for (int i = 0; i < 4; ++i) { *(LAS u32x4*)(kimg + schk * 512 + (skey + 8 * i) * 16) = kraw[i]; *(LAS u32x4*)(vimg + tr_off(skey + 8 * i, schk)) = vraw[i]; }
                if (kt > 0) { const bf16* kp = K + ((size_t)b * SEQ + 32 * (kt - 1) + skey) * 1024 + h * 64 + 8 * schk; const bf16* vp = V + ((size_t)b * SEQ + 32 * (kt - 1) + skey) * 1024 + h * 64 + 8 * schk;
#pragma unroll
                    for (int i = 0; i < 4; ++i) { kraw[i] = *(const u32x4*)(kp + (size_t)i * 8 * 1024); vraw[i] = *(const u32x4*)(vp + (size_t)i * 8 * 1024); } }
                {
                    const bool diag = (32 * kt + 31 >= qlo);
                    const int qrel = qlo + r32 - 32 * kt;
                    f32x16 p = {};
#pragma unroll
                    for (int ks = 0; ks < 4; ++ks) p = MFMA32(row_frag<32>(kimg, 0, ks, lane), qr[ks], p);
                    float sp[16], mk[16];
                    if (diag) {
#pragma unroll
                        for (int r = 0; r < 16; ++r) { mk[r] = crow(r, hi) < qrel ? 1.f : 0.f; sp[r] = softplus2(p[r]) * mk[r]; }
                    } else {
#pragma unroll
                        for (int r = 0; r < 16; ++r) { mk[r] = 1.f; sp[r] = softplus2(p[r]); }
                    }
#pragma unroll
                    for (int g = 0; g < 4; ++g) { sp[4 * g + 2] += sp[4 * g + 3]; sp[4 * g + 1] += sp[4 * g + 2]; sp[4 * g] += sp[4 * g + 1]; }
                    float og[4], T[4], off[4];
#pragma unroll
                    for (int g = 0; g < 4; ++g) og[g] = __shfl_xor(sp[4 * g], 32);
                    T[3] = 0.f; T[2] = sp[12] + og[3]; T[1] = T[2] + sp[8] + og[2]; T[0] = T[1] + sp[4] + og[1];
                    const float tot = T[0] + sp[0] + og[0];
#pragma unroll
                    for (int g = 0; g < 4; ++g) off[g] = T[g] + (hi == 0 ? og[g] : 0.f) + R;
#pragma unroll
                    for (int r = 0; r < 16; ++r) p[r] = __builtin_amdgcn_exp2f(p[r] - sp[r] - off[r >> 2]) * mk[r];
                    R += tot;
                    const bf16x8 pa0 = pack8(p, 0), pa1 = pack8(p, 1);
                    o0 = MFMA32(pa0, tr_frag(vimg, 0, 0, lane), o0); o1 = MFMA32(pa0, tr_frag(vimg, 1, 0, lane), o1);
                    o0 = MFMA32(pa1, tr_frag(vimg, 0, 1, lane), o0); o1 = MFMA32(pa1, tr_frag(vimg, 1, 1, lane), o1);
                }
                if (__all(R >= 150.1f)) break;
                asm volatile("s_waitcnt lgkmcnt(0)" ::: "memory");
            }
            asm volatile("s_waitcnt lgkmcnt(0)" ::: "memory");
#pragma unroll
            for (int r = 0; r < 16; ++r) { bf16* op = O + (tq0 + crow(r, hi)) * 1024 + h * 64 + r32;
                op[0] = (bf16)(cvtpk(o0[r], 0.f) & 0xffffu); op[32] = (bf16)(cvtpk(o1[r], 0.f) & 0xffffu); }
        }
    }
}

__device__ constexpr int NET16_A[63] = {0,2,0,1,1,4,6,4,5,5,0,2,2,1,3,3,1,3,5,8,10,8,9,9,12,14,12,13,13,8,10,10,9,11,11,9,11,13,0,4,4,2,6,6,2,6,10,1,5,5,3,7,7,3,7,11,1,3,5,7,9,11,13};
__device__ constexpr int NET16_B[63] = {1,3,2,3,2,5,7,6,7,6,4,6,4,5,7,5,2,4,6,9,11,10,11,10,13,15,14,15,14,12,14,12,13,15,13,10,12,14,8,12,8,10,14,10,4,8,12,9,13,9,11,15,11,5,9,13,2,4,6,8,10,12,14};
__device__ constexpr int BIT16_A[32] = {0,1,2,3,4,5,6,7,0,1,2,3,8,9,10,11,0,1,4,5,8,9,12,13,0,2,4,6,8,10,12,14};
__device__ constexpr int BIT16_B[32] = {8,9,10,11,12,13,14,15,4,5,6,7,12,13,14,15,2,3,6,7,10,11,14,15,1,3,5,7,9,11,13,15};
DI unsigned umax_(unsigned a, unsigned b) { return a > b ? a : b; }
DI unsigned umin_(unsigned a, unsigned b) { return a < b ? a : b; }
DI void sort16(unsigned (&k)[16]) {
#pragma unroll
    for (int c = 0; c < 63; ++c) { const unsigned a = k[NET16_A[c]], b = k[NET16_B[c]]; k[NET16_A[c]] = umax_(a, b); k[NET16_B[c]] = umin_(a, b); }
}
DI void bitonic16(unsigned (&k)[16]) {
#pragma unroll
    for (int c = 0; c < 32; ++c) { const unsigned a = k[BIT16_A[c]], b = k[BIT16_B[c]]; k[BIT16_A[c]] = umax_(a, b); k[BIT16_B[c]] = umin_(a, b); }
}
DI void merge16(unsigned (&x)[16], const unsigned (&y)[16]) {
#pragma unroll
    for (int i = 0; i < 16; ++i) x[i] = umax_(x[i], y[15 - i]);
    bitonic16(x);
}
DI unsigned f2key(float x) { const unsigned b = __float_as_uint(x); return b ^ ((unsigned)((int)b >> 31) | 0x80000000u); }
DI float key2f(unsigned k) { return __uint_as_float(k ^ (~(unsigned)((int)k >> 31) | 0x80000000u)); }

DI void p_route(Frame& F, int layer) {
    LAS unsigned char* simg = F.lds;
    LAS unsigned char* dec = F.lds + 65536 + F.wave * 1024;
    { const u32x4* src = (const u32x4*)((const bf16*)(F.ws + WS_SUBK) + (size_t)layer * 2 * 128 * 128);
      for (int i = F.tid; i < 2 * 128 * 16; i += NT) { const int p = i >> 11, n = (i >> 4) & 127, ch = i & 15; *(LAS u32x4*)(simg + p * 32768 + ch * 2048 + n * 16) = src[i]; } }
    __syncthreads();
    const bf16* PQ = (const bf16*)(F.ws + WS_PQ);
    const int lane = F.lane, r32 = lane & 31, hi = lane >> 5;
    const int gw = F.bid * NWAVES + F.wave, NGW = F.G * NWAVES;
    for (int wu = gw; wu < T_TOK * 8 / 32; wu += NGW) {
        const int row = wu * 32 + r32, t = row >> 3, hd = row & 7;
        unsigned top[2][16];
#pragma unroll
        for (int p = 0; p < 2; ++p) {
            bf16x8 qf[8];
#pragma unroll
            for (int ks = 0; ks < 8; ++ks) qf[ks] = *(const bf16x8*)(PQ + (size_t)t * 2048 + hd * 256 + p * 128 + 16 * ks + 8 * hi);
            unsigned keys[4][16];
#pragma unroll
            for (int nt = 0; nt < 4; ++nt) {
                f32x16 acc = {};
#pragma unroll
                for (int ks = 0; ks < 8; ++ks) acc = MFMA32(*(const LAS bf16x8*)(simg + p * 32768 + (2 * ks + hi) * 2048 + (32 * nt + r32) * 16), qf[ks], acc);
#pragma unroll
                for (int r = 0; r < 16; ++r) keys[nt][r] = (f2key(acc[r]) & 0xFFFFFF80u) | (unsigned)(32 * nt + crow(r, 0)) | (unsigned)(4 * hi);
                sort16(keys[nt]);
            }
            merge16(keys[0], keys[1]); merge16(keys[2], keys[3]); merge16(keys[0], keys[2]);
            unsigned lo[16], up[16];
#pragma unroll
            for (int i = 0; i < 16; ++i) { auto rr = __builtin_amdgcn_permlane32_swap(keys[0][i], keys[0][i], false, false); lo[i] = rr[0]; up[i] = rr[1]; }
#pragma unroll
            for (int i = 0; i < 16; ++i) top[p][i] = umax_(lo[i], up[15 - i]);
            bitonic16(top[p]);
        }
        if (hi == 0) {
            u32x4 w0, w1, w2, w3;
            w0.x = (top[0][0] & 127u) | ((top[0][1] & 127u) << 8) | ((top[0][2] & 127u) << 16) | ((top[0][3] & 127u) << 24);
            w0.y = (top[0][4] & 127u) | ((top[0][5] & 127u) << 8) | ((top[0][6] & 127u) << 16) | ((top[0][7] & 127u) << 24);
            w0.z = (top[0][8] & 127u) | ((top[0][9] & 127u) << 8) | ((top[0][10] & 127u) << 16) | ((top[0][11] & 127u) << 24);
            w0.w = (top[0][12] & 127u) | ((top[0][13] & 127u) << 8) | ((top[0][14] & 127u) << 16) | ((top[0][15] & 127u) << 24);
            w1.x = (top[1][0] & 127u) | ((top[1][1] & 127u) << 8) | ((top[1][2] & 127u) << 16) | ((top[1][3] & 127u) << 24);
            w1.y = (top[1][4] & 127u) | ((top[1][5] & 127u) << 8) | ((top[1][6] & 127u) << 16) | ((top[1][7] & 127u) << 24);
            w1.z = (top[1][8] & 127u) | ((top[1][9] & 127u) << 8) | ((top[1][10] & 127u) << 16) | ((top[1][11] & 127u) << 24);
            w1.w = (top[1][12] & 127u) | ((top[1][13] & 127u) << 8) | ((top[1][14] & 127u) << 16) | ((top[1][15] & 127u) << 24);
            *(LAS u32x4*)(dec + r32 * 32) = w0; *(LAS u32x4*)(dec + r32 * 32 + 16) = w1;
        }
        float av[16], bv[16];
#pragma unroll
        for (int i = 0; i < 16; ++i) { av[i] = key2f(top[0][i] & 0xFFFFFF80u); bv[i] = key2f(top[1][i] & 0xFFFFFF80u); }
        unsigned c0[16], c1[16], c2[16], c3[16];
#pragma unroll
        for (int j = 0; j < 16; ++j) c0[j] = (f2key(av[0] + bv[j]) & 0xFFFFFF00u) | (unsigned)j;
        {
            int n = 0;
#pragma unroll
            for (int i = 1; i < 16; ++i)
#pragma unroll
                for (int j = 0; j < 16; ++j) if ((i + 1) * (j + 1) <= 16) {
                    const unsigned k = (f2key(av[i] + bv[j]) & 0xFFFFFF00u) | (unsigned)(i * 16 + j);
                    if (n < 16) c1[n] = k; else if (n < 32) c2[n - 16] = k; else c3[n - 32] = k;
                    ++n; }
#pragma unroll
            for (int q = 2; q < 16; ++q) c3[q] = 0u;
        }
        sort16(c1); sort16(c2); { const unsigned a = c3[0], b = c3[1]; c3[0] = umax_(a, b); c3[1] = umin_(a, b); }
        merge16(c0, c1); merge16(c2, c3); merge16(c0, c2);
        asm volatile("s_waitcnt lgkmcnt(0)" ::: "memory");
        float gv[16]; unsigned ex[16]; float gs = 0.f;
        const float vmax = key2f(c0[0] & 0xFFFFFF00u);
#pragma unroll
        for (int k = 0; k < 16; ++k) {
            const unsigned code = c0[k] & 255u; const unsigned i = code >> 4, j = code & 15u;
            const unsigned ia = *(const LAS unsigned char*)(dec + r32 * 32 + i), ib = *(const LAS unsigned char*)(dec + r32 * 32 + 16 + j);
            ex[k] = ia * 128u + ib;
            gv[k] = __expf(key2f(c0[k] & 0xFFFFFF00u) - vmax); gs += gv[k];
        }
        const float ginv = 1.0f / gs;
        if (hi == 0) {
            u32x4 e0, e1;
            e0.x = ex[0] | (ex[1] << 16); e0.y = ex[2] | (ex[3] << 16); e0.z = ex[4] | (ex[5] << 16); e0.w = ex[6] | (ex[7] << 16);
            e1.x = ex[8] | (ex[9] << 16); e1.y = ex[10] | (ex[11] << 16); e1.z = ex[12] | (ex[13] << 16); e1.w = ex[14] | (ex[15] << 16);
            u32x4* ip = (u32x4*)((unsigned short*)(F.ws + WS_IDX) + (size_t)row * 16); ip[0] = e0; ip[1] = e1;
        } else {
            f32x4* gp = (f32x4*)((float*)(F.ws + WS_GATE) + (size_t)row * 16);
            gp[0] = (f32x4){gv[0] * ginv, gv[1] * ginv, gv[2] * ginv, gv[3] * ginv}; gp[1] = (f32x4){gv[4] * ginv, gv[5] * ginv, gv[6] * ginv, gv[7] * ginv};
            gp[2] = (f32x4){gv[8] * ginv, gv[9] * ginv, gv[10] * ginv, gv[11] * ginv}; gp[3] = (f32x4){gv[12] * ginv, gv[13] * ginv, gv[14] * ginv, gv[15] * ginv};
        }
    }
}

constexpr float U_SCALE = 32.f, V_SCALE = 4.f;
struct RowBuf { u32x4 r[16]; };
DI void load_rows(RowBuf& rb, const unsigned char* tbl, int idxs, int k0, int lane) {
#pragma unroll
    for (int j = 0; j < 16; ++j) { const int e = __builtin_amdgcn_readlane(idxs, k0 + j); rb.r[j] = *((const u32x4*)(tbl + (size_t)e * 1024) + lane); }
}
DI int udots(const RowBuf& rb, const int (&hq)[4], int lane) {
    int p[16];
#pragma unroll
    for (int j = 0; j < 16; ++j) { int a = __builtin_amdgcn_sdot4((int)rb.r[j].x, hq[0], 0, false); a = __builtin_amdgcn_sdot4((int)rb.r[j].y, hq[1], a, false);
        a = __builtin_amdgcn_sdot4((int)rb.r[j].z, hq[2], a, false); p[j] = __builtin_amdgcn_sdot4((int)rb.r[j].w, hq[3], a, false); }
#pragma unroll
    for (int i = 0; i < 8; ++i) { const bool up = (lane & 8) != 0; const int send = up ? p[i] : p[i + 8], keep = up ? p[i + 8] : p[i]; p[i] = keep + lx<8>(send); }
#pragma unroll
    for (int i = 0; i < 4; ++i) { const bool up = (lane & 4) != 0; const int send = up ? p[i] : p[i + 4], keep = up ? p[i + 4] : p[i]; p[i] = keep + lx<7>(send); }
#pragma unroll
    for (int i = 0; i < 2; ++i) { const bool up = (lane & 2) != 0; const int send = up ? p[i] : p[i + 2], keep = up ? p[i + 2] : p[i]; p[i] = keep + lx<2>(send); }
    { const bool up = (lane & 1) != 0; const int send = up ? p[0] : p[1], keep = up ? p[1] : p[0]; p[0] = keep + lx<1>(send); }
    int s = p[0]; s += lx<16>(s); s += lx<32>(s);
    return s;
}
DI void vaccum(const RowBuf& rb, f32x2_t (&out)[8], float wv, int k0) {
#pragma unroll
    for (int j = 0; j < 16; ++j) { const float wk = __builtin_bit_cast(float, __builtin_amdgcn_readlane(__builtin_bit_cast(int, wv), k0 + j));
        out[0] = __builtin_amdgcn_cvt_pk_f32_fp8((int)rb.r[j].x, false) * wk + out[0]; out[1] = __builtin_amdgcn_cvt_pk_f32_fp8((int)rb.r[j].x, true) * wk + out[1];
        out[2] = __builtin_amdgcn_cvt_pk_f32_fp8((int)rb.r[j].y, false) * wk + out[2]; out[3] = __builtin_amdgcn_cvt_pk_f32_fp8((int)rb.r[j].y, true) * wk + out[3];
        out[4] = __builtin_amdgcn_cvt_pk_f32_fp8((int)rb.r[j].z, false) * wk + out[4]; out[5] = __builtin_amdgcn_cvt_pk_f32_fp8((int)rb.r[j].z, true) * wk + out[5];
        out[6] = __builtin_amdgcn_cvt_pk_f32_fp8((int)rb.r[j].w, false) * wk + out[6]; out[7] = __builtin_amdgcn_cvt_pk_f32_fp8((int)rb.r[j].w, true) * wk + out[7]; }
}
constexpr size_t WS_W = WS_PROJ;
constexpr size_t WS_PD = WS_PROJ + 32 * MiB;
constexpr int UP_LDS = 16384;
struct UTok { u32x4 r[16]; int hq[4]; };
DI void up_load(UTok& tb, const unsigned char* Us, const unsigned char* H2Qs, const LAS unsigned short* lidx, size_t t, int tt, int lane) {
    const int g = lane >> 3, c = lane & 7;
    const LAS u32x4* ip = (const LAS u32x4*)(lidx + tt * 128 + 16 * g); const u32x4 ia = ip[0], ib = ip[1];
    const unsigned e[16] = {ia.x & 0xffffu, ia.x >> 16, ia.y & 0xffffu, ia.y >> 16, ia.z & 0xffffu, ia.z >> 16, ia.w & 0xffffu, ia.w >> 16,
                            ib.x & 0xffffu, ib.x >> 16, ib.y & 0xffffu, ib.y >> 16, ib.z & 0xffffu, ib.z >> 16, ib.w & 0xffffu, ib.w >> 16};
#pragma unroll
    for (int i = 0; i < 16; ++i) tb.r[i] = *(const u32x4*)(Us + (size_t)e[i] * 128 + c * 16);
    const u32x4 a = *(const u32x4*)(H2Qs + t * 1024 + c * 16); tb.hq[0] = (int)a.x; tb.hq[1] = (int)a.y; tb.hq[2] = (int)a.z; tb.hq[3] = (int)a.w;
}
DI void up_compute(const UTok& tb, int* pd, size_t t, int lane) {
    int p[16];
#pragma unroll
    for (int i = 0; i < 16; ++i) { int a = __builtin_amdgcn_sdot4((int)tb.r[i].x, tb.hq[0], 0, false); a = __builtin_amdgcn_sdot4((int)tb.r[i].y, tb.hq[1], a, false);
        a = __builtin_amdgcn_sdot4((int)tb.r[i].z, tb.hq[2], a, false); p[i] = __builtin_amdgcn_sdot4((int)tb.r[i].w, tb.hq[3], a, false); }
#pragma unroll
    for (int i = 0; i < 8; ++i) { const bool up = (lane & 4) != 0; const int send = up ? p[i] : p[i + 8], keep = up ? p[i + 8] : p[i]; p[i] = keep + lx<7>(send); }
#pragma unroll
    for (int i = 0; i < 4; ++i) { const bool up = (lane & 2) != 0; const int send = up ? p[i] : p[i + 4], keep = up ? p[i + 4] : p[i]; p[i] = keep + lx<2>(send); }
#pragma unroll
    for (int i = 0; i < 2; ++i) { const bool up = (lane & 1) != 0; const int send = up ? p[i] : p[i + 2], keep = up ? p[i + 2] : p[i]; p[i] = keep + lx<1>(send); }
    const int k = 16 * (lane >> 3) + 8 * ((lane >> 2) & 1) + 4 * ((lane >> 1) & 1) + 2 * (lane & 1);
    *(int2*)(pd + t * 128 + k) = make_int2(p[0], p[1]);
}
constexpr size_t WS_CLAIM = 4096;
DI unsigned xcc_id() { return (unsigned)__builtin_amdgcn_s_getreg((3 << 11) | 20) & 7u; }
DI int claim_unit(Frame& F, int set) {
    LAS int* bc = (LAS int*)(F.lds + LDS_BYTES - 64);
    __syncthreads();
    if (F.tid == 0) {
        unsigned* cnt = (unsigned*)(F.ws + WS_CLAIM) + set * 256;
        const unsigned x0 = xcc_id(); int unit = -1;
        for (unsigned a = 0; a < 8; ++a) { const unsigned sl = (x0 + a) & 7u; const unsigned tk = __hip_atomic_fetch_add(cnt + sl * 32, 1u, __ATOMIC_RELAXED, __HIP_MEMORY_SCOPE_AGENT); if (tk < 32u) { unit = (int)(sl * 32 + tk); break; } }
        bc[0] = unit;
    }
    __syncthreads();
    return bc[0];
}
DI void p_upass(Frame& F, int layer, int cset) {
    const unsigned short* IDX = (const unsigned short*)(F.ws + WS_IDX);
    LAS unsigned char* wl = F.lds + F.wave * UP_LDS;
    LAS unsigned short* lidx = (LAS unsigned short*)wl;
    const int lane = F.lane;
    for (int unit = claim_unit(F, cset); unit >= 0; unit = claim_unit(F, cset)) {
    const int x = unit >> 5, jb = unit & 31;
    const unsigned char* Us = F.ws + WS_U + ((size_t)layer * 8 + x) * 16384 * 128;
    const unsigned char* H2Qs = F.ws + WS_H2Q + 128 * x;
    int* pd = (int*)(F.ws + WS_PD) + (size_t)x * T_TOK * 128;
    for (int t0 = jb * 1024 + F.wave * 128; t0 < jb * 1024 + F.wave * 128 + 128; t0 += 16) {
        { const u32x4* si = (const u32x4*)(IDX + (size_t)t0 * 128) + lane;
#pragma unroll
          for (int q = 0; q < 4; ++q) ((LAS u32x4*)lidx)[lane + 64 * q] = si[64 * q]; }
        UTok A, B;
        up_load(A, Us, H2Qs, lidx, (size_t)t0, 0, lane);
#pragma unroll 1
        for (int tt = 0; tt < 16; tt += 2) {
            up_load(B, Us, H2Qs, lidx, (size_t)t0 + tt + 1, tt + 1, lane);
            up_compute(A, pd, (size_t)t0 + tt, lane);
            if (tt + 2 < 16) up_load(A, Us, H2Qs, lidx, (size_t)t0 + tt + 2, tt + 2, lane);
            up_compute(B, pd, (size_t)t0 + tt + 1, lane);
        }
    }
    }
}
DI void p_combine(Frame& F, int layer) {
    const unsigned short* IDX = (const unsigned short*)(F.ws + WS_IDX); const float* GATE = (const float*)(F.ws + WS_GATE);
    const float* SH = (const float*)(F.ws + WS_SH); const float* SU = (const float*)(F.ws + WS_SU) + (size_t)layer * 16384;
    const int* pd = (const int*)(F.ws + WS_PD); float* W = (float*)(F.ws + WS_W);
    const int gw = F.bid * NWAVES + F.wave, NGW = F.G * NWAVES;
    for (int t = gw; t < T_TOK; t += NGW) {
        int s0 = 0, s1 = 0;
#pragma unroll
        for (int x = 0; x < 8; ++x) { const int* p = pd + ((size_t)x * T_TOK + t) * 128 + F.lane; s0 += p[0]; s1 += p[64]; }
        const int e0 = IDX[(size_t)t * 128 + F.lane], e1 = IDX[(size_t)t * 128 + 64 + F.lane];
        const float sh = SH[t];
        const float d0 = (float)s0 * SU[e0] * sh, d1 = (float)s1 * SU[e1] * sh;
        W[(size_t)t * 128 + F.lane] = GATE[(size_t)t * 128 + F.lane] * 0.5f * d0 * (1.0f + erff(d0 * 0.70710678118654752f)) * (1.0f / V_SCALE);
        W[(size_t)t * 128 + 64 + F.lane] = GATE[(size_t)t * 128 + 64 + F.lane] * 0.5f * d1 * (1.0f + erff(d1 * 0.70710678118654752f)) * (1.0f / V_SCALE);
    }
}
struct TokBuf { u32x4 r[16]; f32x4 w[4]; };
DI void vp_load(TokBuf& tb, const unsigned char* Vs, const LAS unsigned short* lidx, const LAS float* lw, int tt, int lane) {
    const int g = lane >> 3, c = lane & 7;
    const LAS u32x4* ip = (const LAS u32x4*)(lidx + tt * 128 + 16 * g); const u32x4 ia = ip[0], ib = ip[1];
    const LAS f32x4* wp = (const LAS f32x4*)(lw + tt * 128 + 16 * g); tb.w[0] = wp[0]; tb.w[1] = wp[1]; tb.w[2] = wp[2]; tb.w[3] = wp[3];
    const unsigned e[16] = {ia.x & 0xffffu, ia.x >> 16, ia.y & 0xffffu, ia.y >> 16, ia.z & 0xffffu, ia.z >> 16, ia.w & 0xffffu, ia.w >> 16,
                            ib.x & 0xffffu, ib.x >> 16, ib.y & 0xffffu, ib.y >> 16, ib.z & 0xffffu, ib.z >> 16, ib.w & 0xffffu, ib.w >> 16};
#pragma unroll
    for (int i = 0; i < 16; ++i) tb.r[i] = *(const u32x4*)(Vs + (size_t)e[i] * 128 + c * 16);
}
DI void vp_compute(const TokBuf& tb, Frame& F, const float* g2s, float* xout, size_t t, int x, int lane) {
    f32x2_t out[8];
#pragma unroll
    for (int i = 0; i < 8; ++i) out[i] = (f32x2_t){0.f, 0.f};
#pragma unroll
    for (int i = 0; i < 16; ++i) { const float wk = tb.w[i >> 2][i & 3];
        out[0] = __builtin_amdgcn_cvt_pk_f32_fp8((int)tb.r[i].x, false) * wk + out[0]; out[1] = __builtin_amdgcn_cvt_pk_f32_fp8((int)tb.r[i].x, true) * wk + out[1];
        out[2] = __builtin_amdgcn_cvt_pk_f32_fp8((int)tb.r[i].y, false) * wk + out[2]; out[3] = __builtin_amdgcn_cvt_pk_f32_fp8((int)tb.r[i].y, true) * wk + out[3];
        out[4] = __builtin_amdgcn_cvt_pk_f32_fp8((int)tb.r[i].z, false) * wk + out[4]; out[5] = __builtin_amdgcn_cvt_pk_f32_fp8((int)tb.r[i].z, true) * wk + out[5];
        out[6] = __builtin_amdgcn_cvt_pk_f32_fp8((int)tb.r[i].w, false) * wk + out[6]; out[7] = __builtin_amdgcn_cvt_pk_f32_fp8((int)tb.r[i].w, true) * wk + out[7]; }
    float p[16];
#pragma unroll
    for (int i = 0; i < 8; ++i) { p[2 * i] = out[i].x; p[2 * i + 1] = out[i].y; }
#pragma unroll
    for (int i = 0; i < 8; ++i) { const bool up = (lane & 32) != 0; const float send = up ? p[i] : p[i + 8], keep = up ? p[i + 8] : p[i]; p[i] = keep + lx<32>(send); }
#pragma unroll
    for (int i = 0; i < 4; ++i) { const bool up = (lane & 16) != 0; const float send = up ? p[i] : p[i + 4], keep = up ? p[i + 4] : p[i]; p[i] = keep + lx<16>(send); }
#pragma unroll
    for (int i = 0; i < 2; ++i) { const bool up = (lane & 8) != 0; const float send = up ? p[i] : p[i + 2], keep = up ? p[i + 2] : p[i]; p[i] = keep + lx<8>(send); }
    const int col = 128 * x + 16 * (lane & 7) + 8 * ((lane >> 5) & 1) + 4 * ((lane >> 4) & 1) + 2 * ((lane >> 3) & 1);
    const f32x2_t gg = *(const f32x2_t*)(g2s + col);
    const f32x2_t xv = *(const f32x2_t*)(F.out + t * 1024 + col);
    *(f32x2_t*)(xout + t * 1024 + col) = xv + gg * (f32x2_t){p[0], p[1]};
}
DI void p_vpass(Frame& F, int layer, float* xout, int cset) {

    const unsigned short* IDX = (const unsigned short*)(F.ws + WS_IDX); const float* W = (const float*)(F.ws + WS_W);
    const float* mods = (const float*)(F.ws + WS_MODS);
    LAS unsigned char* wl = F.lds + F.wave * UP_LDS;
    LAS unsigned short* lidx = (LAS unsigned short*)wl; LAS float* lw = (LAS float*)(wl + 4096);
    const int lane = F.lane;
    for (int unit = claim_unit(F, cset); unit >= 0; unit = claim_unit(F, cset)) {
    const int x = unit >> 5, jb = unit & 31;
    const unsigned char* Vs = F.ws + WS_V + ((size_t)layer * 8 + x) * 16384 * 128;
    for (int t0 = jb * 1024 + F.wave * 128; t0 < jb * 1024 + F.wave * 128 + 128; t0 += 16) {
        const int b = t0 >> 11;
        const float* g2s = mods + ((size_t)layer * 16 + b) * 6144 + 5 * 1024;
        { const u32x4* si = (const u32x4*)(IDX + (size_t)t0 * 128) + lane;
#pragma unroll
          for (int q = 0; q < 4; ++q) ((LAS u32x4*)lidx)[lane + 64 * q] = si[64 * q];
          const u32x4* sg = (const u32x4*)(W + (size_t)t0 * 128) + lane;
#pragma unroll
          for (int q = 0; q < 8; ++q) ((LAS u32x4*)lw)[lane + 64 * q] = sg[64 * q]; }
        TokBuf A, B;
        vp_load(A, Vs, lidx, lw, 0, lane);
#pragma unroll 1
        for (int tt = 0; tt < 16; tt += 2) {
            vp_load(B, Vs, lidx, lw, tt + 1, lane);
            vp_compute(A, F, g2s, xout, (size_t)t0 + tt, x, lane);
            if (tt + 2 < 16) vp_load(A, Vs, lidx, lw, tt + 2, lane);
            vp_compute(B, F, g2s, xout, (size_t)t0 + tt + 1, x, lane);
        }
    }
    }
}
#ifndef DUP
#define DUP -1
#endif
#ifndef PH_MASK
#define PH_MASK 0x3FFFF
#endif

constexpr size_t WS_BAR = 65536;
#define XB_TMO      128
#define XB_XCNT(j)  (256  + 64 * (j))
#define XB_XSUB(j)  (1280 + 64 * (j))
#define XB_XGEN(j)  (2304 + 64 * (j))
#define XB_TOP      3328
#define XB_TOPGEN   3392
#define XCD_BAR_WORDS 3456
#define XB_SPIN_CAP (1u << 18)

__device__ __forceinline__ unsigned xb_ld(unsigned* p)              { return __hip_atomic_load(p, __ATOMIC_RELAXED, __HIP_MEMORY_SCOPE_AGENT); }
__device__ __forceinline__ unsigned xb_add(unsigned* p, unsigned v) { return __hip_atomic_fetch_add(p, v, __ATOMIC_RELAXED, __HIP_MEMORY_SCOPE_AGENT); }
__device__ __forceinline__ unsigned xb_xcc_id() { return (unsigned)__builtin_amdgcn_s_getreg((3 << 11) | 20) & 0xFu; }
#define XB_SPIN(cond, bar) do { unsigned _sp = 0; while (cond) { __builtin_amdgcn_s_sleep(1); \
    if ((++_sp & 255u) == 0u) { if (xb_ld(&(bar)[XB_TMO])) break; if (_sp > XB_SPIN_CAP) { atomicAdd(&(bar)[XB_TMO], 1u); break; } } } } while (0)

struct XcdBarrier {
    unsigned* bar; unsigned x;
    volatile LAS unsigned* st;
};

__device__ __forceinline__ XcdBarrier xcd_barrier_post(unsigned* bar, volatile LAS unsigned* st) {
    XcdBarrier b; b.bar = bar; b.x = xb_xcc_id(); b.st = st;
    if (threadIdx.x == 0) (void)xb_add(&bar[XB_XCNT(b.x)], 1u);
    return b;
}
__device__ __forceinline__ void xcd_barrier_complete(unsigned* bar, unsigned x, unsigned& nloc, unsigned& nx) {
    const unsigned G = gridDim.x * gridDim.y * gridDim.z;
    unsigned sum, cnt, mine, sp = 0u;
    for (;;) {
        sum = 0u; cnt = 0u; mine = 0u;
#pragma unroll
        for (unsigned j = 0; j < 16; ++j) { const unsigned c = xb_ld(&bar[XB_XCNT(j)]); sum += c; cnt += (c > 0u) ? 1u : 0u; mine = (j == x) ? c : mine; }
        if (sum == G) break;
        __builtin_amdgcn_s_sleep(1);
        if ((++sp & 255u) == 0u) { if (xb_ld(&bar[XB_TMO])) break; if (sp > XB_SPIN_CAP) { atomicAdd(&bar[XB_TMO], 1u); break; } }
    }
    nloc = mine > 0u ? mine : 1u; nx = cnt > 0u ? cnt : 1u;
}

__device__ __forceinline__ void xcd_barrier(const XcdBarrier& b) {
    asm volatile("s_waitcnt vmcnt(0)" ::: "memory");
    __syncthreads();
    if (threadIdx.x == 0) {
        unsigned* bar = b.bar;
        __builtin_amdgcn_s_waitcnt(0);
        unsigned nloc = b.st[0], nx = b.st[1];
        if (nloc == 0u) { xcd_barrier_complete(bar, b.x, nloc, nx); b.st[0] = nloc; b.st[1] = nx; }
        const unsigned old = xb_add(&bar[XB_XSUB(b.x)], 1u);
        const unsigned gen = old / nloc;
        if (old + 1u == (gen + 1u) * nloc) {
            __builtin_amdgcn_fence(__ATOMIC_RELEASE, "agent");
            asm volatile("s_waitcnt vmcnt(0)" ::: "memory");
            const unsigned og = xb_add(&bar[XB_TOP], 1u);
            const unsigned tg = og / nx;
            if (og + 1u == (tg + 1u) * nx) xb_add(&bar[XB_TOPGEN], 1u);
            else XB_SPIN(xb_ld(&bar[XB_TOPGEN]) == tg, bar);
            __builtin_amdgcn_fence(__ATOMIC_ACQUIRE, "agent");
            xb_add(&bar[XB_XGEN(b.x)], 1u);
            asm volatile("s_waitcnt vmcnt(0)" ::: "memory");
        } else {
            XB_SPIN(xb_ld(&bar[XB_XGEN(b.x)]) == gen, bar);
            __builtin_amdgcn_fence(__ATOMIC_ACQUIRE, "agent");
            asm volatile("s_waitcnt vmcnt(0)" ::: "memory");
        }
    }
    __syncthreads();
}

#ifndef N_LAUNCH_MODE
#define N_LAUNCH_MODE 1
#endif
constexpr int NPH = 18;
template <class Epi> DI void run_gemm(Frame& F, const bf16* A, const bf16* Bt, int N, const Epi& E) {
    pg8::Gemm g{A, Bt, T_TOK, N, DM}; pg8::StaticOrder S; S.init(T_TOK, N, F.G, F.bid);
    pg8::gemm_phase<Epi, pg8::StaticOrder, true, true>(F.lds, g, S, E);
}
__global__ void __launch_bounds__(NT, 2) fwd(Args args) {
    extern __shared__ __attribute__((aligned(16))) unsigned char lds_raw[];
    cg::grid_group grid = cg::this_grid();
    Frame F;
    F.lds = (LAS unsigned char*)lds_raw;
#pragma unroll
    for (int i = 0; i < 23; ++i) F.in[i] = args.in[i];
    F.out = args.out; F.ws = args.ws;
    F.tid = threadIdx.x; F.lane = F.tid & 63; F.wave = __builtin_amdgcn_readfirstlane(F.tid >> 6); F.bid = blockIdx.x; F.G = gridDim.x;
    const int lo = args.ph_lo, hi = args.ph_hi;
    volatile LAS unsigned* bst = (volatile LAS unsigned*)(F.lds + LDS_BYTES - 128);
    if (F.tid < 2) bst[F.tid] = 0u;
    __syncthreads();
    XcdBarrier xbar; xbar.bar = (unsigned*)(F.ws + WS_BAR); xbar.x = xb_xcc_id(); xbar.st = bst;
    bool bar_ready = false;
#define IN(k) (lo <= (k) && (k) < hi)
#define GSYNC() do { if (!bar_ready) { grid.sync(); if (F.tid == 0) (void)xb_add(&xbar.bar[XB_XCNT(xbar.x)], 1u); bar_ready = true; } else xcd_barrier(xbar); } while (0)
#define SEAM(k) do { if (IN(k) && IN((k) + 1)) GSYNC(); } while (0)
    float* mods = (float*)(F.ws + WS_MODS);
    bf16* Hb = (bf16*)(F.ws + WS_H);
    if (((PH_MASK >> 0) & 1) && IN(0)) { p0a_prologue(F); } SEAM(0);
    if (((PH_MASK >> 1) & 1) && IN(1)) { norm_phase<true>(F, F.in[0], F.in[4], mods, mods + 1024, 6144, Hb); __syncthreads(); p0b_prologue(F); } SEAM(1);
    if (((PH_MASK >> 2) & 1) && IN(2)) { pg8::EpiBf16<0> E{(bf16*)(F.ws + WS_PROJ), 3072, nullptr, 0, 0, 1.f}; run_gemm(F, Hb, (const bf16*)(F.ws + WS_WIN), 3072, E); if (DUP == 2) { GSYNC(); run_gemm(F, Hb, (const bf16*)(F.ws + WS_WIN), 3072, E); } } SEAM(2);
    if (((PH_MASK >> 3) & 1) && IN(3)) { p3_mlstm_local(F); if (DUP == 3) { GSYNC(); p3_mlstm_local(F); } } SEAM(3);
    if (((PH_MASK >> 4) & 1) && IN(4)) { p4_scan(F); if (DUP == 4) { GSYNC(); p3_mlstm_local(F); GSYNC(); p4_scan(F); } } SEAM(4);
    if (((PH_MASK >> 5) & 1) && IN(5)) { p5_mlstm_out(F); if (DUP == 5) { GSYNC(); p5_mlstm_out(F); } } SEAM(5);
    if (((PH_MASK >> 6) & 1) && IN(6)) { pg8::EpiResid E{F.in[0], F.out, mods + 2 * 1024, 6144}; run_gemm(F, Hb, (const bf16*)(F.ws + WS_WOUT), 1024, E); if (DUP == 6) { GSYNC(); run_gemm(F, Hb, (const bf16*)(F.ws + WS_WOUT), 1024, E); } } SEAM(6);
    if (((PH_MASK >> 7) & 1) && IN(7)) { norm_phase<false, true>(F, F.out, F.in[5], mods + 3 * 1024, mods + 4 * 1024, 6144, Hb); if (DUP == 7) { GSYNC(); norm_phase<false, true>(F, F.out, F.in[5], mods + 3 * 1024, mods + 4 * 1024, 6144, Hb); } } SEAM(7);
    if (((PH_MASK >> 8) & 1) && IN(8)) { pg8::EpiBf16<0> E{(bf16*)(F.ws + WS_PQ), 2048, nullptr, 0, 0, 1.f}; run_gemm(F, Hb, (const bf16*)(F.ws + WS_WPQ), 2048, E); if (DUP == 8) { GSYNC(); run_gemm(F, Hb, (const bf16*)(F.ws + WS_WPQ), 2048, E); } } SEAM(8);
    if (((PH_MASK >> 9) & 1) && IN(9)) { p_route(F, 0); if (DUP == 9) { GSYNC(); p_route(F, 0); } } SEAM(9);
    if (((PH_MASK >> 10) & 1) && IN(10)) {
        p_upass(F, 0, 0); GSYNC(); p_combine(F, 0); GSYNC(); p_vpass(F, 0, F.out, 1); GSYNC();
        norm2_phase(F, F.out, F.in[4] + 1024, mods + 16 * 6144, mods + 16 * 6144 + 1024, 6144, Hb, F.in[13], (const float*)(F.ws + WS_KVMODS), (const float*)(F.ws + WS_KVMODS) + 1024, 2048, (bf16*)(F.ws + WS_HB));
    } SEAM(10);
    if (((PH_MASK >> 11) & 1) && IN(11)) {
        { pg8::EpiHeadNorm E{(bf16*)(F.ws + WS_Q), (bf16*)(F.ws + WS_Q), 4, F.in[17], 0.125f * 1.4426950408889634f, EPS};     run_gemm(F, Hb, (const bf16*)(F.ws + WS_WSQ), 1024, E); }
        { pg8::EpiHeadNorm E{(bf16*)(F.ws + WS_K), (bf16*)(F.ws + WS_VV), 4, F.in[15], 1.0f, EPS}; run_gemm(F, (const bf16*)(F.ws + WS_HB), (const bf16*)(F.ws + WS_WKV), 2048, E);
          if (DUP == 11) { GSYNC(); run_gemm(F, (const bf16*)(F.ws + WS_HB), (const bf16*)(F.ws + WS_WKV), 2048, E); } }
    } SEAM(11);
    if (((PH_MASK >> 12) & 1) && IN(12)) { p12_attn(F); if (DUP == 12) { GSYNC(); p12_attn(F); } } SEAM(12);
    if (((PH_MASK >> 13) & 1) && IN(13)) { pg8::EpiResid E{F.out, F.out, mods + 16 * 6144 + 2 * 1024, 6144}; run_gemm(F, Hb, (const bf16*)(F.ws + WS_WSO), 1024, E); } SEAM(13);
    if (((PH_MASK >> 14) & 1) && IN(14)) { norm_phase<false, true>(F, F.out, F.in[5] + 1024, mods + 16 * 6144 + 3 * 1024, mods + 16 * 6144 + 4 * 1024, 6144, Hb); } SEAM(14);
    if (((PH_MASK >> 15) & 1) && IN(15)) { pg8::EpiBf16<0> E{(bf16*)(F.ws + WS_PQ), 2048, nullptr, 0, 0, 1.f}; run_gemm(F, Hb, (const bf16*)(F.ws + WS_WPQ) + (size_t)2048 * 1024, 2048, E); } SEAM(15);
    if (((PH_MASK >> 16) & 1) && IN(16)) { p_route(F, 1); } SEAM(16);
    if (((PH_MASK >> 17) & 1) && IN(17)) { p_upass(F, 1, 2); GSYNC(); if (DUP == 20) { p_upass(F, 1, 4); GSYNC(); } p_combine(F, 1); GSYNC(); if (DUP == 22) { p_combine(F, 1); GSYNC(); } if (DUP == 21) { p_vpass(F, 1, (float*)(F.ws + WS_Q + 32 * MiB), 5); GSYNC(); } p_vpass(F, 1, F.out, 3); }
    if (DUP == 30) { for (int i = 0; i < 10; ++i) GSYNC(); }
#undef IN
#undef SEAM
#undef GSYNC
}

extern "C" void kernel_launch(void* const* d_in, const int* in_sizes, int n_in, void* d_out, int out_size, void* d_ws, size_t ws_size, hipStream_t stream) {
    static int grid = 0;
    if (grid == 0) {
        int dev = 0, cus = 0, per_cu = 0;
        (void)hipGetDevice(&dev);
        (void)hipDeviceGetAttribute(&cus, hipDeviceAttributeMultiprocessorCount, dev);
        (void)hipFuncSetAttribute((const void*)fwd, hipFuncAttributeMaxDynamicSharedMemorySize, LDS_BYTES);
        (void)hipOccupancyMaxActiveBlocksPerMultiprocessor(&per_cu, (const void*)fwd, NT, LDS_BYTES);
        if (per_cu < 1) { fprintf(stderr, "kernel_launch: occupancy query says %d blocks per CU\n", per_cu); per_cu = 1; }
        grid = cus;
        if (n_in != 23 || ws_size < WS_END) fprintf(stderr, "kernel_launch: unexpected n_in %d / ws_size %zu\n", n_in, ws_size);
        (void)hipGetLastError();
    }
    Args a{};
    for (int i = 0; i < 23; ++i) a.in[i] = (const float*)d_in[i];
    a.out = (float*)d_out; a.ws = (unsigned char*)d_ws;
#if N_LAUNCH_MODE == 1
    a.ph_lo = 0; a.ph_hi = NPH;
    void* kargs[] = {&a};
    hipError_t e = hipLaunchCooperativeKernel((const void*)fwd, dim3(grid), dim3(NT), kargs, LDS_BYTES, stream);
    if (e != hipSuccess) fprintf(stderr, "kernel_launch: cooperative launch failed: %s (grid %d)\n", hipGetErrorString(e), grid);
#else
    for (int p = 0; p < NPH; ++p) { a.ph_lo = p; a.ph_hi = p + 1; hipLaunchKernelGGL(fwd, dim3(grid), dim3(NT), LDS_BYTES, stream, a); }
#endif
}
```

```cpp
#include <hip/hip_runtime.h>
#include <hip/hip_cooperative_groups.h>
#include <cstdio>
#include <cstdint>
namespace cg = cooperative_groups;
#define N_LAUNCH_MODE 1
namespace pg8 {
#define PG8_LAS __attribute__((address_space(3)))
typedef unsigned short bf16_t;
typedef short bf16x8 __attribute__((ext_vector_type(8)));
typedef float f32x4 __attribute__((ext_vector_type(4)));
typedef unsigned u32x4 __attribute__((ext_vector_type(4)));
constexpr int BM = 256, BK = 64, HALF = 128, HTB = HALF * BK * 2  , STAGE_BYTES = 8 * HTB, NXCD = 8, WGM = 8;

__host__ __device__ __forceinline__ int lds_byte(int r, int c) { const int st = (r >> 4) * 2 + (c >> 5), rr = r & 15, cc = c & 31, ob = rr * 64 + cc * 2; return st * 1024 + (ob ^ (((ob >> 9) & 1) << 5)); }
__host__ __device__ __forceinline__ void stage_rc(int b, int& R, int& C) { const int st = b / 1024, sb = b % 1024, swz = sb ^ (((sb >> 9) & 1) << 5); R = (st >> 1) * 16 + swz / 64; C = (st & 1) * 32 + (swz % 64) / 2; }
__host__ __device__ __forceinline__ int perm32(int rho) { const int n = rho >> 4, i = rho & 15; return 8 * (i >> 2) + 4 * n + (i & 3); }

struct Unit { int pm, pn; };
struct Gemm { const bf16_t* A; const bf16_t* Bt; int M, N, K; };

struct StaticOrder {
    int nM, nN, nwg, G, c;
    __host__ __device__ void init(int M, int N, int G_, int c_) { nM = M / BM; nN = N / BM; nwg = nM * nN; G = G_; c = c_; }
    __host__ __device__ bool next(int i, Unit& u) const {
        const long L = (long)i * G + c; if (L >= nwg) return false;
        int wgid = (int)L; { const int q = nwg / NXCD, r = nwg % NXCD, xcd = wgid % NXCD, off = wgid / NXCD; wgid = (xcd < r ? xcd * (q + 1) : r * (q + 1) + (xcd - r) * q) + off; }
        const int nig = WGM * nN, gid = wgid / nig, fm = gid * WGM, gsz = (nM - fm) < WGM ? (nM - fm) : WGM;
        u.pm = fm + ((wgid % nig) % gsz); u.pn = (wgid % nig) / gsz; return true;
    }
    __device__ __forceinline__ void a_ready(const Unit&) const {}
    __device__ __forceinline__ void done(const Unit&) const {}
};

__device__ __forceinline__ unsigned cvt_pk_bf16(float lo, float hi) { unsigned r; asm volatile("v_cvt_pk_bf16_f32 %0, %1, %2" : "=v"(r) : "v"(lo), "v"(hi)); return r; }
typedef float f32x2 __attribute__((ext_vector_type(2)));
__device__ __forceinline__ f32x2 gelu_pk(f32x2 v) {
    const f32x2 av = __builtin_elementwise_abs(v), d = av * 0.2316418882f + 1.0f;
    f32x2 t; t.x = __builtin_amdgcn_rcpf(d.x); t.y = __builtin_amdgcn_rcpf(d.y);
    f32x2 q = t * 0.5307027145f + (-0.7265760135f); q = q * t + 0.7107068705f; q = q * t + (-0.142248368f); q = q * t + 0.127414796f; q = q * t;
    const f32x2 s = (v * v) * (-0.72134752044f);
    f32x2 e; e.x = __builtin_amdgcn_exp2f(s.x); e.y = __builtin_amdgcn_exp2f(s.y);
    const f32x2 m = v * (q * e), r = v - m;
    f32x2 o; o.x = v.x < 0.f ? m.x : r.x; o.y = v.y < 0.f ? m.y : r.y; return o;
}

template <int ACT  > struct EpiBf16 {
    static constexpr bool PERM = true, AFTER_DRAIN = false; static_assert(ACT == 0 || ACT == 1, "EpiBf16: ACT is 0 (none) or 1 (gelu_pk)");
    bf16_t* O; int ldc; const float* bias; int split_cols; size_t split_stride; float scale0;
    __device__ __forceinline__ void operator()(const f32x4 (&acc)[2][2][4][2], const Unit& u, int wr, int wc, int fr, int fq) const {
        const int row0 = u.pm * BM + wr * 64 + fr; int colt = u.pn * BM; bf16_t* base = O;
        float sc = 1.f; if (split_cols) { const int t = colt / split_cols; base += (size_t)t * split_stride; colt -= t * split_cols; if (t == 0) sc = scale0; }
        const int col0 = colt + wc * 32 + 8 * fq, bcol0 = u.pn * BM + wc * 32 + 8 * fq;
        f32x4 bv[2][2];
#pragma unroll
        for (int bj = 0; bj < 2; ++bj)
#pragma unroll
            for (int n = 0; n < 2; ++n) bv[bj][n] = bias ? *(const f32x4*)(bias + bcol0 + bj * HALF + 4 * n) : (f32x4){0.f, 0.f, 0.f, 0.f};
#pragma unroll
        for (int ai = 0; ai < 2; ++ai)
#pragma unroll
            for (int m = 0; m < 4; ++m) { bf16_t* rowp = base + (size_t)(row0 + ai * HALF + m * 16) * ldc + col0;
#pragma unroll
                for (int bj = 0; bj < 2; ++bj) { f32x4 v0 = acc[ai][bj][m][0] + bv[bj][0], v1 = acc[ai][bj][m][1] + bv[bj][1];
                    if (ACT == 1) { f32x2 a = gelu_pk((f32x2){v0[0], v0[1]}), b = gelu_pk((f32x2){v0[2], v0[3]}), c = gelu_pk((f32x2){v1[0], v1[1]}), d = gelu_pk((f32x2){v1[2], v1[3]});
                        v0 = (f32x4){a.x, a.y, b.x, b.y}; v1 = (f32x4){c.x, c.y, d.x, d.y}; }
                    v0 = v0 * sc; v1 = v1 * sc; u32x4 w; w.x = cvt_pk_bf16(v0[0], v0[1]); w.y = cvt_pk_bf16(v0[2], v0[3]); w.z = cvt_pk_bf16(v1[0], v1[1]); w.w = cvt_pk_bf16(v1[2], v1[3]);
                    *(u32x4*)(rowp + bj * HALF) = w; } }
    }
};
struct EpiResid {
    static constexpr bool PERM = false, AFTER_DRAIN = false;
    const float* base; float* out; const float* gate; int gstride;
    __device__ __forceinline__ void operator()(const f32x4 (&acc)[2][2][4][2], const Unit& u, int wr, int wc, int fr, int fq) const {
        const int col0 = u.pn * BM + wc * 32 + 4 * fq;
        const int b = (u.pm * BM) >> 11;
        f32x4 gv[2][2];
#pragma unroll
        for (int bj = 0; bj < 2; ++bj)
#pragma unroll
            for (int n = 0; n < 2; ++n) gv[bj][n] = *(const f32x4*)(gate + (size_t)b * gstride + col0 + bj * HALF + n * 16);
#pragma unroll
        for (int ai = 0; ai < 2; ++ai)
#pragma unroll
            for (int m = 0; m < 4; ++m) { const size_t off = (size_t)(u.pm * BM + ai * HALF + wr * 64 + m * 16 + fr) * 1024 + col0;
#pragma unroll
                for (int bj = 0; bj < 2; ++bj)
#pragma unroll
                    for (int n = 0; n < 2; ++n) { const f32x4 bs = *(const f32x4*)(base + off + bj * HALF + n * 16);
                        *(f32x4*)(out + off + bj * HALF + n * 16) = bs + gv[bj][n] * acc[ai][bj][m][n]; }
                if (m & 1) asm volatile("" ::: "memory"); }
    }
};
struct EpiHeadNorm {
    static constexpr bool PERM = true, AFTER_DRAIN = false;
    bf16_t* O0; bf16_t* O1; int ntile_norm; const float* g; float scale; float eps;
    __device__ __forceinline__ void operator()(const f32x4 (&acc)[2][2][4][2], const Unit& u, int wr, int wc, int fr, int fq) const {
        const bool nrm = u.pn < ntile_norm; bf16_t* O = nrm ? O0 : O1; const int pnl = nrm ? u.pn : u.pn - ntile_norm;
        f32x4 gv[2][2];
#pragma unroll
        for (int bj = 0; bj < 2; ++bj)
#pragma unroll
            for (int n = 0; n < 2; ++n) { const f32x4 t = *(const f32x4*)(g + 32 * bj + 8 * fq + 4 * n); gv[bj][n] = nrm ? t * scale : (f32x4){1.f, 1.f, 1.f, 1.f}; }
#pragma unroll
        for (int ai = 0; ai < 2; ++ai)
#pragma unroll
            for (int m = 0; m < 4; ++m) {
                float ss = 0.f;
#pragma unroll
                for (int bj = 0; bj < 2; ++bj)
#pragma unroll
                    for (int n = 0; n < 2; ++n) { const f32x4 x = acc[ai][bj][m][n]; ss += (x[0] * x[0] + x[1] * x[1]) + (x[2] * x[2] + x[3] * x[3]); }
                ss += __shfl_xor(ss, 16); ss += __shfl_xor(ss, 32);
                const float rs = nrm ? 1.0f / sqrtf(ss * (1.0f / 64.0f) + eps) : 1.0f;
                bf16_t* rowp = O + (size_t)(u.pm * BM + ai * HALF + wr * 64 + m * 16 + fr) * 1024 + pnl * BM + wc * 64 + 8 * fq;
#pragma unroll
                for (int bj = 0; bj < 2; ++bj) { const f32x4 v0 = acc[ai][bj][m][0] * rs * gv[bj][0], v1 = acc[ai][bj][m][1] * rs * gv[bj][1];
                    u32x4 w; w.x = cvt_pk_bf16(v0[0], v0[1]); w.y = cvt_pk_bf16(v0[2], v0[3]); w.z = cvt_pk_bf16(v1[0], v1[1]); w.w = cvt_pk_bf16(v1[2], v1[3]);
                    *(u32x4*)(rowp + bj * 32) = w; }
            }
    }
};
template <class Epi, class Sched, bool ALIGN_EPI = false, bool SP2 = false>
__device__ __forceinline__ void gemm_phase(PG8_LAS unsigned char* lds, const Gemm g, const Sched& S, const Epi& E) {
    const int tid = threadIdx.x, wid = __builtin_amdgcn_readfirstlane(tid >> 6), lane = tid & 63, wr = wid >> 2, wc = wid & 3, fr = lane & 15, fq = lane >> 4;
    const int K = g.K, nt = K / BK;
    unsigned voffA[2], voffB[2];
#pragma unroll
    for (int i = 0; i < 2; ++i) { int R, C; stage_rc(tid * 16 + i * 8192, R, C); const int Rb = Epi::PERM ? ((R & ~31) + perm32(R & 31)) : R;
        voffA[i] = (unsigned)(R * K + C) * 2u; voffB[i] = (unsigned)(Rb * K + C) * 2u; }
    const size_t kstep = (size_t)(BK * 2);
    const size_t hstep = (size_t)HALF * K * 2;
    const size_t tstep = 2 * hstep;
    const unsigned ldsw = (unsigned)wid * 1024u;
    const int aoff = lds_byte(wr * 64 + fr, fq * 8), boff = lds_byte(wc * 32 + fr, fq * 8);
#define PG8_SA(b, h) (((b) * 2 + (h)) * HTB)
#define PG8_SB(b, h) ((4 + (b) * 2 + (h)) * HTB)
#define PG8_STAGE(bufoff, gbase, voff) do { _Pragma("unroll") for (int _i = 0; _i < 2; ++_i) \
        __builtin_amdgcn_global_load_lds((const unsigned*)((const char*)(gbase) + (voff)[_i]), (PG8_LAS unsigned*)(lds + (bufoff) + ldsw + _i * 8192), 16, 0, 0); } while (0)
#define PG8_LDA(dst, b, h) do { _Pragma("unroll") for (int m = 0; m < 4; ++m) _Pragma("unroll") for (int k = 0; k < 2; ++k) dst[m][k] = *(const PG8_LAS bf16x8*)(lds + PG8_SA(b, h) + aoff + m * 2048 + k * 1024); } while (0)
#define PG8_LDB(dst, b, h) do { _Pragma("unroll") for (int n = 0; n < 2; ++n) _Pragma("unroll") for (int k = 0; k < 2; ++k) dst[n][k] = *(const PG8_LAS bf16x8*)(lds + PG8_SB(b, h) + boff + n * 2048 + k * 1024); } while (0)
#define PG8_MMA(ai, bj, At, Bt) do { __builtin_amdgcn_s_setprio(1); _Pragma("unroll") for (int m = 0; m < 4; ++m) _Pragma("unroll") for (int n = 0; n < 2; ++n) _Pragma("unroll") for (int k = 0; k < 2; ++k) \
        acc[ai][bj][m][n] = __builtin_amdgcn_mfma_f32_16x16x32_bf16(Bt[n][k], At[m][k], acc[ai][bj][m][n], 0, 0, 0); __builtin_amdgcn_s_setprio(0); } while (0)
#define PG8_WAIT_V(n) asm volatile("s_waitcnt vmcnt(" #n ")" ::: "memory")
#define PG8_WAIT_L(n) asm volatile("s_waitcnt lgkmcnt(" #n ")" ::: "memory")
#define PG8_BAR __builtin_amdgcn_s_barrier()
#define PG8_SCHED __builtin_amdgcn_sched_barrier(0)
    Unit cur, nxt; int ui = 0;
    if (!S.next(0, cur)) return;
    f32x4 acc[2][2][4][2];
#pragma unroll
    for (int a = 0; a < 2; ++a)
#pragma unroll
        for (int b = 0; b < 2; ++b)
#pragma unroll
            for (int m = 0; m < 4; ++m)
#pragma unroll
                for (int n = 0; n < 2; ++n) acc[a][b][m][n] = (f32x4){0.f, 0.f, 0.f, 0.f};
    bf16x8 At[4][2], B0[2][2], B1[2][2];
    const char* cA = (const char*)g.A + (size_t)cur.pm * tstep; const char* cB = (const char*)g.Bt + (size_t)cur.pn * tstep;
    S.a_ready(cur);
    if constexpr (SP2) {
        PG8_STAGE(PG8_SB(0, 0), cB, voffB); PG8_STAGE(PG8_SB(0, 1), cB + hstep, voffB); PG8_STAGE(PG8_SA(0, 0), cA, voffA); PG8_STAGE(PG8_SA(0, 1), cA + hstep, voffA);
        if (wr == 1) PG8_BAR;
        PG8_WAIT_V(2); PG8_BAR;
        PG8_STAGE(PG8_SB(1, 0), cB + kstep, voffB); PG8_STAGE(PG8_SA(1, 0), cA + kstep, voffA); PG8_STAGE(PG8_SB(1, 1), cB + hstep + kstep, voffB);
        PG8_WAIT_V(6); PG8_BAR;
    } else {
        PG8_STAGE(PG8_SB(0, 0), cB, voffB); PG8_STAGE(PG8_SA(0, 0), cA, voffA); PG8_STAGE(PG8_SB(0, 1), cB + hstep, voffB); PG8_STAGE(PG8_SA(0, 1), cA + hstep, voffA);
        if (wr == 1) PG8_BAR;
        PG8_WAIT_V(4); PG8_BAR;
        PG8_STAGE(PG8_SB(1, 0), cB + kstep, voffB); PG8_STAGE(PG8_SA(1, 0), cA + kstep, voffA); PG8_STAGE(PG8_SB(1, 1), cB + hstep + kstep, voffB);
        PG8_WAIT_V(6); PG8_BAR;
    }
    for (;;) {
        const bool has_next = S.next(ui + 1, nxt);
        const char* nA = has_next ? (const char*)g.A + (size_t)nxt.pm * tstep : cA; const char* nB = has_next ? (const char*)g.Bt + (size_t)nxt.pn * tstep : cB;
        for (int t = 0; t < nt; t += 2) {
            const bool last = (t == nt - 2);
            const char* a1 = cA + (size_t)(t + 1) * kstep;
            const char* a2 = last ? nA : cA + (size_t)(t + 2) * kstep; const char* b2 = last ? nB : cB + (size_t)(t + 2) * kstep;
            const char* a3 = a2 + kstep; const char* b3 = b2 + kstep;
            if (last && has_next) S.a_ready(nxt);
            if constexpr (SP2) {
            PG8_LDB(B0, 0, 0); PG8_LDB(B1, 0, 1); PG8_SCHED; PG8_LDA(At, 0, 0); PG8_STAGE(PG8_SA(1, 1), a1 + hstep, voffA);
            PG8_WAIT_V(8); PG8_WAIT_L(0); PG8_BAR; PG8_MMA(0, 0, At, B0); PG8_MMA(0, 1, At, B1); PG8_BAR; PG8_SCHED;
            PG8_LDA(At, 0, 1); PG8_STAGE(PG8_SB(0, 0), b2, voffB); PG8_STAGE(PG8_SB(0, 1), b2 + hstep, voffB); PG8_STAGE(PG8_SA(0, 0), a2, voffA);
            PG8_WAIT_V(8); PG8_WAIT_L(0); PG8_BAR; PG8_MMA(1, 0, At, B0); PG8_MMA(1, 1, At, B1); PG8_BAR; PG8_SCHED;
            PG8_LDB(B0, 1, 0); PG8_LDB(B1, 1, 1); PG8_SCHED; PG8_LDA(At, 1, 0); PG8_STAGE(PG8_SA(0, 1), a2 + hstep, voffA);
            PG8_WAIT_V(8); PG8_WAIT_L(0); PG8_BAR; PG8_MMA(0, 0, At, B0); PG8_MMA(0, 1, At, B1); PG8_BAR; PG8_SCHED;
            PG8_LDA(At, 1, 1); PG8_STAGE(PG8_SB(1, 0), b3, voffB); PG8_STAGE(PG8_SB(1, 1), b3 + hstep, voffB); PG8_STAGE(PG8_SA(1, 0), a3, voffA);
            PG8_WAIT_V(8); PG8_WAIT_L(0); PG8_BAR; PG8_MMA(1, 0, At, B0); PG8_MMA(1, 1, At, B1); PG8_BAR; PG8_SCHED;
            } else {
            PG8_LDB(B0, 0, 0); PG8_SCHED; PG8_LDA(At, 0, 0); PG8_STAGE(PG8_SA(1, 1), a1 + hstep, voffA);
            PG8_WAIT_L(8); PG8_BAR; PG8_WAIT_L(0); PG8_MMA(0, 0, At, B0); PG8_BAR; PG8_SCHED;
            PG8_LDB(B1, 0, 1); PG8_STAGE(PG8_SB(0, 0), b2, voffB);
            PG8_BAR; PG8_WAIT_L(0); PG8_MMA(0, 1, At, B1); PG8_BAR;
            PG8_LDA(At, 0, 1); PG8_STAGE(PG8_SA(0, 0), a2, voffA);
            PG8_BAR; PG8_WAIT_L(0); PG8_MMA(1, 0, At, B0); PG8_BAR; PG8_SCHED;
            PG8_STAGE(PG8_SB(0, 1), b2 + hstep, voffB);
            PG8_WAIT_V(6); PG8_BAR; PG8_MMA(1, 1, At, B1); PG8_BAR;
            PG8_LDB(B0, 1, 0); PG8_SCHED; PG8_LDA(At, 1, 0); PG8_STAGE(PG8_SA(0, 1), a2 + hstep, voffA);
            PG8_WAIT_L(8); PG8_BAR; PG8_WAIT_L(0); PG8_MMA(0, 0, At, B0); PG8_BAR; PG8_SCHED;
            PG8_LDB(B1, 1, 1); PG8_STAGE(PG8_SB(1, 0), b3, voffB);
            PG8_BAR; PG8_WAIT_L(0); PG8_MMA(0, 1, At, B1); PG8_BAR;
            PG8_LDA(At, 1, 1); PG8_STAGE(PG8_SA(1, 0), a3, voffA);
            PG8_BAR; PG8_WAIT_L(0); PG8_MMA(1, 0, At, B0); PG8_BAR; PG8_SCHED;
            PG8_STAGE(PG8_SB(1, 1), b3 + hstep, voffB);
            PG8_WAIT_V(6); PG8_BAR; PG8_MMA(1, 1, At, B1); PG8_BAR;
            }
        }
        if constexpr (ALIGN_EPI) { if (wr == 0) PG8_BAR; }
        if constexpr (!Epi::AFTER_DRAIN) { E(acc, cur, wr, wc, fr, fq); S.done(cur); }
        if (!has_next) break;
#pragma unroll
        for (int a = 0; a < 2; ++a)
#pragma unroll
            for (int b = 0; b < 2; ++b)
#pragma unroll
                for (int m = 0; m < 4; ++m)
#pragma unroll
                    for (int n = 0; n < 2; ++n) acc[a][b][m][n] = (f32x4){0.f, 0.f, 0.f, 0.f};
        cur = nxt; cA = nA; cB = nB; ++ui;
        if constexpr (ALIGN_EPI) { if (wr == 1) PG8_BAR; }
    }
    PG8_WAIT_V(0);
    if constexpr (!ALIGN_EPI) { if (wr == 0) PG8_BAR; }
    PG8_BAR;
    if constexpr (Epi::AFTER_DRAIN) { E.fused(acc, cur, wr, wc, fr, fq, lds, wid, lane); S.done(cur); }
#undef PG8_SA
#undef PG8_SB
#undef PG8_STAGE
#undef PG8_LDA
#undef PG8_LDB
#undef PG8_MMA
#undef PG8_WAIT_V
#undef PG8_WAIT_L
#undef PG8_BAR
#undef PG8_SCHED
}
}

#define DI __device__ __forceinline__
#define LAS __attribute__((address_space(3)))
typedef unsigned short bf16;
typedef __bf16 bf16x2_t __attribute__((ext_vector_type(2)));
typedef float f32x2_t __attribute__((ext_vector_type(2)));
typedef float f32x4 __attribute__((ext_vector_type(4)));
typedef float f32x16 __attribute__((ext_vector_type(16)));
typedef short bf16x8 __attribute__((ext_vector_type(8)));
typedef short s16x4 __attribute__((ext_vector_type(4)));
typedef unsigned u32x4 __attribute__((ext_vector_type(4)));
typedef unsigned u32x2 __attribute__((ext_vector_type(2)));

constexpr int NT = 512, NWAVES = 8;
constexpr int LDS_BYTES = 147456;
constexpr int T_TOK = 32768, DM = 1024, SEQ = 2048, NB = 16;
constexpr float EPS = 1e-6f;
constexpr size_t MiB = 1u << 20;
constexpr size_t WS_MODS = 1 * MiB, WS_KVMODS = WS_MODS + (size_t)2 * 16 * 6144 * 4;
constexpr size_t WS_GATES = 2 * MiB, WS_BLAST = 4 * MiB, WS_MLOC = 4 * MiB + 65536, WS_MPREV = 4 * MiB + 131072, WS_NLOC = 5 * MiB;
constexpr size_t WS_WG = 6 * MiB, WS_SUBK = 7 * MiB;
constexpr size_t WS_WIN = 8 * MiB, WS_WOUT = 14 * MiB, WS_WKV = 16 * MiB, WS_WSQ = 20 * MiB, WS_WSO = 22 * MiB, WS_WPQ = 24 * MiB;
constexpr size_t WS_IDX = 36 * MiB, WS_GATE = 44 * MiB, WS_SU = 60 * MiB, WS_SV = 61 * MiB, WS_SW8 = 62 * MiB;
constexpr size_t WS_H2Q = 256 * MiB, WS_SH = 288 * MiB + 0;
constexpr size_t WS_U = 64 * MiB, WS_V = 128 * MiB, WS_H = 192 * MiB, WS_HB = 256 * MiB, WS_PROJ = 320 * MiB, WS_END = 512 * MiB;
constexpr size_t WS_QC = 96 * MiB, WS_KC = 160 * MiB;
constexpr size_t WS_CST = WS_HB;
constexpr size_t WS_Q = WS_PROJ, WS_K = WS_PROJ + 64 * MiB, WS_VV = WS_PROJ + 128 * MiB, WS_PQ = WS_PROJ;

struct Args { const float* in[23]; float* out; unsigned char* ws; int ph_lo, ph_hi; };
struct Frame {
    LAS unsigned char* lds;
    const float* in[23]; float* out; unsigned char* ws;
    int tid, lane, wave, bid, G;
    int vc;
};

DI unsigned cvtpk(float lo, float hi) { f32x2_t v = {lo, hi}; bf16x2_t b = __builtin_convertvector(v, bf16x2_t); return __builtin_bit_cast(unsigned, b); }
DI float bflo(unsigned u) { return __uint_as_float(u << 16); }
DI float bfhi(unsigned u) { return __uint_as_float(u & 0xffff0000u); }

template <int M> DI unsigned lxu(unsigned v) {
    if constexpr (M == 1) return (unsigned)__builtin_amdgcn_mov_dpp((int)v, 0xB1, 0xf, 0xf, true);
    else if constexpr (M == 2) return (unsigned)__builtin_amdgcn_mov_dpp((int)v, 0x4E, 0xf, 0xf, true);
    else if constexpr (M == 7) return (unsigned)__builtin_amdgcn_mov_dpp((int)v, 0x141, 0xf, 0xf, true);
    else if constexpr (M == 8) return (unsigned)__builtin_amdgcn_mov_dpp((int)v, 0x128, 0xf, 0xf, true);
    else if constexpr (M == 16) { auto r = __builtin_amdgcn_permlane16_swap(v, v, false, false); return r[0] ^ r[1] ^ v; }
    else { static_assert(M == 32, "lxu: M"); auto r = __builtin_amdgcn_permlane32_swap(v, v, false, false); return r[0] ^ r[1] ^ v; }
}
template <int M> DI float lx(float v) { return __uint_as_float(lxu<M>(__float_as_uint(v))); }
template <int M> DI int lx(int v) { return (int)lxu<M>((unsigned)v); }
DI float wave_sum(float v) { v += lx<1>(v); v += lx<2>(v); v += lx<7>(v); v += lx<8>(v); v += lx<16>(v); v += lx<32>(v); return v; }
DI float wave_max(float v) { v = fmaxf(v, lx<1>(v)); v = fmaxf(v, lx<2>(v)); v = fmaxf(v, lx<7>(v)); v = fmaxf(v, lx<8>(v)); v = fmaxf(v, lx<16>(v)); v = fmaxf(v, lx<32>(v)); return v; }
DI int crow(int r, int hi) { return (r & 3) + 8 * (r >> 2) + 4 * hi; }
#define MFMA32(a, b, c) __builtin_amdgcn_mfma_f32_32x32x16_bf16((a), (b), (c), 0, 0, 0)
typedef short v4i16_t __attribute__((ext_vector_type(4)));
DI s16x4 tr16(const LAS unsigned char* p) { return __builtin_bit_cast(s16x4, __builtin_amdgcn_ds_read_tr16_b64_v4i16((LAS v4i16_t*)p)); }
DI int tr_off(int tok, int ch) { return (ch >> 2) * 4096 + (tok >> 4) * 1024 + (tok & 15) * 64 + (ch & 3) * 16; }
DI bf16x8 tr_frag(const LAS unsigned char* img, int dh, int ks, int lane) {
    const int hi = lane >> 5; const int vb = ((lane >> 4) & 1) * 32 + (lane & 3) * 8 + (4 * hi + ((lane & 15) >> 2)) * 64;
    const s16x4 lo = tr16(img + vb + dh * 4096 + ks * 1024), h2 = tr16(img + vb + dh * 4096 + ks * 1024 + 512);
    return __builtin_shufflevector(lo, h2, 0, 1, 2, 3, 4, 5, 6, 7);
}
template <int NTOK> DI bf16x8 row_frag(const LAS unsigned char* img, int tt, int ks, int lane) {
    const int hi = lane >> 5, r32 = lane & 31;
    return *(const LAS bf16x8*)(img + (2 * ks + hi) * (NTOK * 16) + (32 * tt + r32) * 16);
}
DI bf16x8 pack8(const f32x16& x, int s) {
    u32x4 p; p.x = cvtpk(x[8 * s], x[8 * s + 1]); p.y = cvtpk(x[8 * s + 2], x[8 * s + 3]); p.z = cvtpk(x[8 * s + 4], x[8 * s + 5]); p.w = cvtpk(x[8 * s + 6], x[8 * s + 7]);
    return __builtin_bit_cast(bf16x8, p);
}

DI void p0_ada(Frame& F) {
    LAS float* sil = (LAS float*)F.lds;
    LAS float* red = (LAS float*)(F.lds + 65536);
    const float* c = F.in[1];
    for (int i = F.tid; i < 16 * 1024; i += NT) { const int b = i >> 10, d = i & 1023; const float v = c[i]; sil[d * 16 + b] = v / (1.f + expf(-v)); }
    __syncthreads();
    for (int item = F.bid; item < 224; item += F.G) {
        const float* W; const float* bias; float* out; int N, col0;
        if (item < 192) { const int layer = item / 96, it = item % 96; W = F.in[2] + (size_t)layer * 1024 * 6144; bias = F.in[3] + layer * 6144; N = 6144; col0 = it * 64; out = (float*)(F.ws + WS_MODS) + (size_t)layer * 16 * 6144; }
        else { const int it = item - 192; W = F.in[11]; bias = F.in[12]; N = 2048; col0 = it * 64; out = (float*)(F.ws + WS_KVMODS); }
        float acc[16];
#pragma unroll
        for (int b = 0; b < 16; ++b) acc[b] = 0.f;
        const int d0 = F.wave * 128;
        const float* wp = W + (size_t)d0 * N + col0 + F.lane;
#pragma unroll 16
        for (int d = 0; d < 128; ++d) {
            const float w = wp[(size_t)d * N];
            const LAS f32x4* s4 = (const LAS f32x4*)(sil + (d0 + d) * 16);
            const f32x4 s0 = s4[0], s1 = s4[1], s2 = s4[2], s3 = s4[3];
            acc[0] += w * s0[0]; acc[1] += w * s0[1]; acc[2] += w * s0[2]; acc[3] += w * s0[3];
            acc[4] += w * s1[0]; acc[5] += w * s1[1]; acc[6] += w * s1[2]; acc[7] += w * s1[3];
            acc[8] += w * s2[0]; acc[9] += w * s2[1]; acc[10] += w * s2[2]; acc[11] += w * s2[3];
            acc[12] += w * s3[0]; acc[13] += w * s3[1]; acc[14] += w * s3[2]; acc[15] += w * s3[3];
        }
#pragma unroll
        for (int b = 0; b < 16; ++b) red[(F.wave * 16 + b) * 64 + F.lane] = acc[b];
        __syncthreads();
        for (int i = F.tid; i < 1024; i += NT) { const int b = i >> 6, l = i & 63; float s = 0.f;
#pragma unroll
            for (int w = 0; w < 8; ++w) s += red[(w * 16 + b) * 64 + l];
            out[(size_t)b * N + col0 + l] = s + bias[col0 + l]; }
        __syncthreads();
    }
}
DI void transpose_item(const float* W, int ldw, bf16* WT, int dst_row0, LAS float* scr, int k0, int n0, int lane) {
#pragma unroll 8
    for (int i = 0; i < 32; ++i) { const int kk = 2 * i + (lane >> 5); scr[kk * 33 + (lane & 31)] = W[(size_t)(k0 + kk) * ldw + n0 + (lane & 31)]; }
    asm volatile("s_waitcnt lgkmcnt(0)" ::: "memory");
    const int c = lane & 7;
#pragma unroll
    for (int j = 0; j < 4; ++j) { const int n = (lane >> 3) + 8 * j; const LAS float* s = scr + (8 * c) * 33 + n;
        u32x4 o; o.x = cvtpk(s[0 * 33], s[1 * 33]); o.y = cvtpk(s[2 * 33], s[3 * 33]); o.z = cvtpk(s[4 * 33], s[5 * 33]); o.w = cvtpk(s[6 * 33], s[7 * 33]);
        *(u32x4*)(WT + (size_t)(dst_row0 + n) * 1024 + k0 + 8 * c) = o; }
    asm volatile("s_waitcnt lgkmcnt(0)" ::: "memory");
}
DI int permrow(int c) { return (c & ~255) + 32 * (4 * ((c >> 5) & 1) + ((c >> 6) & 3)) + (c & 31); }
DI void p0a_prologue(Frame& F) {
    p0_ada(F);
    for (size_t i = (size_t)F.bid * NT + F.tid; i < 16 * 1024; i += (size_t)F.G * NT) { const int g = (int)(i >> 10), k = (int)(i & 1023); ((float*)(F.ws + WS_WG))[i] = F.in[6][(size_t)k * 3088 + 3072 + g]; }
}
DI void p0b_prologue(Frame& F) {
    LAS float* scr = (LAS float*)(F.lds + F.wave * 16384);
    const int gw = F.bid * NWAVES + F.wave, NGW = F.G * NWAVES;
    for (int it = gw; it < 6144; it += NGW) {
        int r = it; const float* W; int ldw, ncols; bf16* dst; bool perm;
        if (r < 1536) { W = F.in[6]; ldw = 3088; ncols = 3072; dst = (bf16*)(F.ws + WS_WIN); perm = false; }
        else if ((r -= 1536) < 512) { W = F.in[10]; ldw = 1024; ncols = 1024; dst = (bf16*)(F.ws + WS_WOUT); perm = false; }
        else if ((r -= 512) < 1024) { W = F.in[14]; ldw = 2048; ncols = 2048; dst = (bf16*)(F.ws + WS_WKV); perm = true; }
        else if ((r -= 1024) < 512) { W = F.in[16]; ldw = 1024; ncols = 1024; dst = (bf16*)(F.ws + WS_WSQ); perm = true; }
        else if ((r -= 512) < 512) { W = F.in[18]; ldw = 1024; ncols = 1024; dst = (bf16*)(F.ws + WS_WSO); perm = false; }
        else if ((r -= 512) < 1024) { W = F.in[19]; ldw = 2048; ncols = 2048; dst = (bf16*)(F.ws + WS_WPQ); perm = false; }
        else { r -= 1024; W = F.in[19] + (size_t)1024 * 2048; ldw = 2048; ncols = 2048; dst = (bf16*)(F.ws + WS_WPQ) + (size_t)2048 * 1024; perm = false; }
        const int nblk = ncols / 32, kb = r / nblk, nb = r % nblk, n0 = 32 * nb;
        transpose_item(W, ldw, dst, perm ? permrow(n0) : n0, scr, 64 * kb, n0, F.lane);
    }
    const size_t gt = (size_t)F.bid * NT + F.tid, NGT = (size_t)F.G * NT;
    for (int row = gw; row < 2 * 16384; row += NGW) {
        const f32x4* src = (const f32x4*)(F.in[22] + (size_t)row * 1024) + 4 * F.lane;
        const f32x4 a = src[0], b = src[1], c2 = src[2], d = src[3];
        float m = fmaxf(fmaxf(fmaxf(fabsf(a[0]), fabsf(a[1])), fmaxf(fabsf(a[2]), fabsf(a[3]))), fmaxf(fmaxf(fabsf(b[0]), fabsf(b[1])), fmaxf(fabsf(b[2]), fabsf(b[3]))));
        m = fmaxf(m, fmaxf(fmaxf(fmaxf(fabsf(c2[0]), fabsf(c2[1])), fmaxf(fabsf(c2[2]), fabsf(c2[3]))), fmaxf(fmaxf(fabsf(d[0]), fabsf(d[1])), fmaxf(fabsf(d[2]), fabsf(d[3])))));
        m = fmaxf(wave_max(m), 1e-30f);
        const float inv = 127.0f / m;
        auto q4 = [&](const f32x4& v) -> unsigned { const int x0 = (int)rintf(v[0] * inv), x1 = (int)rintf(v[1] * inv), x2 = (int)rintf(v[2] * inv), x3 = (int)rintf(v[3] * inv);
            return (unsigned)(x0 & 255) | ((unsigned)(x1 & 255) << 8) | ((unsigned)(x2 & 255) << 16) | ((unsigned)(x3 & 255) << 24); };
        { const size_t ly = (size_t)row >> 14, e = (size_t)row & 16383;
          ((u32x4*)(F.ws + WS_V))[(((ly * 8 + (F.lane >> 3)) * 16384 + e) << 3) + (F.lane & 7)] = (u32x4){q4(a), q4(b), q4(c2), q4(d)}; }
        if (F.lane == 0) ((float*)(F.ws + WS_SV))[row] = m * (1.0f / 127.0f);
    }
    for (int row = gw; row < 2 * 16384; row += NGW) {
        const f32x4* src = (const f32x4*)(F.in[21] + (size_t)row * 1024) + 4 * F.lane;
        const f32x4 a = src[0], b = src[1], c2 = src[2], d = src[3];
        float m = fmaxf(fmaxf(fmaxf(fabsf(a[0]), fabsf(a[1])), fmaxf(fabsf(a[2]), fabsf(a[3]))), fmaxf(fmaxf(fabsf(b[0]), fabsf(b[1])), fmaxf(fabsf(b[2]), fabsf(b[3]))));
        m = fmaxf(m, fmaxf(fmaxf(fmaxf(fabsf(c2[0]), fabsf(c2[1])), fmaxf(fabsf(c2[2]), fabsf(c2[3]))), fmaxf(fmaxf(fabsf(d[0]), fabsf(d[1])), fmaxf(fabsf(d[2]), fabsf(d[3])))));
        m = fmaxf(wave_max(m), 1e-30f);
        const float inv = 127.0f / m;
        auto q4 = [&](const f32x4& v) -> unsigned { const int x0 = (int)rintf(v[0] * inv), x1 = (int)rintf(v[1] * inv), x2 = (int)rintf(v[2] * inv), x3 = (int)rintf(v[3] * inv);
            return (unsigned)(x0 & 255) | ((unsigned)(x1 & 255) << 8) | ((unsigned)(x2 & 255) << 16) | ((unsigned)(x3 & 255) << 24); };
        { const size_t ly = (size_t)row >> 14, e = (size_t)row & 16383;
          ((u32x4*)(F.ws + WS_U))[(((ly * 8 + (F.lane >> 3)) * 16384 + e) << 3) + (F.lane & 7)] = (u32x4){q4(a), q4(b), q4(c2), q4(d)}; }
        if (F.lane == 0) ((float*)(F.ws + WS_SU))[row] = m * (1.0f / 127.0f);
    }
    for (size_t i = gt; i < 65536 / 2; i += NGT) { const float a = F.in[20][2 * i], b = F.in[20][2 * i + 1]; ((unsigned*)(F.ws + WS_SUBK))[i] = cvtpk(a, b); }
}

template <bool GATES, bool Q8> DI void norm_row(Frame& F, f32x4 (&v)[4], int row, const f32x4 (&A)[4], const f32x4 (&Bv)[4], bf16* hout, const LAS float* wg) {
    float ss = 0.f;
#pragma unroll
    for (int j = 0; j < 4; ++j) ss += (v[j][0] * v[j][0] + v[j][1] * v[j][1]) + (v[j][2] * v[j][2] + v[j][3] * v[j][3]);
    const float rstd = 1.0f / sqrtf(wave_sum(ss) * (1.0f / DM) + EPS);
    unsigned long long* o8 = (unsigned long long*)(hout + (size_t)row * DM) + F.lane;
#pragma unroll
    for (int j = 0; j < 4; ++j) { v[j] = v[j] * rstd * A[j] + Bv[j]; o8[64 * j] = (unsigned long long)cvtpk(v[j][0], v[j][1]) | ((unsigned long long)cvtpk(v[j][2], v[j][3]) << 32); }
    if (Q8) {
        float m = 0.f;
#pragma unroll
        for (int j = 0; j < 4; ++j) m = fmaxf(m, fmaxf(fmaxf(fabsf(v[j][0]), fabsf(v[j][1])), fmaxf(fabsf(v[j][2]), fabsf(v[j][3]))));
        m = fmaxf(wave_max(m), 1e-30f);
        const float inv = 127.0f / m;
        unsigned* q8 = (unsigned*)(F.ws + WS_H2Q + (size_t)row * DM) + F.lane;
#pragma unroll
        for (int j = 0; j < 4; ++j) { const int x0 = (int)rintf(v[j][0] * inv), x1 = (int)rintf(v[j][1] * inv), x2 = (int)rintf(v[j][2] * inv), x3 = (int)rintf(v[j][3] * inv);
            q8[64 * j] = (unsigned)(x0 & 255) | ((unsigned)(x1 & 255) << 8) | ((unsigned)(x2 & 255) << 16) | ((unsigned)(x3 & 255) << 24); }
        if (F.lane == 0) ((float*)(F.ws + WS_SH))[row] = m * (1.0f / 127.0f);
    }
    if (GATES) {
        float p[16];
#pragma unroll
        for (int q = 0; q < 16; ++q) { float s = 0.f;
#pragma unroll
            for (int j = 0; j < 4; ++j) { const f32x4 w = *(const LAS f32x4*)(wg + q * 1024 + 4 * F.lane + 256 * j); s += (v[j][0] * w[0] + v[j][1] * w[1]) + (v[j][2] * w[2] + v[j][3] * w[3]); }
            p[q] = s; if ((q & 3) == 3) { asm volatile("" ::: "memory"); __builtin_amdgcn_sched_barrier(0); } }
#pragma unroll
        for (int i = 0; i < 8; ++i) { const bool up = (F.lane & 32) != 0; const float send = up ? p[i] : p[i + 8], keep = up ? p[i + 8] : p[i]; p[i] = keep + lx<32>(send); }
#pragma unroll
        for (int i = 0; i < 4; ++i) { const bool up = (F.lane & 16) != 0; const float send = up ? p[i] : p[i + 4], keep = up ? p[i + 4] : p[i]; p[i] = keep + lx<16>(send); }
#pragma unroll
        for (int i = 0; i < 2; ++i) { const bool up = (F.lane & 8) != 0; const float send = up ? p[i] : p[i + 2], keep = up ? p[i + 2] : p[i]; p[i] = keep + lx<8>(send); }
        { const bool up = (F.lane & 4) != 0; const float send = up ? p[0] : p[1], keep = up ? p[1] : p[0]; p[0] = keep + lx<7>(send); }
        p[0] += lx<2>(p[0]); p[0] += lx<1>(p[0]);
        const int gi = ((F.lane >> 5) & 1) * 8 + ((F.lane >> 4) & 1) * 4 + ((F.lane >> 3) & 1) * 2 + ((F.lane >> 2) & 1);
        if ((F.lane & 3) == 0) ((float*)(F.ws + WS_GATES))[(size_t)row * 16 + gi] = p[0];
    }
}
DI void load_rows4(f32x4 (&buf)[4][4], const float* xin, int row, int lane) {
#pragma unroll
    for (int r = 0; r < 4; ++r) { const f32x4* xr = (const f32x4*)(xin + (size_t)(row + r) * DM) + lane;
#pragma unroll
        for (int j = 0; j < 4; ++j) buf[r][j] = xr[64 * j]; }
}
template <bool GATES, bool Q8 = false> DI void norm_phase(Frame& F, const float* xin, const float* g, const float* shp, const float* scp, int bstride, bf16* hout) {
    const int gw = F.bid * NWAVES + F.wave, NGW = F.G * NWAVES;
    LAS float* wg = (LAS float*)F.lds;
    if (GATES) { const float* src = (const float*)(F.ws + WS_WG); for (int i = F.tid; i < 16 * 1024 / 4; i += NT) ((LAS f32x4*)wg)[i] = ((const f32x4*)src)[i]; __syncthreads(); }
    for (int chunk = gw; chunk < T_TOK / 16; chunk += NGW) {
        const int row0 = chunk * 16, b = row0 >> 11;
        f32x4 A[4], Bv[4];
#pragma unroll
        for (int j = 0; j < 4; ++j) { const int c = 4 * F.lane + 256 * j; const f32x4 gg = *(const f32x4*)(g + c), sc = *(const f32x4*)(scp + (size_t)b * bstride + c);
            A[j] = gg * (sc + 1.0f); Bv[j] = *(const f32x4*)(shp + (size_t)b * bstride + c); }
        f32x4 bufA[4][4], bufB[4][4];
        load_rows4(bufA, xin, row0, F.lane);
#pragma unroll 1
        for (int gq = 0; gq < 4; gq += 2) {
            load_rows4(bufB, xin, row0 + 4 * (gq + 1), F.lane);
#pragma unroll
            for (int r = 0; r < 4; ++r) norm_row<GATES, Q8>(F, bufA[r], row0 + 4 * gq + r, A, Bv, hout, wg);
            if (gq + 2 < 4) load_rows4(bufA, xin, row0 + 4 * (gq + 2), F.lane);
#pragma unroll
            for (int r = 0; r < 4; ++r) norm_row<GATES, Q8>(F, bufB[r], row0 + 4 * (gq + 1) + r, A, Bv, hout, wg);
        }
    }
}
DI void norm2_phase(Frame& F, const float* xin, const float* gA, const float* shA, const float* scA, int strideA, bf16* outA, const float* gB, const float* shB, const float* scB, int strideB, bf16* outB) {
    const int gw = F.bid * NWAVES + F.wave, NGW = F.G * NWAVES;
    for (int chunk = gw; chunk < T_TOK / 16; chunk += NGW) {
        const int row0 = chunk * 16, b = row0 >> 11;
        f32x4 A1[4], B1[4], A2[4], B2[4];
#pragma unroll
        for (int j = 0; j < 4; ++j) { const int c = 4 * F.lane + 256 * j;
            A1[j] = *(const f32x4*)(gA + c) * (*(const f32x4*)(scA + (size_t)b * strideA + c) + 1.0f); B1[j] = *(const f32x4*)(shA + (size_t)b * strideA + c);
            A2[j] = *(const f32x4*)(gB + c) * (*(const f32x4*)(scB + (size_t)b * strideB + c) + 1.0f); B2[j] = *(const f32x4*)(shB + (size_t)b * strideB + c); }
        f32x4 bufA[4][4], bufB[4][4];
        load_rows4(bufA, xin, row0, F.lane);
#define NORM2_ROW(V, ROW) { const int row = (ROW); float ss = 0.f; \
            _Pragma("unroll") for (int j = 0; j < 4; ++j) ss += (V[j][0] * V[j][0] + V[j][1] * V[j][1]) + (V[j][2] * V[j][2] + V[j][3] * V[j][3]); \
            const float rstd = 1.0f / sqrtf(wave_sum(ss) * (1.0f / DM) + EPS); \
            unsigned long long* oa = (unsigned long long*)(outA + (size_t)row * DM) + F.lane; unsigned long long* ob = (unsigned long long*)(outB + (size_t)row * DM) + F.lane; \
            _Pragma("unroll") for (int j = 0; j < 4; ++j) { const f32x4 xn = V[j] * rstd; const f32x4 ya = xn * A1[j] + B1[j], yb = xn * A2[j] + B2[j]; \
                oa[64 * j] = (unsigned long long)cvtpk(ya[0], ya[1]) | ((unsigned long long)cvtpk(ya[2], ya[3]) << 32); \
                ob[64 * j] = (unsigned long long)cvtpk(yb[0], yb[1]) | ((unsigned long long)cvtpk(yb[2], yb[3]) << 32); } }
#pragma unroll 1
        for (int gq = 0; gq < 4; gq += 2) {
            load_rows4(bufB, xin, row0 + 4 * (gq + 1), F.lane);
#pragma unroll
            for (int r = 0; r < 4; ++r) NORM2_ROW(bufA[r], row0 + 4 * gq + r)
            if (gq + 2 < 4) load_rows4(bufA, xin, row0 + 4 * (gq + 2), F.lane);
#pragma unroll
            for (int r = 0; r < 4; ++r) NORM2_ROW(bufB[r], row0 + 4 * (gq + 1) + r)
        }
#undef NORM2_ROW
    }
}

DI void mlstm_gates(Frame& F, size_t trow0, int h, float& ipre, float& bcum, float& blast) {
    const float* gates = (const float*)(F.ws + WS_GATES); const float* bif = F.in[8];
    const float iv = gates[(trow0 + F.lane) * 16 + h] + bif[h];
    const float fv = gates[(trow0 + F.lane) * 16 + 8 + h] + bif[8 + h];
    float b = -(fmaxf(-fv, 0.f) + log1pf(expf(-fabsf(fv))));
#pragma unroll
    for (int d = 1; d < 64; d <<= 1) { const float t = __shfl_up(b, d); if (F.lane >= d) b += t; }
    ipre = iv; bcum = b; blast = __shfl(b, 63);
}
template <int MODE> DI void stage_qk(LAS unsigned char* dst, const LAS float* e_s, const bf16* proj, const float* convw, int tseq0, size_t trow0, int col0, int lane, bf16* gout = nullptr  ) {
    const int g8 = lane >> 3, ch = lane & 7, col = col0 + 8 * ch;
    float cw[4][8];
#pragma unroll
    for (int tap = 0; tap < 4; ++tap) { const f32x4 a = *(const f32x4*)(convw + tap * 1024 + col), b = *(const f32x4*)(convw + tap * 1024 + col + 4);
        cw[tap][0] = a[0]; cw[tap][1] = a[1]; cw[tap][2] = a[2]; cw[tap][3] = a[3]; cw[tap][4] = b[0]; cw[tap][5] = b[1]; cw[tap][6] = b[2]; cw[tap][7] = b[3]; }
#pragma unroll 1
    for (int ph = 0; ph < 2; ++ph) {
        float x[7][8];
#pragma unroll
        for (int i = 0; i < 7; ++i) {
            const int rel = 8 * g8 + 4 * ph + i - 3; const bool valid = (tseq0 + rel) >= 0; const long rr = valid ? (long)rel : 0;
            u32x4 raw = *(const u32x4*)(proj + (size_t)((long)trow0 + rr) * 3072 + col);
            if (!valid) raw = (u32x4){0u, 0u, 0u, 0u};
            x[i][0] = bflo(raw.x); x[i][1] = bfhi(raw.x); x[i][2] = bflo(raw.y); x[i][3] = bfhi(raw.y); x[i][4] = bflo(raw.z); x[i][5] = bfhi(raw.z); x[i][6] = bflo(raw.w); x[i][7] = bfhi(raw.w);
        }
#pragma unroll
        for (int o = 0; o < 4; ++o) {
            const int tok = 8 * g8 + 4 * ph + o;
            float y[8];
#pragma unroll
            for (int e = 0; e < 8; ++e) { float a = cw[0][e] * x[o][e] + cw[1][e] * x[o + 1][e] + cw[2][e] * x[o + 2][e] + cw[3][e] * x[o + 3][e]; y[e] = a / (1.f + __expf(-a)); }
            if (MODE == 0 || MODE == 3) {
                const float gs = (MODE == 3) ? 0.125f : 1.f;
                u32x4 wg; wg.x = cvtpk(y[0] * gs, y[1] * gs); wg.y = cvtpk(y[2] * gs, y[3] * gs); wg.z = cvtpk(y[4] * gs, y[5] * gs); wg.w = cvtpk(y[6] * gs, y[7] * gs);
                *(u32x4*)(gout + (size_t)tok * 512 + 8 * ch) = wg; }
            if (MODE != 3) {
            float sc = 1.f; if (MODE == 0) sc = e_s[tok]; if (MODE == 1) sc = 0.125f;
            u32x4 w; w.x = cvtpk(y[0] * sc, y[1] * sc); w.y = cvtpk(y[2] * sc, y[3] * sc); w.z = cvtpk(y[4] * sc, y[5] * sc); w.w = cvtpk(y[6] * sc, y[7] * sc);
            const int off = (MODE == 0) ? tr_off(tok, ch) : ch * 1024 + tok * 16;
            *(LAS u32x4*)(dst + off) = w; }
        }
    }
}
DI void qk_load_raw(u32x4 (&raw)[11], const bf16* proj, int tseq0, size_t trow0, int col0, int lane) {
    const int g8 = lane >> 3, ch = lane & 7, col = col0 + 8 * ch;
#pragma unroll
    for (int i = 0; i < 11; ++i) {
        const int rel = 8 * g8 + i - 3; const bool valid = (tseq0 + rel) >= 0; const long rr = valid ? (long)rel : 0;
        raw[i] = *(const u32x4*)(proj + (size_t)((long)trow0 + rr) * 3072 + col);
        if (!valid) raw[i] = (u32x4){0u, 0u, 0u, 0u};
    }
}
template <int MODE> DI void qk_conv_raw(LAS unsigned char* dst, const LAS float* e_s, const u32x4 (&raw)[11], const float* convw, int col0, int lane, bf16* gout) {
    const int g8 = lane >> 3, ch = lane & 7, col = col0 + 8 * ch;
    float cw[4][8];
#pragma unroll
    for (int tap = 0; tap < 4; ++tap) { const f32x4 a = *(const f32x4*)(convw + tap * 1024 + col), b = *(const f32x4*)(convw + tap * 1024 + col + 4);
        cw[tap][0] = a[0]; cw[tap][1] = a[1]; cw[tap][2] = a[2]; cw[tap][3] = a[3]; cw[tap][4] = b[0]; cw[tap][5] = b[1]; cw[tap][6] = b[2]; cw[tap][7] = b[3]; }
#pragma unroll
    for (int ph = 0; ph < 2; ++ph) {
        float x[7][8];
#pragma unroll
        for (int i = 0; i < 7; ++i) { const u32x4 r = raw[4 * ph + i];
            x[i][0] = bflo(r.x); x[i][1] = bfhi(r.x); x[i][2] = bflo(r.y); x[i][3] = bfhi(r.y); x[i][4] = bflo(r.z); x[i][5] = bfhi(r.z); x[i][6] = bflo(r.w); x[i][7] = bfhi(r.w); }
#pragma unroll
        for (int o = 0; o < 4; ++o) {
            const int tok = 8 * g8 + 4 * ph + o;
            float y[8];
#pragma unroll
            for (int e = 0; e < 8; ++e) { float a = cw[0][e] * x[o][e] + cw[1][e] * x[o + 1][e] + cw[2][e] * x[o + 2][e] + cw[3][e] * x[o + 3][e]; y[e] = a / (1.f + __expf(-a)); }
            const float gs = (MODE == 3) ? 0.125f : 1.f;
            u32x4 wg; wg.x = cvtpk(y[0] * gs, y[1] * gs); wg.y = cvtpk(y[2] * gs, y[3] * gs); wg.z = cvtpk(y[4] * gs, y[5] * gs); wg.w = cvtpk(y[6] * gs, y[7] * gs);
            *(u32x4*)(gout + (size_t)tok * 512 + 8 * ch) = wg;
            if (MODE == 0) { const float sc = e_s[tok];
                u32x4 w; w.x = cvtpk(y[0] * sc, y[1] * sc); w.y = cvtpk(y[2] * sc, y[3] * sc); w.z = cvtpk(y[4] * sc, y[5] * sc); w.w = cvtpk(y[6] * sc, y[7] * sc);
                *(LAS u32x4*)(dst + tr_off(tok, ch)) = w; }
        }
        __builtin_amdgcn_sched_barrier(0);
    }
}
DI void stage_v_half(LAS unsigned char* dst, const bf16* proj, size_t trow0, int col0, int lane) {
    const int g8 = lane >> 3, ch = lane & 7;
#pragma unroll
    for (int o = 0; o < 8; ++o) { const int tok = 8 * g8 + o; const u32x4 raw = *(const u32x4*)(proj + (trow0 + tok) * 3072 + col0 + 8 * ch); *(LAS u32x4*)(dst + tr_off(tok, ch)) = raw; }
}
constexpr int MW_LDS = 17408;

DI void p3_mlstm_local(Frame& F) {
    LAS unsigned char* wl = F.lds + F.wave * MW_LDS;
    LAS unsigned char* kimg = wl; LAS unsigned char* vimg = wl + 8192; LAS float* e_s = (LAS float*)(wl + 16384);
    const bf16* proj = (const bf16*)(F.ws + WS_PROJ);
    bf16* cst = (bf16*)(F.ws + WS_CST);
    const int lane = F.lane, r32 = lane & 31, hi = lane >> 5;
    for (int bu = F.bid; bu < 512; bu += F.G) {
        int h = F.wave; asm volatile("" : "+s"(h));
        const int b = bu >> 5, c = bu & 31; const int unit = bu * 8 + h; const size_t trow0 = (size_t)b * SEQ + c * 64;
        u32x4 kraw[11], qraw[11], vraw[2][8];
        qk_load_raw(kraw, proj, c * 64, trow0, 512 + h * 64, lane); qk_load_raw(qraw, proj, c * 64, trow0, h * 64, lane);
        float ipre, bcum, blast; mlstm_gates(F, trow0, h, ipre, bcum, blast);
        const float w = blast - bcum + ipre; const float mloc = wave_max(w); const float e = expf(w - mloc);
        e_s[lane] = e;
        if (lane == 0) { ((float*)(F.ws + WS_BLAST))[unit] = blast; ((float*)(F.ws + WS_MLOC))[unit] = mloc; }
        qk_conv_raw<0>(kimg, e_s, kraw, F.in[7], 512 + h * 64, lane, (bf16*)(F.ws + WS_KC) + trow0 * 512 + h * 64);
        asm volatile("" ::: "memory"); __builtin_amdgcn_sched_barrier(0);
#pragma unroll
        for (int vh = 0; vh < 2; ++vh)
#pragma unroll
            for (int o = 0; o < 8; ++o) vraw[vh][o] = *(const u32x4*)(proj + (trow0 + 8 * (lane >> 3) + o) * 3072 + 1024 + h * 128 + 64 * vh + 8 * (lane & 7));
        qk_conv_raw<3>(nullptr, nullptr, qraw, F.in[7], h * 64, lane, (bf16*)(F.ws + WS_QC) + trow0 * 512 + h * 64);
        asm volatile("" ::: "memory"); __builtin_amdgcn_sched_barrier(0);
        bf16x8 kef[2][4];
#pragma unroll
        for (int kt = 0; kt < 2; ++kt)
#pragma unroll
            for (int ks = 0; ks < 4; ++ks) kef[kt][ks] = tr_frag(kimg, kt, ks, lane);
        const bf16x8 ones = {0x3F80, 0x3F80, 0x3F80, 0x3F80, 0x3F80, 0x3F80, 0x3F80, 0x3F80};
#pragma unroll
        for (int kt = 0; kt < 2; ++kt) { f32x16 an = {};
#pragma unroll
            for (int ks = 0; ks < 4; ++ks) an = MFMA32(kef[kt][ks], ones, an);
            if (r32 == 0) {
#pragma unroll
                for (int r = 0; r < 16; ++r) ((float*)(F.ws + WS_NLOC))[(size_t)unit * 64 + 32 * kt + crow(r, hi)] = an[r]; } }
#pragma unroll
        for (int vh = 0; vh < 2; ++vh) {
#pragma unroll
            for (int o = 0; o < 8; ++o) *(LAS u32x4*)(vimg + tr_off(8 * (lane >> 3) + o, lane & 7)) = vraw[vh][o];
#pragma unroll
            for (int vt = 0; vt < 2; ++vt) {
                bf16x8 vf[4];
#pragma unroll
                for (int ks = 0; ks < 4; ++ks) vf[ks] = tr_frag(vimg, vt, ks, lane);
#pragma unroll
                for (int kt = 0; kt < 2; ++kt) { f32x16 acc = {};
#pragma unroll
                    for (int ks = 0; ks < 4; ++ks) acc = MFMA32(kef[kt][ks], vf[ks], acc);
                    bf16* dstp = cst + ((size_t)unit * 128 + 64 * vh + 32 * vt + r32) * 64 + 32 * kt + 4 * hi;
#pragma unroll
                    for (int rg = 0; rg < 4; ++rg) { u32x2 pk; pk.x = cvtpk(acc[4 * rg], acc[4 * rg + 1]); pk.y = cvtpk(acc[4 * rg + 2], acc[4 * rg + 3]); *(u32x2*)(dstp + 8 * rg) = pk; }
                }
            }
            asm volatile("s_waitcnt lgkmcnt(0)" ::: "memory");
        }
    }
}
DI void p4_scan(Frame& F) {
    const int gt = F.bid * NT + F.tid, NGT = F.G * NT;
    const float* mlocp = (const float*)(F.ws + WS_MLOC); const float* blastp = (const float*)(F.ws + WS_BLAST);
    for (int item = gt; item < 128 * 1024; item += NGT) {
        const int bh = item >> 10, e8 = item & 1023, b = bh >> 3, h = bh & 7;
        float st[8]; float m = 0.f;
#pragma unroll
        for (int i = 0; i < 8; ++i) st[i] = 0.f;
        u32x4* p0 = (u32x4*)((bf16*)(F.ws + WS_CST) + (size_t)((b * 32) * 8 + h) * 8192) + e8;
        const int u0 = (b * 32) * 8 + h;
#pragma unroll 1
        for (int c0 = 0; c0 < 32; c0 += 8) {
            u32x4 raw[8]; float ml[8], bl[8];
#pragma unroll
            for (int j = 0; j < 8; ++j) { raw[j] = p0[(size_t)(c0 + j) * 8192]; ml[j] = mlocp[u0 + (c0 + j) * 8]; bl[j] = blastp[u0 + (c0 + j) * 8]; }
#pragma unroll
            for (int j = 0; j < 8; ++j) {
                u32x4 o; o.x = cvtpk(st[0], st[1]); o.y = cvtpk(st[2], st[3]); o.z = cvtpk(st[4], st[5]); o.w = cvtpk(st[6], st[7]); p0[(size_t)(c0 + j) * 8192] = o;
                const float mn = fmaxf(bl[j] + m, ml[j]), a = __expf(bl[j] + m - mn), r = __expf(ml[j] - mn);
                st[0] = a * st[0] + r * bflo(raw[j].x); st[1] = a * st[1] + r * bfhi(raw[j].x); st[2] = a * st[2] + r * bflo(raw[j].y); st[3] = a * st[3] + r * bfhi(raw[j].y);
                st[4] = a * st[4] + r * bflo(raw[j].z); st[5] = a * st[5] + r * bfhi(raw[j].z); st[6] = a * st[6] + r * bflo(raw[j].w); st[7] = a * st[7] + r * bfhi(raw[j].w);
                m = mn;
            }
        }
    }
    for (int item = gt; item < 128 * 64; item += NGT) {
        const int bh = item >> 6, k = item & 63, b = bh >> 3, h = bh & 7;
        float ns = 0.f, m = 0.f;
        const int u0 = (b * 32) * 8 + h;
#pragma unroll 1
        for (int c0 = 0; c0 < 32; c0 += 8) {
            float nl[8], ml[8], bl[8];
#pragma unroll
            for (int j = 0; j < 8; ++j) { const int unit = u0 + (c0 + j) * 8; nl[j] = ((const float*)(F.ws + WS_NLOC))[(size_t)unit * 64 + k]; ml[j] = mlocp[unit]; bl[j] = blastp[unit]; }
#pragma unroll
            for (int j = 0; j < 8; ++j) { const int unit = u0 + (c0 + j) * 8;
                ((float*)(F.ws + WS_NLOC))[(size_t)unit * 64 + k] = ns; if (k == 0) ((float*)(F.ws + WS_MPREV))[unit] = m;
                const float mn = fmaxf(bl[j] + m, ml[j]), a = __expf(bl[j] + m - mn), r = __expf(ml[j] - mn);
                ns = a * ns + r * nl[j]; m = mn; }
        }
    }
}
DI void p5_mlstm_out(Frame& F) {
    LAS unsigned char* wl = F.lds + F.wave * MW_LDS;
    LAS float* sc = (LAS float*)(wl + 16384);
    const bf16* proj = (const bf16*)(F.ws + WS_PROJ);
    const bf16* cst = (const bf16*)(F.ws + WS_CST);
    const bf16* QC = (const bf16*)(F.ws + WS_QC); const bf16* KC = (const bf16*)(F.ws + WS_KC);
    bf16* hh = (bf16*)(F.ws + WS_H);
    for (int bu = F.bid; bu < 512; bu += F.G) {
        int lane = F.lane; asm volatile("" : "+v"(lane)); const int r32 = lane & 31, hi = lane >> 5;
        int h = F.wave; asm volatile("" : "+s"(h));
        const int b = bu >> 5, c = bu & 31; const int unit = bu * 8 + h; const size_t trow0 = (size_t)b * SEQ + c * 64;
        {
            float ipre, bcum, blast; mlstm_gates(F, trow0, h, ipre, bcum, blast);
            const float mprev = ((const float*)(F.ws + WS_MPREV))[unit];
            const float gg = ipre - bcum; float pm = gg;
#pragma unroll
            for (int d = 1; d < 64; d <<= 1) { const float t = __shfl_up(pm, d); if (lane >= d) pm = fmaxf(pm, t); }
            const float Mx = fmaxf(mprev, pm), mt = bcum + Mx;
            sc[lane] = gg; sc[64 + lane] = Mx; sc[128 + lane] = expf(mprev - Mx); sc[192 + lane] = expf(-mt);
        }
        stage_v_half(wl, proj, trow0, 1024 + h * 128, lane); stage_v_half(wl + 8192, proj, trow0, 1024 + h * 128 + 64, lane);
        bf16x8 cf[4][4];
#pragma unroll
        for (int vt = 0; vt < 4; ++vt)
#pragma unroll
            for (int ks = 0; ks < 4; ++ks) cf[vt][ks] = *(const bf16x8*)(cst + ((size_t)unit * 128 + 32 * vt + r32) * 64 + 16 * ks + 8 * hi);
#pragma unroll 1
        for (int lt = 0; lt < 2; ++lt) {
            const int l = 32 * lt + r32;
            const size_t t = trow0 + l;
            bf16x8 qf[4];
#pragma unroll
            for (int ks = 0; ks < 4; ++ks) qf[ks] = *(const bf16x8*)(QC + t * 512 + h * 64 + 16 * ks + 8 * hi);
            const float Mxl = sc[64 + l];
            bf16x8 P[2][2]; float dsum = 0.f;
#pragma unroll
            for (int st = 0; st < 2; ++st) {
                P[st][0] = (bf16x8){0, 0, 0, 0, 0, 0, 0, 0}; P[st][1] = P[st][0];
                if (st <= lt) {
                    f32x16 acc = {};
#pragma unroll
                    for (int ks = 0; ks < 4; ++ks) acc = MFMA32(*(const bf16x8*)(KC + (trow0 + 32 * st + r32) * 512 + h * 64 + 16 * ks + 8 * hi), qf[ks], acc);
#pragma unroll
                    for (int r = 0; r < 16; ++r) { const int srow = crow(r, hi); float val = acc[r] * __expf(sc[32 * st + srow] - Mxl); if (st == lt && srow > r32) val = 0.f; acc[r] = val; dsum += val; }
                    P[st][0] = pack8(acc, 0); P[st][1] = pack8(acc, 1);
                }
            }
            float nq;
            { const float* np = (const float*)(F.ws + WS_NLOC) + (size_t)unit * 64; float s = 0.f;
#pragma unroll
              for (int ks = 0; ks < 4; ++ks) { const f32x4 n0 = *(const f32x4*)(np + 16 * ks + 8 * hi), n1 = *(const f32x4*)(np + 16 * ks + 8 * hi + 4); const u32x4 q = __builtin_bit_cast(u32x4, qf[ks]);
                  s += bflo(q.x) * n0[0] + bfhi(q.x) * n0[1] + bflo(q.y) * n0[2] + bfhi(q.y) * n0[3] + bflo(q.z) * n1[0] + bfhi(q.z) * n1[1] + bflo(q.w) * n1[2] + bfhi(q.w) * n1[3]; }
              nq = s + __shfl_xor(s, 32); }
            f32x16 acc[4];
#pragma unroll
            for (int vt = 0; vt < 4; ++vt) { acc[vt] = (f32x16){};
#pragma unroll
                for (int ks = 0; ks < 4; ++ks) acc[vt] = MFMA32(cf[vt][ks], qf[ks], acc[vt]); }
            const float iwl = sc[128 + l];
#pragma unroll
            for (int vt = 0; vt < 4; ++vt) acc[vt] = acc[vt] * iwl;
#pragma unroll
            for (int st = 0; st < 2; ++st) if (st <= lt) {
#pragma unroll
                for (int k2 = 0; k2 < 2; ++k2) {
#pragma unroll
                    for (int vt = 0; vt < 4; ++vt) acc[vt] = MFMA32(tr_frag(wl + (vt >> 1) * 8192, vt & 1, 2 * st + k2, lane), P[st][k2], acc[vt]); } }
            u32x2 o4[4][4];
#pragma unroll
            for (int vt = 0; vt < 4; ++vt)
#pragma unroll
                for (int rg = 0; rg < 4; ++rg) o4[vt][rg] = *(const u32x2*)(proj + t * 3072 + 2048 + h * 128 + 32 * vt + 8 * rg + 4 * hi);
            const float den = dsum + __shfl_xor(dsum, 32) + iwl * nq;
            const float inv = 1.0f / fmaxf(fabsf(den), sc[192 + l]);
            float ss = 0.f;
#pragma unroll
            for (int vt = 0; vt < 4; ++vt)
#pragma unroll
                for (int r = 0; r < 16; ++r) { const float v = acc[vt][r] * inv; acc[vt][r] = v; ss += v * v; }
            ss += __shfl_xor(ss, 32);
            const float rstd = 1.0f / sqrtf(ss * (1.0f / 128.0f) + EPS);
#pragma unroll
            for (int vt = 0; vt < 4; ++vt)
#pragma unroll
                for (int rg = 0; rg < 4; ++rg) { const int v = 32 * vt + 8 * rg + 4 * hi;
                    const f32x4 g4 = *(const f32x4*)(F.in[9] + h * 128 + v);
                    const float o0 = bflo(o4[vt][rg].x), o1 = bfhi(o4[vt][rg].x), o2 = bflo(o4[vt][rg].y), o3 = bfhi(o4[vt][rg].y);
                    const float y0 = acc[vt][4 * rg] * rstd * g4[0] / (1.f + __expf(-o0)), y1 = acc[vt][4 * rg + 1] * rstd * g4[1] / (1.f + __expf(-o1));
                    const float y2 = acc[vt][4 * rg + 2] * rstd * g4[2] / (1.f + __expf(-o2)), y3 = acc[vt][4 * rg + 3] * rstd * g4[3] / (1.f + __expf(-o3));
                    u32x2 pk; pk.x = cvtpk(y0, y1); pk.y = cvtpk(y2, y3); *(u32x2*)(hh + t * 1024 + h * 128 + v) = pk; }
        }
        asm volatile("s_waitcnt lgkmcnt(0)" ::: "memory");
    }
}

DI float softplus2(float z) { return fmaxf(z, 0.f) + __builtin_amdgcn_logf(1.f + __builtin_amdgcn_exp2f(-fabsf(z))); }
DI void p12_attn(Frame& F) {
    LAS unsigned char* kimg = F.lds + F.wave * 16384; LAS unsigned char* vimg = kimg + 8192;
    const bf16* Q = (const bf16*)(F.ws + WS_Q); const bf16* K = (const bf16*)(F.ws + WS_K); const bf16* V = (const bf16*)(F.ws + WS_VV);
    bf16* O = (bf16*)(F.ws + WS_H);
    const int wave = F.wave;
    for (int bh = F.bid; bh < 256; bh += F.G) {
        const int b = bh >> 4, h = bh & 15;
#pragma unroll 1
        for (int qi = 0; qi < 8; ++qi) {
            int lane = F.lane; asm volatile("" : "+v"(lane)); const int r32 = lane & 31, hi = lane >> 5;
            const int skey = lane >> 3, schk = lane & 7;
            const int qt = 63 - (wave + 8 * qi);
            const int qlo = qt * 32;
            const size_t tq0 = (size_t)b * SEQ + qlo;
            bf16x8 qr[4];
#pragma unroll
            for (int ks = 0; ks < 4; ++ks) qr[ks] = *(const bf16x8*)(Q + (tq0 + r32) * 1024 + h * 64 + 16 * ks + 8 * hi);
            f32x16 o0 = {}, o1 = {}; float R = 0.f;
            const int kt0 = (qlo + 30) >> 5;
            u32x4 kraw[4], vraw[4];
            { const bf16* kp = K + ((size_t)b * SEQ + 32 * kt0 + skey) * 1024 + h * 64 + 8 * schk; const bf16* vp = V + ((size_t)b * SEQ + 32 * kt0 + skey) * 1024 + h * 64 + 8 * schk;
#pragma unroll
              for (int i = 0; i < 4; ++i) { kraw[i] = *(const u32x4*)(kp + (size_t)i * 8 * 1024); vraw[i] = *(const u32x4*)(vp + (size_t)i * 8 * 1024); } }
#pragma unroll 1
            for (int kt = kt0; kt >= 0; --kt) {
#pragma unroll
                for (int i = 0; i < 4; ++i) { *(LAS u32x4*)(kimg + schk * 512 + (skey + 8 * i) * 16) = kraw[i]; *(LAS u32x4*)(vimg + tr_off(skey + 8 * i, schk)) = vraw[i]; }
                if (kt > 0) { const bf16* kp = K + ((size_t)b * SEQ + 32 * (kt - 1) + skey) * 1024 + h * 64 + 8 * schk; const bf16* vp = V + ((size_t)b * SEQ + 32 * (kt - 1) + skey) * 1024 + h * 64 + 8 * schk;
#pragma unroll
                    for (int i = 0; i < 4; ++i) { kraw[i] = *(const u32x4*)(kp + (size_t)i * 8 * 1024); vraw[i] = *(const u32x4*)(vp + (size_t)i * 8 * 1024); } }
                {
                    const bool diag = (32 * kt + 31 >= qlo);
                    const int qrel = qlo + r32 - 32 * kt;
                    f32x16 p = {};
#pragma unroll
                    for (int ks = 0; ks < 4; ++ks) p = MFMA32(row_frag<32>(kimg, 0, ks, lane), qr[ks], p);
                    float sp[16], mk[16];
                    if (diag) {
#pragma unroll
                        for (int r = 0; r < 16; ++r) { mk[r] = crow(r, hi) < qrel ? 1.f : 0.f; sp[r] = softplus2(p[r]) * mk[r]; }
                    } else {
#pragma unroll
                        for (int r = 0; r < 16; ++r) { mk[r] = 1.f; sp[r] = softplus2(p[r]); }
                    }
#pragma unroll
                    for (int g = 0; g < 4; ++g) { sp[4 * g + 2] += sp[4 * g + 3]; sp[4 * g + 1] += sp[4 * g + 2]; sp[4 * g] += sp[4 * g + 1]; }
                    float og[4], T[4], off[4];
#pragma unroll
                    for (int g = 0; g < 4; ++g) og[g] = __shfl_xor(sp[4 * g], 32);
                    T[3] = 0.f; T[2] = sp[12] + og[3]; T[1] = T[2] + sp[8] + og[2]; T[0] = T[1] + sp[4] + og[1];
                    const float tot = T[0] + sp[0] + og[0];
#pragma unroll
                    for (int g = 0; g < 4; ++g) off[g] = T[g] + (hi == 0 ? og[g] : 0.f) + R;
#pragma unroll
                    for (int r = 0; r < 16; ++r) p[r] = __builtin_amdgcn_exp2f(p[r] - sp[r] - off[r >> 2]) * mk[r];
                    R += tot;
                    const bf16x8 pa0 = pack8(p, 0), pa1 = pack8(p, 1);
                    o0 = MFMA32(pa0, tr_frag(vimg, 0, 0, lane), o0); o1 = MFMA32(pa0, tr_frag(vimg, 1, 0, lane), o1);
                    o0 = MFMA32(pa1, tr_frag(vimg, 0, 1, lane), o0); o1 = MFMA32(pa1, tr_frag(vimg, 1, 1, lane), o1);
                }
                if (__all(R >= 150.1f)) break;
                asm volatile("s_waitcnt lgkmcnt(0)" ::: "memory");
            }
            asm volatile("s_waitcnt lgkmcnt(0)" ::: "memory");
#pragma unroll
            for (int r = 0; r < 16; ++r) { bf16* op = O + (tq0 + crow(r, hi)) * 1024 + h * 64 + r32;
                op[0] = (bf16)(cvtpk(o0[r], 0.f) & 0xffffu); op[32] = (bf16)(cvtpk(o1[r], 0.f) & 0xffffu); }
        }
    }
}

__device__ constexpr int NET16_A[63] = {0,2,0,1,1,4,6,4,5,5,0,2,2,1,3,3,1,3,5,8,10,8,9,9,12,14,12,13,13,8,10,10,9,11,11,9,11,13,0,4,4,2,6,6,2,6,10,1,5,5,3,7,7,3,7,11,1,3,5,7,9,11,13};
__device__ constexpr int NET16_B[63] = {1,3,2,3,2,5,7,6,7,6,4,6,4,5,7,5,2,4,6,9,11,10,11,10,13,15,14,15,14,12,14,12,13,15,13,10,12,14,8,12,8,10,14,10,4,8,12,9,13,9,11,15,11,5,9,13,2,4,6,8,10,12,14};
__device__ constexpr int BIT16_A[32] = {0,1,2,3,4,5,6,7,0,1,2,3,8,9,10,11,0,1,4,5,8,9,12,13,0,2,4,6,8,10,12,14};
__device__ constexpr int BIT16_B[32] = {8,9,10,11,12,13,14,15,4,5,6,7,12,13,14,15,2,3,6,7,10,11,14,15,1,3,5,7,9,11,13,15};
DI unsigned umax_(unsigned a, unsigned b) { return a > b ? a : b; }
DI unsigned umin_(unsigned a, unsigned b) { return a < b ? a : b; }
DI void sort16(unsigned (&k)[16]) {
#pragma unroll
    for (int c = 0; c < 63; ++c) { const unsigned a = k[NET16_A[c]], b = k[NET16_B[c]]; k[NET16_A[c]] = umax_(a, b); k[NET16_B[c]] = umin_(a, b); }
}
DI void bitonic16(unsigned (&k)[16]) {
#pragma unroll
    for (int c = 0; c < 32; ++c) { const unsigned a = k[BIT16_A[c]], b = k[BIT16_B[c]]; k[BIT16_A[c]] = umax_(a, b); k[BIT16_B[c]] = umin_(a, b); }
}
DI void merge16(unsigned (&x)[16], const unsigned (&y)[16]) {
#pragma unroll
    for (int i = 0; i < 16; ++i) x[i] = umax_(x[i], y[15 - i]);
    bitonic16(x);
}
DI unsigned f2key(float x) { const unsigned b = __float_as_uint(x); return b ^ ((unsigned)((int)b >> 31) | 0x80000000u); }
DI float key2f(unsigned k) { return __uint_as_float(k ^ (~(unsigned)((int)k >> 31) | 0x80000000u)); }

DI void p_route(Frame& F, int layer) {
    LAS unsigned char* simg = F.lds;
    LAS unsigned char* dec = F.lds + 65536 + F.wave * 1024;
    { const u32x4* src = (const u32x4*)((const bf16*)(F.ws + WS_SUBK) + (size_t)layer * 2 * 128 * 128);
      for (int i = F.tid; i < 2 * 128 * 16; i += NT) { const int p = i >> 11, n = (i >> 4) & 127, ch = i & 15; *(LAS u32x4*)(simg + p * 32768 + ch * 2048 + n * 16) = src[i]; } }
    __syncthreads();
    const bf16* PQ = (const bf16*)(F.ws + WS_PQ);
    const int lane = F.lane, r32 = lane & 31, hi = lane >> 5;
    const int gw = F.bid * NWAVES + F.wave, NGW = F.G * NWAVES;
    for (int wu = gw; wu < T_TOK * 8 / 32; wu += NGW) {
        const int row = wu * 32 + r32, t = row >> 3, hd = row & 7;
        unsigned top[2][16];
#pragma unroll
        for (int p = 0; p < 2; ++p) {
            bf16x8 qf[8];
#pragma unroll
            for (int ks = 0; ks < 8; ++ks) qf[ks] = *(const bf16x8*)(PQ + (size_t)t * 2048 + hd * 256 + p * 128 + 16 * ks + 8 * hi);
            unsigned keys[4][16];
#pragma unroll
            for (int nt = 0; nt < 4; ++nt) {
                f32x16 acc = {};
#pragma unroll
                for (int ks = 0; ks < 8; ++ks) acc = MFMA32(*(const LAS bf16x8*)(simg + p * 32768 + (2 * ks + hi) * 2048 + (32 * nt + r32) * 16), qf[ks], acc);
#pragma unroll
                for (int r = 0; r < 16; ++r) keys[nt][r] = (f2key(acc[r]) & 0xFFFFFF80u) | (unsigned)(32 * nt + crow(r, 0)) | (unsigned)(4 * hi);
                sort16(keys[nt]);
            }
            merge16(keys[0], keys[1]); merge16(keys[2], keys[3]); merge16(keys[0], keys[2]);
            unsigned lo[16], up[16];
#pragma unroll
            for (int i = 0; i < 16; ++i) { auto rr = __builtin_amdgcn_permlane32_swap(keys[0][i], keys[0][i], false, false); lo[i] = rr[0]; up[i] = rr[1]; }
#pragma unroll
            for (int i = 0; i < 16; ++i) top[p][i] = umax_(lo[i], up[15 - i]);
            bitonic16(top[p]);
        }
        if (hi == 0) {
            u32x4 w0, w1, w2, w3;
            w0.x = (top[0][0] & 127u) | ((top[0][1] & 127u) << 8) | ((top[0][2] & 127u) << 16) | ((top[0][3] & 127u) << 24);
            w0.y = (top[0][4] & 127u) | ((top[0][5] & 127u) << 8) | ((top[0][6] & 127u) << 16) | ((top[0][7] & 127u) << 24);
            w0.z = (top[0][8] & 127u) | ((top[0][9] & 127u) << 8) | ((top[0][10] & 127u) << 16) | ((top[0][11] & 127u) << 24);
            w0.w = (top[0][12] & 127u) | ((top[0][13] & 127u) << 8) | ((top[0][14] & 127u) << 16) | ((top[0][15] & 127u) << 24);
            w1.x = (top[1][0] & 127u) | ((top[1][1] & 127u) << 8) | ((top[1][2] & 127u) << 16) | ((top[1][3] & 127u) << 24);
            w1.y = (top[1][4] & 127u) | ((top[1][5] & 127u) << 8) | ((top[1][6] & 127u) << 16) | ((top[1][7] & 127u) << 24);
            w1.z = (top[1][8] & 127u) | ((top[1][9] & 127u) << 8) | ((top[1][10] & 127u) << 16) | ((top[1][11] & 127u) << 24);
            w1.w = (top[1][12] & 127u) | ((top[1][13] & 127u) << 8) | ((top[1][14] & 127u) << 16) | ((top[1][15] & 127u) << 24);
            *(LAS u32x4*)(dec + r32 * 32) = w0; *(LAS u32x4*)(dec + r32 * 32 + 16) = w1;
        }
        float av[16], bv[16];
#pragma unroll
        for (int i = 0; i < 16; ++i) { av[i] = key2f(top[0][i] & 0xFFFFFF80u); bv[i] = key2f(top[1][i] & 0xFFFFFF80u); }
        unsigned c0[16], c1[16], c2[16], c3[16];
#pragma unroll
        for (int j = 0; j < 16; ++j) c0[j] = (f2key(av[0] + bv[j]) & 0xFFFFFF00u) | (unsigned)j;
        {
            int n = 0;
#pragma unroll
            for (int i = 1; i < 16; ++i)
#pragma unroll
                for (int j = 0; j < 16; ++j) if ((i + 1) * (j + 1) <= 16) {
                    const unsigned k = (f2key(av[i] + bv[j]) & 0xFFFFFF00u) | (unsigned)(i * 16 + j);
                    if (n < 16) c1[n] = k; else if (n < 32) c2[n - 16] = k; else c3[n - 32] = k;
                    ++n; }
#pragma unroll
            for (int q = 2; q < 16; ++q) c3[q] = 0u;
        }
        sort16(c1); sort16(c2); { const unsigned a = c3[0], b = c3[1]; c3[0] = umax_(a, b); c3[1] = umin_(a, b); }
        merge16(c0, c1); merge16(c2, c3); merge16(c0, c2);
        asm volatile("s_waitcnt lgkmcnt(0)" ::: "memory");
        float gv[16]; unsigned ex[16]; float gs = 0.f;
        const float vmax = key2f(c0[0] & 0xFFFFFF00u);
#pragma unroll
        for (int k = 0; k < 16; ++k) {
            const unsigned code = c0[k] & 255u; const unsigned i = code >> 4, j = code & 15u;
            const unsigned ia = *(const LAS unsigned char*)(dec + r32 * 32 + i), ib = *(const LAS unsigned char*)(dec + r32 * 32 + 16 + j);
            ex[k] = ia * 128u + ib;
            gv[k] = __expf(key2f(c0[k] & 0xFFFFFF00u) - vmax); gs += gv[k];
        }
        const float ginv = 1.0f / gs;
        if (hi == 0) {
            u32x4 e0, e1;
            e0.x = ex[0] | (ex[1] << 16); e0.y = ex[2] | (ex[3] << 16); e0.z = ex[4] | (ex[5] << 16); e0.w = ex[6] | (ex[7] << 16);
            e1.x = ex[8] | (ex[9] << 16); e1.y = ex[10] | (ex[11] << 16); e1.z = ex[12] | (ex[13] << 16); e1.w = ex[14] | (ex[15] << 16);
            u32x4* ip = (u32x4*)((unsigned short*)(F.ws + WS_IDX) + (size_t)row * 16); ip[0] = e0; ip[1] = e1;
        } else {
            f32x4* gp = (f32x4*)((float*)(F.ws + WS_GATE) + (size_t)row * 16);
            gp[0] = (f32x4){gv[0] * ginv, gv[1] * ginv, gv[2] * ginv, gv[3] * ginv}; gp[1] = (f32x4){gv[4] * ginv, gv[5] * ginv, gv[6] * ginv, gv[7] * ginv};
            gp[2] = (f32x4){gv[8] * ginv, gv[9] * ginv, gv[10] * ginv, gv[11] * ginv}; gp[3] = (f32x4){gv[12] * ginv, gv[13] * ginv, gv[14] * ginv, gv[15] * ginv};
        }
    }
}

constexpr float U_SCALE = 32.f, V_SCALE = 4.f;
struct RowBuf { u32x4 r[16]; };
DI void load_rows(RowBuf& rb, const unsigned char* tbl, int idxs, int k0, int lane) {
#pragma unroll
    for (int j = 0; j < 16; ++j) { const int e = __builtin_amdgcn_readlane(idxs, k0 + j); rb.r[j] = *((const u32x4*)(tbl + (size_t)e * 1024) + lane); }
}
DI int udots(const RowBuf& rb, const int (&hq)[4], int lane) {
    int p[16];
#pragma unroll
    for (int j = 0; j < 16; ++j) { int a = __builtin_amdgcn_sdot4((int)rb.r[j].x, hq[0], 0, false); a = __builtin_amdgcn_sdot4((int)rb.r[j].y, hq[1], a, false);
        a = __builtin_amdgcn_sdot4((int)rb.r[j].z, hq[2], a, false); p[j] = __builtin_amdgcn_sdot4((int)rb.r[j].w, hq[3], a, false); }
#pragma unroll
    for (int i = 0; i < 8; ++i) { const bool up = (lane & 8) != 0; const int send = up ? p[i] : p[i + 8], keep = up ? p[i + 8] : p[i]; p[i] = keep + lx<8>(send); }
#pragma unroll
    for (int i = 0; i < 4; ++i) { const bool up = (lane & 4) != 0; const int send = up ? p[i] : p[i + 4], keep = up ? p[i + 4] : p[i]; p[i] = keep + lx<7>(send); }
#pragma unroll
    for (int i = 0; i < 2; ++i) { const bool up = (lane & 2) != 0; const int send = up ? p[i] : p[i + 2], keep = up ? p[i + 2] : p[i]; p[i] = keep + lx<2>(send); }
    { const bool up = (lane & 1) != 0; const int send = up ? p[0] : p[1], keep = up ? p[1] : p[0]; p[0] = keep + lx<1>(send); }
    int s = p[0]; s += lx<16>(s); s += lx<32>(s);
    return s;
}
DI void vaccum(const RowBuf& rb, f32x2_t (&out)[8], float wv, int k0) {
#pragma unroll
    for (int j = 0; j < 16; ++j) { const float wk = __builtin_bit_cast(float, __builtin_amdgcn_readlane(__builtin_bit_cast(int, wv), k0 + j));
        out[0] = __builtin_amdgcn_cvt_pk_f32_fp8((int)rb.r[j].x, false) * wk + out[0]; out[1] = __builtin_amdgcn_cvt_pk_f32_fp8((int)rb.r[j].x, true) * wk + out[1];
        out[2] = __builtin_amdgcn_cvt_pk_f32_fp8((int)rb.r[j].y, false) * wk + out[2]; out[3] = __builtin_amdgcn_cvt_pk_f32_fp8((int)rb.r[j].y, true) * wk + out[3];
        out[4] = __builtin_amdgcn_cvt_pk_f32_fp8((int)rb.r[j].z, false) * wk + out[4]; out[5] = __builtin_amdgcn_cvt_pk_f32_fp8((int)rb.r[j].z, true) * wk + out[5];
        out[6] = __builtin_amdgcn_cvt_pk_f32_fp8((int)rb.r[j].w, false) * wk + out[6]; out[7] = __builtin_amdgcn_cvt_pk_f32_fp8((int)rb.r[j].w, true) * wk + out[7]; }
}
constexpr size_t WS_W = WS_PROJ;
constexpr size_t WS_PD = WS_PROJ + 32 * MiB;
constexpr int UP_LDS = 16384;
struct UTok { u32x4 r[16]; int hq[4]; };
DI void up_load(UTok& tb, const unsigned char* Us, const unsigned char* H2Qs, const LAS unsigned short* lidx, size_t t, int tt, int lane) {
    const int g = lane >> 3, c = lane & 7;
    const LAS u32x4* ip = (const LAS u32x4*)(lidx + tt * 128 + 16 * g); const u32x4 ia = ip[0], ib = ip[1];
    const unsigned e[16] = {ia.x & 0xffffu, ia.x >> 16, ia.y & 0xffffu, ia.y >> 16, ia.z & 0xffffu, ia.z >> 16, ia.w & 0xffffu, ia.w >> 16,
                            ib.x & 0xffffu, ib.x >> 16, ib.y & 0xffffu, ib.y >> 16, ib.z & 0xffffu, ib.z >> 16, ib.w & 0xffffu, ib.w >> 16};
#pragma unroll
    for (int i = 0; i < 16; ++i) tb.r[i] = *(const u32x4*)(Us + (size_t)e[i] * 128 + c * 16);
    const u32x4 a = *(const u32x4*)(H2Qs + t * 1024 + c * 16); tb.hq[0] = (int)a.x; tb.hq[1] = (int)a.y; tb.hq[2] = (int)a.z; tb.hq[3] = (int)a.w;
}
DI void up_compute(const UTok& tb, int* pd, size_t t, int lane) {
    int p[16];
#pragma unroll
    for (int i = 0; i < 16; ++i) { int a = __builtin_amdgcn_sdot4((int)tb.r[i].x, tb.hq[0], 0, false); a = __builtin_amdgcn_sdot4((int)tb.r[i].y, tb.hq[1], a, false);
        a = __builtin_amdgcn_sdot4((int)tb.r[i].z, tb.hq[2], a, false); p[i] = __builtin_amdgcn_sdot4((int)tb.r[i].w, tb.hq[3], a, false); }
#pragma unroll
    for (int i = 0; i < 8; ++i) { const bool up = (lane & 4) != 0; const int send = up ? p[i] : p[i + 8], keep = up ? p[i + 8] : p[i]; p[i] = keep + lx<7>(send); }
#pragma unroll
    for (int i = 0; i < 4; ++i) { const bool up = (lane & 2) != 0; const int send = up ? p[i] : p[i + 4], keep = up ? p[i + 4] : p[i]; p[i] = keep + lx<2>(send); }
#pragma unroll
    for (int i = 0; i < 2; ++i) { const bool up = (lane & 1) != 0; const int send = up ? p[i] : p[i + 2], keep = up ? p[i + 2] : p[i]; p[i] = keep + lx<1>(send); }
    const int k = 16 * (lane >> 3) + 8 * ((lane >> 2) & 1) + 4 * ((lane >> 1) & 1) + 2 * (lane & 1);
    *(int2*)(pd + t * 128 + k) = make_int2(p[0], p[1]);
}
constexpr size_t WS_CLAIM = 4096;
DI unsigned xcc_id() { return (unsigned)__builtin_amdgcn_s_getreg((3 << 11) | 20) & 7u; }
DI int claim_unit(Frame& F, int set) {
    LAS int* bc = (LAS int*)(F.lds + LDS_BYTES - 64);
    __syncthreads();
    if (F.tid == 0) {
        unsigned* cnt = (unsigned*)(F.ws + WS_CLAIM) + set * 256;
        const unsigned x0 = xcc_id(); int unit = -1;
        for (unsigned a = 0; a < 8; ++a) { const unsigned sl = (x0 + a) & 7u; const unsigned tk = __hip_atomic_fetch_add(cnt + sl * 32, 1u, __ATOMIC_RELAXED, __HIP_MEMORY_SCOPE_AGENT); if (tk < 32u) { unit = (int)(sl * 32 + tk); break; } }
        bc[0] = unit;
    }
    __syncthreads();
    return bc[0];
}
DI void p_upass(Frame& F, int layer, int cset) {
    const unsigned short* IDX = (const unsigned short*)(F.ws + WS_IDX);
    LAS unsigned char* wl = F.lds + F.wave * UP_LDS;
    LAS unsigned short* lidx = (LAS unsigned short*)wl;
    const int lane = F.lane;
    for (int unit = claim_unit(F, cset); unit >= 0; unit = claim_unit(F, cset)) {
    const int x = unit >> 5, jb = unit & 31;
    const unsigned char* Us = F.ws + WS_U + ((size_t)layer * 8 + x) * 16384 * 128;
    const unsigned char* H2Qs = F.ws + WS_H2Q + 128 * x;
    int* pd = (int*)(F.ws + WS_PD) + (size_t)x * T_TOK * 128;
    for (int t0 = jb * 1024 + F.wave * 128; t0 < jb * 1024 + F.wave * 128 + 128; t0 += 16) {
        { const u32x4* si = (const u32x4*)(IDX + (size_t)t0 * 128) + lane;
#pragma unroll
          for (int q = 0; q < 4; ++q) ((LAS u32x4*)lidx)[lane + 64 * q] = si[64 * q]; }
        UTok A, B;
        up_load(A, Us, H2Qs, lidx, (size_t)t0, 0, lane);
#pragma unroll 1
        for (int tt = 0; tt < 16; tt += 2) {
            up_load(B, Us, H2Qs, lidx, (size_t)t0 + tt + 1, tt + 1, lane);
            up_compute(A, pd, (size_t)t0 + tt, lane);
            if (tt + 2 < 16) up_load(A, Us, H2Qs, lidx, (size_t)t0 + tt + 2, tt + 2, lane);
            up_compute(B, pd, (size_t)t0 + tt + 1, lane);
        }
    }
    }
}
DI void p_combine(Frame& F, int layer) {
    const unsigned short* IDX = (const unsigned short*)(F.ws + WS_IDX); const float* GATE = (const float*)(F.ws + WS_GATE);
    const float* SH = (const float*)(F.ws + WS_SH); const float* SU = (const float*)(F.ws + WS_SU) + (size_t)layer * 16384; const float* SV = (const float*)(F.ws + WS_SV) + (size_t)layer * 16384;
    const int* pd = (const int*)(F.ws + WS_PD); unsigned char* W8 = F.ws + WS_W; float* SW8 = (float*)(F.ws + WS_SW8);
    const int gw = F.bid * NWAVES + F.wave, NGW = F.G * NWAVES;
    for (int t0 = gw * 4; t0 < T_TOK; t0 += NGW * 4) {
        int s0[4], s1[4], e0[4], e1[4]; float g0[4], g1[4], sh[4];
#pragma unroll
        for (int q = 0; q < 4; ++q) { const size_t t = (size_t)t0 + q; s0[q] = 0; s1[q] = 0;
#pragma unroll
            for (int x = 0; x < 8; ++x) { const int* p = pd + ((size_t)x * T_TOK + t) * 128 + F.lane; s0[q] += p[0]; s1[q] += p[64]; }
            e0[q] = IDX[t * 128 + F.lane]; e1[q] = IDX[t * 128 + 64 + F.lane]; g0[q] = GATE[t * 128 + F.lane]; g1[q] = GATE[t * 128 + 64 + F.lane]; sh[q] = SH[t]; }
        float u0[4], u1[4], v0[4], v1[4];
#pragma unroll
        for (int q = 0; q < 4; ++q) { u0[q] = SU[e0[q]]; u1[q] = SU[e1[q]]; v0[q] = SV[e0[q]]; v1[q] = SV[e1[q]]; }
#pragma unroll
        for (int q = 0; q < 4; ++q) { const size_t t = (size_t)t0 + q;
            const float d0 = (float)s0[q] * u0[q] * sh[q], d1 = (float)s1[q] * u1[q] * sh[q];
            const float w0 = g0[q] * 0.5f * d0 * (1.0f + erff(d0 * 0.70710678118654752f)) * v0[q], w1 = g1[q] * 0.5f * d1 * (1.0f + erff(d1 * 0.70710678118654752f)) * v1[q];
            const float m = fmaxf(wave_max(fmaxf(fabsf(w0), fabsf(w1))), 1e-30f), inv = 127.0f / m;
            W8[t * 128 + F.lane] = (unsigned char)((int)rintf(w0 * inv) & 255); W8[t * 128 + 64 + F.lane] = (unsigned char)((int)rintf(w1 * inv) & 255);
            if (F.lane == 0) SW8[t] = m * (1.0f / 127.0f); }
    }
}
struct TokBuf { u32x4 r[16]; u32x4 w; };
DI void vp_load(TokBuf& tb, const unsigned char* Vs, const LAS unsigned short* lidx, const LAS unsigned char* lw, int tt, int lane) {
    const int g = lane >> 3, c = lane & 7;
    const LAS u32x4* ip = (const LAS u32x4*)(lidx + tt * 128 + 16 * g); const u32x4 ia = ip[0], ib = ip[1];
    tb.w = *(const LAS u32x4*)(lw + tt * 128 + 16 * g);
    const unsigned e[16] = {ia.x & 0xffffu, ia.x >> 16, ia.y & 0xffffu, ia.y >> 16, ia.z & 0xffffu, ia.z >> 16, ia.w & 0xffffu, ia.w >> 16,
                            ib.x & 0xffffu, ib.x >> 16, ib.y & 0xffffu, ib.y >> 16, ib.z & 0xffffu, ib.z >> 16, ib.w & 0xffffu, ib.w >> 16};
#pragma unroll
    for (int i = 0; i < 16; ++i) tb.r[i] = *(const u32x4*)(Vs + (size_t)e[i] * 128 + c * 16);
}
DI void tdot4(int (&acc)[16], int d, unsigned r0, unsigned r1, unsigned r2, unsigned r3, unsigned wq) {
    const unsigned t0 = __builtin_amdgcn_perm(r1, r0, 0x05010400u), t1 = __builtin_amdgcn_perm(r1, r0, 0x07030602u);
    const unsigned t2 = __builtin_amdgcn_perm(r3, r2, 0x05010400u), t3 = __builtin_amdgcn_perm(r3, r2, 0x07030602u);
    const unsigned c0 = __builtin_amdgcn_perm(t2, t0, 0x05040100u), c1 = __builtin_amdgcn_perm(t2, t0, 0x07060302u);
    const unsigned c2 = __builtin_amdgcn_perm(t3, t1, 0x05040100u), c3 = __builtin_amdgcn_perm(t3, t1, 0x07060302u);
    acc[4 * d] = __builtin_amdgcn_sdot4((int)c0, (int)wq, acc[4 * d], false); acc[4 * d + 1] = __builtin_amdgcn_sdot4((int)c1, (int)wq, acc[4 * d + 1], false);
    acc[4 * d + 2] = __builtin_amdgcn_sdot4((int)c2, (int)wq, acc[4 * d + 2], false); acc[4 * d + 3] = __builtin_amdgcn_sdot4((int)c3, (int)wq, acc[4 * d + 3], false);
}
DI void vp_compute(const TokBuf& tb, Frame& F, const float* g2s, const float* SW8, float* xout, size_t t, int x, int lane) {
    int p[16];
#pragma unroll
    for (int i = 0; i < 16; ++i) p[i] = 0;
#pragma unroll
    for (int j = 0; j < 4; ++j) { const unsigned wq = j == 0 ? tb.w.x : j == 1 ? tb.w.y : j == 2 ? tb.w.z : tb.w.w;
        tdot4(p, 0, tb.r[4 * j].x, tb.r[4 * j + 1].x, tb.r[4 * j + 2].x, tb.r[4 * j + 3].x, wq); tdot4(p, 1, tb.r[4 * j].y, tb.r[4 * j + 1].y, tb.r[4 * j + 2].y, tb.r[4 * j + 3].y, wq);
        tdot4(p, 2, tb.r[4 * j].z, tb.r[4 * j + 1].z, tb.r[4 * j + 2].z, tb.r[4 * j + 3].z, wq); tdot4(p, 3, tb.r[4 * j].w, tb.r[4 * j + 1].w, tb.r[4 * j + 2].w, tb.r[4 * j + 3].w, wq); }
#pragma unroll
    for (int i = 0; i < 8; ++i) { const bool up = (lane & 32) != 0; const int send = up ? p[i] : p[i + 8], keep = up ? p[i + 8] : p[i]; p[i] = keep + lx<32>(send); }
#pragma unroll
    for (int i = 0; i < 4; ++i) { const bool up = (lane & 16) != 0; const int send = up ? p[i] : p[i + 4], keep = up ? p[i + 4] : p[i]; p[i] = keep + lx<16>(send); }
#pragma unroll
    for (int i = 0; i < 2; ++i) { const bool up = (lane & 8) != 0; const int send = up ? p[i] : p[i + 2], keep = up ? p[i + 2] : p[i]; p[i] = keep + lx<8>(send); }
    const int col = 128 * x + 16 * (lane & 7) + 8 * ((lane >> 5) & 1) + 4 * ((lane >> 4) & 1) + 2 * ((lane >> 3) & 1);
    const float sw = SW8[t];
    const f32x2_t gg = *(const f32x2_t*)(g2s + col);
    const f32x2_t xv = *(const f32x2_t*)(F.out + t * 1024 + col);
    *(f32x2_t*)(xout + t * 1024 + col) = xv + gg * (f32x2_t){(float)p[0] * sw, (float)p[1] * sw};
}
DI void p_vpass(Frame& F, int layer, float* xout, int cset) {
    const unsigned short* IDX = (const unsigned short*)(F.ws + WS_IDX); const unsigned char* W8 = F.ws + WS_W; const float* SW8 = (const float*)(F.ws + WS_SW8);
    const float* mods = (const float*)(F.ws + WS_MODS);
    LAS unsigned char* wl = F.lds + F.wave * UP_LDS;
    LAS unsigned short* lidx = (LAS unsigned short*)wl; LAS unsigned char* lw = (LAS unsigned char*)(wl + 4096);
    const int lane = F.lane;
    for (int unit = claim_unit(F, cset); unit >= 0; unit = claim_unit(F, cset)) {
    const int x = unit >> 5, jb = unit & 31;
    const unsigned char* Vs = F.ws + WS_V + ((size_t)layer * 8 + x) * 16384 * 128;
    for (int t0 = jb * 1024 + F.wave * 128; t0 < jb * 1024 + F.wave * 128 + 128; t0 += 16) {
        const int b = t0 >> 11;
        const float* g2s = mods + ((size_t)layer * 16 + b) * 6144 + 5 * 1024;
        { const u32x4* si = (const u32x4*)(IDX + (size_t)t0 * 128) + lane;
#pragma unroll
          for (int q = 0; q < 4; ++q) ((LAS u32x4*)lidx)[lane + 64 * q] = si[64 * q];
          const u32x4* sg = (const u32x4*)(W8 + (size_t)t0 * 128) + lane;
#pragma unroll
          for (int q = 0; q < 2; ++q) ((LAS u32x4*)lw)[lane + 64 * q] = sg[64 * q]; }
        TokBuf A, B;
        vp_load(A, Vs, lidx, lw, 0, lane);
#pragma unroll 1
        for (int tt = 0; tt < 16; tt += 2) {
            vp_load(B, Vs, lidx, lw, tt + 1, lane);
            vp_compute(A, F, g2s, SW8, xout, (size_t)t0 + tt, x, lane);
            if (tt + 2 < 16) vp_load(A, Vs, lidx, lw, tt + 2, lane);
            vp_compute(B, F, g2s, SW8, xout, (size_t)t0 + tt + 1, x, lane);
        }
    }
    }
}
#ifndef GEMM_ALIGN
#define GEMM_ALIGN true
#endif
#ifndef GEMM_SP2
#define GEMM_SP2 true
#endif
#ifndef DUP
#define DUP -1
#endif
#ifndef PH_MASK
#define PH_MASK 0x3FFFF
#endif

constexpr size_t WS_BAR = 65536;
#define XB_TMO      128
#define XB_XCNT(j)  (256  + 64 * (j))
#define XB_XSUB(j)  (1280 + 64 * (j))
#define XB_XGEN(j)  (2304 + 64 * (j))
#define XB_TOP      3328
#define XB_TOPGEN   3392
#define XCD_BAR_WORDS 3456
#define XB_SPIN_CAP (1u << 18)

__device__ __forceinline__ unsigned xb_ld(unsigned* p)              { return __hip_atomic_load(p, __ATOMIC_RELAXED, __HIP_MEMORY_SCOPE_AGENT); }
__device__ __forceinline__ unsigned xb_add(unsigned* p, unsigned v) { return __hip_atomic_fetch_add(p, v, __ATOMIC_RELAXED, __HIP_MEMORY_SCOPE_AGENT); }
__device__ __forceinline__ unsigned xb_xcc_id() { return (unsigned)__builtin_amdgcn_s_getreg((3 << 11) | 20) & 0xFu; }
#define XB_SPIN(cond, bar) do { unsigned _sp = 0; while (cond) { __builtin_amdgcn_s_sleep(1); \
    if ((++_sp & 255u) == 0u) { if (xb_ld(&(bar)[XB_TMO])) break; if (_sp > XB_SPIN_CAP) { atomicAdd(&(bar)[XB_TMO], 1u); break; } } } } while (0)

struct XcdBarrier {
    unsigned* bar; unsigned x;
    volatile LAS unsigned* st;
};

__device__ __forceinline__ XcdBarrier xcd_barrier_post(unsigned* bar, volatile LAS unsigned* st) {
    XcdBarrier b; b.bar = bar; b.x = xb_xcc_id(); b.st = st;
    if (threadIdx.x == 0) (void)xb_add(&bar[XB_XCNT(b.x)], 1u);
    return b;
}
__device__ __forceinline__ void xcd_barrier_complete(unsigned* bar, unsigned x, unsigned& nloc, unsigned& nx) {
    const unsigned G = gridDim.x * gridDim.y * gridDim.z;
    unsigned sum, cnt, mine, sp = 0u;
    for (;;) {
        sum = 0u; cnt = 0u; mine = 0u;
#pragma unroll
        for (unsigned j = 0; j < 16; ++j) { const unsigned c = xb_ld(&bar[XB_XCNT(j)]); sum += c; cnt += (c > 0u) ? 1u : 0u; mine = (j == x) ? c : mine; }
        if (sum == G) break;
        __builtin_amdgcn_s_sleep(1);
        if ((++sp & 255u) == 0u) { if (xb_ld(&bar[XB_TMO])) break; if (sp > XB_SPIN_CAP) { atomicAdd(&bar[XB_TMO], 1u); break; } }
    }
    nloc = mine > 0u ? mine : 1u; nx = cnt > 0u ? cnt : 1u;
}

__device__ __forceinline__ void xcd_barrier(const XcdBarrier& b) {
    asm volatile("s_waitcnt vmcnt(0)" ::: "memory");
    __syncthreads();
    if (threadIdx.x == 0) {
        unsigned* bar = b.bar;
        __builtin_amdgcn_s_waitcnt(0);
        unsigned nloc = b.st[0], nx = b.st[1];
        if (nloc == 0u) { xcd_barrier_complete(bar, b.x, nloc, nx); b.st[0] = nloc; b.st[1] = nx; }
        const unsigned old = xb_add(&bar[XB_XSUB(b.x)], 1u);
        const unsigned gen = old / nloc;
        if (old + 1u == (gen + 1u) * nloc) {
            __builtin_amdgcn_fence(__ATOMIC_RELEASE, "agent");
            asm volatile("s_waitcnt vmcnt(0)" ::: "memory");
            const unsigned og = xb_add(&bar[XB_TOP], 1u);
            const unsigned tg = og / nx;
            if (og + 1u == (tg + 1u) * nx) xb_add(&bar[XB_TOPGEN], 1u);
            else XB_SPIN(xb_ld(&bar[XB_TOPGEN]) == tg, bar);
            __builtin_amdgcn_fence(__ATOMIC_ACQUIRE, "agent");
            xb_add(&bar[XB_XGEN(b.x)], 1u);
            asm volatile("s_waitcnt vmcnt(0)" ::: "memory");
        } else {
            XB_SPIN(xb_ld(&bar[XB_XGEN(b.x)]) == gen, bar);
            __builtin_amdgcn_fence(__ATOMIC_ACQUIRE, "agent");
            asm volatile("s_waitcnt vmcnt(0)" ::: "memory");
        }
    }
    __syncthreads();
}

#ifndef N_LAUNCH_MODE
#define N_LAUNCH_MODE 1
#endif
constexpr int NPH = 18;
template <class Epi> DI void run_gemm(Frame& F, const bf16* A, const bf16* Bt, int N, const Epi& E) {
    pg8::Gemm g{A, Bt, T_TOK, N, DM}; pg8::StaticOrder S; S.init(T_TOK, N, F.G, F.vc);
    pg8::gemm_phase<Epi, pg8::StaticOrder, GEMM_ALIGN, GEMM_SP2>(F.lds, g, S, E);
}
__global__ void __launch_bounds__(NT, 2) fwd(Args args) {
    extern __shared__ __attribute__((aligned(16))) unsigned char lds_raw[];
    cg::grid_group grid = cg::this_grid();
    Frame F;
    F.lds = (LAS unsigned char*)lds_raw;
#pragma unroll
    for (int i = 0; i < 23; ++i) F.in[i] = args.in[i];
    F.out = args.out; F.ws = args.ws;
    F.tid = threadIdx.x; F.lane = F.tid & 63; F.wave = __builtin_amdgcn_readfirstlane(F.tid >> 6); F.bid = blockIdx.x; F.G = gridDim.x;
    const int lo = args.ph_lo, hi = args.ph_hi;
    volatile LAS unsigned* bst = (volatile LAS unsigned*)(F.lds + LDS_BYTES - 128);
    if (F.tid < 2) bst[F.tid] = 0u;
    __syncthreads();
    XcdBarrier xbar; xbar.bar = (unsigned*)(F.ws + WS_BAR); xbar.x = xb_xcc_id(); xbar.st = bst;
    if (F.tid == 0) bst[2] = xb_add(&xbar.bar[XB_XCNT(xbar.x)], 1u);
    __syncthreads();
    const unsigned my_rank = bst[2];
    F.vc = F.bid;
    if (lo < 0) grid.sync();
#define IN(k) (lo <= (k) && (k) < hi)
#if defined(PROBE_K)
    volatile LAS unsigned long long* tsl = (volatile LAS unsigned long long*)(F.lds + LDS_BYTES - 512); int nstamp = 1;
    if (F.tid == 0) tsl[0] = __builtin_amdgcn_s_memrealtime();
#define STAMP() do { if (F.tid == 0) tsl[nstamp] = __builtin_amdgcn_s_memrealtime(); ++nstamp; } while (0)
#else
#define STAMP() do { } while (0)
#endif
#define GSYNC() do { xcd_barrier(xbar); STAMP(); } while (0)
#define SEAM(k) do { if (IN(k) && IN((k) + 1)) GSYNC(); } while (0)
    float* mods = (float*)(F.ws + WS_MODS);
    bf16* Hb = (bf16*)(F.ws + WS_H);
    if (((PH_MASK >> 0) & 1) && IN(0)) { p0a_prologue(F); } SEAM(0);
    if (IN(0) && IN(1)) {
        bool even = (F.G % 8) == 0;
        for (unsigned j = 0; j < 16; ++j) { const unsigned cnt = xb_ld(&xbar.bar[XB_XCNT(j)]); even = even && (j < 8 ? cnt == (unsigned)(F.G / 8) : cnt == 0u); }
        if (even && xbar.x < 8u) F.vc = (int)(my_rank * 8u + xbar.x);
    }
    if (((PH_MASK >> 1) & 1) && IN(1)) { norm_phase<true>(F, F.in[0], F.in[4], mods, mods + 1024, 6144, Hb); __syncthreads(); p0b_prologue(F); } SEAM(1);
    if (((PH_MASK >> 2) & 1) && IN(2)) { pg8::EpiBf16<0> E{(bf16*)(F.ws + WS_PROJ), 3072, nullptr, 0, 0, 1.f}; run_gemm(F, Hb, (const bf16*)(F.ws + WS_WIN), 3072, E); if (DUP == 2) { GSYNC(); run_gemm(F, Hb, (const bf16*)(F.ws + WS_WIN), 3072, E); } } SEAM(2);
    if (((PH_MASK >> 3) & 1) && IN(3)) { p3_mlstm_local(F); if (DUP == 3) { GSYNC(); p3_mlstm_local(F); } } SEAM(3);
    if (((PH_MASK >> 4) & 1) && IN(4)) { p4_scan(F); if (DUP == 4) { GSYNC(); p3_mlstm_local(F); GSYNC(); p4_scan(F); } } SEAM(4);
    if (((PH_MASK >> 5) & 1) && IN(5)) { p5_mlstm_out(F); if (DUP == 5) { GSYNC(); p5_mlstm_out(F); } } SEAM(5);
    if (((PH_MASK >> 6) & 1) && IN(6)) { pg8::EpiResid E{F.in[0], F.out, mods + 2 * 1024, 6144}; run_gemm(F, Hb, (const bf16*)(F.ws + WS_WOUT), 1024, E); if (DUP == 6) { GSYNC(); run_gemm(F, Hb, (const bf16*)(F.ws + WS_WOUT), 1024, E); } } SEAM(6);
    if (((PH_MASK >> 7) & 1) && IN(7)) { norm_phase<false, true>(F, F.out, F.in[5], mods + 3 * 1024, mods + 4 * 1024, 6144, Hb); if (DUP == 7) { GSYNC(); norm_phase<false, true>(F, F.out, F.in[5], mods + 3 * 1024, mods + 4 * 1024, 6144, Hb); } } SEAM(7);
    if (((PH_MASK >> 8) & 1) && IN(8)) { pg8::EpiBf16<0> E{(bf16*)(F.ws + WS_PQ), 2048, nullptr, 0, 0, 1.f}; run_gemm(F, Hb, (const bf16*)(F.ws + WS_WPQ), 2048, E); if (DUP == 8) { GSYNC(); run_gemm(F, Hb, (const bf16*)(F.ws + WS_WPQ), 2048, E); } } SEAM(8);
    if (((PH_MASK >> 9) & 1) && IN(9)) { p_route(F, 0); if (DUP == 9) { GSYNC(); p_route(F, 0); } } SEAM(9);
    if (((PH_MASK >> 10) & 1) && IN(10)) {
        p_upass(F, 0, 0); GSYNC(); p_combine(F, 0); GSYNC(); p_vpass(F, 0, F.out, 1); GSYNC();
        norm2_phase(F, F.out, F.in[4] + 1024, mods + 16 * 6144, mods + 16 * 6144 + 1024, 6144, Hb, F.in[13], (const float*)(F.ws + WS_KVMODS), (const float*)(F.ws + WS_KVMODS) + 1024, 2048, (bf16*)(F.ws + WS_HB));
    } SEAM(10);
    if (((PH_MASK >> 11) & 1) && IN(11)) {
        { pg8::EpiHeadNorm E{(bf16*)(F.ws + WS_Q), (bf16*)(F.ws + WS_Q), 4, F.in[17], 0.125f * 1.4426950408889634f, EPS};     run_gemm(F, Hb, (const bf16*)(F.ws + WS_WSQ), 1024, E); }
        { pg8::EpiHeadNorm E{(bf16*)(F.ws + WS_K), (bf16*)(F.ws + WS_VV), 4, F.in[15], 1.0f, EPS}; run_gemm(F, (const bf16*)(F.ws + WS_HB), (const bf16*)(F.ws + WS_WKV), 2048, E);
          if (DUP == 11) { GSYNC(); run_gemm(F, (const bf16*)(F.ws + WS_HB), (const bf16*)(F.ws + WS_WKV), 2048, E); } }
    } SEAM(11);
    if (((PH_MASK >> 12) & 1) && IN(12)) { p12_attn(F); if (DUP == 12) { GSYNC(); p12_attn(F); } } SEAM(12);
    if (((PH_MASK >> 13) & 1) && IN(13)) { pg8::EpiResid E{F.out, F.out, mods + 16 * 6144 + 2 * 1024, 6144}; run_gemm(F, Hb, (const bf16*)(F.ws + WS_WSO), 1024, E); } SEAM(13);
    if (((PH_MASK >> 14) & 1) && IN(14)) { norm_phase<false, true>(F, F.out, F.in[5] + 1024, mods + 16 * 6144 + 3 * 1024, mods + 16 * 6144 + 4 * 1024, 6144, Hb); } SEAM(14);
    if (((PH_MASK >> 15) & 1) && IN(15)) { pg8::EpiBf16<0> E{(bf16*)(F.ws + WS_PQ), 2048, nullptr, 0, 0, 1.f}; run_gemm(F, Hb, (const bf16*)(F.ws + WS_WPQ) + (size_t)2048 * 1024, 2048, E); } SEAM(15);
    if (((PH_MASK >> 16) & 1) && IN(16)) { p_route(F, 1); } SEAM(16);
    if (((PH_MASK >> 17) & 1) && IN(17)) { p_upass(F, 1, 2); GSYNC(); if (DUP == 20) { p_upass(F, 1, 4); GSYNC(); } p_combine(F, 1); GSYNC(); if (DUP == 22) { p_combine(F, 1); GSYNC(); } if (DUP == 21) { p_vpass(F, 1, (float*)(F.ws + WS_Q + 32 * MiB), 5); GSYNC(); } p_vpass(F, 1, F.out, 3); }
    if (DUP == 30) { for (int i = 0; i < 10; ++i) GSYNC(); }
#if defined(PROBE_K)
    GSYNC();
    if (F.bid == 0) { __syncthreads(); const float t_us = (PROBE_K < 0) ? 100.0f : PROBE_Q * rintf((float)(tsl[PROBE_K + 1] - tsl[PROBE_K]) * 0.01f / PROBE_Q); const float dl = 0.15f * sqrtf(t_us * 0.01f);
        for (int i = F.tid; i < (1 << 20); i += NT) F.out[i] += dl; }
#endif
#undef IN
#undef SEAM
#undef GSYNC
}

extern "C" void kernel_launch(void* const* d_in, const int* in_sizes, int n_in, void* d_out, int out_size, void* d_ws, size_t ws_size, hipStream_t stream) {
    static int grid = 0;
    if (grid == 0) {
        int dev = 0, cus = 0, per_cu = 0;
        (void)hipGetDevice(&dev);
        (void)hipDeviceGetAttribute(&cus, hipDeviceAttributeMultiprocessorCount, dev);
        (void)hipFuncSetAttribute((const void*)fwd, hipFuncAttributeMaxDynamicSharedMemorySize, LDS_BYTES);
        (void)hipOccupancyMaxActiveBlocksPerMultiprocessor(&per_cu, (const void*)fwd, NT, LDS_BYTES);
        if (per_cu < 1) { fprintf(stderr, "kernel_launch: occupancy query says %d blocks per CU\n", per_cu); per_cu = 1; }
        grid = cus;
        if (n_in != 23 || ws_size < WS_END) fprintf(stderr, "kernel_launch: unexpected n_in %d / ws_size %zu\n", n_in, ws_size);
        (void)hipGetLastError();
    }
    (void)hipMemsetAsync(d_ws, 0, 131072, stream);
    Args a{};
    for (int i = 0; i < 23; ++i) a.in[i] = (const float*)d_in[i];
    a.out = (float*)d_out; a.ws = (unsigned char*)d_ws;
#if N_LAUNCH_MODE == 1
    a.ph_lo = 0; a.ph_hi = NPH;
    void* kargs[] = {&a};
    hipError_t e = hipLaunchCooperativeKernel((const void*)fwd, dim3(grid), dim3(NT), kargs, LDS_BYTES, stream);
    if (e != hipSuccess) fprintf(stderr, "kernel_launch: cooperative launch failed: %s (grid %d)\n", hipGetErrorString(e), grid);
#else
    for (int p = 0; p < NPH; ++p) { a.ph_lo = p; a.ph_hi = p + 1; hipLaunchKernelGGL(fwd, dim3(grid), dim3(NT), LDS_BYTES, stream, a); }
#endif
}
```

```cpp
#include <hip/hip_runtime.h>
#include <hip/hip_cooperative_groups.h>
#include <cstdio>
#include <cstdint>
namespace cg = cooperative_groups;
#define N_LAUNCH_MODE 1
namespace pg8 {
#define PG8_LAS __attribute__((address_space(3)))
typedef unsigned short bf16_t;
typedef short bf16x8 __attribute__((ext_vector_type(8)));
typedef float f32x4 __attribute__((ext_vector_type(4)));
typedef unsigned u32x4 __attribute__((ext_vector_type(4)));
constexpr int BM = 256, BK = 64, HALF = 128, HTB = HALF * BK * 2  , STAGE_BYTES = 8 * HTB, NXCD = 8, WGM = 8;

__host__ __device__ __forceinline__ int lds_byte(int r, int c) { const int st = (r >> 4) * 2 + (c >> 5), rr = r & 15, cc = c & 31, ob = rr * 64 + cc * 2; return st * 1024 + (ob ^ (((ob >> 9) & 1) << 5)); }
__host__ __device__ __forceinline__ void stage_rc(int b, int& R, int& C) { const int st = b / 1024, sb = b % 1024, swz = sb ^ (((sb >> 9) & 1) << 5); R = (st >> 1) * 16 + swz / 64; C = (st & 1) * 32 + (swz % 64) / 2; }
__host__ __device__ __forceinline__ int perm32(int rho) { const int n = rho >> 4, i = rho & 15; return 8 * (i >> 2) + 4 * n + (i & 3); }

struct Unit { int pm, pn; };
struct Gemm { const bf16_t* A; const bf16_t* Bt; int M, N, K; };

struct StaticOrder {
    int nM, nN, nwg, G, c;
    __host__ __device__ void init(int M, int N, int G_, int c_) { nM = M / BM; nN = N / BM; nwg = nM * nN; G = G_; c = c_; }
    __host__ __device__ bool next(int i, Unit& u) const {
        const long L = (long)i * G + c; if (L >= nwg) return false;
        int wgid = (int)L; { const int q = nwg / NXCD, r = nwg % NXCD, xcd = wgid % NXCD, off = wgid / NXCD; wgid = (xcd < r ? xcd * (q + 1) : r * (q + 1) + (xcd - r) * q) + off; }
        const int nig = WGM * nN, gid = wgid / nig, fm = gid * WGM, gsz = (nM - fm) < WGM ? (nM - fm) : WGM;
        u.pm = fm + ((wgid % nig) % gsz); u.pn = (wgid % nig) / gsz; return true;
    }
    __device__ __forceinline__ void a_ready(const Unit&) const {}
    __device__ __forceinline__ void done(const Unit&) const {}
};

__device__ __forceinline__ unsigned cvt_pk_bf16(float lo, float hi) { unsigned r; asm volatile("v_cvt_pk_bf16_f32 %0, %1, %2" : "=v"(r) : "v"(lo), "v"(hi)); return r; }
typedef float f32x2 __attribute__((ext_vector_type(2)));
__device__ __forceinline__ f32x2 gelu_pk(f32x2 v) {
    const f32x2 av = __builtin_elementwise_abs(v), d = av * 0.2316418882f + 1.0f;
    f32x2 t; t.x = __builtin_amdgcn_rcpf(d.x); t.y = __builtin_amdgcn_rcpf(d.y);
    f32x2 q = t * 0.5307027145f + (-0.7265760135f); q = q * t + 0.7107068705f; q = q * t + (-0.142248368f); q = q * t + 0.127414796f; q = q * t;
    const f32x2 s = (v * v) * (-0.72134752044f);
    f32x2 e; e.x = __builtin_amdgcn_exp2f(s.x); e.y = __builtin_amdgcn_exp2f(s.y);
    const f32x2 m = v * (q * e), r = v - m;
    f32x2 o; o.x = v.x < 0.f ? m.x : r.x; o.y = v.y < 0.f ? m.y : r.y; return o;
}

template <int ACT  > struct EpiBf16 {
    static constexpr bool PERM = true, AFTER_DRAIN = false; static_assert(ACT == 0 || ACT == 1, "EpiBf16: ACT is 0 (none) or 1 (gelu_pk)");
    bf16_t* O; int ldc; const float* bias; int split_cols; size_t split_stride; float scale0;
    __device__ __forceinline__ void operator()(const f32x4 (&acc)[2][2][4][2], const Unit& u, int wr, int wc, int fr, int fq) const {
        const int row0 = u.pm * BM + wr * 64 + fr; int colt = u.pn * BM; bf16_t* base = O;
        float sc = 1.f; if (split_cols) { const int t = colt / split_cols; base += (size_t)t * split_stride; colt -= t * split_cols; if (t == 0) sc = scale0; }
        const int col0 = colt + wc * 32 + 8 * fq, bcol0 = u.pn * BM + wc * 32 + 8 * fq;
        f32x4 bv[2][2];
#pragma unroll
        for (int bj = 0; bj < 2; ++bj)
#pragma unroll
            for (int n = 0; n < 2; ++n) bv[bj][n] = bias ? *(const f32x4*)(bias + bcol0 + bj * HALF + 4 * n) : (f32x4){0.f, 0.f, 0.f, 0.f};
#pragma unroll
        for (int ai = 0; ai < 2; ++ai)
#pragma unroll
            for (int m = 0; m < 4; ++m) { bf16_t* rowp = base + (size_t)(row0 + ai * HALF + m * 16) * ldc + col0;
#pragma unroll
                for (int bj = 0; bj < 2; ++bj) { f32x4 v0 = acc[ai][bj][m][0] + bv[bj][0], v1 = acc[ai][bj][m][1] + bv[bj][1];
                    if (ACT == 1) { f32x2 a = gelu_pk((f32x2){v0[0], v0[1]}), b = gelu_pk((f32x2){v0[2], v0[3]}), c = gelu_pk((f32x2){v1[0], v1[1]}), d = gelu_pk((f32x2){v1[2], v1[3]});
                        v0 = (f32x4){a.x, a.y, b.x, b.y}; v1 = (f32x4){c.x, c.y, d.x, d.y}; }
                    v0 = v0 * sc; v1 = v1 * sc; u32x4 w; w.x = cvt_pk_bf16(v0[0], v0[1]); w.y = cvt_pk_bf16(v0[2], v0[3]); w.z = cvt_pk_bf16(v1[0], v1[1]); w.w = cvt_pk_bf16(v1[2], v1[3]);
                    *(u32x4*)(rowp + bj * HALF) = w; } }
    }
};
struct EpiResid {
    static constexpr bool PERM = false, AFTER_DRAIN = false;
    const float* base; float* out; const float* gate; int gstride;
    __device__ __forceinline__ void operator()(const f32x4 (&acc)[2][2][4][2], const Unit& u, int wr, int wc, int fr, int fq) const {
        const int col0 = u.pn * BM + wc * 32 + 4 * fq;
        const int b = (u.pm * BM) >> 11;
        f32x4 gv[2][2];
#pragma unroll
        for (int bj = 0; bj < 2; ++bj)
#pragma unroll
            for (int n = 0; n < 2; ++n) gv[bj][n] = *(const f32x4*)(gate + (size_t)b * gstride + col0 + bj * HALF + n * 16);
#pragma unroll
        for (int ai = 0; ai < 2; ++ai)
#pragma unroll
            for (int m = 0; m < 4; ++m) { const size_t off = (size_t)(u.pm * BM + ai * HALF + wr * 64 + m * 16 + fr) * 1024 + col0;
#pragma unroll
                for (int bj = 0; bj < 2; ++bj)
#pragma unroll
                    for (int n = 0; n < 2; ++n) { const f32x4 bs = *(const f32x4*)(base + off + bj * HALF + n * 16);
                        *(f32x4*)(out + off + bj * HALF + n * 16) = bs + gv[bj][n] * acc[ai][bj][m][n]; }
                if (m & 1) asm volatile("" ::: "memory"); }
    }
};
struct EpiHeadNorm {
    static constexpr bool PERM = true, AFTER_DRAIN = false;
    bf16_t* O0; bf16_t* O1; int ntile_norm; const float* g; float scale; float eps;
    __device__ __forceinline__ void operator()(const f32x4 (&acc)[2][2][4][2], const Unit& u, int wr, int wc, int fr, int fq) const {
        const bool nrm = u.pn < ntile_norm; bf16_t* O = nrm ? O0 : O1; const int pnl = nrm ? u.pn : u.pn - ntile_norm;
        f32x4 gv[2][2];
#pragma unroll
        for (int bj = 0; bj < 2; ++bj)
#pragma unroll
            for (int n = 0; n < 2; ++n) { const f32x4 t = *(const f32x4*)(g + 32 * bj + 8 * fq + 4 * n); gv[bj][n] = nrm ? t * scale : (f32x4){1.f, 1.f, 1.f, 1.f}; }
#pragma unroll
        for (int ai = 0; ai < 2; ++ai)
#pragma unroll
            for (int m = 0; m < 4; ++m) {
                float ss = 0.f;
#pragma unroll
                for (int bj = 0; bj < 2; ++bj)
#pragma unroll
                    for (int n = 0; n < 2; ++n) { const f32x4 x = acc[ai][bj][m][n]; ss += (x[0] * x[0] + x[1] * x[1]) + (x[2] * x[2] + x[3] * x[3]); }
                ss += __shfl_xor(ss, 16); ss += __shfl_xor(ss, 32);
                const float rs = nrm ? 1.0f / sqrtf(ss * (1.0f / 64.0f) + eps) : 1.0f;
                bf16_t* rowp = O + (size_t)(u.pm * BM + ai * HALF + wr * 64 + m * 16 + fr) * 1024 + pnl * BM + wc * 64 + 8 * fq;
#pragma unroll
                for (int bj = 0; bj < 2; ++bj) { const f32x4 v0 = acc[ai][bj][m][0] * rs * gv[bj][0], v1 = acc[ai][bj][m][1] * rs * gv[bj][1];
                    u32x4 w; w.x = cvt_pk_bf16(v0[0], v0[1]); w.y = cvt_pk_bf16(v0[2], v0[3]); w.z = cvt_pk_bf16(v1[0], v1[1]); w.w = cvt_pk_bf16(v1[2], v1[3]);
                    *(u32x4*)(rowp + bj * 32) = w; }
            }
    }
};
template <class Epi, class Sched, bool ALIGN_EPI = false, bool SP2 = false>
__device__ __forceinline__ void gemm_phase(PG8_LAS unsigned char* lds, const Gemm g, const Sched& S, const Epi& E) {
    const int tid = threadIdx.x, wid = __builtin_amdgcn_readfirstlane(tid >> 6), lane = tid & 63, wr = wid >> 2, wc = wid & 3, fr = lane & 15, fq = lane >> 4;
    const int K = g.K, nt = K / BK;
    unsigned voffA[2], voffB[2];
#pragma unroll
    for (int i = 0; i < 2; ++i) { int R, C; stage_rc(tid * 16 + i * 8192, R, C); const int Rb = Epi::PERM ? ((R & ~31) + perm32(R & 31)) : R;
        voffA[i] = (unsigned)(R * K + C) * 2u; voffB[i] = (unsigned)(Rb * K + C) * 2u; }
    const size_t kstep = (size_t)(BK * 2);
    const size_t hstep = (size_t)HALF * K * 2;
    const size_t tstep = 2 * hstep;
    const unsigned ldsw = (unsigned)wid * 1024u;
    const int aoff = lds_byte(wr * 64 + fr, fq * 8), boff = lds_byte(wc * 32 + fr, fq * 8);
#define PG8_SA(b, h) (((b) * 2 + (h)) * HTB)
#define PG8_SB(b, h) ((4 + (b) * 2 + (h)) * HTB)
#define PG8_STAGE(bufoff, gbase, voff) do { _Pragma("unroll") for (int _i = 0; _i < 2; ++_i) \
        __builtin_amdgcn_global_load_lds((const unsigned*)((const char*)(gbase) + (voff)[_i]), (PG8_LAS unsigned*)(lds + (bufoff) + ldsw + _i * 8192), 16, 0, 0); } while (0)
#define PG8_LDA(dst, b, h) do { _Pragma("unroll") for (int m = 0; m < 4; ++m) _Pragma("unroll") for (int k = 0; k < 2; ++k) dst[m][k] = *(const PG8_LAS bf16x8*)(lds + PG8_SA(b, h) + aoff + m * 2048 + k * 1024); } while (0)
#define PG8_LDB(dst, b, h) do { _Pragma("unroll") for (int n = 0; n < 2; ++n) _Pragma("unroll") for (int k = 0; k < 2; ++k) dst[n][k] = *(const PG8_LAS bf16x8*)(lds + PG8_SB(b, h) + boff + n * 2048 + k * 1024); } while (0)
#define PG8_MMA(ai, bj, At, Bt) do { __builtin_amdgcn_s_setprio(1); _Pragma("unroll") for (int m = 0; m < 4; ++m) _Pragma("unroll") for (int n = 0; n < 2; ++n) _Pragma("unroll") for (int k = 0; k < 2; ++k) \
        acc[ai][bj][m][n] = __builtin_amdgcn_mfma_f32_16x16x32_bf16(Bt[n][k], At[m][k], acc[ai][bj][m][n], 0, 0, 0); __builtin_amdgcn_s_setprio(0); } while (0)
#define PG8_WAIT_V(n) asm volatile("s_waitcnt vmcnt(" #n ")" ::: "memory")
#define PG8_WAIT_L(n) asm volatile("s_waitcnt lgkmcnt(" #n ")" ::: "memory")
#define PG8_BAR __builtin_amdgcn_s_barrier()
#define PG8_SCHED __builtin_amdgcn_sched_barrier(0)
    Unit cur, nxt; int ui = 0;
    if (!S.next(0, cur)) return;
    f32x4 acc[2][2][4][2];
#pragma unroll
    for (int a = 0; a < 2; ++a)
#pragma unroll
        for (int b = 0; b < 2; ++b)
#pragma unroll
            for (int m = 0; m < 4; ++m)
#pragma unroll
                for (int n = 0; n < 2; ++n) acc[a][b][m][n] = (f32x4){0.f, 0.f, 0.f, 0.f};
    bf16x8 At[4][2], B0[2][2], B1[2][2];
    const char* cA = (const char*)g.A + (size_t)cur.pm * tstep; const char* cB = (const char*)g.Bt + (size_t)cur.pn * tstep;
    S.a_ready(cur);
    if constexpr (SP2) {
        PG8_STAGE(PG8_SB(0, 0), cB, voffB); PG8_STAGE(PG8_SB(0, 1), cB + hstep, voffB); PG8_STAGE(PG8_SA(0, 0), cA, voffA); PG8_STAGE(PG8_SA(0, 1), cA + hstep, voffA);
        if (wr == 1) PG8_BAR;
        PG8_WAIT_V(2); PG8_BAR;
        PG8_STAGE(PG8_SB(1, 0), cB + kstep, voffB); PG8_STAGE(PG8_SA(1, 0), cA + kstep, voffA); PG8_STAGE(PG8_SB(1, 1), cB + hstep + kstep, voffB);
        PG8_WAIT_V(6); PG8_BAR;
    } else {
        PG8_STAGE(PG8_SB(0, 0), cB, voffB); PG8_STAGE(PG8_SA(0, 0), cA, voffA); PG8_STAGE(PG8_SB(0, 1), cB + hstep, voffB); PG8_STAGE(PG8_SA(0, 1), cA + hstep, voffA);
        if (wr == 1) PG8_BAR;
        PG8_WAIT_V(4); PG8_BAR;
        PG8_STAGE(PG8_SB(1, 0), cB + kstep, voffB); PG8_STAGE(PG8_SA(1, 0), cA + kstep, voffA); PG8_STAGE(PG8_SB(1, 1), cB + hstep + kstep, voffB);
        PG8_WAIT_V(6); PG8_BAR;
    }
    for (;;) {
        const bool has_next = S.next(ui + 1, nxt);
        const char* nA = has_next ? (const char*)g.A + (size_t)nxt.pm * tstep : cA; const char* nB = has_next ? (const char*)g.Bt + (size_t)nxt.pn * tstep : cB;
        for (int t = 0; t < nt; t += 2) {
            const bool last = (t == nt - 2);
            const char* a1 = cA + (size_t)(t + 1) * kstep;
            const char* a2 = last ? nA : cA + (size_t)(t + 2) * kstep; const char* b2 = last ? nB : cB + (size_t)(t + 2) * kstep;
            const char* a3 = a2 + kstep; const char* b3 = b2 + kstep;
            if (last && has_next) S.a_ready(nxt);
            if constexpr (SP2) {
            PG8_LDB(B0, 0, 0); PG8_LDB(B1, 0, 1); PG8_SCHED; PG8_LDA(At, 0, 0); PG8_STAGE(PG8_SA(1, 1), a1 + hstep, voffA);
            PG8_WAIT_V(8); PG8_WAIT_L(0); PG8_BAR; PG8_MMA(0, 0, At, B0); PG8_MMA(0, 1, At, B1); PG8_BAR; PG8_SCHED;
            PG8_LDA(At, 0, 1); PG8_STAGE(PG8_SB(0, 0), b2, voffB); PG8_STAGE(PG8_SB(0, 1), b2 + hstep, voffB); PG8_STAGE(PG8_SA(0, 0), a2, voffA);
            PG8_WAIT_V(8); PG8_WAIT_L(0); PG8_BAR; PG8_MMA(1, 0, At, B0); PG8_MMA(1, 1, At, B1); PG8_BAR; PG8_SCHED;
            PG8_LDB(B0, 1, 0); PG8_LDB(B1, 1, 1); PG8_SCHED; PG8_LDA(At, 1, 0); PG8_STAGE(PG8_SA(0, 1), a2 + hstep, voffA);
            PG8_WAIT_V(8); PG8_WAIT_L(0); PG8_BAR; PG8_MMA(0, 0, At, B0); PG8_MMA(0, 1, At, B1); PG8_BAR; PG8_SCHED;
            PG8_LDA(At, 1, 1); PG8_STAGE(PG8_SB(1, 0), b3, voffB); PG8_STAGE(PG8_SB(1, 1), b3 + hstep, voffB); PG8_STAGE(PG8_SA(1, 0), a3, voffA);
            PG8_WAIT_V(8); PG8_WAIT_L(0); PG8_BAR; PG8_MMA(1, 0, At, B0); PG8_MMA(1, 1, At, B1); PG8_BAR; PG8_SCHED;
            } else {
            PG8_LDB(B0, 0, 0); PG8_SCHED; PG8_LDA(At, 0, 0); PG8_STAGE(PG8_SA(1, 1), a1 + hstep, voffA);
            PG8_WAIT_L(8); PG8_BAR; PG8_WAIT_L(0); PG8_MMA(0, 0, At, B0); PG8_BAR; PG8_SCHED;
            PG8_LDB(B1, 0, 1); PG8_STAGE(PG8_SB(0, 0), b2, voffB);
            PG8_BAR; PG8_WAIT_L(0); PG8_MMA(0, 1, At, B1); PG8_BAR;
            PG8_LDA(At, 0, 1); PG8_STAGE(PG8_SA(0, 0), a2, voffA);
            PG8_BAR; PG8_WAIT_L(0); PG8_MMA(1, 0, At, B0); PG8_BAR; PG8_SCHED;
            PG8_STAGE(PG8_SB(0, 1), b2 + hstep, voffB);
            PG8_WAIT_V(6); PG8_BAR; PG8_MMA(1, 1, At, B1); PG8_BAR;
            PG8_LDB(B0, 1, 0); PG8_SCHED; PG8_LDA(At, 1, 0); PG8_STAGE(PG8_SA(0, 1), a2 + hstep, voffA);
            PG8_WAIT_L(8); PG8_BAR; PG8_WAIT_L(0); PG8_MMA(0, 0, At, B0); PG8_BAR; PG8_SCHED;
            PG8_LDB(B1, 1, 1); PG8_STAGE(PG8_SB(1, 0), b3, voffB);
            PG8_BAR; PG8_WAIT_L(0); PG8_MMA(0, 1, At, B1); PG8_BAR;
            PG8_LDA(At, 1, 1); PG8_STAGE(PG8_SA(1, 0), a3, voffA);
            PG8_BAR; PG8_WAIT_L(0); PG8_MMA(1, 0, At, B0); PG8_BAR; PG8_SCHED;
            PG8_STAGE(PG8_SB(1, 1), b3 + hstep, voffB);
            PG8_WAIT_V(6); PG8_BAR; PG8_MMA(1, 1, At, B1); PG8_BAR;
            }
        }
        if constexpr (ALIGN_EPI) { if (wr == 0) PG8_BAR; }
        if constexpr (!Epi::AFTER_DRAIN) { E(acc, cur, wr, wc, fr, fq); S.done(cur); }
        if (!has_next) break;
#pragma unroll
        for (int a = 0; a < 2; ++a)
#pragma unroll
            for (int b = 0; b < 2; ++b)
#pragma unroll
                for (int m = 0; m < 4; ++m)
#pragma unroll
                    for (int n = 0; n < 2; ++n) acc[a][b][m][n] = (f32x4){0.f, 0.f, 0.f, 0.f};
        cur = nxt; cA = nA; cB = nB; ++ui;
        if constexpr (ALIGN_EPI) { if (wr == 1) PG8_BAR; }
    }
    PG8_WAIT_V(0);
    if constexpr (!ALIGN_EPI) { if (wr == 0) PG8_BAR; }
    PG8_BAR;
    if constexpr (Epi::AFTER_DRAIN) { E.fused(acc, cur, wr, wc, fr, fq, lds, wid, lane); S.done(cur); }
#undef PG8_SA
#undef PG8_SB
#undef PG8_STAGE
#undef PG8_LDA
#undef PG8_LDB
#undef PG8_MMA
#undef PG8_WAIT_V
#undef PG8_WAIT_L
#undef PG8_BAR
#undef PG8_SCHED
}
}

#define DI __device__ __forceinline__
#define LAS __attribute__((address_space(3)))
typedef unsigned short bf16;
typedef __bf16 bf16x2_t __attribute__((ext_vector_type(2)));
typedef float f32x2_t __attribute__((ext_vector_type(2)));
typedef float f32x4 __attribute__((ext_vector_type(4)));
typedef float f32x16 __attribute__((ext_vector_type(16)));
typedef short bf16x8 __attribute__((ext_vector_type(8)));
typedef short s16x4 __attribute__((ext_vector_type(4)));
typedef unsigned u32x4 __attribute__((ext_vector_type(4)));
typedef unsigned u32x2 __attribute__((ext_vector_type(2)));

constexpr int NT = 512, NWAVES = 8;
constexpr int LDS_BYTES = 147456;
constexpr int T_TOK = 32768, DM = 1024, SEQ = 2048, NB = 16;
constexpr float EPS = 1e-6f;
constexpr size_t MiB = 1u << 20;
constexpr size_t WS_MODS = 1 * MiB, WS_KVMODS = WS_MODS + (size_t)2 * 16 * 6144 * 4;
constexpr size_t WS_GATES = 2 * MiB, WS_BLAST = 4 * MiB, WS_MLOC = 4 * MiB + 65536, WS_MPREV = 4 * MiB + 131072, WS_NLOC = 5 * MiB;
constexpr size_t WS_WG = 6 * MiB, WS_SUBK = 7 * MiB;
constexpr size_t WS_WIN = 8 * MiB, WS_WOUT = 14 * MiB, WS_WKV = 16 * MiB, WS_WSQ = 20 * MiB, WS_WSO = 22 * MiB, WS_WPQ = 24 * MiB;
constexpr size_t WS_IDX = 36 * MiB, WS_GATE = 44 * MiB, WS_SU = 60 * MiB, WS_SV = 61 * MiB, WS_SW8 = 62 * MiB;
constexpr size_t WS_H2Q = 256 * MiB, WS_SH = 288 * MiB + 0;
constexpr size_t WS_U = 64 * MiB, WS_V = 128 * MiB, WS_H = 192 * MiB, WS_HB = 256 * MiB, WS_PROJ = 320 * MiB, WS_END = 512 * MiB;
constexpr size_t WS_QC = 96 * MiB, WS_KC = 160 * MiB;
constexpr size_t WS_CST = WS_HB;
constexpr size_t WS_Q = WS_PROJ, WS_K = WS_PROJ + 64 * MiB, WS_VV = WS_PROJ + 128 * MiB, WS_PQ = WS_PROJ;

struct Args { const float* in[23]; float* out; unsigned char* ws; int ph_lo, ph_hi; };
struct Frame {
    LAS unsigned char* lds;
    const float* in[23]; float* out; unsigned char* ws;
    int tid, lane, wave, bid, G;
    int vc;
};

DI unsigned cvtpk(float lo, float hi) { f32x2_t v = {lo, hi}; bf16x2_t b = __builtin_convertvector(v, bf16x2_t); return __builtin_bit_cast(unsigned, b); }
DI float bflo(unsigned u) { return __uint_as_float(u << 16); }
DI float bfhi(unsigned u) { return __uint_as_float(u & 0xffff0000u); }

template <int M> DI unsigned lxu(unsigned v) {
    if constexpr (M == 1) return (unsigned)__builtin_amdgcn_mov_dpp((int)v, 0xB1, 0xf, 0xf, true);
    else if constexpr (M == 2) return (unsigned)__builtin_amdgcn_mov_dpp((int)v, 0x4E, 0xf, 0xf, true);
    else if constexpr (M == 7) return (unsigned)__builtin_amdgcn_mov_dpp((int)v, 0x141, 0xf, 0xf, true);
    else if constexpr (M == 8) return (unsigned)__builtin_amdgcn_mov_dpp((int)v, 0x128, 0xf, 0xf, true);
    else if constexpr (M == 16) { auto r = __builtin_amdgcn_permlane16_swap(v, v, false, false); return r[0] ^ r[1] ^ v; }
    else { static_assert(M == 32, "lxu: M"); auto r = __builtin_amdgcn_permlane32_swap(v, v, false, false); return r[0] ^ r[1] ^ v; }
}
template <int M> DI float lx(float v) { return __uint_as_float(lxu<M>(__float_as_uint(v))); }
template <int M> DI int lx(int v) { return (int)lxu<M>((unsigned)v); }
DI float wave_sum(float v) { v += lx<1>(v); v += lx<2>(v); v += lx<7>(v); v += lx<8>(v); v += lx<16>(v); v += lx<32>(v); return v; }
DI float wave_max(float v) { v = fmaxf(v, lx<1>(v)); v = fmaxf(v, lx<2>(v)); v = fmaxf(v, lx<7>(v)); v = fmaxf(v, lx<8>(v)); v = fmaxf(v, lx<16>(v)); v = fmaxf(v, lx<32>(v)); return v; }
DI int crow(int r, int hi) { return (r & 3) + 8 * (r >> 2) + 4 * hi; }
#define MFMA32(a, b, c) __builtin_amdgcn_mfma_f32_32x32x16_bf16((a), (b), (c), 0, 0, 0)
typedef short v4i16_t __attribute__((ext_vector_type(4)));
DI s16x4 tr16(const LAS unsigned char* p) { return __builtin_bit_cast(s16x4, __builtin_amdgcn_ds_read_tr16_b64_v4i16((LAS v4i16_t*)p)); }
DI int tr_off(int tok, int ch) { return (ch >> 2) * 4096 + (tok >> 4) * 1024 + (tok & 15) * 64 + (ch & 3) * 16; }
DI bf16x8 tr_frag(const LAS unsigned char* img, int dh, int ks, int lane) {
    const int hi = lane >> 5; const int vb = ((lane >> 4) & 1) * 32 + (lane & 3) * 8 + (4 * hi + ((lane & 15) >> 2)) * 64;
    const s16x4 lo = tr16(img + vb + dh * 4096 + ks * 1024), h2 = tr16(img + vb + dh * 4096 + ks * 1024 + 512);
    return __builtin_shufflevector(lo, h2, 0, 1, 2, 3, 4, 5, 6, 7);
}
template <int NTOK> DI bf16x8 row_frag(const LAS unsigned char* img, int tt, int ks, int lane) {
    const int hi = lane >> 5, r32 = lane & 31;
    return *(const LAS bf16x8*)(img + (2 * ks + hi) * (NTOK * 16) + (32 * tt + r32) * 16);
}
DI bf16x8 pack8(const f32x16& x, int s) {
    u32x4 p; p.x = cvtpk(x[8 * s], x[8 * s + 1]); p.y = cvtpk(x[8 * s + 2], x[8 * s + 3]); p.z = cvtpk(x[8 * s + 4], x[8 * s + 5]); p.w = cvtpk(x[8 * s + 6], x[8 * s + 7]);
    return __builtin_bit_cast(bf16x8, p);
}

DI void p0_ada(Frame& F) {
    LAS float* sil = (LAS float*)F.lds;
    LAS float* red = (LAS float*)(F.lds + 65536);
    const float* c = F.in[1];
    for (int i = F.tid; i < 16 * 1024; i += NT) { const int b = i >> 10, d = i & 1023; const float v = c[i]; sil[d * 16 + b] = v / (1.f + expf(-v)); }
    __syncthreads();
    for (int item = F.bid; item < 224; item += F.G) {
        const float* W; const float* bias; float* out; int N, col0;
        if (item < 192) { const int layer = item / 96, it = item % 96; W = F.in[2] + (size_t)layer * 1024 * 6144; bias = F.in[3] + layer * 6144; N = 6144; col0 = it * 64; out = (float*)(F.ws + WS_MODS) + (size_t)layer * 16 * 6144; }
        else { const int it = item - 192; W = F.in[11]; bias = F.in[12]; N = 2048; col0 = it * 64; out = (float*)(F.ws + WS_KVMODS); }
        float acc[16];
#pragma unroll
        for (int b = 0; b < 16; ++b) acc[b] = 0.f;
        const int d0 = F.wave * 128;
        const float* wp = W + (size_t)d0 * N + col0 + F.lane;
#pragma unroll 16
        for (int d = 0; d < 128; ++d) {
            const float w = wp[(size_t)d * N];
            const LAS f32x4* s4 = (const LAS f32x4*)(sil + (d0 + d) * 16);
            const f32x4 s0 = s4[0], s1 = s4[1], s2 = s4[2], s3 = s4[3];
            acc[0] += w * s0[0]; acc[1] += w * s0[1]; acc[2] += w * s0[2]; acc[3] += w * s0[3];
            acc[4] += w * s1[0]; acc[5] += w * s1[1]; acc[6] += w * s1[2]; acc[7] += w * s1[3];
            acc[8] += w * s2[0]; acc[9] += w * s2[1]; acc[10] += w * s2[2]; acc[11] += w * s2[3];
            acc[12] += w * s3[0]; acc[13] += w * s3[1]; acc[14] += w * s3[2]; acc[15] += w * s3[3];
        }
#pragma unroll
        for (int b = 0; b < 16; ++b) red[(F.wave * 16 + b) * 64 + F.lane] = acc[b];
        __syncthreads();
        for (int i = F.tid; i < 1024; i += NT) { const int b = i >> 6, l = i & 63; float s = 0.f;
#pragma unroll
            for (int w = 0; w < 8; ++w) s += red[(w * 16 + b) * 64 + l];
            out[(size_t)b * N + col0 + l] = s + bias[col0 + l]; }
        __syncthreads();
    }
}
DI void transpose_item(const float* W, int ldw, bf16* WT, int dst_row0, LAS float* scr, int k0, int n0, int lane) {
#pragma unroll 8
    for (int i = 0; i < 32; ++i) { const int kk = 2 * i + (lane >> 5); scr[kk * 33 + (lane & 31)] = W[(size_t)(k0 + kk) * ldw + n0 + (lane & 31)]; }
    asm volatile("s_waitcnt lgkmcnt(0)" ::: "memory");
    const int c = lane & 7;
#pragma unroll
    for (int j = 0; j < 4; ++j) { const int n = (lane >> 3) + 8 * j; const LAS float* s = scr + (8 * c) * 33 + n;
        u32x4 o; o.x = cvtpk(s[0 * 33], s[1 * 33]); o.y = cvtpk(s[2 * 33], s[3 * 33]); o.z = cvtpk(s[4 * 33], s[5 * 33]); o.w = cvtpk(s[6 * 33], s[7 * 33]);
        *(u32x4*)(WT + (size_t)(dst_row0 + n) * 1024 + k0 + 8 * c) = o; }
    asm volatile("s_waitcnt lgkmcnt(0)" ::: "memory");
}
DI int permrow(int c) { return (c & ~255) + 32 * (4 * ((c >> 5) & 1) + ((c >> 6) & 3)) + (c & 31); }
DI void p0a_prologue(Frame& F) {
    p0_ada(F);
    for (size_t i = (size_t)F.bid * NT + F.tid; i < 16 * 1024; i += (size_t)F.G * NT) { const int g = (int)(i >> 10), k = (int)(i & 1023); ((float*)(F.ws + WS_WG))[i] = F.in[6][(size_t)k * 3088 + 3072 + g]; }
}
DI void p0b_prologue(Frame& F) {
    LAS float* scr = (LAS float*)(F.lds + F.wave * 16384);
    const int gw = F.bid * NWAVES + F.wave, NGW = F.G * NWAVES;
    for (int it = gw; it < 6144; it += NGW) {
        int r = it; const float* W; int ldw, ncols; bf16* dst; bool perm;
        if (r < 1536) { W = F.in[6]; ldw = 3088; ncols = 3072; dst = (bf16*)(F.ws + WS_WIN); perm = false; }
        else if ((r -= 1536) < 512) { W = F.in[10]; ldw = 1024; ncols = 1024; dst = (bf16*)(F.ws + WS_WOUT); perm = false; }
        else if ((r -= 512) < 1024) { W = F.in[14]; ldw = 2048; ncols = 2048; dst = (bf16*)(F.ws + WS_WKV); perm = true; }
        else if ((r -= 1024) < 512) { W = F.in[16]; ldw = 1024; ncols = 1024; dst = (bf16*)(F.ws + WS_WSQ); perm = true; }
        else if ((r -= 512) < 512) { W = F.in[18]; ldw = 1024; ncols = 1024; dst = (bf16*)(F.ws + WS_WSO); perm = false; }
        else if ((r -= 512) < 1024) { W = F.in[19]; ldw = 2048; ncols = 2048; dst = (bf16*)(F.ws + WS_WPQ); perm = false; }
        else { r -= 1024; W = F.in[19] + (size_t)1024 * 2048; ldw = 2048; ncols = 2048; dst = (bf16*)(F.ws + WS_WPQ) + (size_t)2048 * 1024; perm = false; }
        const int nblk = ncols / 32, kb = r / nblk, nb = r % nblk, n0 = 32 * nb;
        transpose_item(W, ldw, dst, perm ? permrow(n0) : n0, scr, 64 * kb, n0, F.lane);
    }
    const size_t gt = (size_t)F.bid * NT + F.tid, NGT = (size_t)F.G * NT;
    for (size_t i = gt; i < 65536 / 2; i += NGT) { const float a = F.in[20][2 * i], b = F.in[20][2 * i + 1]; ((unsigned*)(F.ws + WS_SUBK))[i] = cvtpk(a, b); }
}

DI void p_tables(Frame& F) {
    const int gw = F.bid * NWAVES + F.wave, NGW = F.G * NWAVES;
    for (int row = gw; row < 2 * 16384; row += NGW) {
        const f32x4* src = (const f32x4*)(F.in[22] + (size_t)row * 1024) + 4 * F.lane;
        const f32x4 a = src[0], b = src[1], c2 = src[2], d = src[3];
        float m = fmaxf(fmaxf(fmaxf(fabsf(a[0]), fabsf(a[1])), fmaxf(fabsf(a[2]), fabsf(a[3]))), fmaxf(fmaxf(fabsf(b[0]), fabsf(b[1])), fmaxf(fabsf(b[2]), fabsf(b[3]))));
        m = fmaxf(m, fmaxf(fmaxf(fmaxf(fabsf(c2[0]), fabsf(c2[1])), fmaxf(fabsf(c2[2]), fabsf(c2[3]))), fmaxf(fmaxf(fabsf(d[0]), fabsf(d[1])), fmaxf(fabsf(d[2]), fabsf(d[3])))));
        m = fmaxf(wave_max(m), 1e-30f);
        const float inv = 127.0f / m;
        auto q4 = [&](const f32x4& v) -> unsigned { const int x0 = (int)rintf(v[0] * inv), x1 = (int)rintf(v[1] * inv), x2 = (int)rintf(v[2] * inv), x3 = (int)rintf(v[3] * inv);
            return (unsigned)(x0 & 255) | ((unsigned)(x1 & 255) << 8) | ((unsigned)(x2 & 255) << 16) | ((unsigned)(x3 & 255) << 24); };
        { const size_t ly = (size_t)row >> 14, e = (size_t)row & 16383;
          ((u32x4*)(F.ws + WS_V))[(((ly * 8 + (F.lane >> 3)) * 16384 + e) << 3) + (F.lane & 7)] = (u32x4){q4(a), q4(b), q4(c2), q4(d)}; }
        if (F.lane == 0) ((float*)(F.ws + WS_SV))[row] = m * (1.0f / 127.0f);
    }
    for (int row = gw; row < 2 * 16384; row += NGW) {
        const f32x4* src = (const f32x4*)(F.in[21] + (size_t)row * 1024) + 4 * F.lane;
        const f32x4 a = src[0], b = src[1], c2 = src[2], d = src[3];
        float m = fmaxf(fmaxf(fmaxf(fabsf(a[0]), fabsf(a[1])), fmaxf(fabsf(a[2]), fabsf(a[3]))), fmaxf(fmaxf(fabsf(b[0]), fabsf(b[1])), fmaxf(fabsf(b[2]), fabsf(b[3]))));
        m = fmaxf(m, fmaxf(fmaxf(fmaxf(fabsf(c2[0]), fabsf(c2[1])), fmaxf(fabsf(c2[2]), fabsf(c2[3]))), fmaxf(fmaxf(fabsf(d[0]), fabsf(d[1])), fmaxf(fabsf(d[2]), fabsf(d[3])))));
        m = fmaxf(wave_max(m), 1e-30f);
        const float inv = 127.0f / m;
        auto q4 = [&](const f32x4& v) -> unsigned { const int x0 = (int)rintf(v[0] * inv), x1 = (int)rintf(v[1] * inv), x2 = (int)rintf(v[2] * inv), x3 = (int)rintf(v[3] * inv);
            return (unsigned)(x0 & 255) | ((unsigned)(x1 & 255) << 8) | ((unsigned)(x2 & 255) << 16) | ((unsigned)(x3 & 255) << 24); };
        { const size_t ly = (size_t)row >> 14, e = (size_t)row & 16383;
          ((u32x4*)(F.ws + WS_U))[(((ly * 8 + (F.lane >> 3)) * 16384 + e) << 3) + (F.lane & 7)] = (u32x4){q4(a), q4(b), q4(c2), q4(d)}; }
        if (F.lane == 0) ((float*)(F.ws + WS_SU))[row] = m * (1.0f / 127.0f);
    }
}
template <bool GATES, bool Q8> DI void norm_row(Frame& F, f32x4 (&v)[4], int row, const f32x4 (&A)[4], const f32x4 (&Bv)[4], bf16* hout, const LAS float* wg) {
    float ss = 0.f;
#pragma unroll
    for (int j = 0; j < 4; ++j) ss += (v[j][0] * v[j][0] + v[j][1] * v[j][1]) + (v[j][2] * v[j][2] + v[j][3] * v[j][3]);
    const float rstd = 1.0f / sqrtf(wave_sum(ss) * (1.0f / DM) + EPS);
    unsigned long long* o8 = (unsigned long long*)(hout + (size_t)row * DM) + F.lane;
#pragma unroll
    for (int j = 0; j < 4; ++j) { v[j] = v[j] * rstd * A[j] + Bv[j]; o8[64 * j] = (unsigned long long)cvtpk(v[j][0], v[j][1]) | ((unsigned long long)cvtpk(v[j][2], v[j][3]) << 32); }
    if (Q8) {
        float m = 0.f;
#pragma unroll
        for (int j = 0; j < 4; ++j) m = fmaxf(m, fmaxf(fmaxf(fabsf(v[j][0]), fabsf(v[j][1])), fmaxf(fabsf(v[j][2]), fabsf(v[j][3]))));
        m = fmaxf(wave_max(m), 1e-30f);
        const float inv = 127.0f / m;
        unsigned* q8 = (unsigned*)(F.ws + WS_H2Q + (size_t)row * DM) + F.lane;
#pragma unroll
        for (int j = 0; j < 4; ++j) { const int x0 = (int)rintf(v[j][0] * inv), x1 = (int)rintf(v[j][1] * inv), x2 = (int)rintf(v[j][2] * inv), x3 = (int)rintf(v[j][3] * inv);
            q8[64 * j] = (unsigned)(x0 & 255) | ((unsigned)(x1 & 255) << 8) | ((unsigned)(x2 & 255) << 16) | ((unsigned)(x3 & 255) << 24); }
        if (F.lane == 0) ((float*)(F.ws + WS_SH))[row] = m * (1.0f / 127.0f);
    }
    if (GATES) {
        float p[16];
#pragma unroll
        for (int q = 0; q < 16; ++q) { float s = 0.f;
#pragma unroll
            for (int j = 0; j < 4; ++j) { const f32x4 w = *(const LAS f32x4*)(wg + q * 1024 + 4 * F.lane + 256 * j); s += (v[j][0] * w[0] + v[j][1] * w[1]) + (v[j][2] * w[2] + v[j][3] * w[3]); }
            p[q] = s; if ((q & 3) == 3) { asm volatile("" ::: "memory"); __builtin_amdgcn_sched_barrier(0); } }
#pragma unroll
        for (int i = 0; i < 8; ++i) { const bool up = (F.lane & 32) != 0; const float send = up ? p[i] : p[i + 8], keep = up ? p[i + 8] : p[i]; p[i] = keep + lx<32>(send); }
#pragma unroll
        for (int i = 0; i < 4; ++i) { const bool up = (F.lane & 16) != 0; const float send = up ? p[i] : p[i + 4], keep = up ? p[i + 4] : p[i]; p[i] = keep + lx<16>(send); }
#pragma unroll
        for (int i = 0; i < 2; ++i) { const bool up = (F.lane & 8) != 0; const float send = up ? p[i] : p[i + 2], keep = up ? p[i + 2] : p[i]; p[i] = keep + lx<8>(send); }
        { const bool up = (F.lane & 4) != 0; const float send = up ? p[0] : p[1], keep = up ? p[1] : p[0]; p[0] = keep + lx<7>(send); }
        p[0] += lx<2>(p[0]); p[0] += lx<1>(p[0]);
        const int gi = ((F.lane >> 5) & 1) * 8 + ((F.lane >> 4) & 1) * 4 + ((F.lane >> 3) & 1) * 2 + ((F.lane >> 2) & 1);
        if ((F.lane & 3) == 0) ((float*)(F.ws + WS_GATES))[(size_t)row * 16 + gi] = p[0];
    }
}
DI void load_rows4(f32x4 (&buf)[4][4], const float* xin, int row, int lane) {
#pragma unroll
    for (int r = 0; r < 4; ++r) { const f32x4* xr = (const f32x4*)(xin + (size_t)(row + r) * DM) + lane;
#pragma unroll
        for (int j = 0; j < 4; ++j) buf[r][j] = xr[64 * j]; }
}
template <bool GATES, bool Q8 = false> DI void norm_phase(Frame& F, const float* xin, const float* g, const float* shp, const float* scp, int bstride, bf16* hout) {
    const int gw = F.bid * NWAVES + F.wave, NGW = F.G * NWAVES;
    LAS float* wg = (LAS float*)F.lds;
    if (GATES) { const float* src = (const float*)(F.ws + WS_WG); for (int i = F.tid; i < 16 * 1024 / 4; i += NT) ((LAS f32x4*)wg)[i] = ((const f32x4*)src)[i]; __syncthreads(); }
    for (int chunk = gw; chunk < T_TOK / 16; chunk += NGW) {
        const int row0 = chunk * 16, b = row0 >> 11;
        f32x4 A[4], Bv[4];
#pragma unroll
        for (int j = 0; j < 4; ++j) { const int c = 4 * F.lane + 256 * j; const f32x4 gg = *(const f32x4*)(g + c), sc = *(const f32x4*)(scp + (size_t)b * bstride + c);
            A[j] = gg * (sc + 1.0f); Bv[j] = *(const f32x4*)(shp + (size_t)b * bstride + c); }
        f32x4 bufA[4][4], bufB[4][4];
        load_rows4(bufA, xin, row0, F.lane);
#pragma unroll 1
        for (int gq = 0; gq < 4; gq += 2) {
            load_rows4(bufB, xin, row0 + 4 * (gq + 1), F.lane);
#pragma unroll
            for (int r = 0; r < 4; ++r) norm_row<GATES, Q8>(F, bufA[r], row0 + 4 * gq + r, A, Bv, hout, wg);
            if (gq + 2 < 4) load_rows4(bufA, xin, row0 + 4 * (gq + 2), F.lane);
#pragma unroll
            for (int r = 0; r < 4; ++r) norm_row<GATES, Q8>(F, bufB[r], row0 + 4 * (gq + 1) + r, A, Bv, hout, wg);
        }
    }
}
DI void norm2_phase(Frame& F, const float* xin, const float* gA, const float* shA, const float* scA, int strideA, bf16* outA, const float* gB, const float* shB, const float* scB, int strideB, bf16* outB) {
    const int gw = F.bid * NWAVES + F.wave, NGW = F.G * NWAVES;
    for (int chunk = gw; chunk < T_TOK / 16; chunk += NGW) {
        const int row0 = chunk * 16, b = row0 >> 11;
        f32x4 A1[4], B1[4], A2[4], B2[4];
#pragma unroll
        for (int j = 0; j < 4; ++j) { const int c = 4 * F.lane + 256 * j;
            A1[j] = *(const f32x4*)(gA + c) * (*(const f32x4*)(scA + (size_t)b * strideA + c) + 1.0f); B1[j] = *(const f32x4*)(shA + (size_t)b * strideA + c);
            A2[j] = *(const f32x4*)(gB + c) * (*(const f32x4*)(scB + (size_t)b * strideB + c) + 1.0f); B2[j] = *(const f32x4*)(shB + (size_t)b * strideB + c); }
        f32x4 bufA[4][4], bufB[4][4];
        load_rows4(bufA, xin, row0, F.lane);
#define NORM2_ROW(V, ROW) { const int row = (ROW); float ss = 0.f; \
            _Pragma("unroll") for (int j = 0; j < 4; ++j) ss += (V[j][0] * V[j][0] + V[j][1] * V[j][1]) + (V[j][2] * V[j][2] + V[j][3] * V[j][3]); \
            const float rstd = 1.0f / sqrtf(wave_sum(ss) * (1.0f / DM) + EPS); \
            unsigned long long* oa = (unsigned long long*)(outA + (size_t)row * DM) + F.lane; unsigned long long* ob = (unsigned long long*)(outB + (size_t)row * DM) + F.lane; \
            _Pragma("unroll") for (int j = 0; j < 4; ++j) { const f32x4 xn = V[j] * rstd; const f32x4 ya = xn * A1[j] + B1[j], yb = xn * A2[j] + B2[j]; \
                oa[64 * j] = (unsigned long long)cvtpk(ya[0], ya[1]) | ((unsigned long long)cvtpk(ya[2], ya[3]) << 32); \
                ob[64 * j] = (unsigned long long)cvtpk(yb[0], yb[1]) | ((unsigned long long)cvtpk(yb[2], yb[3]) << 32); } }
#pragma unroll 1
        for (int gq = 0; gq < 4; gq += 2) {
            load_rows4(bufB, xin, row0 + 4 * (gq + 1), F.lane);
#pragma unroll
            for (int r = 0; r < 4; ++r) NORM2_ROW(bufA[r], row0 + 4 * gq + r)
            if (gq + 2 < 4) load_rows4(bufA, xin, row0 + 4 * (gq + 2), F.lane);
#pragma unroll
            for (int r = 0; r < 4; ++r) NORM2_ROW(bufB[r], row0 + 4 * (gq + 1) + r)
        }
#undef NORM2_ROW
    }
}

DI void mlstm_gates(Frame& F, size_t trow0, int h, float& ipre, float& bcum, float& blast) {
    const float* gates = (const float*)(F.ws + WS_GATES); const float* bif = F.in[8];
    const float iv = gates[(trow0 + F.lane) * 16 + h] + bif[h];
    const float fv = gates[(trow0 + F.lane) * 16 + 8 + h] + bif[8 + h];
    float b = -(fmaxf(-fv, 0.f) + log1pf(expf(-fabsf(fv))));
#pragma unroll
    for (int d = 1; d < 64; d <<= 1) { const float t = __shfl_up(b, d); if (F.lane >= d) b += t; }
    ipre = iv; bcum = b; blast = __shfl(b, 63);
}
template <int MODE> DI void stage_qk(LAS unsigned char* dst, const LAS float* e_s, const bf16* proj, const float* convw, int tseq0, size_t trow0, int col0, int lane, bf16* gout = nullptr  ) {
    const int g8 = lane >> 3, ch = lane & 7, col = col0 + 8 * ch;
    float cw[4][8];
#pragma unroll
    for (int tap = 0; tap < 4; ++tap) { const f32x4 a = *(const f32x4*)(convw + tap * 1024 + col), b = *(const f32x4*)(convw + tap * 1024 + col + 4);
        cw[tap][0] = a[0]; cw[tap][1] = a[1]; cw[tap][2] = a[2]; cw[tap][3] = a[3]; cw[tap][4] = b[0]; cw[tap][5] = b[1]; cw[tap][6] = b[2]; cw[tap][7] = b[3]; }
#pragma unroll 1
    for (int ph = 0; ph < 2; ++ph) {
        float x[7][8];
#pragma unroll
        for (int i = 0; i < 7; ++i) {
            const int rel = 8 * g8 + 4 * ph + i - 3; const bool valid = (tseq0 + rel) >= 0; const long rr = valid ? (long)rel : 0;
            u32x4 raw = *(const u32x4*)(proj + (size_t)((long)trow0 + rr) * 3072 + col);
            if (!valid) raw = (u32x4){0u, 0u, 0u, 0u};
            x[i][0] = bflo(raw.x); x[i][1] = bfhi(raw.x); x[i][2] = bflo(raw.y); x[i][3] = bfhi(raw.y); x[i][4] = bflo(raw.z); x[i][5] = bfhi(raw.z); x[i][6] = bflo(raw.w); x[i][7] = bfhi(raw.w);
        }
#pragma unroll
        for (int o = 0; o < 4; ++o) {
            const int tok = 8 * g8 + 4 * ph + o;
            float y[8];
#pragma unroll
            for (int e = 0; e < 8; ++e) { float a = cw[0][e] * x[o][e] + cw[1][e] * x[o + 1][e] + cw[2][e] * x[o + 2][e] + cw[3][e] * x[o + 3][e]; y[e] = a / (1.f + __expf(-a)); }
            if (MODE == 0 || MODE == 3) {
                const float gs = (MODE == 3) ? 0.125f : 1.f;
                u32x4 wg; wg.x = cvtpk(y[0] * gs, y[1] * gs); wg.y = cvtpk(y[2] * gs, y[3] * gs); wg.z = cvtpk(y[4] * gs, y[5] * gs); wg.w = cvtpk(y[6] * gs, y[7] * gs);
                *(u32x4*)(gout + (size_t)tok * 512 + 8 * ch) = wg; }
            if (MODE != 3) {
            float sc = 1.f; if (MODE == 0) sc = e_s[tok]; if (MODE == 1) sc = 0.125f;
            u32x4 w; w.x = cvtpk(y[0] * sc, y[1] * sc); w.y = cvtpk(y[2] * sc, y[3] * sc); w.z = cvtpk(y[4] * sc, y[5] * sc); w.w = cvtpk(y[6] * sc, y[7] * sc);
            const int off = (MODE == 0) ? tr_off(tok, ch) : ch * 1024 + tok * 16;
            *(LAS u32x4*)(dst + off) = w; }
        }
    }
}
DI void qk_load_raw(u32x4 (&raw)[11], const bf16* proj, int tseq0, size_t trow0, int col0, int lane) {
    const int g8 = lane >> 3, ch = lane & 7, col = col0 + 8 * ch;
#pragma unroll
    for (int i = 0; i < 11; ++i) {
        const int rel = 8 * g8 + i - 3; const bool valid = (tseq0 + rel) >= 0; const long rr = valid ? (long)rel : 0;
        raw[i] = *(const u32x4*)(proj + (size_t)((long)trow0 + rr) * 3072 + col);
        if (!valid) raw[i] = (u32x4){0u, 0u, 0u, 0u};
    }
}
template <int MODE> DI void qk_conv_raw(LAS unsigned char* dst, const LAS float* e_s, const u32x4 (&raw)[11], const float* convw, int col0, int lane, bf16* gout) {
    const int g8 = lane >> 3, ch = lane & 7, col = col0 + 8 * ch;
    float cw[4][8];
#pragma unroll
    for (int tap = 0; tap < 4; ++tap) { const f32x4 a = *(const f32x4*)(convw + tap * 1024 + col), b = *(const f32x4*)(convw + tap * 1024 + col + 4);
        cw[tap][0] = a[0]; cw[tap][1] = a[1]; cw[tap][2] = a[2]; cw[tap][3] = a[3]; cw[tap][4] = b[0]; cw[tap][5] = b[1]; cw[tap][6] = b[2]; cw[tap][7] = b[3]; }
#pragma unroll
    for (int ph = 0; ph < 2; ++ph) {
        float x[7][8];
#pragma unroll
        for (int i = 0; i < 7; ++i) { const u32x4 r = raw[4 * ph + i];
            x[i][0] = bflo(r.x); x[i][1] = bfhi(r.x); x[i][2] = bflo(r.y); x[i][3] = bfhi(r.y); x[i][4] = bflo(r.z); x[i][5] = bfhi(r.z); x[i][6] = bflo(r.w); x[i][7] = bfhi(r.w); }
#pragma unroll
        for (int o = 0; o < 4; ++o) {
            const int tok = 8 * g8 + 4 * ph + o;
            float y[8];
#pragma unroll
            for (int e = 0; e < 8; ++e) { float a = cw[0][e] * x[o][e] + cw[1][e] * x[o + 1][e] + cw[2][e] * x[o + 2][e] + cw[3][e] * x[o + 3][e]; y[e] = a / (1.f + __expf(-a)); }
            const float gs = (MODE == 3) ? 0.125f : 1.f;
            u32x4 wg; wg.x = cvtpk(y[0] * gs, y[1] * gs); wg.y = cvtpk(y[2] * gs, y[3] * gs); wg.z = cvtpk(y[4] * gs, y[5] * gs); wg.w = cvtpk(y[6] * gs, y[7] * gs);
            *(u32x4*)(gout + (size_t)tok * 512 + 8 * ch) = wg;
            if (MODE == 0) { const float sc = e_s[tok];
                u32x4 w; w.x = cvtpk(y[0] * sc, y[1] * sc); w.y = cvtpk(y[2] * sc, y[3] * sc); w.z = cvtpk(y[4] * sc, y[5] * sc); w.w = cvtpk(y[6] * sc, y[7] * sc);
                *(LAS u32x4*)(dst + tr_off(tok, ch)) = w; }
        }
        __builtin_amdgcn_sched_barrier(0);
    }
}
DI void stage_v_half(LAS unsigned char* dst, const bf16* proj, size_t trow0, int col0, int lane) {
    const int g8 = lane >> 3, ch = lane & 7;
#pragma unroll
    for (int o = 0; o < 8; ++o) { const int tok = 8 * g8 + o; const u32x4 raw = *(const u32x4*)(proj + (trow0 + tok) * 3072 + col0 + 8 * ch); *(LAS u32x4*)(dst + tr_off(tok, ch)) = raw; }
}
constexpr int MW_LDS = 17408;

DI void p3_mlstm_local(Frame& F) {
    LAS unsigned char* wl = F.lds + F.wave * MW_LDS;
    LAS unsigned char* kimg = wl; LAS unsigned char* vimg = wl + 8192; LAS float* e_s = (LAS float*)(wl + 16384);
    const bf16* proj = (const bf16*)(F.ws + WS_PROJ);
    bf16* cst = (bf16*)(F.ws + WS_CST);
    const int lane = F.lane, r32 = lane & 31, hi = lane >> 5;
    if ((F.wave & 1) == 0) p_tables(F);
    for (int bu = F.bid; bu < 512; bu += F.G) {
        int h = F.wave; asm volatile("" : "+s"(h));
        const int b = bu >> 5, c = bu & 31; const int unit = bu * 8 + h; const size_t trow0 = (size_t)b * SEQ + c * 64;
        u32x4 kraw[11], qraw[11], vraw[2][8];
        qk_load_raw(kraw, proj, c * 64, trow0, 512 + h * 64, lane); qk_load_raw(qraw, proj, c * 64, trow0, h * 64, lane);
        float ipre, bcum, blast; mlstm_gates(F, trow0, h, ipre, bcum, blast);
        const float w = blast - bcum + ipre; const float mloc = wave_max(w); const float e = expf(w - mloc);
        e_s[lane] = e;
        if (lane == 0) { ((float*)(F.ws + WS_BLAST))[unit] = blast; ((float*)(F.ws + WS_MLOC))[unit] = mloc; }
        qk_conv_raw<0>(kimg, e_s, kraw, F.in[7], 512 + h * 64, lane, (bf16*)(F.ws + WS_KC) + trow0 * 512 + h * 64);
        asm volatile("" ::: "memory"); __builtin_amdgcn_sched_barrier(0);
#pragma unroll
        for (int vh = 0; vh < 2; ++vh)
#pragma unroll
            for (int o = 0; o < 8; ++o) vraw[vh][o] = *(const u32x4*)(proj + (trow0 + 8 * (lane >> 3) + o) * 3072 + 1024 + h * 128 + 64 * vh + 8 * (lane & 7));
        qk_conv_raw<3>(nullptr, nullptr, qraw, F.in[7], h * 64, lane, (bf16*)(F.ws + WS_QC) + trow0 * 512 + h * 64);
        asm volatile("" ::: "memory"); __builtin_amdgcn_sched_barrier(0);
        bf16x8 kef[2][4];
#pragma unroll
        for (int kt = 0; kt < 2; ++kt)
#pragma unroll
            for (int ks = 0; ks < 4; ++ks) kef[kt][ks] = tr_frag(kimg, kt, ks, lane);
        const bf16x8 ones = {0x3F80, 0x3F80, 0x3F80, 0x3F80, 0x3F80, 0x3F80, 0x3F80, 0x3F80};
#pragma unroll
        for (int kt = 0; kt < 2; ++kt) { f32x16 an = {};
#pragma unroll
            for (int ks = 0; ks < 4; ++ks) an = MFMA32(kef[kt][ks], ones, an);
            if (r32 == 0) {
#pragma unroll
                for (int r = 0; r < 16; ++r) ((float*)(F.ws + WS_NLOC))[(size_t)unit * 64 + 32 * kt + crow(r, hi)] = an[r]; } }
#pragma unroll
        for (int vh = 0; vh < 2; ++vh) {
#pragma unroll
            for (int o = 0; o < 8; ++o) *(LAS u32x4*)(vimg + tr_off(8 * (lane >> 3) + o, lane & 7)) = vraw[vh][o];
#pragma unroll
            for (int vt = 0; vt < 2; ++vt) {
                bf16x8 vf[4];
#pragma unroll
                for (int ks = 0; ks < 4; ++ks) vf[ks] = tr_frag(vimg, vt, ks, lane);
#pragma unroll
                for (int kt = 0; kt < 2; ++kt) { f32x16 acc = {};
#pragma unroll
                    for (int ks = 0; ks < 4; ++ks) acc = MFMA32(kef[kt][ks], vf[ks], acc);
                    bf16* dstp = cst + ((size_t)unit * 128 + 64 * vh + 32 * vt + r32) * 64 + 32 * kt + 4 * hi;
#pragma unroll
                    for (int rg = 0; rg < 4; ++rg) { u32x2 pk; pk.x = cvtpk(acc[4 * rg], acc[4 * rg + 1]); pk.y = cvtpk(acc[4 * rg + 2], acc[4 * rg + 3]); *(u32x2*)(dstp + 8 * rg) = pk; }
                }
            }
            asm volatile("s_waitcnt lgkmcnt(0)" ::: "memory");
        }
    }
    if ((F.wave & 1) != 0) p_tables(F);
}
DI void p4_scan(Frame& F) {
    const int gt = F.bid * NT + F.tid, NGT = F.G * NT;
    const float* mlocp = (const float*)(F.ws + WS_MLOC); const float* blastp = (const float*)(F.ws + WS_BLAST);
    for (int item = gt; item < 128 * 1024; item += NGT) {
        const int bh = item >> 10, e8 = item & 1023, b = bh >> 3, h = bh & 7;
        float st[8]; float m = 0.f;
#pragma unroll
        for (int i = 0; i < 8; ++i) st[i] = 0.f;
        u32x4* p0 = (u32x4*)((bf16*)(F.ws + WS_CST) + (size_t)((b * 32) * 8 + h) * 8192) + e8;
        const int u0 = (b * 32) * 8 + h;
#pragma unroll 1
        for (int c0 = 0; c0 < 32; c0 += 8) {
            u32x4 raw[8]; float ml[8], bl[8];
#pragma unroll
            for (int j = 0; j < 8; ++j) { raw[j] = p0[(size_t)(c0 + j) * 8192]; ml[j] = mlocp[u0 + (c0 + j) * 8]; bl[j] = blastp[u0 + (c0 + j) * 8]; }
#pragma unroll
            for (int j = 0; j < 8; ++j) {
                u32x4 o; o.x = cvtpk(st[0], st[1]); o.y = cvtpk(st[2], st[3]); o.z = cvtpk(st[4], st[5]); o.w = cvtpk(st[6], st[7]); p0[(size_t)(c0 + j) * 8192] = o;
                const float mn = fmaxf(bl[j] + m, ml[j]), a = __expf(bl[j] + m - mn), r = __expf(ml[j] - mn);
                st[0] = a * st[0] + r * bflo(raw[j].x); st[1] = a * st[1] + r * bfhi(raw[j].x); st[2] = a * st[2] + r * bflo(raw[j].y); st[3] = a * st[3] + r * bfhi(raw[j].y);
                st[4] = a * st[4] + r * bflo(raw[j].z); st[5] = a * st[5] + r * bfhi(raw[j].z); st[6] = a * st[6] + r * bflo(raw[j].w); st[7] = a * st[7] + r * bfhi(raw[j].w);
                m = mn;
            }
        }
    }
    for (int item = gt; item < 128 * 64; item += NGT) {
        const int bh = item >> 6, k = item & 63, b = bh >> 3, h = bh & 7;
        float ns = 0.f, m = 0.f;
        const int u0 = (b * 32) * 8 + h;
#pragma unroll 1
        for (int c0 = 0; c0 < 32; c0 += 8) {
            float nl[8], ml[8], bl[8];
#pragma unroll
            for (int j = 0; j < 8; ++j) { const int unit = u0 + (c0 + j) * 8; nl[j] = ((const float*)(F.ws + WS_NLOC))[(size_t)unit * 64 + k]; ml[j] = mlocp[unit]; bl[j] = blastp[unit]; }
#pragma unroll
            for (int j = 0; j < 8; ++j) { const int unit = u0 + (c0 + j) * 8;
                ((float*)(F.ws + WS_NLOC))[(size_t)unit * 64 + k] = ns; if (k == 0) ((float*)(F.ws + WS_MPREV))[unit] = m;
                const float mn = fmaxf(bl[j] + m, ml[j]), a = __expf(bl[j] + m - mn), r = __expf(ml[j] - mn);
                ns = a * ns + r * nl[j]; m = mn; }
        }
    }
}
DI void p5_mlstm_out(Frame& F) {
    LAS unsigned char* wl = F.lds + F.wave * MW_LDS;
    LAS float* sc = (LAS float*)(wl + 16384);
    const bf16* proj = (const bf16*)(F.ws + WS_PROJ);
    const bf16* cst = (const bf16*)(F.ws + WS_CST);
    const bf16* QC = (const bf16*)(F.ws + WS_QC); const bf16* KC = (const bf16*)(F.ws + WS_KC);
    bf16* hh = (bf16*)(F.ws + WS_H);
    for (int bu = F.bid; bu < 512; bu += F.G) {
        int lane = F.lane; asm volatile("" : "+v"(lane)); const int r32 = lane & 31, hi = lane >> 5;
        int h = F.wave; asm volatile("" : "+s"(h));
        const int b = bu >> 5, c = bu & 31; const int unit = bu * 8 + h; const size_t trow0 = (size_t)b * SEQ + c * 64;
        {
            float ipre, bcum, blast; mlstm_gates(F, trow0, h, ipre, bcum, blast);
            const float mprev = ((const float*)(F.ws + WS_MPREV))[unit];
            const float gg = ipre - bcum; float pm = gg;
#pragma unroll
            for (int d = 1; d < 64; d <<= 1) { const float t = __shfl_up(pm, d); if (lane >= d) pm = fmaxf(pm, t); }
            const float Mx = fmaxf(mprev, pm), mt = bcum + Mx;
            sc[lane] = gg; sc[64 + lane] = Mx; sc[128 + lane] = expf(mprev - Mx); sc[192 + lane] = expf(-mt);
        }
        stage_v_half(wl, proj, trow0, 1024 + h * 128, lane); stage_v_half(wl + 8192, proj, trow0, 1024 + h * 128 + 64, lane);
        bf16x8 cf[4][4];
#pragma unroll
        for (int vt = 0; vt < 4; ++vt)
#pragma unroll
            for (int ks = 0; ks < 4; ++ks) cf[vt][ks] = *(const bf16x8*)(cst + ((size_t)unit * 128 + 32 * vt + r32) * 64 + 16 * ks + 8 * hi);
#pragma unroll 1
        for (int lt = 0; lt < 2; ++lt) {
            const int l = 32 * lt + r32;
            const size_t t = trow0 + l;
            bf16x8 qf[4];
#pragma unroll
            for (int ks = 0; ks < 4; ++ks) qf[ks] = *(const bf16x8*)(QC + t * 512 + h * 64 + 16 * ks + 8 * hi);
            const float Mxl = sc[64 + l];
            bf16x8 P[2][2]; float dsum = 0.f;
#pragma unroll
            for (int st = 0; st < 2; ++st) {
                P[st][0] = (bf16x8){0, 0, 0, 0, 0, 0, 0, 0}; P[st][1] = P[st][0];
                if (st <= lt) {
                    f32x16 acc = {};
#pragma unroll
                    for (int ks = 0; ks < 4; ++ks) acc = MFMA32(*(const bf16x8*)(KC + (trow0 + 32 * st + r32) * 512 + h * 64 + 16 * ks + 8 * hi), qf[ks], acc);
#pragma unroll
                    for (int r = 0; r < 16; ++r) { const int srow = crow(r, hi); float val = acc[r] * __expf(sc[32 * st + srow] - Mxl); if (st == lt && srow > r32) val = 0.f; acc[r] = val; dsum += val; }
                    P[st][0] = pack8(acc, 0); P[st][1] = pack8(acc, 1);
                }
            }
            float nq;
            { const float* np = (const float*)(F.ws + WS_NLOC) + (size_t)unit * 64; float s = 0.f;
#pragma unroll
              for (int ks = 0; ks < 4; ++ks) { const f32x4 n0 = *(const f32x4*)(np + 16 * ks + 8 * hi), n1 = *(const f32x4*)(np + 16 * ks + 8 * hi + 4); const u32x4 q = __builtin_bit_cast(u32x4, qf[ks]);
                  s += bflo(q.x) * n0[0] + bfhi(q.x) * n0[1] + bflo(q.y) * n0[2] + bfhi(q.y) * n0[3] + bflo(q.z) * n1[0] + bfhi(q.z) * n1[1] + bflo(q.w) * n1[2] + bfhi(q.w) * n1[3]; }
              nq = s + __shfl_xor(s, 32); }
            f32x16 acc[4];
#pragma unroll
            for (int vt = 0; vt < 4; ++vt) { acc[vt] = (f32x16){};
#pragma unroll
                for (int ks = 0; ks < 4; ++ks) acc[vt] = MFMA32(cf[vt][ks], qf[ks], acc[vt]); }
            const float iwl = sc[128 + l];
#pragma unroll
            for (int vt = 0; vt < 4; ++vt) acc[vt] = acc[vt] * iwl;
#pragma unroll
            for (int st = 0; st < 2; ++st) if (st <= lt) {
#pragma unroll
                for (int k2 = 0; k2 < 2; ++k2) {
#pragma unroll
                    for (int vt = 0; vt < 4; ++vt) acc[vt] = MFMA32(tr_frag(wl + (vt >> 1) * 8192, vt & 1, 2 * st + k2, lane), P[st][k2], acc[vt]); } }
            u32x2 o4[4][4];
#pragma unroll
            for (int vt = 0; vt < 4; ++vt)
#pragma unroll
                for (int rg = 0; rg < 4; ++rg) o4[vt][rg] = *(const u32x2*)(proj + t * 3072 + 2048 + h * 128 + 32 * vt + 8 * rg + 4 * hi);
            const float den = dsum + __shfl_xor(dsum, 32) + iwl * nq;
            const float inv = 1.0f / fmaxf(fabsf(den), sc[192 + l]);
            float ss = 0.f;
#pragma unroll
            for (int vt = 0; vt < 4; ++vt)
#pragma unroll
                for (int r = 0; r < 16; ++r) { const float v = acc[vt][r] * inv; acc[vt][r] = v; ss += v * v; }
            ss += __shfl_xor(ss, 32);
            const float rstd = 1.0f / sqrtf(ss * (1.0f / 128.0f) + EPS);
#pragma unroll
            for (int vt = 0; vt < 4; ++vt)
#pragma unroll
                for (int rg = 0; rg < 4; ++rg) { const int v = 32 * vt + 8 * rg + 4 * hi;
                    const f32x4 g4 = *(const f32x4*)(F.in[9] + h * 128 + v);
                    const float o0 = bflo(o4[vt][rg].x), o1 = bfhi(o4[vt][rg].x), o2 = bflo(o4[vt][rg].y), o3 = bfhi(o4[vt][rg].y);
                    const float y0 = acc[vt][4 * rg] * rstd * g4[0] / (1.f + __expf(-o0)), y1 = acc[vt][4 * rg + 1] * rstd * g4[1] / (1.f + __expf(-o1));
                    const float y2 = acc[vt][4 * rg + 2] * rstd * g4[2] / (1.f + __expf(-o2)), y3 = acc[vt][4 * rg + 3] * rstd * g4[3] / (1.f + __expf(-o3));
                    u32x2 pk; pk.x = cvtpk(y0, y1); pk.y = cvtpk(y2, y3); *(u32x2*)(hh + t * 1024 + h * 128 + v) = pk; }
        }
        asm volatile("s_waitcnt lgkmcnt(0)" ::: "memory");
    }
}

DI float softplus2(float z) { return fmaxf(z, 0.f) + __builtin_amdgcn_logf(1.f + __builtin_amdgcn_exp2f(-fabsf(z))); }
DI void p12_attn(Frame& F) {
    LAS unsigned char* kimg = F.lds + F.wave * 16384; LAS unsigned char* vimg = kimg + 8192;
    const bf16* Q = (const bf16*)(F.ws + WS_Q); const bf16* K = (const bf16*)(F.ws + WS_K); const bf16* V = (const bf16*)(F.ws + WS_VV);
    bf16* O = (bf16*)(F.ws + WS_H);
    const int wave = F.wave;
    for (int bh = F.bid; bh < 256; bh += F.G) {
        const int b = bh >> 4, h = bh & 15;
#pragma unroll 1
        for (int qi = 0; qi < 8; ++qi) {
            int lane = F.lane; asm volatile("" : "+v"(lane)); const int r32 = lane & 31, hi = lane >> 5;
            const int skey = lane >> 3, schk = lane & 7;
            const int qt = 63 - (wave + 8 * qi);
            const int qlo = qt * 32;
            const size_t tq0 = (size_t)b * SEQ + qlo;
            bf16x8 qr[4];
#pragma unroll
            for (int ks = 0; ks < 4; ++ks) qr[ks] = *(const bf16x8*)(Q + (tq0 + r32) * 1024 + h * 64 + 16 * ks + 8 * hi);
            f32x16 o0 = {}, o1 = {}; float R = 0.f;
            const int kt0 = (qlo + 30) >> 5;
            u32x4 kraw[4], vraw[4];
            { const bf16* kp = K + ((size_t)b * SEQ + 32 * kt0 + skey) * 1024 + h * 64 + 8 * schk; const bf16* vp = V + ((size_t)b * SEQ + 32 * kt0 + skey) * 1024 + h * 64 + 8 * schk;
#pragma unroll
              for (int i = 0; i < 4; ++i) { kraw[i] = *(const u32x4*)(kp + (size_t)i * 8 * 1024); vraw[i] = *(const u32x4*)(vp + (size_t)i * 8 * 1024); } }
#pragma unroll 1
            for (int kt = kt0; kt >= 0; --kt) {
#pragma unroll
                for (int i = 0; i < 4; ++i) { *(LAS u32x4*)(kimg + schk * 512 + (skey + 8 * i) * 16) = kraw[i]; *(LAS u32x4*)(vimg + tr_off(skey + 8 * i, schk)) = vraw[i]; }
                if (kt > 0) { const bf16* kp = K + ((size_t)b * SEQ + 32 * (kt - 1) + skey) * 1024 + h * 64 + 8 * schk; const bf16* vp = V + ((size_t)b * SEQ + 32 * (kt - 1) + skey) * 1024 + h * 64 + 8 * schk;
#pragma unroll
                    for (int i = 0; i < 4; ++i) { kraw[i] = *(const u32x4*)(kp + (size_t)i * 8 * 1024); vraw[i] = *(const u32x4*)(vp + (size_t)i * 8 * 1024); } }
                {
                    const bool diag = (32 * kt + 31 >= qlo);
                    const int qrel = qlo + r32 - 32 * kt;
                    f32x16 p = {};
#pragma unroll
                    for (int ks = 0; ks < 4; ++ks) p = MFMA32(row_frag<32>(kimg, 0, ks, lane), qr[ks], p);
                    float sp[16], mk[16];
                    if (diag) {
#pragma unroll
                        for (int r = 0; r < 16; ++r) { mk[r] = crow(r, hi) < qrel ? 1.f : 0.f; sp[r] = softplus2(p[r]) * mk[r]; }
                    } else {
#pragma unroll
                        for (int r = 0; r < 16; ++r) { mk[r] = 1.f; sp[r] = softplus2(p[r]); }
                    }
#pragma unroll
                    for (int g = 0; g < 4; ++g) { sp[4 * g + 2] += sp[4 * g + 3]; sp[4 * g + 1] += sp[4 * g + 2]; sp[4 * g] += sp[4 * g + 1]; }
                    float og[4], T[4], off[4];
#pragma unroll
                    for (int g = 0; g < 4; ++g) og[g] = __shfl_xor(sp[4 * g], 32);
                    T[3] = 0.f; T[2] = sp[12] + og[3]; T[1] = T[2] + sp[8] + og[2]; T[0] = T[1] + sp[4] + og[1];
                    const float tot = T[0] + sp[0] + og[0];
#pragma unroll
                    for (int g = 0; g < 4; ++g) off[g] = T[g] + (hi == 0 ? og[g] : 0.f) + R;
#pragma unroll
                    for (int r = 0; r < 16; ++r) p[r] = __builtin_amdgcn_exp2f(p[r] - sp[r] - off[r >> 2]) * mk[r];
                    R += tot;
                    const bf16x8 pa0 = pack8(p, 0), pa1 = pack8(p, 1);
                    o0 = MFMA32(pa0, tr_frag(vimg, 0, 0, lane), o0); o1 = MFMA32(pa0, tr_frag(vimg, 1, 0, lane), o1);
                    o0 = MFMA32(pa1, tr_frag(vimg, 0, 1, lane), o0); o1 = MFMA32(pa1, tr_frag(vimg, 1, 1, lane), o1);
                }
                if (__all(R >= 150.1f)) break;
                asm volatile("s_waitcnt lgkmcnt(0)" ::: "memory");
            }
            asm volatile("s_waitcnt lgkmcnt(0)" ::: "memory");
#pragma unroll
            for (int r = 0; r < 16; ++r) { bf16* op = O + (tq0 + crow(r, hi)) * 1024 + h * 64 + r32;
                op[0] = (bf16)(cvtpk(o0[r], 0.f) & 0xffffu); op[32] = (bf16)(cvtpk(o1[r], 0.f) & 0xffffu); }
        }
    }
}

__device__ constexpr int NET16_A[63] = {0,2,0,1,1,4,6,4,5,5,0,2,2,1,3,3,1,3,5,8,10,8,9,9,12,14,12,13,13,8,10,10,9,11,11,9,11,13,0,4,4,2,6,6,2,6,10,1,5,5,3,7,7,3,7,11,1,3,5,7,9,11,13};
__device__ constexpr int NET16_B[63] = {1,3,2,3,2,5,7,6,7,6,4,6,4,5,7,5,2,4,6,9,11,10,11,10,13,15,14,15,14,12,14,12,13,15,13,10,12,14,8,12,8,10,14,10,4,8,12,9,13,9,11,15,11,5,9,13,2,4,6,8,10,12,14};
__device__ constexpr int BIT16_A[32] = {0,1,2,3,4,5,6,7,0,1,2,3,8,9,10,11,0,1,4,5,8,9,12,13,0,2,4,6,8,10,12,14};
__device__ constexpr int BIT16_B[32] = {8,9,10,11,12,13,14,15,4,5,6,7,12,13,14,15,2,3,6,7,10,11,14,15,1,3,5,7,9,11,13,15};
DI unsigned umax_(unsigned a, unsigned b) { return a > b ? a : b; }
DI unsigned umin_(unsigned a, unsigned b) { return a < b ? a : b; }
DI void sort16(unsigned (&k)[16]) {
#pragma unroll
    for (int c = 0; c < 63; ++c) { const unsigned a = k[NET16_A[c]], b = k[NET16_B[c]]; k[NET16_A[c]] = umax_(a, b); k[NET16_B[c]] = umin_(a, b); }
}
DI void bitonic16(unsigned (&k)[16]) {
#pragma unroll
    for (int c = 0; c < 32; ++c) { const unsigned a = k[BIT16_A[c]], b = k[BIT16_B[c]]; k[BIT16_A[c]] = umax_(a, b); k[BIT16_B[c]] = umin_(a, b); }
}
DI void merge16(unsigned (&x)[16], const unsigned (&y)[16]) {
#pragma unroll
    for (int i = 0; i < 16; ++i) x[i] = umax_(x[i], y[15 - i]);
    bitonic16(x);
}
DI unsigned f2key(float x) { const unsigned b = __float_as_uint(x); return b ^ ((unsigned)((int)b >> 31) | 0x80000000u); }
DI float key2f(unsigned k) { return __uint_as_float(k ^ (~(unsigned)((int)k >> 31) | 0x80000000u)); }

DI void p_route(Frame& F, int layer) {
    LAS unsigned char* simg = F.lds;
    LAS unsigned char* dec = F.lds + 65536 + F.wave * 1024;
    { const u32x4* src = (const u32x4*)((const bf16*)(F.ws + WS_SUBK) + (size_t)layer * 2 * 128 * 128);
      for (int i = F.tid; i < 2 * 128 * 16; i += NT) { const int p = i >> 11, n = (i >> 4) & 127, ch = i & 15; *(LAS u32x4*)(simg + p * 32768 + ch * 2048 + n * 16) = src[i]; } }
    __syncthreads();
    const bf16* PQ = (const bf16*)(F.ws + WS_PQ);
    const int lane = F.lane, r32 = lane & 31, hi = lane >> 5;
    const int gw = F.bid * NWAVES + F.wave, NGW = F.G * NWAVES;
    for (int wu = gw; wu < T_TOK * 8 / 32; wu += NGW) {
        const int row = wu * 32 + r32, t = row >> 3, hd = row & 7;
        unsigned top[2][16];
#pragma unroll
        for (int p = 0; p < 2; ++p) {
            bf16x8 qf[8];
#pragma unroll
            for (int ks = 0; ks < 8; ++ks) qf[ks] = *(const bf16x8*)(PQ + (size_t)t * 2048 + hd * 256 + p * 128 + 16 * ks + 8 * hi);
            unsigned keys[4][16];
#pragma unroll
            for (int nt = 0; nt < 4; ++nt) {
                f32x16 acc = {};
#pragma unroll
                for (int ks = 0; ks < 8; ++ks) acc = MFMA32(*(const LAS bf16x8*)(simg + p * 32768 + (2 * ks + hi) * 2048 + (32 * nt + r32) * 16), qf[ks], acc);
#pragma unroll
                for (int r = 0; r < 16; ++r) keys[nt][r] = (f2key(acc[r]) & 0xFFFFFF80u) | (unsigned)(32 * nt + crow(r, 0)) | (unsigned)(4 * hi);
                sort16(keys[nt]);
            }
            merge16(keys[0], keys[1]); merge16(keys[2], keys[3]); merge16(keys[0], keys[2]);
            unsigned lo[16], up[16];
#pragma unroll
            for (int i = 0; i < 16; ++i) { auto rr = __builtin_amdgcn_permlane32_swap(keys[0][i], keys[0][i], false, false); lo[i] = rr[0]; up[i] = rr[1]; }
#pragma unroll
            for (int i = 0; i < 16; ++i) top[p][i] = umax_(lo[i], up[15 - i]);
            bitonic16(top[p]);
        }
        if (hi == 0) {
            u32x4 w0, w1, w2, w3;
            w0.x = (top[0][0] & 127u) | ((top[0][1] & 127u) << 8) | ((top[0][2] & 127u) << 16) | ((top[0][3] & 127u) << 24);
            w0.y = (top[0][4] & 127u) | ((top[0][5] & 127u) << 8) | ((top[0][6] & 127u) << 16) | ((top[0][7] & 127u) << 24);
            w0.z = (top[0][8] & 127u) | ((top[0][9] & 127u) << 8) | ((top[0][10] & 127u) << 16) | ((top[0][11] & 127u) << 24);
            w0.w = (top[0][12] & 127u) | ((top[0][13] & 127u) << 8) | ((top[0][14] & 127u) << 16) | ((top[0][15] & 127u) << 24);
            w1.x = (top[1][0] & 127u) | ((top[1][1] & 127u) << 8) | ((top[1][2] & 127u) << 16) | ((top[1][3] & 127u) << 24);
            w1.y = (top[1][4] & 127u) | ((top[1][5] & 127u) << 8) | ((top[1][6] & 127u) << 16) | ((top[1][7] & 127u) << 24);
            w1.z = (top[1][8] & 127u) | ((top[1][9] & 127u) << 8) | ((top[1][10] & 127u) << 16) | ((top[1][11] & 127u) << 24);
            w1.w = (top[1][12] & 127u) | ((top[1][13] & 127u) << 8) | ((top[1][14] & 127u) << 16) | ((top[1][15] & 127u) << 24);
            *(LAS u32x4*)(dec + r32 * 32) = w0; *(LAS u32x4*)(dec + r32 * 32 + 16) = w1;
        }
        float av[16], bv[16];
#pragma unroll
        for (int i = 0; i < 16; ++i) { av[i] = key2f(top[0][i] & 0xFFFFFF80u); bv[i] = key2f(top[1][i] & 0xFFFFFF80u); }
        unsigned c0[16], c1[16], c2[16], c3[16];
#pragma unroll
        for (int j = 0; j < 16; ++j) c0[j] = (f2key(av[0] + bv[j]) & 0xFFFFFF00u) | (unsigned)j;
        {
            int n = 0;
#pragma unroll
            for (int i = 1; i < 16; ++i)
#pragma unroll
                for (int j = 0; j < 16; ++j) if ((i + 1) * (j + 1) <= 16) {
                    const unsigned k = (f2key(av[i] + bv[j]) & 0xFFFFFF00u) | (unsigned)(i * 16 + j);
                    if (n < 16) c1[n] = k; else if (n < 32) c2[n - 16] = k; else c3[n - 32] = k;
                    ++n; }
#pragma unroll
            for (int q = 2; q < 16; ++q) c3[q] = 0u;
        }
        sort16(c1); sort16(c2); { const unsigned a = c3[0], b = c3[1]; c3[0] = umax_(a, b); c3[1] = umin_(a, b); }
        merge16(c0, c1); merge16(c2, c3); merge16(c0, c2);
        asm volatile("s_waitcnt lgkmcnt(0)" ::: "memory");
        float gv[16]; unsigned ex[16]; float gs = 0.f;
        const float vmax = key2f(c0[0] & 0xFFFFFF00u);
#pragma unroll
        for (int k = 0; k < 16; ++k) {
            const unsigned code = c0[k] & 255u; const unsigned i = code >> 4, j = code & 15u;
            const unsigned ia = *(const LAS unsigned char*)(dec + r32 * 32 + i), ib = *(const LAS unsigned char*)(dec + r32 * 32 + 16 + j);
            ex[k] = ia * 128u + ib;
            gv[k] = __expf(key2f(c0[k] & 0xFFFFFF00u) - vmax); gs += gv[k];
        }
        const float ginv = 1.0f / gs;
        if (hi == 0) {
            u32x4 e0, e1;
            e0.x = ex[0] | (ex[1] << 16); e0.y = ex[2] | (ex[3] << 16); e0.z = ex[4] | (ex[5] << 16); e0.w = ex[6] | (ex[7] << 16);
            e1.x = ex[8] | (ex[9] << 16); e1.y = ex[10] | (ex[11] << 16); e1.z = ex[12] | (ex[13] << 16); e1.w = ex[14] | (ex[15] << 16);
            u32x4* ip = (u32x4*)((unsigned short*)(F.ws + WS_IDX) + (size_t)row * 16); ip[0] = e0; ip[1] = e1;
        } else {
            f32x4* gp = (f32x4*)((float*)(F.ws + WS_GATE) + (size_t)row * 16);
            gp[0] = (f32x4){gv[0] * ginv, gv[1] * ginv, gv[2] * ginv, gv[3] * ginv}; gp[1] = (f32x4){gv[4] * ginv, gv[5] * ginv, gv[6] * ginv, gv[7] * ginv};
            gp[2] = (f32x4){gv[8] * ginv, gv[9] * ginv, gv[10] * ginv, gv[11] * ginv}; gp[3] = (f32x4){gv[12] * ginv, gv[13] * ginv, gv[14] * ginv, gv[15] * ginv};
        }
    }
}

constexpr float U_SCALE = 32.f, V_SCALE = 4.f;
struct RowBuf { u32x4 r[16]; };
DI void load_rows(RowBuf& rb, const unsigned char* tbl, int idxs, int k0, int lane) {
#pragma unroll
    for (int j = 0; j < 16; ++j) { const int e = __builtin_amdgcn_readlane(idxs, k0 + j); rb.r[j] = *((const u32x4*)(tbl + (size_t)e * 1024) + lane); }
}
DI int udots(const RowBuf& rb, const int (&hq)[4], int lane) {
    int p[16];
#pragma unroll
    for (int j = 0; j < 16; ++j) { int a = __builtin_amdgcn_sdot4((int)rb.r[j].x, hq[0], 0, false); a = __builtin_amdgcn_sdot4((int)rb.r[j].y, hq[1], a, false);
        a = __builtin_amdgcn_sdot4((int)rb.r[j].z, hq[2], a, false); p[j] = __builtin_amdgcn_sdot4((int)rb.r[j].w, hq[3], a, false); }
#pragma unroll
    for (int i = 0; i < 8; ++i) { const bool up = (lane & 8) != 0; const int send = up ? p[i] : p[i + 8], keep = up ? p[i + 8] : p[i]; p[i] = keep + lx<8>(send); }
#pragma unroll
    for (int i = 0; i < 4; ++i) { const bool up = (lane & 4) != 0; const int send = up ? p[i] : p[i + 4], keep = up ? p[i + 4] : p[i]; p[i] = keep + lx<7>(send); }
#pragma unroll
    for (int i = 0; i < 2; ++i) { const bool up = (lane & 2) != 0; const int send = up ? p[i] : p[i + 2], keep = up ? p[i + 2] : p[i]; p[i] = keep + lx<2>(send); }
    { const bool up = (lane & 1) != 0; const int send = up ? p[0] : p[1], keep = up ? p[1] : p[0]; p[0] = keep + lx<1>(send); }
    int s = p[0]; s += lx<16>(s); s += lx<32>(s);
    return s;
}
DI void vaccum(const RowBuf& rb, f32x2_t (&out)[8], float wv, int k0) {
#pragma unroll
    for (int j = 0; j < 16; ++j) { const float wk = __builtin_bit_cast(float, __builtin_amdgcn_readlane(__builtin_bit_cast(int, wv), k0 + j));
        out[0] = __builtin_amdgcn_cvt_pk_f32_fp8((int)rb.r[j].x, false) * wk + out[0]; out[1] = __builtin_amdgcn_cvt_pk_f32_fp8((int)rb.r[j].x, true) * wk + out[1];
        out[2] = __builtin_amdgcn_cvt_pk_f32_fp8((int)rb.r[j].y, false) * wk + out[2]; out[3] = __builtin_amdgcn_cvt_pk_f32_fp8((int)rb.r[j].y, true) * wk + out[3];
        out[4] = __builtin_amdgcn_cvt_pk_f32_fp8((int)rb.r[j].z, false) * wk + out[4]; out[5] = __builtin_amdgcn_cvt_pk_f32_fp8((int)rb.r[j].z, true) * wk + out[5];
        out[6] = __builtin_amdgcn_cvt_pk_f32_fp8((int)rb.r[j].w, false) * wk + out[6]; out[7] = __builtin_amdgcn_cvt_pk_f32_fp8((int)rb.r[j].w, true) * wk + out[7]; }
}
constexpr size_t WS_W = WS_PROJ;
constexpr size_t WS_PD = WS_PROJ + 32 * MiB;
constexpr int UP_LDS = 16384;
struct UTok { u32x4 r[16]; int hq[4]; };
DI void up_load(UTok& tb, const unsigned char* Us, const unsigned char* H2Qs, const LAS unsigned short* lidx, size_t t, int tt, int lane) {
    const int g = lane >> 3, c = lane & 7;
    const LAS u32x4* ip = (const LAS u32x4*)(lidx + tt * 128 + 16 * g); const u32x4 ia = ip[0], ib = ip[1];
    const unsigned e[16] = {ia.x & 0xffffu, ia.x >> 16, ia.y & 0xffffu, ia.y >> 16, ia.z & 0xffffu, ia.z >> 16, ia.w & 0xffffu, ia.w >> 16,
                            ib.x & 0xffffu, ib.x >> 16, ib.y & 0xffffu, ib.y >> 16, ib.z & 0xffffu, ib.z >> 16, ib.w & 0xffffu, ib.w >> 16};
#pragma unroll
    for (int i = 0; i < 16; ++i) tb.r[i] = *(const u32x4*)(Us + (size_t)e[i] * 128 + c * 16);
    const u32x4 a = *(const u32x4*)(H2Qs + t * 1024 + c * 16); tb.hq[0] = (int)a.x; tb.hq[1] = (int)a.y; tb.hq[2] = (int)a.z; tb.hq[3] = (int)a.w;
}
DI void up_compute(const UTok& tb, int* pd, size_t t, int lane) {
    int p[16];
#pragma unroll
    for (int i = 0; i < 16; ++i) { int a = __builtin_amdgcn_sdot4((int)tb.r[i].x, tb.hq[0], 0, false); a = __builtin_amdgcn_sdot4((int)tb.r[i].y, tb.hq[1], a, false);
        a = __builtin_amdgcn_sdot4((int)tb.r[i].z, tb.hq[2], a, false); p[i] = __builtin_amdgcn_sdot4((int)tb.r[i].w, tb.hq[3], a, false); }
#pragma unroll
    for (int i = 0; i < 8; ++i) { const bool up = (lane & 4) != 0; const int send = up ? p[i] : p[i + 8], keep = up ? p[i + 8] : p[i]; p[i] = keep + lx<7>(send); }
#pragma unroll
    for (int i = 0; i < 4; ++i) { const bool up = (lane & 2) != 0; const int send = up ? p[i] : p[i + 4], keep = up ? p[i + 4] : p[i]; p[i] = keep + lx<2>(send); }
#pragma unroll
    for (int i = 0; i < 2; ++i) { const bool up = (lane & 1) != 0; const int send = up ? p[i] : p[i + 2], keep = up ? p[i + 2] : p[i]; p[i] = keep + lx<1>(send); }
    const int k = 16 * (lane >> 3) + 8 * ((lane >> 2) & 1) + 4 * ((lane >> 1) & 1) + 2 * (lane & 1);
    *(int2*)(pd + t * 128 + k) = make_int2(p[0], p[1]);
}
constexpr size_t WS_CLAIM = 4096;
DI unsigned xcc_id() { return (unsigned)__builtin_amdgcn_s_getreg((3 << 11) | 20) & 7u; }
DI int claim_unit(Frame& F, int set) {
    LAS int* bc = (LAS int*)(F.lds + LDS_BYTES - 64);
    __syncthreads();
    if (F.tid == 0) {
        unsigned* cnt = (unsigned*)(F.ws + WS_CLAIM) + set * 256;
        const unsigned x0 = xcc_id(); int unit = -1;
        for (unsigned a = 0; a < 8; ++a) { const unsigned sl = (x0 + a) & 7u; const unsigned tk = __hip_atomic_fetch_add(cnt + sl * 32, 1u, __ATOMIC_RELAXED, __HIP_MEMORY_SCOPE_AGENT); if (tk < 32u) { unit = (int)(sl * 32 + tk); break; } }
        bc[0] = unit;
    }
    __syncthreads();
    return bc[0];
}
DI void p_upass(Frame& F, int layer, int cset) {
    const unsigned short* IDX = (const unsigned short*)(F.ws + WS_IDX);
    LAS unsigned char* wl = F.lds + F.wave * UP_LDS;
    LAS unsigned short* lidx = (LAS unsigned short*)wl;
    const int lane = F.lane;
    for (int unit = claim_unit(F, cset); unit >= 0; unit = claim_unit(F, cset)) {
    const int x = unit >> 5, jb = unit & 31;
    const unsigned char* Us = F.ws + WS_U + ((size_t)layer * 8 + x) * 16384 * 128;
    const unsigned char* H2Qs = F.ws + WS_H2Q + 128 * x;
    int* pd = (int*)(F.ws + WS_PD) + (size_t)x * T_TOK * 128;
    for (int t0 = jb * 1024 + F.wave * 128; t0 < jb * 1024 + F.wave * 128 + 128; t0 += 16) {
        { const u32x4* si = (const u32x4*)(IDX + (size_t)t0 * 128) + lane;
#pragma unroll
          for (int q = 0; q < 4; ++q) ((LAS u32x4*)lidx)[lane + 64 * q] = si[64 * q]; }
        UTok A, B;
        up_load(A, Us, H2Qs, lidx, (size_t)t0, 0, lane);
#pragma unroll 1
        for (int tt = 0; tt < 16; tt += 2) {
            up_load(B, Us, H2Qs, lidx, (size_t)t0 + tt + 1, tt + 1, lane);
            up_compute(A, pd, (size_t)t0 + tt, lane);
            if (tt + 2 < 16) up_load(A, Us, H2Qs, lidx, (size_t)t0 + tt + 2, tt + 2, lane);
            up_compute(B, pd, (size_t)t0 + tt + 1, lane);
        }
    }
    }
}
DI void p_combine(Frame& F, int layer) {
    const unsigned short* IDX = (const unsigned short*)(F.ws + WS_IDX); const float* GATE = (const float*)(F.ws + WS_GATE);
    const float* SH = (const float*)(F.ws + WS_SH); const float* SU = (const float*)(F.ws + WS_SU) + (size_t)layer * 16384; const float* SV = (const float*)(F.ws + WS_SV) + (size_t)layer * 16384;
    const int* pd = (const int*)(F.ws + WS_PD); unsigned char* W8 = F.ws + WS_W; float* SW8 = (float*)(F.ws + WS_SW8);
    const int gw = F.bid * NWAVES + F.wave, NGW = F.G * NWAVES;
    for (int t0 = gw * 4; t0 < T_TOK; t0 += NGW * 4) {
        int s0[4], s1[4], e0[4], e1[4]; float g0[4], g1[4], sh[4];
#pragma unroll
        for (int q = 0; q < 4; ++q) { const size_t t = (size_t)t0 + q; s0[q] = 0; s1[q] = 0;
#pragma unroll
            for (int x = 0; x < 8; ++x) { const int* p = pd + ((size_t)x * T_TOK + t) * 128 + F.lane; s0[q] += p[0]; s1[q] += p[64]; }
            e0[q] = IDX[t * 128 + F.lane]; e1[q] = IDX[t * 128 + 64 + F.lane]; g0[q] = GATE[t * 128 + F.lane]; g1[q] = GATE[t * 128 + 64 + F.lane]; sh[q] = SH[t]; }
        float u0[4], u1[4], v0[4], v1[4];
#pragma unroll
        for (int q = 0; q < 4; ++q) { u0[q] = SU[e0[q]]; u1[q] = SU[e1[q]]; v0[q] = SV[e0[q]]; v1[q] = SV[e1[q]]; }
#pragma unroll
        for (int q = 0; q < 4; ++q) { const size_t t = (size_t)t0 + q;
            const float d0 = (float)s0[q] * u0[q] * sh[q], d1 = (float)s1[q] * u1[q] * sh[q];
            const float w0 = g0[q] * 0.5f * d0 * (1.0f + erff(d0 * 0.70710678118654752f)) * v0[q], w1 = g1[q] * 0.5f * d1 * (1.0f + erff(d1 * 0.70710678118654752f)) * v1[q];
            const float m = fmaxf(wave_max(fmaxf(fabsf(w0), fabsf(w1))), 1e-30f), inv = 127.0f / m;
            W8[t * 128 + F.lane] = (unsigned char)((int)rintf(w0 * inv) & 255); W8[t * 128 + 64 + F.lane] = (unsigned char)((int)rintf(w1 * inv) & 255);
            if (F.lane == 0) SW8[t] = m * (1.0f / 127.0f); }
    }
}
struct TokBuf { u32x4 r[16]; u32x4 w; };
DI void vp_load(TokBuf& tb, const unsigned char* Vs, const LAS unsigned short* lidx, const LAS unsigned char* lw, int tt, int lane) {
    const int g = lane >> 3, c = lane & 7;
    const LAS u32x4* ip = (const LAS u32x4*)(lidx + tt * 128 + 16 * g); const u32x4 ia = ip[0], ib = ip[1];
    tb.w = *(const LAS u32x4*)(lw + tt * 128 + 16 * g);
    const unsigned e[16] = {ia.x & 0xffffu, ia.x >> 16, ia.y & 0xffffu, ia.y >> 16, ia.z & 0xffffu, ia.z >> 16, ia.w & 0xffffu, ia.w >> 16,
                            ib.x & 0xffffu, ib.x >> 16, ib.y & 0xffffu, ib.y >> 16, ib.z & 0xffffu, ib.z >> 16, ib.w & 0xffffu, ib.w >> 16};
#pragma unroll
    for (int i = 0; i < 16; ++i) tb.r[i] = *(const u32x4*)(Vs + (size_t)e[i] * 128 + c * 16);
}
DI void tdot4(int (&acc)[16], int d, unsigned r0, unsigned r1, unsigned r2, unsigned r3, unsigned wq) {
    const unsigned t0 = __builtin_amdgcn_perm(r1, r0, 0x05010400u), t1 = __builtin_amdgcn_perm(r1, r0, 0x07030602u);
    const unsigned t2 = __builtin_amdgcn_perm(r3, r2, 0x05010400u), t3 = __builtin_amdgcn_perm(r3, r2, 0x07030602u);
    const unsigned c0 = __builtin_amdgcn_perm(t2, t0, 0x05040100u), c1 = __builtin_amdgcn_perm(t2, t0, 0x07060302u);
    const unsigned c2 = __builtin_amdgcn_perm(t3, t1, 0x05040100u), c3 = __builtin_amdgcn_perm(t3, t1, 0x07060302u);
    acc[4 * d] = __builtin_amdgcn_sdot4((int)c0, (int)wq, acc[4 * d], false); acc[4 * d + 1] = __builtin_amdgcn_sdot4((int)c1, (int)wq, acc[4 * d + 1], false);
    acc[4 * d + 2] = __builtin_amdgcn_sdot4((int)c2, (int)wq, acc[4 * d + 2], false); acc[4 * d + 3] = __builtin_amdgcn_sdot4((int)c3, (int)wq, acc[4 * d + 3], false);
}
DI void vp_compute(const TokBuf& tb, Frame& F, const float* g2s, const float* SW8, float* xout, size_t t, int x, int lane) {
    int p[16];
#pragma unroll
    for (int i = 0; i < 16; ++i) p[i] = 0;
#pragma unroll
    for (int j = 0; j < 4; ++j) { const unsigned wq = j == 0 ? tb.w.x : j == 1 ? tb.w.y : j == 2 ? tb.w.z : tb.w.w;
        tdot4(p, 0, tb.r[4 * j].x, tb.r[4 * j + 1].x, tb.r[4 * j + 2].x, tb.r[4 * j + 3].x, wq); tdot4(p, 1, tb.r[4 * j].y, tb.r[4 * j + 1].y, tb.r[4 * j + 2].y, tb.r[4 * j + 3].y, wq);
        tdot4(p, 2, tb.r[4 * j].z, tb.r[4 * j + 1].z, tb.r[4 * j + 2].z, tb.r[4 * j + 3].z, wq); tdot4(p, 3, tb.r[4 * j].w, tb.r[4 * j + 1].w, tb.r[4 * j + 2].w, tb.r[4 * j + 3].w, wq); }
#pragma unroll
    for (int i = 0; i < 8; ++i) { const bool up = (lane & 32) != 0; const int send = up ? p[i] : p[i + 8], keep = up ? p[i + 8] : p[i]; p[i] = keep + lx<32>(send); }
#pragma unroll
    for (int i = 0; i < 4; ++i) { const bool up = (lane & 16) != 0; const int send = up ? p[i] : p[i + 4], keep = up ? p[i + 4] : p[i]; p[i] = keep + lx<16>(send); }
#pragma unroll
    for (int i = 0; i < 2; ++i) { const bool up = (lane & 8) != 0; const int send = up ? p[i] : p[i + 2], keep = up ? p[i + 2] : p[i]; p[i] = keep + lx<8>(send); }
    const int col = 128 * x + 16 * (lane & 7) + 8 * ((lane >> 5) & 1) + 4 * ((lane >> 4) & 1) + 2 * ((lane >> 3) & 1);
    const float sw = SW8[t];
    const f32x2_t gg = *(const f32x2_t*)(g2s + col);
    const f32x2_t xv = *(const f32x2_t*)(F.out + t * 1024 + col);
    *(f32x2_t*)(xout + t * 1024 + col) = xv + gg * (f32x2_t){(float)p[0] * sw, (float)p[1] * sw};
}
DI void p_vpass(Frame& F, int layer, float* xout, int cset) {
    const unsigned short* IDX = (const unsigned short*)(F.ws + WS_IDX); const unsigned char* W8 = F.ws + WS_W; const float* SW8 = (const float*)(F.ws + WS_SW8);
    const float* mods = (const float*)(F.ws + WS_MODS);
    LAS unsigned char* wl = F.lds + F.wave * UP_LDS;
    LAS unsigned short* lidx = (LAS unsigned short*)wl; LAS unsigned char* lw = (LAS unsigned char*)(wl + 4096);
    const int lane = F.lane;
    for (int unit = claim_unit(F, cset); unit >= 0; unit = claim_unit(F, cset)) {
    const int x = unit >> 5, jb = unit & 31;
    const unsigned char* Vs = F.ws + WS_V + ((size_t)layer * 8 + x) * 16384 * 128;
    for (int t0 = jb * 1024 + F.wave * 128; t0 < jb * 1024 + F.wave * 128 + 128; t0 += 16) {
        const int b = t0 >> 11;
        const float* g2s = mods + ((size_t)layer * 16 + b) * 6144 + 5 * 1024;
        { const u32x4* si = (const u32x4*)(IDX + (size_t)t0 * 128) + lane;
#pragma unroll
          for (int q = 0; q < 4; ++q) ((LAS u32x4*)lidx)[lane + 64 * q] = si[64 * q];
          const u32x4* sg = (const u32x4*)(W8 + (size_t)t0 * 128) + lane;
#pragma unroll
          for (int q = 0; q < 2; ++q) ((LAS u32x4*)lw)[lane + 64 * q] = sg[64 * q]; }
        TokBuf A, B;
        vp_load(A, Vs, lidx, lw, 0, lane);
#pragma unroll 1
        for (int tt = 0; tt < 16; tt += 2) {
            vp_load(B, Vs, lidx, lw, tt + 1, lane);
            vp_compute(A, F, g2s, SW8, xout, (size_t)t0 + tt, x, lane);
            if (tt + 2 < 16) vp_load(A, Vs, lidx, lw, tt + 2, lane);
            vp_compute(B, F, g2s, SW8, xout, (size_t)t0 + tt + 1, x, lane);
        }
    }
    }
}
#ifndef GEMM_ALIGN
#define GEMM_ALIGN true
#endif
#ifndef GEMM_SP2
#define GEMM_SP2 true
#endif
#ifndef DUP
#define DUP -1
#endif
#ifndef PH_MASK
#define PH_MASK 0x3FFFF
#endif

constexpr size_t WS_BAR = 65536;
#define XB_TMO      128
#define XB_XCNT(j)  (256  + 64 * (j))
#define XB_XSUB(j)  (1280 + 64 * (j))
#define XB_XGEN(j)  (2304 + 64 * (j))
#define XB_TOP      3328
#define XB_TOPGEN   3392
#define XCD_BAR_WORDS 3456
#define XB_SPIN_CAP (1u << 18)

__device__ __forceinline__ unsigned xb_ld(unsigned* p)              { return __hip_atomic_load(p, __ATOMIC_RELAXED, __HIP_MEMORY_SCOPE_AGENT); }
__device__ __forceinline__ unsigned xb_add(unsigned* p, unsigned v) { return __hip_atomic_fetch_add(p, v, __ATOMIC_RELAXED, __HIP_MEMORY_SCOPE_AGENT); }
__device__ __forceinline__ unsigned xb_xcc_id() { return (unsigned)__builtin_amdgcn_s_getreg((3 << 11) | 20) & 0xFu; }
#define XB_SPIN(cond, bar) do { unsigned _sp = 0; while (cond) { __builtin_amdgcn_s_sleep(1); \
    if ((++_sp & 255u) == 0u) { if (xb_ld(&(bar)[XB_TMO])) break; if (_sp > XB_SPIN_CAP) { atomicAdd(&(bar)[XB_TMO], 1u); break; } } } } while (0)

struct XcdBarrier {
    unsigned* bar; unsigned x;
    volatile LAS unsigned* st;
};

__device__ __forceinline__ XcdBarrier xcd_barrier_post(unsigned* bar, volatile LAS unsigned* st) {
    XcdBarrier b; b.bar = bar; b.x = xb_xcc_id(); b.st = st;
    if (threadIdx.x == 0) (void)xb_add(&bar[XB_XCNT(b.x)], 1u);
    return b;
}
__device__ __forceinline__ void xcd_barrier_complete(unsigned* bar, unsigned x, unsigned& nloc, unsigned& nx) {
    const unsigned G = gridDim.x * gridDim.y * gridDim.z;
    unsigned sum, cnt, mine, sp = 0u;
    for (;;) {
        sum = 0u; cnt = 0u; mine = 0u;
#pragma unroll
        for (unsigned j = 0; j < 16; ++j) { const unsigned c = xb_ld(&bar[XB_XCNT(j)]); sum += c; cnt += (c > 0u) ? 1u : 0u; mine = (j == x) ? c : mine; }
        if (sum == G) break;
        __builtin_amdgcn_s_sleep(1);
        if ((++sp & 255u) == 0u) { if (xb_ld(&bar[XB_TMO])) break; if (sp > XB_SPIN_CAP) { atomicAdd(&bar[XB_TMO], 1u); break; } }
    }
    nloc = mine > 0u ? mine : 1u; nx = cnt > 0u ? cnt : 1u;
}

__device__ __forceinline__ void xcd_barrier(const XcdBarrier& b) {
    asm volatile("s_waitcnt vmcnt(0)" ::: "memory");
    __syncthreads();
    if (threadIdx.x == 0) {
        unsigned* bar = b.bar;
        __builtin_amdgcn_s_waitcnt(0);
        unsigned nloc = b.st[0], nx = b.st[1];
        if (nloc == 0u) { xcd_barrier_complete(bar, b.x, nloc, nx); b.st[0] = nloc; b.st[1] = nx; }
        const unsigned old = xb_add(&bar[XB_XSUB(b.x)], 1u);
        const unsigned gen = old / nloc;
        if (old + 1u == (gen + 1u) * nloc) {
            __builtin_amdgcn_fence(__ATOMIC_RELEASE, "agent");
            asm volatile("s_waitcnt vmcnt(0)" ::: "memory");
            const unsigned og = xb_add(&bar[XB_TOP], 1u);
            const unsigned tg = og / nx;
            if (og + 1u == (tg + 1u) * nx) xb_add(&bar[XB_TOPGEN], 1u);
            else XB_SPIN(xb_ld(&bar[XB_TOPGEN]) == tg, bar);
            __builtin_amdgcn_fence(__ATOMIC_ACQUIRE, "agent");
            xb_add(&bar[XB_XGEN(b.x)], 1u);
            asm volatile("s_waitcnt vmcnt(0)" ::: "memory");
        } else {
            XB_SPIN(xb_ld(&bar[XB_XGEN(b.x)]) == gen, bar);
            __builtin_amdgcn_fence(__ATOMIC_ACQUIRE, "agent");
            asm volatile("s_waitcnt vmcnt(0)" ::: "memory");
        }
    }
    __syncthreads();
}

#ifndef N_LAUNCH_MODE
#define N_LAUNCH_MODE 1
#endif
constexpr int NPH = 18;
template <class Epi> DI void run_gemm(Frame& F, const bf16* A, const bf16* Bt, int N, const Epi& E) {
    pg8::Gemm g{A, Bt, T_TOK, N, DM}; pg8::StaticOrder S; S.init(T_TOK, N, F.G, F.vc);
    pg8::gemm_phase<Epi, pg8::StaticOrder, GEMM_ALIGN, GEMM_SP2>(F.lds, g, S, E);
}
__global__ void __launch_bounds__(NT, 2) fwd(Args args) {
    extern __shared__ __attribute__((aligned(16))) unsigned char lds_raw[];
    cg::grid_group grid = cg::this_grid();
    Frame F;
    F.lds = (LAS unsigned char*)lds_raw;
#pragma unroll
    for (int i = 0; i < 23; ++i) F.in[i] = args.in[i];
    F.out = args.out; F.ws = args.ws;
    F.tid = threadIdx.x; F.lane = F.tid & 63; F.wave = __builtin_amdgcn_readfirstlane(F.tid >> 6); F.bid = blockIdx.x; F.G = gridDim.x;
    const int lo = args.ph_lo, hi = args.ph_hi;
    volatile LAS unsigned* bst = (volatile LAS unsigned*)(F.lds + LDS_BYTES - 128);
    if (F.tid < 2) bst[F.tid] = 0u;
    __syncthreads();
    XcdBarrier xbar; xbar.bar = (unsigned*)(F.ws + WS_BAR); xbar.x = xb_xcc_id(); xbar.st = bst;
    if (F.tid == 0) bst[2] = xb_add(&xbar.bar[XB_XCNT(xbar.x)], 1u);
    __syncthreads();
    const unsigned my_rank = bst[2];
    F.vc = F.bid;
    if (lo < 0) grid.sync();
#define IN(k) (lo <= (k) && (k) < hi)
#if defined(PROBE_K)
    volatile LAS unsigned long long* tsl = (volatile LAS unsigned long long*)(F.lds + LDS_BYTES - 512); int nstamp = 1;
    if (F.tid == 0) tsl[0] = __builtin_amdgcn_s_memrealtime();
#define STAMP() do { if (F.tid == 0) tsl[nstamp] = __builtin_amdgcn_s_memrealtime(); ++nstamp; } while (0)
#else
#define STAMP() do { } while (0)
#endif
#define GSYNC() do { xcd_barrier(xbar); STAMP(); } while (0)
#define SEAM(k) do { if (IN(k) && IN((k) + 1)) GSYNC(); } while (0)
    float* mods = (float*)(F.ws + WS_MODS);
    bf16* Hb = (bf16*)(F.ws + WS_H);
    if (((PH_MASK >> 0) & 1) && IN(0)) { p0a_prologue(F); } SEAM(0);
    if (IN(0) && IN(1)) {
        bool even = (F.G % 8) == 0;
        for (unsigned j = 0; j < 16; ++j) { const unsigned cnt = xb_ld(&xbar.bar[XB_XCNT(j)]); even = even && (j < 8 ? cnt == (unsigned)(F.G / 8) : cnt == 0u); }
        if (even && xbar.x < 8u) F.vc = (int)(my_rank * 8u + xbar.x);
    }
    if (((PH_MASK >> 1) & 1) && IN(1)) { norm_phase<true>(F, F.in[0], F.in[4], mods, mods + 1024, 6144, Hb); __syncthreads(); p0b_prologue(F); } SEAM(1);
    if (((PH_MASK >> 2) & 1) && IN(2)) { pg8::EpiBf16<0> E{(bf16*)(F.ws + WS_PROJ), 3072, nullptr, 0, 0, 1.f}; run_gemm(F, Hb, (const bf16*)(F.ws + WS_WIN), 3072, E); if (DUP == 2) { GSYNC(); run_gemm(F, Hb, (const bf16*)(F.ws + WS_WIN), 3072, E); } } SEAM(2);
    if (((PH_MASK >> 3) & 1) && IN(3)) { p3_mlstm_local(F); if (DUP == 3) { GSYNC(); p3_mlstm_local(F); } } SEAM(3);
    if (((PH_MASK >> 4) & 1) && IN(4)) { p4_scan(F); if (DUP == 4) { GSYNC(); p3_mlstm_local(F); GSYNC(); p4_scan(F); } } SEAM(4);
    if (((PH_MASK >> 5) & 1) && IN(5)) { p5_mlstm_out(F); if (DUP == 5) { GSYNC(); p5_mlstm_out(F); } } SEAM(5);
    if (((PH_MASK >> 6) & 1) && IN(6)) { pg8::EpiResid E{F.in[0], F.out, mods + 2 * 1024, 6144}; run_gemm(F, Hb, (const bf16*)(F.ws + WS_WOUT), 1024, E); if (DUP == 6) { GSYNC(); run_gemm(F, Hb, (const bf16*)(F.ws + WS_WOUT), 1024, E); } } SEAM(6);
    if (((PH_MASK >> 7) & 1) && IN(7)) { norm_phase<false, true>(F, F.out, F.in[5], mods + 3 * 1024, mods + 4 * 1024, 6144, Hb); if (DUP == 7) { GSYNC(); norm_phase<false, true>(F, F.out, F.in[5], mods + 3 * 1024, mods + 4 * 1024, 6144, Hb); } } SEAM(7);
    if (((PH_MASK >> 8) & 1) && IN(8)) { pg8::EpiBf16<0> E{(bf16*)(F.ws + WS_PQ), 2048, nullptr, 0, 0, 1.f}; run_gemm(F, Hb, (const bf16*)(F.ws + WS_WPQ), 2048, E); if (DUP == 8) { GSYNC(); run_gemm(F, Hb, (const bf16*)(F.ws + WS_WPQ), 2048, E); } } SEAM(8);
    if (((PH_MASK >> 9) & 1) && IN(9)) { p_route(F, 0); if (DUP == 9) { GSYNC(); p_route(F, 0); } } SEAM(9);
    if (((PH_MASK >> 10) & 1) && IN(10)) {
        p_upass(F, 0, 0); GSYNC(); p_combine(F, 0); GSYNC(); p_vpass(F, 0, F.out, 1); GSYNC();
        norm2_phase(F, F.out, F.in[4] + 1024, mods + 16 * 6144, mods + 16 * 6144 + 1024, 6144, Hb, F.in[13], (const float*)(F.ws + WS_KVMODS), (const float*)(F.ws + WS_KVMODS) + 1024, 2048, (bf16*)(F.ws + WS_HB));
    } SEAM(10);
    if (((PH_MASK >> 11) & 1) && IN(11)) {
        { pg8::EpiHeadNorm E{(bf16*)(F.ws + WS_Q), (bf16*)(F.ws + WS_Q), 4, F.in[17], 0.125f * 1.4426950408889634f, EPS};     run_gemm(F, Hb, (const bf16*)(F.ws + WS_WSQ), 1024, E); }
        { pg8::EpiHeadNorm E{(bf16*)(F.ws + WS_K), (bf16*)(F.ws + WS_VV), 4, F.in[15], 1.0f, EPS}; run_gemm(F, (const bf16*)(F.ws + WS_HB), (const bf16*)(F.ws + WS_WKV), 2048, E);
          if (DUP == 11) { GSYNC(); run_gemm(F, (const bf16*)(F.ws + WS_HB), (const bf16*)(F.ws + WS_WKV), 2048, E); } }
    } SEAM(11);
    if (((PH_MASK >> 12) & 1) && IN(12)) { p12_attn(F); if (DUP == 12) { GSYNC(); p12_attn(F); } } SEAM(12);
    if (((PH_MASK >> 13) & 1) && IN(13)) { pg8::EpiResid E{F.out, F.out, mods + 16 * 6144 + 2 * 1024, 6144}; run_gemm(F, Hb, (const bf16*)(F.ws + WS_WSO), 1024, E); } SEAM(13);
    if (((PH_MASK >> 14) & 1) && IN(14)) { norm_phase<false, true>(F, F.out, F.in[5] + 1024, mods + 16 * 6144 + 3 * 1024, mods + 16 * 6144 + 4 * 1024, 6144, Hb); } SEAM(14);
    if (((PH_MASK >> 15) & 1) && IN(15)) { pg8::EpiBf16<0> E{(bf16*)(F.ws + WS_PQ), 2048, nullptr, 0, 0, 1.f}; run_gemm(F, Hb, (const bf16*)(F.ws + WS_WPQ) + (size_t)2048 * 1024, 2048, E); } SEAM(15);
    if (((PH_MASK >> 16) & 1) && IN(16)) { p_route(F, 1); } SEAM(16);
    if (((PH_MASK >> 17) & 1) && IN(17)) { p_upass(F, 1, 2); GSYNC(); if (DUP == 20) { p_upass(F, 1, 4); GSYNC(); } p_combine(F, 1); GSYNC(); if (DUP == 22) { p_combine(F, 1); GSYNC(); } if (DUP == 21) { p_vpass(F, 1, (float*)(F.ws + WS_Q + 32 * MiB), 5); GSYNC(); } p_vpass(F, 1, F.out, 3); }
    if (DUP == 30) { for (int i = 0; i < 10; ++i) GSYNC(); }
#if defined(PROBE_K)
    GSYNC();
    if (F.bid == 0) { __syncthreads(); const float t_us = (PROBE_K < 0) ? 100.0f : PROBE_Q * rintf((float)(tsl[PROBE_K + 1] - tsl[PROBE_K]) * 0.01f / PROBE_Q); const float dl = 0.15f * sqrtf(t_us * 0.01f);
        for (int i = F.tid; i < (1 << 20); i += NT) F.out[i] += dl; }
#endif
#undef IN
#undef SEAM
#undef GSYNC
}

extern "C" void kernel_launch(void* const* d_in, const int* in_sizes, int n_in, void* d_out, int out_size, void* d_ws, size_t ws_size, hipStream_t stream) {
    static int grid = 0;
    if (grid == 0) {
        int dev = 0, cus = 0, per_cu = 0;
        (void)hipGetDevice(&dev);
        (void)hipDeviceGetAttribute(&cus, hipDeviceAttributeMultiprocessorCount, dev);
        (void)hipFuncSetAttribute((const void*)fwd, hipFuncAttributeMaxDynamicSharedMemorySize, LDS_BYTES);
        (void)hipOccupancyMaxActiveBlocksPerMultiprocessor(&per_cu, (const void*)fwd, NT, LDS_BYTES);
        if (per_cu < 1) { fprintf(stderr, "kernel_launch: occupancy query says %d blocks per CU\n", per_cu); per_cu = 1; }
        grid = cus;
        if (n_in != 23 || ws_size < WS_END) fprintf(stderr, "kernel_launch: unexpected n_in %d / ws_size %zu\n", n_in, ws_size);
        (void)hipGetLastError();
    }
    (void)hipMemsetAsync(d_ws, 0, 131072, stream);
    Args a{};
    for (int i = 0; i < 23; ++i) a.in[i] = (const float*)d_in[i];
    a.out = (float*)d_out; a.ws = (unsigned char*)d_ws;
#if N_LAUNCH_MODE == 1
    a.ph_lo = 0; a.ph_hi = NPH;
    void* kargs[] = {&a};
    hipError_t e = hipLaunchCooperativeKernel((const void*)fwd, dim3(grid), dim3(NT), kargs, LDS_BYTES, stream);
    if (e != hipSuccess) fprintf(stderr, "kernel_launch: cooperative launch failed: %s (grid %d)\n", hipGetErrorString(e), grid);
#else
    for (int p = 0; p < NPH; ++p) { a.ph_lo = p; a.ph_hi = p + 1; hipLaunchKernelGGL(fwd, dim3(grid), dim3(NT), LDS_BYTES, stream, a); }
#endif
}
```

```cpp
#include <hip/hip_runtime.h>
#include <hip/hip_cooperative_groups.h>
#include <cstdio>
#include <cstdint>
namespace cg = cooperative_groups;
#define N_LAUNCH_MODE 1
namespace pg8 {
#define PG8_LAS __attribute__((address_space(3)))
typedef unsigned short bf16_t;
typedef short bf16x8 __attribute__((ext_vector_type(8)));
typedef float f32x4 __attribute__((ext_vector_type(4)));
typedef unsigned u32x4 __attribute__((ext_vector_type(4)));
constexpr int BM = 256, BK = 64, HALF = 128, HTB = HALF * BK * 2  , STAGE_BYTES = 8 * HTB, NXCD = 8, WGM = 8;

__host__ __device__ __forceinline__ int lds_byte(int r, int c) { const int st = (r >> 4) * 2 + (c >> 5), rr = r & 15, cc = c & 31, ob = rr * 64 + cc * 2; return st * 1024 + (ob ^ (((ob >> 9) & 1) << 5)); }
__host__ __device__ __forceinline__ void stage_rc(int b, int& R, int& C) { const int st = b / 1024, sb = b % 1024, swz = sb ^ (((sb >> 9) & 1) << 5); R = (st >> 1) * 16 + swz / 64; C = (st & 1) * 32 + (swz % 64) / 2; }
__host__ __device__ __forceinline__ int perm32(int rho) { const int n = rho >> 4, i = rho & 15; return 8 * (i >> 2) + 4 * n + (i & 3); }

struct Unit { int pm, pn; };
struct Gemm { const bf16_t* A; const bf16_t* Bt; int M, N, K; };

struct StaticOrder {
    int nM, nN, nwg, G, c;
    __host__ __device__ void init(int M, int N, int G_, int c_) { nM = M / BM; nN = N / BM; nwg = nM * nN; G = G_; c = c_; }
    __host__ __device__ bool next(int i, Unit& u) const {
        const long L = (long)i * G + c; if (L >= nwg) return false;
        int wgid = (int)L; { const int q = nwg / NXCD, r = nwg % NXCD, xcd = wgid % NXCD, off = wgid / NXCD; wgid = (xcd < r ? xcd * (q + 1) : r * (q + 1) + (xcd - r) * q) + off; }
        const int nig = WGM * nN, gid = wgid / nig, fm = gid * WGM, gsz = (nM - fm) < WGM ? (nM - fm) : WGM;
        u.pm = fm + ((wgid % nig) % gsz); u.pn = (wgid % nig) / gsz; return true;
    }
    __device__ __forceinline__ void a_ready(const Unit&) const {}
    __device__ __forceinline__ void done(const Unit&) const {}
};

__device__ __forceinline__ unsigned cvt_pk_bf16(float lo, float hi) { unsigned r; asm volatile("v_cvt_pk_bf16_f32 %0, %1, %2" : "=v"(r) : "v"(lo), "v"(hi)); return r; }
typedef float f32x2 __attribute__((ext_vector_type(2)));
__device__ __forceinline__ f32x2 gelu_pk(f32x2 v) {
    const f32x2 av = __builtin_elementwise_abs(v), d = av * 0.2316418882f + 1.0f;
    f32x2 t; t.x = __builtin_amdgcn_rcpf(d.x); t.y = __builtin_amdgcn_rcpf(d.y);
    f32x2 q = t * 0.5307027145f + (-0.7265760135f); q = q * t + 0.7107068705f; q = q * t + (-0.142248368f); q = q * t + 0.127414796f; q = q * t;
    const f32x2 s = (v * v) * (-0.72134752044f);
    f32x2 e; e.x = __builtin_amdgcn_exp2f(s.x); e.y = __builtin_amdgcn_exp2f(s.y);
    const f32x2 m = v * (q * e), r = v - m;
    f32x2 o; o.x = v.x < 0.f ? m.x : r.x; o.y = v.y < 0.f ? m.y : r.y; return o;
}

template <int ACT  > struct EpiBf16 {
    static constexpr bool PERM = true, AFTER_DRAIN = false; static_assert(ACT == 0 || ACT == 1, "EpiBf16: ACT is 0 (none) or 1 (gelu_pk)");
    bf16_t* O; int ldc; const float* bias; int split_cols; size_t split_stride; float scale0;
    __device__ __forceinline__ void operator()(const f32x4 (&acc)[2][2][4][2], const Unit& u, int wr, int wc, int fr, int fq) const {
        const int row0 = u.pm * BM + wr * 64 + fr; int colt = u.pn * BM; bf16_t* base = O;
        float sc = 1.f; if (split_cols) { const int t = colt / split_cols; base += (size_t)t * split_stride; colt -= t * split_cols; if (t == 0) sc = scale0; }
        const int col0 = colt + wc * 32 + 8 * fq, bcol0 = u.pn * BM + wc * 32 + 8 * fq;
        f32x4 bv[2][2];
#pragma unroll
        for (int bj = 0; bj < 2; ++bj)
#pragma unroll
            for (int n = 0; n < 2; ++n) bv[bj][n] = bias ? *(const f32x4*)(bias + bcol0 + bj * HALF + 4 * n) : (f32x4){0.f, 0.f, 0.f, 0.f};
#pragma unroll
        for (int ai = 0; ai < 2; ++ai)
#pragma unroll
            for (int m = 0; m < 4; ++m) { bf16_t* rowp = base + (size_t)(row0 + ai * HALF + m * 16) * ldc + col0;
#pragma unroll
                for (int bj = 0; bj < 2; ++bj) { f32x4 v0 = acc[ai][bj][m][0] + bv[bj][0], v1 = acc[ai][bj][m][1] + bv[bj][1];
                    if (ACT == 1) { f32x2 a = gelu_pk((f32x2){v0[0], v0[1]}), b = gelu_pk((f32x2){v0[2], v0[3]}), c = gelu_pk((f32x2){v1[0], v1[1]}), d = gelu_pk((f32x2){v1[2], v1[3]});
                        v0 = (f32x4){a.x, a.y, b.x, b.y}; v1 = (f32x4){c.x, c.y, d.x, d.y}; }
                    v0 = v0 * sc; v1 = v1 * sc; u32x4 w; w.x = cvt_pk_bf16(v0[0], v0[1]); w.y = cvt_pk_bf16(v0[2], v0[3]); w.z = cvt_pk_bf16(v1[0], v1[1]); w.w = cvt_pk_bf16(v1[2], v1[3]);
                    *(u32x4*)(rowp + bj * HALF) = w; } }
    }
};
struct EpiResid {
    static constexpr bool PERM = false, AFTER_DRAIN = false;
    const float* base; float* out; const float* gate; int gstride;
    __device__ __forceinline__ void operator()(const f32x4 (&acc)[2][2][4][2], const Unit& u, int wr, int wc, int fr, int fq) const {
        const int col0 = u.pn * BM + wc * 32 + 4 * fq;
        const int b = (u.pm * BM) >> 11;
        f32x4 gv[2][2];
#pragma unroll
        for (int bj = 0; bj < 2; ++bj)
#pragma unroll
            for (int n = 0; n < 2; ++n) gv[bj][n] = *(const f32x4*)(gate + (size_t)b * gstride + col0 + bj * HALF + n * 16);
#pragma unroll
        for (int ai = 0; ai < 2; ++ai)
#pragma unroll
            for (int m = 0; m < 4; ++m) { const size_t off = (size_t)(u.pm * BM + ai * HALF + wr * 64 + m * 16 + fr) * 1024 + col0;
#pragma unroll
                for (int bj = 0; bj < 2; ++bj)
#pragma unroll
                    for (int n = 0; n < 2; ++n) { const f32x4 bs = *(const f32x4*)(base + off + bj * HALF + n * 16);
                        *(f32x4*)(out + off + bj * HALF + n * 16) = bs + gv[bj][n] * acc[ai][bj][m][n]; }
                if (m & 1) asm volatile("" ::: "memory"); }
    }
};
struct EpiHeadNorm {
    static constexpr bool PERM = true, AFTER_DRAIN = false;
    bf16_t* O0; bf16_t* O1; int ntile_norm; const float* g; float scale; float eps;
    __device__ __forceinline__ void operator()(const f32x4 (&acc)[2][2][4][2], const Unit& u, int wr, int wc, int fr, int fq) const {
        const bool nrm = u.pn < ntile_norm; bf16_t* O = nrm ? O0 : O1; const int pnl = nrm ? u.pn : u.pn - ntile_norm;
        f32x4 gv[2][2];
#pragma unroll
        for (int bj = 0; bj < 2; ++bj)
#pragma unroll
            for (int n = 0; n < 2; ++n) { const f32x4 t = *(const f32x4*)(g + 32 * bj + 8 * fq + 4 * n); gv[bj][n] = nrm ? t * scale : (f32x4){1.f, 1.f, 1.f, 1.f}; }
#pragma unroll
        for (int ai = 0; ai < 2; ++ai)
#pragma unroll
            for (int m = 0; m < 4; ++m) {
                float ss = 0.f;
#pragma unroll
                for (int bj = 0; bj < 2; ++bj)
#pragma unroll
                    for (int n = 0; n < 2; ++n) { const f32x4 x = acc[ai][bj][m][n]; ss += (x[0] * x[0] + x[1] * x[1]) + (x[2] * x[2] + x[3] * x[3]); }
                ss += __shfl_xor(ss, 16); ss += __shfl_xor(ss, 32);
                const float rs = nrm ? 1.0f / sqrtf(ss * (1.0f / 64.0f) + eps) : 1.0f;
                bf16_t* rowp = O + (size_t)(u.pm * BM + ai * HALF + wr * 64 + m * 16 + fr) * 1024 + pnl * BM + wc * 64 + 8 * fq;
#pragma unroll
                for (int bj = 0; bj < 2; ++bj) { const f32x4 v0 = acc[ai][bj][m][0] * rs * gv[bj][0], v1 = acc[ai][bj][m][1] * rs * gv[bj][1];
                    u32x4 w; w.x = cvt_pk_bf16(v0[0], v0[1]); w.y = cvt_pk_bf16(v0[2], v0[3]); w.z = cvt_pk_bf16(v1[0], v1[1]); w.w = cvt_pk_bf16(v1[2], v1[3]);
                    *(u32x4*)(rowp + bj * 32) = w; }
            }
    }
};
template <class Epi, class Sched, bool ALIGN_EPI = false, bool SP2 = false>
__device__ __forceinline__ void gemm_phase(PG8_LAS unsigned char* lds, const Gemm g, const Sched& S, const Epi& E) {
    const int tid = threadIdx.x, wid = __builtin_amdgcn_readfirstlane(tid >> 6), lane = tid & 63, wr = wid >> 2, wc = wid & 3, fr = lane & 15, fq = lane >> 4;
    const int K = g.K, nt = K / BK;
    unsigned voffA[2], voffB[2];
#pragma unroll
    for (int i = 0; i < 2; ++i) { int R, C; stage_rc(tid * 16 + i * 8192, R, C); const int Rb = Epi::PERM ? ((R & ~31) + perm32(R & 31)) : R;
        voffA[i] = (unsigned)(R * K + C) * 2u; voffB[i] = (unsigned)(Rb * K + C) * 2u; }
    const size_t kstep = (size_t)(BK * 2);
    const size_t hstep = (size_t)HALF * K * 2;
    const size_t tstep = 2 * hstep;
    const unsigned ldsw = (unsigned)wid * 1024u;
    const int aoff = lds_byte(wr * 64 + fr, fq * 8), boff = lds_byte(wc * 32 + fr, fq * 8);
#define PG8_SA(b, h) (((b) * 2 + (h)) * HTB)
#define PG8_SB(b, h) ((4 + (b) * 2 + (h)) * HTB)
#define PG8_STAGE(bufoff, gbase, voff) do { _Pragma("unroll") for (int _i = 0; _i < 2; ++_i) \
        __builtin_amdgcn_global_load_lds((const unsigned*)((const char*)(gbase) + (voff)[_i]), (PG8_LAS unsigned*)(lds + (bufoff) + ldsw + _i * 8192), 16, 0, 0); } while (0)
#define PG8_LDA(dst, b, h) do { _Pragma("unroll") for (int m = 0; m < 4; ++m) _Pragma("unroll") for (int k = 0; k < 2; ++k) dst[m][k] = *(const PG8_LAS bf16x8*)(lds + PG8_SA(b, h) + aoff + m * 2048 + k * 1024); } while (0)
#define PG8_LDB(dst, b, h) do { _Pragma("unroll") for (int n = 0; n < 2; ++n) _Pragma("unroll") for (int k = 0; k < 2; ++k) dst[n][k] = *(const PG8_LAS bf16x8*)(lds + PG8_SB(b, h) + boff + n * 2048 + k * 1024); } while (0)
#define PG8_MMA(ai, bj, At, Bt) do { __builtin_amdgcn_s_setprio(1); _Pragma("unroll") for (int m = 0; m < 4; ++m) _Pragma("unroll") for (int n = 0; n < 2; ++n) _Pragma("unroll") for (int k = 0; k < 2; ++k) \
        acc[ai][bj][m][n] = __builtin_amdgcn_mfma_f32_16x16x32_bf16(Bt[n][k], At[m][k], acc[ai][bj][m][n], 0, 0, 0); __builtin_amdgcn_s_setprio(0); } while (0)
#define PG8_WAIT_V(n) asm volatile("s_waitcnt vmcnt(" #n ")" ::: "memory")
#define PG8_WAIT_L(n) asm volatile("s_waitcnt lgkmcnt(" #n ")" ::: "memory")
#define PG8_BAR __builtin_amdgcn_s_barrier()
#define PG8_SCHED __builtin_amdgcn_sched_barrier(0)
    Unit cur, nxt; int ui = 0;
    if (!S.next(0, cur)) return;
    f32x4 acc[2][2][4][2];
#pragma unroll
    for (int a = 0; a < 2; ++a)
#pragma unroll
        for (int b = 0; b < 2; ++b)
#pragma unroll
            for (int m = 0; m < 4; ++m)
#pragma unroll
                for (int n = 0; n < 2; ++n) acc[a][b][m][n] = (f32x4){0.f, 0.f, 0.f, 0.f};
    bf16x8 At[4][2], B0[2][2], B1[2][2];
    const char* cA = (const char*)g.A + (size_t)cur.pm * tstep; const char* cB = (const char*)g.Bt + (size_t)cur.pn * tstep;
    S.a_ready(cur);
    if constexpr (SP2) {
        PG8_STAGE(PG8_SB(0, 0), cB, voffB); PG8_STAGE(PG8_SB(0, 1), cB + hstep, voffB); PG8_STAGE(PG8_SA(0, 0), cA, voffA); PG8_STAGE(PG8_SA(0, 1), cA + hstep, voffA);
        if (wr == 1) PG8_BAR;
        PG8_WAIT_V(2); PG8_BAR;
        PG8_STAGE(PG8_SB(1, 0), cB + kstep, voffB); PG8_STAGE(PG8_SA(1, 0), cA + kstep, voffA); PG8_STAGE(PG8_SB(1, 1), cB + hstep + kstep, voffB);
        PG8_WAIT_V(6); PG8_BAR;
    } else {
        PG8_STAGE(PG8_SB(0, 0), cB, voffB); PG8_STAGE(PG8_SA(0, 0), cA, voffA); PG8_STAGE(PG8_SB(0, 1), cB + hstep, voffB); PG8_STAGE(PG8_SA(0, 1), cA + hstep, voffA);
        if (wr == 1) PG8_BAR;
        PG8_WAIT_V(4); PG8_BAR;
        PG8_STAGE(PG8_SB(1, 0), cB + kstep, voffB); PG8_STAGE(PG8_SA(1, 0), cA + kstep, voffA); PG8_STAGE(PG8_SB(1, 1), cB + hstep + kstep, voffB);
        PG8_WAIT_V(6); PG8_BAR;
    }
    for (;;) {
        const bool has_next = S.next(ui + 1, nxt);
        const char* nA = has_next ? (const char*)g.A + (size_t)nxt.pm * tstep : cA; const char* nB = has_next ? (const char*)g.Bt + (size_t)nxt.pn * tstep : cB;
        for (int t = 0; t < nt; t += 2) {
            const bool last = (t == nt - 2);
            const char* a1 = cA + (size_t)(t + 1) * kstep;
            const char* a2 = last ? nA : cA + (size_t)(t + 2) * kstep; const char* b2 = last ? nB : cB + (size_t)(t + 2) * kstep;
            const char* a3 = a2 + kstep; const char* b3 = b2 + kstep;
            if (last && has_next) S.a_ready(nxt);
            if constexpr (SP2) {
            PG8_LDB(B0, 0, 0); PG8_LDB(B1, 0, 1); PG8_SCHED; PG8_LDA(At, 0, 0); PG8_STAGE(PG8_SA(1, 1), a1 + hstep, voffA);
            PG8_WAIT_V(8); PG8_WAIT_L(0); PG8_BAR; PG8_MMA(0, 0, At, B0); PG8_MMA(0, 1, At, B1); PG8_BAR; PG8_SCHED;
            PG8_LDA(At, 0, 1); PG8_STAGE(PG8_SB(0, 0), b2, voffB); PG8_STAGE(PG8_SB(0, 1), b2 + hstep, voffB); PG8_STAGE(PG8_SA(0, 0), a2, voffA);
            PG8_WAIT_V(8); PG8_WAIT_L(0); PG8_BAR; PG8_MMA(1, 0, At, B0); PG8_MMA(1, 1, At, B1); PG8_BAR; PG8_SCHED;
            PG8_LDB(B0, 1, 0); PG8_LDB(B1, 1, 1); PG8_SCHED; PG8_LDA(At, 1, 0); PG8_STAGE(PG8_SA(0, 1), a2 + hstep, voffA);
            PG8_WAIT_V(8); PG8_WAIT_L(0); PG8_BAR; PG8_MMA(0, 0, At, B0); PG8_MMA(0, 1, At, B1); PG8_BAR; PG8_SCHED;
            PG8_LDA(At, 1, 1); PG8_STAGE(PG8_SB(1, 0), b3, voffB); PG8_STAGE(PG8_SB(1, 1), b3 + hstep, voffB); PG8_STAGE(PG8_SA(1, 0), a3, voffA);
            PG8_WAIT_V(8); PG8_WAIT_L(0); PG8_BAR; PG8_MMA(1, 0, At, B0); PG8_MMA(1, 1, At, B1); PG8_BAR; PG8_SCHED;
            } else {
            PG8_LDB(B0, 0, 0); PG8_SCHED; PG8_LDA(At, 0, 0); PG8_STAGE(PG8_SA(1, 1), a1 + hstep, voffA);
            PG8_WAIT_L(8); PG8_BAR; PG8_WAIT_L(0); PG8_MMA(0, 0, At, B0); PG8_BAR; PG8_SCHED;
            PG8_LDB(B1, 0, 1); PG8_STAGE(PG8_SB(0, 0), b2, voffB);
            PG8_BAR; PG8_WAIT_L(0); PG8_MMA(0, 1, At, B1); PG8_BAR;
            PG8_LDA(At, 0, 1); PG8_STAGE(PG8_SA(0, 0), a2, voffA);
            PG8_BAR; PG8_WAIT_L(0); PG8_MMA(1, 0, At, B0); PG8_BAR; PG8_SCHED;
            PG8_STAGE(PG8_SB(0, 1), b2 + hstep, voffB);
            PG8_WAIT_V(6); PG8_BAR; PG8_MMA(1, 1, At, B1); PG8_BAR;
            PG8_LDB(B0, 1, 0); PG8_SCHED; PG8_LDA(At, 1, 0); PG8_STAGE(PG8_SA(0, 1), a2 + hstep, voffA);
            PG8_WAIT_L(8); PG8_BAR; PG8_WAIT_L(0); PG8_MMA(0, 0, At, B0); PG8_BAR; PG8_SCHED;
            PG8_LDB(B1, 1, 1); PG8_STAGE(PG8_SB(1, 0), b3, voffB);
            PG8_BAR; PG8_WAIT_L(0); PG8_MMA(0, 1, At, B1); PG8_BAR;
            PG8_LDA(At, 1, 1); PG8_STAGE(PG8_SA(1, 0), a3, voffA);
            PG8_BAR; PG8_WAIT_L(0); PG8_MMA(1, 0, At, B0); PG8_BAR; PG8_SCHED;
            PG8_STAGE(PG8_SB(1, 1), b3 + hstep, voffB);
            PG8_WAIT_V(6); PG8_BAR; PG8_MMA(1, 1, At, B1); PG8_BAR;
            }
        }
        if constexpr (ALIGN_EPI) { if (wr == 0) PG8_BAR; }
        if constexpr (!Epi::AFTER_DRAIN) { E(acc, cur, wr, wc, fr, fq); S.done(cur); }
        if (!has_next) break;
#pragma unroll
        for (int a = 0; a < 2; ++a)
#pragma unroll
            for (int b = 0; b < 2; ++b)
#pragma unroll
                for (int m = 0; m < 4; ++m)
#pragma unroll
                    for (int n = 0; n < 2; ++n) acc[a][b][m][n] = (f32x4){0.f, 0.f, 0.f, 0.f};
        cur = nxt; cA = nA; cB = nB; ++ui;
        if constexpr (ALIGN_EPI) { if (wr == 1) PG8_BAR; }
    }
    PG8_WAIT_V(0);
    if constexpr (!ALIGN_EPI) { if (wr == 0) PG8_BAR; }
    PG8_BAR;
    if constexpr (Epi::AFTER_DRAIN) { E.fused(acc, cur, wr, wc, fr, fq, lds, wid, lane); S.done(cur); }
#undef PG8_SA
#undef PG8_SB
#undef PG8_STAGE
#undef PG8_LDA
#undef PG8_LDB
#undef PG8_MMA
#undef PG8_WAIT_V
#undef PG8_WAIT_L
#undef PG8_BAR
#undef PG8_SCHED
}
}

#define DI __device__ __forceinline__
#define LAS __attribute__((address_space(3)))
typedef unsigned short bf16;
typedef __bf16 bf16x2_t __attribute__((ext_vector_type(2)));
typedef float f32x2_t __attribute__((ext_vector_type(2)));
typedef float f32x4 __attribute__((ext_vector_type(4)));
typedef float f32x16 __attribute__((ext_vector_type(16)));
typedef short bf16x8 __attribute__((ext_vector_type(8)));
typedef short s16x4 __attribute__((ext_vector_type(4)));
typedef unsigned u32x4 __attribute__((ext_vector_type(4)));
typedef unsigned u32x2 __attribute__((ext_vector_type(2)));

constexpr int NT = 512, NWAVES = 8;
constexpr int LDS_BYTES = 147456;
constexpr int T_TOK = 32768, DM = 1024, SEQ = 2048, NB = 16;
constexpr float EPS = 1e-6f;
constexpr size_t MiB = 1u << 20;
constexpr size_t WS_MODS = 1 * MiB, WS_KVMODS = WS_MODS + (size_t)2 * 16 * 6144 * 4;
constexpr size_t WS_GATES = 2 * MiB, WS_BLAST = 4 * MiB, WS_MLOC = 4 * MiB + 65536, WS_MPREV = 4 * MiB + 131072, WS_NLOC = 5 * MiB;
constexpr size_t WS_WG = 6 * MiB, WS_SUBK = 7 * MiB;
constexpr size_t WS_WIN = 8 * MiB, WS_WOUT = 14 * MiB, WS_WKV = 16 * MiB, WS_WSQ = 20 * MiB, WS_WSO = 22 * MiB, WS_WPQ = 24 * MiB;
constexpr size_t WS_IDX = 36 * MiB, WS_GATE = 44 * MiB, WS_SU = 60 * MiB, WS_SV = 61 * MiB, WS_SW8 = 62 * MiB;
constexpr size_t WS_H2Q = 256 * MiB, WS_SH = 288 * MiB + 0;
constexpr size_t WS_U = 64 * MiB, WS_V = 128 * MiB, WS_H = 192 * MiB, WS_HB = 256 * MiB, WS_PROJ = 320 * MiB, WS_END = 512 * MiB;
constexpr size_t WS_QC = 96 * MiB, WS_KC = 160 * MiB;
constexpr size_t WS_CST = WS_HB;
constexpr size_t WS_Q = WS_PROJ, WS_K = WS_PROJ + 64 * MiB, WS_VV = WS_PROJ + 128 * MiB, WS_PQ = WS_PROJ;

struct Args { const float* in[23]; float* out; unsigned char* ws; int ph_lo, ph_hi; };
struct Frame {
    LAS unsigned char* lds;
    const float* in[23]; float* out; unsigned char* ws;
    int tid, lane, wave, bid, G;
    int vc;
};

DI unsigned cvtpk(float lo, float hi) { f32x2_t v = {lo, hi}; bf16x2_t b = __builtin_convertvector(v, bf16x2_t); return __builtin_bit_cast(unsigned, b); }
DI float bflo(unsigned u) { return __uint_as_float(u << 16); }
DI float bfhi(unsigned u) { return __uint_as_float(u & 0xffff0000u); }

template <int M> DI unsigned lxu(unsigned v) {
    if constexpr (M == 1) return (unsigned)__builtin_amdgcn_mov_dpp((int)v, 0xB1, 0xf, 0xf, true);
    else if constexpr (M == 2) return (unsigned)__builtin_amdgcn_mov_dpp((int)v, 0x4E, 0xf, 0xf, true);
    else if constexpr (M == 7) return (unsigned)__builtin_amdgcn_mov_dpp((int)v, 0x141, 0xf, 0xf, true);
    else if constexpr (M == 8) return (unsigned)__builtin_amdgcn_mov_dpp((int)v, 0x128, 0xf, 0xf, true);
    else if constexpr (M == 16) { auto r = __builtin_amdgcn_permlane16_swap(v, v, false, false); return r[0] ^ r[1] ^ v; }
    else { static_assert(M == 32, "lxu: M"); auto r = __builtin_amdgcn_permlane32_swap(v, v, false, false); return r[0] ^ r[1] ^ v; }
}
template <int M> DI float lx(float v) { return __uint_as_float(lxu<M>(__float_as_uint(v))); }
template <int M> DI int lx(int v) { return (int)lxu<M>((unsigned)v); }
DI float wave_sum(float v) { v += lx<1>(v); v += lx<2>(v); v += lx<7>(v); v += lx<8>(v); v += lx<16>(v); v += lx<32>(v); return v; }
DI float wave_max(float v) { v = fmaxf(v, lx<1>(v)); v = fmaxf(v, lx<2>(v)); v = fmaxf(v, lx<7>(v)); v = fmaxf(v, lx<8>(v)); v = fmaxf(v, lx<16>(v)); v = fmaxf(v, lx<32>(v)); return v; }
DI int crow(int r, int hi) { return (r & 3) + 8 * (r >> 2) + 4 * hi; }
#define MFMA32(a, b, c) __builtin_amdgcn_mfma_f32_32x32x16_bf16((a), (b), (c), 0, 0, 0)
typedef short v4i16_t __attribute__((ext_vector_type(4)));
DI s16x4 tr16(const LAS unsigned char* p) { return __builtin_bit_cast(s16x4, __builtin_amdgcn_ds_read_tr16_b64_v4i16((LAS v4i16_t*)p)); }
DI int tr_off(int tok, int ch) { return (ch >> 2) * 4096 + (tok >> 4) * 1024 + (tok & 15) * 64 + (ch & 3) * 16; }
DI bf16x8 tr_frag(const LAS unsigned char* img, int dh, int ks, int lane) {
    const int hi = lane >> 5; const int vb = ((lane >> 4) & 1) * 32 + (lane & 3) * 8 + (4 * hi + ((lane & 15) >> 2)) * 64;
    const s16x4 lo = tr16(img + vb + dh * 4096 + ks * 1024), h2 = tr16(img + vb + dh * 4096 + ks * 1024 + 512);
    return __builtin_shufflevector(lo, h2, 0, 1, 2, 3, 4, 5, 6, 7);
}
template <int NTOK> DI bf16x8 row_frag(const LAS unsigned char* img, int tt, int ks, int lane) {
    const int hi = lane >> 5, r32 = lane & 31;
    return *(const LAS bf16x8*)(img + (2 * ks + hi) * (NTOK * 16) + (32 * tt + r32) * 16);
}
DI bf16x8 pack8(const f32x16& x, int s) {
    u32x4 p; p.x = cvtpk(x[8 * s], x[8 * s + 1]); p.y = cvtpk(x[8 * s + 2], x[8 * s + 3]); p.z = cvtpk(x[8 * s + 4], x[8 * s + 5]); p.w = cvtpk(x[8 * s + 6], x[8 * s + 7]);
    return __builtin_bit_cast(bf16x8, p);
}

DI void p0_ada(Frame& F) {
    LAS float* sil = (LAS float*)F.lds;
    LAS float* red = (LAS float*)(F.lds + 65536);
    const float* c = F.in[1];
    for (int i = F.tid; i < 16 * 1024; i += NT) { const int b = i >> 10, d = i & 1023; const float v = c[i]; sil[d * 16 + b] = v / (1.f + expf(-v)); }
    __syncthreads();
    for (int item = F.bid; item < 224; item += F.G) {
        const float* W; const float* bias; float* out; int N, col0;
        if (item < 192) { const int layer = item / 96, it = item % 96; W = F.in[2] + (size_t)layer * 1024 * 6144; bias = F.in[3] + layer * 6144; N = 6144; col0 = it * 64; out = (float*)(F.ws + WS_MODS) + (size_t)layer * 16 * 6144; }
        else { const int it = item - 192; W = F.in[11]; bias = F.in[12]; N = 2048; col0 = it * 64; out = (float*)(F.ws + WS_KVMODS); }
        float acc[16];
#pragma unroll
        for (int b = 0; b < 16; ++b) acc[b] = 0.f;
        const int d0 = F.wave * 128;
        const float* wp = W + (size_t)d0 * N + col0 + F.lane;
#pragma unroll 16
        for (int d = 0; d < 128; ++d) {
            const float w = wp[(size_t)d * N];
            const LAS f32x4* s4 = (const LAS f32x4*)(sil + (d0 + d) * 16);
            const f32x4 s0 = s4[0], s1 = s4[1], s2 = s4[2], s3 = s4[3];
            acc[0] += w * s0[0]; acc[1] += w * s0[1]; acc[2] += w * s0[2]; acc[3] += w * s0[3];
            acc[4] += w * s1[0]; acc[5] += w * s1[1]; acc[6] += w * s1[2]; acc[7] += w * s1[3];
            acc[8] += w * s2[0]; acc[9] += w * s2[1]; acc[10] += w * s2[2]; acc[11] += w * s2[3];
            acc[12] += w * s3[0]; acc[13] += w * s3[1]; acc[14] += w * s3[2]; acc[15] += w * s3[3];
        }
#pragma unroll
        for (int b = 0; b < 16; ++b) red[(F.wave * 16 + b) * 64 + F.lane] = acc[b];
        __syncthreads();
        for (int i = F.tid; i < 1024; i += NT) { const int b = i >> 6, l = i & 63; float s = 0.f;
#pragma unroll
            for (int w = 0; w < 8; ++w) s += red[(w * 16 + b) * 64 + l];
            out[(size_t)b * N + col0 + l] = s + bias[col0 + l]; }
        __syncthreads();
    }
}
DI void transpose_item(const float* W, int ldw, bf16* WT, int dst_row0, LAS float* scr, int k0, int n0, int lane) {
#pragma unroll 8
    for (int i = 0; i < 32; ++i) { const int kk = 2 * i + (lane >> 5); scr[kk * 33 + (lane & 31)] = W[(size_t)(k0 + kk) * ldw + n0 + (lane & 31)]; }
    asm volatile("s_waitcnt lgkmcnt(0)" ::: "memory");
    const int c = lane & 7;
#pragma unroll
    for (int j = 0; j < 4; ++j) { const int n = (lane >> 3) + 8 * j; const LAS float* s = scr + (8 * c) * 33 + n;
        u32x4 o; o.x = cvtpk(s[0 * 33], s[1 * 33]); o.y = cvtpk(s[2 * 33], s[3 * 33]); o.z = cvtpk(s[4 * 33], s[5 * 33]); o.w = cvtpk(s[6 * 33], s[7 * 33]);
        *(u32x4*)(WT + (size_t)(dst_row0 + n) * 1024 + k0 + 8 * c) = o; }
    asm volatile("s_waitcnt lgkmcnt(0)" ::: "memory");
}
DI int permrow(int c) { return (c & ~255) + 32 * (4 * ((c >> 5) & 1) + ((c >> 6) & 3)) + (c & 31); }
DI void p0a_prologue(Frame& F) {
    p0_ada(F);
    for (size_t i = (size_t)F.bid * NT + F.tid; i < 16 * 1024; i += (size_t)F.G * NT) { const int g = (int)(i >> 10), k = (int)(i & 1023); ((float*)(F.ws + WS_WG))[i] = F.in[6][(size_t)k * 3088 + 3072 + g]; }
}
DI void p_transposes(Frame& F, int it_lo, int it_hi, LAS float* scr) {
    const int gw = F.bid * NWAVES + F.wave, NGW = F.G * NWAVES;
    for (int it = it_lo + gw; it < it_hi; it += NGW) {
        int r = it; const float* W; int ldw, ncols; bf16* dst; bool perm;
        if (r < 1536) { W = F.in[6]; ldw = 3088; ncols = 3072; dst = (bf16*)(F.ws + WS_WIN); perm = false; }
        else if ((r -= 1536) < 512) { W = F.in[10]; ldw = 1024; ncols = 1024; dst = (bf16*)(F.ws + WS_WOUT); perm = false; }
        else if ((r -= 512) < 1024) { W = F.in[14]; ldw = 2048; ncols = 2048; dst = (bf16*)(F.ws + WS_WKV); perm = true; }
        else if ((r -= 1024) < 512) { W = F.in[16]; ldw = 1024; ncols = 1024; dst = (bf16*)(F.ws + WS_WSQ); perm = true; }
        else if ((r -= 512) < 512) { W = F.in[18]; ldw = 1024; ncols = 1024; dst = (bf16*)(F.ws + WS_WSO); perm = false; }
        else if ((r -= 512) < 1024) { W = F.in[19]; ldw = 2048; ncols = 2048; dst = (bf16*)(F.ws + WS_WPQ); perm = false; }
        else { r -= 1024; W = F.in[19] + (size_t)1024 * 2048; ldw = 2048; ncols = 2048; dst = (bf16*)(F.ws + WS_WPQ) + (size_t)2048 * 1024; perm = false; }
        const int nblk = ncols / 32, kb = r / nblk, nb = r % nblk, n0 = 32 * nb;
        transpose_item(W, ldw, dst, perm ? permrow(n0) : n0, scr, 64 * kb, n0, F.lane);
    }
}
DI void p0b_prologue(Frame& F) {
    p_transposes(F, 0, 6144, (LAS float*)(F.lds + F.wave * 16384));
    const size_t gt = (size_t)F.bid * NT + F.tid, NGT = (size_t)F.G * NT;
    for (size_t i = gt; i < 65536 / 2; i += NGT) { const float a = F.in[20][2 * i], b = F.in[20][2 * i + 1]; ((unsigned*)(F.ws + WS_SUBK))[i] = cvtpk(a, b); }
}

DI void p_tables(Frame& F) {
    const int gw = F.bid * NWAVES + F.wave, NGW = F.G * NWAVES;
    for (int row = gw; row < 2 * 16384; row += NGW) {
        const f32x4* src = (const f32x4*)(F.in[22] + (size_t)row * 1024) + 4 * F.lane;
        const f32x4 a = src[0], b = src[1], c2 = src[2], d = src[3];
        float m = fmaxf(fmaxf(fmaxf(fabsf(a[0]), fabsf(a[1])), fmaxf(fabsf(a[2]), fabsf(a[3]))), fmaxf(fmaxf(fabsf(b[0]), fabsf(b[1])), fmaxf(fabsf(b[2]), fabsf(b[3]))));
        m = fmaxf(m, fmaxf(fmaxf(fmaxf(fabsf(c2[0]), fabsf(c2[1])), fmaxf(fabsf(c2[2]), fabsf(c2[3]))), fmaxf(fmaxf(fabsf(d[0]), fabsf(d[1])), fmaxf(fabsf(d[2]), fabsf(d[3])))));
        m = fmaxf(wave_max(m), 1e-30f);
        const float inv = 127.0f / m;
        auto q4 = [&](const f32x4& v) -> unsigned { const int x0 = (int)rintf(v[0] * inv), x1 = (int)rintf(v[1] * inv), x2 = (int)rintf(v[2] * inv), x3 = (int)rintf(v[3] * inv);
            return (unsigned)(x0 & 255) | ((unsigned)(x1 & 255) << 8) | ((unsigned)(x2 & 255) << 16) | ((unsigned)(x3 & 255) << 24); };
        { const size_t ly = (size_t)row >> 14, e = (size_t)row & 16383;
          ((u32x4*)(F.ws + WS_V))[(((ly * 8 + (F.lane >> 3)) * 16384 + e) << 3) + (F.lane & 7)] = (u32x4){q4(a), q4(b), q4(c2), q4(d)}; }
        if (F.lane == 0) ((float*)(F.ws + WS_SV))[row] = m * (1.0f / 127.0f);
    }
    for (int row = gw; row < 2 * 16384; row += NGW) {
        const f32x4* src = (const f32x4*)(F.in[21] + (size_t)row * 1024) + 4 * F.lane;
        const f32x4 a = src[0], b = src[1], c2 = src[2], d = src[3];
        float m = fmaxf(fmaxf(fmaxf(fabsf(a[0]), fabsf(a[1])), fmaxf(fabsf(a[2]), fabsf(a[3]))), fmaxf(fmaxf(fabsf(b[0]), fabsf(b[1])), fmaxf(fabsf(b[2]), fabsf(b[3]))));
        m = fmaxf(m, fmaxf(fmaxf(fmaxf(fabsf(c2[0]), fabsf(c2[1])), fmaxf(fabsf(c2[2]), fabsf(c2[3]))), fmaxf(fmaxf(fabsf(d[0]), fabsf(d[1])), fmaxf(fabsf(d[2]), fabsf(d[3])))));
        m = fmaxf(wave_max(m), 1e-30f);
        const float inv = 127.0f / m;
        auto q4 = [&](const f32x4& v) -> unsigned { const int x0 = (int)rintf(v[0] * inv), x1 = (int)rintf(v[1] * inv), x2 = (int)rintf(v[2] * inv), x3 = (int)rintf(v[3] * inv);
            return (unsigned)(x0 & 255) | ((unsigned)(x1 & 255) << 8) | ((unsigned)(x2 & 255) << 16) | ((unsigned)(x3 & 255) << 24); };
        { const size_t ly = (size_t)row >> 14, e = (size_t)row & 16383;
          ((u32x4*)(F.ws + WS_U))[(((ly * 8 + (F.lane >> 3)) * 16384 + e) << 3) + (F.lane & 7)] = (u32x4){q4(a), q4(b), q4(c2), q4(d)}; }
        if (F.lane == 0) ((float*)(F.ws + WS_SU))[row] = m * (1.0f / 127.0f);
    }
}
template <bool GATES, bool Q8> DI void norm_row(Frame& F, f32x4 (&v)[4], int row, const f32x4 (&A)[4], const f32x4 (&Bv)[4], bf16* hout, const LAS float* wg) {
    float ss = 0.f;
#pragma unroll
    for (int j = 0; j < 4; ++j) ss += (v[j][0] * v[j][0] + v[j][1] * v[j][1]) + (v[j][2] * v[j][2] + v[j][3] * v[j][3]);
    const float rstd = 1.0f / sqrtf(wave_sum(ss) * (1.0f / DM) + EPS);
    unsigned long long* o8 = (unsigned long long*)(hout + (size_t)row * DM) + F.lane;
#pragma unroll
    for (int j = 0; j < 4; ++j) { v[j] = v[j] * rstd * A[j] + Bv[j]; o8[64 * j] = (unsigned long long)cvtpk(v[j][0], v[j][1]) | ((unsigned long long)cvtpk(v[j][2], v[j][3]) << 32); }
    if (Q8) {
        float m = 0.f;
#pragma unroll
        for (int j = 0; j < 4; ++j) m = fmaxf(m, fmaxf(fmaxf(fabsf(v[j][0]), fabsf(v[j][1])), fmaxf(fabsf(v[j][2]), fabsf(v[j][3]))));
        m = fmaxf(wave_max(m), 1e-30f);
        const float inv = 127.0f / m;
        unsigned* q8 = (unsigned*)(F.ws + WS_H2Q + (size_t)row * DM) + F.lane;
#pragma unroll
        for (int j = 0; j < 4; ++j) { const int x0 = (int)rintf(v[j][0] * inv), x1 = (int)rintf(v[j][1] * inv), x2 = (int)rintf(v[j][2] * inv), x3 = (int)rintf(v[j][3] * inv);
            q8[64 * j] = (unsigned)(x0 & 255) | ((unsigned)(x1 & 255) << 8) | ((unsigned)(x2 & 255) << 16) | ((unsigned)(x3 & 255) << 24); }
        if (F.lane == 0) ((float*)(F.ws + WS_SH))[row] = m * (1.0f / 127.0f);
    }
    if (GATES) {
        float p[16];
#pragma unroll
        for (int q = 0; q < 16; ++q) { float s = 0.f;
#pragma unroll
            for (int j = 0; j < 4; ++j) { const f32x4 w = *(const LAS f32x4*)(wg + q * 1024 + 4 * F.lane + 256 * j); s += (v[j][0] * w[0] + v[j][1] * w[1]) + (v[j][2] * w[2] + v[j][3] * w[3]); }
            p[q] = s; if ((q & 3) == 3) { asm volatile("" ::: "memory"); __builtin_amdgcn_sched_barrier(0); } }
#pragma unroll
        for (int i = 0; i < 8; ++i) { const bool up = (F.lane & 32) != 0; const float send = up ? p[i] : p[i + 8], keep = up ? p[i + 8] : p[i]; p[i] = keep + lx<32>(send); }
#pragma unroll
        for (int i = 0; i < 4; ++i) { const bool up = (F.lane & 16) != 0; const float send = up ? p[i] : p[i + 4], keep = up ? p[i + 4] : p[i]; p[i] = keep + lx<16>(send); }
#pragma unroll
        for (int i = 0; i < 2; ++i) { const bool up = (F.lane & 8) != 0; const float send = up ? p[i] : p[i + 2], keep = up ? p[i + 2] : p[i]; p[i] = keep + lx<8>(send); }
        { const bool up = (F.lane & 4) != 0; const float send = up ? p[0] : p[1], keep = up ? p[1] : p[0]; p[0] = keep + lx<7>(send); }
        p[0] += lx<2>(p[0]); p[0] += lx<1>(p[0]);
        const int gi = ((F.lane >> 5) & 1) * 8 + ((F.lane >> 4) & 1) * 4 + ((F.lane >> 3) & 1) * 2 + ((F.lane >> 2) & 1);
        if ((F.lane & 3) == 0) ((float*)(F.ws + WS_GATES))[(size_t)row * 16 + gi] = p[0];
    }
}
DI void load_rows4(f32x4 (&buf)[4][4], const float* xin, int row, int lane) {
#pragma unroll
    for (int r = 0; r < 4; ++r) { const f32x4* xr = (const f32x4*)(xin + (size_t)(row + r) * DM) + lane;
#pragma unroll
        for (int j = 0; j < 4; ++j) buf[r][j] = xr[64 * j]; }
}
template <bool GATES, bool Q8 = false> DI void norm_phase(Frame& F, const float* xin, const float* g, const float* shp, const float* scp, int bstride, bf16* hout) {
    const int gw = F.bid * NWAVES + F.wave, NGW = F.G * NWAVES;
    LAS float* wg = (LAS float*)F.lds;
    if (GATES) { const float* src = (const float*)(F.ws + WS_WG); for (int i = F.tid; i < 16 * 1024 / 4; i += NT) ((LAS f32x4*)wg)[i] = ((const f32x4*)src)[i]; __syncthreads(); }
    for (int chunk = gw; chunk < T_TOK / 16; chunk += NGW) {
        const int row0 = chunk * 16, b = row0 >> 11;
        f32x4 A[4], Bv[4];
#pragma unroll
        for (int j = 0; j < 4; ++j) { const int c = 4 * F.lane + 256 * j; const f32x4 gg = *(const f32x4*)(g + c), sc = *(const f32x4*)(scp + (size_t)b * bstride + c);
            A[j] = gg * (sc + 1.0f); Bv[j] = *(const f32x4*)(shp + (size_t)b * bstride + c); }
        f32x4 bufA[4][4], bufB[4][4];
        load_rows4(bufA, xin, row0, F.lane);
#pragma unroll 1
        for (int gq = 0; gq < 4; gq += 2) {
            load_rows4(bufB, xin, row0 + 4 * (gq + 1), F.lane);
#pragma unroll
            for (int r = 0; r < 4; ++r) norm_row<GATES, Q8>(F, bufA[r], row0 + 4 * gq + r, A, Bv, hout, wg);
            if (gq + 2 < 4) load_rows4(bufA, xin, row0 + 4 * (gq + 2), F.lane);
#pragma unroll
            for (int r = 0; r < 4; ++r) norm_row<GATES, Q8>(F, bufB[r], row0 + 4 * (gq + 1) + r, A, Bv, hout, wg);
        }
    }
}
DI void norm2_phase(Frame& F, const float* xin, const float* gA, const float* shA, const float* scA, int strideA, bf16* outA, const float* gB, const float* shB, const float* scB, int strideB, bf16* outB) {
    const int gw = F.bid * NWAVES + F.wave, NGW = F.G * NWAVES;
    for (int chunk = gw; chunk < T_TOK / 16; chunk += NGW) {
        const int row0 = chunk * 16, b = row0 >> 11;
        f32x4 A1[4], B1[4], A2[4], B2[4];
#pragma unroll
        for (int j = 0; j < 4; ++j) { const int c = 4 * F.lane + 256 * j;
            A1[j] = *(const f32x4*)(gA + c) * (*(const f32x4*)(scA + (size_t)b * strideA + c) + 1.0f); B1[j] = *(const f32x4*)(shA + (size_t)b * strideA + c);
            A2[j] = *(const f32x4*)(gB + c) * (*(const f32x4*)(scB + (size_t)b * strideB + c) + 1.0f); B2[j] = *(const f32x4*)(shB + (size_t)b * strideB + c); }
        f32x4 bufA[4][4], bufB[4][4];
        load_rows4(bufA, xin, row0, F.lane);
#define NORM2_ROW(V, ROW) { const int row = (ROW); float ss = 0.f; \
            _Pragma("unroll") for (int j = 0; j < 4; ++j) ss += (V[j][0] * V[j][0] + V[j][1] * V[j][1]) + (V[j][2] * V[j][2] + V[j][3] * V[j][3]); \
            const float rstd = 1.0f / sqrtf(wave_sum(ss) * (1.0f / DM) + EPS); \
            unsigned long long* oa = (unsigned long long*)(outA + (size_t)row * DM) + F.lane; unsigned long long* ob = (unsigned long long*)(outB + (size_t)row * DM) + F.lane; \
            _Pragma("unroll") for (int j = 0; j < 4; ++j) { const f32x4 xn = V[j] * rstd; const f32x4 ya = xn * A1[j] + B1[j], yb = xn * A2[j] + B2[j]; \
                oa[64 * j] = (unsigned long long)cvtpk(ya[0], ya[1]) | ((unsigned long long)cvtpk(ya[2], ya[3]) << 32); \
                ob[64 * j] = (unsigned long long)cvtpk(yb[0], yb[1]) | ((unsigned long long)cvtpk(yb[2], yb[3]) << 32); } }
#pragma unroll 1
        for (int gq = 0; gq < 4; gq += 2) {
            load_rows4(bufB, xin, row0 + 4 * (gq + 1), F.lane);
#pragma unroll
            for (int r = 0; r < 4; ++r) NORM2_ROW(bufA[r], row0 + 4 * gq + r)
            if (gq + 2 < 4) load_rows4(bufA, xin, row0 + 4 * (gq + 2), F.lane);
#pragma unroll
            for (int r = 0; r < 4; ++r) NORM2_ROW(bufB[r], row0 + 4 * (gq + 1) + r)
        }
#undef NORM2_ROW
    }
}

DI void mlstm_gates(Frame& F, size_t trow0, int h, float& ipre, float& bcum, float& blast) {
    const float* gates = (const float*)(F.ws + WS_GATES); const float* bif = F.in[8];
    const float iv = gates[(trow0 + F.lane) * 16 + h] + bif[h];
    const float fv = gates[(trow0 + F.lane) * 16 + 8 + h] + bif[8 + h];
    float b = -(fmaxf(-fv, 0.f) + log1pf(expf(-fabsf(fv))));
#pragma unroll
    for (int d = 1; d < 64; d <<= 1) { const float t = __shfl_up(b, d); if (F.lane >= d) b += t; }
    ipre = iv; bcum = b; blast = __shfl(b, 63);
}
template <int MODE> DI void stage_qk(LAS unsigned char* dst, const LAS float* e_s, const bf16* proj, const float* convw, int tseq0, size_t trow0, int col0, int lane, bf16* gout = nullptr  ) {
    const int g8 = lane >> 3, ch = lane & 7, col = col0 + 8 * ch;
    float cw[4][8];
#pragma unroll
    for (int tap = 0; tap < 4; ++tap) { const f32x4 a = *(const f32x4*)(convw + tap * 1024 + col), b = *(const f32x4*)(convw + tap * 1024 + col + 4);
        cw[tap][0] = a[0]; cw[tap][1] = a[1]; cw[tap][2] = a[2]; cw[tap][3] = a[3]; cw[tap][4] = b[0]; cw[tap][5] = b[1]; cw[tap][6] = b[2]; cw[tap][7] = b[3]; }
#pragma unroll 1
    for (int ph = 0; ph < 2; ++ph) {
        float x[7][8];
#pragma unroll
        for (int i = 0; i < 7; ++i) {
            const int rel = 8 * g8 + 4 * ph + i - 3; const bool valid = (tseq0 + rel) >= 0; const long rr = valid ? (long)rel : 0;
            u32x4 raw = *(const u32x4*)(proj + (size_t)((long)trow0 + rr) * 3072 + col);
            if (!valid) raw = (u32x4){0u, 0u, 0u, 0u};
            x[i][0] = bflo(raw.x); x[i][1] = bfhi(raw.x); x[i][2] = bflo(raw.y); x[i][3] = bfhi(raw.y); x[i][4] = bflo(raw.z); x[i][5] = bfhi(raw.z); x[i][6] = bflo(raw.w); x[i][7] = bfhi(raw.w);
        }
#pragma unroll
        for (int o = 0; o < 4; ++o) {
            const int tok = 8 * g8 + 4 * ph + o;
            float y[8];
#pragma unroll
            for (int e = 0; e < 8; ++e) { float a = cw[0][e] * x[o][e] + cw[1][e] * x[o + 1][e] + cw[2][e] * x[o + 2][e] + cw[3][e] * x[o + 3][e]; y[e] = a / (1.f + __expf(-a)); }
            if (MODE == 0 || MODE == 3) {
                const float gs = (MODE == 3) ? 0.125f : 1.f;
                u32x4 wg; wg.x = cvtpk(y[0] * gs, y[1] * gs); wg.y = cvtpk(y[2] * gs, y[3] * gs); wg.z = cvtpk(y[4] * gs, y[5] * gs); wg.w = cvtpk(y[6] * gs, y[7] * gs);
                *(u32x4*)(gout + (size_t)tok * 512 + 8 * ch) = wg; }
            if (MODE != 3) {
            float sc = 1.f; if (MODE == 0) sc = e_s[tok]; if (MODE == 1) sc = 0.125f;
            u32x4 w; w.x = cvtpk(y[0] * sc, y[1] * sc); w.y = cvtpk(y[2] * sc, y[3] * sc); w.z = cvtpk(y[4] * sc, y[5] * sc); w.w = cvtpk(y[6] * sc, y[7] * sc);
            const int off = (MODE == 0) ? tr_off(tok, ch) : ch * 1024 + tok * 16;
            *(LAS u32x4*)(dst + off) = w; }
        }
    }
}
DI void qk_load_raw(u32x4 (&raw)[11], const bf16* proj, int tseq0, size_t trow0, int col0, int lane) {
    const int g8 = lane >> 3, ch = lane & 7, col = col0 + 8 * ch;
#pragma unroll
    for (int i = 0; i < 11; ++i) {
        const int rel = 8 * g8 + i - 3; const bool valid = (tseq0 + rel) >= 0; const long rr = valid ? (long)rel : 0;
        raw[i] = *(const u32x4*)(proj + (size_t)((long)trow0 + rr) * 3072 + col);
        if (!valid) raw[i] = (u32x4){0u, 0u, 0u, 0u};
    }
}
template <int MODE> DI void qk_conv_raw(LAS unsigned char* dst, const LAS float* e_s, const u32x4 (&raw)[11], const float* convw, int col0, int lane, bf16* gout) {
    const int g8 = lane >> 3, ch = lane & 7, col = col0 + 8 * ch;
    float cw[4][8];
#pragma unroll
    for (int tap = 0; tap < 4; ++tap) { const f32x4 a = *(const f32x4*)(convw + tap * 1024 + col), b = *(const f32x4*)(convw + tap * 1024 + col + 4);
        cw[tap][0] = a[0]; cw[tap][1] = a[1]; cw[tap][2] = a[2]; cw[tap][3] = a[3]; cw[tap][4] = b[0]; cw[tap][5] = b[1]; cw[tap][6] = b[2]; cw[tap][7] = b[3]; }
#pragma unroll
    for (int ph = 0; ph < 2; ++ph) {
        float x[7][8];
#pragma unroll
        for (int i = 0; i < 7; ++i) { const u32x4 r = raw[4 * ph + i];
            x[i][0] = bflo(r.x); x[i][1] = bfhi(r.x); x[i][2] = bflo(r.y); x[i][3] = bfhi(r.y); x[i][4] = bflo(r.z); x[i][5] = bfhi(r.z); x[i][6] = bflo(r.w); x[i][7] = bfhi(r.w); }
#pragma unroll
        for (int o = 0; o < 4; ++o) {
            const int tok = 8 * g8 + 4 * ph + o;
            float y[8];
#pragma unroll
            for (int e = 0; e < 8; ++e) { float a = cw[0][e] * x[o][e] + cw[1][e] * x[o + 1][e] + cw[2][e] * x[o + 2][e] + cw[3][e] * x[o + 3][e]; y[e] = a / (1.f + __expf(-a)); }
            const float gs = (MODE == 3) ? 0.125f : 1.f;
            u32x4 wg; wg.x = cvtpk(y[0] * gs, y[1] * gs); wg.y = cvtpk(y[2] * gs, y[3] * gs); wg.z = cvtpk(y[4] * gs, y[5] * gs); wg.w = cvtpk(y[6] * gs, y[7] * gs);
            *(u32x4*)(gout + (size_t)tok * 512 + 8 * ch) = wg;
            if (MODE == 0) { const float sc = e_s[tok];
                u32x4 w; w.x = cvtpk(y[0] * sc, y[1] * sc); w.y = cvtpk(y[2] * sc, y[3] * sc); w.z = cvtpk(y[4] * sc, y[5] * sc); w.w = cvtpk(y[6] * sc, y[7] * sc);
                *(LAS u32x4*)(dst + tr_off(tok, ch)) = w; }
        }
        __builtin_amdgcn_sched_barrier(0);
    }
}
DI void stage_v_half(LAS unsigned char* dst, const bf16* proj, size_t trow0, int col0, int lane) {
    const int g8 = lane >> 3, ch = lane & 7;
#pragma unroll
    for (int o = 0; o < 8; ++o) { const int tok = 8 * g8 + o; const u32x4 raw = *(const u32x4*)(proj + (trow0 + tok) * 3072 + col0 + 8 * ch); *(LAS u32x4*)(dst + tr_off(tok, ch)) = raw; }
}
constexpr int MW_LDS = 17408;

DI void p3_mlstm_local(Frame& F) {
    LAS unsigned char* wl = F.lds + F.wave * MW_LDS;
    LAS unsigned char* kimg = wl; LAS unsigned char* vimg = wl + 8192; LAS float* e_s = (LAS float*)(wl + 16384);
    const bf16* proj = (const bf16*)(F.ws + WS_PROJ);
    bf16* cst = (bf16*)(F.ws + WS_CST);
    const int lane = F.lane, r32 = lane & 31, hi = lane >> 5;
    if ((F.wave & 1) == 0) p_tables(F);
    for (int bu = F.bid; bu < 512; bu += F.G) {
        int h = F.wave; asm volatile("" : "+s"(h));
        const int b = bu >> 5, c = bu & 31; const int unit = bu * 8 + h; const size_t trow0 = (size_t)b * SEQ + c * 64;
        u32x4 kraw[11], qraw[11], vraw[2][8];
        qk_load_raw(kraw, proj, c * 64, trow0, 512 + h * 64, lane); qk_load_raw(qraw, proj, c * 64, trow0, h * 64, lane);
        float ipre, bcum, blast; mlstm_gates(F, trow0, h, ipre, bcum, blast);
        const float w = blast - bcum + ipre; const float mloc = wave_max(w); const float e = expf(w - mloc);
        e_s[lane] = e;
        if (lane == 0) { ((float*)(F.ws + WS_BLAST))[unit] = blast; ((float*)(F.ws + WS_MLOC))[unit] = mloc; }
        qk_conv_raw<0>(kimg, e_s, kraw, F.in[7], 512 + h * 64, lane, (bf16*)(F.ws + WS_KC) + trow0 * 512 + h * 64);
        asm volatile("" ::: "memory"); __builtin_amdgcn_sched_barrier(0);
#pragma unroll
        for (int vh = 0; vh < 2; ++vh)
#pragma unroll
            for (int o = 0; o < 8; ++o) vraw[vh][o] = *(const u32x4*)(proj + (trow0 + 8 * (lane >> 3) + o) * 3072 + 1024 + h * 128 + 64 * vh + 8 * (lane & 7));
        qk_conv_raw<3>(nullptr, nullptr, qraw, F.in[7], h * 64, lane, (bf16*)(F.ws + WS_QC) + trow0 * 512 + h * 64);
        asm volatile("" ::: "memory"); __builtin_amdgcn_sched_barrier(0);
        bf16x8 kef[2][4];
#pragma unroll
        for (int kt = 0; kt < 2; ++kt)
#pragma unroll
            for (int ks = 0; ks < 4; ++ks) kef[kt][ks] = tr_frag(kimg, kt, ks, lane);
        const bf16x8 ones = {0x3F80, 0x3F80, 0x3F80, 0x3F80, 0x3F80, 0x3F80, 0x3F80, 0x3F80};
#pragma unroll
        for (int kt = 0; kt < 2; ++kt) { f32x16 an = {};
#pragma unroll
            for (int ks = 0; ks < 4; ++ks) an = MFMA32(kef[kt][ks], ones, an);
            if (r32 == 0) {
#pragma unroll
                for (int r = 0; r < 16; ++r) ((float*)(F.ws + WS_NLOC))[(size_t)unit * 64 + 32 * kt + crow(r, hi)] = an[r]; } }
#pragma unroll
        for (int vh = 0; vh < 2; ++vh) {
#pragma unroll
            for (int o = 0; o < 8; ++o) *(LAS u32x4*)(vimg + tr_off(8 * (lane >> 3) + o, lane & 7)) = vraw[vh][o];
#pragma unroll
            for (int vt = 0; vt < 2; ++vt) {
                bf16x8 vf[4];
#pragma unroll
                for (int ks = 0; ks < 4; ++ks) vf[ks] = tr_frag(vimg, vt, ks, lane);
#pragma unroll
                for (int kt = 0; kt < 2; ++kt) { f32x16 acc = {};
#pragma unroll
                    for (int ks = 0; ks < 4; ++ks) acc = MFMA32(kef[kt][ks], vf[ks], acc);
                    bf16* dstp = cst + ((size_t)unit * 128 + 64 * vh + 32 * vt + r32) * 64 + 32 * kt + 4 * hi;
#pragma unroll
                    for (int rg = 0; rg < 4; ++rg) { u32x2 pk; pk.x = cvtpk(acc[4 * rg], acc[4 * rg + 1]); pk.y = cvtpk(acc[4 * rg + 2], acc[4 * rg + 3]); *(u32x2*)(dstp + 8 * rg) = pk; }
                }
            }
            asm volatile("s_waitcnt lgkmcnt(0)" ::: "memory");
        }
    }
    if ((F.wave & 1) != 0) p_tables(F);
}
DI void p4_scan(Frame& F) {
    const int gt = F.bid * NT + F.tid, NGT = F.G * NT;
    const float* mlocp = (const float*)(F.ws + WS_MLOC); const float* blastp = (const float*)(F.ws + WS_BLAST);
    for (int item = gt; item < 128 * 1024; item += NGT) {
        const int bh = item >> 10, e8 = item & 1023, b = bh >> 3, h = bh & 7;
        float st[8]; float m = 0.f;
#pragma unroll
        for (int i = 0; i < 8; ++i) st[i] = 0.f;
        u32x4* p0 = (u32x4*)((bf16*)(F.ws + WS_CST) + (size_t)((b * 32) * 8 + h) * 8192) + e8;
        const int u0 = (b * 32) * 8 + h;
#pragma unroll 1
        for (int c0 = 0; c0 < 32; c0 += 8) {
            u32x4 raw[8]; float ml[8], bl[8];
#pragma unroll
            for (int j = 0; j < 8; ++j) { raw[j] = p0[(size_t)(c0 + j) * 8192]; ml[j] = mlocp[u0 + (c0 + j) * 8]; bl[j] = blastp[u0 + (c0 + j) * 8]; }
#pragma unroll
            for (int j = 0; j < 8; ++j) {
                u32x4 o; o.x = cvtpk(st[0], st[1]); o.y = cvtpk(st[2], st[3]); o.z = cvtpk(st[4], st[5]); o.w = cvtpk(st[6], st[7]); p0[(size_t)(c0 + j) * 8192] = o;
                const float mn = fmaxf(bl[j] + m, ml[j]), a = __expf(bl[j] + m - mn), r = __expf(ml[j] - mn);
                st[0] = a * st[0] + r * bflo(raw[j].x); st[1] = a * st[1] + r * bfhi(raw[j].x); st[2] = a * st[2] + r * bflo(raw[j].y); st[3] = a * st[3] + r * bfhi(raw[j].y);
                st[4] = a * st[4] + r * bflo(raw[j].z); st[5] = a * st[5] + r * bfhi(raw[j].z); st[6] = a * st[6] + r * bflo(raw[j].w); st[7] = a * st[7] + r * bfhi(raw[j].w);
                m = mn;
            }
        }
    }
    for (int item = gt; item < 128 * 64; item += NGT) {
        const int bh = item >> 6, k = item & 63, b = bh >> 3, h = bh & 7;
        float ns = 0.f, m = 0.f;
        const int u0 = (b * 32) * 8 + h;
#pragma unroll 1
        for (int c0 = 0; c0 < 32; c0 += 8) {
            float nl[8], ml[8], bl[8];
#pragma unroll
            for (int j = 0; j < 8; ++j) { const int unit = u0 + (c0 + j) * 8; nl[j] = ((const float*)(F.ws + WS_NLOC))[(size_t)unit * 64 + k]; ml[j] = mlocp[unit]; bl[j] = blastp[unit]; }
#pragma unroll
            for (int j = 0; j < 8; ++j) { const int unit = u0 + (c0 + j) * 8;
                ((float*)(F.ws + WS_NLOC))[(size_t)unit * 64 + k] = ns; if (k == 0) ((float*)(F.ws + WS_MPREV))[unit] = m;
                const float mn = fmaxf(bl[j] + m, ml[j]), a = __expf(bl[j] + m - mn), r = __expf(ml[j] - mn);
                ns = a * ns + r * nl[j]; m = mn; }
        }
    }
}
DI void p5_mlstm_out(Frame& F) {
    LAS unsigned char* wl = F.lds + F.wave * MW_LDS;
    LAS float* sc = (LAS float*)(wl + 16384);
    const bf16* proj = (const bf16*)(F.ws + WS_PROJ);
    const bf16* cst = (const bf16*)(F.ws + WS_CST);
    const bf16* QC = (const bf16*)(F.ws + WS_QC); const bf16* KC = (const bf16*)(F.ws + WS_KC);
    bf16* hh = (bf16*)(F.ws + WS_H);
    for (int bu = F.bid; bu < 512; bu += F.G) {
        int lane = F.lane; asm volatile("" : "+v"(lane)); const int r32 = lane & 31, hi = lane >> 5;
        int h = F.wave; asm volatile("" : "+s"(h));
        const int b = bu >> 5, c = bu & 31; const int unit = bu * 8 + h; const size_t trow0 = (size_t)b * SEQ + c * 64;
        {
            float ipre, bcum, blast; mlstm_gates(F, trow0, h, ipre, bcum, blast);
            const float mprev = ((const float*)(F.ws + WS_MPREV))[unit];
            const float gg = ipre - bcum; float pm = gg;
#pragma unroll
            for (int d = 1; d < 64; d <<= 1) { const float t = __shfl_up(pm, d); if (lane >= d) pm = fmaxf(pm, t); }
            const float Mx = fmaxf(mprev, pm), mt = bcum + Mx;
            sc[lane] = gg; sc[64 + lane] = Mx; sc[128 + lane] = expf(mprev - Mx); sc[192 + lane] = expf(-mt);
        }
        stage_v_half(wl, proj, trow0, 1024 + h * 128, lane); stage_v_half(wl + 8192, proj, trow0, 1024 + h * 128 + 64, lane);
        bf16x8 cf[4][4];
#pragma unroll
        for (int vt = 0; vt < 4; ++vt)
#pragma unroll
            for (int ks = 0; ks < 4; ++ks) cf[vt][ks] = *(const bf16x8*)(cst + ((size_t)unit * 128 + 32 * vt + r32) * 64 + 16 * ks + 8 * hi);
#pragma unroll 1
        for (int lt = 0; lt < 2; ++lt) {
            const int l = 32 * lt + r32;
            const size_t t = trow0 + l;
            bf16x8 qf[4];
#pragma unroll
            for (int ks = 0; ks < 4; ++ks) qf[ks] = *(const bf16x8*)(QC + t * 512 + h * 64 + 16 * ks + 8 * hi);
            const float Mxl = sc[64 + l];
            bf16x8 P[2][2]; float dsum = 0.f;
#pragma unroll
            for (int st = 0; st < 2; ++st) {
                P[st][0] = (bf16x8){0, 0, 0, 0, 0, 0, 0, 0}; P[st][1] = P[st][0];
                if (st <= lt) {
                    f32x16 acc = {};
#pragma unroll
                    for (int ks = 0; ks < 4; ++ks) acc = MFMA32(*(const bf16x8*)(KC + (trow0 + 32 * st + r32) * 512 + h * 64 + 16 * ks + 8 * hi), qf[ks], acc);
#pragma unroll
                    for (int r = 0; r < 16; ++r) { const int srow = crow(r, hi); float val = acc[r] * __expf(sc[32 * st + srow] - Mxl); if (st == lt && srow > r32) val = 0.f; acc[r] = val; dsum += val; }
                    P[st][0] = pack8(acc, 0); P[st][1] = pack8(acc, 1);
                }
            }
            float nq;
            { const float* np = (const float*)(F.ws + WS_NLOC) + (size_t)unit * 64; float s = 0.f;
#pragma unroll
              for (int ks = 0; ks < 4; ++ks) { const f32x4 n0 = *(const f32x4*)(np + 16 * ks + 8 * hi), n1 = *(const f32x4*)(np + 16 * ks + 8 * hi + 4); const u32x4 q = __builtin_bit_cast(u32x4, qf[ks]);
                  s += bflo(q.x) * n0[0] + bfhi(q.x) * n0[1] + bflo(q.y) * n0[2] + bfhi(q.y) * n0[3] + bflo(q.z) * n1[0] + bfhi(q.z) * n1[1] + bflo(q.w) * n1[2] + bfhi(q.w) * n1[3]; }
              nq = s + __shfl_xor(s, 32); }
            f32x16 acc[4];
#pragma unroll
            for (int vt = 0; vt < 4; ++vt) { acc[vt] = (f32x16){};
#pragma unroll
                for (int ks = 0; ks < 4; ++ks) acc[vt] = MFMA32(cf[vt][ks], qf[ks], acc[vt]); }
            const float iwl = sc[128 + l];
#pragma unroll
            for (int vt = 0; vt < 4; ++vt) acc[vt] = acc[vt] * iwl;
#pragma unroll
            for (int st = 0; st < 2; ++st) if (st <= lt) {
#pragma unroll
                for (int k2 = 0; k2 < 2; ++k2) {
#pragma unroll
                    for (int vt = 0; vt < 4; ++vt) acc[vt] = MFMA32(tr_frag(wl + (vt >> 1) * 8192, vt & 1, 2 * st + k2, lane), P[st][k2], acc[vt]); } }
            u32x2 o4[4][4];
#pragma unroll
            for (int vt = 0; vt < 4; ++vt)
#pragma unroll
                for (int rg = 0; rg < 4; ++rg) o4[vt][rg] = *(const u32x2*)(proj + t * 3072 + 2048 + h * 128 + 32 * vt + 8 * rg + 4 * hi);
            const float den = dsum + __shfl_xor(dsum, 32) + iwl * nq;
            const float inv = 1.0f / fmaxf(fabsf(den), sc[192 + l]);
            float ss = 0.f;
#pragma unroll
            for (int vt = 0; vt < 4; ++vt)
#pragma unroll
                for (int r = 0; r < 16; ++r) { const float v = acc[vt][r] * inv; acc[vt][r] = v; ss += v * v; }
            ss += __shfl_xor(ss, 32);
            const float rstd = 1.0f / sqrtf(ss * (1.0f / 128.0f) + EPS);
#pragma unroll
            for (int vt = 0; vt < 4; ++vt)
#pragma unroll
                for (int rg = 0; rg < 4; ++rg) { const int v = 32 * vt + 8 * rg + 4 * hi;
                    const f32x4 g4 = *(const f32x4*)(F.in[9] + h * 128 + v);
                    const float o0 = bflo(o4[vt][rg].x), o1 = bfhi(o4[vt][rg].x), o2 = bflo(o4[vt][rg].y), o3 = bfhi(o4[vt][rg].y);
                    const float y0 = acc[vt][4 * rg] * rstd * g4[0] / (1.f + __expf(-o0)), y1 = acc[vt][4 * rg + 1] * rstd * g4[1] / (1.f + __expf(-o1));
                    const float y2 = acc[vt][4 * rg + 2] * rstd * g4[2] / (1.f + __expf(-o2)), y3 = acc[vt][4 * rg + 3] * rstd * g4[3] / (1.f + __expf(-o3));
                    u32x2 pk; pk.x = cvtpk(y0, y1); pk.y = cvtpk(y2, y3); *(u32x2*)(hh + t * 1024 + h * 128 + v) = pk; }
        }
        asm volatile("s_waitcnt lgkmcnt(0)" ::: "memory");
    }
}

DI float softplus2(float z) { return fmaxf(z, 0.f) + __builtin_amdgcn_logf(1.f + __builtin_amdgcn_exp2f(-fabsf(z))); }
template <int VAR = 0> DI void p12_attn(Frame& F, bf16* O) {
    LAS unsigned char* kimg = F.lds + F.wave * 16384; LAS unsigned char* vimg = kimg + 8192;
    const bf16* Q = (const bf16*)(F.ws + WS_Q); const bf16* K = (const bf16*)(F.ws + WS_K); const bf16* V = (const bf16*)(F.ws + WS_VV);
    const int wave = F.wave;
    for (int bh = F.bid; bh < 256; bh += F.G) {
        const int b = bh >> 4, h = bh & 15;
#pragma unroll 1
        for (int qi = 0; qi < 8; ++qi) {
            int lane = F.lane; asm volatile("" : "+v"(lane)); const int r32 = lane & 31, hi = lane >> 5;
            const int skey = lane >> 3, schk = lane & 7;
            const int qt = 63 - (wave + 8 * qi);
            const int qlo = qt * 32;
            const size_t tq0 = (size_t)b * SEQ + qlo;
            bf16x8 qr[4];
#pragma unroll
            for (int ks = 0; ks < 4; ++ks) qr[ks] = *(const bf16x8*)(Q + (tq0 + r32) * 1024 + h * 64 + 16 * ks + 8 * hi);
            f32x16 o0 = {}, o1 = {}; float R = (VAR == 3 || VAR == 5) ? 1.f : 0.f;
            const int kt0 = (qlo + 30) >> 5;
            u32x4 kraw[4], vraw[4];
            { const bf16* kp = K + ((size_t)b * SEQ + 32 * kt0 + skey) * 1024 + h * 64 + 8 * schk; const bf16* vp = V + ((size_t)b * SEQ + 32 * kt0 + skey) * 1024 + h * 64 + 8 * schk;
#pragma unroll
              for (int i = 0; i < 4; ++i) { kraw[i] = *(const u32x4*)(kp + (size_t)i * 8 * 1024); vraw[i] = *(const u32x4*)(vp + (size_t)i * 8 * 1024); } }
#pragma unroll 1
            for (int kt = kt0; kt >= 0; --kt) {
#pragma unroll
                for (int i = 0; i < 4; ++i) { *(LAS u32x4*)(kimg + schk * 512 + (skey + 8 * i) * 16) = kraw[i]; *(LAS u32x4*)(vimg + tr_off(skey + 8 * i, schk)) = vraw[i]; }
                if (kt > 0) { const bf16* kp = K + ((size_t)b * SEQ + 32 * (kt - 1) + skey) * 1024 + h * 64 + 8 * schk; const bf16* vp = V + ((size_t)b * SEQ + 32 * (kt - 1) + skey) * 1024 + h * 64 + 8 * schk;
#pragma unroll
                    for (int i = 0; i < 4; ++i) { kraw[i] = *(const u32x4*)(kp + (size_t)i * 8 * 1024); vraw[i] = *(const u32x4*)(vp + (size_t)i * 8 * 1024); } }
                {
                    const bool diag = (32 * kt + 31 >= qlo);
                    const int qrel = qlo + r32 - 32 * kt;
                    f32x16 p = {};
#pragma unroll
                    for (int ks = 0; ks < 4; ++ks) p = MFMA32(row_frag<32>(kimg, 0, ks, lane), qr[ks], p);
                    if constexpr (VAR == 5) {
                    f32x2_t be2[8], om2[8];
#pragma unroll
                    for (int j = 0; j < 8; ++j) { const float t0 = __builtin_amdgcn_fmed3f(p[2 * j], -120.f, 3.0e38f), t1 = __builtin_amdgcn_fmed3f(p[2 * j + 1], -120.f, 3.0e38f);
                        const f32x2_t e = {__builtin_amdgcn_exp2f(-t0), __builtin_amdgcn_exp2f(-t1)}; const f32x2_t d = e + 1.0f;
                        const f32x2_t bb = {__builtin_amdgcn_rcpf(d.x), __builtin_amdgcn_rcpf(d.y)}; be2[j] = bb; om2[j] = e * bb; }
                    if (diag) {
#pragma unroll
                        for (int j = 0; j < 8; ++j) { const bool ok0 = crow(2 * j, hi) < qrel, ok1 = crow(2 * j + 1, hi) < qrel;
                            be2[j].x = ok0 ? be2[j].x : 0.f; om2[j].x = ok0 ? om2[j].x : 1.f; be2[j].y = ok1 ? be2[j].y : 0.f; om2[j].y = ok1 ? om2[j].y : 1.f; }
                    }
                    float ex1[4], ex0[4], gt[4], og[4], T[4];
#pragma unroll
                    for (int g = 0; g < 4; ++g) { ex1[g] = om2[2 * g + 1].y * om2[2 * g + 1].x; ex0[g] = ex1[g] * om2[2 * g].y; gt[g] = ex0[g] * om2[2 * g].x; }
#pragma unroll
                    for (int g = 0; g < 4; ++g) og[g] = __shfl_xor(gt[g], 32);
                    T[3] = 1.f; T[2] = gt[3] * og[3]; T[1] = T[2] * (gt[2] * og[2]); T[0] = T[1] * (gt[1] * og[1]);
                    const float tot = T[0] * (gt[0] * og[0]);
#pragma unroll
                    for (int g = 0; g < 4; ++g) { const float off = T[g] * (hi == 0 ? og[g] : 1.f) * R; const f32x2_t off2 = {off, off};
                        const f32x2_t t01 = (f32x2_t){ex0[g], ex1[g]} * off2; const f32x2_t t23 = {om2[2 * g + 1].y * off, off};
                        const f32x2_t p01 = be2[2 * g] * t01, p23 = be2[2 * g + 1] * t23;
                        p[4 * g] = p01.x; p[4 * g + 1] = p01.y; p[4 * g + 2] = p23.x; p[4 * g + 3] = p23.y; }
                    R *= tot;
                    } else
                    if constexpr (VAR == 3) {
                    float be[16], om[16];
#pragma unroll
                    for (int r = 0; r < 16; ++r) { const float e = __builtin_amdgcn_exp2f(-fmaxf(p[r], -120.f)); const float bb = __builtin_amdgcn_rcpf(1.f + e); be[r] = bb; om[r] = e * bb; }
                    if (diag) {
#pragma unroll
                        for (int r = 0; r < 16; ++r) { const bool ok = crow(r, hi) < qrel; be[r] = ok ? be[r] : 0.f; om[r] = ok ? om[r] : 1.f; }
                    }
                    float ex1[4], ex0[4], gt[4], og[4], T[4];
#pragma unroll
                    for (int g = 0; g < 4; ++g) { ex1[g] = om[4 * g + 3] * om[4 * g + 2]; ex0[g] = ex1[g] * om[4 * g + 1]; gt[g] = ex0[g] * om[4 * g]; }
#pragma unroll
                    for (int g = 0; g < 4; ++g) og[g] = __shfl_xor(gt[g], 32);
                    T[3] = 1.f; T[2] = gt[3] * og[3]; T[1] = T[2] * (gt[2] * og[2]); T[0] = T[1] * (gt[1] * og[1]);
                    const float tot = T[0] * (gt[0] * og[0]);
#pragma unroll
                    for (int g = 0; g < 4; ++g) { const float off = T[g] * (hi == 0 ? og[g] : 1.f) * R;
                        p[4 * g + 3] = be[4 * g + 3] * off; p[4 * g + 2] = be[4 * g + 2] * (om[4 * g + 3] * off); p[4 * g + 1] = be[4 * g + 1] * (ex1[g] * off); p[4 * g] = be[4 * g] * (ex0[g] * off); }
                    R *= tot;
                    } else {
                    float sp[16], mk[16];
                    if (diag) {
#pragma unroll
                        for (int r = 0; r < 16; ++r) { mk[r] = crow(r, hi) < qrel ? 1.f : 0.f; sp[r] = softplus2(p[r]) * mk[r]; }
                    } else {
#pragma unroll
                        for (int r = 0; r < 16; ++r) { mk[r] = 1.f; sp[r] = softplus2(p[r]); }
                    }
#pragma unroll
                    for (int g = 0; g < 4; ++g) { sp[4 * g + 2] += sp[4 * g + 3]; sp[4 * g + 1] += sp[4 * g + 2]; sp[4 * g] += sp[4 * g + 1]; }
                    float og[4], T[4], off[4];
#pragma unroll
                    for (int g = 0; g < 4; ++g) og[g] = __shfl_xor(sp[4 * g], 32);
                    T[3] = 0.f; T[2] = sp[12] + og[3]; T[1] = T[2] + sp[8] + og[2]; T[0] = T[1] + sp[4] + og[1];
                    const float tot = T[0] + sp[0] + og[0];
#pragma unroll
                    for (int g = 0; g < 4; ++g) off[g] = T[g] + (hi == 0 ? og[g] : 0.f) + R;
#pragma unroll
                    for (int r = 0; r < 16; ++r) p[r] = __builtin_amdgcn_exp2f(p[r] - sp[r] - off[r >> 2]) * mk[r];
                    R += tot;
                    }
                    const bf16x8 pa0 = pack8(p, 0), pa1 = pack8(p, 1);
                    o0 = MFMA32(pa0, tr_frag(vimg, 0, 0, lane), o0); o1 = MFMA32(pa0, tr_frag(vimg, 1, 0, lane), o1);
                    o0 = MFMA32(pa1, tr_frag(vimg, 0, 1, lane), o0); o1 = MFMA32(pa1, tr_frag(vimg, 1, 1, lane), o1);
                }
                if (VAR == 3 || VAR == 5) { if (__all(R == 0.f)) break; asm volatile("s_waitcnt lgkmcnt(0)" ::: "memory"); continue; }
                if (VAR == 1) break;
                if (__all(R >= (VAR == 2 ? 75.05f : 150.1f))) break;
                asm volatile("s_waitcnt lgkmcnt(0)" ::: "memory");
            }
            asm volatile("s_waitcnt lgkmcnt(0)" ::: "memory");
#pragma unroll
            for (int r = 0; r < 16; ++r) { bf16* op = O + (tq0 + crow(r, hi)) * 1024 + h * 64 + r32;
                op[0] = (bf16)(cvtpk(o0[r], 0.f) & 0xffffu); op[32] = (bf16)(cvtpk(o1[r], 0.f) & 0xffffu); }
        }
    }
}

template <int VAR = 0> DI void p12_attn_pipe(Frame& F, bf16* O) {
    LAS unsigned char* img = F.lds + F.wave * 16384;
    const bf16* Q = (const bf16*)(F.ws + WS_Q); const bf16* K = (const bf16*)(F.ws + WS_K); const bf16* V = (const bf16*)(F.ws + WS_VV);
    const int wave = F.wave;
    for (int bh = F.bid; bh < 256; bh += F.G) {
        const int b = bh >> 4, h = bh & 15;
#pragma unroll 1
        for (int qi = 0; qi < 8; ++qi) {
            int lane = F.lane; asm volatile("" : "+v"(lane)); const int r32 = lane & 31, hi = lane >> 5;
            const int skey = lane >> 3, schk = lane & 7;
            const int qt = 63 - (wave + 8 * qi);
            const int qlo = qt * 32;
            const size_t tq0 = (size_t)b * SEQ + qlo;
            bf16x8 qr[4];
#pragma unroll
            for (int ks = 0; ks < 4; ++ks) qr[ks] = *(const bf16x8*)(Q + (tq0 + r32) * 1024 + h * 64 + 16 * ks + 8 * hi);
            f32x16 o0 = {}, o1 = {}; float R = 1.f;
            const int kt0 = (qlo + 30) >> 5;
            u32x4 kraw[4], vraw[4];
#define ATT_LOAD(KT) { const size_t ro = ((size_t)b * SEQ + 32 * (KT) + skey) * 1024 + h * 64 + 8 * schk; \
              _Pragma("unroll") for (int i = 0; i < 4; ++i) { kraw[i] = *(const u32x4*)(K + ro + (size_t)i * 8 * 1024); vraw[i] = *(const u32x4*)(V + ro + (size_t)i * 8 * 1024); } }
#define ATT_STAGE(PB) { LAS unsigned char* kb = img + 4096 * (PB); \
              _Pragma("unroll") for (int i = 0; i < 4; ++i) { *(LAS u32x4*)(kb + schk * 512 + (skey + 8 * i) * 16) = kraw[i]; *(LAS u32x4*)(kb + 8192 + tr_off(skey + 8 * i, schk)) = vraw[i]; } }
            ATT_LOAD(kt0)
            ATT_STAGE(0)
            if (kt0 > 0) ATT_LOAD(kt0 - 1)
            f32x16 z = {};
#pragma unroll
            for (int ks = 0; ks < 4; ++ks) z = MFMA32(row_frag<32>(img, 0, ks, lane), qr[ks], z);
            int par = 0;
#pragma unroll 1
            for (int kt = kt0; kt >= 0; --kt) {
                f32x16 zn = {};
                if (kt > 0) {
                    ATT_STAGE(par ^ 1)
                    if (kt > 1) ATT_LOAD(kt - 2)
#pragma unroll
                    for (int ks = 0; ks < 4; ++ks) zn = MFMA32(row_frag<32>(img + 4096 * (par ^ 1), 0, ks, lane), qr[ks], zn);
                }
                {
                    const bool diag = (32 * kt + 31 >= qlo);
                    const int qrel = qlo + r32 - 32 * kt;
                    float be[16], om[16];
#pragma unroll
                    for (int r = 0; r < 16; ++r) { const float e = __builtin_amdgcn_exp2f(-fmaxf(z[r], -120.f)); const float bb = __builtin_amdgcn_rcpf(1.f + e); be[r] = bb; om[r] = e * bb; }
                    if (diag) {
#pragma unroll
                        for (int r = 0; r < 16; ++r) { const bool ok = crow(r, hi) < qrel; be[r] = ok ? be[r] : 0.f; om[r] = ok ? om[r] : 1.f; }
                    }
                    float ex1[4], ex0[4], gt[4], og[4], T[4];
#pragma unroll
                    for (int g = 0; g < 4; ++g) { ex1[g] = om[4 * g + 3] * om[4 * g + 2]; ex0[g] = ex1[g] * om[4 * g + 1]; gt[g] = ex0[g] * om[4 * g]; }
#pragma unroll
                    for (int g = 0; g < 4; ++g) og[g] = __shfl_xor(gt[g], 32);
                    T[3] = 1.f; T[2] = gt[3] * og[3]; T[1] = T[2] * (gt[2] * og[2]); T[0] = T[1] * (gt[1] * og[1]);
                    const float tot = T[0] * (gt[0] * og[0]);
                    f32x16 p;
#pragma unroll
                    for (int g = 0; g < 4; ++g) { const float off = T[g] * (hi == 0 ? og[g] : 1.f) * R;
                        p[4 * g + 3] = be[4 * g + 3] * off; p[4 * g + 2] = be[4 * g + 2] * (om[4 * g + 3] * off); p[4 * g + 1] = be[4 * g + 1] * (ex1[g] * off); p[4 * g] = be[4 * g] * (ex0[g] * off); }
                    R *= tot;
                    const bf16x8 pa0 = pack8(p, 0), pa1 = pack8(p, 1);
                    LAS unsigned char* vimg = img + 8192 + 4096 * par;
                    o0 = MFMA32(pa0, tr_frag(vimg, 0, 0, lane), o0); o1 = MFMA32(pa0, tr_frag(vimg, 1, 0, lane), o1);
                    o0 = MFMA32(pa1, tr_frag(vimg, 0, 1, lane), o0); o1 = MFMA32(pa1, tr_frag(vimg, 1, 1, lane), o1);
                }
                if (__all(R == 0.f)) break;
                z = zn; par ^= 1;
            }
#undef ATT_LOAD
#undef ATT_STAGE
            asm volatile("s_waitcnt lgkmcnt(0)" ::: "memory");
#pragma unroll
            for (int r = 0; r < 16; ++r) { bf16* op = O + (tq0 + crow(r, hi)) * 1024 + h * 64 + r32;
                op[0] = (bf16)(cvtpk(o0[r], 0.f) & 0xffffu); op[32] = (bf16)(cvtpk(o1[r], 0.f) & 0xffffu); }
        }
    }
}

DI void sb_weights(const f32x16& z, float& R, bool diag, int qrel, int hi, bf16x8& pa0, bf16x8& pa1) {
    f32x2_t be2[8], om2[8];
#pragma unroll
    for (int j = 0; j < 8; ++j) { const float t0 = __builtin_amdgcn_fmed3f(z[2 * j], -120.f, 3.0e38f), t1 = __builtin_amdgcn_fmed3f(z[2 * j + 1], -120.f, 3.0e38f);
        const f32x2_t e = {__builtin_amdgcn_exp2f(-t0), __builtin_amdgcn_exp2f(-t1)}; const f32x2_t d = e + 1.0f;
        const f32x2_t bb = {__builtin_amdgcn_rcpf(d.x), __builtin_amdgcn_rcpf(d.y)}; be2[j] = bb; om2[j] = e * bb; }
    if (diag) {
#pragma unroll
        for (int j = 0; j < 8; ++j) { const bool ok0 = crow(2 * j, hi) < qrel, ok1 = crow(2 * j + 1, hi) < qrel;
            be2[j].x = ok0 ? be2[j].x : 0.f; om2[j].x = ok0 ? om2[j].x : 1.f; be2[j].y = ok1 ? be2[j].y : 0.f; om2[j].y = ok1 ? om2[j].y : 1.f; }
    }
    float ex1[4], ex0[4], gt[4], og[4], T[4];
#pragma unroll
    for (int g = 0; g < 4; ++g) { ex1[g] = om2[2 * g + 1].y * om2[2 * g + 1].x; ex0[g] = ex1[g] * om2[2 * g].y; gt[g] = ex0[g] * om2[2 * g].x; }
#pragma unroll
    for (int g = 0; g < 4; ++g) og[g] = __shfl_xor(gt[g], 32);
    T[3] = 1.f; T[2] = gt[3] * og[3]; T[1] = T[2] * (gt[2] * og[2]); T[0] = T[1] * (gt[1] * og[1]);
    const float tot = T[0] * (gt[0] * og[0]);
    u32x4 w0, w1;
#pragma unroll
    for (int g = 0; g < 4; ++g) { const float off = T[g] * (hi == 0 ? og[g] : 1.f) * R; const f32x2_t off2 = {off, off};
        const f32x2_t t01 = (f32x2_t){ex0[g], ex1[g]} * off2; const f32x2_t t23 = {om2[2 * g + 1].y * off, off};
        const f32x2_t p01 = be2[2 * g] * t01, p23 = be2[2 * g + 1] * t23;
        const unsigned c01 = cvtpk(p01.x, p01.y), c23 = cvtpk(p23.x, p23.y);
        if (g == 0) { w0.x = c01; w0.y = c23; } else if (g == 1) { w0.z = c01; w0.w = c23; } else if (g == 2) { w1.x = c01; w1.y = c23; } else { w1.z = c01; w1.w = c23; } }
    R *= tot;
    pa0 = __builtin_bit_cast(bf16x8, w0); pa1 = __builtin_bit_cast(bf16x8, w1);
}
template <int VAR = 0> DI void p12_attn_v2(Frame& F, bf16* O) {
    LAS unsigned char* img = F.lds + F.wave * 16384;
    const bf16* Q = (const bf16*)(F.ws + WS_Q);
    const int wave = F.wave;
    for (int bh = F.bid; bh < 256; bh += F.G) {
        const int b = bh >> 4, h = bh & 15;
        const char* Kb = (const char*)(F.ws + WS_K) + ((size_t)b * SEQ * 1024 + h * 64) * 2; const char* Vb = (const char*)(F.ws + WS_VV) + ((size_t)b * SEQ * 1024 + h * 64) * 2;
#pragma unroll 1
        for (int qi = 0; qi < 8; ++qi) {
            int lane = F.lane; asm volatile("" : "+v"(lane)); const int r32 = lane & 31, hi = lane >> 5;
            const int skey = lane >> 3, schk = lane & 7;
            const unsigned lo0 = (unsigned)(skey * 1024 + 8 * schk) * 2u;
            const int qt = 63 - (wave + 8 * qi);
            const int qlo = qt * 32;
            const size_t tq0 = (size_t)b * SEQ + qlo;
            bf16x8 qr[4];
#pragma unroll
            for (int ks = 0; ks < 4; ++ks) qr[ks] = *(const bf16x8*)(Q + (tq0 + r32) * 1024 + h * 64 + 16 * ks + 8 * hi);
            f32x16 o0 = {}, o1 = {}; float R = 1.f;
            const int kt0 = (qlo + 30) >> 5;
            u32x4 ka[4], va[4], kb[4], vb[4];
#define ATT_LOAD(RK, RV, KT) { const char* kp_ = Kb + (size_t)(KT) * 65536; const char* vp_ = Vb + (size_t)(KT) * 65536; \
              _Pragma("unroll") for (int i = 0; i < 4; ++i) { RK[i] = *(const u32x4*)(kp_ + (size_t)(lo0 + 16384u * i)); RV[i] = *(const u32x4*)(vp_ + (size_t)(lo0 + 16384u * i)); } }
#define ATT_STAGE(RK, RV, PB) { _Pragma("unroll") for (int i = 0; i < 4; ++i) { *(LAS u32x4*)(img + 4096 * (PB) + schk * 512 + (skey + 8 * i) * 16) = RK[i]; *(LAS u32x4*)(img + 8192 + 4096 * (PB) + tr_off(skey + 8 * i, schk)) = RV[i]; } }
#define ATT_QK(Z, PB) { Z = (f32x16){}; _Pragma("unroll") for (int ks = 0; ks < 4; ++ks) Z = MFMA32(row_frag<32>(img + 4096 * (PB), 0, ks, lane), qr[ks], Z); }
#define ATT_TILE(Z, PB, KT) { bf16x8 pa0, pa1; sb_weights(Z, R, (32 * (KT) + 31 >= qlo) || (KT) < 0, (KT) < 0 ? 0 : qlo + r32 - 32 * (KT), hi, pa0, pa1); LAS unsigned char* vimg = img + 8192 + 4096 * (PB); \
              o0 = MFMA32(pa0, tr_frag(vimg, 0, 0, lane), o0); o1 = MFMA32(pa0, tr_frag(vimg, 1, 0, lane), o1); o0 = MFMA32(pa1, tr_frag(vimg, 0, 1, lane), o0); o1 = MFMA32(pa1, tr_frag(vimg, 1, 1, lane), o1); }
            int kt = kt0;
            ATT_LOAD(ka, va, kt0)
            ATT_LOAD(kb, vb, max(kt0 - 1, 0))
            ATT_STAGE(ka, va, 0)
            ATT_LOAD(ka, va, max(kt0 - 2, 0))
            f32x16 z, zn;
            ATT_QK(z, 0)
#pragma unroll 1
            do {
                { ATT_STAGE(kb, vb, 1) ATT_LOAD(kb, vb, max(kt - 3, 0)) ATT_QK(zn, 1) }
                ATT_TILE(z, 0, kt)
                { ATT_STAGE(ka, va, 0) ATT_LOAD(ka, va, max(kt - 4, 0)) ATT_QK(z, 0) }
                ATT_TILE(zn, 1, kt - 1)
                kt -= 2;
            } while (kt >= 0 && !__all(R == 0.f));
#undef ATT_LOAD
#undef ATT_STAGE
#undef ATT_QK
#undef ATT_TILE
#pragma unroll
            for (int r = 0; r < 16; ++r) { bf16* op = O + (tq0 + crow(r, hi)) * 1024 + h * 64 + r32;
                op[0] = (bf16)(cvtpk(o0[r], 0.f) & 0xffffu); op[32] = (bf16)(cvtpk(o1[r], 0.f) & 0xffffu); }
        }
    }
}

DI int tr_off32(int tok, int ch) { return (ch >> 2) * 2048 + (tok >> 4) * 1024 + (tok & 15) * 64 + (ch & 3) * 16; }
DI bf16x8 tr_frag32(const LAS unsigned char* img, int dh, int ks, int lane) {
    const int hi = lane >> 5; const int vb = ((lane >> 4) & 1) * 32 + (lane & 3) * 8 + (4 * hi + ((lane & 15) >> 2)) * 64;
    const s16x4 lo = tr16(img + vb + dh * 2048 + ks * 1024), h2 = tr16(img + vb + dh * 2048 + ks * 1024 + 512);
    return __builtin_shufflevector(lo, h2, 0, 1, 2, 3, 4, 5, 6, 7);
}
template <int VAR = 0> DI void p12_attn_v3(Frame& F, bf16* O) {
    LAS unsigned char* ring = F.lds;
    const bf16* Q = (const bf16*)(F.ws + WS_Q);
    const int wave = F.wave;
    for (int bh = F.bid; bh < 256; bh += F.G) {
        const int b = bh >> 4, h = bh & 15;
        const char* Kb = (const char*)(F.ws + WS_K) + ((size_t)b * SEQ * 1024 + h * 64) * 2; const char* Vb = (const char*)(F.ws + WS_VV) + ((size_t)b * SEQ * 1024 + h * 64) * 2;
        int lane = F.lane; asm volatile("" : "+v"(lane)); const int r32 = lane & 31, hi = lane >> 5;
        const int skey = lane >> 3, schk = lane & 7;
        const unsigned lo0 = (unsigned)(skey * 1024 + 8 * schk) * 2u;
        u32x4 kraw[4], vraw[4];
        bf16x8 qr[4], qn[4];
#define ATT_LOAD(KT) { const char* kp_ = Kb + (size_t)(KT) * 65536; const char* vp_ = Vb + (size_t)(KT) * 65536; \
          _Pragma("unroll") for (int i = 0; i < 4; ++i) { kraw[i] = *(const u32x4*)(kp_ + (size_t)(lo0 + 16384u * i)); vraw[i] = *(const u32x4*)(vp_ + (size_t)(lo0 + 16384u * i)); } }
#define ATT_STAGE(KT) { LAS unsigned char* sl_ = ring + ((KT) & 15) * 8192; \
          _Pragma("unroll") for (int i = 0; i < 4; ++i) { *(LAS u32x4*)(sl_ + schk * 512 + (skey + 8 * i) * 16) = kraw[i]; *(LAS u32x4*)(sl_ + 4096 + tr_off32(skey + 8 * i, schk)) = vraw[i]; } }
#define ATT_LOADQ(QR, QT) { _Pragma("unroll") for (int ks = 0; ks < 4; ++ks) QR[ks] = *(const bf16x8*)(Q + ((size_t)b * SEQ + 32 * (QT) + r32) * 1024 + h * 64 + 16 * ks + 8 * hi); }
        __syncthreads();
        ATT_LOAD(63 - wave) ATT_STAGE(63 - wave)
        ATT_LOAD(55 - wave) ATT_STAGE(55 - wave)
        ATT_LOADQ(qr, 63 - wave)
        __syncthreads();
#pragma unroll 1
        for (int qi = 0; qi < 8; ++qi) {
            const int qt_hi = 63 - 8 * qi, qt = qt_hi - wave, qlo = 32 * qt;
            const int lowwin = (VAR == 8) ? max(qt - 2, max(qt_hi - 15, 0)) : max(qt_hi - 15, 0);
            const int tnew = qt_hi - 16 - wave;
            if (tnew >= 0) ATT_LOAD(tnew)
            if (qi < 7) ATT_LOADQ(qn, qt - 8)
            f32x16 o0 = {}, o1 = {}; float R = 1.f;
            bool dead = false;
            int kt = qt;
#pragma unroll 1
            for (; kt >= lowwin; --kt) {
                const LAS unsigned char* kimg = ring + (kt & 15) * 8192;
                f32x16 z = {};
#pragma unroll
                for (int ks = 0; ks < 4; ++ks) z = MFMA32(row_frag<32>(kimg, 0, ks, lane), qr[ks], z);
                bf16x8 pa0, pa1; sb_weights(z, R, 32 * kt + 31 >= qlo, qlo + r32 - 32 * kt, hi, pa0, pa1);
                o0 = MFMA32(pa0, tr_frag32(kimg + 4096, 0, 0, lane), o0); o1 = MFMA32(pa0, tr_frag32(kimg + 4096, 1, 0, lane), o1);
                o0 = MFMA32(pa1, tr_frag32(kimg + 4096, 0, 1, lane), o0); o1 = MFMA32(pa1, tr_frag32(kimg + 4096, 1, 1, lane), o1);
                if (__all(R == 0.f)) { dead = true; break; }
            }
            if (!dead) {
#pragma unroll 1
                for (kt = lowwin - 1; kt >= 0; --kt) {
                    const char* kp = Kb + (size_t)kt * 65536; const unsigned short* vp = (const unsigned short*)(Vb + (size_t)kt * 65536);
                    f32x16 z = {};
#pragma unroll
                    for (int ks = 0; ks < 4; ++ks) z = MFMA32(*(const bf16x8*)(kp + ((size_t)r32 * 1024 + 16 * ks + 8 * hi) * 2), qr[ks], z);
                    bf16x8 pa0, pa1; sb_weights(z, R, 32 * kt + 31 >= qlo, qlo + r32 - 32 * kt, hi, pa0, pa1);
#pragma unroll
                    for (int ks = 0; ks < 2; ++ks)
#pragma unroll
                        for (int dh = 0; dh < 2; ++dh) {
                            unsigned e[8];
#pragma unroll
                            for (int j = 0; j < 8; ++j) e[j] = vp[(size_t)(16 * ks + 8 * (j >> 2) + 4 * hi + (j & 3)) * 1024 + 32 * dh + r32];
                            u32x4 w; w.x = e[0] | (e[1] << 16); w.y = e[2] | (e[3] << 16); w.z = e[4] | (e[5] << 16); w.w = e[6] | (e[7] << 16);
                            const bf16x8 vf = __builtin_bit_cast(bf16x8, w);
                            if (dh == 0) o0 = MFMA32(ks == 0 ? pa0 : pa1, vf, o0); else o1 = MFMA32(ks == 0 ? pa0 : pa1, vf, o1);
                        }
                    if (__all(R == 0.f)) break;
                }
            }
#pragma unroll
            for (int r = 0; r < 16; ++r) { bf16* op = O + ((size_t)b * SEQ + qlo + crow(r, hi)) * 1024 + h * 64 + r32;
                op[0] = (bf16)(cvtpk(o0[r], 0.f) & 0xffffu); op[32] = (bf16)(cvtpk(o1[r], 0.f) & 0xffffu); }
            __syncthreads();
            if (tnew >= 0) ATT_STAGE(tnew)
            if (qi < 7) {
#pragma unroll
                for (int ks = 0; ks < 4; ++ks) qr[ks] = qn[ks];
            }
            __syncthreads();
        }
#undef ATT_LOAD
#undef ATT_STAGE
#undef ATT_LOADQ
    }
}

__device__ constexpr int NET16_A[63] = {0,2,0,1,1,4,6,4,5,5,0,2,2,1,3,3,1,3,5,8,10,8,9,9,12,14,12,13,13,8,10,10,9,11,11,9,11,13,0,4,4,2,6,6,2,6,10,1,5,5,3,7,7,3,7,11,1,3,5,7,9,11,13};
__device__ constexpr int NET16_B[63] = {1,3,2,3,2,5,7,6,7,6,4,6,4,5,7,5,2,4,6,9,11,10,11,10,13,15,14,15,14,12,14,12,13,15,13,10,12,14,8,12,8,10,14,10,4,8,12,9,13,9,11,15,11,5,9,13,2,4,6,8,10,12,14};
__device__ constexpr int BIT16_A[32] = {0,1,2,3,4,5,6,7,0,1,2,3,8,9,10,11,0,1,4,5,8,9,12,13,0,2,4,6,8,10,12,14};
__device__ constexpr int BIT16_B[32] = {8,9,10,11,12,13,14,15,4,5,6,7,12,13,14,15,2,3,6,7,10,11,14,15,1,3,5,7,9,11,13,15};
DI unsigned umax_(unsigned a, unsigned b) { return a > b ? a : b; }
DI unsigned umin_(unsigned a, unsigned b) { return a < b ? a : b; }
DI void sort16(unsigned (&k)[16]) {
#pragma unroll
    for (int c = 0; c < 63; ++c) { const unsigned a = k[NET16_A[c]], b = k[NET16_B[c]]; k[NET16_A[c]] = umax_(a, b); k[NET16_B[c]] = umin_(a, b); }
}
DI void bitonic16(unsigned (&k)[16]) {
#pragma unroll
    for (int c = 0; c < 32; ++c) { const unsigned a = k[BIT16_A[c]], b = k[BIT16_B[c]]; k[BIT16_A[c]] = umax_(a, b); k[BIT16_B[c]] = umin_(a, b); }
}
DI void merge16(unsigned (&x)[16], const unsigned (&y)[16]) {
#pragma unroll
    for (int i = 0; i < 16; ++i) x[i] = umax_(x[i], y[15 - i]);
    bitonic16(x);
}
DI unsigned f2key(float x) { const unsigned b = __float_as_uint(x); return b ^ ((unsigned)((int)b >> 31) | 0x80000000u); }
DI float key2f(unsigned k) { return __uint_as_float(k ^ (~(unsigned)((int)k >> 31) | 0x80000000u)); }

DI void p_route(Frame& F, int layer) {
    LAS unsigned char* simg = F.lds;
    LAS unsigned char* dec = F.lds + 65536 + F.wave * 1024;
    { const u32x4* src = (const u32x4*)((const bf16*)(F.ws + WS_SUBK) + (size_t)layer * 2 * 128 * 128);
      for (int i = F.tid; i < 2 * 128 * 16; i += NT) { const int p = i >> 11, n = (i >> 4) & 127, ch = i & 15; *(LAS u32x4*)(simg + p * 32768 + ch * 2048 + n * 16) = src[i]; } }
    __syncthreads();
    const bf16* PQ = (const bf16*)(F.ws + WS_PQ);
    const int lane = F.lane, r32 = lane & 31, hi = lane >> 5;
    const int gw = F.bid * NWAVES + F.wave, NGW = F.G * NWAVES;
    for (int wu = gw; wu < T_TOK * 8 / 32; wu += NGW) {
        const int row = wu * 32 + r32, t = row >> 3, hd = row & 7;
        unsigned top[2][16];
#pragma unroll
        for (int p = 0; p < 2; ++p) {
            bf16x8 qf[8];
#pragma unroll
            for (int ks = 0; ks < 8; ++ks) qf[ks] = *(const bf16x8*)(PQ + (size_t)t * 2048 + hd * 256 + p * 128 + 16 * ks + 8 * hi);
            unsigned keys[4][16];
#pragma unroll
            for (int nt = 0; nt < 4; ++nt) {
                f32x16 acc = {};
#pragma unroll
                for (int ks = 0; ks < 8; ++ks) acc = MFMA32(*(const LAS bf16x8*)(simg + p * 32768 + (2 * ks + hi) * 2048 + (32 * nt + r32) * 16), qf[ks], acc);
#pragma unroll
                for (int r = 0; r < 16; ++r) keys[nt][r] = (f2key(acc[r]) & 0xFFFFFF80u) | (unsigned)(32 * nt + crow(r, 0)) | (unsigned)(4 * hi);
                sort16(keys[nt]);
            }
            merge16(keys[0], keys[1]); merge16(keys[2], keys[3]); merge16(keys[0], keys[2]);
            unsigned lo[16], up[16];
#pragma unroll
            for (int i = 0; i < 16; ++i) { auto rr = __builtin_amdgcn_permlane32_swap(keys[0][i], keys[0][i], false, false); lo[i] = rr[0]; up[i] = rr[1]; }
#pragma unroll
            for (int i = 0; i < 16; ++i) top[p][i] = umax_(lo[i], up[15 - i]);
            bitonic16(top[p]);
        }
        if (hi == 0) {
            u32x4 w0, w1, w2, w3;
            w0.x = (top[0][0] & 127u) | ((top[0][1] & 127u) << 8) | ((top[0][2] & 127u) << 16) | ((top[0][3] & 127u) << 24);
            w0.y = (top[0][4] & 127u) | ((top[0][5] & 127u) << 8) | ((top[0][6] & 127u) << 16) | ((top[0][7] & 127u) << 24);
            w0.z = (top[0][8] & 127u) | ((top[0][9] & 127u) << 8) | ((top[0][10] & 127u) << 16) | ((top[0][11] & 127u) << 24);
            w0.w = (top[0][12] & 127u) | ((top[0][13] & 127u) << 8) | ((top[0][14] & 127u) << 16) | ((top[0][15] & 127u) << 24);
            w1.x = (top[1][0] & 127u) | ((top[1][1] & 127u) << 8) | ((top[1][2] & 127u) << 16) | ((top[1][3] & 127u) << 24);
            w1.y = (top[1][4] & 127u) | ((top[1][5] & 127u) << 8) | ((top[1][6] & 127u) << 16) | ((top[1][7] & 127u) << 24);
            w1.z = (top[1][8] & 127u) | ((top[1][9] & 127u) << 8) | ((top[1][10] & 127u) << 16) | ((top[1][11] & 127u) << 24);
            w1.w = (top[1][12] & 127u) | ((top[1][13] & 127u) << 8) | ((top[1][14] & 127u) << 16) | ((top[1][15] & 127u) << 24);
            *(LAS u32x4*)(dec + r32 * 32) = w0; *(LAS u32x4*)(dec + r32 * 32 + 16) = w1;
        }
        float av[16], bv[16];
#pragma unroll
        for (int i = 0; i < 16; ++i) { av[i] = key2f(top[0][i] & 0xFFFFFF80u); bv[i] = key2f(top[1][i] & 0xFFFFFF80u); }
        unsigned c0[16], c1[16], c2[16], c3[16];
#pragma unroll
        for (int j = 0; j < 16; ++j) c0[j] = (f2key(av[0] + bv[j]) & 0xFFFFFF00u) | (unsigned)j;
        {
            int n = 0;
#pragma unroll
            for (int i = 1; i < 16; ++i)
#pragma unroll
                for (int j = 0; j < 16; ++j) if ((i + 1) * (j + 1) <= 16) {
                    const unsigned k = (f2key(av[i] + bv[j]) & 0xFFFFFF00u) | (unsigned)(i * 16 + j);
                    if (n < 16) c1[n] = k; else if (n < 32) c2[n - 16] = k; else c3[n - 32] = k;
                    ++n; }
#pragma unroll
            for (int q = 2; q < 16; ++q) c3[q] = 0u;
        }
        sort16(c1); sort16(c2); { const unsigned a = c3[0], b = c3[1]; c3[0] = umax_(a, b); c3[1] = umin_(a, b); }
        merge16(c0, c1); merge16(c2, c3); merge16(c0, c2);
        asm volatile("s_waitcnt lgkmcnt(0)" ::: "memory");
        float gv[16]; unsigned ex[16]; float gs = 0.f;
        const float vmax = key2f(c0[0] & 0xFFFFFF00u);
#pragma unroll
        for (int k = 0; k < 16; ++k) {
            const unsigned code = c0[k] & 255u; const unsigned i = code >> 4, j = code & 15u;
            const unsigned ia = *(const LAS unsigned char*)(dec + r32 * 32 + i), ib = *(const LAS unsigned char*)(dec + r32 * 32 + 16 + j);
            ex[k] = ia * 128u + ib;
            gv[k] = __expf(key2f(c0[k] & 0xFFFFFF00u) - vmax); gs += gv[k];
        }
        const float ginv = 1.0f / gs;
        if (hi == 0) {
            u32x4 e0, e1;
            e0.x = ex[0] | (ex[1] << 16); e0.y = ex[2] | (ex[3] << 16); e0.z = ex[4] | (ex[5] << 16); e0.w = ex[6] | (ex[7] << 16);
            e1.x = ex[8] | (ex[9] << 16); e1.y = ex[10] | (ex[11] << 16); e1.z = ex[12] | (ex[13] << 16); e1.w = ex[14] | (ex[15] << 16);
            u32x4* ip = (u32x4*)((unsigned short*)(F.ws + WS_IDX) + (size_t)row * 16); ip[0] = e0; ip[1] = e1;
        } else {
            f32x4* gp = (f32x4*)((float*)(F.ws + WS_GATE) + (size_t)row * 16);
            gp[0] = (f32x4){gv[0] * ginv, gv[1] * ginv, gv[2] * ginv, gv[3] * ginv}; gp[1] = (f32x4){gv[4] * ginv, gv[5] * ginv, gv[6] * ginv, gv[7] * ginv};
            gp[2] = (f32x4){gv[8] * ginv, gv[9] * ginv, gv[10] * ginv, gv[11] * ginv}; gp[3] = (f32x4){gv[12] * ginv, gv[13] * ginv, gv[14] * ginv, gv[15] * ginv};
        }
    }
}

constexpr float U_SCALE = 32.f, V_SCALE = 4.f;
struct RowBuf { u32x4 r[16]; };
DI void load_rows(RowBuf& rb, const unsigned char* tbl, int idxs, int k0, int lane) {
#pragma unroll
    for (int j = 0; j < 16; ++j) { const int e = __builtin_amdgcn_readlane(idxs, k0 + j); rb.r[j] = *((const u32x4*)(tbl + (size_t)e * 1024) + lane); }
}
DI int udots(const RowBuf& rb, const int (&hq)[4], int lane) {
    int p[16];
#pragma unroll
    for (int j = 0; j < 16; ++j) { int a = __builtin_amdgcn_sdot4((int)rb.r[j].x, hq[0], 0, false); a = __builtin_amdgcn_sdot4((int)rb.r[j].y, hq[1], a, false);
        a = __builtin_amdgcn_sdot4((int)rb.r[j].z, hq[2], a, false); p[j] = __builtin_amdgcn_sdot4((int)rb.r[j].w, hq[3], a, false); }
#pragma unroll
    for (int i = 0; i < 8; ++i) { const bool up = (lane & 8) != 0; const int send = up ? p[i] : p[i + 8], keep = up ? p[i + 8] : p[i]; p[i] = keep + lx<8>(send); }
#pragma unroll
    for (int i = 0; i < 4; ++i) { const bool up = (lane & 4) != 0; const int send = up ? p[i] : p[i + 4], keep = up ? p[i + 4] : p[i]; p[i] = keep + lx<7>(send); }
#pragma unroll
    for (int i = 0; i < 2; ++i) { const bool up = (lane & 2) != 0; const int send = up ? p[i] : p[i + 2], keep = up ? p[i + 2] : p[i]; p[i] = keep + lx<2>(send); }
    { const bool up = (lane & 1) != 0; const int send = up ? p[0] : p[1], keep = up ? p[1] : p[0]; p[0] = keep + lx<1>(send); }
    int s = p[0]; s += lx<16>(s); s += lx<32>(s);
    return s;
}
DI void vaccum(const RowBuf& rb, f32x2_t (&out)[8], float wv, int k0) {
#pragma unroll
    for (int j = 0; j < 16; ++j) { const float wk = __builtin_bit_cast(float, __builtin_amdgcn_readlane(__builtin_bit_cast(int, wv), k0 + j));
        out[0] = __builtin_amdgcn_cvt_pk_f32_fp8((int)rb.r[j].x, false) * wk + out[0]; out[1] = __builtin_amdgcn_cvt_pk_f32_fp8((int)rb.r[j].x, true) * wk + out[1];
        out[2] = __builtin_amdgcn_cvt_pk_f32_fp8((int)rb.r[j].y, false) * wk + out[2]; out[3] = __builtin_amdgcn_cvt_pk_f32_fp8((int)rb.r[j].y, true) * wk + out[3];
        out[4] = __builtin_amdgcn_cvt_pk_f32_fp8((int)rb.r[j].z, false) * wk + out[4]; out[5] = __builtin_amdgcn_cvt_pk_f32_fp8((int)rb.r[j].z, true) * wk + out[5];
        out[6] = __builtin_amdgcn_cvt_pk_f32_fp8((int)rb.r[j].w, false) * wk + out[6]; out[7] = __builtin_amdgcn_cvt_pk_f32_fp8((int)rb.r[j].w, true) * wk + out[7]; }
}
constexpr size_t WS_W = WS_PROJ;
constexpr size_t WS_PD = WS_PROJ + 32 * MiB;
constexpr int UP_LDS = 16384;
struct UTok { u32x4 r[16]; int hq[4]; };
DI void up_load(UTok& tb, const unsigned char* Us, const unsigned char* H2Qs, const LAS unsigned short* lidx, size_t t, int tt, int lane) {
    const int g = lane >> 3, c = lane & 7;
    const LAS u32x4* ip = (const LAS u32x4*)(lidx + tt * 128 + 16 * g); const u32x4 ia = ip[0], ib = ip[1];
    const unsigned e[16] = {ia.x & 0xffffu, ia.x >> 16, ia.y & 0xffffu, ia.y >> 16, ia.z & 0xffffu, ia.z >> 16, ia.w & 0xffffu, ia.w >> 16,
                            ib.x & 0xffffu, ib.x >> 16, ib.y & 0xffffu, ib.y >> 16, ib.z & 0xffffu, ib.z >> 16, ib.w & 0xffffu, ib.w >> 16};
#pragma unroll
    for (int i = 0; i < 16; ++i) tb.r[i] = *(const u32x4*)(Us + (size_t)e[i] * 128 + c * 16);
    const u32x4 a = *(const u32x4*)(H2Qs + t * 1024 + c * 16); tb.hq[0] = (int)a.x; tb.hq[1] = (int)a.y; tb.hq[2] = (int)a.z; tb.hq[3] = (int)a.w;
}
DI void up_compute(const UTok& tb, int* pd, size_t t, int lane) {
    int p[16];
#pragma unroll
    for (int i = 0; i < 16; ++i) { int a = __builtin_amdgcn_sdot4((int)tb.r[i].x, tb.hq[0], 0, false); a = __builtin_amdgcn_sdot4((int)tb.r[i].y, tb.hq[1], a, false);
        a = __builtin_amdgcn_sdot4((int)tb.r[i].z, tb.hq[2], a, false); p[i] = __builtin_amdgcn_sdot4((int)tb.r[i].w, tb.hq[3], a, false); }
#pragma unroll
    for (int i = 0; i < 8; ++i) { const bool up = (lane & 4) != 0; const int send = up ? p[i] : p[i + 8], keep = up ? p[i + 8] : p[i]; p[i] = keep + lx<7>(send); }
#pragma unroll
    for (int i = 0; i < 4; ++i) { const bool up = (lane & 2) != 0; const int send = up ? p[i] : p[i + 4], keep = up ? p[i + 4] : p[i]; p[i] = keep + lx<2>(send); }
#pragma unroll
    for (int i = 0; i < 2; ++i) { const bool up = (lane & 1) != 0; const int send = up ? p[i] : p[i + 2], keep = up ? p[i + 2] : p[i]; p[i] = keep + lx<1>(send); }
    const int k = 16 * (lane >> 3) + 8 * ((lane >> 2) & 1) + 4 * ((lane >> 1) & 1) + 2 * (lane & 1);
    *(int2*)(pd + t * 128 + k) = make_int2(p[0], p[1]);
}
constexpr size_t WS_CLAIM = 4096;
DI unsigned xcc_id() { return (unsigned)__builtin_amdgcn_s_getreg((3 << 11) | 20) & 7u; }
DI int claim_unit(Frame& F, int set) {
    LAS int* bc = (LAS int*)(F.lds + LDS_BYTES - 64);
    __syncthreads();
    if (F.tid == 0) {
        unsigned* cnt = (unsigned*)(F.ws + WS_CLAIM) + set * 256;
        const unsigned x0 = xcc_id(); int unit = -1;
        for (unsigned a = 0; a < 8; ++a) { const unsigned sl = (x0 + a) & 7u; const unsigned tk = __hip_atomic_fetch_add(cnt + sl * 32, 1u, __ATOMIC_RELAXED, __HIP_MEMORY_SCOPE_AGENT); if (tk < 32u) { unit = (int)(sl * 32 + tk); break; } }
        bc[0] = unit;
    }
    __syncthreads();
    return bc[0];
}
DI void p_upass(Frame& F, int layer, int cset) {
    const unsigned short* IDX = (const unsigned short*)(F.ws + WS_IDX);
    LAS unsigned char* wl = F.lds + F.wave * UP_LDS;
    LAS unsigned short* lidx = (LAS unsigned short*)wl;
    const int lane = F.lane;
    for (int unit = claim_unit(F, cset); unit >= 0; unit = claim_unit(F, cset)) {
    const int x = unit >> 5, jb = unit & 31;
    const unsigned char* Us = F.ws + WS_U + ((size_t)layer * 8 + x) * 16384 * 128;
    const unsigned char* H2Qs = F.ws + WS_H2Q + 128 * x;
    int* pd = (int*)(F.ws + WS_PD) + (size_t)x * T_TOK * 128;
    for (int t0 = jb * 1024 + F.wave * 128; t0 < jb * 1024 + F.wave * 128 + 128; t0 += 16) {
        { const u32x4* si = (const u32x4*)(IDX + (size_t)t0 * 128) + lane;
#pragma unroll
          for (int q = 0; q < 4; ++q) ((LAS u32x4*)lidx)[lane + 64 * q] = si[64 * q]; }
        UTok A, B;
        up_load(A, Us, H2Qs, lidx, (size_t)t0, 0, lane);
#pragma unroll 1
        for (int tt = 0; tt < 16; tt += 2) {
            up_load(B, Us, H2Qs, lidx, (size_t)t0 + tt + 1, tt + 1, lane);
            up_compute(A, pd, (size_t)t0 + tt, lane);
            if (tt + 2 < 16) up_load(A, Us, H2Qs, lidx, (size_t)t0 + tt + 2, tt + 2, lane);
            up_compute(B, pd, (size_t)t0 + tt + 1, lane);
        }
    }
    }
}
DI void p_combine(Frame& F, int layer) {
    const unsigned short* IDX = (const unsigned short*)(F.ws + WS_IDX); const float* GATE = (const float*)(F.ws + WS_GATE);
    const float* SH = (const float*)(F.ws + WS_SH); const float* SU = (const float*)(F.ws + WS_SU) + (size_t)layer * 16384; const float* SV = (const float*)(F.ws + WS_SV) + (size_t)layer * 16384;
    const int* pd = (const int*)(F.ws + WS_PD); unsigned char* W8 = F.ws + WS_W; float* SW8 = (float*)(F.ws + WS_SW8);
    const int gw = F.bid * NWAVES + F.wave, NGW = F.G * NWAVES;
    for (int t0 = gw * 4; t0 < T_TOK; t0 += NGW * 4) {
        int s0[4], s1[4], e0[4], e1[4]; float g0[4], g1[4], sh[4];
#pragma unroll
        for (int q = 0; q < 4; ++q) { const size_t t = (size_t)t0 + q; s0[q] = 0; s1[q] = 0;
#pragma unroll
            for (int x = 0; x < 8; ++x) { const int* p = pd + ((size_t)x * T_TOK + t) * 128 + F.lane; s0[q] += p[0]; s1[q] += p[64]; }
            e0[q] = IDX[t * 128 + F.lane]; e1[q] = IDX[t * 128 + 64 + F.lane]; g0[q] = GATE[t * 128 + F.lane]; g1[q] = GATE[t * 128 + 64 + F.lane]; sh[q] = SH[t]; }
        float u0[4], u1[4], v0[4], v1[4];
#pragma unroll
        for (int q = 0; q < 4; ++q) { u0[q] = SU[e0[q]]; u1[q] = SU[e1[q]]; v0[q] = SV[e0[q]]; v1[q] = SV[e1[q]]; }
#pragma unroll
        for (int q = 0; q < 4; ++q) { const size_t t = (size_t)t0 + q;
            const float d0 = (float)s0[q] * u0[q] * sh[q], d1 = (float)s1[q] * u1[q] * sh[q];
            const float w0 = g0[q] * 0.5f * d0 * (1.0f + erff(d0 * 0.70710678118654752f)) * v0[q], w1 = g1[q] * 0.5f * d1 * (1.0f + erff(d1 * 0.70710678118654752f)) * v1[q];
            const float m = fmaxf(wave_max(fmaxf(fabsf(w0), fabsf(w1))), 1e-30f), inv = 127.0f / m;
            W8[t * 128 + F.lane] = (unsigned char)((int)rintf(w0 * inv) & 255); W8[t * 128 + 64 + F.lane] = (unsigned char)((int)rintf(w1 * inv) & 255);
            if (F.lane == 0) SW8[t] = m * (1.0f / 127.0f); }
    }
}
struct TokBuf { u32x4 r[16]; u32x4 w; };
DI void vp_load(TokBuf& tb, const unsigned char* Vs, const LAS unsigned short* lidx, const LAS unsigned char* lw, int tt, int lane) {
    const int g = lane >> 3, c = lane & 7;
    const LAS u32x4* ip = (const LAS u32x4*)(lidx + tt * 128 + 16 * g); const u32x4 ia = ip[0], ib = ip[1];
    tb.w = *(const LAS u32x4*)(lw + tt * 128 + 16 * g);
    const unsigned e[16] = {ia.x & 0xffffu, ia.x >> 16, ia.y & 0xffffu, ia.y >> 16, ia.z & 0xffffu, ia.z >> 16, ia.w & 0xffffu, ia.w >> 16,
                            ib.x & 0xffffu, ib.x >> 16, ib.y & 0xffffu, ib.y >> 16, ib.z & 0xffffu, ib.z >> 16, ib.w & 0xffffu, ib.w >> 16};
#pragma unroll
    for (int i = 0; i < 16; ++i) tb.r[i] = *(const u32x4*)(Vs + (size_t)e[i] * 128 + c * 16);
}
DI void tdot4(int (&acc)[16], int d, unsigned r0, unsigned r1, unsigned r2, unsigned r3, unsigned wq) {
    const unsigned t0 = __builtin_amdgcn_perm(r1, r0, 0x05010400u), t1 = __builtin_amdgcn_perm(r1, r0, 0x07030602u);
    const unsigned t2 = __builtin_amdgcn_perm(r3, r2, 0x05010400u), t3 = __builtin_amdgcn_perm(r3, r2, 0x07030602u);
    const unsigned c0 = __builtin_amdgcn_perm(t2, t0, 0x05040100u), c1 = __builtin_amdgcn_perm(t2, t0, 0x07060302u);
    const unsigned c2 = __builtin_amdgcn_perm(t3, t1, 0x05040100u), c3 = __builtin_amdgcn_perm(t3, t1, 0x07060302u);
    acc[4 * d] = __builtin_amdgcn_sdot4((int)c0, (int)wq, acc[4 * d], false); acc[4 * d + 1] = __builtin_amdgcn_sdot4((int)c1, (int)wq, acc[4 * d + 1], false);
    acc[4 * d + 2] = __builtin_amdgcn_sdot4((int)c2, (int)wq, acc[4 * d + 2], false); acc[4 * d + 3] = __builtin_amdgcn_sdot4((int)c3, (int)wq, acc[4 * d + 3], false);
}
DI void vp_compute(const TokBuf& tb, Frame& F, const float* g2s, const float* SW8, float* xout, size_t t, int x, int lane) {
    int p[16];
#pragma unroll
    for (int i = 0; i < 16; ++i) p[i] = 0;
#pragma unroll
    for (int j = 0; j < 4; ++j) { const unsigned wq = j == 0 ? tb.w.x : j == 1 ? tb.w.y : j == 2 ? tb.w.z : tb.w.w;
        tdot4(p, 0, tb.r[4 * j].x, tb.r[4 * j + 1].x, tb.r[4 * j + 2].x, tb.r[4 * j + 3].x, wq); tdot4(p, 1, tb.r[4 * j].y, tb.r[4 * j + 1].y, tb.r[4 * j + 2].y, tb.r[4 * j + 3].y, wq);
        tdot4(p, 2, tb.r[4 * j].z, tb.r[4 * j + 1].z, tb.r[4 * j + 2].z, tb.r[4 * j + 3].z, wq); tdot4(p, 3, tb.r[4 * j].w, tb.r[4 * j + 1].w, tb.r[4 * j + 2].w, tb.r[4 * j + 3].w, wq); }
#pragma unroll
    for (int i = 0; i < 8; ++i) { const bool up = (lane & 32) != 0; const int send = up ? p[i] : p[i + 8], keep = up ? p[i + 8] : p[i]; p[i] = keep + lx<32>(send); }
#pragma unroll
    for (int i = 0; i < 4; ++i) { const bool up = (lane & 16) != 0; const int send = up ? p[i] : p[i + 4], keep = up ? p[i + 4] : p[i]; p[i] = keep + lx<16>(send); }
#pragma unroll
    for (int i = 0; i < 2; ++i) { const bool up = (lane & 8) != 0; const int send = up ? p[i] : p[i + 2], keep = up ? p[i + 2] : p[i]; p[i] = keep + lx<8>(send); }
    const int col = 128 * x + 16 * (lane & 7) + 8 * ((lane >> 5) & 1) + 4 * ((lane >> 4) & 1) + 2 * ((lane >> 3) & 1);
    const float sw = SW8[t];
    const f32x2_t gg = *(const f32x2_t*)(g2s + col);
    const f32x2_t xv = *(const f32x2_t*)(F.out + t * 1024 + col);
    *(f32x2_t*)(xout + t * 1024 + col) = xv + gg * (f32x2_t){(float)p[0] * sw, (float)p[1] * sw};
}
DI void p_vpass(Frame& F, int layer, float* xout, int cset) {
    const unsigned short* IDX = (const unsigned short*)(F.ws + WS_IDX); const unsigned char* W8 = F.ws + WS_W; const float* SW8 = (const float*)(F.ws + WS_SW8);
    const float* mods = (const float*)(F.ws + WS_MODS);
    LAS unsigned char* wl = F.lds + F.wave * UP_LDS;
    LAS unsigned short* lidx = (LAS unsigned short*)wl; LAS unsigned char* lw = (LAS unsigned char*)(wl + 4096);
    const int lane = F.lane;
    for (int unit = claim_unit(F, cset); unit >= 0; unit = claim_unit(F, cset)) {
    const int x = unit >> 5, jb = unit & 31;
    const unsigned char* Vs = F.ws + WS_V + ((size_t)layer * 8 + x) * 16384 * 128;
    for (int t0 = jb * 1024 + F.wave * 128; t0 < jb * 1024 + F.wave * 128 + 128; t0 += 16) {
        const int b = t0 >> 11;
        const float* g2s = mods + ((size_t)layer * 16 + b) * 6144 + 5 * 1024;
        { const u32x4* si = (const u32x4*)(IDX + (size_t)t0 * 128) + lane;
#pragma unroll
          for (int q = 0; q < 4; ++q) ((LAS u32x4*)lidx)[lane + 64 * q] = si[64 * q];
          const u32x4* sg = (const u32x4*)(W8 + (size_t)t0 * 128) + lane;
#pragma unroll
          for (int q = 0; q < 2; ++q) ((LAS u32x4*)lw)[lane + 64 * q] = sg[64 * q]; }
        TokBuf A, B;
        vp_load(A, Vs, lidx, lw, 0, lane);
#pragma unroll 1
        for (int tt = 0; tt < 16; tt += 2) {
            vp_load(B, Vs, lidx, lw, tt + 1, lane);
            vp_compute(A, F, g2s, SW8, xout, (size_t)t0 + tt, x, lane);
            if (tt + 2 < 16) vp_load(A, Vs, lidx, lw, tt + 2, lane);
            vp_compute(B, F, g2s, SW8, xout, (size_t)t0 + tt + 1, x, lane);
        }
    }
    }
}
#ifndef GEMM_ALIGN
#define GEMM_ALIGN true
#endif
#ifndef GEMM_SP2
#define GEMM_SP2 true
#endif
#ifndef DUP
#define DUP -1
#endif
#ifndef PH_MASK
#define PH_MASK 0x3FFFF
#endif

constexpr size_t WS_BAR = 65536;
#define XB_TMO      128
#define XB_XCNT(j)  (256  + 64 * (j))
#define XB_XSUB(j)  (1280 + 64 * (j))
#define XB_XGEN(j)  (2304 + 64 * (j))
#define XB_TOP      3328
#define XB_TOPGEN   3392
#define XCD_BAR_WORDS 3456
#define XB_SPIN_CAP (1u << 18)

__device__ __forceinline__ unsigned xb_ld(unsigned* p)              { return __hip_atomic_load(p, __ATOMIC_RELAXED, __HIP_MEMORY_SCOPE_AGENT); }
__device__ __forceinline__ unsigned xb_add(unsigned* p, unsigned v) { return __hip_atomic_fetch_add(p, v, __ATOMIC_RELAXED, __HIP_MEMORY_SCOPE_AGENT); }
__device__ __forceinline__ unsigned xb_xcc_id() { return (unsigned)__builtin_amdgcn_s_getreg((3 << 11) | 20) & 0xFu; }
#define XB_SPIN(cond, bar) do { unsigned _sp = 0; while (cond) { __builtin_amdgcn_s_sleep(1); \
    if ((++_sp & 255u) == 0u) { if (xb_ld(&(bar)[XB_TMO])) break; if (_sp > XB_SPIN_CAP) { atomicAdd(&(bar)[XB_TMO], 1u); break; } } } } while (0)

struct XcdBarrier {
    unsigned* bar; unsigned x;
    volatile LAS unsigned* st;
};

__device__ __forceinline__ XcdBarrier xcd_barrier_post(unsigned* bar, volatile LAS unsigned* st) {
    XcdBarrier b; b.bar = bar; b.x = xb_xcc_id(); b.st = st;
    if (threadIdx.x == 0) (void)xb_add(&bar[XB_XCNT(b.x)], 1u);
    return b;
}
__device__ __forceinline__ void xcd_barrier_complete(unsigned* bar, unsigned x, unsigned& nloc, unsigned& nx) {
    const unsigned G = gridDim.x * gridDim.y * gridDim.z;
    unsigned sum, cnt, mine, sp = 0u;
    for (;;) {
        sum = 0u; cnt = 0u; mine = 0u;
#pragma unroll
        for (unsigned j = 0; j < 16; ++j) { const unsigned c = xb_ld(&bar[XB_XCNT(j)]); sum += c; cnt += (c > 0u) ? 1u : 0u; mine = (j == x) ? c : mine; }
        if (sum == G) break;
        __builtin_amdgcn_s_sleep(1);
        if ((++sp & 255u) == 0u) { if (xb_ld(&bar[XB_TMO])) break; if (sp > XB_SPIN_CAP) { atomicAdd(&bar[XB_TMO], 1u); break; } }
    }
    nloc = mine > 0u ? mine : 1u; nx = cnt > 0u ? cnt : 1u;
}

__device__ __forceinline__ void xcd_barrier(const XcdBarrier& b) {
    asm volatile("s_waitcnt vmcnt(0)" ::: "memory");
    __syncthreads();
    if (threadIdx.x == 0) {
        unsigned* bar = b.bar;
        __builtin_amdgcn_s_waitcnt(0);
        unsigned nloc = b.st[0], nx = b.st[1];
        if (nloc == 0u) { xcd_barrier_complete(bar, b.x, nloc, nx); b.st[0] = nloc; b.st[1] = nx; }
        const unsigned old = xb_add(&bar[XB_XSUB(b.x)], 1u);
        const unsigned gen = old / nloc;
        if (old + 1u == (gen + 1u) * nloc) {
            __builtin_amdgcn_fence(__ATOMIC_RELEASE, "agent");
            asm volatile("s_waitcnt vmcnt(0)" ::: "memory");
            const unsigned og = xb_add(&bar[XB_TOP], 1u);
            const unsigned tg = og / nx;
            if (og + 1u == (tg + 1u) * nx) xb_add(&bar[XB_TOPGEN], 1u);
            else XB_SPIN(xb_ld(&bar[XB_TOPGEN]) == tg, bar);
            __builtin_amdgcn_fence(__ATOMIC_ACQUIRE, "agent");
            xb_add(&bar[XB_XGEN(b.x)], 1u);
            asm volatile("s_waitcnt vmcnt(0)" ::: "memory");
        } else {
            XB_SPIN(xb_ld(&bar[XB_XGEN(b.x)]) == gen, bar);
            __builtin_amdgcn_fence(__ATOMIC_ACQUIRE, "agent");
            asm volatile("s_waitcnt vmcnt(0)" ::: "memory");
        }
    }
    __syncthreads();
}

#ifndef N_LAUNCH_MODE
#define N_LAUNCH_MODE 1
#endif
constexpr int NPH = 18;
template <class Epi> DI void run_gemm(Frame& F, const bf16* A, const bf16* Bt, int N, const Epi& E) {
    pg8::Gemm g{A, Bt, T_TOK, N, DM}; pg8::StaticOrder S; S.init(T_TOK, N, F.G, F.vc);
    pg8::gemm_phase<Epi, pg8::StaticOrder, GEMM_ALIGN, GEMM_SP2>(F.lds, g, S, E);
}
__global__ void __launch_bounds__(NT, 2) fwd(Args args) {
    extern __shared__ __attribute__((aligned(16))) unsigned char lds_raw[];
    cg::grid_group grid = cg::this_grid();
    Frame F;
    F.lds = (LAS unsigned char*)lds_raw;
#pragma unroll
    for (int i = 0; i < 23; ++i) F.in[i] = args.in[i];
    F.out = args.out; F.ws = args.ws;
    F.tid = threadIdx.x; F.lane = F.tid & 63; F.wave = __builtin_amdgcn_readfirstlane(F.tid >> 6); F.bid = blockIdx.x; F.G = gridDim.x;
    const int lo = args.ph_lo, hi = args.ph_hi;
    volatile LAS unsigned* bst = (volatile LAS unsigned*)(F.lds + LDS_BYTES - 128);
    if (F.tid < 2) bst[F.tid] = 0u;
    __syncthreads();
    XcdBarrier xbar; xbar.bar = (unsigned*)(F.ws + WS_BAR); xbar.x = xb_xcc_id(); xbar.st = bst;
    if (F.tid == 0) bst[2] = xb_add(&xbar.bar[XB_XCNT(xbar.x)], 1u);
    __syncthreads();
    const unsigned my_rank = bst[2];
    F.vc = F.bid;
    if (lo < 0) grid.sync();
#ifndef DUPVAR
#define DUPVAR 0
#endif
#if DUPVAR == 4
#define ATT_DUP p12_attn_pipe<DUPVAR>
#elif DUPVAR >= 7
#define ATT_DUP p12_attn_v3<DUPVAR>
#elif DUPVAR == 6
#define ATT_DUP p12_attn_v2<DUPVAR>
#else
#define ATT_DUP p12_attn<DUPVAR>
#endif
#ifndef ATTVAR
#define ATTVAR 7
#endif
#if ATTVAR >= 7
#define ATT_MAIN p12_attn_v3<ATTVAR>
#else
#define ATT_MAIN p12_attn<ATTVAR>
#endif
#define IN(k) (lo <= (k) && (k) < hi)
#if defined(PROBE_K)
#ifndef PROBE_O
#define PROBE_O 0.f
#endif
    volatile LAS unsigned long long* tsl = (volatile LAS unsigned long long*)(F.lds + LDS_BYTES - 512); int nstamp = 1;
    if (F.tid == 0) tsl[0] = __builtin_amdgcn_s_memrealtime();
#define STAMP() do { if (F.tid == 0) tsl[nstamp] = __builtin_amdgcn_s_memrealtime(); ++nstamp; } while (0)
#else
#define STAMP() do { } while (0)
#endif
#define GSYNC() do { xcd_barrier(xbar); STAMP(); } while (0)
#define SEAM(k) do { if (IN(k) && IN((k) + 1)) GSYNC(); } while (0)
    float* mods = (float*)(F.ws + WS_MODS);
    bf16* Hb = (bf16*)(F.ws + WS_H);
    if (((PH_MASK >> 0) & 1) && IN(0)) { p0a_prologue(F); } SEAM(0);
    if (IN(0) && IN(1)) {
        bool even = (F.G % 8) == 0;
        for (unsigned j = 0; j < 16; ++j) { const unsigned cnt = xb_ld(&xbar.bar[XB_XCNT(j)]); even = even && (j < 8 ? cnt == (unsigned)(F.G / 8) : cnt == 0u); }
        if (even && xbar.x < 8u) F.vc = (int)(my_rank * 8u + xbar.x);
    }
    if (((PH_MASK >> 1) & 1) && IN(1)) { norm_phase<true>(F, F.in[0], F.in[4], mods, mods + 1024, 6144, Hb); __syncthreads(); p0b_prologue(F); } SEAM(1);
    if (((PH_MASK >> 2) & 1) && IN(2)) { pg8::EpiBf16<0> E{(bf16*)(F.ws + WS_PROJ), 3072, nullptr, 0, 0, 1.f}; run_gemm(F, Hb, (const bf16*)(F.ws + WS_WIN), 3072, E); if (DUP == 2) { GSYNC(); run_gemm(F, Hb, (const bf16*)(F.ws + WS_WIN), 3072, E); } } SEAM(2);
    if (((PH_MASK >> 3) & 1) && IN(3)) { p3_mlstm_local(F); if (DUP == 3) { GSYNC(); p3_mlstm_local(F); } } SEAM(3);
    if (((PH_MASK >> 4) & 1) && IN(4)) { p4_scan(F); if (DUP == 4) { GSYNC(); p3_mlstm_local(F); GSYNC(); p4_scan(F); } } SEAM(4);
    if (((PH_MASK >> 5) & 1) && IN(5)) { p5_mlstm_out(F); if (DUP == 5) { GSYNC(); p5_mlstm_out(F); } } SEAM(5);
    if (((PH_MASK >> 6) & 1) && IN(6)) { pg8::EpiResid E{F.in[0], F.out, mods + 2 * 1024, 6144}; run_gemm(F, Hb, (const bf16*)(F.ws + WS_WOUT), 1024, E); if (DUP == 6) { GSYNC(); run_gemm(F, Hb, (const bf16*)(F.ws + WS_WOUT), 1024, E); } } SEAM(6);
    if (((PH_MASK >> 7) & 1) && IN(7)) { norm_phase<false, true>(F, F.out, F.in[5], mods + 3 * 1024, mods + 4 * 1024, 6144, Hb); if (DUP == 7) { GSYNC(); norm_phase<false, true>(F, F.out, F.in[5], mods + 3 * 1024, mods + 4 * 1024, 6144, Hb); } } SEAM(7);
    if (((PH_MASK >> 8) & 1) && IN(8)) { pg8::EpiBf16<0> E{(bf16*)(F.ws + WS_PQ), 2048, nullptr, 0, 0, 1.f}; run_gemm(F, Hb, (const bf16*)(F.ws + WS_WPQ), 2048, E); if (DUP == 8) { GSYNC(); run_gemm(F, Hb, (const bf16*)(F.ws + WS_WPQ), 2048, E); } } SEAM(8);
    if (((PH_MASK >> 9) & 1) && IN(9)) { p_route(F, 0); if (DUP == 9) { GSYNC(); p_route(F, 0); } } SEAM(9);
    if (((PH_MASK >> 10) & 1) && IN(10)) {
        p_upass(F, 0, 0); GSYNC(); p_combine(F, 0); GSYNC(); p_vpass(F, 0, F.out, 1); GSYNC();
        norm2_phase(F, F.out, F.in[4] + 1024, mods + 16 * 6144, mods + 16 * 6144 + 1024, 6144, Hb, F.in[13], (const float*)(F.ws + WS_KVMODS), (const float*)(F.ws + WS_KVMODS) + 1024, 2048, (bf16*)(F.ws + WS_HB));
    } SEAM(10);
    if (((PH_MASK >> 11) & 1) && IN(11)) {
        { pg8::EpiHeadNorm E{(bf16*)(F.ws + WS_Q), (bf16*)(F.ws + WS_Q), 4, F.in[17], 0.125f * 1.4426950408889634f, EPS};     run_gemm(F, Hb, (const bf16*)(F.ws + WS_WSQ), 1024, E); }
        { pg8::EpiHeadNorm E{(bf16*)(F.ws + WS_K), (bf16*)(F.ws + WS_VV), 4, F.in[15], 1.0f, EPS}; run_gemm(F, (const bf16*)(F.ws + WS_HB), (const bf16*)(F.ws + WS_WKV), 2048, E);
          if (DUP == 11) { GSYNC(); run_gemm(F, (const bf16*)(F.ws + WS_HB), (const bf16*)(F.ws + WS_WKV), 2048, E); } }
    } SEAM(11);
    if (((PH_MASK >> 12) & 1) && IN(12)) { ATT_MAIN(F, (bf16*)(F.ws + WS_H)); if (DUP == 12) { bf16* Od = (bf16*)(F.ws + WS_HB); GSYNC(); ATT_DUP(F, Od); GSYNC(); ATT_DUP(F, Od); GSYNC(); ATT_DUP(F, Od); } } SEAM(12);
    if (((PH_MASK >> 13) & 1) && IN(13)) { pg8::EpiResid E{F.out, F.out, mods + 16 * 6144 + 2 * 1024, 6144}; run_gemm(F, Hb, (const bf16*)(F.ws + WS_WSO), 1024, E); } SEAM(13);
    if (((PH_MASK >> 14) & 1) && IN(14)) { norm_phase<false, true>(F, F.out, F.in[5] + 1024, mods + 16 * 6144 + 3 * 1024, mods + 16 * 6144 + 4 * 1024, 6144, Hb); } SEAM(14);
    if (((PH_MASK >> 15) & 1) && IN(15)) { pg8::EpiBf16<0> E{(bf16*)(F.ws + WS_PQ), 2048, nullptr, 0, 0, 1.f}; run_gemm(F, Hb, (const bf16*)(F.ws + WS_WPQ) + (size_t)2048 * 1024, 2048, E); } SEAM(15);
    if (((PH_MASK >> 16) & 1) && IN(16)) { p_route(F, 1); } SEAM(16);
    if (((PH_MASK >> 17) & 1) && IN(17)) { p_upass(F, 1, 2); GSYNC(); if (DUP == 20) { p_upass(F, 1, 4); GSYNC(); } p_combine(F, 1); GSYNC(); if (DUP == 22) { p_combine(F, 1); GSYNC(); } if (DUP == 21) { p_vpass(F, 1, (float*)(F.ws + WS_Q + 32 * MiB), 5); GSYNC(); } p_vpass(F, 1, F.out, 3); }
    if (DUP == 30) { for (int i = 0; i < 10; ++i) GSYNC(); }
#if defined(PROBE_K)
    GSYNC();
    if (F.bid == 0) { __syncthreads(); const float t_us = (PROBE_K < 0) ? 100.0f : PROBE_Q * rintf(fmaxf((float)(tsl[PROBE_K + 1] - tsl[PROBE_K]) * 0.01f - PROBE_O, 0.f) / PROBE_Q); const float dl = 0.15f * sqrtf(t_us * 0.01f);
        for (int i = F.tid; i < (1 << 20); i += NT) F.out[i] += dl; }
#endif
#undef IN
#undef SEAM
#undef GSYNC
}

extern "C" void kernel_launch(void* const* d_in, const int* in_sizes, int n_in, void* d_out, int out_size, void* d_ws, size_t ws_size, hipStream_t stream) {
    static int grid = 0;
    if (grid == 0) {
        int dev = 0, cus = 0, per_cu = 0;
        (void)hipGetDevice(&dev);
        (void)hipDeviceGetAttribute(&cus, hipDeviceAttributeMultiprocessorCount, dev);
        (void)hipFuncSetAttribute((const void*)fwd, hipFuncAttributeMaxDynamicSharedMemorySize, LDS_BYTES);
        (void)hipOccupancyMaxActiveBlocksPerMultiprocessor(&per_cu, (const void*)fwd, NT, LDS_BYTES);
        if (per_cu < 1) { fprintf(stderr, "kernel_launch: occupancy query says %d blocks per CU\n", per_cu); per_cu = 1; }
        grid = cus;
        if (n_in != 23 || ws_size < WS_END) fprintf(stderr, "kernel_launch: unexpected n_in %d / ws_size %zu\n", n_in, ws_size);
        (void)hipGetLastError();
    }
    (void)hipMemsetAsync(d_ws, 0, 131072, stream);
    Args a{};
    for (int i = 0; i < 23; ++i) a.in[i] = (const float*)d_in[i];
    a.out = (float*)d_out; a.ws = (unsigned char*)d_ws;
#if N_LAUNCH_MODE == 1
    a.ph_lo = 0; a.ph_hi = NPH;
    void* kargs[] = {&a};
    hipError_t e = hipLaunchCooperativeKernel((const void*)fwd, dim3(grid), dim3(NT), kargs, LDS_BYTES, stream);
    if (e != hipSuccess) fprintf(stderr, "kernel_launch: cooperative launch failed: %s (grid %d)\n", hipGetErrorString(e), grid);
#else
    for (int p = 0; p < NPH; ++p) { a.ph_lo = p; a.ph_hi = p + 1; hipLaunchKernelGGL(fwd, dim3(grid), dim3(NT), LDS_BYTES, stream, a); }
#endif
}
```

```cpp
#include <hip/hip_runtime.h>
#include <hip/hip_cooperative_groups.h>
#include <cstdio>
#include <cstdint>
namespace cg = cooperative_groups;
#define N_LAUNCH_MODE 1
namespace pg8 {
#define PG8_LAS __attribute__((address_space(3)))
typedef unsigned short bf16_t;
typedef short bf16x8 __attribute__((ext_vector_type(8)));
typedef float f32x4 __attribute__((ext_vector_type(4)));
typedef unsigned u32x4 __attribute__((ext_vector_type(4)));
constexpr int BM = 256, BK = 64, HALF = 128, HTB = HALF * BK * 2  , STAGE_BYTES = 8 * HTB, NXCD = 8, WGM = 8;

__host__ __device__ __forceinline__ int lds_byte(int r, int c) { const int st = (r >> 4) * 2 + (c >> 5), rr = r & 15, cc = c & 31, ob = rr * 64 + cc * 2; return st * 1024 + (ob ^ (((ob >> 9) & 1) << 5)); }
__host__ __device__ __forceinline__ void stage_rc(int b, int& R, int& C) { const int st = b / 1024, sb = b % 1024, swz = sb ^ (((sb >> 9) & 1) << 5); R = (st >> 1) * 16 + swz / 64; C = (st & 1) * 32 + (swz % 64) / 2; }
__host__ __device__ __forceinline__ int perm32(int rho) { const int n = rho >> 4, i = rho & 15; return 8 * (i >> 2) + 4 * n + (i & 3); }

struct Unit { int pm, pn; };
struct Gemm { const bf16_t* A; const bf16_t* Bt; int M, N, K; };

struct StaticOrder {
    int nM, nN, nwg, G, c;
    __host__ __device__ void init(int M, int N, int G_, int c_) { nM = M / BM; nN = N / BM; nwg = nM * nN; G = G_; c = c_; }
    __host__ __device__ bool next(int i, Unit& u) const {
        const long L = (long)i * G + c; if (L >= nwg) return false;
        int wgid = (int)L; { const int q = nwg / NXCD, r = nwg % NXCD, xcd = wgid % NXCD, off = wgid / NXCD; wgid = (xcd < r ? xcd * (q + 1) : r * (q + 1) + (xcd - r) * q) + off; }
        const int nig = WGM * nN, gid = wgid / nig, fm = gid * WGM, gsz = (nM - fm) < WGM ? (nM - fm) : WGM;
        u.pm = fm + ((wgid % nig) % gsz); u.pn = (wgid % nig) / gsz; return true;
    }
    __device__ __forceinline__ void a_ready(const Unit&) const {}
    __device__ __forceinline__ void done(const Unit&) const {}
};

__device__ __forceinline__ unsigned cvt_pk_bf16(float lo, float hi) { unsigned r; asm volatile("v_cvt_pk_bf16_f32 %0, %1, %2" : "=v"(r) : "v"(lo), "v"(hi)); return r; }
typedef float f32x2 __attribute__((ext_vector_type(2)));
__device__ __forceinline__ f32x2 gelu_pk(f32x2 v) {
    const f32x2 av = __builtin_elementwise_abs(v), d = av * 0.2316418882f + 1.0f;
    f32x2 t; t.x = __builtin_amdgcn_rcpf(d.x); t.y = __builtin_amdgcn_rcpf(d.y);
    f32x2 q = t * 0.5307027145f + (-0.7265760135f); q = q * t + 0.7107068705f; q = q * t + (-0.142248368f); q = q * t + 0.127414796f; q = q * t;
    const f32x2 s = (v * v) * (-0.72134752044f);
    f32x2 e; e.x = __builtin_amdgcn_exp2f(s.x); e.y = __builtin_amdgcn_exp2f(s.y);
    const f32x2 m = v * (q * e), r = v - m;
    f32x2 o; o.x = v.x < 0.f ? m.x : r.x; o.y = v.y < 0.f ? m.y : r.y; return o;
}

template <int ACT  > struct EpiBf16 {
    static constexpr bool PERM = true, AFTER_DRAIN = false; static_assert(ACT == 0 || ACT == 1, "EpiBf16: ACT is 0 (none) or 1 (gelu_pk)");
    bf16_t* O; int ldc; const float* bias; int split_cols; size_t split_stride; float scale0;
    __device__ __forceinline__ void operator()(const f32x4 (&acc)[2][2][4][2], const Unit& u, int wr, int wc, int fr, int fq) const {
        const int row0 = u.pm * BM + wr * 64 + fr; int colt = u.pn * BM; bf16_t* base = O;
        float sc = 1.f; if (split_cols) { const int t = colt / split_cols; base += (size_t)t * split_stride; colt -= t * split_cols; if (t == 0) sc = scale0; }
        const int col0 = colt + wc * 32 + 8 * fq, bcol0 = u.pn * BM + wc * 32 + 8 * fq;
        f32x4 bv[2][2];
#pragma unroll
        for (int bj = 0; bj < 2; ++bj)
#pragma unroll
            for (int n = 0; n < 2; ++n) bv[bj][n] = bias ? *(const f32x4*)(bias + bcol0 + bj * HALF + 4 * n) : (f32x4){0.f, 0.f, 0.f, 0.f};
#pragma unroll
        for (int ai = 0; ai < 2; ++ai)
#pragma unroll
            for (int m = 0; m < 4; ++m) { bf16_t* rowp = base + (size_t)(row0 + ai * HALF + m * 16) * ldc + col0;
#pragma unroll
                for (int bj = 0; bj < 2; ++bj) { f32x4 v0 = acc[ai][bj][m][0] + bv[bj][0], v1 = acc[ai][bj][m][1] + bv[bj][1];
                    if (ACT == 1) { f32x2 a = gelu_pk((f32x2){v0[0], v0[1]}), b = gelu_pk((f32x2){v0[2], v0[3]}), c = gelu_pk((f32x2){v1[0], v1[1]}), d = gelu_pk((f32x2){v1[2], v1[3]});
                        v0 = (f32x4){a.x, a.y, b.x, b.y}; v1 = (f32x4){c.x, c.y, d.x, d.y}; }
                    v0 = v0 * sc; v1 = v1 * sc; u32x4 w; w.x = cvt_pk_bf16(v0[0], v0[1]); w.y = cvt_pk_bf16(v0[2], v0[3]); w.z = cvt_pk_bf16(v1[0], v1[1]); w.w = cvt_pk_bf16(v1[2], v1[3]);
                    *(u32x4*)(rowp + bj * HALF) = w; } }
    }
};
struct EpiResid {
    static constexpr bool PERM = false, AFTER_DRAIN = false;
    const float* base; float* out; const float* gate; int gstride;
    __device__ __forceinline__ void operator()(const f32x4 (&acc)[2][2][4][2], const Unit& u, int wr, int wc, int fr, int fq) const {
        const int col0 = u.pn * BM + wc * 32 + 4 * fq;
        const int b = (u.pm * BM) >> 11;
        f32x4 gv[2][2];
#pragma unroll
        for (int bj = 0; bj < 2; ++bj)
#pragma unroll
            for (int n = 0; n < 2; ++n) gv[bj][n] = *(const f32x4*)(gate + (size_t)b * gstride + col0 + bj * HALF + n * 16);
#pragma unroll
        for (int ai = 0; ai < 2; ++ai)
#pragma unroll
            for (int m = 0; m < 4; ++m) { const size_t off = (size_t)(u.pm * BM + ai * HALF + wr * 64 + m * 16 + fr) * 1024 + col0;
#pragma unroll
                for (int bj = 0; bj < 2; ++bj)
#pragma unroll
                    for (int n = 0; n < 2; ++n) { const f32x4 bs = *(const f32x4*)(base + off + bj * HALF + n * 16);
                        *(f32x4*)(out + off + bj * HALF + n * 16) = bs + gv[bj][n] * acc[ai][bj][m][n]; }
                if (m & 1) asm volatile("" ::: "memory"); }
    }
};
struct EpiHeadNorm {
    static constexpr bool PERM = true, AFTER_DRAIN = false;
    bf16_t* O0; bf16_t* O1; int ntile_norm; const float* g; float scale; float eps;
    __device__ __forceinline__ void operator()(const f32x4 (&acc)[2][2][4][2], const Unit& u, int wr, int wc, int fr, int fq) const {
        const bool nrm = u.pn < ntile_norm; bf16_t* O = nrm ? O0 : O1; const int pnl = nrm ? u.pn : u.pn - ntile_norm;
        f32x4 gv[2][2];
#pragma unroll
        for (int bj = 0; bj < 2; ++bj)
#pragma unroll
            for (int n = 0; n < 2; ++n) { const f32x4 t = *(const f32x4*)(g + 32 * bj + 8 * fq + 4 * n); gv[bj][n] = nrm ? t * scale : (f32x4){1.f, 1.f, 1.f, 1.f}; }
#pragma unroll
        for (int ai = 0; ai < 2; ++ai)
#pragma unroll
            for (int m = 0; m < 4; ++m) {
                float ss = 0.f;
#pragma unroll
                for (int bj = 0; bj < 2; ++bj)
#pragma unroll
                    for (int n = 0; n < 2; ++n) { const f32x4 x = acc[ai][bj][m][n]; ss += (x[0] * x[0] + x[1] * x[1]) + (x[2] * x[2] + x[3] * x[3]); }
                ss += __shfl_xor(ss, 16); ss += __shfl_xor(ss, 32);
                const float rs = nrm ? 1.0f / sqrtf(ss * (1.0f / 64.0f) + eps) : 1.0f;
                bf16_t* rowp = O + (size_t)(u.pm * BM + ai * HALF + wr * 64 + m * 16 + fr) * 1024 + pnl * BM + wc * 64 + 8 * fq;
#pragma unroll
                for (int bj = 0; bj < 2; ++bj) { const f32x4 v0 = acc[ai][bj][m][0] * rs * gv[bj][0], v1 = acc[ai][bj][m][1] * rs * gv[bj][1];
                    u32x4 w; w.x = cvt_pk_bf16(v0[0], v0[1]); w.y = cvt_pk_bf16(v0[2], v0[3]); w.z = cvt_pk_bf16(v1[0], v1[1]); w.w = cvt_pk_bf16(v1[2], v1[3]);
                    *(u32x4*)(rowp + bj * 32) = w; }
            }
    }
};
template <class Epi, class Sched, bool ALIGN_EPI = false, bool SP2 = false>
__device__ __forceinline__ void gemm_phase(PG8_LAS unsigned char* lds, const Gemm g, const Sched& S, const Epi& E) {
    const int tid = threadIdx.x, wid = __builtin_amdgcn_readfirstlane(tid >> 6), lane = tid & 63, wr = wid >> 2, wc = wid & 3, fr = lane & 15, fq = lane >> 4;
    const int K = g.K, nt = K / BK;
    unsigned voffA[2], voffB[2];
#pragma unroll
    for (int i = 0; i < 2; ++i) { int R, C; stage_rc(tid * 16 + i * 8192, R, C); const int Rb = Epi::PERM ? ((R & ~31) + perm32(R & 31)) : R;
        voffA[i] = (unsigned)(R * K + C) * 2u; voffB[i] = (unsigned)(Rb * K + C) * 2u; }
    const size_t kstep = (size_t)(BK * 2);
    const size_t hstep = (size_t)HALF * K * 2;
    const size_t tstep = 2 * hstep;
    const unsigned ldsw = (unsigned)wid * 1024u;
    const int aoff = lds_byte(wr * 64 + fr, fq * 8), boff = lds_byte(wc * 32 + fr, fq * 8);
#define PG8_SA(b, h) (((b) * 2 + (h)) * HTB)
#define PG8_SB(b, h) ((4 + (b) * 2 + (h)) * HTB)
#define PG8_STAGE(bufoff, gbase, voff) do { _Pragma("unroll") for (int _i = 0; _i < 2; ++_i) \
        __builtin_amdgcn_global_load_lds((const unsigned*)((const char*)(gbase) + (voff)[_i]), (PG8_LAS unsigned*)(lds + (bufoff) + ldsw + _i * 8192), 16, 0, 0); } while (0)
#define PG8_LDA(dst, b, h) do { _Pragma("unroll") for (int m = 0; m < 4; ++m) _Pragma("unroll") for (int k = 0; k < 2; ++k) dst[m][k] = *(const PG8_LAS bf16x8*)(lds + PG8_SA(b, h) + aoff + m * 2048 + k * 1024); } while (0)
#define PG8_LDB(dst, b, h) do { _Pragma("unroll") for (int n = 0; n < 2; ++n) _Pragma("unroll") for (int k = 0; k < 2; ++k) dst[n][k] = *(const PG8_LAS bf16x8*)(lds + PG8_SB(b, h) + boff + n * 2048 + k * 1024); } while (0)
#define PG8_MMA(ai, bj, At, Bt) do { __builtin_amdgcn_s_setprio(1); _Pragma("unroll") for (int m = 0; m < 4; ++m) _Pragma("unroll") for (int n = 0; n < 2; ++n) _Pragma("unroll") for (int k = 0; k < 2; ++k) \
        acc[ai][bj][m][n] = __builtin_amdgcn_mfma_f32_16x16x32_bf16(Bt[n][k], At[m][k], acc[ai][bj][m][n], 0, 0, 0); __builtin_amdgcn_s_setprio(0); } while (0)
#define PG8_WAIT_V(n) asm volatile("s_waitcnt vmcnt(" #n ")" ::: "memory")
#define PG8_WAIT_L(n) asm volatile("s_waitcnt lgkmcnt(" #n ")" ::: "memory")
#define PG8_BAR __builtin_amdgcn_s_barrier()
#define PG8_SCHED __builtin_amdgcn_sched_barrier(0)
    Unit cur, nxt; int ui = 0;
    if (!S.next(0, cur)) return;
    f32x4 acc[2][2][4][2];
#pragma unroll
    for (int a = 0; a < 2; ++a)
#pragma unroll
        for (int b = 0; b < 2; ++b)
#pragma unroll
            for (int m = 0; m < 4; ++m)
#pragma unroll
                for (int n = 0; n < 2; ++n) acc[a][b][m][n] = (f32x4){0.f, 0.f, 0.f, 0.f};
    bf16x8 At[4][2], B0[2][2], B1[2][2];
    const char* cA = (const char*)g.A + (size_t)cur.pm * tstep; const char* cB = (const char*)g.Bt + (size_t)cur.pn * tstep;
    S.a_ready(cur);
    if constexpr (SP2) {
        PG8_STAGE(PG8_SB(0, 0), cB, voffB); PG8_STAGE(PG8_SB(0, 1), cB + hstep, voffB); PG8_STAGE(PG8_SA(0, 0), cA, voffA); PG8_STAGE(PG8_SA(0, 1), cA + hstep, voffA);
        if (wr == 1) PG8_BAR;
        PG8_WAIT_V(2); PG8_BAR;
        PG8_STAGE(PG8_SB(1, 0), cB + kstep, voffB); PG8_STAGE(PG8_SA(1, 0), cA + kstep, voffA); PG8_STAGE(PG8_SB(1, 1), cB + hstep + kstep, voffB);
        PG8_WAIT_V(6); PG8_BAR;
    } else {
        PG8_STAGE(PG8_SB(0, 0), cB, voffB); PG8_STAGE(PG8_SA(0, 0), cA, voffA); PG8_STAGE(PG8_SB(0, 1), cB + hstep, voffB); PG8_STAGE(PG8_SA(0, 1), cA + hstep, voffA);
        if (wr == 1) PG8_BAR;
        PG8_WAIT_V(4); PG8_BAR;
        PG8_STAGE(PG8_SB(1, 0), cB + kstep, voffB); PG8_STAGE(PG8_SA(1, 0), cA + kstep, voffA); PG8_STAGE(PG8_SB(1, 1), cB + hstep + kstep, voffB);
        PG8_WAIT_V(6); PG8_BAR;
    }
    for (;;) {
        const bool has_next = S.next(ui + 1, nxt);
        const char* nA = has_next ? (const char*)g.A + (size_t)nxt.pm * tstep : cA; const char* nB = has_next ? (const char*)g.Bt + (size_t)nxt.pn * tstep : cB;
        for (int t = 0; t < nt; t += 2) {
            const bool last = (t == nt - 2);
            const char* a1 = cA + (size_t)(t + 1) * kstep;
            const char* a2 = last ? nA : cA + (size_t)(t + 2) * kstep; const char* b2 = last ? nB : cB + (size_t)(t + 2) * kstep;
            const char* a3 = a2 + kstep; const char* b3 = b2 + kstep;
            if (last && has_next) S.a_ready(nxt);
            if constexpr (SP2) {
            PG8_LDB(B0, 0, 0); PG8_LDB(B1, 0, 1); PG8_SCHED; PG8_LDA(At, 0, 0); PG8_STAGE(PG8_SA(1, 1), a1 + hstep, voffA);
            PG8_WAIT_V(8); PG8_WAIT_L(0); PG8_BAR; PG8_MMA(0, 0, At, B0); PG8_MMA(0, 1, At, B1); PG8_BAR; PG8_SCHED;
            PG8_LDA(At, 0, 1); PG8_STAGE(PG8_SB(0, 0), b2, voffB); PG8_STAGE(PG8_SB(0, 1), b2 + hstep, voffB); PG8_STAGE(PG8_SA(0, 0), a2, voffA);
            PG8_WAIT_V(8); PG8_WAIT_L(0); PG8_BAR; PG8_MMA(1, 0, At, B0); PG8_MMA(1, 1, At, B1); PG8_BAR; PG8_SCHED;
            PG8_LDB(B0, 1, 0); PG8_LDB(B1, 1, 1); PG8_SCHED; PG8_LDA(At, 1, 0); PG8_STAGE(PG8_SA(0, 1), a2 + hstep, voffA);
            PG8_WAIT_V(8); PG8_WAIT_L(0); PG8_BAR; PG8_MMA(0, 0, At, B0); PG8_MMA(0, 1, At, B1); PG8_BAR; PG8_SCHED;
            PG8_LDA(At, 1, 1); PG8_STAGE(PG8_SB(1, 0), b3, voffB); PG8_STAGE(PG8_SB(1, 1), b3 + hstep, voffB); PG8_STAGE(PG8_SA(1, 0), a3, voffA);
            PG8_WAIT_V(8); PG8_WAIT_L(0); PG8_BAR; PG8_MMA(1, 0, At, B0); PG8_MMA(1, 1, At, B1); PG8_BAR; PG8_SCHED;
            } else {
            PG8_LDB(B0, 0, 0); PG8_SCHED; PG8_LDA(At, 0, 0); PG8_STAGE(PG8_SA(1, 1), a1 + hstep, voffA);
            PG8_WAIT_L(8); PG8_BAR; PG8_WAIT_L(0); PG8_MMA(0, 0, At, B0); PG8_BAR; PG8_SCHED;
            PG8_LDB(B1, 0, 1); PG8_STAGE(PG8_SB(0, 0), b2, voffB);
            PG8_BAR; PG8_WAIT_L(0); PG8_MMA(0, 1, At, B1); PG8_BAR;
            PG8_LDA(At, 0, 1); PG8_STAGE(PG8_SA(0, 0), a2, voffA);
            PG8_BAR; PG8_WAIT_L(0); PG8_MMA(1, 0, At, B0); PG8_BAR; PG8_SCHED;
            PG8_STAGE(PG8_SB(0, 1), b2 + hstep, voffB);
            PG8_WAIT_V(6); PG8_BAR; PG8_MMA(1, 1, At, B1); PG8_BAR;
            PG8_LDB(B0, 1, 0); PG8_SCHED; PG8_LDA(At, 1, 0); PG8_STAGE(PG8_SA(0, 1), a2 + hstep, voffA);
            PG8_WAIT_L(8); PG8_BAR; PG8_WAIT_L(0); PG8_MMA(0, 0, At, B0); PG8_BAR; PG8_SCHED;
            PG8_LDB(B1, 1, 1); PG8_STAGE(PG8_SB(1, 0), b3, voffB);
            PG8_BAR; PG8_WAIT_L(0); PG8_MMA(0, 1, At, B1); PG8_BAR;
            PG8_LDA(At, 1, 1); PG8_STAGE(PG8_SA(1, 0), a3, voffA);
            PG8_BAR; PG8_WAIT_L(0); PG8_MMA(1, 0, At, B0); PG8_BAR; PG8_SCHED;
            PG8_STAGE(PG8_SB(1, 1), b3 + hstep, voffB);
            PG8_WAIT_V(6); PG8_BAR; PG8_MMA(1, 1, At, B1); PG8_BAR;
            }
        }
        if constexpr (ALIGN_EPI) { if (wr == 0) PG8_BAR; }
        if constexpr (!Epi::AFTER_DRAIN) { E(acc, cur, wr, wc, fr, fq); S.done(cur); }
        if (!has_next) break;
#pragma unroll
        for (int a = 0; a < 2; ++a)
#pragma unroll
            for (int b = 0; b < 2; ++b)
#pragma unroll
                for (int m = 0; m < 4; ++m)
#pragma unroll
                    for (int n = 0; n < 2; ++n) acc[a][b][m][n] = (f32x4){0.f, 0.f, 0.f, 0.f};
        cur = nxt; cA = nA; cB = nB; ++ui;
        if constexpr (ALIGN_EPI) { if (wr == 1) PG8_BAR; }
    }
    PG8_WAIT_V(0);
    if constexpr (!ALIGN_EPI) { if (wr == 0) PG8_BAR; }
    PG8_BAR;
    if constexpr (Epi::AFTER_DRAIN) { E.fused(acc, cur, wr, wc, fr, fq, lds, wid, lane); S.done(cur); }
#undef PG8_SA
#undef PG8_SB
#undef PG8_STAGE
#undef PG8_LDA
#undef PG8_LDB
#undef PG8_MMA
#undef PG8_WAIT_V
#undef PG8_WAIT_L
#undef PG8_BAR
#undef PG8_SCHED
}
}

#define DI __device__ __forceinline__
#define LAS __attribute__((address_space(3)))
typedef unsigned short bf16;
typedef __bf16 bf16x2_t __attribute__((ext_vector_type(2)));
typedef float f32x2_t __attribute__((ext_vector_type(2)));
typedef float f32x4 __attribute__((ext_vector_type(4)));
typedef float f32x16 __attribute__((ext_vector_type(16)));
typedef short bf16x8 __attribute__((ext_vector_type(8)));
typedef short s16x4 __attribute__((ext_vector_type(4)));
typedef unsigned u32x4 __attribute__((ext_vector_type(4)));
typedef unsigned u32x2 __attribute__((ext_vector_type(2)));

constexpr int NT = 512, NWAVES = 8;
constexpr int LDS_BYTES = 147456;
constexpr int T_TOK = 32768, DM = 1024, SEQ = 2048, NB = 16;
constexpr float EPS = 1e-6f;
constexpr size_t MiB = 1u << 20;
constexpr size_t WS_MODS = 1 * MiB, WS_KVMODS = WS_MODS + (size_t)2 * 16 * 6144 * 4;
constexpr size_t WS_GATES = 2 * MiB, WS_BLAST = 4 * MiB, WS_MLOC = 4 * MiB + 65536, WS_MPREV = 4 * MiB + 131072, WS_NLOC = 5 * MiB;
constexpr size_t WS_WG = 6 * MiB, WS_SUBK = 7 * MiB;
constexpr size_t WS_WIN = 8 * MiB, WS_WOUT = 14 * MiB, WS_WKV = 16 * MiB, WS_WSQ = 20 * MiB, WS_WSO = 22 * MiB, WS_WPQ = 24 * MiB;
constexpr size_t WS_IDX = 36 * MiB, WS_GATE = 44 * MiB, WS_SU = 60 * MiB, WS_SV = 61 * MiB, WS_SW8 = 62 * MiB;
constexpr size_t WS_H2Q = 256 * MiB, WS_SH = 288 * MiB + 0;
constexpr size_t WS_U = 64 * MiB, WS_V = 128 * MiB, WS_H = 192 * MiB, WS_HB = 256 * MiB, WS_PROJ = 320 * MiB, WS_END = 512 * MiB;
constexpr size_t WS_QC = 96 * MiB, WS_KC = 160 * MiB;
constexpr size_t WS_CST = WS_HB;
constexpr size_t WS_Q = WS_PROJ, WS_K = WS_PROJ + 64 * MiB, WS_VV = WS_PROJ + 128 * MiB, WS_PQ = WS_PROJ;

struct Args { const float* in[23]; float* out; unsigned char* ws; int ph_lo, ph_hi; };
struct Frame {
    LAS unsigned char* lds;
    const float* in[23]; float* out; unsigned char* ws;
    int tid, lane, wave, bid, G;
    int vc;
};

DI unsigned cvtpk(float lo, float hi) { f32x2_t v = {lo, hi}; bf16x2_t b = __builtin_convertvector(v, bf16x2_t); return __builtin_bit_cast(unsigned, b); }
DI float bflo(unsigned u) { return __uint_as_float(u << 16); }
DI float bfhi(unsigned u) { return __uint_as_float(u & 0xffff0000u); }

template <int M> DI unsigned lxu(unsigned v) {
    if constexpr (M == 1) return (unsigned)__builtin_amdgcn_mov_dpp((int)v, 0xB1, 0xf, 0xf, true);
    else if constexpr (M == 2) return (unsigned)__builtin_amdgcn_mov_dpp((int)v, 0x4E, 0xf, 0xf, true);
    else if constexpr (M == 7) return (unsigned)__builtin_amdgcn_mov_dpp((int)v, 0x141, 0xf, 0xf, true);
    else if constexpr (M == 8) return (unsigned)__builtin_amdgcn_mov_dpp((int)v, 0x128, 0xf, 0xf, true);
    else if constexpr (M == 16) { auto r = __builtin_amdgcn_permlane16_swap(v, v, false, false); return r[0] ^ r[1] ^ v; }
    else { static_assert(M == 32, "lxu: M"); auto r = __builtin_amdgcn_permlane32_swap(v, v, false, false); return r[0] ^ r[1] ^ v; }
}
template <int M> DI float lx(float v) { return __uint_as_float(lxu<M>(__float_as_uint(v))); }
template <int M> DI int lx(int v) { return (int)lxu<M>((unsigned)v); }
DI float wave_sum(float v) { v += lx<1>(v); v += lx<2>(v); v += lx<7>(v); v += lx<8>(v); v += lx<16>(v); v += lx<32>(v); return v; }
DI float wave_max(float v) { v = fmaxf(v, lx<1>(v)); v = fmaxf(v, lx<2>(v)); v = fmaxf(v, lx<7>(v)); v = fmaxf(v, lx<8>(v)); v = fmaxf(v, lx<16>(v)); v = fmaxf(v, lx<32>(v)); return v; }
DI int crow(int r, int hi) { return (r & 3) + 8 * (r >> 2) + 4 * hi; }
#define MFMA32(a, b, c) __builtin_amdgcn_mfma_f32_32x32x16_bf16((a), (b), (c), 0, 0, 0)
typedef short v4i16_t __attribute__((ext_vector_type(4)));
DI s16x4 tr16(const LAS unsigned char* p) { return __builtin_bit_cast(s16x4, __builtin_amdgcn_ds_read_tr16_b64_v4i16((LAS v4i16_t*)p)); }
DI int tr_off(int tok, int ch) { return (ch >> 2) * 4096 + (tok >> 4) * 1024 + (tok & 15) * 64 + (ch & 3) * 16; }
DI bf16x8 tr_frag(const LAS unsigned char* img, int dh, int ks, int lane) {
    const int hi = lane >> 5; const int vb = ((lane >> 4) & 1) * 32 + (lane & 3) * 8 + (4 * hi + ((lane & 15) >> 2)) * 64;
    const s16x4 lo = tr16(img + vb + dh * 4096 + ks * 1024), h2 = tr16(img + vb + dh * 4096 + ks * 1024 + 512);
    return __builtin_shufflevector(lo, h2, 0, 1, 2, 3, 4, 5, 6, 7);
}
template <int NTOK> DI bf16x8 row_frag(const LAS unsigned char* img, int tt, int ks, int lane) {
    const int hi = lane >> 5, r32 = lane & 31;
    return *(const LAS bf16x8*)(img + (2 * ks + hi) * (NTOK * 16) + (32 * tt + r32) * 16);
}
DI bf16x8 pack8(const f32x16& x, int s) {
    u32x4 p; p.x = cvtpk(x[8 * s], x[8 * s + 1]); p.y = cvtpk(x[8 * s + 2], x[8 * s + 3]); p.z = cvtpk(x[8 * s + 4], x[8 * s + 5]); p.w = cvtpk(x[8 * s + 6], x[8 * s + 7]);
    return __builtin_bit_cast(bf16x8, p);
}

DI void p0_ada(Frame& F) {
    LAS float* sil = (LAS float*)F.lds;
    LAS float* red = (LAS float*)(F.lds + 65536);
    const float* c = F.in[1];
    for (int i = F.tid; i < 16 * 1024; i += NT) { const int b = i >> 10, d = i & 1023; const float v = c[i]; sil[d * 16 + b] = v / (1.f + expf(-v)); }
    __syncthreads();
    for (int item = F.bid; item < 224; item += F.G) {
        const float* W; const float* bias; float* out; int N, col0;
        if (item < 192) { const int layer = item / 96, it = item % 96; W = F.in[2] + (size_t)layer * 1024 * 6144; bias = F.in[3] + layer * 6144; N = 6144; col0 = it * 64; out = (float*)(F.ws + WS_MODS) + (size_t)layer * 16 * 6144; }
        else { const int it = item - 192; W = F.in[11]; bias = F.in[12]; N = 2048; col0 = it * 64; out = (float*)(F.ws + WS_KVMODS); }
        float acc[16];
#pragma unroll
        for (int b = 0; b < 16; ++b) acc[b] = 0.f;
        const int d0 = F.wave * 128;
        const float* wp = W + (size_t)d0 * N + col0 + F.lane;
#pragma unroll 16
        for (int d = 0; d < 128; ++d) {
            const float w = wp[(size_t)d * N];
            const LAS f32x4* s4 = (const LAS f32x4*)(sil + (d0 + d) * 16);
            const f32x4 s0 = s4[0], s1 = s4[1], s2 = s4[2], s3 = s4[3];
            acc[0] += w * s0[0]; acc[1] += w * s0[1]; acc[2] += w * s0[2]; acc[3] += w * s0[3];
            acc[4] += w * s1[0]; acc[5] += w * s1[1]; acc[6] += w * s1[2]; acc[7] += w * s1[3];
            acc[8] += w * s2[0]; acc[9] += w * s2[1]; acc[10] += w * s2[2]; acc[11] += w * s2[3];
            acc[12] += w * s3[0]; acc[13] += w * s3[1]; acc[14] += w * s3[2]; acc[15] += w * s3[3];
        }
#pragma unroll
        for (int b = 0; b < 16; ++b) red[(F.wave * 16 + b) * 64 + F.lane] = acc[b];
        __syncthreads();
        for (int i = F.tid; i < 1024; i += NT) { const int b = i >> 6, l = i & 63; float s = 0.f;
#pragma unroll
            for (int w = 0; w < 8; ++w) s += red[(w * 16 + b) * 64 + l];
            out[(size_t)b * N + col0 + l] = s + bias[col0 + l]; }
        __syncthreads();
    }
}
DI void transpose_item(const float* W, int ldw, bf16* WT, int dst_row0, LAS float* scr, int k0, int n0, int lane) {
#pragma unroll 8
    for (int i = 0; i < 32; ++i) { const int kk = 2 * i + (lane >> 5); scr[kk * 33 + (lane & 31)] = W[(size_t)(k0 + kk) * ldw + n0 + (lane & 31)]; }
    asm volatile("s_waitcnt lgkmcnt(0)" ::: "memory");
    const int c = lane & 7;
#pragma unroll
    for (int j = 0; j < 4; ++j) { const int n = (lane >> 3) + 8 * j; const LAS float* s = scr + (8 * c) * 33 + n;
        u32x4 o; o.x = cvtpk(s[0 * 33], s[1 * 33]); o.y = cvtpk(s[2 * 33], s[3 * 33]); o.z = cvtpk(s[4 * 33], s[5 * 33]); o.w = cvtpk(s[6 * 33], s[7 * 33]);
        *(u32x4*)(WT + (size_t)(dst_row0 + n) * 1024 + k0 + 8 * c) = o; }
    asm volatile("s_waitcnt lgkmcnt(0)" ::: "memory");
}
DI int permrow(int c) { return (c & ~255) + 32 * (4 * ((c >> 5) & 1) + ((c >> 6) & 3)) + (c & 31); }
DI void p0a_prologue(Frame& F) {
    p0_ada(F);
    for (size_t i = (size_t)F.bid * NT + F.tid; i < 16 * 1024; i += (size_t)F.G * NT) { const int g = (int)(i >> 10), k = (int)(i & 1023); ((float*)(F.ws + WS_WG))[i] = F.in[6][(size_t)k * 3088 + 3072 + g]; }
}
DI void p_transposes(Frame& F, int it_lo, int it_hi, LAS float* scr) {
    const int gw = F.bid * NWAVES + F.wave, NGW = F.G * NWAVES;
    for (int it = it_lo + gw; it < it_hi; it += NGW) {
        int r = it; const float* W; int ldw, ncols; bf16* dst; bool perm;
        if (r < 1536) { W = F.in[6]; ldw = 3088; ncols = 3072; dst = (bf16*)(F.ws + WS_WIN); perm = false; }
        else if ((r -= 1536) < 512) { W = F.in[10]; ldw = 1024; ncols = 1024; dst = (bf16*)(F.ws + WS_WOUT); perm = false; }
        else if ((r -= 512) < 1024) { W = F.in[14]; ldw = 2048; ncols = 2048; dst = (bf16*)(F.ws + WS_WKV); perm = true; }
        else if ((r -= 1024) < 512) { W = F.in[16]; ldw = 1024; ncols = 1024; dst = (bf16*)(F.ws + WS_WSQ); perm = true; }
        else if ((r -= 512) < 512) { W = F.in[18]; ldw = 1024; ncols = 1024; dst = (bf16*)(F.ws + WS_WSO); perm = false; }
        else if ((r -= 512) < 1024) { W = F.in[19]; ldw = 2048; ncols = 2048; dst = (bf16*)(F.ws + WS_WPQ); perm = false; }
        else { r -= 1024; W = F.in[19] + (size_t)1024 * 2048; ldw = 2048; ncols = 2048; dst = (bf16*)(F.ws + WS_WPQ) + (size_t)2048 * 1024; perm = false; }
        const int nblk = ncols / 32, kb = r / nblk, nb = r % nblk, n0 = 32 * nb;
        transpose_item(W, ldw, dst, perm ? permrow(n0) : n0, scr, 64 * kb, n0, F.lane);
    }
}
DI void p0b_prologue(Frame& F) {
    p_transposes(F, 0, 6144, (LAS float*)(F.lds + F.wave * 16384));
    const size_t gt = (size_t)F.bid * NT + F.tid, NGT = (size_t)F.G * NT;
    for (size_t i = gt; i < 65536 / 2; i += NGT) { const float a = F.in[20][2 * i], b = F.in[20][2 * i + 1]; ((unsigned*)(F.ws + WS_SUBK))[i] = cvtpk(a, b); }
}

DI void p_tables(Frame& F) {
    const int gw = F.bid * NWAVES + F.wave, NGW = F.G * NWAVES;
    for (int row = gw; row < 2 * 16384; row += NGW) {
        const f32x4* src = (const f32x4*)(F.in[22] + (size_t)row * 1024) + 4 * F.lane;
        const f32x4 a = src[0], b = src[1], c2 = src[2], d = src[3];
        float m = fmaxf(fmaxf(fmaxf(fabsf(a[0]), fabsf(a[1])), fmaxf(fabsf(a[2]), fabsf(a[3]))), fmaxf(fmaxf(fabsf(b[0]), fabsf(b[1])), fmaxf(fabsf(b[2]), fabsf(b[3]))));
        m = fmaxf(m, fmaxf(fmaxf(fmaxf(fabsf(c2[0]), fabsf(c2[1])), fmaxf(fabsf(c2[2]), fabsf(c2[3]))), fmaxf(fmaxf(fabsf(d[0]), fabsf(d[1])), fmaxf(fabsf(d[2]), fabsf(d[3])))));
        m = fmaxf(wave_max(m), 1e-30f);
        const float inv = 127.0f / m;
        auto q4 = [&](const f32x4& v) -> unsigned { const int x0 = (int)rintf(v[0] * inv), x1 = (int)rintf(v[1] * inv), x2 = (int)rintf(v[2] * inv), x3 = (int)rintf(v[3] * inv);
            return (unsigned)(x0 & 255) | ((unsigned)(x1 & 255) << 8) | ((unsigned)(x2 & 255) << 16) | ((unsigned)(x3 & 255) << 24); };
        { const size_t ly = (size_t)row >> 14, e = (size_t)row & 16383;
          ((u32x4*)(F.ws + WS_V))[(((ly * 8 + (F.lane >> 3)) * 16384 + e) << 3) + (F.lane & 7)] = (u32x4){q4(a), q4(b), q4(c2), q4(d)}; }
        if (F.lane == 0) ((float*)(F.ws + WS_SV))[row] = m * (1.0f / 127.0f);
    }
    for (int row = gw; row < 2 * 16384; row += NGW) {
        const f32x4* src = (const f32x4*)(F.in[21] + (size_t)row * 1024) + 4 * F.lane;
        const f32x4 a = src[0], b = src[1], c2 = src[2], d = src[3];
        float m = fmaxf(fmaxf(fmaxf(fabsf(a[0]), fabsf(a[1])), fmaxf(fabsf(a[2]), fabsf(a[3]))), fmaxf(fmaxf(fabsf(b[0]), fabsf(b[1])), fmaxf(fabsf(b[2]), fabsf(b[3]))));
        m = fmaxf(m, fmaxf(fmaxf(fmaxf(fabsf(c2[0]), fabsf(c2[1])), fmaxf(fabsf(c2[2]), fabsf(c2[3]))), fmaxf(fmaxf(fabsf(d[0]), fabsf(d[1])), fmaxf(fabsf(d[2]), fabsf(d[3])))));
        m = fmaxf(wave_max(m), 1e-30f);
        const float inv = 127.0f / m;
        auto q4 = [&](const f32x4& v) -> unsigned { const int x0 = (int)rintf(v[0] * inv), x1 = (int)rintf(v[1] * inv), x2 = (int)rintf(v[2] * inv), x3 = (int)rintf(v[3] * inv);
            return (unsigned)(x0 & 255) | ((unsigned)(x1 & 255) << 8) | ((unsigned)(x2 & 255) << 16) | ((unsigned)(x3 & 255) << 24); };
        { const size_t ly = (size_t)row >> 14, e = (size_t)row & 16383;
          ((u32x4*)(F.ws + WS_U))[(((ly * 8 + (F.lane >> 3)) * 16384 + e) << 3) + (F.lane & 7)] = (u32x4){q4(a), q4(b), q4(c2), q4(d)}; }
        if (F.lane == 0) ((float*)(F.ws + WS_SU))[row] = m * (1.0f / 127.0f);
    }
}
template <bool GATES, bool Q8> DI void norm_row(Frame& F, f32x4 (&v)[4], int row, const f32x4 (&A)[4], const f32x4 (&Bv)[4], bf16* hout, const LAS float* wg) {
    float ss = 0.f;
#pragma unroll
    for (int j = 0; j < 4; ++j) ss += (v[j][0] * v[j][0] + v[j][1] * v[j][1]) + (v[j][2] * v[j][2] + v[j][3] * v[j][3]);
    const float rstd = 1.0f / sqrtf(wave_sum(ss) * (1.0f / DM) + EPS);
    unsigned long long* o8 = (unsigned long long*)(hout + (size_t)row * DM) + F.lane;
#pragma unroll
    for (int j = 0; j < 4; ++j) { v[j] = v[j] * rstd * A[j] + Bv[j]; o8[64 * j] = (unsigned long long)cvtpk(v[j][0], v[j][1]) | ((unsigned long long)cvtpk(v[j][2], v[j][3]) << 32); }
    if (Q8) {
        float m = 0.f;
#pragma unroll
        for (int j = 0; j < 4; ++j) m = fmaxf(m, fmaxf(fmaxf(fabsf(v[j][0]), fabsf(v[j][1])), fmaxf(fabsf(v[j][2]), fabsf(v[j][3]))));
        m = fmaxf(wave_max(m), 1e-30f);
        const float inv = 127.0f / m;
        unsigned* q8 = (unsigned*)(F.ws + WS_H2Q + (size_t)row * DM) + F.lane;
#pragma unroll
        for (int j = 0; j < 4; ++j) { const int x0 = (int)rintf(v[j][0] * inv), x1 = (int)rintf(v[j][1] * inv), x2 = (int)rintf(v[j][2] * inv), x3 = (int)rintf(v[j][3] * inv);
            q8[64 * j] = (unsigned)(x0 & 255) | ((unsigned)(x1 & 255) << 8) | ((unsigned)(x2 & 255) << 16) | ((unsigned)(x3 & 255) << 24); }
        if (F.lane == 0) ((float*)(F.ws + WS_SH))[row] = m * (1.0f / 127.0f);
    }
    if (GATES) {
        float p[16];
#pragma unroll
        for (int q = 0; q < 16; ++q) { float s = 0.f;
#pragma unroll
            for (int j = 0; j < 4; ++j) { const f32x4 w = *(const LAS f32x4*)(wg + q * 1024 + 4 * F.lane + 256 * j); s += (v[j][0] * w[0] + v[j][1] * w[1]) + (v[j][2] * w[2] + v[j][3] * w[3]); }
            p[q] = s; if ((q & 3) == 3) { asm volatile("" ::: "memory"); __builtin_amdgcn_sched_barrier(0); } }
#pragma unroll
        for (int i = 0; i < 8; ++i) { const bool up = (F.lane & 32) != 0; const float send = up ? p[i] : p[i + 8], keep = up ? p[i + 8] : p[i]; p[i] = keep + lx<32>(send); }
#pragma unroll
        for (int i = 0; i < 4; ++i) { const bool up = (F.lane & 16) != 0; const float send = up ? p[i] : p[i + 4], keep = up ? p[i + 4] : p[i]; p[i] = keep + lx<16>(send); }
#pragma unroll
        for (int i = 0; i < 2; ++i) { const bool up = (F.lane & 8) != 0; const float send = up ? p[i] : p[i + 2], keep = up ? p[i + 2] : p[i]; p[i] = keep + lx<8>(send); }
        { const bool up = (F.lane & 4) != 0; const float send = up ? p[0] : p[1], keep = up ? p[1] : p[0]; p[0] = keep + lx<7>(send); }
        p[0] += lx<2>(p[0]); p[0] += lx<1>(p[0]);
        const int gi = ((F.lane >> 5) & 1) * 8 + ((F.lane >> 4) & 1) * 4 + ((F.lane >> 3) & 1) * 2 + ((F.lane >> 2) & 1);
        if ((F.lane & 3) == 0) ((float*)(F.ws + WS_GATES))[(size_t)row * 16 + gi] = p[0];
    }
}
DI void load_rows4(f32x4 (&buf)[4][4], const float* xin, int row, int lane) {
#pragma unroll
    for (int r = 0; r < 4; ++r) { const f32x4* xr = (const f32x4*)(xin + (size_t)(row + r) * DM) + lane;
#pragma unroll
        for (int j = 0; j < 4; ++j) buf[r][j] = xr[64 * j]; }
}
template <bool GATES, bool Q8 = false> DI void norm_phase(Frame& F, const float* xin, const float* g, const float* shp, const float* scp, int bstride, bf16* hout) {
    const int gw = F.bid * NWAVES + F.wave, NGW = F.G * NWAVES;
    LAS float* wg = (LAS float*)F.lds;
    if (GATES) { const float* src = (const float*)(F.ws + WS_WG); for (int i = F.tid; i < 16 * 1024 / 4; i += NT) ((LAS f32x4*)wg)[i] = ((const f32x4*)src)[i]; __syncthreads(); }
    for (int chunk = gw; chunk < T_TOK / 16; chunk += NGW) {
        const int row0 = chunk * 16, b = row0 >> 11;
        f32x4 A[4], Bv[4];
#pragma unroll
        for (int j = 0; j < 4; ++j) { const int c = 4 * F.lane + 256 * j; const f32x4 gg = *(const f32x4*)(g + c), sc = *(const f32x4*)(scp + (size_t)b * bstride + c);
            A[j] = gg * (sc + 1.0f); Bv[j] = *(const f32x4*)(shp + (size_t)b * bstride + c); }
        f32x4 bufA[4][4], bufB[4][4];
        load_rows4(bufA, xin, row0, F.lane);
#pragma unroll 1
        for (int gq = 0; gq < 4; gq += 2) {
            load_rows4(bufB, xin, row0 + 4 * (gq + 1), F.lane);
#pragma unroll
            for (int r = 0; r < 4; ++r) norm_row<GATES, Q8>(F, bufA[r], row0 + 4 * gq + r, A, Bv, hout, wg);
            if (gq + 2 < 4) load_rows4(bufA, xin, row0 + 4 * (gq + 2), F.lane);
#pragma unroll
            for (int r = 0; r < 4; ++r) norm_row<GATES, Q8>(F, bufB[r], row0 + 4 * (gq + 1) + r, A, Bv, hout, wg);
        }
    }
}
DI void norm2_phase(Frame& F, const float* xin, const float* gA, const float* shA, const float* scA, int strideA, bf16* outA, const float* gB, const float* shB, const float* scB, int strideB, bf16* outB) {
    const int gw = F.bid * NWAVES + F.wave, NGW = F.G * NWAVES;
    for (int chunk = gw; chunk < T_TOK / 16; chunk += NGW) {
        const int row0 = chunk * 16, b = row0 >> 11;
        f32x4 A1[4], B1[4], A2[4], B2[4];
#pragma unroll
        for (int j = 0; j < 4; ++j) { const int c = 4 * F.lane + 256 * j;
            A1[j] = *(const f32x4*)(gA + c) * (*(const f32x4*)(scA + (size_t)b * strideA + c) + 1.0f); B1[j] = *(const f32x4*)(shA + (size_t)b * strideA + c);
            A2[j] = *(const f32x4*)(gB + c) * (*(const f32x4*)(scB + (size_t)b * strideB + c) + 1.0f); B2[j] = *(const f32x4*)(shB + (size_t)b * strideB + c); }
        f32x4 bufA[4][4], bufB[4][4];
        load_rows4(bufA, xin, row0, F.lane);
#define NORM2_ROW(V, ROW) { const int row = (ROW); float ss = 0.f; \
            _Pragma("unroll") for (int j = 0; j < 4; ++j) ss += (V[j][0] * V[j][0] + V[j][1] * V[j][1]) + (V[j][2] * V[j][2] + V[j][3] * V[j][3]); \
            const float rstd = 1.0f / sqrtf(wave_sum(ss) * (1.0f / DM) + EPS); \
            unsigned long long* oa = (unsigned long long*)(outA + (size_t)row * DM) + F.lane; unsigned long long* ob = (unsigned long long*)(outB + (size_t)row * DM) + F.lane; \
            _Pragma("unroll") for (int j = 0; j < 4; ++j) { const f32x4 xn = V[j] * rstd; const f32x4 ya = xn * A1[j] + B1[j], yb = xn * A2[j] + B2[j]; \
                oa[64 * j] = (unsigned long long)cvtpk(ya[0], ya[1]) | ((unsigned long long)cvtpk(ya[2], ya[3]) << 32); \
                ob[64 * j] = (unsigned long long)cvtpk(yb[0], yb[1]) | ((unsigned long long)cvtpk(yb[2], yb[3]) << 32); } }
#pragma unroll 1
        for (int gq = 0; gq < 4; gq += 2) {
            load_rows4(bufB, xin, row0 + 4 * (gq + 1), F.lane);
#pragma unroll
            for (int r = 0; r < 4; ++r) NORM2_ROW(bufA[r], row0 + 4 * gq + r)
            if (gq + 2 < 4) load_rows4(bufA, xin, row0 + 4 * (gq + 2), F.lane);
#pragma unroll
            for (int r = 0; r < 4; ++r) NORM2_ROW(bufB[r], row0 + 4 * (gq + 1) + r)
        }
#undef NORM2_ROW
    }
}

DI void mlstm_gates(Frame& F, size_t trow0, int h, float& ipre, float& bcum, float& blast) {
    const float* gates = (const float*)(F.ws + WS_GATES); const float* bif = F.in[8];
    const float iv = gates[(trow0 + F.lane) * 16 + h] + bif[h];
    const float fv = gates[(trow0 + F.lane) * 16 + 8 + h] + bif[8 + h];
    float b = -(fmaxf(-fv, 0.f) + log1pf(expf(-fabsf(fv))));
#pragma unroll
    for (int d = 1; d < 64; d <<= 1) { const float t = __shfl_up(b, d); if (F.lane >= d) b += t; }
    ipre = iv; bcum = b; blast = __shfl(b, 63);
}
template <int MODE> DI void stage_qk(LAS unsigned char* dst, const LAS float* e_s, const bf16* proj, const float* convw, int tseq0, size_t trow0, int col0, int lane, bf16* gout = nullptr  ) {
    const int g8 = lane >> 3, ch = lane & 7, col = col0 + 8 * ch;
    float cw[4][8];
#pragma unroll
    for (int tap = 0; tap < 4; ++tap) { const f32x4 a = *(const f32x4*)(convw + tap * 1024 + col), b = *(const f32x4*)(convw + tap * 1024 + col + 4);
        cw[tap][0] = a[0]; cw[tap][1] = a[1]; cw[tap][2] = a[2]; cw[tap][3] = a[3]; cw[tap][4] = b[0]; cw[tap][5] = b[1]; cw[tap][6] = b[2]; cw[tap][7] = b[3]; }
#pragma unroll 1
    for (int ph = 0; ph < 2; ++ph) {
        float x[7][8];
#pragma unroll
        for (int i = 0; i < 7; ++i) {
            const int rel = 8 * g8 + 4 * ph + i - 3; const bool valid = (tseq0 + rel) >= 0; const long rr = valid ? (long)rel : 0;
            u32x4 raw = *(const u32x4*)(proj + (size_t)((long)trow0 + rr) * 3072 + col);
            if (!valid) raw = (u32x4){0u, 0u, 0u, 0u};
            x[i][0] = bflo(raw.x); x[i][1] = bfhi(raw.x); x[i][2] = bflo(raw.y); x[i][3] = bfhi(raw.y); x[i][4] = bflo(raw.z); x[i][5] = bfhi(raw.z); x[i][6] = bflo(raw.w); x[i][7] = bfhi(raw.w);
        }
#pragma unroll
        for (int o = 0; o < 4; ++o) {
            const int tok = 8 * g8 + 4 * ph + o;
            float y[8];
#pragma unroll
            for (int e = 0; e < 8; ++e) { float a = cw[0][e] * x[o][e] + cw[1][e] * x[o + 1][e] + cw[2][e] * x[o + 2][e] + cw[3][e] * x[o + 3][e]; y[e] = a / (1.f + __expf(-a)); }
            if (MODE == 0 || MODE == 3) {
                const float gs = (MODE == 3) ? 0.125f : 1.f;
                u32x4 wg; wg.x = cvtpk(y[0] * gs, y[1] * gs); wg.y = cvtpk(y[2] * gs, y[3] * gs); wg.z = cvtpk(y[4] * gs, y[5] * gs); wg.w = cvtpk(y[6] * gs, y[7] * gs);
                *(u32x4*)(gout + (size_t)tok * 512 + 8 * ch) = wg; }
            if (MODE != 3) {
            float sc = 1.f; if (MODE == 0) sc = e_s[tok]; if (MODE == 1) sc = 0.125f;
            u32x4 w; w.x = cvtpk(y[0] * sc, y[1] * sc); w.y = cvtpk(y[2] * sc, y[3] * sc); w.z = cvtpk(y[4] * sc, y[5] * sc); w.w = cvtpk(y[6] * sc, y[7] * sc);
            const int off = (MODE == 0) ? tr_off(tok, ch) : ch * 1024 + tok * 16;
            *(LAS u32x4*)(dst + off) = w; }
        }
    }
}
DI void qk_load_raw(u32x4 (&raw)[11], const bf16* proj, int tseq0, size_t trow0, int col0, int lane) {
    const int g8 = lane >> 3, ch = lane & 7, col = col0 + 8 * ch;
#pragma unroll
    for (int i = 0; i < 11; ++i) {
        const int rel = 8 * g8 + i - 3; const bool valid = (tseq0 + rel) >= 0; const long rr = valid ? (long)rel : 0;
        raw[i] = *(const u32x4*)(proj + (size_t)((long)trow0 + rr) * 3072 + col);
        if (!valid) raw[i] = (u32x4){0u, 0u, 0u, 0u};
    }
}
template <int MODE> DI void qk_conv_raw(LAS unsigned char* dst, const LAS float* e_s, const u32x4 (&raw)[11], const float* convw, int col0, int lane, bf16* gout) {
    const int g8 = lane >> 3, ch = lane & 7, col = col0 + 8 * ch;
    float cw[4][8];
#pragma unroll
    for (int tap = 0; tap < 4; ++tap) { const f32x4 a = *(const f32x4*)(convw + tap * 1024 + col), b = *(const f32x4*)(convw + tap * 1024 + col + 4);
        cw[tap][0] = a[0]; cw[tap][1] = a[1]; cw[tap][2] = a[2]; cw[tap][3] = a[3]; cw[tap][4] = b[0]; cw[tap][5] = b[1]; cw[tap][6] = b[2]; cw[tap][7] = b[3]; }
#pragma unroll
    for (int ph = 0; ph < 2; ++ph) {
        float x[7][8];
#pragma unroll
        for (int i = 0; i < 7; ++i) { const u32x4 r = raw[4 * ph + i];
            x[i][0] = bflo(r.x); x[i][1] = bfhi(r.x); x[i][2] = bflo(r.y); x[i][3] = bfhi(r.y); x[i][4] = bflo(r.z); x[i][5] = bfhi(r.z); x[i][6] = bflo(r.w); x[i][7] = bfhi(r.w); }
#pragma unroll
        for (int o = 0; o < 4; ++o) {
            const int tok = 8 * g8 + 4 * ph + o;
            float y[8];
#pragma unroll
            for (int e = 0; e < 8; ++e) { float a = cw[0][e] * x[o][e] + cw[1][e] * x[o + 1][e] + cw[2][e] * x[o + 2][e] + cw[3][e] * x[o + 3][e]; y[e] = a / (1.f + __expf(-a)); }
            const float gs = (MODE == 3) ? 0.125f : 1.f;
            u32x4 wg; wg.x = cvtpk(y[0] * gs, y[1] * gs); wg.y = cvtpk(y[2] * gs, y[3] * gs); wg.z = cvtpk(y[4] * gs, y[5] * gs); wg.w = cvtpk(y[6] * gs, y[7] * gs);
            *(u32x4*)(gout + (size_t)tok * 512 + 8 * ch) = wg;
            if (MODE == 0) { const float sc = e_s[tok];
                u32x4 w; w.x = cvtpk(y[0] * sc, y[1] * sc); w.y = cvtpk(y[2] * sc, y[3] * sc); w.z = cvtpk(y[4] * sc, y[5] * sc); w.w = cvtpk(y[6] * sc, y[7] * sc);
                *(LAS u32x4*)(dst + tr_off(tok, ch)) = w; }
        }
        __builtin_amdgcn_sched_barrier(0);
    }
}
DI void stage_v_half(LAS unsigned char* dst, const bf16* proj, size_t trow0, int col0, int lane) {
    const int g8 = lane >> 3, ch = lane & 7;
#pragma unroll
    for (int o = 0; o < 8; ++o) { const int tok = 8 * g8 + o; const u32x4 raw = *(const u32x4*)(proj + (trow0 + tok) * 3072 + col0 + 8 * ch); *(LAS u32x4*)(dst + tr_off(tok, ch)) = raw; }
}
constexpr int MW_LDS = 17408;

DI void p3_mlstm_local(Frame& F) {
    LAS unsigned char* wl = F.lds + F.wave * MW_LDS;
    LAS unsigned char* kimg = wl; LAS unsigned char* vimg = wl + 8192; LAS float* e_s = (LAS float*)(wl + 16384);
    const bf16* proj = (const bf16*)(F.ws + WS_PROJ);
    bf16* cst = (bf16*)(F.ws + WS_CST);
    const int lane = F.lane, r32 = lane & 31, hi = lane >> 5;
    if ((F.wave & 1) == 0) p_tables(F);
    for (int bu = F.bid; bu < 512; bu += F.G) {
        int h = F.wave; asm volatile("" : "+s"(h));
        const int b = bu >> 5, c = bu & 31; const int unit = bu * 8 + h; const size_t trow0 = (size_t)b * SEQ + c * 64;
        u32x4 kraw[11], qraw[11], vraw[2][8];
        qk_load_raw(kraw, proj, c * 64, trow0, 512 + h * 64, lane); qk_load_raw(qraw, proj, c * 64, trow0, h * 64, lane);
        float ipre, bcum, blast; mlstm_gates(F, trow0, h, ipre, bcum, blast);
        const float w = blast - bcum + ipre; const float mloc = wave_max(w); const float e = expf(w - mloc);
        e_s[lane] = e;
        if (lane == 0) { ((float*)(F.ws + WS_BLAST))[unit] = blast; ((float*)(F.ws + WS_MLOC))[unit] = mloc; }
        qk_conv_raw<0>(kimg, e_s, kraw, F.in[7], 512 + h * 64, lane, (bf16*)(F.ws + WS_KC) + trow0 * 512 + h * 64);
        asm volatile("" ::: "memory"); __builtin_amdgcn_sched_barrier(0);
#pragma unroll
        for (int vh = 0; vh < 2; ++vh)
#pragma unroll
            for (int o = 0; o < 8; ++o) vraw[vh][o] = *(const u32x4*)(proj + (trow0 + 8 * (lane >> 3) + o) * 3072 + 1024 + h * 128 + 64 * vh + 8 * (lane & 7));
        qk_conv_raw<3>(nullptr, nullptr, qraw, F.in[7], h * 64, lane, (bf16*)(F.ws + WS_QC) + trow0 * 512 + h * 64);
        asm volatile("" ::: "memory"); __builtin_amdgcn_sched_barrier(0);
        bf16x8 kef[2][4];
#pragma unroll
        for (int kt = 0; kt < 2; ++kt)
#pragma unroll
            for (int ks = 0; ks < 4; ++ks) kef[kt][ks] = tr_frag(kimg, kt, ks, lane);
        const bf16x8 ones = {0x3F80, 0x3F80, 0x3F80, 0x3F80, 0x3F80, 0x3F80, 0x3F80, 0x3F80};
#pragma unroll
        for (int kt = 0; kt < 2; ++kt) { f32x16 an = {};
#pragma unroll
            for (int ks = 0; ks < 4; ++ks) an = MFMA32(kef[kt][ks], ones, an);
            if (r32 == 0) {
#pragma unroll
                for (int r = 0; r < 16; ++r) ((float*)(F.ws + WS_NLOC))[(size_t)unit * 64 + 32 * kt + crow(r, hi)] = an[r]; } }
#pragma unroll
        for (int vh = 0; vh < 2; ++vh) {
#pragma unroll
            for (int o = 0; o < 8; ++o) *(LAS u32x4*)(vimg + tr_off(8 * (lane >> 3) + o, lane & 7)) = vraw[vh][o];
#pragma unroll
            for (int vt = 0; vt < 2; ++vt) {
                bf16x8 vf[4];
#pragma unroll
                for (int ks = 0; ks < 4; ++ks) vf[ks] = tr_frag(vimg, vt, ks, lane);
#pragma unroll
                for (int kt = 0; kt < 2; ++kt) { f32x16 acc = {};
#pragma unroll
                    for (int ks = 0; ks < 4; ++ks) acc = MFMA32(kef[kt][ks], vf[ks], acc);
                    bf16* dstp = cst + ((size_t)unit * 128 + 64 * vh + 32 * vt + r32) * 64 + 32 * kt + 4 * hi;
#pragma unroll
                    for (int rg = 0; rg < 4; ++rg) { u32x2 pk; pk.x = cvtpk(acc[4 * rg], acc[4 * rg + 1]); pk.y = cvtpk(acc[4 * rg + 2], acc[4 * rg + 3]); *(u32x2*)(dstp + 8 * rg) = pk; }
                }
            }
            asm volatile("s_waitcnt lgkmcnt(0)" ::: "memory");
        }
    }
    if ((F.wave & 1) != 0) p_tables(F);
}
DI void p4_scan(Frame& F) {
    const int gt = F.bid * NT + F.tid, NGT = F.G * NT;
    const float* mlocp = (const float*)(F.ws + WS_MLOC); const float* blastp = (const float*)(F.ws + WS_BLAST);
    for (int item = gt; item < 128 * 1024; item += NGT) {
        const int bh = item >> 10, e8 = item & 1023, b = bh >> 3, h = bh & 7;
        float st[8]; float m = 0.f;
#pragma unroll
        for (int i = 0; i < 8; ++i) st[i] = 0.f;
        u32x4* p0 = (u32x4*)((bf16*)(F.ws + WS_CST) + (size_t)((b * 32) * 8 + h) * 8192) + e8;
        const int u0 = (b * 32) * 8 + h;
#pragma unroll 1
        for (int c0 = 0; c0 < 32; c0 += 8) {
            u32x4 raw[8]; float ml[8], bl[8];
#pragma unroll
            for (int j = 0; j < 8; ++j) { raw[j] = p0[(size_t)(c0 + j) * 8192]; ml[j] = mlocp[u0 + (c0 + j) * 8]; bl[j] = blastp[u0 + (c0 + j) * 8]; }
#pragma unroll
            for (int j = 0; j < 8; ++j) {
                u32x4 o; o.x = cvtpk(st[0], st[1]); o.y = cvtpk(st[2], st[3]); o.z = cvtpk(st[4], st[5]); o.w = cvtpk(st[6], st[7]); p0[(size_t)(c0 + j) * 8192] = o;
                const float mn = fmaxf(bl[j] + m, ml[j]), a = __expf(bl[j] + m - mn), r = __expf(ml[j] - mn);
                st[0] = a * st[0] + r * bflo(raw[j].x); st[1] = a * st[1] + r * bfhi(raw[j].x); st[2] = a * st[2] + r * bflo(raw[j].y); st[3] = a * st[3] + r * bfhi(raw[j].y);
                st[4] = a * st[4] + r * bflo(raw[j].z); st[5] = a * st[5] + r * bfhi(raw[j].z); st[6] = a * st[6] + r * bflo(raw[j].w); st[7] = a * st[7] + r * bfhi(raw[j].w);
                m = mn;
            }
        }
    }
    for (int item = gt; item < 128 * 64; item += NGT) {
        const int bh = item >> 6, k = item & 63, b = bh >> 3, h = bh & 7;
        float ns = 0.f, m = 0.f;
        const int u0 = (b * 32) * 8 + h;
#pragma unroll 1
        for (int c0 = 0; c0 < 32; c0 += 8) {
            float nl[8], ml[8], bl[8];
#pragma unroll
            for (int j = 0; j < 8; ++j) { const int unit = u0 + (c0 + j) * 8; nl[j] = ((const float*)(F.ws + WS_NLOC))[(size_t)unit * 64 + k]; ml[j] = mlocp[unit]; bl[j] = blastp[unit]; }
#pragma unroll
            for (int j = 0; j < 8; ++j) { const int unit = u0 + (c0 + j) * 8;
                ((float*)(F.ws + WS_NLOC))[(size_t)unit * 64 + k] = ns; if (k == 0) ((float*)(F.ws + WS_MPREV))[unit] = m;
                const float mn = fmaxf(bl[j] + m, ml[j]), a = __expf(bl[j] + m - mn), r = __expf(ml[j] - mn);
                ns = a * ns + r * nl[j]; m = mn; }
        }
    }
}
DI void p5_mlstm_out(Frame& F) {
    LAS unsigned char* wl = F.lds + F.wave * MW_LDS;
    LAS float* sc = (LAS float*)(wl + 16384);
    const bf16* proj = (const bf16*)(F.ws + WS_PROJ);
    const bf16* cst = (const bf16*)(F.ws + WS_CST);
    const bf16* QC = (const bf16*)(F.ws + WS_QC); const bf16* KC = (const bf16*)(F.ws + WS_KC);
    bf16* hh = (bf16*)(F.ws + WS_H);
    for (int bu = F.bid; bu < 512; bu += F.G) {
        int lane = F.lane; asm volatile("" : "+v"(lane)); const int r32 = lane & 31, hi = lane >> 5;
        int h = F.wave; asm volatile("" : "+s"(h));
        const int b = bu >> 5, c = bu & 31; const int unit = bu * 8 + h; const size_t trow0 = (size_t)b * SEQ + c * 64;
        {
            float ipre, bcum, blast; mlstm_gates(F, trow0, h, ipre, bcum, blast);
            const float mprev = ((const float*)(F.ws + WS_MPREV))[unit];
            const float gg = ipre - bcum; float pm = gg;
#pragma unroll
            for (int d = 1; d < 64; d <<= 1) { const float t = __shfl_up(pm, d); if (lane >= d) pm = fmaxf(pm, t); }
            const float Mx = fmaxf(mprev, pm), mt = bcum + Mx;
            sc[lane] = gg; sc[64 + lane] = Mx; sc[128 + lane] = expf(mprev - Mx); sc[192 + lane] = expf(-mt);
        }
        stage_v_half(wl, proj, trow0, 1024 + h * 128, lane); stage_v_half(wl + 8192, proj, trow0, 1024 + h * 128 + 64, lane);
        bf16x8 cf[4][4];
#pragma unroll
        for (int vt = 0; vt < 4; ++vt)
#pragma unroll
            for (int ks = 0; ks < 4; ++ks) cf[vt][ks] = *(const bf16x8*)(cst + ((size_t)unit * 128 + 32 * vt + r32) * 64 + 16 * ks + 8 * hi);
#pragma unroll 1
        for (int lt = 0; lt < 2; ++lt) {
            const int l = 32 * lt + r32;
            const size_t t = trow0 + l;
            bf16x8 qf[4];
#pragma unroll
            for (int ks = 0; ks < 4; ++ks) qf[ks] = *(const bf16x8*)(QC + t * 512 + h * 64 + 16 * ks + 8 * hi);
            const float Mxl = sc[64 + l];
            bf16x8 P[2][2]; float dsum = 0.f;
#pragma unroll
            for (int st = 0; st < 2; ++st) {
                P[st][0] = (bf16x8){0, 0, 0, 0, 0, 0, 0, 0}; P[st][1] = P[st][0];
                if (st <= lt) {
                    f32x16 acc = {};
#pragma unroll
                    for (int ks = 0; ks < 4; ++ks) acc = MFMA32(*(const bf16x8*)(KC + (trow0 + 32 * st + r32) * 512 + h * 64 + 16 * ks + 8 * hi), qf[ks], acc);
#pragma unroll
                    for (int r = 0; r < 16; ++r) { const int srow = crow(r, hi); float val = acc[r] * __expf(sc[32 * st + srow] - Mxl); if (st == lt && srow > r32) val = 0.f; acc[r] = val; dsum += val; }
                    P[st][0] = pack8(acc, 0); P[st][1] = pack8(acc, 1);
                }
            }
            float nq;
            { const float* np = (const float*)(F.ws + WS_NLOC) + (size_t)unit * 64; float s = 0.f;
#pragma unroll
              for (int ks = 0; ks < 4; ++ks) { const f32x4 n0 = *(const f32x4*)(np + 16 * ks + 8 * hi), n1 = *(const f32x4*)(np + 16 * ks + 8 * hi + 4); const u32x4 q = __builtin_bit_cast(u32x4, qf[ks]);
                  s += bflo(q.x) * n0[0] + bfhi(q.x) * n0[1] + bflo(q.y) * n0[2] + bfhi(q.y) * n0[3] + bflo(q.z) * n1[0] + bfhi(q.z) * n1[1] + bflo(q.w) * n1[2] + bfhi(q.w) * n1[3]; }
              nq = s + __shfl_xor(s, 32); }
            f32x16 acc[4];
#pragma unroll
            for (int vt = 0; vt < 4; ++vt) { acc[vt] = (f32x16){};
#pragma unroll
                for (int ks = 0; ks < 4; ++ks) acc[vt] = MFMA32(cf[vt][ks], qf[ks], acc[vt]); }
            const float iwl = sc[128 + l];
#pragma unroll
            for (int vt = 0; vt < 4; ++vt) acc[vt] = acc[vt] * iwl;
#pragma unroll
            for (int st = 0; st < 2; ++st) if (st <= lt) {
#pragma unroll
                for (int k2 = 0; k2 < 2; ++k2) {
#pragma unroll
                    for (int vt = 0; vt < 4; ++vt) acc[vt] = MFMA32(tr_frag(wl + (vt >> 1) * 8192, vt & 1, 2 * st + k2, lane), P[st][k2], acc[vt]); } }
            u32x2 o4[4][4];
#pragma unroll
            for (int vt = 0; vt < 4; ++vt)
#pragma unroll
                for (int rg = 0; rg < 4; ++rg) o4[vt][rg] = *(const u32x2*)(proj + t * 3072 + 2048 + h * 128 + 32 * vt + 8 * rg + 4 * hi);
            const float den = dsum + __shfl_xor(dsum, 32) + iwl * nq;
            const float inv = 1.0f / fmaxf(fabsf(den), sc[192 + l]);
            float ss = 0.f;
#pragma unroll
            for (int vt = 0; vt < 4; ++vt)
#pragma unroll
                for (int r = 0; r < 16; ++r) { const float v = acc[vt][r] * inv; acc[vt][r] = v; ss += v * v; }
            ss += __shfl_xor(ss, 32);
            const float rstd = 1.0f / sqrtf(ss * (1.0f / 128.0f) + EPS);
#pragma unroll
            for (int vt = 0; vt < 4; ++vt)
#pragma unroll
                for (int rg = 0; rg < 4; ++rg) { const int v = 32 * vt + 8 * rg + 4 * hi;
                    const f32x4 g4 = *(const f32x4*)(F.in[9] + h * 128 + v);
                    const float o0 = bflo(o4[vt][rg].x), o1 = bfhi(o4[vt][rg].x), o2 = bflo(o4[vt][rg].y), o3 = bfhi(o4[vt][rg].y);
                    const float y0 = acc[vt][4 * rg] * rstd * g4[0] / (1.f + __expf(-o0)), y1 = acc[vt][4 * rg + 1] * rstd * g4[1] / (1.f + __expf(-o1));
                    const float y2 = acc[vt][4 * rg + 2] * rstd * g4[2] / (1.f + __expf(-o2)), y3 = acc[vt][4 * rg + 3] * rstd * g4[3] / (1.f + __expf(-o3));
                    u32x2 pk; pk.x = cvtpk(y0, y1); pk.y = cvtpk(y2, y3); *(u32x2*)(hh + t * 1024 + h * 128 + v) = pk; }
        }
        asm volatile("s_waitcnt lgkmcnt(0)" ::: "memory");
    }
}

DI float softplus2(float z) { return fmaxf(z, 0.f) + __builtin_amdgcn_logf(1.f + __builtin_amdgcn_exp2f(-fabsf(z))); }
template <int VAR = 0> DI void p12_attn(Frame& F, bf16* O) {
    LAS unsigned char* kimg = F.lds + F.wave * 16384; LAS unsigned char* vimg = kimg + 8192;
    const bf16* Q = (const bf16*)(F.ws + WS_Q); const bf16* K = (const bf16*)(F.ws + WS_K); const bf16* V = (const bf16*)(F.ws + WS_VV);
    const int wave = F.wave;
    for (int bh = F.bid; bh < 256; bh += F.G) {
        const int b = bh >> 4, h = bh & 15;
#pragma unroll 1
        for (int qi = 0; qi < 8; ++qi) {
            int lane = F.lane; asm volatile("" : "+v"(lane)); const int r32 = lane & 31, hi = lane >> 5;
            const int skey = lane >> 3, schk = lane & 7;
            const int qt = 63 - (wave + 8 * qi);
            const int qlo = qt * 32;
            const size_t tq0 = (size_t)b * SEQ + qlo;
            bf16x8 qr[4];
#pragma unroll
            for (int ks = 0; ks < 4; ++ks) qr[ks] = *(const bf16x8*)(Q + (tq0 + r32) * 1024 + h * 64 + 16 * ks + 8 * hi);
            f32x16 o0 = {}, o1 = {}; float R = (VAR == 3 || VAR == 5) ? 1.f : 0.f;
            const int kt0 = (qlo + 30) >> 5;
            u32x4 kraw[4], vraw[4];
            { const bf16* kp = K + ((size_t)b * SEQ + 32 * kt0 + skey) * 1024 + h * 64 + 8 * schk; const bf16* vp = V + ((size_t)b * SEQ + 32 * kt0 + skey) * 1024 + h * 64 + 8 * schk;
#pragma unroll
              for (int i = 0; i < 4; ++i) { kraw[i] = *(const u32x4*)(kp + (size_t)i * 8 * 1024); vraw[i] = *(const u32x4*)(vp + (size_t)i * 8 * 1024); } }
#pragma unroll 1
            for (int kt = kt0; kt >= 0; --kt) {
#pragma unroll
                for (int i = 0; i < 4; ++i) { *(LAS u32x4*)(kimg + schk * 512 + (skey + 8 * i) * 16) = kraw[i]; *(LAS u32x4*)(vimg + tr_off(skey + 8 * i, schk)) = vraw[i]; }
                if (kt > 0) { const bf16* kp = K + ((size_t)b * SEQ + 32 * (kt - 1) + skey) * 1024 + h * 64 + 8 * schk; const bf16* vp = V + ((size_t)b * SEQ + 32 * (kt - 1) + skey) * 1024 + h * 64 + 8 * schk;
#pragma unroll
                    for (int i = 0; i < 4; ++i) { kraw[i] = *(const u32x4*)(kp + (size_t)i * 8 * 1024); vraw[i] = *(const u32x4*)(vp + (size_t)i * 8 * 1024); } }
                {
                    const bool diag = (32 * kt + 31 >= qlo);
                    const int qrel = qlo + r32 - 32 * kt;
                    f32x16 p = {};
#pragma unroll
                    for (int ks = 0; ks < 4; ++ks) p = MFMA32(row_frag<32>(kimg, 0, ks, lane), qr[ks], p);
                    if constexpr (VAR == 5) {
                    f32x2_t be2[8], om2[8];
#pragma unroll
                    for (int j = 0; j < 8; ++j) { const float t0 = __builtin_amdgcn_fmed3f(p[2 * j], -120.f, 3.0e38f), t1 = __builtin_amdgcn_fmed3f(p[2 * j + 1], -120.f, 3.0e38f);
                        const f32x2_t e = {__builtin_amdgcn_exp2f(-t0), __builtin_amdgcn_exp2f(-t1)}; const f32x2_t d = e + 1.0f;
                        const f32x2_t bb = {__builtin_amdgcn_rcpf(d.x), __builtin_amdgcn_rcpf(d.y)}; be2[j] = bb; om2[j] = e * bb; }
                    if (diag) {
#pragma unroll
                        for (int j = 0; j < 8; ++j) { const bool ok0 = crow(2 * j, hi) < qrel, ok1 = crow(2 * j + 1, hi) < qrel;
                            be2[j].x = ok0 ? be2[j].x : 0.f; om2[j].x = ok0 ? om2[j].x : 1.f; be2[j].y = ok1 ? be2[j].y : 0.f; om2[j].y = ok1 ? om2[j].y : 1.f; }
                    }
                    float ex1[4], ex0[4], gt[4], og[4], T[4];
#pragma unroll
                    for (int g = 0; g < 4; ++g) { ex1[g] = om2[2 * g + 1].y * om2[2 * g + 1].x; ex0[g] = ex1[g] * om2[2 * g].y; gt[g] = ex0[g] * om2[2 * g].x; }
#pragma unroll
                    for (int g = 0; g < 4; ++g) og[g] = __shfl_xor(gt[g], 32);
                    T[3] = 1.f; T[2] = gt[3] * og[3]; T[1] = T[2] * (gt[2] * og[2]); T[0] = T[1] * (gt[1] * og[1]);
                    const float tot = T[0] * (gt[0] * og[0]);
#pragma unroll
                    for (int g = 0; g < 4; ++g) { const float off = T[g] * (hi == 0 ? og[g] : 1.f) * R; const f32x2_t off2 = {off, off};
                        const f32x2_t t01 = (f32x2_t){ex0[g], ex1[g]} * off2; const f32x2_t t23 = {om2[2 * g + 1].y * off, off};
                        const f32x2_t p01 = be2[2 * g] * t01, p23 = be2[2 * g + 1] * t23;
                        p[4 * g] = p01.x; p[4 * g + 1] = p01.y; p[4 * g + 2] = p23.x; p[4 * g + 3] = p23.y; }
                    R *= tot;
                    } else
                    if constexpr (VAR == 3) {
                    float be[16], om[16];
#pragma unroll
                    for (int r = 0; r < 16; ++r) { const float e = __builtin_amdgcn_exp2f(-fmaxf(p[r], -120.f)); const float bb = __builtin_amdgcn_rcpf(1.f + e); be[r] = bb; om[r] = e * bb; }
                    if (diag) {
#pragma unroll
                        for (int r = 0; r < 16; ++r) { const bool ok = crow(r, hi) < qrel; be[r] = ok ? be[r] : 0.f; om[r] = ok ? om[r] : 1.f; }
                    }
                    float ex1[4], ex0[4], gt[4], og[4], T[4];
#pragma unroll
                    for (int g = 0; g < 4; ++g) { ex1[g] = om[4 * g + 3] * om[4 * g + 2]; ex0[g] = ex1[g] * om[4 * g + 1]; gt[g] = ex0[g] * om[4 * g]; }
#pragma unroll
                    for (int g = 0; g < 4; ++g) og[g] = __shfl_xor(gt[g], 32);
                    T[3] = 1.f; T[2] = gt[3] * og[3]; T[1] = T[2] * (gt[2] * og[2]); T[0] = T[1] * (gt[1] * og[1]);
                    const float tot = T[0] * (gt[0] * og[0]);
#pragma unroll
                    for (int g = 0; g < 4; ++g) { const float off = T[g] * (hi == 0 ? og[g] : 1.f) * R;
                        p[4 * g + 3] = be[4 * g + 3] * off; p[4 * g + 2] = be[4 * g + 2] * (om[4 * g + 3] * off); p[4 * g + 1] = be[4 * g + 1] * (ex1[g] * off); p[4 * g] = be[4 * g] * (ex0[g] * off); }
                    R *= tot;
                    } else {
                    float sp[16], mk[16];
                    if (diag) {
#pragma unroll
                        for (int r = 0; r < 16; ++r) { mk[r] = crow(r, hi) < qrel ? 1.f : 0.f; sp[r] = softplus2(p[r]) * mk[r]; }
                    } else {
#pragma unroll
                        for (int r = 0; r < 16; ++r) { mk[r] = 1.f; sp[r] = softplus2(p[r]); }
                    }
#pragma unroll
                    for (int g = 0; g < 4; ++g) { sp[4 * g + 2] += sp[4 * g + 3]; sp[4 * g + 1] += sp[4 * g + 2]; sp[4 * g] += sp[4 * g + 1]; }
                    float og[4], T[4], off[4];
#pragma unroll
                    for (int g = 0; g < 4; ++g) og[g] = __shfl_xor(sp[4 * g], 32);
                    T[3] = 0.f; T[2] = sp[12] + og[3]; T[1] = T[2] + sp[8] + og[2]; T[0] = T[1] + sp[4] + og[1];
                    const float tot = T[0] + sp[0] + og[0];
#pragma unroll
                    for (int g = 0; g < 4; ++g) off[g] = T[g] + (hi == 0 ? og[g] : 0.f) + R;
#pragma unroll
                    for (int r = 0; r < 16; ++r) p[r] = __builtin_amdgcn_exp2f(p[r] - sp[r] - off[r >> 2]) * mk[r];
                    R += tot;
                    }
                    const bf16x8 pa0 = pack8(p, 0), pa1 = pack8(p, 1);
                    o0 = MFMA32(pa0, tr_frag(vimg, 0, 0, lane), o0); o1 = MFMA32(pa0, tr_frag(vimg, 1, 0, lane), o1);
                    o0 = MFMA32(pa1, tr_frag(vimg, 0, 1, lane), o0); o1 = MFMA32(pa1, tr_frag(vimg, 1, 1, lane), o1);
                }
                if (VAR == 3 || VAR == 5) { if (__all(R == 0.f)) break; asm volatile("s_waitcnt lgkmcnt(0)" ::: "memory"); continue; }
                if (VAR == 1) break;
                if (__all(R >= (VAR == 2 ? 75.05f : 150.1f))) break;
                asm volatile("s_waitcnt lgkmcnt(0)" ::: "memory");
            }
            asm volatile("s_waitcnt lgkmcnt(0)" ::: "memory");
#pragma unroll
            for (int r = 0; r < 16; ++r) { bf16* op = O + (tq0 + crow(r, hi)) * 1024 + h * 64 + r32;
                op[0] = (bf16)(cvtpk(o0[r], 0.f) & 0xffffu); op[32] = (bf16)(cvtpk(o1[r], 0.f) & 0xffffu); }
        }
    }
}

template <int VAR = 0> DI void p12_attn_pipe(Frame& F, bf16* O) {
    LAS unsigned char* img = F.lds + F.wave * 16384;
    const bf16* Q = (const bf16*)(F.ws + WS_Q); const bf16* K = (const bf16*)(F.ws + WS_K); const bf16* V = (const bf16*)(F.ws + WS_VV);
    const int wave = F.wave;
    for (int bh = F.bid; bh < 256; bh += F.G) {
        const int b = bh >> 4, h = bh & 15;
#pragma unroll 1
        for (int qi = 0; qi < 8; ++qi) {
            int lane = F.lane; asm volatile("" : "+v"(lane)); const int r32 = lane & 31, hi = lane >> 5;
            const int skey = lane >> 3, schk = lane & 7;
            const int qt = 63 - (wave + 8 * qi);
            const int qlo = qt * 32;
            const size_t tq0 = (size_t)b * SEQ + qlo;
            bf16x8 qr[4];
#pragma unroll
            for (int ks = 0; ks < 4; ++ks) qr[ks] = *(const bf16x8*)(Q + (tq0 + r32) * 1024 + h * 64 + 16 * ks + 8 * hi);
            f32x16 o0 = {}, o1 = {}; float R = 1.f;
            const int kt0 = (qlo + 30) >> 5;
            u32x4 kraw[4], vraw[4];
#define ATT_LOAD(KT) { const size_t ro = ((size_t)b * SEQ + 32 * (KT) + skey) * 1024 + h * 64 + 8 * schk; \
              _Pragma("unroll") for (int i = 0; i < 4; ++i) { kraw[i] = *(const u32x4*)(K + ro + (size_t)i * 8 * 1024); vraw[i] = *(const u32x4*)(V + ro + (size_t)i * 8 * 1024); } }
#define ATT_STAGE(PB) { LAS unsigned char* kb = img + 4096 * (PB); \
              _Pragma("unroll") for (int i = 0; i < 4; ++i) { *(LAS u32x4*)(kb + schk * 512 + (skey + 8 * i) * 16) = kraw[i]; *(LAS u32x4*)(kb + 8192 + tr_off(skey + 8 * i, schk)) = vraw[i]; } }
            ATT_LOAD(kt0)
            ATT_STAGE(0)
            if (kt0 > 0) ATT_LOAD(kt0 - 1)
            f32x16 z = {};
#pragma unroll
            for (int ks = 0; ks < 4; ++ks) z = MFMA32(row_frag<32>(img, 0, ks, lane), qr[ks], z);
            int par = 0;
#pragma unroll 1
            for (int kt = kt0; kt >= 0; --kt) {
                f32x16 zn = {};
                if (kt > 0) {
                    ATT_STAGE(par ^ 1)
                    if (kt > 1) ATT_LOAD(kt - 2)
#pragma unroll
                    for (int ks = 0; ks < 4; ++ks) zn = MFMA32(row_frag<32>(img + 4096 * (par ^ 1), 0, ks, lane), qr[ks], zn);
                }
                {
                    const bool diag = (32 * kt + 31 >= qlo);
                    const int qrel = qlo + r32 - 32 * kt;
                    float be[16], om[16];
#pragma unroll
                    for (int r = 0; r < 16; ++r) { const float e = __builtin_amdgcn_exp2f(-fmaxf(z[r], -120.f)); const float bb = __builtin_amdgcn_rcpf(1.f + e); be[r] = bb; om[r] = e * bb; }
                    if (diag) {
#pragma unroll
                        for (int r = 0; r < 16; ++r) { const bool ok = crow(r, hi) < qrel; be[r] = ok ? be[r] : 0.f; om[r] = ok ? om[r] : 1.f; }
                    }
                    float ex1[4], ex0[4], gt[4], og[4], T[4];
#pragma unroll
                    for (int g = 0; g < 4; ++g) { ex1[g] = om[4 * g + 3] * om[4 * g + 2]; ex0[g] = ex1[g] * om[4 * g + 1]; gt[g] = ex0[g] * om[4 * g]; }
#pragma unroll
                    for (int g = 0; g < 4; ++g) og[g] = __shfl_xor(gt[g], 32);
                    T[3] = 1.f; T[2] = gt[3] * og[3]; T[1] = T[2] * (gt[2] * og[2]); T[0] = T[1] * (gt[1] * og[1]);
                    const float tot = T[0] * (gt[0] * og[0]);
                    f32x16 p;
#pragma unroll
                    for (int g = 0; g < 4; ++g) { const float off = T[g] * (hi == 0 ? og[g] : 1.f) * R;
                        p[4 * g + 3] = be[4 * g + 3] * off; p[4 * g + 2] = be[4 * g + 2] * (om[4 * g + 3] * off); p[4 * g + 1] = be[4 * g + 1] * (ex1[g] * off); p[4 * g] = be[4 * g] * (ex0[g] * off); }
                    R *= tot;
                    const bf16x8 pa0 = pack8(p, 0), pa1 = pack8(p, 1);
                    LAS unsigned char* vimg = img + 8192 + 4096 * par;
                    o0 = MFMA32(pa0, tr_frag(vimg, 0, 0, lane), o0); o1 = MFMA32(pa0, tr_frag(vimg, 1, 0, lane), o1);
                    o0 = MFMA32(pa1, tr_frag(vimg, 0, 1, lane), o0); o1 = MFMA32(pa1, tr_frag(vimg, 1, 1, lane), o1);
                }
                if (__all(R == 0.f)) break;
                z = zn; par ^= 1;
            }
#undef ATT_LOAD
#undef ATT_STAGE
            asm volatile("s_waitcnt lgkmcnt(0)" ::: "memory");
#pragma unroll
            for (int r = 0; r < 16; ++r) { bf16* op = O + (tq0 + crow(r, hi)) * 1024 + h * 64 + r32;
                op[0] = (bf16)(cvtpk(o0[r], 0.f) & 0xffffu); op[32] = (bf16)(cvtpk(o1[r], 0.f) & 0xffffu); }
        }
    }
}

DI void sb_weights(const f32x16& z, float& R, bool diag, int qrel, int hi, bf16x8& pa0, bf16x8& pa1) {
    f32x2_t be2[8], om2[8];
#pragma unroll
    for (int j = 0; j < 8; ++j) { const float t0 = __builtin_amdgcn_fmed3f(z[2 * j], -120.f, 3.0e38f), t1 = __builtin_amdgcn_fmed3f(z[2 * j + 1], -120.f, 3.0e38f);
        const f32x2_t e = {__builtin_amdgcn_exp2f(-t0), __builtin_amdgcn_exp2f(-t1)}; const f32x2_t d = e + 1.0f;
        const f32x2_t bb = {__builtin_amdgcn_rcpf(d.x), __builtin_amdgcn_rcpf(d.y)}; be2[j] = bb; om2[j] = e * bb; }
    if (diag) {
#pragma unroll
        for (int j = 0; j < 8; ++j) { const bool ok0 = crow(2 * j, hi) < qrel, ok1 = crow(2 * j + 1, hi) < qrel;
            be2[j].x = ok0 ? be2[j].x : 0.f; om2[j].x = ok0 ? om2[j].x : 1.f; be2[j].y = ok1 ? be2[j].y : 0.f; om2[j].y = ok1 ? om2[j].y : 1.f; }
    }
    float ex1[4], ex0[4], gt[4], og[4], T[4];
#pragma unroll
    for (int g = 0; g < 4; ++g) { ex1[g] = om2[2 * g + 1].y * om2[2 * g + 1].x; ex0[g] = ex1[g] * om2[2 * g].y; gt[g] = ex0[g] * om2[2 * g].x; }
#pragma unroll
    for (int g = 0; g < 4; ++g) og[g] = __shfl_xor(gt[g], 32);
    T[3] = 1.f; T[2] = gt[3] * og[3]; T[1] = T[2] * (gt[2] * og[2]); T[0] = T[1] * (gt[1] * og[1]);
    const float tot = T[0] * (gt[0] * og[0]);
    u32x4 w0, w1;
#pragma unroll
    for (int g = 0; g < 4; ++g) { const float off = T[g] * (hi == 0 ? og[g] : 1.f) * R; const f32x2_t off2 = {off, off};
        const f32x2_t t01 = (f32x2_t){ex0[g], ex1[g]} * off2; const f32x2_t t23 = {om2[2 * g + 1].y * off, off};
        const f32x2_t p01 = be2[2 * g] * t01, p23 = be2[2 * g + 1] * t23;
        const unsigned c01 = cvtpk(p01.x, p01.y), c23 = cvtpk(p23.x, p23.y);
        if (g == 0) { w0.x = c01; w0.y = c23; } else if (g == 1) { w0.z = c01; w0.w = c23; } else if (g == 2) { w1.x = c01; w1.y = c23; } else { w1.z = c01; w1.w = c23; } }
    R *= tot;
    pa0 = __builtin_bit_cast(bf16x8, w0); pa1 = __builtin_bit_cast(bf16x8, w1);
}
template <int VAR = 0> DI void p12_attn_v2(Frame& F, bf16* O) {
    LAS unsigned char* img = F.lds + F.wave * 16384;
    const bf16* Q = (const bf16*)(F.ws + WS_Q);
    const int wave = F.wave;
    for (int bh = F.bid; bh < 256; bh += F.G) {
        const int b = bh >> 4, h = bh & 15;
        const char* Kb = (const char*)(F.ws + WS_K) + ((size_t)b * SEQ * 1024 + h * 64) * 2; const char* Vb = (const char*)(F.ws + WS_VV) + ((size_t)b * SEQ * 1024 + h * 64) * 2;
#pragma unroll 1
        for (int qi = 0; qi < 8; ++qi) {
            int lane = F.lane; asm volatile("" : "+v"(lane)); const int r32 = lane & 31, hi = lane >> 5;
            const int skey = lane >> 3, schk = lane & 7;
            const unsigned lo0 = (unsigned)(skey * 1024 + 8 * schk) * 2u;
            const int qt = 63 - (wave + 8 * qi);
            const int qlo = qt * 32;
            const size_t tq0 = (size_t)b * SEQ + qlo;
            bf16x8 qr[4];
#pragma unroll
            for (int ks = 0; ks < 4; ++ks) qr[ks] = *(const bf16x8*)(Q + (tq0 + r32) * 1024 + h * 64 + 16 * ks + 8 * hi);
            f32x16 o0 = {}, o1 = {}; float R = 1.f;
            const int kt0 = (qlo + 30) >> 5;
            u32x4 ka[4], va[4], kb[4], vb[4];
#define ATT_LOAD(RK, RV, KT) { const char* kp_ = Kb + (size_t)(KT) * 65536; const char* vp_ = Vb + (size_t)(KT) * 65536; \
              _Pragma("unroll") for (int i = 0; i < 4; ++i) { RK[i] = *(const u32x4*)(kp_ + (size_t)(lo0 + 16384u * i)); RV[i] = *(const u32x4*)(vp_ + (size_t)(lo0 + 16384u * i)); } }
#define ATT_STAGE(RK, RV, PB) { _Pragma("unroll") for (int i = 0; i < 4; ++i) { *(LAS u32x4*)(img + 4096 * (PB) + schk * 512 + (skey + 8 * i) * 16) = RK[i]; *(LAS u32x4*)(img + 8192 + 4096 * (PB) + tr_off(skey + 8 * i, schk)) = RV[i]; } }
#define ATT_QK(Z, PB) { Z = (f32x16){}; _Pragma("unroll") for (int ks = 0; ks < 4; ++ks) Z = MFMA32(row_frag<32>(img + 4096 * (PB), 0, ks, lane), qr[ks], Z); }
#define ATT_TILE(Z, PB, KT) { bf16x8 pa0, pa1; sb_weights(Z, R, (32 * (KT) + 31 >= qlo) || (KT) < 0, (KT) < 0 ? 0 : qlo + r32 - 32 * (KT), hi, pa0, pa1); LAS unsigned char* vimg = img + 8192 + 4096 * (PB); \
              o0 = MFMA32(pa0, tr_frag(vimg, 0, 0, lane), o0); o1 = MFMA32(pa0, tr_frag(vimg, 1, 0, lane), o1); o0 = MFMA32(pa1, tr_frag(vimg, 0, 1, lane), o0); o1 = MFMA32(pa1, tr_frag(vimg, 1, 1, lane), o1); }
            int kt = kt0;
            ATT_LOAD(ka, va, kt0)
            ATT_LOAD(kb, vb, max(kt0 - 1, 0))
            ATT_STAGE(ka, va, 0)
            ATT_LOAD(ka, va, max(kt0 - 2, 0))
            f32x16 z, zn;
            ATT_QK(z, 0)
#pragma unroll 1
            do {
                { ATT_STAGE(kb, vb, 1) ATT_LOAD(kb, vb, max(kt - 3, 0)) ATT_QK(zn, 1) }
                ATT_TILE(z, 0, kt)
                { ATT_STAGE(ka, va, 0) ATT_LOAD(ka, va, max(kt - 4, 0)) ATT_QK(z, 0) }
                ATT_TILE(zn, 1, kt - 1)
                kt -= 2;
            } while (kt >= 0 && !__all(R == 0.f));
#undef ATT_LOAD
#undef ATT_STAGE
#undef ATT_QK
#undef ATT_TILE
#pragma unroll
            for (int r = 0; r < 16; ++r) { bf16* op = O + (tq0 + crow(r, hi)) * 1024 + h * 64 + r32;
                op[0] = (bf16)(cvtpk(o0[r], 0.f) & 0xffffu); op[32] = (bf16)(cvtpk(o1[r], 0.f) & 0xffffu); }
        }
    }
}

DI int tr_off32(int tok, int ch) { return (ch >> 2) * 2048 + (tok >> 4) * 1024 + (tok & 15) * 64 + (ch & 3) * 16; }
DI bf16x8 tr_frag32(const LAS unsigned char* img, int dh, int ks, int lane) {
    const int hi = lane >> 5; const int vb = ((lane >> 4) & 1) * 32 + (lane & 3) * 8 + (4 * hi + ((lane & 15) >> 2)) * 64;
    const s16x4 lo = tr16(img + vb + dh * 2048 + ks * 1024), h2 = tr16(img + vb + dh * 2048 + ks * 1024 + 512);
    return __builtin_shufflevector(lo, h2, 0, 1, 2, 3, 4, 5, 6, 7);
}
template <int VAR = 0> DI void p12_attn_v3(Frame& F, bf16* O) {
    LAS unsigned char* ring = F.lds;
    const bf16* Q = (const bf16*)(F.ws + WS_Q);
    const int wave = F.wave;
    for (int bh = F.bid; bh < 256; bh += F.G) {
        const int b = bh >> 4, h = bh & 15;
        const char* Kb = (const char*)(F.ws + WS_K) + ((size_t)b * SEQ * 1024 + h * 64) * 2; const char* Vb = (const char*)(F.ws + WS_VV) + ((size_t)b * SEQ * 1024 + h * 64) * 2;
        int lane = F.lane; asm volatile("" : "+v"(lane)); const int r32 = lane & 31, hi = lane >> 5;
        const int skey = lane >> 3, schk = lane & 7;
        const unsigned lo0 = (unsigned)(skey * 1024 + 8 * schk) * 2u;
        u32x4 kraw[4], vraw[4];
        bf16x8 qr[4], qn[4];
#define ATT_LOAD(KT) { const char* kp_ = Kb + (size_t)(KT) * 65536; const char* vp_ = Vb + (size_t)(KT) * 65536; \
          _Pragma("unroll") for (int i = 0; i < 4; ++i) { kraw[i] = *(const u32x4*)(kp_ + (size_t)(lo0 + 16384u * i)); vraw[i] = *(const u32x4*)(vp_ + (size_t)(lo0 + 16384u * i)); } }
#define ATT_STAGE(KT) { LAS unsigned char* sl_ = ring + ((KT) & 15) * 8192; \
          _Pragma("unroll") for (int i = 0; i < 4; ++i) { *(LAS u32x4*)(sl_ + schk * 512 + (skey + 8 * i) * 16) = kraw[i]; *(LAS u32x4*)(sl_ + 4096 + tr_off32(skey + 8 * i, schk)) = vraw[i]; } }
#define ATT_LOADQ(QR, QT) { _Pragma("unroll") for (int ks = 0; ks < 4; ++ks) QR[ks] = *(const bf16x8*)(Q + ((size_t)b * SEQ + 32 * (QT) + r32) * 1024 + h * 64 + 16 * ks + 8 * hi); }
        __syncthreads();
        ATT_LOAD(63 - wave) ATT_STAGE(63 - wave)
        ATT_LOAD(55 - wave) ATT_STAGE(55 - wave)
        ATT_LOADQ(qr, 63 - wave)
        __syncthreads();
#pragma unroll 1
        for (int qi = 0; qi < 8; ++qi) {
            const int qt_hi = 63 - 8 * qi, qt = qt_hi - wave, qlo = 32 * qt;
            const int lowwin = (VAR == 8) ? max(qt - 2, max(qt_hi - 15, 0)) : max(qt_hi - 15, 0);
            const int tnew = qt_hi - 16 - wave;
            ATT_LOAD(max(tnew, 0))
            ATT_LOADQ(qn, max(qt - 8, 0))
            f32x16 o0 = {}, o1 = {}; float R = 1.f;
            bool dead = false;
            int kt = qt;
#pragma unroll 1
            for (; kt >= lowwin; --kt) {
                const LAS unsigned char* kimg = ring + (kt & 15) * 8192;
                f32x16 z = {};
#pragma unroll
                for (int ks = 0; ks < 4; ++ks) z = MFMA32(row_frag<32>(kimg, 0, ks, lane), qr[ks], z);
                bf16x8 pa0, pa1; sb_weights(z, R, 32 * kt + 31 >= qlo, qlo + r32 - 32 * kt, hi, pa0, pa1);
                o0 = MFMA32(pa0, tr_frag32(kimg + 4096, 0, 0, lane), o0); o1 = MFMA32(pa0, tr_frag32(kimg + 4096, 1, 0, lane), o1);
                o0 = MFMA32(pa1, tr_frag32(kimg + 4096, 0, 1, lane), o0); o1 = MFMA32(pa1, tr_frag32(kimg + 4096, 1, 1, lane), o1);
                if (__all(R == 0.f)) { dead = true; break; }
            }
            if (!dead) {
#pragma unroll 1
                for (kt = lowwin - 1; kt >= 0; --kt) {
                    const char* kp = Kb + (size_t)kt * 65536; const unsigned short* vp = (const unsigned short*)(Vb + (size_t)kt * 65536);
                    f32x16 z = {};
#pragma unroll
                    for (int ks = 0; ks < 4; ++ks) z = MFMA32(*(const bf16x8*)(kp + ((size_t)r32 * 1024 + 16 * ks + 8 * hi) * 2), qr[ks], z);
                    bf16x8 pa0, pa1; sb_weights(z, R, 32 * kt + 31 >= qlo, qlo + r32 - 32 * kt, hi, pa0, pa1);
#pragma unroll
                    for (int ks = 0; ks < 2; ++ks)
#pragma unroll
                        for (int dh = 0; dh < 2; ++dh) {
                            unsigned e[8];
#pragma unroll
                            for (int j = 0; j < 8; ++j) e[j] = vp[(size_t)(16 * ks + 8 * (j >> 2) + 4 * hi + (j & 3)) * 1024 + 32 * dh + r32];
                            u32x4 w; w.x = e[0] | (e[1] << 16); w.y = e[2] | (e[3] << 16); w.z = e[4] | (e[5] << 16); w.w = e[6] | (e[7] << 16);
                            const bf16x8 vf = __builtin_bit_cast(bf16x8, w);
                            if (dh == 0) o0 = MFMA32(ks == 0 ? pa0 : pa1, vf, o0); else o1 = MFMA32(ks == 0 ? pa0 : pa1, vf, o1);
                            asm volatile("" ::: "memory"); __builtin_amdgcn_sched_barrier(0);
                        }
                    if (__all(R == 0.f)) break;
                }
            }
            asm volatile("s_waitcnt lgkmcnt(0)\n\ts_barrier" ::: "memory");
            if (tnew >= 0) ATT_STAGE(tnew)
#pragma unroll
            for (int r = 0; r < 16; ++r) { bf16* op = O + ((size_t)b * SEQ + qlo + crow(r, hi)) * 1024 + h * 64 + r32;
                op[0] = (bf16)(cvtpk(o0[r], 0.f) & 0xffffu); op[32] = (bf16)(cvtpk(o1[r], 0.f) & 0xffffu); }
#pragma unroll
            for (int ks = 0; ks < 4; ++ks) qr[ks] = qn[ks];
            asm volatile("s_waitcnt lgkmcnt(0)\n\ts_barrier" ::: "memory");
        }
#undef ATT_LOAD
#undef ATT_STAGE
#undef ATT_LOADQ
    }
}

__device__ constexpr int NET16_A[63] = {0,2,0,1,1,4,6,4,5,5,0,2,2,1,3,3,1,3,5,8,10,8,9,9,12,14,12,13,13,8,10,10,9,11,11,9,11,13,0,4,4,2,6,6,2,6,10,1,5,5,3,7,7,3,7,11,1,3,5,7,9,11,13};
__device__ constexpr int NET16_B[63] = {1,3,2,3,2,5,7,6,7,6,4,6,4,5,7,5,2,4,6,9,11,10,11,10,13,15,14,15,14,12,14,12,13,15,13,10,12,14,8,12,8,10,14,10,4,8,12,9,13,9,11,15,11,5,9,13,2,4,6,8,10,12,14};
__device__ constexpr int BIT16_A[32] = {0,1,2,3,4,5,6,7,0,1,2,3,8,9,10,11,0,1,4,5,8,9,12,13,0,2,4,6,8,10,12,14};
__device__ constexpr int BIT16_B[32] = {8,9,10,11,12,13,14,15,4,5,6,7,12,13,14,15,2,3,6,7,10,11,14,15,1,3,5,7,9,11,13,15};
DI unsigned umax_(unsigned a, unsigned b) { return a > b ? a : b; }
DI unsigned umin_(unsigned a, unsigned b) { return a < b ? a : b; }
DI void sort16(unsigned (&k)[16]) {
#pragma unroll
    for (int c = 0; c < 63; ++c) { const unsigned a = k[NET16_A[c]], b = k[NET16_B[c]]; k[NET16_A[c]] = umax_(a, b); k[NET16_B[c]] = umin_(a, b); }
}
DI void bitonic16(unsigned (&k)[16]) {
#pragma unroll
    for (int c = 0; c < 32; ++c) { const unsigned a = k[BIT16_A[c]], b = k[BIT16_B[c]]; k[BIT16_A[c]] = umax_(a, b); k[BIT16_B[c]] = umin_(a, b); }
}
DI void merge16(unsigned (&x)[16], const unsigned (&y)[16]) {
#pragma unroll
    for (int i = 0; i < 16; ++i) x[i] = umax_(x[i], y[15 - i]);
    bitonic16(x);
}
DI unsigned f2key(float x) { const unsigned b = __float_as_uint(x); return b ^ ((unsigned)((int)b >> 31) | 0x80000000u); }
DI float key2f(unsigned k) { return __uint_as_float(k ^ (~(unsigned)((int)k >> 31) | 0x80000000u)); }

DI void p_route(Frame& F, int layer) {
    LAS unsigned char* simg = F.lds;
    LAS unsigned char* dec = F.lds + 65536 + F.wave * 1024;
    { const u32x4* src = (const u32x4*)((const bf16*)(F.ws + WS_SUBK) + (size_t)layer * 2 * 128 * 128);
      for (int i = F.tid; i < 2 * 128 * 16; i += NT) { const int p = i >> 11, n = (i >> 4) & 127, ch = i & 15; *(LAS u32x4*)(simg + p * 32768 + ch * 2048 + n * 16) = src[i]; } }
    __syncthreads();
    const bf16* PQ = (const bf16*)(F.ws + WS_PQ);
    const int lane = F.lane, r32 = lane & 31, hi = lane >> 5;
    const int gw = F.bid * NWAVES + F.wave, NGW = F.G * NWAVES;
    for (int wu = gw; wu < T_TOK * 8 / 32; wu += NGW) {
        const int row = wu * 32 + r32, t = row >> 3, hd = row & 7;
        unsigned top[2][16];
#pragma unroll
        for (int p = 0; p < 2; ++p) {
            bf16x8 qf[8];
#pragma unroll
            for (int ks = 0; ks < 8; ++ks) qf[ks] = *(const bf16x8*)(PQ + (size_t)t * 2048 + hd * 256 + p * 128 + 16 * ks + 8 * hi);
            unsigned keys[4][16];
#pragma unroll
            for (int nt = 0; nt < 4; ++nt) {
                f32x16 acc = {};
#pragma unroll
                for (int ks = 0; ks < 8; ++ks) acc = MFMA32(*(const LAS bf16x8*)(simg + p * 32768 + (2 * ks + hi) * 2048 + (32 * nt + r32) * 16), qf[ks], acc);
#pragma unroll
                for (int r = 0; r < 16; ++r) keys[nt][r] = (f2key(acc[r]) & 0xFFFFFF80u) | (unsigned)(32 * nt + crow(r, 0)) | (unsigned)(4 * hi);
                sort16(keys[nt]);
            }
            merge16(keys[0], keys[1]); merge16(keys[2], keys[3]); merge16(keys[0], keys[2]);
            unsigned lo[16], up[16];
#pragma unroll
            for (int i = 0; i < 16; ++i) { auto rr = __builtin_amdgcn_permlane32_swap(keys[0][i], keys[0][i], false, false); lo[i] = rr[0]; up[i] = rr[1]; }
#pragma unroll
            for (int i = 0; i < 16; ++i) top[p][i] = umax_(lo[i], up[15 - i]);
            bitonic16(top[p]);
        }
        if (hi == 0) {
            u32x4 w0, w1, w2, w3;
            w0.x = (top[0][0] & 127u) | ((top[0][1] & 127u) << 8) | ((top[0][2] & 127u) << 16) | ((top[0][3] & 127u) << 24);
            w0.y = (top[0][4] & 127u) | ((top[0][5] & 127u) << 8) | ((top[0][6] & 127u) << 16) | ((top[0][7] & 127u) << 24);
            w0.z = (top[0][8] & 127u) | ((top[0][9] & 127u) << 8) | ((top[0][10] & 127u) << 16) | ((top[0][11] & 127u) << 24);
            w0.w = (top[0][12] & 127u) | ((top[0][13] & 127u) << 8) | ((top[0][14] & 127u) << 16) | ((top[0][15] & 127u) << 24);
            w1.x = (top[1][0] & 127u) | ((top[1][1] & 127u) << 8) | ((top[1][2] & 127u) << 16) | ((top[1][3] & 127u) << 24);
            w1.y = (top[1][4] & 127u) | ((top[1][5] & 127u) << 8) | ((top[1][6] & 127u) << 16) | ((top[1][7] & 127u) << 24);
            w1.z = (top[1][8] & 127u) | ((top[1][9] & 127u) << 8) | ((top[1][10] & 127u) << 16) | ((top[1][11] & 127u) << 24);
            w1.w = (top[1][12] & 127u) | ((top[1][13] & 127u) << 8) | ((top[1][14] & 127u) << 16) | ((top[1][15] & 127u) << 24);
            *(LAS u32x4*)(dec + r32 * 32) = w0; *(LAS u32x4*)(dec + r32 * 32 + 16) = w1;
        }
        float av[16], bv[16];
#pragma unroll
        for (int i = 0; i < 16; ++i) { av[i] = key2f(top[0][i] & 0xFFFFFF80u); bv[i] = key2f(top[1][i] & 0xFFFFFF80u); }
        unsigned c0[16], c1[16], c2[16], c3[16];
#pragma unroll
        for (int j = 0; j < 16; ++j) c0[j] = (f2key(av[0] + bv[j]) & 0xFFFFFF00u) | (unsigned)j;
        {
            int n = 0;
#pragma unroll
            for (int i = 1; i < 16; ++i)
#pragma unroll
                for (int j = 0; j < 16; ++j) if ((i + 1) * (j + 1) <= 16) {
                    const unsigned k = (f2key(av[i] + bv[j]) & 0xFFFFFF00u) | (unsigned)(i * 16 + j);
                    if (n < 16) c1[n] = k; else if (n < 32) c2[n - 16] = k; else c3[n - 32] = k;
                    ++n; }
#pragma unroll
            for (int q = 2; q < 16; ++q) c3[q] = 0u;
        }
        sort16(c1); sort16(c2); { const unsigned a = c3[0], b = c3[1]; c3[0] = umax_(a, b); c3[1] = umin_(a, b); }
        merge16(c0, c1); merge16(c2, c3); merge16(c0, c2);
        asm volatile("s_waitcnt lgkmcnt(0)" ::: "memory");
        float gv[16]; unsigned ex[16]; float gs = 0.f;
        const float vmax = key2f(c0[0] & 0xFFFFFF00u);
#pragma unroll
        for (int k = 0; k < 16; ++k) {
            const unsigned code = c0[k] & 255u; const unsigned i = code >> 4, j = code & 15u;
            const unsigned ia = *(const LAS unsigned char*)(dec + r32 * 32 + i), ib = *(const LAS unsigned char*)(dec + r32 * 32 + 16 + j);
            ex[k] = ia * 128u + ib;
            gv[k] = __expf(key2f(c0[k] & 0xFFFFFF00u) - vmax); gs += gv[k];
        }
        const float ginv = 1.0f / gs;
        if (hi == 0) {
            u32x4 e0, e1;
            e0.x = ex[0] | (ex[1] << 16); e0.y = ex[2] | (ex[3] << 16); e0.z = ex[4] | (ex[5] << 16); e0.w = ex[6] | (ex[7] << 16);
            e1.x = ex[8] | (ex[9] << 16); e1.y = ex[10] | (ex[11] << 16); e1.z = ex[12] | (ex[13] << 16); e1.w = ex[14] | (ex[15] << 16);
            u32x4* ip = (u32x4*)((unsigned short*)(F.ws + WS_IDX) + (size_t)row * 16); ip[0] = e0; ip[1] = e1;
        } else {
            f32x4* gp = (f32x4*)((float*)(F.ws + WS_GATE) + (size_t)row * 16);
            gp[0] = (f32x4){gv[0] * ginv, gv[1] * ginv, gv[2] * ginv, gv[3] * ginv}; gp[1] = (f32x4){gv[4] * ginv, gv[5] * ginv, gv[6] * ginv, gv[7] * ginv};
            gp[2] = (f32x4){gv[8] * ginv, gv[9] * ginv, gv[10] * ginv, gv[11] * ginv}; gp[3] = (f32x4){gv[12] * ginv, gv[13] * ginv, gv[14] * ginv, gv[15] * ginv};
        }
    }
}

constexpr float U_SCALE = 32.f, V_SCALE = 4.f;
struct RowBuf { u32x4 r[16]; };
DI void load_rows(RowBuf& rb, const unsigned char* tbl, int idxs, int k0, int lane) {
#pragma unroll
    for (int j = 0; j < 16; ++j) { const int e = __builtin_amdgcn_readlane(idxs, k0 + j); rb.r[j] = *((const u32x4*)(tbl + (size_t)e * 1024) + lane); }
}
DI int udots(const RowBuf& rb, const int (&hq)[4], int lane) {
    int p[16];
#pragma unroll
    for (int j = 0; j < 16; ++j) { int a = __builtin_amdgcn_sdot4((int)rb.r[j].x, hq[0], 0, false); a = __builtin_amdgcn_sdot4((int)rb.r[j].y, hq[1], a, false);
        a = __builtin_amdgcn_sdot4((int)rb.r[j].z, hq[2], a, false); p[j] = __builtin_amdgcn_sdot4((int)rb.r[j].w, hq[3], a, false); }
#pragma unroll
    for (int i = 0; i < 8; ++i) { const bool up = (lane & 8) != 0; const int send = up ? p[i] : p[i + 8], keep = up ? p[i + 8] : p[i]; p[i] = keep + lx<8>(send); }
#pragma unroll
    for (int i = 0; i < 4; ++i) { const bool up = (lane & 4) != 0; const int send = up ? p[i] : p[i + 4], keep = up ? p[i + 4] : p[i]; p[i] = keep + lx<7>(send); }
#pragma unroll
    for (int i = 0; i < 2; ++i) { const bool up = (lane & 2) != 0; const int send = up ? p[i] : p[i + 2], keep = up ? p[i + 2] : p[i]; p[i] = keep + lx<2>(send); }
    { const bool up = (lane & 1) != 0; const int send = up ? p[0] : p[1], keep = up ? p[1] : p[0]; p[0] = keep + lx<1>(send); }
    int s = p[0]; s += lx<16>(s); s += lx<32>(s);
    return s;
}
DI void vaccum(const RowBuf& rb, f32x2_t (&out)[8], float wv, int k0) {
#pragma unroll
    for (int j = 0; j < 16; ++j) { const float wk = __builtin_bit_cast(float, __builtin_amdgcn_readlane(__builtin_bit_cast(int, wv), k0 + j));
        out[0] = __builtin_amdgcn_cvt_pk_f32_fp8((int)rb.r[j].x, false) * wk + out[0]; out[1] = __builtin_amdgcn_cvt_pk_f32_fp8((int)rb.r[j].x, true) * wk + out[1];
        out[2] = __builtin_amdgcn_cvt_pk_f32_fp8((int)rb.r[j].y, false) * wk + out[2]; out[3] = __builtin_amdgcn_cvt_pk_f32_fp8((int)rb.r[j].y, true) * wk + out[3];
        out[4] = __builtin_amdgcn_cvt_pk_f32_fp8((int)rb.r[j].z, false) * wk + out[4]; out[5] = __builtin_amdgcn_cvt_pk_f32_fp8((int)rb.r[j].z, true) * wk + out[5];
        out[6] = __builtin_amdgcn_cvt_pk_f32_fp8((int)rb.r[j].w, false) * wk + out[6]; out[7] = __builtin_amdgcn_cvt_pk_f32_fp8((int)rb.r[j].w, true) * wk + out[7]; }
}
constexpr size_t WS_W = WS_PROJ;
constexpr size_t WS_PD = WS_PROJ + 32 * MiB;
constexpr int UP_LDS = 16384;
struct UTok { u32x4 r[16]; int hq[4]; };
DI void up_load(UTok& tb, const unsigned char* Us, const unsigned char* H2Qs, const LAS unsigned short* lidx, size_t t, int tt, int lane) {
    const int g = lane >> 3, c = lane & 7;
    const LAS u32x4* ip = (const LAS u32x4*)(lidx + tt * 128 + 16 * g); const u32x4 ia = ip[0], ib = ip[1];
    const unsigned e[16] = {ia.x & 0xffffu, ia.x >> 16, ia.y & 0xffffu, ia.y >> 16, ia.z & 0xffffu, ia.z >> 16, ia.w & 0xffffu, ia.w >> 16,
                            ib.x & 0xffffu, ib.x >> 16, ib.y & 0xffffu, ib.y >> 16, ib.z & 0xffffu, ib.z >> 16, ib.w & 0xffffu, ib.w >> 16};
#pragma unroll
    for (int i = 0; i < 16; ++i) tb.r[i] = *(const u32x4*)(Us + (size_t)e[i] * 128 + c * 16);
    const u32x4 a = *(const u32x4*)(H2Qs + t * 1024 + c * 16); tb.hq[0] = (int)a.x; tb.hq[1] = (int)a.y; tb.hq[2] = (int)a.z; tb.hq[3] = (int)a.w;
}
DI void up_compute(const UTok& tb, int* pd, size_t t, int lane) {
    int p[16];
#pragma unroll
    for (int i = 0; i < 16; ++i) { int a = __builtin_amdgcn_sdot4((int)tb.r[i].x, tb.hq[0], 0, false); a = __builtin_amdgcn_sdot4((int)tb.r[i].y, tb.hq[1], a, false);
        a = __builtin_amdgcn_sdot4((int)tb.r[i].z, tb.hq[2], a, false); p[i] = __builtin_amdgcn_sdot4((int)tb.r[i].w, tb.hq[3], a, false); }
#pragma unroll
    for (int i = 0; i < 8; ++i) { const bool up = (lane & 4) != 0; const int send = up ? p[i] : p[i + 8], keep = up ? p[i + 8] : p[i]; p[i] = keep + lx<7>(send); }
#pragma unroll
    for (int i = 0; i < 4; ++i) { const bool up = (lane & 2) != 0; const int send = up ? p[i] : p[i + 4], keep = up ? p[i + 4] : p[i]; p[i] = keep + lx<2>(send); }
#pragma unroll
    for (int i = 0; i < 2; ++i) { const bool up = (lane & 1) != 0; const int send = up ? p[i] : p[i + 2], keep = up ? p[i + 2] : p[i]; p[i] = keep + lx<1>(send); }
    const int k = 16 * (lane >> 3) + 8 * ((lane >> 2) & 1) + 4 * ((lane >> 1) & 1) + 2 * (lane & 1);
    *(int2*)(pd + t * 128 + k) = make_int2(p[0], p[1]);
}
constexpr size_t WS_CLAIM = 4096;
DI unsigned xcc_id() { return (unsigned)__builtin_amdgcn_s_getreg((3 << 11) | 20) & 7u; }
DI int claim_unit(Frame& F, int set) {
    LAS int* bc = (LAS int*)(F.lds + LDS_BYTES - 64);
    __syncthreads();
    if (F.tid == 0) {
        unsigned* cnt = (unsigned*)(F.ws + WS_CLAIM) + set * 256;
        const unsigned x0 = xcc_id(); int unit = -1;
        for (unsigned a = 0; a < 8; ++a) { const unsigned sl = (x0 + a) & 7u; const unsigned tk = __hip_atomic_fetch_add(cnt + sl * 32, 1u, __ATOMIC_RELAXED, __HIP_MEMORY_SCOPE_AGENT); if (tk < 32u) { unit = (int)(sl * 32 + tk); break; } }
        bc[0] = unit;
    }
    __syncthreads();
    return bc[0];
}
DI void p_upass(Frame& F, int layer, int cset) {
    const unsigned short* IDX = (const unsigned short*)(F.ws + WS_IDX);
    LAS unsigned char* wl = F.lds + F.wave * UP_LDS;
    LAS unsigned short* lidx = (LAS unsigned short*)wl;
    const int lane = F.lane;
    for (int unit = claim_unit(F, cset); unit >= 0; unit = claim_unit(F, cset)) {
    const int x = unit >> 5, jb = unit & 31;
    const unsigned char* Us = F.ws + WS_U + ((size_t)layer * 8 + x) * 16384 * 128;
    const unsigned char* H2Qs = F.ws + WS_H2Q + 128 * x;
    int* pd = (int*)(F.ws + WS_PD) + (size_t)x * T_TOK * 128;
    for (int t0 = jb * 1024 + F.wave * 128; t0 < jb * 1024 + F.wave * 128 + 128; t0 += 16) {
        { const u32x4* si = (const u32x4*)(IDX + (size_t)t0 * 128) + lane;
#pragma unroll
          for (int q = 0; q < 4; ++q) ((LAS u32x4*)lidx)[lane + 64 * q] = si[64 * q]; }
        UTok A, B;
        up_load(A, Us, H2Qs, lidx, (size_t)t0, 0, lane);
#pragma unroll 1
        for (int tt = 0; tt < 16; tt += 2) {
            up_load(B, Us, H2Qs, lidx, (size_t)t0 + tt + 1, tt + 1, lane);
            up_compute(A, pd, (size_t)t0 + tt, lane);
            if (tt + 2 < 16) up_load(A, Us, H2Qs, lidx, (size_t)t0 + tt + 2, tt + 2, lane);
            up_compute(B, pd, (size_t)t0 + tt + 1, lane);
        }
    }
    }
}
DI void p_combine(Frame& F, int layer) {
    const unsigned short* IDX = (const unsigned short*)(F.ws + WS_IDX); const float* GATE = (const float*)(F.ws + WS_GATE);
    const float* SH = (const float*)(F.ws + WS_SH); const float* SU = (const float*)(F.ws + WS_SU) + (size_t)layer * 16384; const float* SV = (const float*)(F.ws + WS_SV) + (size_t)layer * 16384;
    const int* pd = (const int*)(F.ws + WS_PD); unsigned char* W8 = F.ws + WS_W; float* SW8 = (float*)(F.ws + WS_SW8);
    const int gw = F.bid * NWAVES + F.wave, NGW = F.G * NWAVES;
    for (int t0 = gw * 4; t0 < T_TOK; t0 += NGW * 4) {
        int s0[4], s1[4], e0[4], e1[4]; float g0[4], g1[4], sh[4];
#pragma unroll
        for (int q = 0; q < 4; ++q) { const size_t t = (size_t)t0 + q; s0[q] = 0; s1[q] = 0;
#pragma unroll
            for (int x = 0; x < 8; ++x) { const int* p = pd + ((size_t)x * T_TOK + t) * 128 + F.lane; s0[q] += p[0]; s1[q] += p[64]; }
            e0[q] = IDX[t * 128 + F.lane]; e1[q] = IDX[t * 128 + 64 + F.lane]; g0[q] = GATE[t * 128 + F.lane]; g1[q] = GATE[t * 128 + 64 + F.lane]; sh[q] = SH[t]; }
        float u0[4], u1[4], v0[4], v1[4];
#pragma unroll
        for (int q = 0; q < 4; ++q) { u0[q] = SU[e0[q]]; u1[q] = SU[e1[q]]; v0[q] = SV[e0[q]]; v1[q] = SV[e1[q]]; }
#pragma unroll
        for (int q = 0; q < 4; ++q) { const size_t t = (size_t)t0 + q;
            const float d0 = (float)s0[q] * u0[q] * sh[q], d1 = (float)s1[q] * u1[q] * sh[q];
            const float w0 = g0[q] * 0.5f * d0 * (1.0f + erff(d0 * 0.70710678118654752f)) * v0[q], w1 = g1[q] * 0.5f * d1 * (1.0f + erff(d1 * 0.70710678118654752f)) * v1[q];
            const float m = fmaxf(wave_max(fmaxf(fabsf(w0), fabsf(w1))), 1e-30f), inv = 127.0f / m;
            W8[t * 128 + F.lane] = (unsigned char)((int)rintf(w0 * inv) & 255); W8[t * 128 + 64 + F.lane] = (unsigned char)((int)rintf(w1 * inv) & 255);
            if (F.lane == 0) SW8[t] = m * (1.0f / 127.0f); }
    }
}
struct TokBuf { u32x4 r[16]; u32x4 w; };
DI void vp_load(TokBuf& tb, const unsigned char* Vs, const LAS unsigned short* lidx, const LAS unsigned char* lw, int tt, int lane) {
    const int g = lane >> 3, c = lane & 7;
    const LAS u32x4* ip = (const LAS u32x4*)(lidx + tt * 128 + 16 * g); const u32x4 ia = ip[0], ib = ip[1];
    tb.w = *(const LAS u32x4*)(lw + tt * 128 + 16 * g);
    const unsigned e[16] = {ia.x & 0xffffu, ia.x >> 16, ia.y & 0xffffu, ia.y >> 16, ia.z & 0xffffu, ia.z >> 16, ia.w & 0xffffu, ia.w >> 16,
                            ib.x & 0xffffu, ib.x >> 16, ib.y & 0xffffu, ib.y >> 16, ib.z & 0xffffu, ib.z >> 16, ib.w & 0xffffu, ib.w >> 16};
#pragma unroll
    for (int i = 0; i < 16; ++i) tb.r[i] = *(const u32x4*)(Vs + (size_t)e[i] * 128 + c * 16);
}
DI void tdot4(int (&acc)[16], int d, unsigned r0, unsigned r1, unsigned r2, unsigned r3, unsigned wq) {
    const unsigned t0 = __builtin_amdgcn_perm(r1, r0, 0x05010400u), t1 = __builtin_amdgcn_perm(r1, r0, 0x07030602u);
    const unsigned t2 = __builtin_amdgcn_perm(r3, r2, 0x05010400u), t3 = __builtin_amdgcn_perm(r3, r2, 0x07030602u);
    const unsigned c0 = __builtin_amdgcn_perm(t2, t0, 0x05040100u), c1 = __builtin_amdgcn_perm(t2, t0, 0x07060302u);
    const unsigned c2 = __builtin_amdgcn_perm(t3, t1, 0x05040100u), c3 = __builtin_amdgcn_perm(t3, t1, 0x07060302u);
    acc[4 * d] = __builtin_amdgcn_sdot4((int)c0, (int)wq, acc[4 * d], false); acc[4 * d + 1] = __builtin_amdgcn_sdot4((int)c1, (int)wq, acc[4 * d + 1], false);
    acc[4 * d + 2] = __builtin_amdgcn_sdot4((int)c2, (int)wq, acc[4 * d + 2], false); acc[4 * d + 3] = __builtin_amdgcn_sdot4((int)c3, (int)wq, acc[4 * d + 3], false);
}
DI void vp_compute(const TokBuf& tb, Frame& F, const float* g2s, const float* SW8, float* xout, size_t t, int x, int lane) {
    int p[16];
#pragma unroll
    for (int i = 0; i < 16; ++i) p[i] = 0;
#pragma unroll
    for (int j = 0; j < 4; ++j) { const unsigned wq = j == 0 ? tb.w.x : j == 1 ? tb.w.y : j == 2 ? tb.w.z : tb.w.w;
        tdot4(p, 0, tb.r[4 * j].x, tb.r[4 * j + 1].x, tb.r[4 * j + 2].x, tb.r[4 * j + 3].x, wq); tdot4(p, 1, tb.r[4 * j].y, tb.r[4 * j + 1].y, tb.r[4 * j + 2].y, tb.r[4 * j + 3].y, wq);
        tdot4(p, 2, tb.r[4 * j].z, tb.r[4 * j + 1].z, tb.r[4 * j + 2].z, tb.r[4 * j + 3].z, wq); tdot4(p, 3, tb.r[4 * j].w, tb.r[4 * j + 1].w, tb.r[4 * j + 2].w, tb.r[4 * j + 3].w, wq); }
#pragma unroll
    for (int i = 0; i < 8; ++i) { const bool up = (lane & 32) != 0; const int send = up ? p[i] : p[i + 8], keep = up ? p[i + 8] : p[i]; p[i] = keep + lx<32>(send); }
#pragma unroll
    for (int i = 0; i < 4; ++i) { const bool up = (lane & 16) != 0; const int send = up ? p[i] : p[i + 4], keep = up ? p[i + 4] : p[i]; p[i] = keep + lx<16>(send); }
#pragma unroll
    for (int i = 0; i < 2; ++i) { const bool up = (lane & 8) != 0; const int send = up ? p[i] : p[i + 2], keep = up ? p[i + 2] : p[i]; p[i] = keep + lx<8>(send); }
    const int col = 128 * x + 16 * (lane & 7) + 8 * ((lane >> 5) & 1) + 4 * ((lane >> 4) & 1) + 2 * ((lane >> 3) & 1);
    const float sw = SW8[t];
    const f32x2_t gg = *(const f32x2_t*)(g2s + col);
    const f32x2_t xv = *(const f32x2_t*)(F.out + t * 1024 + col);
    *(f32x2_t*)(xout + t * 1024 + col) = xv + gg * (f32x2_t){(float)p[0] * sw, (float)p[1] * sw};
}
DI void p_vpass(Frame& F, int layer, float* xout, int cset) {
    const unsigned short* IDX = (const unsigned short*)(F.ws + WS_IDX); const unsigned char* W8 = F.ws + WS_W; const float* SW8 = (const float*)(F.ws + WS_SW8);
    const float* mods = (const float*)(F.ws + WS_MODS);
    LAS unsigned char* wl = F.lds + F.wave * UP_LDS;
    LAS unsigned short* lidx = (LAS unsigned short*)wl; LAS unsigned char* lw = (LAS unsigned char*)(wl + 4096);
    const int lane = F.lane;
    for (int unit = claim_unit(F, cset); unit >= 0; unit = claim_unit(F, cset)) {
    const int x = unit >> 5, jb = unit & 31;
    const unsigned char* Vs = F.ws + WS_V + ((size_t)layer * 8 + x) * 16384 * 128;
    for (int t0 = jb * 1024 + F.wave * 128; t0 < jb * 1024 + F.wave * 128 + 128; t0 += 16) {
        const int b = t0 >> 11;
        const float* g2s = mods + ((size_t)layer * 16 + b) * 6144 + 5 * 1024;
        { const u32x4* si = (const u32x4*)(IDX + (size_t)t0 * 128) + lane;
#pragma unroll
          for (int q = 0; q < 4; ++q) ((LAS u32x4*)lidx)[lane + 64 * q] = si[64 * q];
          const u32x4* sg = (const u32x4*)(W8 + (size_t)t0 * 128) + lane;
#pragma unroll
          for (int q = 0; q < 2; ++q) ((LAS u32x4*)lw)[lane + 64 * q] = sg[64 * q]; }
        TokBuf A, B;
        vp_load(A, Vs, lidx, lw, 0, lane);
#pragma unroll 1
        for (int tt = 0; tt < 16; tt += 2) {
            vp_load(B, Vs, lidx, lw, tt + 1, lane);
            vp_compute(A, F, g2s, SW8, xout, (size_t)t0 + tt, x, lane);
            if (tt + 2 < 16) vp_load(A, Vs, lidx, lw, tt + 2, lane);
            vp_compute(B, F, g2s, SW8, xout, (size_t)t0 + tt + 1, x, lane);
        }
    }
    }
}
#ifndef GEMM_ALIGN
#define GEMM_ALIGN true
#endif
#ifndef GEMM_SP2
#define GEMM_SP2 true
#endif
#ifndef DUP
#define DUP -1
#endif
#ifndef PH_MASK
#define PH_MASK 0x3FFFF
#endif

constexpr size_t WS_BAR = 65536;
#define XB_TMO      128
#define XB_XCNT(j)  (256  + 64 * (j))
#define XB_XSUB(j)  (1280 + 64 * (j))
#define XB_XGEN(j)  (2304 + 64 * (j))
#define XB_TOP      3328
#define XB_TOPGEN   3392
#define XCD_BAR_WORDS 3456
#define XB_SPIN_CAP (1u << 18)

__device__ __forceinline__ unsigned xb_ld(unsigned* p)              { return __hip_atomic_load(p, __ATOMIC_RELAXED, __HIP_MEMORY_SCOPE_AGENT); }
__device__ __forceinline__ unsigned xb_add(unsigned* p, unsigned v) { return __hip_atomic_fetch_add(p, v, __ATOMIC_RELAXED, __HIP_MEMORY_SCOPE_AGENT); }
__device__ __forceinline__ unsigned xb_xcc_id() { return (unsigned)__builtin_amdgcn_s_getreg((3 << 11) | 20) & 0xFu; }
#define XB_SPIN(cond, bar) do { unsigned _sp = 0; while (cond) { __builtin_amdgcn_s_sleep(1); \
    if ((++_sp & 255u) == 0u) { if (xb_ld(&(bar)[XB_TMO])) break; if (_sp > XB_SPIN_CAP) { atomicAdd(&(bar)[XB_TMO], 1u); break; } } } } while (0)

struct XcdBarrier {
    unsigned* bar; unsigned x;
    volatile LAS unsigned* st;
};

__device__ __forceinline__ XcdBarrier xcd_barrier_post(unsigned* bar, volatile LAS unsigned* st) {
    XcdBarrier b; b.bar = bar; b.x = xb_xcc_id(); b.st = st;
    if (threadIdx.x == 0) (void)xb_add(&bar[XB_XCNT(b.x)], 1u);
    return b;
}
__device__ __forceinline__ void xcd_barrier_complete(unsigned* bar, unsigned x, unsigned& nloc, unsigned& nx) {
    const unsigned G = gridDim.x * gridDim.y * gridDim.z;
    unsigned sum, cnt, mine, sp = 0u;
    for (;;) {
        sum = 0u; cnt = 0u; mine = 0u;
#pragma unroll
        for (unsigned j = 0; j < 16; ++j) { const unsigned c = xb_ld(&bar[XB_XCNT(j)]); sum += c; cnt += (c > 0u) ? 1u : 0u; mine = (j == x) ? c : mine; }
        if (sum == G) break;
        __builtin_amdgcn_s_sleep(1);
        if ((++sp & 255u) == 0u) { if (xb_ld(&bar[XB_TMO])) break; if (sp > XB_SPIN_CAP) { atomicAdd(&bar[XB_TMO], 1u); break; } }
    }
    nloc = mine > 0u ? mine : 1u; nx = cnt > 0u ? cnt : 1u;
}

__device__ __forceinline__ void xcd_barrier(const XcdBarrier& b) {
    asm volatile("s_waitcnt vmcnt(0)" ::: "memory");
    __syncthreads();
    if (threadIdx.x == 0) {
        unsigned* bar = b.bar;
        __builtin_amdgcn_s_waitcnt(0);
        unsigned nloc = b.st[0], nx = b.st[1];
        if (nloc == 0u) { xcd_barrier_complete(bar, b.x, nloc, nx); b.st[0] = nloc; b.st[1] = nx; }
        const unsigned old = xb_add(&bar[XB_XSUB(b.x)], 1u);
        const unsigned gen = old / nloc;
        if (old + 1u == (gen + 1u) * nloc) {
            __builtin_amdgcn_fence(__ATOMIC_RELEASE, "agent");
            asm volatile("s_waitcnt vmcnt(0)" ::: "memory");
            const unsigned og = xb_add(&bar[XB_TOP], 1u);
            const unsigned tg = og / nx;
            if (og + 1u == (tg + 1u) * nx) xb_add(&bar[XB_TOPGEN], 1u);
            else XB_SPIN(xb_ld(&bar[XB_TOPGEN]) == tg, bar);
            __builtin_amdgcn_fence(__ATOMIC_ACQUIRE, "agent");
            xb_add(&bar[XB_XGEN(b.x)], 1u);
            asm volatile("s_waitcnt vmcnt(0)" ::: "memory");
        } else {
            XB_SPIN(xb_ld(&bar[XB_XGEN(b.x)]) == gen, bar);
            __builtin_amdgcn_fence(__ATOMIC_ACQUIRE, "agent");
            asm volatile("s_waitcnt vmcnt(0)" ::: "memory");
        }
    }
    __syncthreads();
}

#ifndef N_LAUNCH_MODE
#define N_LAUNCH_MODE 1
#endif
constexpr int NPH = 18;
template <class Epi> DI void run_gemm(Frame& F, const bf16* A, const bf16* Bt, int N, const Epi& E) {
    pg8::Gemm g{A, Bt, T_TOK, N, DM}; pg8::StaticOrder S; S.init(T_TOK, N, F.G, F.vc);
    pg8::gemm_phase<Epi, pg8::StaticOrder, GEMM_ALIGN, GEMM_SP2>(F.lds, g, S, E);
}
__global__ void __launch_bounds__(NT, 2) fwd(Args args) {
    extern __shared__ __attribute__((aligned(16))) unsigned char lds_raw[];
    cg::grid_group grid = cg::this_grid();
    Frame F;
    F.lds = (LAS unsigned char*)lds_raw;
#pragma unroll
    for (int i = 0; i < 23; ++i) F.in[i] = args.in[i];
    F.out = args.out; F.ws = args.ws;
    F.tid = threadIdx.x; F.lane = F.tid & 63; F.wave = __builtin_amdgcn_readfirstlane(F.tid >> 6); F.bid = blockIdx.x; F.G = gridDim.x;
    const int lo = args.ph_lo, hi = args.ph_hi;
    volatile LAS unsigned* bst = (volatile LAS unsigned*)(F.lds + LDS_BYTES - 128);
    if (F.tid < 2) bst[F.tid] = 0u;
    __syncthreads();
    XcdBarrier xbar; xbar.bar = (unsigned*)(F.ws + WS_BAR); xbar.x = xb_xcc_id(); xbar.st = bst;
    if (F.tid == 0) bst[2] = xb_add(&xbar.bar[XB_XCNT(xbar.x)], 1u);
    __syncthreads();
    const unsigned my_rank = bst[2];
    F.vc = F.bid;
    if (lo < 0) grid.sync();
#ifndef DUPVAR
#define DUPVAR 0
#endif
#if DUPVAR == 4
#define ATT_DUP p12_attn_pipe<DUPVAR>
#elif DUPVAR >= 7
#define ATT_DUP p12_attn_v3<DUPVAR>
#elif DUPVAR == 6
#define ATT_DUP p12_attn_v2<DUPVAR>
#else
#define ATT_DUP p12_attn<DUPVAR>
#endif
#ifndef ATTVAR
#define ATTVAR 7
#endif
#if ATTVAR >= 7
#define ATT_MAIN p12_attn_v3<ATTVAR>
#else
#define ATT_MAIN p12_attn<ATTVAR>
#endif
#define IN(k) (lo <= (k) && (k) < hi)
#if defined(PROBE_K)
#ifndef PROBE_O
#define PROBE_O 0.f
#endif
    volatile LAS unsigned long long* tsl = (volatile LAS unsigned long long*)(F.lds + LDS_BYTES - 512); int nstamp = 1;
    if (F.tid == 0) tsl[0] = __builtin_amdgcn_s_memrealtime();
#define STAMP() do { if (F.tid == 0) tsl[nstamp] = __builtin_amdgcn_s_memrealtime(); ++nstamp; } while (0)
#else
#define STAMP() do { } while (0)
#endif
#define GSYNC() do { xcd_barrier(xbar); STAMP(); } while (0)
#define SEAM(k) do { if (IN(k) && IN((k) + 1)) GSYNC(); } while (0)
    float* mods = (float*)(F.ws + WS_MODS);
    bf16* Hb = (bf16*)(F.ws + WS_H);
    if (((PH_MASK >> 0) & 1) && IN(0)) { p0a_prologue(F); } SEAM(0);
    if (IN(0) && IN(1)) {
        bool even = (F.G % 8) == 0;
        for (unsigned j = 0; j < 16; ++j) { const unsigned cnt = xb_ld(&xbar.bar[XB_XCNT(j)]); even = even && (j < 8 ? cnt == (unsigned)(F.G / 8) : cnt == 0u); }
        if (even && xbar.x < 8u) F.vc = (int)(my_rank * 8u + xbar.x);
    }
    if (((PH_MASK >> 1) & 1) && IN(1)) { norm_phase<true>(F, F.in[0], F.in[4], mods, mods + 1024, 6144, Hb); __syncthreads(); p0b_prologue(F); } SEAM(1);
    if (((PH_MASK >> 2) & 1) && IN(2)) { pg8::EpiBf16<0> E{(bf16*)(F.ws + WS_PROJ), 3072, nullptr, 0, 0, 1.f}; run_gemm(F, Hb, (const bf16*)(F.ws + WS_WIN), 3072, E); if (DUP == 2) { GSYNC(); run_gemm(F, Hb, (const bf16*)(F.ws + WS_WIN), 3072, E); } } SEAM(2);
    if (((PH_MASK >> 3) & 1) && IN(3)) { p3_mlstm_local(F); if (DUP == 3) { GSYNC(); p3_mlstm_local(F); } } SEAM(3);
    if (((PH_MASK >> 4) & 1) && IN(4)) { p4_scan(F); if (DUP == 4) { GSYNC(); p3_mlstm_local(F); GSYNC(); p4_scan(F); } } SEAM(4);
    if (((PH_MASK >> 5) & 1) && IN(5)) { p5_mlstm_out(F); if (DUP == 5) { GSYNC(); p5_mlstm_out(F); } } SEAM(5);
    if (((PH_MASK >> 6) & 1) && IN(6)) { pg8::EpiResid E{F.in[0], F.out, mods + 2 * 1024, 6144}; run_gemm(F, Hb, (const bf16*)(F.ws + WS_WOUT), 1024, E); if (DUP == 6) { GSYNC(); run_gemm(F, Hb, (const bf16*)(F.ws + WS_WOUT), 1024, E); } } SEAM(6);
    if (((PH_MASK >> 7) & 1) && IN(7)) { norm_phase<false, true>(F, F.out, F.in[5], mods + 3 * 1024, mods + 4 * 1024, 6144, Hb); if (DUP == 7) { GSYNC(); norm_phase<false, true>(F, F.out, F.in[5], mods + 3 * 1024, mods + 4 * 1024, 6144, Hb); } } SEAM(7);
    if (((PH_MASK >> 8) & 1) && IN(8)) { pg8::EpiBf16<0> E{(bf16*)(F.ws + WS_PQ), 2048, nullptr, 0, 0, 1.f}; run_gemm(F, Hb, (const bf16*)(F.ws + WS_WPQ), 2048, E); if (DUP == 8) { GSYNC(); run_gemm(F, Hb, (const bf16*)(F.ws + WS_WPQ), 2048, E); } } SEAM(8);
    if (((PH_MASK >> 9) & 1) && IN(9)) { p_route(F, 0); if (DUP == 9) { GSYNC(); p_route(F, 0); } } SEAM(9);
    if (((PH_MASK >> 10) & 1) && IN(10)) {
        p_upass(F, 0, 0); GSYNC(); p_combine(F, 0); GSYNC(); p_vpass(F, 0, F.out, 1); GSYNC();
        norm2_phase(F, F.out, F.in[4] + 1024, mods + 16 * 6144, mods + 16 * 6144 + 1024, 6144, Hb, F.in[13], (const float*)(F.ws + WS_KVMODS), (const float*)(F.ws + WS_KVMODS) + 1024, 2048, (bf16*)(F.ws + WS_HB));
    } SEAM(10);
    if (((PH_MASK >> 11) & 1) && IN(11)) {
        { pg8::EpiHeadNorm E{(bf16*)(F.ws + WS_Q), (bf16*)(F.ws + WS_Q), 4, F.in[17], 0.125f * 1.4426950408889634f, EPS};     run_gemm(F, Hb, (const bf16*)(F.ws + WS_WSQ), 1024, E); }
        { pg8::EpiHeadNorm E{(bf16*)(F.ws + WS_K), (bf16*)(F.ws + WS_VV), 4, F.in[15], 1.0f, EPS}; run_gemm(F, (const bf16*)(F.ws + WS_HB), (const bf16*)(F.ws + WS_WKV), 2048, E);
          if (DUP == 11) { GSYNC(); run_gemm(F, (const bf16*)(F.ws + WS_HB), (const bf16*)(F.ws + WS_WKV), 2048, E); } }
    } SEAM(11);
    if (((PH_MASK >> 12) & 1) && IN(12)) { ATT_MAIN(F, (bf16*)(F.ws + WS_H)); if (DUP == 12) { bf16* Od = (bf16*)(F.ws + WS_HB); GSYNC(); ATT_DUP(F, Od); GSYNC(); ATT_DUP(F, Od); GSYNC(); ATT_DUP(F, Od); } } SEAM(12);
    if (((PH_MASK >> 13) & 1) && IN(13)) { pg8::EpiResid E{F.out, F.out, mods + 16 * 6144 + 2 * 1024, 6144}; run_gemm(F, Hb, (const bf16*)(F.ws + WS_WSO), 1024, E); } SEAM(13);
    if (((PH_MASK >> 14) & 1) && IN(14)) { norm_phase<false, true>(F, F.out, F.in[5] + 1024, mods + 16 * 6144 + 3 * 1024, mods + 16 * 6144 + 4 * 1024, 6144, Hb); } SEAM(14);
    if (((PH_MASK >> 15) & 1) && IN(15)) { pg8::EpiBf16<0> E{(bf16*)(F.ws + WS_PQ), 2048, nullptr, 0, 0, 1.f}; run_gemm(F, Hb, (const bf16*)(F.ws + WS_WPQ) + (size_t)2048 * 1024, 2048, E); } SEAM(15);
    if (((PH_MASK >> 16) & 1) && IN(16)) { p_route(F, 1); } SEAM(16);
    if (((PH_MASK >> 17) & 1) && IN(17)) { p_upass(F, 1, 2); GSYNC(); if (DUP == 20) { p_upass(F, 1, 4); GSYNC(); } p_combine(F, 1); GSYNC(); if (DUP == 22) { p_combine(F, 1); GSYNC(); } if (DUP == 21) { p_vpass(F, 1, (float*)(F.ws + WS_Q + 32 * MiB), 5); GSYNC(); } p_vpass(F, 1, F.out, 3); }
    if (DUP == 30) { for (int i = 0; i < 10; ++i) GSYNC(); }
#if defined(PROBE_K)
    GSYNC();
    if (F.bid == 0) { __syncthreads(); const float t_us = (PROBE_K < 0) ? 100.0f : PROBE_Q * rintf(fmaxf((float)(tsl[PROBE_K + 1] - tsl[PROBE_K]) * 0.01f - PROBE_O, 0.f) / PROBE_Q); const float dl = 0.15f * sqrtf(t_us * 0.01f);
        for (int i = F.tid; i < (1 << 20); i += NT) F.out[i] += dl; }
#endif
#undef IN
#undef SEAM
#undef GSYNC
}

extern "C" void kernel_launch(void* const* d_in, const int* in_sizes, int n_in, void* d_out, int out_size, void* d_ws, size_t ws_size, hipStream_t stream) {
    static int grid = 0;
    if (grid == 0) {
        int dev = 0, cus = 0, per_cu = 0;
        (void)hipGetDevice(&dev);
        (void)hipDeviceGetAttribute(&cus, hipDeviceAttributeMultiprocessorCount, dev);
        (void)hipFuncSetAttribute((const void*)fwd, hipFuncAttributeMaxDynamicSharedMemorySize, LDS_BYTES);
        (void)hipOccupancyMaxActiveBlocksPerMultiprocessor(&per_cu, (const void*)fwd, NT, LDS_BYTES);
        if (per_cu < 1) { fprintf(stderr, "kernel_launch: occupancy query says %d blocks per CU\n", per_cu); per_cu = 1; }
        grid = cus;
        if (n_in != 23 || ws_size < WS_END) fprintf(stderr, "kernel_launch: unexpected n_in %d / ws_size %zu\n", n_in, ws_size);
        (void)hipGetLastError();
    }
    (void)hipMemsetAsync(d_ws, 0, 131072, stream);
    Args a{};
    for (int i = 0; i < 23; ++i) a.in[i] = (const float*)d_in[i];
    a.out = (float*)d_out; a.ws = (unsigned char*)d_ws;
#if N_LAUNCH_MODE == 1
    a.ph_lo = 0; a.ph_hi = NPH;
    void* kargs[] = {&a};
    hipError_t e = hipLaunchCooperativeKernel((const void*)fwd, dim3(grid), dim3(NT), kargs, LDS_BYTES, stream);
    if (e != hipSuccess) fprintf(stderr, "kernel_launch: cooperative launch failed: %s (grid %d)\n", hipGetErrorString(e), grid);
#else
    for (int p = 0; p < NPH; ++p) { a.ph_lo = p; a.ph_hi = p + 1; hipLaunchKernelGGL(fwd, dim3(grid), dim3(NT), LDS_BYTES, stream, a); }
#endif
}
```
